# Optimizing an MI355X kernel written in HIP

```python
import math
import jax, jax.numpy as jnp
from jax import lax
import numpy as np

D_MODEL = 1024
BATCH = 16
SEQ = 2048
DEPTH = 1

N_MEM = 256
FOX_WIDTH = D_MODEL // 2
HEAD_DIM = 64
N_FOX_HEADS = FOX_WIDTH // HEAD_DIM
Q_BLOCK = 128
S5_WIDTH = D_MODEL - FOX_WIDTH
S5_GROUP_CH = 16
S5_GROUPS = S5_WIDTH // S5_GROUP_CH
S5_STATE = 64
N_X_HEADS = 4
X_HEAD_DIM = D_MODEL // N_X_HEADS
D_FF = 128 * ((8 * D_MODEL // 3 + 127) // 128)
CONV_W = 3
IN_COLS = 3 * FOX_WIDTH + N_FOX_HEADS + S5_WIDTH
EPS = 1e-6

kernel_name = "fox_s5_parallel_hybrid_layer"


def _rms_norm(x, g):
    xf = x.astype(jnp.float32)
    y = xf * lax.rsqrt(jnp.mean(xf * xf, axis=-1, keepdims=True) + EPS)
    return (y * g.astype(jnp.float32)).astype(x.dtype)


def _fox_attention(q, k, v, log_f):
    L = q.shape[2]
    c = jnp.cumsum(log_f, axis=-1)
    scale = HEAD_DIM ** -0.5
    outs = []
    for blk in range(L // Q_BLOCK):
        qs = blk * Q_BLOCK
        ke = qs + Q_BLOCK
        s = jnp.einsum('bhqd,bhkd->bhqk', q[:, :, qs:ke], k[:, :, :ke]).astype(jnp.float32) * scale
        s = s + c[:, :, qs:ke, None] - c[:, :, None, :ke]
        mask = jnp.arange(ke)[None, :] <= (qs + jnp.arange(Q_BLOCK))[:, None]
        s = jnp.where(mask, s, -jnp.inf)
        p = jax.nn.softmax(s, axis=-1).astype(v.dtype)
        outs.append(jnp.einsum('bhqk,bhkd->bhqd', p, v[:, :, :ke]))
    return jnp.concatenate(outs, axis=2)


def _cdiag_combine(left, right):
    a1r, a1i, b1r, b1i = left
    a2r, a2i, b2r, b2i = right
    ar = a2r * a1r - a2i * a1i
    ai = a2r * a1i + a2i * a1r
    br = a2r * b1r - a2i * b1i + b2r
    bi = a2r * b1i + a2i * b1r + b2i
    return (ar, ai, br, bi)


def _s5(u, a_re, a_im, log_dt, b_re, b_im, c_re, c_im, d):
    Bsz, L, _ = u.shape
    uf = u.astype(jnp.float32).reshape(Bsz, L, S5_GROUPS, S5_GROUP_CH)
    ar = a_re.astype(jnp.float32)
    ai = a_im.astype(jnp.float32)
    dt = jnp.exp(log_dt.astype(jnp.float32))[:, None]
    mag = jnp.exp(ar * dt)
    lb_r = mag * jnp.cos(ai * dt)
    lb_i = mag * jnp.sin(ai * dt)
    den = ar * ar + ai * ai
    nr = lb_r - 1.0
    coef_r = (nr * ar + lb_i * ai) / den
    coef_i = (lb_i * ar - nr * ai) / den
    br = b_re.astype(jnp.float32)
    bi = b_im.astype(jnp.float32)
    bb_r = coef_r[:, :, None] * br - coef_i[:, :, None] * bi
    bb_i = coef_r[:, :, None] * bi + coef_i[:, :, None] * br
    bu_r = jnp.einsum('blgc,gpc->lbgp', uf, bb_r)
    bu_i = jnp.einsum('blgc,gpc->lbgp', uf, bb_i)
    a_r = jnp.broadcast_to(lb_r[None, None], (L, 1, S5_GROUPS, S5_STATE))
    a_i = jnp.broadcast_to(lb_i[None, None], (L, 1, S5_GROUPS, S5_STATE))
    _, _, xr, xi = lax.associative_scan(_cdiag_combine, (a_r, a_i, bu_r, bu_i), axis=0)
    y = (jnp.einsum('lbgp,gcp->blgc', xr, c_re.astype(jnp.float32))
         - jnp.einsum('lbgp,gcp->blgc', xi, c_im.astype(jnp.float32))
         + d.astype(jnp.float32) * uf)
    return y.reshape(Bsz, L, S5_WIDTH)


def _causal_dwconv(a, w, b):
    L = a.shape[1]
    ap = jnp.pad(a, ((0, 0), (CONV_W - 1, 0), (0, 0)))
    out = b
    for i in range(CONV_W):
        out = out + w[i] * ap[:, i:i + L]
    return out


def setup_inputs(seed: int = 0) -> dict:
    key = jax.random.key(seed)
    ks = jax.random.split(key, 40)
    f32 = jnp.float32

    def nrm(k, shape, scale):
        return jax.random.normal(k, shape, f32) * scale

    def gain(k, shape):
        return 1.0 + 0.02 * jax.random.normal(k, shape, f32)

    Ld = DEPTH
    n_idx = jnp.arange(S5_STATE, dtype=f32)
    inp = {
        "x": jax.random.normal(ks[0], (BATCH, SEQ, D_MODEL), f32),
        "mem": jax.random.normal(ks[1], (BATCH, N_MEM, D_MODEL), f32),
        "norm_mix": gain(ks[2], (Ld, D_MODEL)),
        "w_in": nrm(ks[3], (Ld, D_MODEL, IN_COLS), D_MODEL ** -0.5),
        "fox_q_norm": gain(ks[4], (Ld, HEAD_DIM)),
        "fox_k_norm": gain(ks[5], (Ld, HEAD_DIM)),
        "fox_f_bias": 3.0 + 0.5 * jax.random.normal(ks[6], (Ld, N_FOX_HEADS), f32),
        "s5_a_re": -0.5 + 0.01 * jax.random.normal(ks[7], (Ld, S5_GROUPS, S5_STATE), f32),
        "s5_a_im": math.pi * n_idx[None, None, :] + 0.01 * jax.random.normal(ks[8], (Ld, S5_GROUPS, S5_STATE), f32),
        "s5_log_dt": jax.random.uniform(ks[9], (Ld, S5_GROUPS), f32, math.log(1e-3), math.log(1e-1)),
        "s5_b_re": nrm(ks[10], (Ld, S5_GROUPS, S5_STATE, S5_GROUP_CH), (2 * S5_GROUP_CH) ** -0.5),
        "s5_b_im": nrm(ks[11], (Ld, S5_GROUPS, S5_STATE, S5_GROUP_CH), (2 * S5_GROUP_CH) ** -0.5),
        "s5_c_re": nrm(ks[12], (Ld, S5_GROUPS, S5_GROUP_CH, S5_STATE), (2 * S5_STATE) ** -0.5),
        "s5_c_im": nrm(ks[13], (Ld, S5_GROUPS, S5_GROUP_CH, S5_STATE), (2 * S5_STATE) ** -0.5),
        "s5_d": nrm(ks[14], (Ld, S5_GROUPS, S5_GROUP_CH), 1.0),
        "s5_w_glu": nrm(ks[15], (Ld, S5_WIDTH, S5_WIDTH), S5_WIDTH ** -0.5),
        "s5_b_glu": nrm(ks[16], (Ld, S5_WIDTH), 0.02),
        "out_norm_fox": gain(ks[17], (Ld, FOX_WIDTH)),
        "out_norm_s5": gain(ks[18], (Ld, S5_WIDTH)),
        "w_out": nrm(ks[19], (Ld, D_MODEL, D_MODEL), D_MODEL ** -0.5),
        "norm_cross": gain(ks[20], (Ld, D_MODEL)),
        "norm_mem": gain(ks[21], (Ld, D_MODEL)),
        "w_xq": nrm(ks[22], (Ld, D_MODEL, D_MODEL), D_MODEL ** -0.5),
        "w_xkv": nrm(ks[23], (Ld, D_MODEL, 2 * D_MODEL), D_MODEL ** -0.5),
        "xq_norm": gain(ks[24], (Ld, X_HEAD_DIM)),
        "xk_norm": gain(ks[25], (Ld, X_HEAD_DIM)),
        "w_xo": nrm(ks[26], (Ld, D_MODEL, D_MODEL), D_MODEL ** -0.5),
        "norm_ffn": gain(ks[27], (Ld, D_MODEL)),
        "w_ffn_up": nrm(ks[28], (Ld, D_MODEL, 2 * D_FF), D_MODEL ** -0.5),
        "ffn_conv_w": nrm(ks[29], (Ld, CONV_W, D_FF), CONV_W ** -0.5),
        "ffn_conv_b": nrm(ks[30], (Ld, D_FF), 0.02),
        "w_ffn_down": nrm(ks[31], (Ld, D_FF, D_MODEL), D_FF ** -0.5),
    }
    return inp


def reference(x, mem, norm_mix, w_in, fox_q_norm, fox_k_norm, fox_f_bias,
              s5_a_re, s5_a_im, s5_log_dt, s5_b_re, s5_b_im, s5_c_re, s5_c_im,
              s5_d, s5_w_glu, s5_b_glu, out_norm_fox, out_norm_s5, w_out,
              norm_cross, norm_mem, w_xq, w_xkv, xq_norm, xk_norm, w_xo,
              norm_ffn, w_ffn_up, ffn_conv_w, ffn_conv_b, w_ffn_down):
    Bsz, L, _ = x.shape
    h = x
    for l in range(DEPTH):
        hn = _rms_norm(h, norm_mix[l])
        proj = hn @ w_in[l]
        q, k, v, f_logit, u = jnp.split(
            proj, [FOX_WIDTH, 2 * FOX_WIDTH, 3 * FOX_WIDTH, 3 * FOX_WIDTH + N_FOX_HEADS], axis=-1)
        q = _rms_norm(q.reshape(Bsz, L, N_FOX_HEADS, HEAD_DIM), fox_q_norm[l]).transpose(0, 2, 1, 3)
        k = _rms_norm(k.reshape(Bsz, L, N_FOX_HEADS, HEAD_DIM), fox_k_norm[l]).transpose(0, 2, 1, 3)
        v = v.reshape(Bsz, L, N_FOX_HEADS, HEAD_DIM).transpose(0, 2, 1, 3)
        log_f = jax.nn.log_sigmoid(f_logit.astype(jnp.float32) + fox_f_bias[l].astype(jnp.float32))
        fox = _fox_attention(q, k, v, log_f.transpose(0, 2, 1))
        fox = fox.transpose(0, 2, 1, 3).reshape(Bsz, L, FOX_WIDTH)

        y = _s5(u, s5_a_re[l], s5_a_im[l], s5_log_dt[l], s5_b_re[l], s5_b_im[l],
                s5_c_re[l], s5_c_im[l], s5_d[l])
        y = jax.nn.gelu(y)
        y = y * jax.nn.sigmoid(y @ s5_w_glu[l].astype(jnp.float32) + s5_b_glu[l].astype(jnp.float32))
        y = y.astype(h.dtype)

        mixed = jnp.concatenate([_rms_norm(fox, out_norm_fox[l]), _rms_norm(y, out_norm_s5[l])], axis=-1)
        h = h + mixed @ w_out[l]

        hn = _rms_norm(h, norm_cross[l])
        mn = _rms_norm(mem, norm_mem[l])
        xq = _rms_norm((hn @ w_xq[l]).reshape(Bsz, L, N_X_HEADS, X_HEAD_DIM), xq_norm[l])
        xk, xv = jnp.split(mn @ w_xkv[l], 2, axis=-1)
        xk = _rms_norm(xk.reshape(Bsz, N_MEM, N_X_HEADS, X_HEAD_DIM), xk_norm[l])
        xv = xv.reshape(Bsz, N_MEM, N_X_HEADS, X_HEAD_DIM)
        s = jnp.einsum('bqhd,bmhd->bhqm', xq, xk).astype(jnp.float32) * (X_HEAD_DIM ** -0.5)
        p = jax.nn.softmax(s, axis=-1).astype(xv.dtype)
        xo = jnp.einsum('bhqm,bmhd->bqhd', p, xv).reshape(Bsz, L, D_MODEL)
        h = h + xo @ w_xo[l]

        hn = _rms_norm(h, norm_ffn[l])
        gate, up = jnp.split(hn @ w_ffn_up[l], 2, axis=-1)
        gate = _causal_dwconv(gate, ffn_conv_w[l], ffn_conv_b[l])
        h = h + (jax.nn.silu(gate) * up) @ w_ffn_down[l]
    return h
```

```cpp
#include <hip/hip_runtime.h>
#include <hip/hip_cooperative_groups.h>
#include <hip/hip_bf16.h>
#include <cstdio>
#include <cstdint>
#include <cmath>
namespace cg = cooperative_groups;

#ifndef DBG_SSM
#define DBG_SSM 1.f
#endif
#ifndef DBG_BIAS
#define DBG_BIAS 1.f
#endif
#ifndef DBG_SLOWATTN
#define DBG_SLOWATTN 0
#endif
#ifndef DBG_NOFOXH
#define DBG_NOFOXH 0
#endif
#ifndef DBG_NOS5H
#define DBG_NOS5H 0
#endif
#ifndef DBG_SLOWQKV
#define DBG_SLOWQKV 0
#endif
#ifndef DBG_CROSS
#define DBG_CROSS 1.f
#endif
#ifndef DBG_MIX
#define DBG_MIX 1.f
#endif
#ifndef DBG_FFN
#define DBG_FFN 1.f
#endif
constexpr int BATCH = 16, SEQ = 2048, DM = 1024, T = BATCH * SEQ;
constexpr int NMEM = 256, TM = BATCH * NMEM;
constexpr int FOXW = 512, HD = 64, NFH = 8;
constexpr int S5W = 512, S5G = 32, S5C = 16, S5P = 64;
constexpr int NXH = 4, XHD = 256;
constexpr int DFF = 2816;
constexpr int INCOLS = 2056;
constexpr float EPS = 1e-6f;
constexpr int TC = 32, NCH = SEQ / TC;
constexpr int UGP = TC * 16 + 128;
constexpr float LOG2E = 1.4426950408889634f;
constexpr float C2Q = 0.125f * LOG2E;

#define LAS __attribute__((address_space(3)))
typedef unsigned short bf16_t;
typedef short bf16x8 __attribute__((ext_vector_type(8)));
typedef float f32x4 __attribute__((ext_vector_type(4)));
typedef float f32x2 __attribute__((ext_vector_type(2)));
typedef unsigned u32x4 __attribute__((ext_vector_type(4)));
typedef unsigned u32x2 __attribute__((ext_vector_type(2)));

__device__ __forceinline__ unsigned f2bf(float f) { unsigned u = __builtin_bit_cast(unsigned, f); return (u + 0x7fffu + ((u >> 16) & 1u)) >> 16; }
__device__ __forceinline__ unsigned pk2(float lo, float hi) { return f2bf(lo) | (f2bf(hi) << 16); }
__device__ __forceinline__ float bflo(unsigned w) { return __builtin_bit_cast(float, w << 16); }
__device__ __forceinline__ float bfhi(unsigned w) { return __builtin_bit_cast(float, w & 0xffff0000u); }
__device__ __forceinline__ float wave_sum(float v) {
#pragma unroll
    for (int o = 1; o < 64; o <<= 1) v += __shfl_xor(v, o);
    return v;
}

__device__ __forceinline__ float red_fq(float v) {
    v += __builtin_bit_cast(float, __builtin_amdgcn_ds_swizzle(__builtin_bit_cast(int, v), 0x401F));
    float a = v, b = v;
    asm volatile("s_nop 1\n\tv_permlane32_swap_b32 %0, %1\n\ts_nop 1" : "+v"(a), "+v"(b));
    return a + b;
}

constexpr size_t MiB = 1u << 20;
constexpr size_t WS_WIN = 1 * MiB, WS_WGLU = 5 * MiB, WS_WOUT = 6 * MiB, WS_WXQ = 8 * MiB, WS_WXK = 10 * MiB, WS_WXV = 12 * MiB, WS_WXO = 14 * MiB,
                 WS_WUP = 16 * MiB, WS_WDN = 27 * MiB, WS_BTY = 33 * MiB, WS_BTE = 53 * MiB, WS_KTAB = 61 * MiB, WS_LB32 = 62 * MiB, WS_LOGF = 63 * MiB,
                 WS_CB = 64 * MiB, WS_SSQF = 65 * MiB, WS_SSQY = 66 * MiB, WS_SSQ1 = 67 * MiB, WS_SSQ2 = 69 * MiB, WS_SSQQ = 71 * MiB, WS_PSUM = 73 * MiB,
                 WS_SSQK = 75 * MiB, WS_SCK = 76 * MiB;
constexpr size_t WS_HN = 80 * MiB, WS_FOX = 80 * MiB, WS_Y1 = 112 * MiB, WS_QST = 80 * MiB, WS_H2B = 80 * MiB;
constexpr size_t WS_MN = 144 * MiB, WS_KST = 152 * MiB, WS_VT = 160 * MiB;
constexpr size_t WS_Q = 168 * MiB, WS_K = 200 * MiB, WS_V = 232 * MiB, WS_Y2 = 168 * MiB, WS_MIXN = 200 * MiB, WS_P = 168 * MiB;
constexpr size_t WS_UG = 264 * MiB, WS_EPART = 304 * MiB, WS_H1B = 264 * MiB, WS_XO = 264 * MiB;
constexpr size_t WS_G = 144 * MiB, WS_U = 320 * MiB, WS_END = 496 * MiB;

namespace pg8 {
constexpr int BM = 256, BK = 64, HALF = 128, HTB = HALF * BK * 2, STAGE_BYTES = 8 * HTB;
__device__ __forceinline__ int lds_byte(int r, int c) { const int st = (r >> 4) * 2 + (c >> 5), rr = r & 15, cc = c & 31, ob = rr * 64 + cc * 2; return st * 1024 + (ob ^ (((ob >> 9) & 1) << 5)); }
__device__ __forceinline__ void stage_rc(int b, int& R, int& C) { const int st = b / 1024, sb = b % 1024, swz = sb ^ (((sb >> 9) & 1) << 5); R = (st >> 1) * 16 + swz / 64; C = (st & 1) * 32 + (swz % 64) / 2; }
__device__ __forceinline__ int perm32(int rho) { const int n = rho >> 4, i = rho & 15; return 8 * (i >> 2) + 4 * n + (i & 3); }

struct Unit { int pm, pn; long offA, offB; };
struct Gemm { const bf16_t* A; const bf16_t* Bt; int lda, ldb, K; };

template <class Epi, class Sched>
__device__ __forceinline__ void gemm_phase(LAS unsigned char* lds, const Gemm g, const Sched& S, const Epi& E, unsigned* dbg = nullptr) {
    int tid = threadIdx.x; asm volatile("" : "+v"(tid));
    const int wid = __builtin_amdgcn_readfirstlane(tid >> 6), lane = tid & 63, wr = wid >> 2, wc = wid & 3, fr = lane & 15, fq = lane >> 4;
    const int K = g.K, nt = K / BK;
    unsigned voffA[2], voffB[2];
#pragma unroll
    for (int i = 0; i < 2; ++i) { int R, C; stage_rc(tid * 16 + i * 8192, R, C); const int Rb = (R & ~31) + perm32(R & 31);
        voffA[i] = (unsigned)(R * g.lda + C) * 2u; voffB[i] = (unsigned)(Rb * g.ldb + C) * 2u; }
    const size_t kstep = (size_t)(BK * 2);
    const size_t hstepA = (size_t)HALF * g.lda * 2, hstepB = (size_t)HALF * g.ldb * 2;
    const unsigned ldsw = (unsigned)wid * 1024u;
    const int aoff = lds_byte(wr * 64 + fr, fq * 8), boff = lds_byte(wc * 32 + fr, fq * 8);
#define PG8_SA(b, h) (((b) * 2 + (h)) * HTB)
#define PG8_SB(b, h) ((4 + (b) * 2 + (h)) * HTB)
#define PG8_STAGE(bufoff, gbase, voff) do { _Pragma("unroll") for (int _i = 0; _i < 2; ++_i) \
        __builtin_amdgcn_global_load_lds((const unsigned*)((const char*)(gbase) + (voff)[_i]), (LAS unsigned*)(lds + (bufoff) + ldsw + _i * 8192), 16, 0, 0); } while (0)
#define PG8_LDA(dst, b, h) do { _Pragma("unroll") for (int m = 0; m < 4; ++m) _Pragma("unroll") for (int k = 0; k < 2; ++k) dst[m][k] = *(const LAS bf16x8*)(lds + PG8_SA(b, h) + aoff + m * 2048 + k * 1024); } while (0)
#define PG8_LDB(dst, b, h) do { _Pragma("unroll") for (int n = 0; n < 2; ++n) _Pragma("unroll") for (int k = 0; k < 2; ++k) dst[n][k] = *(const LAS bf16x8*)(lds + PG8_SB(b, h) + boff + n * 2048 + k * 1024); } while (0)
#define PG8_MMA(ai, bj, At, Bt) do { __builtin_amdgcn_s_setprio(1); _Pragma("unroll") for (int m = 0; m < 4; ++m) _Pragma("unroll") for (int n = 0; n < 2; ++n) _Pragma("unroll") for (int k = 0; k < 2; ++k) \
        acc[ai][bj][m][n] = __builtin_amdgcn_mfma_f32_16x16x32_bf16(Bt[n][k], At[m][k], acc[ai][bj][m][n], 0, 0, 0); __builtin_amdgcn_s_setprio(0); } while (0)
#define PG8_WAIT_V(n) asm volatile("s_waitcnt vmcnt(" #n ")" ::: "memory")
#define PG8_WAIT_L(n) asm volatile("s_waitcnt lgkmcnt(" #n ")" ::: "memory")
#define PG8_BAR __builtin_amdgcn_s_barrier()
#define PG8_SCHED __builtin_amdgcn_sched_barrier(0)
    Unit cur, nxt; int ui = 0;
    if (!S.next(0, cur)) return;
    f32x4 acc[2][2][4][2];
#pragma unroll
    for (int a = 0; a < 2; ++a)
#pragma unroll
        for (int b = 0; b < 2; ++b)
#pragma unroll
            for (int m = 0; m < 4; ++m)
#pragma unroll
                for (int n = 0; n < 2; ++n) acc[a][b][m][n] = (f32x4){0.f, 0.f, 0.f, 0.f};
    bf16x8 At[4][2], B0[2][2], B1[2][2];
    const char* cA = (const char*)g.A + cur.offA; const char* cB = (const char*)g.Bt + cur.offB;
    PG8_STAGE(PG8_SB(0, 0), cB, voffB); PG8_STAGE(PG8_SB(0, 1), cB + hstepB, voffB); PG8_STAGE(PG8_SA(0, 0), cA, voffA); PG8_STAGE(PG8_SA(0, 1), cA + hstepA, voffA);
    if (wr == 1) PG8_BAR;
    PG8_WAIT_V(2); PG8_BAR;
    PG8_STAGE(PG8_SB(1, 0), cB + kstep, voffB); PG8_STAGE(PG8_SA(1, 0), cA + kstep, voffA); PG8_STAGE(PG8_SB(1, 1), cB + hstepB + kstep, voffB);
    PG8_WAIT_V(6); PG8_BAR;
    for (;;) {
        const bool has_next = S.next(ui + 1, nxt);
        const char* nA = has_next ? (const char*)g.A + nxt.offA : cA; const char* nB = has_next ? (const char*)g.Bt + nxt.offB : cB;
        for (int t = 0; t < nt; t += 2) {
            const bool last = (t == nt - 2);
            const char* a1 = cA + (size_t)(t + 1) * kstep;
            const char* a2 = last ? nA : cA + (size_t)(t + 2) * kstep; const char* b2 = last ? nB : cB + (size_t)(t + 2) * kstep;
            const char* a3 = a2 + kstep; const char* b3 = b2 + kstep;
            PG8_LDB(B0, 0, 0); PG8_LDB(B1, 0, 1); PG8_SCHED; PG8_LDA(At, 0, 0); PG8_STAGE(PG8_SA(1, 1), a1 + hstepA, voffA);
            PG8_WAIT_V(8); PG8_WAIT_L(0); PG8_BAR; PG8_MMA(0, 0, At, B0); PG8_MMA(0, 1, At, B1); PG8_BAR; PG8_SCHED;
            PG8_LDA(At, 0, 1); PG8_STAGE(PG8_SB(0, 0), b2, voffB); PG8_STAGE(PG8_SB(0, 1), b2 + hstepB, voffB); PG8_STAGE(PG8_SA(0, 0), a2, voffA);
            PG8_WAIT_V(8); PG8_WAIT_L(0); PG8_BAR; PG8_MMA(1, 0, At, B0); PG8_MMA(1, 1, At, B1); PG8_BAR; PG8_SCHED;
            PG8_LDB(B0, 1, 0); PG8_LDB(B1, 1, 1); PG8_SCHED; PG8_LDA(At, 1, 0); PG8_STAGE(PG8_SA(0, 1), a2 + hstepA, voffA);
            PG8_WAIT_V(8); PG8_WAIT_L(0); PG8_BAR; PG8_MMA(0, 0, At, B0); PG8_MMA(0, 1, At, B1); PG8_BAR; PG8_SCHED;
            PG8_LDA(At, 1, 1); PG8_STAGE(PG8_SB(1, 0), b3, voffB); PG8_STAGE(PG8_SB(1, 1), b3 + hstepB, voffB); PG8_STAGE(PG8_SA(1, 0), a3, voffA);
            PG8_WAIT_V(8); PG8_WAIT_L(0); PG8_BAR; PG8_MMA(1, 0, At, B0); PG8_MMA(1, 1, At, B1); PG8_BAR; PG8_SCHED;
        }
        if (wr == 0) PG8_BAR;
        { int fr2 = fr, fq2 = fq; asm volatile("" : "+v"(fr2), "+v"(fq2));
          if (dbg && fr2 == 0 && fq2 == 0) {
              const bf16_t* ar = (const bf16_t*)((const char*)g.A + cur.offA) + (size_t)(wr * 64) * g.lda; const bf16_t* br = (const bf16_t*)((const char*)g.Bt + cur.offB) + (size_t)(wc * 32) * g.ldb;
              float ref = 0.f; for (int k = 0; k < K; ++k) ref += __builtin_bit_cast(float, (unsigned)ar[k] << 16) * __builtin_bit_cast(float, (unsigned)br[k] << 16);
              const float got = acc[0][0][0][0][0]; if (!(fabsf(got - ref) <= 0.02f * fmaxf(1.f, fabsf(ref)))) atomicAdd(dbg, 1u); }
          E(acc, cur, wr, wc, fr2, fq2); }
        if (!has_next) break;
#pragma unroll
        for (int a = 0; a < 2; ++a)
#pragma unroll
            for (int b = 0; b < 2; ++b)
#pragma unroll
                for (int m = 0; m < 4; ++m)
#pragma unroll
                    for (int n = 0; n < 2; ++n) acc[a][b][m][n] = (f32x4){0.f, 0.f, 0.f, 0.f};
        cur = nxt; cA = nA; cB = nB; ++ui;
        if (wr == 1) PG8_BAR;
    }
    PG8_WAIT_V(0);
    PG8_BAR;
#undef PG8_SA
#undef PG8_SB
#undef PG8_STAGE
#undef PG8_LDA
#undef PG8_LDB
#undef PG8_MMA
#undef PG8_WAIT_V
#undef PG8_WAIT_L
#undef PG8_BAR
#undef PG8_SCHED
}
}
using pg8::Unit;

enum OrderKind { OK_PLAIN = 0, OK_S5E, OK_S5Y, OK_XS, OK_XO };
template <int kind> struct GOrder {
    int nM, nN, nwg, G, c, lda, ldb;
    __device__ __forceinline__ void init(int nM_, int nN_, int G_, int c_, int lda_, int ldb_) { nM = nM_; nN = nN_; nwg = nM_ * nN_; G = G_; c = c_; lda = lda_; ldb = ldb_; }
    __device__ __forceinline__ bool next(int i, Unit& u) const {
        const long L = (long)i * G + c; if (L >= nwg) return false;
        const int l = (int)L;
        if constexpr (kind == OK_PLAIN) {
            int wgid = l; { const int q = nwg / 8, r = nwg % 8, xcd = wgid % 8, off = wgid / 8; wgid = (xcd < r ? xcd * (q + 1) : r * (q + 1) + (xcd - r) * q) + off; }
            const int nig = 8 * nN, gid = wgid / nig, fm = gid * 8, gsz = (nM - fm) < 8 ? (nM - fm) : 8;
            u.pm = fm + ((wgid % nig) % gsz); u.pn = (wgid % nig) / gsz;
            u.offA = (long)u.pm * 256 * lda * 2; u.offB = (long)u.pn * 256 * ldb * 2;
        } else if constexpr (kind == OK_S5E) {
            const int kq = l & 1, pmm = (l >> 1) & 3, gg = l >> 3;
            u.pm = gg * 4 + pmm; u.pn = kq;
            u.offA = ((long)u.pm * 256 * UGP + kq * 256) * 2; u.offB = ((long)gg * 256 * 512 + kq * 256) * 2;
        } else if constexpr (kind == OK_S5Y) {
            const int pn = l & 1, pmm = (l >> 1) & 3, gg = l >> 3;
            u.pm = gg * 4 + pmm; u.pn = pn;
            u.offA = (long)u.pm * 256 * UGP * 2; u.offB = ((long)gg * 512 + pn * 256) * UGP * 2;
        } else if constexpr (kind == OK_XS) {
            const int h = l & 3, pm = l >> 2, b = pm >> 3;
            u.pm = pm; u.pn = h;
            u.offA = ((long)pm * 256 * DM + h * 256) * 2; u.offB = ((long)b * 256 * DM + h * 256) * 2;
        } else {
            const int h = l & 3, pm = l >> 2, b = pm >> 3;
            u.pm = pm; u.pn = h;
            u.offA = ((long)pm * 256 * DM + h * 256) * 2; u.offB = ((long)h * 256 * TM + b * 256) * 2;
        }
        return true;
    }
};

enum EpiKind { EK_PROJ = 0, EK_MEMK, EK_MEMVT, EK_S5E, EK_S5Y, EK_GLU, EK_WOUT, EK_XQ, EK_XS, EK_XO, EK_WXO, EK_UP, EK_DOWN };
    __device__ __forceinline__ u32x4 pack8(const f32x4 a, const f32x4 b) { u32x4 w; w.x = pk2(a[0], a[1]); w.y = pk2(a[2], a[3]); w.z = pk2(b[0], b[1]); w.w = pk2(b[2], b[3]); return w; }
    __device__ __forceinline__ float gelu_t(float y) { const float z = 0.7978845608028654f * (y + 0.044715f * y * y * y); const float e = __expf(2.f * z); const float th = 1.f - 2.f / (e + 1.f); return 0.5f * y * (1.f + th); }
    __device__ __forceinline__ float sigm(float z) { return 1.f / (1.f + __expf(-z)); }
    __device__ __forceinline__ float ssq8(const f32x4 a, const f32x4 b) { return (a[0] * a[0] + a[1] * a[1]) + (a[2] * a[2] + a[3] * a[3]) + (b[0] * b[0] + b[1] * b[1]) + (b[2] * b[2] + b[3] * b[3]); }

template <int kind> struct Epi {
    void* p0; void* p1; void* p2; void* p3; const void* c0; const void* c1; const void* c2;
    __device__ __forceinline__ void operator()(const f32x4 (&acc)[2][2][4][2], const Unit& u, int wr, int wc, int fr, int fq) const {
        const int rbase = u.pm * 256 + wr * 64 + fr;
        const int cl0 = wc * 32 + 8 * fq;
        switch (kind) {
        case EK_PROJ: {
            const int pn = u.pn;
            if (pn < 4) {
                const bool isq = pn < 2; bf16_t* dst = (bf16_t*)(isq ? p0 : p1); const float* gptr = (const float*)(isq ? c0 : c1); const float post = isq ? C2Q : 1.f;
                const int head = 4 * (pn & 1) + wc;
#pragma unroll
                for (int ai = 0; ai < 2; ++ai)
#pragma unroll
                    for (int m = 0; m < 4; ++m) {
                        float ss = ssq8(acc[ai][0][m][0], acc[ai][0][m][1]) + ssq8(acc[ai][1][m][0], acc[ai][1][m][1]);
                        ss = red_fq(ss);
                        const float sc = rsqrtf(ss * (1.f / 64.f) + EPS) * post;
                        const size_t row = (size_t)(rbase + ai * 128 + m * 16);
#pragma unroll
                        for (int bj = 0; bj < 2; ++bj)
                            *(u32x4*)(dst + row * 512 + head * 64 + 32 * bj + 8 * fq) = pack8(acc[ai][bj][m][0] * sc * *(const f32x4*)(gptr + 32 * bj + 8 * fq), acc[ai][bj][m][1] * sc * *(const f32x4*)(gptr + 32 * bj + 8 * fq + 4));
                    }
            } else if (pn < 6) {
                bf16_t* dst = (bf16_t*)p2;
#pragma unroll
                for (int ai = 0; ai < 2; ++ai)
#pragma unroll
                    for (int m = 0; m < 4; ++m) { const size_t row = (size_t)(rbase + ai * 128 + m * 16);
#pragma unroll
                        for (int bj = 0; bj < 2; ++bj) *(u32x4*)(dst + row * 512 + (pn - 4) * 256 + bj * 128 + cl0) = pack8(acc[ai][bj][m][0], acc[ai][bj][m][1]); }
            } else {
                bf16_t* dst = (bf16_t*)p3;
#pragma unroll
                for (int ai = 0; ai < 2; ++ai)
#pragma unroll
                    for (int m = 0; m < 4; ++m) { const int row = rbase + ai * 128 + m * 16; const int b = row >> 11, t = row & 2047, ch = t >> 5, s = t & 31;
#pragma unroll
                        for (int bj = 0; bj < 2; ++bj) { const int f = (pn - 6) * 256 + bj * 128 + cl0; const int gI = f >> 4, cc = f & 15;
                            *(u32x4*)(dst + ((size_t)(gI * 1024 + b * 64 + ch)) * UGP + s * 16 + cc) = pack8(acc[ai][bj][m][0], acc[ai][bj][m][1]); } }
            }
        } break;
        case EK_MEMK: {
            bf16_t* dst = (bf16_t*)p0; float* sq = (float*)p1;
#pragma unroll
            for (int ai = 0; ai < 2; ++ai)
#pragma unroll
                for (int m = 0; m < 4; ++m) { const size_t row = (size_t)(rbase + ai * 128 + m * 16);
                    float ss = ssq8(acc[ai][0][m][0], acc[ai][0][m][1]) + ssq8(acc[ai][1][m][0], acc[ai][1][m][1]);
                    ss = red_fq(ss);
                    if (fq == 0) sq[row * 16 + u.pn * 4 + wc] = ss;
#pragma unroll
                    for (int bj = 0; bj < 2; ++bj) *(u32x4*)(dst + row * DM + u.pn * 256 + bj * 128 + cl0) = pack8(acc[ai][bj][m][0], acc[ai][bj][m][1]); }
        } break;
        case EK_MEMVT: {
            bf16_t* dst = (bf16_t*)p0;
#pragma unroll
            for (int ai = 0; ai < 2; ++ai)
#pragma unroll
                for (int m = 0; m < 4; ++m) { const size_t row = (size_t)(rbase + ai * 128 + m * 16);
#pragma unroll
                    for (int bj = 0; bj < 2; ++bj) *(u32x4*)(dst + row * TM + u.pn * 256 + bj * 128 + cl0) = pack8(acc[ai][bj][m][0], acc[ai][bj][m][1]); }
        } break;
        case EK_S5E: {
            float* dst = (float*)p0 + (size_t)u.pn * 32768 * 128;
#pragma unroll
            for (int ai = 0; ai < 2; ++ai)
#pragma unroll
                for (int m = 0; m < 4; ++m) { const size_t row = (size_t)(rbase + ai * 128 + m * 16);
                    *(f32x4*)(dst + row * 128 + cl0) = acc[ai][0][m][0]; *(f32x4*)(dst + row * 128 + cl0 + 4) = acc[ai][0][m][1]; }
        } break;
        case EK_S5Y: {
            bf16_t* dst = (bf16_t*)p0;
#pragma unroll
            for (int ai = 0; ai < 2; ++ai)
#pragma unroll
                for (int m = 0; m < 4; ++m) { const int r = rbase + ai * 128 + m * 16; const int gI = r >> 10, b = (r >> 6) & 15, k = r & 63;
#pragma unroll
                    for (int bj = 0; bj < 2; ++bj) { const int nn = u.pn * 256 + bj * 128 + cl0; const int tt = nn >> 4, cc = nn & 15;
                        f32x4 a = acc[ai][bj][m][0], c = acc[ai][bj][m][1];
#pragma unroll
                        for (int j = 0; j < 4; ++j) { a[j] = gelu_t(a[j]); c[j] = gelu_t(c[j]); }
                        *(u32x4*)(dst + ((size_t)(b * SEQ + k * TC + tt)) * 512 + gI * 16 + cc) = pack8(a, c); } }
        } break;
        case EK_GLU: {
            bf16_t* dst = (bf16_t*)p0; float* sq = (float*)p1; const bf16_t* y1 = (const bf16_t*)c0; const float* bg = (const float*)c1;
            f32x4 bv[2][2];
#pragma unroll
            for (int bj = 0; bj < 2; ++bj)
#pragma unroll
                for (int n = 0; n < 2; ++n) bv[bj][n] = *(const f32x4*)(bg + u.pn * 256 + bj * 128 + cl0 + 4 * n);
#pragma unroll
            for (int ai = 0; ai < 2; ++ai)
#pragma unroll
                for (int m = 0; m < 4; ++m) { const size_t row = (size_t)(rbase + ai * 128 + m * 16); float ss = 0.f;
#pragma unroll
                    for (int bj = 0; bj < 2; ++bj) { const size_t off = row * 512 + u.pn * 256 + bj * 128 + cl0;
                        const u32x4 yv = *(const u32x4*)(y1 + off);
                        f32x4 a = acc[ai][bj][m][0] + bv[bj][0], c = acc[ai][bj][m][1] + bv[bj][1];
                        a[0] = bflo(yv.x) * sigm(a[0]); a[1] = bfhi(yv.x) * sigm(a[1]); a[2] = bflo(yv.y) * sigm(a[2]); a[3] = bfhi(yv.y) * sigm(a[3]);
                        c[0] = bflo(yv.z) * sigm(c[0]); c[1] = bfhi(yv.z) * sigm(c[1]); c[2] = bflo(yv.w) * sigm(c[2]); c[3] = bfhi(yv.w) * sigm(c[3]);
                        ss += ssq8(a, c);
                        *(u32x4*)(dst + off) = pack8(a, c); }
                    ss = red_fq(ss);
                    if (fq == 0) sq[row * 8 + u.pn * 4 + wc] = ss; }
        } break;
        case EK_WOUT: case EK_WXO: {
            float* out = (float*)p0; bf16_t* hb = (bf16_t*)p1; float* sq = (float*)p2; const float* base = (const float*)c0;
#pragma unroll
            for (int ai = 0; ai < 2; ++ai)
#pragma unroll
                for (int m = 0; m < 4; ++m) { const size_t row = (size_t)(rbase + ai * 128 + m * 16); float ss = 0.f;
#pragma unroll
                    for (int bj = 0; bj < 2; ++bj) { const size_t off = row * DM + u.pn * 256 + bj * 128 + cl0;
                        const float dz = (kind == EK_WXO) ? DBG_CROSS : DBG_MIX;
                        const f32x4 a = acc[ai][bj][m][0] * dz + *(const f32x4*)(base + off), c = acc[ai][bj][m][1] * dz + *(const f32x4*)(base + off + 4);
                        *(f32x4*)(out + off) = a; *(f32x4*)(out + off + 4) = c;
                        ss += ssq8(a, c);
                        *(u32x4*)(hb + off) = pack8(a, c); }
                    ss = red_fq(ss);
                    if (fq == 0) sq[row * 16 + u.pn * 4 + wc] = ss; }
        } break;
        case EK_XQ: {
            bf16_t* dst = (bf16_t*)p0; float* sq = (float*)p1; const float* gq = (const float*)c0; const float* gk = (const float*)c1;
            f32x4 gg[2][2];
#pragma unroll
            for (int bj = 0; bj < 2; ++bj)
#pragma unroll
                for (int n = 0; n < 2; ++n) gg[bj][n] = *(const f32x4*)(gq + bj * 128 + cl0 + 4 * n) * *(const f32x4*)(gk + bj * 128 + cl0 + 4 * n);
#pragma unroll
            for (int ai = 0; ai < 2; ++ai)
#pragma unroll
                for (int m = 0; m < 4; ++m) { const size_t row = (size_t)(rbase + ai * 128 + m * 16);
                    float ss = ssq8(acc[ai][0][m][0], acc[ai][0][m][1]) + ssq8(acc[ai][1][m][0], acc[ai][1][m][1]);
                    ss = red_fq(ss);
                    if (fq == 0) sq[row * 16 + u.pn * 4 + wc] = ss;
#pragma unroll
                    for (int bj = 0; bj < 2; ++bj) *(u32x4*)(dst + row * DM + u.pn * 256 + bj * 128 + cl0) = pack8(acc[ai][bj][m][0] * gg[bj][0], acc[ai][bj][m][1] * gg[bj][1]); }
        } break;
        case EK_XS: {
            bf16_t* dst = (bf16_t*)p0; float* ps = (float*)p1; const float* s1 = (const float*)c0; const float* sqq = (const float*)c1; const float* sck = (const float*)c2;
            const int h = u.pn, b = u.pm >> 3;
            f32x4 kv[2][2];
#pragma unroll
            for (int bj = 0; bj < 2; ++bj)
#pragma unroll
                for (int n = 0; n < 2; ++n) kv[bj][n] = *(const f32x4*)(sck + (size_t)h * TM + b * 256 + bj * 128 + cl0 + 4 * n) * (LOG2E / 16.f);
#pragma unroll
            for (int ai = 0; ai < 2; ++ai)
#pragma unroll
                for (int m = 0; m < 4; ++m) { const size_t row = (size_t)(rbase + ai * 128 + m * 16);
                    const f32x4 t0 = *(const f32x4*)(s1 + row * 16), t1 = *(const f32x4*)(s1 + row * 16 + 4), t2 = *(const f32x4*)(s1 + row * 16 + 8), t3 = *(const f32x4*)(s1 + row * 16 + 12);
                    const float tot = ((t0[0] + t0[1]) + (t0[2] + t0[3])) + ((t1[0] + t1[1]) + (t1[2] + t1[3])) + ((t2[0] + t2[1]) + (t2[2] + t2[3])) + ((t3[0] + t3[1]) + (t3[2] + t3[3]));
                    const float rs1 = rsqrtf(tot * (1.f / DM) + EPS);
                    const f32x4 qq = *(const f32x4*)(sqq + row * 16 + h * 4);
                    const float sq = rs1 * rsqrtf(rs1 * rs1 * ((qq[0] + qq[1]) + (qq[2] + qq[3])) * (1.f / 256.f) + EPS);
                    float ss = 0.f;
#pragma unroll
                    for (int bj = 0; bj < 2; ++bj) { f32x4 a = acc[ai][bj][m][0] * kv[bj][0] * sq, c = acc[ai][bj][m][1] * kv[bj][1] * sq;
#pragma unroll
                        for (int j = 0; j < 4; ++j) { a[j] = __builtin_amdgcn_exp2f(a[j]); c[j] = __builtin_amdgcn_exp2f(c[j]); }
                        const u32x4 w = pack8(a, c);
                        ss += (bflo(w.x) + bfhi(w.x)) + (bflo(w.y) + bfhi(w.y)) + (bflo(w.z) + bfhi(w.z)) + (bflo(w.w) + bfhi(w.w));
                        *(u32x4*)(dst + row * DM + h * 256 + bj * 128 + cl0) = w; }
                    ss = red_fq(ss);
                    if (fq == 0) ps[row * 16 + h * 4 + wc] = ss; }
        } break;
        case EK_XO: {
            bf16_t* dst = (bf16_t*)p0; const float* ps = (const float*)c0; const int h = u.pn;
#pragma unroll
            for (int ai = 0; ai < 2; ++ai)
#pragma unroll
                for (int m = 0; m < 4; ++m) { const size_t row = (size_t)(rbase + ai * 128 + m * 16);
                    const f32x4 pp = *(const f32x4*)(ps + row * 16 + h * 4); const float inv = 1.f / ((pp[0] + pp[1]) + (pp[2] + pp[3]));
#pragma unroll
                    for (int bj = 0; bj < 2; ++bj) *(u32x4*)(dst + row * DM + h * 256 + bj * 128 + cl0) = pack8(acc[ai][bj][m][0] * inv, acc[ai][bj][m][1] * inv); }
        } break;
        case EK_UP: {
            bf16_t* G = (bf16_t*)p0; bf16_t* U = (bf16_t*)p1; const float* s2 = (const float*)c0;
#pragma unroll
            for (int ai = 0; ai < 2; ++ai)
#pragma unroll
                for (int m = 0; m < 4; ++m) { const size_t row = (size_t)(rbase + ai * 128 + m * 16);
                    const f32x4 t0 = *(const f32x4*)(s2 + row * 16), t1 = *(const f32x4*)(s2 + row * 16 + 4), t2 = *(const f32x4*)(s2 + row * 16 + 8), t3 = *(const f32x4*)(s2 + row * 16 + 12);
                    const float tot = ((t0[0] + t0[1]) + (t0[2] + t0[3])) + ((t1[0] + t1[1]) + (t1[2] + t1[3])) + ((t2[0] + t2[1]) + (t2[2] + t2[3])) + ((t3[0] + t3[1]) + (t3[2] + t3[3]));
                    const float rs = rsqrtf(tot * (1.f / DM) + EPS);
                    const size_t off = row * DFF + u.pn * 128 + cl0;
                    *(u32x4*)(G + off) = pack8(acc[ai][0][m][0] * rs, acc[ai][0][m][1] * rs);
                    *(u32x4*)(U + off) = pack8(acc[ai][1][m][0] * rs, acc[ai][1][m][1] * rs); }
        } break;
        case EK_DOWN: {
            float* out = (float*)p0;
#pragma unroll
            for (int ai = 0; ai < 2; ++ai)
#pragma unroll
                for (int m = 0; m < 4; ++m) { const size_t row = (size_t)(rbase + ai * 128 + m * 16);
#pragma unroll
                    for (int bj = 0; bj < 2; ++bj) { const size_t off = row * DM + u.pn * 256 + bj * 128 + cl0;
                        const f32x4 a = acc[ai][bj][m][0] * DBG_FFN + *(const f32x4*)(out + off), c = acc[ai][bj][m][1] * DBG_FFN + *(const f32x4*)(out + off + 4);
                        *(f32x4*)(out + off) = a; *(f32x4*)(out + off + 4) = c; } }
        } break;
        default: break;
        }
    }
};

namespace attn_body {
using bf16=__hip_bfloat16;
using s16x4=__attribute__((ext_vector_type(4)))short;
using f32x16=__attribute__((ext_vector_type(16)))float;
constexpr int NHEAD=NFH,D=64,ADM=NHEAD*D;
constexpr int NW=8,QBLK=32,QB=QBLK*NW,KVBLK=64,NQB=SEQ/QB;
__device__ __forceinline__ int crow(int r,int hi){return (r&3)+8*(r>>2)+4*hi;}
#define SBAR() __builtin_amdgcn_sched_barrier(0)
__device__ __forceinline__ void cmask(f32x16&p0,f32x16&p1,int jb,int qrel,int hi){
  const float NEG=-INFINITY; int kb=64*jb+4*hi;
  #pragma unroll
  for(int r=0;r<16;++r){int kv=kb+(r&3)+8*(r>>2); if(kv>qrel)p0[r]=NEG; if(kv+32>qrel)p1[r]=NEG;}
}
constexpr int NSLOT=3, SLOTB=8192;
constexpr int LDS_K=0, LDS_V=NSLOT*SLOTB, LDS_WS=2*NSLOT*SLOTB, LDS_OST=LDS_WS+NW*64*4, LDS_BYTES=LDS_OST+NW*4096;
constexpr int LDS_BIAS=86016;
__device__ __forceinline__ void glds16(const void*gsrc,unsigned lds_dst){unsigned keep;
  asm volatile("s_mov_b32 %0, m0\n\ts_mov_b32 m0, %2\n\ts_nop 0\n\tglobal_load_lds_dwordx4 %1, off\n\ts_mov_b32 m0, %0":"=&s"(keep):"v"(gsrc),"s"(lds_dst):"memory");}
__device__ __forceinline__ float max3f(float a,float b,float c){float r;asm("v_max3_f32 %0, %1, %2, %3":"=v"(r):"v"(a),"v"(b),"v"(c));return r;}
__device__ __forceinline__ float max2f(float a,float b){float r;asm("v_max_f32_e32 %0, %1, %2":"=v"(r):"v"(a),"v"(b));return r;}
__device__ __forceinline__ float fadd_s(float a,float b){float r;asm("v_add_f32_e32 %0, %1, %2":"=v"(r):"v"(a),"v"(b));return r;}
__device__ __forceinline__ float fsub_s(float a,float b){float r;asm("v_sub_f32_e32 %0, %1, %2":"=v"(r):"v"(a),"v"(b));return r;}
typedef float f32x2_t __attribute__((ext_vector_type(2))); typedef __bf16 bf16x2_t __attribute__((ext_vector_type(2)));
__device__ __forceinline__ unsigned cvtpk_s(float lo,float hi){f32x2_t v={lo,hi};bf16x2_t b=__builtin_convertvector(v,bf16x2_t);return __builtin_bit_cast(unsigned,b);}
#define WAIT_BAR(N) asm volatile("s_waitcnt vmcnt(" #N ") lgkmcnt(0)\n\ts_barrier":::"memory")

__device__ __forceinline__ void qkt(f32x16&p0,f32x16&p1,const char*Kslot,const bf16x8*qr,const f32x16&negm,int r32,int hi){
  const char*kb=Kslot+hi*1024+r32*16;
  #pragma unroll
  for(int d0=0;d0<4;++d0){
    const bf16x8 b0=*reinterpret_cast<const bf16x8*>(kb+d0*2048);
    const bf16x8 b1=*reinterpret_cast<const bf16x8*>(kb+d0*2048+512);
    if(d0==0){p0=__builtin_amdgcn_mfma_f32_32x32x16_bf16(b0,qr[0],negm,0,0,0);p1=__builtin_amdgcn_mfma_f32_32x32x16_bf16(b1,qr[0],negm,0,0,0);}
    else{p0=__builtin_amdgcn_mfma_f32_32x32x16_bf16(b0,qr[d0],p0,0,0,0);p1=__builtin_amdgcn_mfma_f32_32x32x16_bf16(b1,qr[d0],p1,0,0,0);}}
}
typedef __attribute__((address_space(3))) const char* lds_cptr;
typedef short v4i16_t __attribute__((ext_vector_type(4)));
__device__ __forceinline__ void kload8(bf16x8*kf,lds_cptr kp){
  kf[0]=*(const __attribute__((address_space(3))) bf16x8*)(kp);      kf[1]=*(const __attribute__((address_space(3))) bf16x8*)(kp+512);
  kf[2]=*(const __attribute__((address_space(3))) bf16x8*)(kp+2048); kf[3]=*(const __attribute__((address_space(3))) bf16x8*)(kp+2560);
  kf[4]=*(const __attribute__((address_space(3))) bf16x8*)(kp+4096); kf[5]=*(const __attribute__((address_space(3))) bf16x8*)(kp+4608);
  kf[6]=*(const __attribute__((address_space(3))) bf16x8*)(kp+6144); kf[7]=*(const __attribute__((address_space(3))) bf16x8*)(kp+6656);
}
__device__ __forceinline__ void kload2(bf16x8*kf,lds_cptr kp,int j){ kf[2*j]=*(const __attribute__((address_space(3))) bf16x8*)(kp+j*2048); kf[2*j+1]=*(const __attribute__((address_space(3))) bf16x8*)(kp+j*2048+512); }
__device__ __forceinline__ s16x4 vtr(lds_cptr p){ return __builtin_bit_cast(s16x4,__builtin_amdgcn_ds_read_tr16_b64_v4i16((__attribute__((address_space(3))) v4i16_t*)p)); }
__device__ __forceinline__ float rowmax(const f32x16&p0,const f32x16&p1){
  float a=max3f(p0[0],p0[1],p1[0]),b=max3f(p0[2],p0[3],p1[1]);a=max3f(a,p1[2],p1[3]);
  #pragma unroll
  for(int r=4;r<16;r+=4){a=max3f(a,p0[r],p0[r+1]);b=max3f(b,p0[r+2],p0[r+3]);a=max3f(a,p1[r],p1[r+1]);b=max3f(b,p1[r+2],p1[r+3]);}
  const float m=max2f(a,b);
  auto rr=__builtin_amdgcn_permlane32_swap(__float_as_uint(m),__float_as_uint(m),false,false);
  return max2f(__uint_as_float(rr[0]),__uint_as_float(rr[1]));
}
__device__ __forceinline__ void pv(f32x16*o,int vb,bf16x8 pa0,bf16x8 pa1,bf16x8 pa2,bf16x8 pa3){
  #pragma unroll
  for(int d0=0;d0<2;++d0){s16x4 lo[4],hi[4];
    #pragma unroll
    for(int ks=0;ks<4;++ks){
      asm volatile("ds_read_b64_tr_b16 %0,%1 offset:%c2":"=&v"(lo[ks]):"v"(vb),"i"(d0*4096+ks*1024):"memory");
      asm volatile("ds_read_b64_tr_b16 %0,%1 offset:%c2":"=&v"(hi[ks]):"v"(vb),"i"(d0*4096+ks*1024+512):"memory");}
    asm volatile("s_waitcnt lgkmcnt(0)":::"memory");SBAR();
    #define PK(k) (bf16x8){lo[k][0],lo[k][1],lo[k][2],lo[k][3],hi[k][0],hi[k][1],hi[k][2],hi[k][3]}
    o[d0]=__builtin_amdgcn_mfma_f32_32x32x16_bf16(pa0,PK(0),o[d0],0,0,0);
    o[d0]=__builtin_amdgcn_mfma_f32_32x32x16_bf16(pa1,PK(1),o[d0],0,0,0);
    o[d0]=__builtin_amdgcn_mfma_f32_32x32x16_bf16(pa2,PK(2),o[d0],0,0,0);
    o[d0]=__builtin_amdgcn_mfma_f32_32x32x16_bf16(pa3,PK(3),o[d0],0,0,0);
    #undef PK
  }
}
typedef const __attribute__((address_space(3))) f32x4* lds_f4ptr;
#define BIASADD(P0,P1,t) do{ const lds_f4ptr bp_=(lds_f4ptr)(shm3+LDS_BIAS+((t)*64+4*hi)*4); \
    _Pragma("unroll") for(int j_=0;j_<4;++j_){ const f32x4 b0_=bp_[2*j_]-mhat, b1_=bp_[8+2*j_]-mhat; \
      P0[4*j_]+=b0_[0]; P0[4*j_+1]+=b0_[1]; P0[4*j_+2]+=b0_[2]; P0[4*j_+3]+=b0_[3]; \
      P1[4*j_]+=b1_[0]; P1[4*j_+1]+=b1_[1]; P1[4*j_+2]+=b1_[2]; P1[4*j_+3]+=b1_[3]; } }while(0)

template<int THRL> __device__ __forceinline__ void attn_unit(int b,int h,int qb,const bf16*Q,const bf16*__restrict__ K,const bf16*__restrict__ V,bf16*O,const float*__restrict__ CB,float*__restrict__ SSQ,char*shm){
  int tid=threadIdx.x; asm volatile("":"+v"(tid));
  const int lane=tid&63,r32=lane&31,hi=lane>>5; const int wid=__builtin_amdgcn_readfirstlane(tid>>6);
  const long rowbase=(long)b*SEQ; const int q0=qb*QB;
  const bf16*Qw=Q+(rowbase+q0+wid*QBLK)*ADM+h*D;
  const bf16*Kh=K+rowbase*ADM+h*D,*Vh=V+rowbase*ADM+h*D;
  const unsigned lds0=(unsigned)(uintptr_t)shm;
  float*wsf=(float*)(shm+LDS_WS)+wid*64;
  const lds_cptr shm3=(lds_cptr)shm;
  { const float*cbh=CB+(long)(b*NHEAD+h)*SEQ; const float cref=cbh[q0+128];
    if(tid*4<q0+QB){ const f32x4 c4=*(const f32x4*)(cbh+tid*4); *(__attribute__((address_space(3))) f32x4*)(shm3+LDS_BIAS+tid*16)=(f32x4){cref-c4[0],cref-c4[1],cref-c4[2],cref-c4[3]}*DBG_BIAS; } }
  const bf16*ksrc=Kh+(long)lane*ADM+wid*8;
  const bf16*vsrc=Vh+(long)(16*(wid&3)+(lane>>2))*ADM+(wid>>2)*32+(lane&3)*8;
  const unsigned kdst=lds0+LDS_K+wid*1024, vdst=lds0+LDS_V+wid*1024;
  #define DMA_K(t,slot) glds16(ksrc+(long)(t)*KVBLK*ADM,(unsigned)__builtin_amdgcn_readfirstlane(kdst+(slot)))
  #define DMA_V(t,slot) glds16(vsrc+(long)(t)*KVBLK*ADM,(unsigned)__builtin_amdgcn_readfirstlane(vdst+(slot)))
  const int vb0=(int)(lds0+LDS_V)+((lane>>4)&1)*32+(lane&3)*8+(4*hi+((lane&15)>>2))*64;
  const char*Kbase=shm+LDS_K; bf16x8 kf[8];
  const lds_cptr kp0=shm3+LDS_K+hi*1024+r32*16; const lds_cptr vp0=shm3+LDS_V+((lane>>4)&1)*32+(lane&3)*8+(4*hi+((lane&15)>>2))*64;
  const int NT=(q0+QB)/KVBLK;
  DMA_K(0,0);DMA_V(0,0);DMA_K(1,SLOTB);
  bf16x8 qr[4];
  #pragma unroll
  for(int d0=0;d0<4;++d0)qr[d0]=*reinterpret_cast<const bf16x8*>(&Qw[(long)r32*ADM+d0*16+hi*8]);
  float mhat=0.f,l_reg=0.f;f32x16 o[2];o[0]=f32x16{};o[1]=f32x16{};const f32x16 negm=f32x16{};
  const int qrel=wid*QBLK+r32;
  #define CMASK(P0,P1,t) do{int jb_=(t)-(NT-4); if(jb_>=0)cmask(P0,P1,jb_,qrel,hi);}while(0)
  bool resc=false;
  #define START(P0,P1) do{ const float rm=rowmax(P0,P1); resc=false; \
    { const float dl=max2f(rm,-24.f); mhat=fadd_s(mhat,dl); \
      _Pragma("unroll") for(int r=0;r<16;++r){P0[r]=fsub_s(P0[r],dl);P1[r]=fsub_s(P1[r],dl);} } \
    _Pragma("unroll") for(int r=0;r<16;++r)P0[r]=__builtin_amdgcn_exp2f(P0[r]); }while(0)
  #define RESC() do{ if(resc){ asm volatile("s_waitcnt lgkmcnt(0)":::"memory"); \
      _Pragma("unroll") for(int d_=0;d_<2;++d_) _Pragma("unroll") for(int r=0;r<16;++r)o[d_][r]*=wsf[crow(r,hi)]; } }while(0)
  f32x16 pA0,pA1,pB0,pB1;
  int sl_prev=0,sl_cur=0,sl_next=SLOTB;
  #define ROT() do{sl_prev=sl_cur;sl_cur=sl_next;sl_next=(sl_next==(NSLOT-1)*SLOTB)?0:sl_next+SLOTB;}while(0)
  DMA_K(2,2*SLOTB);
  WAIT_BAR(3);
  qkt(pA0,pA1,Kbase,qr,negm,r32,hi);asm volatile("s_nop 15\n\ts_nop 7":"+v"(pA0),"+v"(pA1));BIASADD(pA0,pA1,0);CMASK(pA0,pA1,0);
  START(pA0,pA1);
  _Pragma("unroll") for(int r=0;r<16;++r)pA1[r]=__builtin_amdgcn_exp2f(pA1[r]);
  WAIT_BAR(0);
  DMA_K(3,0);DMA_V(1,SLOTB);
  ROT();
  kload8(kf,kp0+sl_cur);
  WAIT_BAR(2);
  s16x4 vlo[8],vhi[8]; u32x4 pw0,pw1,pw2,pw3;
  #define PKW(P,B) cvtpk_s(P[B],P[B+1])
  #define PAF(k) __builtin_bit_cast(bf16x8,pw##k)
  #define VFR(i) (bf16x8){vlo[i][0],vlo[i][1],vlo[i][2],vlo[i][3],vhi[i][0],vhi[i][1],vhi[i][2],vhi[i][3]}
  #define PIN(x) asm volatile("":"+v"(x))
  #define MX3(a,b,c) __builtin_fmaxf(__builtin_fmaxf((a),(b)),(c))
  #define GAPA(MF,A0,A1,A2,A3,W0,W1,PW) do{ MF; sacc+=A0; sacc+=A1; sacc+=A2; sacc+=A3; PIN(sacc); W0; W1; PIN(PW); SBAR(); }while(0)
  #define EX(v) __builtin_amdgcn_exp2f(v)
  #define GAPB(MF,X,B) do{ MF; X[B]=EX(X[B]); X[B+1]=EX(X[B+1]); X[B+2]=EX(X[B+2]); X[B+3]=EX(X[B+3]); PIN(X); SBAR(); }while(0)
  #define VRD(i) do{ vlo[i]=vtr(vp_+(((i)>>2)*4096+((i)&3)*1024)); vhi[i]=vtr(vp_+(((i)>>2)*4096+((i)&3)*1024+512)); }while(0)
  #define KRD(G,j) do{ if(G){ kload2(kf,kp0+sl_next,j); SBAR(); } }while(0)
  #define STEP(C0,C1,P0,P1,t,GK,GV,GL) do{ SBAR(); \
    const lds_cptr vp_=vp0+sl_prev; \
    VRD(0); SBAR(); float sacc=(P0[0]+P0[1]); \
    GAPA(C0=__builtin_amdgcn_mfma_f32_32x32x16_bf16(kf[0],qr[0],negm,0,0,0), P0[2],P0[3],P0[4],P0[5],     pw0[0]=PKW(P0,0), pw0[1]=PKW(P0,2), pw0); \
    VRD(4); SBAR(); GAPA(C1=__builtin_amdgcn_mfma_f32_32x32x16_bf16(kf[1],qr[0],negm,0,0,0), P0[6],P0[7],P0[8],P0[9],     pw0[2]=PKW(P0,4), pw0[3]=PKW(P0,6), pw0); \
    VRD(1); SBAR(); GAPA(C0=__builtin_amdgcn_mfma_f32_32x32x16_bf16(kf[2],qr[1],C0,0,0,0),   P0[10],P0[11],P0[12],P0[13], pw1[0]=PKW(P0,8), pw1[1]=PKW(P0,10), pw1); \
    VRD(5); SBAR(); GAPA(C1=__builtin_amdgcn_mfma_f32_32x32x16_bf16(kf[3],qr[1],C1,0,0,0),   P0[14],P0[15],P1[0],P1[1],   pw1[2]=PKW(P0,12),pw1[3]=PKW(P0,14), pw1); \
    VRD(2); SBAR(); GAPA(C0=__builtin_amdgcn_mfma_f32_32x32x16_bf16(kf[4],qr[2],C0,0,0,0),   P1[2],P1[3],P1[4],P1[5],     pw2[0]=PKW(P1,0), pw2[1]=PKW(P1,2), pw2); \
    VRD(6); SBAR(); GAPA(C1=__builtin_amdgcn_mfma_f32_32x32x16_bf16(kf[5],qr[2],C1,0,0,0),   P1[6],P1[7],P1[8],P1[9],     pw2[2]=PKW(P1,4), pw2[3]=PKW(P1,6), pw2); \
    VRD(3); SBAR(); GAPA(C0=__builtin_amdgcn_mfma_f32_32x32x16_bf16(kf[6],qr[3],C0,0,0,0),   P1[10],P1[11],P1[12],P1[13], pw3[0]=PKW(P1,8), pw3[1]=PKW(P1,10), pw3); \
    VRD(7); SBAR(); GAPA(C1=__builtin_amdgcn_mfma_f32_32x32x16_bf16(kf[7],qr[3],C1,0,0,0),   P1[14],P1[15],0.f,0.f,       pw3[2]=PKW(P1,12),pw3[3]=PKW(P1,14), pw3); \
    l_reg+=sacc; \
    if(GK){DMA_K((t)+3,sl_cur);} if(GV){DMA_V((t)+1,sl_next);} \
    BIASADD(C0,C1,t); \
    CMASK(C0,C1,t); \
    { float a=MX3(C0[0],C0[1],C1[0]),b=MX3(C0[2],C0[3],C1[1]); a=MX3(a,C1[2],C1[3]); \
      _Pragma("unroll") for(int r=4;r<16;r+=4){a=MX3(a,C0[r],C0[r+1]);b=MX3(b,C0[r+2],C0[r+3]);a=MX3(a,C1[r],C1[r+1]);b=MX3(b,C1[r+2],C1[r+3]);} \
      float rm=__builtin_fmaxf(a,b); { auto rr=__builtin_amdgcn_permlane32_swap(__float_as_uint(rm),__float_as_uint(rm),false,false); rm=__builtin_fmaxf(__uint_as_float(rr[0]),__uint_as_float(rr[1])); } \
      resc=false; \
      if(__builtin_expect(__any(rm>(float)THRL),0)){ const float dl=__builtin_fmaxf(rm,0.f); mhat+=dl; \
        _Pragma("unroll") for(int r=0;r<16;++r){C0[r]-=dl;C1[r]-=dl;} \
        const float f=__builtin_amdgcn_exp2f(-dl); l_reg*=f; if(hi==0)wsf[r32]=f; resc=true; } } \
    SBAR(); \
    GAPB(o[0]=__builtin_amdgcn_mfma_f32_32x32x16_bf16(PAF(0),VFR(0),o[0],0,0,0), C0,0); \
    GAPB(o[1]=__builtin_amdgcn_mfma_f32_32x32x16_bf16(PAF(0),VFR(4),o[1],0,0,0), C0,4); \
    KRD(GL,0); GAPB(o[0]=__builtin_amdgcn_mfma_f32_32x32x16_bf16(PAF(1),VFR(1),o[0],0,0,0), C0,8); \
    KRD(GL,1); GAPB(o[1]=__builtin_amdgcn_mfma_f32_32x32x16_bf16(PAF(1),VFR(5),o[1],0,0,0), C0,12); \
    KRD(GL,2); GAPB(o[0]=__builtin_amdgcn_mfma_f32_32x32x16_bf16(PAF(2),VFR(2),o[0],0,0,0), C1,0); \
    KRD(GL,3); GAPB(o[1]=__builtin_amdgcn_mfma_f32_32x32x16_bf16(PAF(2),VFR(6),o[1],0,0,0), C1,4); \
    GAPB(o[0]=__builtin_amdgcn_mfma_f32_32x32x16_bf16(PAF(3),VFR(3),o[0],0,0,0), C1,8); \
    GAPB(o[1]=__builtin_amdgcn_mfma_f32_32x32x16_bf16(PAF(3),VFR(7),o[1],0,0,0), C1,12); \
    }while(0)
  int t=1;
  #undef CMASK
  #define CMASK(P0,P1,t) do{}while(0)
  for(;t+5<NT;t+=2){
    STEP(pB0,pB1,pA0,pA1,t,true,true,true);     WAIT_BAR(2); RESC(); ROT();
    STEP(pA0,pA1,pB0,pB1,t+1,true,true,true);   WAIT_BAR(2); RESC(); ROT();
  }
  #undef CMASK
  #define CMASK(P0,P1,t) do{int jb_=(t)-(NT-4); if(jb_>=0)cmask(P0,P1,jb_,qrel,hi);}while(0)
  #define ENDW(tt) do{ if((tt)+3<NT){WAIT_BAR(2);} else if((tt)+2<NT){WAIT_BAR(1);} else {WAIT_BAR(0);} }while(0)
  for(;t+1<NT;t+=2){
    STEP(pB0,pB1,pA0,pA1,t,(t+3<NT),(t+1<NT),(t+1<NT));       ENDW(t);   RESC(); ROT();
    STEP(pA0,pA1,pB0,pB1,t+1,(t+4<NT),(t+2<NT),(t+2<NT));     ENDW(t+1); RESC(); ROT();
  }
  STEP(pB0,pB1,pA0,pA1,NT-1,false,false,false); RESC();
  { float sacc=pB0[0]+pB0[1]; _Pragma("unroll") for(int r=2;r<16;++r)sacc+=pB0[r]; _Pragma("unroll") for(int r=0;r<16;++r)sacc+=pB1[r]; l_reg+=sacc;
    pw0=(u32x4){PKW(pB0,0),PKW(pB0,2),PKW(pB0,4),PKW(pB0,6)};pw1=(u32x4){PKW(pB0,8),PKW(pB0,10),PKW(pB0,12),PKW(pB0,14)};pw2=(u32x4){PKW(pB1,0),PKW(pB1,2),PKW(pB1,4),PKW(pB1,6)};pw3=(u32x4){PKW(pB1,8),PKW(pB1,10),PKW(pB1,12),PKW(pB1,14)};
    SBAR(); pv(o,vb0+sl_cur,PAF(0),PAF(1),PAF(2),PAF(3)); }
  #undef PKW
  #undef PAF
  #undef VFR
  #undef PIN
  #undef MX3
  #undef GAPA
  #undef GAPB
  #undef EX
  #undef VRD
  #undef KRD
  #undef STEP
  #undef ENDW
  {auto rr=__builtin_amdgcn_permlane32_swap(__float_as_uint(l_reg),__float_as_uint(l_reg),false,false);l_reg=__uint_as_float(rr[0])+__uint_as_float(rr[1]);}
  if(hi==0)wsf[32+r32]=l_reg;asm volatile("s_waitcnt lgkmcnt(0)":::"memory");
  float rli[16];
  #pragma unroll
  for(int r=0;r<16;++r)rli[r]=__builtin_amdgcn_rcpf(wsf[32+crow(r,hi)]);
  int lane2=lane; asm volatile("":"+v"(lane2));
  bf16*Ow=O+(rowbase+q0+wid*QBLK)*ADM+h*D;
  { bf16*stg=(bf16*)(shm+LDS_OST)+wid*2048;
    #pragma unroll
    for(int r=0;r<16;++r){const int orow=crow(r,hi);
      #pragma unroll
      for(int d0=0;d0<2;++d0)stg[orow*64+d0*32+r32]=__float2bfloat16(o[d0][r]*rli[r]);}
    asm volatile("s_waitcnt lgkmcnt(0)":::"memory");
    #pragma unroll
    for(int i=0;i<4;++i){const int row=i*8+(lane2>>3),ch=lane2&7; const u32x4 v=*(const u32x4*)(stg+row*64+ch*8); *(u32x4*)(Ow+(long)row*ADM+ch*8)=v;
      float s=(bflo(v.x)*bflo(v.x)+bfhi(v.x)*bfhi(v.x))+(bflo(v.y)*bflo(v.y)+bfhi(v.y)*bfhi(v.y))+(bflo(v.z)*bflo(v.z)+bfhi(v.z)*bfhi(v.z))+(bflo(v.w)*bflo(v.w)+bfhi(v.w)*bfhi(v.w));
      s+=__shfl_xor(s,1); s+=__shfl_xor(s,2); s+=__shfl_xor(s,4);
      if(ch==0)SSQ[(rowbase+q0+wid*QBLK+row)*NHEAD+h]=s; } }
  asm volatile("s_waitcnt lgkmcnt(0)\n\ts_barrier":::"memory");
  #undef DMA_K
  #undef DMA_V
  #undef CMASK
  #undef START
  #undef RESC
  #undef ROT
}
#undef SBAR
#undef WAIT_BAR
}

constexpr int RING_BYTES = 131072;
constexpr int LDS_TOTAL = 147456;
struct Args { const float* in[32]; float* out; unsigned char* ws; };
typedef const float* const __attribute__((address_space(4)))* InTab;
enum In { I_X = 0, I_MEM, I_NORM_MIX, I_W_IN, I_FQN, I_FKN, I_FBIAS, I_ARE, I_AIM, I_LOGDT, I_BRE, I_BIM, I_CRE, I_CIM, I_D, I_WGLU, I_BGLU, I_ONF, I_ONS, I_WOUT,
          I_NCROSS, I_NMEM, I_WXQ, I_WXKV, I_XQN, I_XKN, I_WXO, I_NFFN, I_WUP, I_CONVW, I_CONVB, I_WDN };

struct TJob { const float* W; int ldw, col0, ncols, K; const float* kg; const float* kg2; bf16_t* WT; int mapid, rowoff, items; };
__device__ __forceinline__ int tmap(int mapid, int n, int rowoff) {
    if (mapid == 1) { const int part = n >> 9, f = n & 511, head = f >> 6, d = f & 63; return 512 * part + 256 * (head >> 2) + 128 * (d >> 5) + 32 * (head & 3) + (d & 31); }
    if (mapid == 2) { const int isup = n >= DFF ? 1 : 0; const int j = n - isup * DFF; return 256 * (j >> 7) + 128 * isup + (j & 127); }
    return rowoff + n;
}
__device__ __forceinline__ void transpose_item(const TJob& J, LAS float* scr, int item, int lane) {
    const int nblk = J.ncols / 32, kb = item / nblk, nb = item % nblk, k0 = 64 * kb, n0 = 32 * nb;
#pragma unroll 8
    for (int i = 0; i < 32; ++i) { const int kk = 2 * i + (lane >> 5); float w = J.W[(size_t)(k0 + kk) * J.ldw + J.col0 + n0 + (lane & 31)];
        if (J.kg) { const int k = k0 + kk; w *= (J.kg2 && k >= 512) ? J.kg2[k - 512] : J.kg[k]; }
        scr[kk * 33 + (lane & 31)] = w; }
    asm volatile("s_waitcnt lgkmcnt(0)" ::: "memory");
    const int c = lane & 7;
#pragma unroll
    for (int j = 0; j < 4; ++j) { const int n = (lane >> 3) + 8 * j; const LAS float* s = scr + (8 * c) * 33 + n;
        u32x4 o; o.x = pk2(s[0 * 33], s[1 * 33]); o.y = pk2(s[2 * 33], s[3 * 33]); o.z = pk2(s[4 * 33], s[5 * 33]); o.w = pk2(s[6 * 33], s[7 * 33]);
        *(u32x4*)(J.WT + (size_t)tmap(J.mapid, n0 + n, J.rowoff) * J.K + k0 + 8 * c) = o; }
    asm volatile("s_waitcnt lgkmcnt(0)" ::: "memory");
}
constexpr int NTJ = 11;
__device__ __forceinline__ void get_tjob(InTab in, unsigned char* ws, int j, TJob& J) {
    J.kg = nullptr; J.kg2 = nullptr; J.mapid = 0; J.rowoff = 0; J.col0 = 0;
    switch (j) {
    case 0: J.W = in[I_W_IN]; J.ldw = INCOLS; J.col0 = 0; J.ncols = 1024; J.K = 1024; J.WT = (bf16_t*)(ws + WS_WIN); J.mapid = 1; break;
    case 1: J.W = in[I_W_IN]; J.ldw = INCOLS; J.col0 = 1024; J.ncols = 512; J.K = 1024; J.WT = (bf16_t*)(ws + WS_WIN); J.rowoff = 1024; break;
    case 2: J.W = in[I_W_IN]; J.ldw = INCOLS; J.col0 = 1544; J.ncols = 512; J.K = 1024; J.WT = (bf16_t*)(ws + WS_WIN); J.rowoff = 1536; break;
    case 3: J.W = in[I_WGLU]; J.ldw = 512; J.ncols = 512; J.K = 512; J.WT = (bf16_t*)(ws + WS_WGLU); break;
    case 4: J.W = in[I_WOUT]; J.ldw = 1024; J.ncols = 1024; J.K = 1024; J.WT = (bf16_t*)(ws + WS_WOUT); J.kg = in[I_ONF]; J.kg2 = in[I_ONS]; break;
    case 5: J.W = in[I_WXQ]; J.ldw = 1024; J.ncols = 1024; J.K = 1024; J.WT = (bf16_t*)(ws + WS_WXQ); J.kg = in[I_NCROSS]; break;
    case 6: J.W = in[I_WXKV]; J.ldw = 2048; J.col0 = 0; J.ncols = 1024; J.K = 1024; J.WT = (bf16_t*)(ws + WS_WXK); break;
    case 7: J.W = in[I_WXKV]; J.ldw = 2048; J.col0 = 1024; J.ncols = 1024; J.K = 1024; J.WT = (bf16_t*)(ws + WS_WXV); break;
    case 8: J.W = in[I_WXO]; J.ldw = 1024; J.ncols = 1024; J.K = 1024; J.WT = (bf16_t*)(ws + WS_WXO); break;
    case 9: J.W = in[I_WUP]; J.ldw = 2 * DFF; J.ncols = 2 * DFF; J.K = 1024; J.WT = (bf16_t*)(ws + WS_WUP); J.kg = in[I_NFFN]; J.mapid = 2; break;
    default: J.W = in[I_WDN]; J.ldw = 1024; J.ncols = 1024; J.K = DFF; J.WT = (bf16_t*)(ws + WS_WDN); break;
    }
    J.items = (J.K / 64) * (J.ncols / 32);
}

__device__ __forceinline__ void rms_row(const float* xrow, const float* gain, bf16_t* orow, int lane, f32x4 (&v)[4]) {
    const f32x4* xr = (const f32x4*)xrow + lane; float s = 0.f;
#pragma unroll
    for (int j = 0; j < 4; ++j) { v[j] = xr[64 * j]; s += (v[j][0] * v[j][0] + v[j][1] * v[j][1]) + (v[j][2] * v[j][2] + v[j][3] * v[j][3]); }
    const float rs = rsqrtf(wave_sum(s) * (1.f / DM) + EPS);
    u32x2* o8 = (u32x2*)orow + lane;
#pragma unroll
    for (int j = 0; j < 4; ++j) { v[j] = v[j] * rs * ((const f32x4*)gain)[64 * j + lane]; u32x2 w; w.x = pk2(v[j][0], v[j][1]); w.y = pk2(v[j][2], v[j][3]); o8[64 * j] = w; }
}

__device__ __forceinline__ void cpow(float ar, float ai, float dt, float e, float& r, float& i) {
    const float mag = __expf(ar * dt * e);
    float rev = ai * dt * e * 0.15915494309189535f; rev -= rintf(rev);
    const float ang = rev * 6.283185307179586f;
    r = mag * cosf(ang); i = mag * sinf(ang);
}

__device__ __forceinline__ void s5_prep_task(InTab in, unsigned char* ws, int g, int tt, LAS float* L, int tid) {
    LAS float* pwA = L; LAS float* pwB = L + 128; LAS float* pwC = L + 256; LAS float* cf = L + 384; LAS float* bb = L + 512; LAS float* cc = L + 512 + 2048;
    const float dt = __expf(in[I_LOGDT][g]);
    if (tid < 64) { const int p = tid; const float ar = in[I_ARE][g * 64 + p], ai = in[I_AIM][g * 64 + p];
        float r, i; cpow(ar, ai, dt, (float)tt, r, i); pwA[2 * p] = r; pwA[2 * p + 1] = i;
        cpow(ar, ai, dt, (float)(tt + 1), r, i); pwB[2 * p] = r; pwB[2 * p + 1] = i;
        cpow(ar, ai, dt, (float)(TC - 1 - tt), r, i); pwC[2 * p] = r; pwC[2 * p + 1] = i;
        float lr, li; cpow(ar, ai, dt, 1.f, lr, li);
        const float den = ar * ar + ai * ai, nr = lr - 1.f;
        cf[2 * p] = (nr * ar + li * ai) / den; cf[2 * p + 1] = (li * ar - nr * ai) / den;
        if (tt == 0) { cpow(ar, ai, dt, (float)TC, r, i); float* lb = (float*)(ws + WS_LB32); lb[(g * 64 + p) * 2] = r; lb[(g * 64 + p) * 2 + 1] = i; } }
    for (int idx = tid; idx < 1024; idx += 512) { cc[2 * idx] = in[I_CRE][g * 1024 + idx]; cc[2 * idx + 1] = in[I_CIM][g * 1024 + idx]; }
    __syncthreads();
    for (int idx = tid; idx < 1024; idx += 512) { const int p = idx >> 4; const float br = in[I_BRE][g * 1024 + idx], bi = in[I_BIM][g * 1024 + idx], cr = cf[2 * p], ci = cf[2 * p + 1];
        bb[2 * idx] = cr * br - ci * bi; bb[2 * idx + 1] = cr * bi + ci * br; }
    __syncthreads();
    if (tid < 256) {
        const int c = tid >> 4, cp = tid & 15; float s = 0.f;
        for (int p = 0; p < 64; ++p) { const float pr = pwA[2 * p], pi = pwA[2 * p + 1], br = bb[2 * (p * 16 + cp)], bi = bb[2 * (p * 16 + cp) + 1];
            const float mr = pr * br - pi * bi, mi = pr * bi + pi * br; s += cc[2 * (c * 64 + p)] * mr - cc[2 * (c * 64 + p) + 1] * mi; }
        s *= DBG_SSM;
        if (tt == 0 && c == cp) s += in[I_D][g * 16 + c];
        ((float*)(ws + WS_KTAB))[((g * TC + tt) * 16 + c) * 16 + cp] = s;
    } else {
        const int u = tid - 256;
        bf16_t* bty = (bf16_t*)(ws + WS_BTY) + (size_t)g * 512 * UGP; bf16_t* bte = (bf16_t*)(ws + WS_BTE) + (size_t)g * 256 * 512;
        for (int idx = u; idx < 1024; idx += 256) { const int c = idx >> 6, p = idx & 63;
            const float cr = cc[2 * idx], ci = cc[2 * idx + 1], pr = pwB[2 * p], pi = pwB[2 * p + 1];
            const float zr = cr * pr - ci * pi, zi = cr * pi + ci * pr;
            *(unsigned*)(bty + (size_t)(tt * 16 + c) * UGP + 512 + 2 * p) = pk2(zr * DBG_SSM, -zi * DBG_SSM); }
        for (int idx = u; idx < 1024; idx += 256) { const int p = idx >> 4, cp = idx & 15;
            const float pr = pwC[2 * p], pi = pwC[2 * p + 1], br = bb[2 * idx], bi = bb[2 * idx + 1];
            bte[(size_t)(2 * p) * 512 + tt * 16 + cp] = (bf16_t)f2bf(pr * br - pi * bi); bte[(size_t)(2 * p + 1) * 512 + tt * 16 + cp] = (bf16_t)f2bf(pr * bi + pi * br); }
        *(u32x4*)(bte + (size_t)(128 + (u >> 1)) * 512 + tt * 16 + (u & 1) * 8) = (u32x4){0u, 0u, 0u, 0u};
    }
    __syncthreads();
}

#ifndef FIRST_STEP
#define FIRST_STEP 0
#endif
#ifndef LAST_STEP
#define LAST_STEP 18
#endif
#define ON(n) (FIRST_STEP <= (n) && (n) <= LAST_STEP)
#define SYNC(n) do { if ((n) < LAST_STEP) { asm volatile("s_waitcnt vmcnt(0) lgkmcnt(0)" ::: "memory"); __syncthreads(); grid.sync(); } } while (0)
#define WSB(off) ((const bf16_t*)(ws + (off)))
__global__ void __launch_bounds__(512, 2) fox_s5_mega(Args a) {
    extern __shared__ __attribute__((aligned(16))) unsigned char lds[];
    cg::grid_group grid = cg::this_grid();
    LAS unsigned char* L = (LAS unsigned char*)lds;
    const int G = gridDim.x, bx = blockIdx.x, NGW = G * 8, NGT = G * 512;
#define KA const __attribute__((address_space(4))) unsigned char* ka_ = (const __attribute__((address_space(4))) unsigned char*)__builtin_amdgcn_kernarg_segment_ptr(); asm volatile("" : "+s"(ka_)); \
    InTab in = (InTab)ka_; float* out = *(float* const __attribute__((address_space(4)))*)(ka_ + 256); unsigned char* ws = *(unsigned char* const __attribute__((address_space(4)))*)(ka_ + 264); (void)in; (void)out;
#define IDS int tid = threadIdx.x; asm volatile("" : "+v"(tid)); const int lane = tid & 63, wave = __builtin_amdgcn_readfirstlane(tid >> 6); const int gw = bx * 8 + wave, gt = bx * 512 + tid; (void)lane; (void)gw; (void)gt;

    if (ON(0)) {
        KA
        IDS
        LAS float* scr = (LAS float*)(L + wave * 16384);
        { int base = 0;
          for (int j = 0; j < NTJ; ++j) { TJob J; get_tjob(in, ws, j, J);
              int first = gw - (base % NGW); if (first < 0) first += NGW;
              for (int it = first; it < J.items; it += NGW) transpose_item(J, scr, it, lane);
              base += J.items; } }
        __syncthreads();
        LAS float* wf = (LAS float*)L;
        for (int idx = tid; idx < 8192; idx += 512) wf[idx] = in[I_W_IN][(size_t)(idx >> 3) * INCOLS + 1536 + (idx & 7)];
        __syncthreads();
        for (int m = gw; m < T; m += NGW) {
            f32x4 v[4]; rms_row(in[I_X] + (size_t)m * DM, in[I_NORM_MIX], (bf16_t*)(ws + WS_HN) + (size_t)m * DM, lane, v);
            float d[8];
#pragma unroll
            for (int h = 0; h < 8; ++h) d[h] = 0.f;
#pragma unroll
            for (int j = 0; j < 4; ++j)
#pragma unroll
                for (int i = 0; i < 4; ++i) { const int k = 256 * j + 4 * lane + i; const f32x4 w0 = *(const LAS f32x4*)(wf + k * 8), w1 = *(const LAS f32x4*)(wf + k * 8 + 4);
                    d[0] += v[j][i] * w0[0]; d[1] += v[j][i] * w0[1]; d[2] += v[j][i] * w0[2]; d[3] += v[j][i] * w0[3];
                    d[4] += v[j][i] * w1[0]; d[5] += v[j][i] * w1[1]; d[6] += v[j][i] * w1[2]; d[7] += v[j][i] * w1[3]; }
#pragma unroll
            for (int h = 0; h < 8; ++h) d[h] = wave_sum(d[h]);
            if (lane < 8) { float z = 0.f;
#pragma unroll
                for (int h = 0; h < 8; ++h) z = (lane == h) ? d[h] : z;
                z += in[I_FBIAS][lane];
                const float ls = fminf(z, 0.f) - __logf(1.f + __expf(-fabsf(z)));
                const int b = m >> 11, t = m & 2047;
                ((float*)(ws + WS_LOGF))[(size_t)(b * 8 + lane) * SEQ + t] = ls; }
        }
        for (int m = gw; m < TM; m += NGW) { f32x4 v[4]; rms_row(in[I_MEM] + (size_t)m * DM, in[I_NMEM], (bf16_t*)(ws + WS_MN) + (size_t)m * DM, lane, v); }
        __syncthreads();
        for (int task = bx; task < S5G * TC; task += G) s5_prep_task(in, ws, task / TC, task % TC, (LAS float*)L, tid);
        SYNC(0);
    }
    if (ON(1)) {
        KA
        IDS
        const float* kt = (const float*)(ws + WS_KTAB); bf16_t* bty = (bf16_t*)(ws + WS_BTY);
        for (int idx = gt; idx < S5G * 512 * 64; idx += NGT) {
            const int half = idx & 1, ss = (idx >> 1) & 31, nn = (idx >> 6) & 511, gI = idx >> 15; const int tt = nn >> 4, c = nn & 15;
            u32x4 w = (u32x4){0u, 0u, 0u, 0u};
            if (ss <= tt) { const float* src = kt + ((size_t)((gI * TC + (tt - ss)) * 16 + c)) * 16 + half * 8; const f32x4 k0 = *(const f32x4*)src, k1 = *(const f32x4*)(src + 4);
                w.x = pk2(k0[0], k0[1]); w.y = pk2(k0[2], k0[3]); w.z = pk2(k1[0], k1[1]); w.w = pk2(k1[2], k1[3]); }
            *(u32x4*)(bty + ((size_t)gI * 512 + nn) * UGP + ss * 16 + half * 8) = w; }
        if (wave == 0 && bx < BATCH * NFH) {
            const float* lf = (const float*)(ws + WS_LOGF) + (size_t)bx * SEQ + lane * 32; float* cb = (float*)(ws + WS_CB) + (size_t)bx * SEQ + lane * 32;
            f32x4 x[8]; float run = 0.f;
#pragma unroll
            for (int j = 0; j < 8; ++j) { x[j] = ((const f32x4*)lf)[j]; x[j][0] += run; x[j][1] += x[j][0]; x[j][2] += x[j][1]; x[j][3] += x[j][2]; run = x[j][3]; }
            float incl = run;
#pragma unroll
            for (int o = 1; o < 64; o <<= 1) { const float y = __shfl_up(incl, o); if (lane >= o) incl += y; }
            const float excl = incl - run;
#pragma unroll
            for (int j = 0; j < 8; ++j) ((f32x4*)cb)[j] = (x[j] + excl) * LOG2E;
        }
    }
    if (ON(2)) {
        KA
        pg8::Gemm g{WSB(WS_HN), WSB(WS_WIN), DM, DM, DM}; GOrder<OK_PLAIN> S; S.init(T / 256, 8, G, bx, DM, DM);
        Epi<EK_PROJ> E{ws + WS_Q, ws + WS_K, ws + WS_V, ws + WS_UG, in[I_FQN], in[I_FKN], nullptr};
        pg8::gemm_phase(L, g, S, E);
    }
    if (ON(3)) {
        KA
        pg8::Gemm g{WSB(WS_MN), WSB(WS_WXK), DM, DM, DM}; GOrder<OK_PLAIN> S; S.init(TM / 256, 4, G, bx, DM, DM);
        Epi<EK_MEMK> E{ws + WS_KST, ws + WS_SSQK, nullptr, nullptr, nullptr, nullptr, nullptr};
        pg8::gemm_phase(L, g, S, E);
    }
    if (ON(4)) {
        KA
        pg8::Gemm g{WSB(WS_WXV), WSB(WS_MN), DM, DM, DM}; GOrder<OK_PLAIN> S; S.init(4, TM / 256, G, (bx + 128) % G, DM, DM);
        Epi<EK_MEMVT> E{ws + WS_VT, nullptr, nullptr, nullptr, nullptr, nullptr, nullptr};
        pg8::gemm_phase(L, g, S, E);
        SYNC(4);
    }
    if (ON(5)) {
        KA
#if DBG_SLOWQKV
        {
            IDS
            LAS float* hrow = (LAS float*)(L + wave * 4096);
            bf16_t* Qp = (bf16_t*)(ws + WS_Q); bf16_t* Kp = (bf16_t*)(ws + WS_K); bf16_t* Vp = (bf16_t*)(ws + WS_V);
            const float* W = in[I_W_IN];
            for (int m = gw; m < T; m += NGW) {
                const f32x4* xr = (const f32x4*)(in[I_X] + (size_t)m * DM) + lane; f32x4 v[4]; float s = 0.f;
#pragma unroll
                for (int j = 0; j < 4; ++j) { v[j] = xr[64 * j]; s += (v[j][0] * v[j][0] + v[j][1] * v[j][1]) + (v[j][2] * v[j][2] + v[j][3] * v[j][3]); }
                const float rs = rsqrtf(wave_sum(s) * (1.f / DM) + EPS);
#pragma unroll
                for (int j = 0; j < 4; ++j) { const f32x4 g4 = ((const f32x4*)in[I_NORM_MIX])[64 * j + lane]; *(LAS f32x4*)(hrow + (64 * j + lane) * 4) = v[j] * rs * g4; }
                asm volatile("s_waitcnt lgkmcnt(0)" ::: "memory");
                for (int ch = 0; ch < 24; ++ch) {
                    float acc = 0.f; const float* wc_ = W + ch * 64 + lane;
                    for (int k = 0; k < DM; ++k) acc += hrow[k] * wc_[(size_t)k * INCOLS];
                    const int part = ch >> 3, head = ch & 7;
                    if (part < 2) { const float ss = wave_sum(acc * acc); const float g = (part == 0 ? in[I_FQN] : in[I_FKN])[lane];
                        acc = acc * rsqrtf(ss * (1.f / 64.f) + EPS) * g * (part == 0 ? C2Q : 1.f); }
                    bf16_t* dst = part == 0 ? Qp : (part == 1 ? Kp : Vp);
                    const float fast = __builtin_bit_cast(float, (unsigned)dst[(size_t)m * 512 + head * 64 + lane] << 16);
                    const int bad = !(fabsf(fast - acc) <= 0.03f * fabsf(acc) + 0.02f * (part == 0 ? C2Q : 1.f));
                    if (__any(bad) && lane == 0) atomicAdd((unsigned*)ws + 4 + part, 1u);
                }
                asm volatile("s_waitcnt lgkmcnt(0)" ::: "memory");
            }
            if (0 && gt < BATCH * NFH) {
                const float* lf = (const float*)(ws + WS_LOGF) + (size_t)gt * SEQ; float* cbp = (float*)(ws + WS_CB) + (size_t)gt * SEQ; float run = 0.f;
                for (int t = 0; t < SEQ; ++t) { run += lf[t]; cbp[t] = run * LOG2E; }
            }
            asm volatile("s_waitcnt vmcnt(0) lgkmcnt(0)" ::: "memory"); __syncthreads(); grid.sync();
        }
#endif
#if DBG_SLOWATTN
        {
            IDS
            const bf16_t* Qp = WSB(WS_Q); const bf16_t* Kp = WSB(WS_K); const bf16_t* Vp = WSB(WS_V); bf16_t* Op = (bf16_t*)(ws + WS_FOX);
            const float* CBp = (const float*)(ws + WS_CB); float* SQ = (float*)(ws + WS_SSQF);
            for (int item = gw; item < BATCH * NFH * SEQ; item += NGW) {
                const int t = item & 2047, bh = item >> 11, b = bh >> 3, h = bh & 7;
                const size_t rowq = (size_t)(b * SEQ + t);
                float qv[64];
#pragma unroll
                for (int c8 = 0; c8 < 8; ++c8) { const u32x4 w = *(const u32x4*)(Qp + rowq * 512 + h * 64 + c8 * 8);
                    qv[c8 * 8 + 0] = bflo(w.x); qv[c8 * 8 + 1] = bfhi(w.x); qv[c8 * 8 + 2] = bflo(w.y); qv[c8 * 8 + 3] = bfhi(w.y);
                    qv[c8 * 8 + 4] = bflo(w.z); qv[c8 * 8 + 5] = bfhi(w.z); qv[c8 * 8 + 6] = bflo(w.w); qv[c8 * 8 + 7] = bfhi(w.w); }
                const float* cbh = CBp + (size_t)bh * SEQ; const float ct = cbh[t];
                float mx = -INFINITY, lsum = 0.f, o = 0.f;
                for (int s0 = 0; s0 <= t; s0 += 64) {
                    const int s = s0 + lane; float sc = -INFINITY;
                    if (s <= t) { const size_t rowk = (size_t)(b * SEQ + s); float dsum = 0.f;
#pragma unroll
                        for (int c8 = 0; c8 < 8; ++c8) { const u32x4 w = *(const u32x4*)(Kp + rowk * 512 + h * 64 + c8 * 8);
                            dsum += qv[c8 * 8 + 0] * bflo(w.x) + qv[c8 * 8 + 1] * bfhi(w.x) + qv[c8 * 8 + 2] * bflo(w.y) + qv[c8 * 8 + 3] * bfhi(w.y)
                                  + qv[c8 * 8 + 4] * bflo(w.z) + qv[c8 * 8 + 5] * bfhi(w.z) + qv[c8 * 8 + 6] * bflo(w.w) + qv[c8 * 8 + 7] * bfhi(w.w); }
                        sc = dsum + (ct - cbh[s]); }
                    float cm = sc;
#pragma unroll
                    for (int of = 1; of < 64; of <<= 1) cm = fmaxf(cm, __shfl_xor(cm, of));
                    const float nm = fmaxf(mx, cm), f = __builtin_amdgcn_exp2f(mx - nm); mx = nm;
                    const float p = (s <= t) ? __builtin_amdgcn_exp2f(sc - nm) : 0.f;
                    lsum = lsum * f + wave_sum(p); o *= f;
                    const int nk = (t - s0 + 1) < 64 ? (t - s0 + 1) : 64;
                    for (int j = 0; j < nk; ++j) { const float pj = __shfl(p, j); const unsigned short vv = Vp[(size_t)(b * SEQ + s0 + j) * 512 + h * 64 + lane];
                        o += pj * __builtin_bit_cast(float, (unsigned)vv << 16); }
                }
                const float ov = o / lsum; const unsigned ob = f2bf(ov); const float orr = __builtin_bit_cast(float, ob << 16);
                Op[rowq * 512 + h * 64 + lane] = (bf16_t)ob;
                const float ssq = wave_sum(orr * orr);
                if (lane == 0) SQ[rowq * 8 + h] = ssq;
            }
        }
#else
        const int vcu = (G % 8 == 0) ? (bx % 8) * (G / 8) + bx / 8 : bx;
        for (int L2 = vcu; L2 < BATCH * NFH * 2; L2 += G) { const int bh = L2 >> 1, s = L2 & 1;
            for (int i = 0; i < 4; ++i) { const int qb = (i == 0) ? s : (i == 1) ? 3 - s : (i == 2) ? 4 + s : 7 - s;
                attn_body::attn_unit<8>(bh >> 3, bh & 7, qb, (const attn_body::bf16*)(ws + WS_Q), (const attn_body::bf16*)(ws + WS_K), (const attn_body::bf16*)(ws + WS_V),
                                        (attn_body::bf16*)(ws + WS_FOX), (const float*)(ws + WS_CB), (float*)(ws + WS_SSQF), (char*)lds); } }
#endif
    }
    if (ON(6)) {
        KA
        pg8::Gemm g{WSB(WS_UG), WSB(WS_BTE), UGP, 512, 256}; GOrder<OK_S5E> S; S.init(256, 1, G, bx, UGP, 512);
        Epi<EK_S5E> E{ws + WS_EPART, nullptr, nullptr, nullptr, nullptr, nullptr, nullptr};
        pg8::gemm_phase(L, g, S, E);
        SYNC(6);
    }
    if (ON(7)) {
        KA
        IDS
        const float* ep = (const float*)(ws + WS_EPART); const float* lb = (const float*)(ws + WS_LB32); bf16_t* ug = (bf16_t*)(ws + WS_UG);
        for (int idx = gt; idx < S5G * BATCH * S5P; idx += NGT) { const int p = idx & 63, gb = idx >> 6, gI = gb >> 4;
            const float lr = lb[(gI * 64 + p) * 2], li = lb[(gI * 64 + p) * 2 + 1]; float sr = 0.f, si = 0.f;
            for (int k = 0; k < NCH; ++k) { const size_t row = (size_t)gb * NCH + k;
                *(unsigned*)(ug + row * UGP + 512 + 2 * p) = pk2(sr, si);
                const f32x2 e0 = *(const f32x2*)(ep + row * 128 + 2 * p), e1 = *(const f32x2*)(ep + (size_t)32768 * 128 + row * 128 + 2 * p);
                const float nr = lr * sr - li * si + (e0[0] + e1[0]), ni = lr * si + li * sr + (e0[1] + e1[1]); sr = nr; si = ni; } }
        SYNC(7);
    }
    if (ON(8)) {
        KA
        pg8::Gemm g{WSB(WS_UG), WSB(WS_BTY), UGP, UGP, UGP}; GOrder<OK_S5Y> S; S.init(256, 1, G, bx, UGP, UGP);
        Epi<EK_S5Y> E{ws + WS_Y1, nullptr, nullptr, nullptr, nullptr, nullptr, nullptr};
        pg8::gemm_phase(L, g, S, E);
        SYNC(8);
    }
    if (ON(9)) {
        KA
        pg8::Gemm g{WSB(WS_Y1), WSB(WS_WGLU), 512, 512, 512}; GOrder<OK_PLAIN> S; S.init(T / 256, 2, G, bx, 512, 512);
        Epi<EK_GLU> E{ws + WS_Y2, ws + WS_SSQY, nullptr, nullptr, ws + WS_Y1, in[I_BGLU], nullptr};
        pg8::gemm_phase(L, g, S, E);
        SYNC(9);
    }
    if (ON(10)) {
        KA
        IDS
        const float* sf = (const float*)(ws + WS_SSQF); const float* sy = (const float*)(ws + WS_SSQY);
        const bf16_t* fox = WSB(WS_FOX); const bf16_t* y2 = WSB(WS_Y2); bf16_t* mx = (bf16_t*)(ws + WS_MIXN);
        for (int m = gw; m < T; m += NGW) {
            const f32x4 a0 = *(const f32x4*)(sf + (size_t)m * 8), a1 = *(const f32x4*)(sf + (size_t)m * 8 + 4), b0 = *(const f32x4*)(sy + (size_t)m * 8), b1 = *(const f32x4*)(sy + (size_t)m * 8 + 4);
            const float rf = rsqrtf((((a0[0] + a0[1]) + (a0[2] + a0[3])) + ((a1[0] + a1[1]) + (a1[2] + a1[3]))) * (1.f / 512.f) + EPS);
            const float ry = rsqrtf((((b0[0] + b0[1]) + (b0[2] + b0[3])) + ((b1[0] + b1[1]) + (b1[2] + b1[3]))) * (1.f / 512.f) + EPS);
            const u32x4 f = *(const u32x4*)(fox + (size_t)m * 512 + lane * 8), y = *(const u32x4*)(y2 + (size_t)m * 512 + lane * 8);
            u32x4 of, oy;
            of.x = pk2(bflo(f.x) * rf, bfhi(f.x) * rf); of.y = pk2(bflo(f.y) * rf, bfhi(f.y) * rf); of.z = pk2(bflo(f.z) * rf, bfhi(f.z) * rf); of.w = pk2(bflo(f.w) * rf, bfhi(f.w) * rf);
            oy.x = pk2(bflo(y.x) * ry, bfhi(y.x) * ry); oy.y = pk2(bflo(y.y) * ry, bfhi(y.y) * ry); oy.z = pk2(bflo(y.z) * ry, bfhi(y.z) * ry); oy.w = pk2(bflo(y.w) * ry, bfhi(y.w) * ry);
            if (DBG_NOFOXH) of = (u32x4){0u, 0u, 0u, 0u};
            if (DBG_NOS5H) oy = (u32x4){0u, 0u, 0u, 0u};
            *(u32x4*)(mx + (size_t)m * DM + lane * 8) = of; *(u32x4*)(mx + (size_t)m * DM + 512 + lane * 8) = oy; }
        SYNC(10);
    }
    if (ON(11)) {
        KA
        pg8::Gemm g{WSB(WS_MIXN), WSB(WS_WOUT), DM, DM, DM}; GOrder<OK_PLAIN> S; S.init(T / 256, 4, G, bx, DM, DM);
        Epi<EK_WOUT> E{out, ws + WS_H1B, ws + WS_SSQ1, nullptr, in[I_X], nullptr, nullptr};
        pg8::gemm_phase(L, g, S, E);
        SYNC(11);
    }
    if (ON(12)) {
        KA
        IDS
        const float* sk = (const float*)(ws + WS_SSQK); float* sck = (float*)(ws + WS_SCK);
        for (int idx = gt; idx < TM * 4; idx += NGT) { const int key = idx >> 2, h = idx & 3; const f32x4 q = *(const f32x4*)(sk + (size_t)key * 16 + h * 4);
            sck[(size_t)h * TM + key] = rsqrtf(((q[0] + q[1]) + (q[2] + q[3])) * (1.f / 256.f) + EPS); }
        pg8::Gemm g{WSB(WS_H1B), WSB(WS_WXQ), DM, DM, DM}; GOrder<OK_PLAIN> S; S.init(T / 256, 4, G, bx, DM, DM);
        Epi<EK_XQ> E{ws + WS_QST, ws + WS_SSQQ, nullptr, nullptr, in[I_XQN], in[I_XKN], nullptr};
        pg8::gemm_phase(L, g, S, E);
        SYNC(12);
    }
    if (ON(13)) {
        KA
        pg8::Gemm g{WSB(WS_QST), WSB(WS_KST), DM, DM, 256}; GOrder<OK_XS> S; S.init(512, 1, G, bx, DM, DM);
        Epi<EK_XS> E{ws + WS_P, ws + WS_PSUM, nullptr, nullptr, ws + WS_SSQ1, ws + WS_SSQQ, ws + WS_SCK};
        pg8::gemm_phase(L, g, S, E);
        SYNC(13);
    }
    if (ON(14)) {
        KA
        pg8::Gemm g{WSB(WS_P), WSB(WS_VT), DM, TM, 256}; GOrder<OK_XO> S; S.init(512, 1, G, bx, DM, TM);
        Epi<EK_XO> E{ws + WS_XO, nullptr, nullptr, nullptr, ws + WS_PSUM, nullptr, nullptr};
        pg8::gemm_phase(L, g, S, E);
        SYNC(14);
    }
    if (ON(15)) {
        KA
        pg8::Gemm g{WSB(WS_XO), WSB(WS_WXO), DM, DM, DM}; GOrder<OK_PLAIN> S; S.init(T / 256, 4, G, bx, DM, DM);
        Epi<EK_WXO> E{out, ws + WS_H2B, ws + WS_SSQ2, nullptr, out, nullptr, nullptr};
        pg8::gemm_phase(L, g, S, E);
        SYNC(15);
    }
    if (ON(16)) {
        KA
        pg8::Gemm g{WSB(WS_H2B), WSB(WS_WUP), DM, DM, DM}; GOrder<OK_PLAIN> S; S.init(T / 256, 22, G, bx, DM, DM);
        Epi<EK_UP> E{ws + WS_G, ws + WS_U, nullptr, nullptr, ws + WS_SSQ2, nullptr, nullptr};
        pg8::gemm_phase(L, g, S, E);
        SYNC(16);
    }
    if (ON(17)) {
        KA
        IDS
        const bf16_t* Gp = WSB(WS_G); bf16_t* Up = (bf16_t*)(ws + WS_U);
        const float* cw = in[I_CONVW]; const float* cbv = in[I_CONVB];
        for (int item = gw; item < 11 * (T / 64); item += NGW) {
            const int jg = item % 11, tch = item / 11; const int j0 = (jg * 32 + (lane & 31)) * 8; const int t0 = tch * 64 + (lane >> 5) * 32;
            float w0[8], w1[8], w2[8], bb[8];
#pragma unroll
            for (int i = 0; i < 8; ++i) { w0[i] = cw[j0 + i]; w1[i] = cw[DFF + j0 + i]; w2[i] = cw[2 * DFF + j0 + i]; bb[i] = cbv[j0 + i]; }
            u32x4 gm2 = (u32x4){0u, 0u, 0u, 0u}, gm1 = gm2;
            if ((t0 & 2047) != 0) { gm2 = *(const u32x4*)(Gp + (size_t)(t0 - 2) * DFF + j0); gm1 = *(const u32x4*)(Gp + (size_t)(t0 - 1) * DFF + j0); }
            for (int t = t0; t < t0 + 32; ++t) {
                const u32x4 g0 = *(const u32x4*)(Gp + (size_t)t * DFF + j0); const u32x4 uu = *(const u32x4*)(Up + (size_t)t * DFF + j0);
                float r[8];
#pragma unroll
                for (int q = 0; q < 4; ++q) { const unsigned a2 = gm2[q], a1 = gm1[q], a0 = g0[q], u0 = uu[q];
                    const float z0 = bb[2 * q] + w0[2 * q] * bflo(a2) + w1[2 * q] * bflo(a1) + w2[2 * q] * bflo(a0);
                    const float z1 = bb[2 * q + 1] + w0[2 * q + 1] * bfhi(a2) + w1[2 * q + 1] * bfhi(a1) + w2[2 * q + 1] * bfhi(a0);
                    r[2 * q] = z0 * sigm(z0) * bflo(u0); r[2 * q + 1] = z1 * sigm(z1) * bfhi(u0); }
                u32x4 o; o.x = pk2(r[0], r[1]); o.y = pk2(r[2], r[3]); o.z = pk2(r[4], r[5]); o.w = pk2(r[6], r[7]);
                *(u32x4*)(Up + (size_t)t * DFF + j0) = o;
                gm2 = gm1; gm1 = g0; } }
        SYNC(17);
    }
    if (ON(18)) {
        KA
        pg8::Gemm g{WSB(WS_U), WSB(WS_WDN), DFF, DFF, DFF}; GOrder<OK_PLAIN> S; S.init(T / 256, 4, G, bx, DFF, DFF);
        Epi<EK_DOWN> E{out, nullptr, nullptr, nullptr, nullptr, nullptr, nullptr};
        pg8::gemm_phase(L, g, S, E);
    }
}

extern "C" void kernel_launch(void* const* d_in, const int* in_sizes, int n_in, void* d_out, int out_size, void* d_ws, size_t ws_size, hipStream_t stream) {
    static int grid = 0;
    if (grid == 0) {
        if (n_in != 32 || out_size != T * DM || ws_size < WS_END) { fprintf(stderr, "kernel_launch: unexpected shapes (n_in %d out %d ws %zu)\n", n_in, out_size, ws_size); grid = -1; return; }
        int dev = 0, cus = 0, per_cu = 0;
        (void)hipGetDevice(&dev); (void)hipDeviceGetAttribute(&cus, hipDeviceAttributeMultiprocessorCount, dev);
        if (hipFuncSetAttribute((const void*)fox_s5_mega, hipFuncAttributeMaxDynamicSharedMemorySize, LDS_TOTAL) != hipSuccess) { fprintf(stderr, "kernel_launch: hipFuncSetAttribute failed\n"); grid = -1; return; }
        if (hipOccupancyMaxActiveBlocksPerMultiprocessor(&per_cu, (const void*)fox_s5_mega, 512, LDS_TOTAL) != hipSuccess || per_cu < 1) { fprintf(stderr, "kernel_launch: occupancy query says %d\n", per_cu); per_cu = 1; }
        (void)hipGetLastError();
        grid = cus;
        if (grid > cus * per_cu) grid = cus * per_cu;
    }
    if (grid < 0) return;
    Args a{};
    for (int i = 0; i < 32; ++i) a.in[i] = (const float*)d_in[i];
    a.out = (float*)d_out; a.ws = (unsigned char*)d_ws;
    void* args[] = {&a};
    hipError_t e = hipLaunchCooperativeKernel((const void*)fox_s5_mega, dim3(grid), dim3(512), args, LDS_TOTAL, stream);
    if (e != hipSuccess) fprintf(stderr, "cooperative launch failed: %s (grid %d)\n", hipGetErrorString(e), grid);
}
```

```cpp
#include <hip/hip_runtime.h>
#include <hip/hip_cooperative_groups.h>
#include <hip/hip_bf16.h>
#include <cstdio>
#include <cstdint>
#include <cmath>
namespace cg = cooperative_groups;

#ifndef DBG_SSM
#define DBG_SSM 1.f
#endif
#ifndef DBG_BIAS
#define DBG_BIAS 1.f
#endif
#ifndef DBG_SLOWATTN
#define DBG_SLOWATTN 0
#endif
#ifndef DBG_NOFOXH
#define DBG_NOFOXH 0
#endif
#ifndef DBG_NOS5H
#define DBG_NOS5H 0
#endif
#ifndef DBG_SLOWQKV
#define DBG_SLOWQKV 0
#endif
#ifndef DBG_CROSS
#define DBG_CROSS 1.f
#endif
#ifndef DBG_MIX
#define DBG_MIX 1.f
#endif
#ifndef DBG_FFN
#define DBG_FFN 1.f
#endif
constexpr int BATCH = 16, SEQ = 2048, DM = 1024, T = BATCH * SEQ;
constexpr int NMEM = 256, TM = BATCH * NMEM;
constexpr int FOXW = 512, HD = 64, NFH = 8;
constexpr int S5W = 512, S5G = 32, S5C = 16, S5P = 64;
constexpr int NXH = 4, XHD = 256;
constexpr int DFF = 2816;
constexpr int INCOLS = 2056;
constexpr float EPS = 1e-6f;
constexpr int TC = 32, NCH = SEQ / TC;
constexpr int UGP = TC * 16 + 128;
constexpr float LOG2E = 1.4426950408889634f;
constexpr float C2Q = 0.125f * LOG2E;

#define LAS __attribute__((address_space(3)))
typedef unsigned short bf16_t;
typedef short bf16x8 __attribute__((ext_vector_type(8)));
typedef float f32x4 __attribute__((ext_vector_type(4)));
typedef float f32x2 __attribute__((ext_vector_type(2)));
typedef unsigned u32x4 __attribute__((ext_vector_type(4)));
typedef unsigned u32x2 __attribute__((ext_vector_type(2)));

__device__ __forceinline__ unsigned f2bf(float f) { unsigned u = __builtin_bit_cast(unsigned, f); return (u + 0x7fffu + ((u >> 16) & 1u)) >> 16; }
__device__ __forceinline__ unsigned pk2(float lo, float hi) { return f2bf(lo) | (f2bf(hi) << 16); }
__device__ __forceinline__ float bflo(unsigned w) { return __builtin_bit_cast(float, w << 16); }
__device__ __forceinline__ float bfhi(unsigned w) { return __builtin_bit_cast(float, w & 0xffff0000u); }
__device__ __forceinline__ float wave_sum(float v) {
#pragma unroll
    for (int o = 1; o < 64; o <<= 1) v += __shfl_xor(v, o);
    return v;
}

__device__ __forceinline__ float red_fq(float v) {
    v += __builtin_bit_cast(float, __builtin_amdgcn_ds_swizzle(__builtin_bit_cast(int, v), 0x401F));
    float a = v, b = v;
    asm volatile("s_nop 1\n\tv_permlane32_swap_b32 %0, %1\n\ts_nop 1" : "+v"(a), "+v"(b));
    return a + b;
}

constexpr size_t MiB = 1u << 20;
constexpr size_t WS_WIN = 1 * MiB, WS_WGLU = 5 * MiB, WS_WOUT = 6 * MiB, WS_WXQ = 8 * MiB, WS_WXK = 10 * MiB, WS_WXV = 12 * MiB, WS_WXO = 14 * MiB,
                 WS_WUP = 16 * MiB, WS_WDN = 27 * MiB, WS_BTY = 33 * MiB, WS_BTE = 53 * MiB, WS_KTAB = 61 * MiB, WS_LB32 = 62 * MiB, WS_LOGF = 63 * MiB,
                 WS_CB = 64 * MiB, WS_SSQF = 65 * MiB, WS_SSQY = 66 * MiB, WS_SSQ1 = 67 * MiB, WS_SSQ2 = 69 * MiB, WS_SSQQ = 71 * MiB, WS_PSUM = 73 * MiB,
                 WS_SSQK = 75 * MiB, WS_SCK = 76 * MiB, WS_RS2 = 77 * MiB;
constexpr size_t WS_HN = 80 * MiB, WS_FOX = 80 * MiB, WS_Y1 = 112 * MiB, WS_QST = 80 * MiB, WS_H2B = 80 * MiB;
constexpr size_t WS_MN = 144 * MiB, WS_KST = 152 * MiB, WS_VT = 160 * MiB;
constexpr size_t WS_Q = 168 * MiB, WS_K = 200 * MiB, WS_V = 232 * MiB, WS_Y2 = 168 * MiB, WS_MIXN = 200 * MiB, WS_P = 168 * MiB;
constexpr size_t WS_UG = 264 * MiB, WS_EPART = 304 * MiB, WS_H1B = 264 * MiB, WS_XO = 264 * MiB;
constexpr size_t WS_G = 144 * MiB, WS_U = 320 * MiB, WS_END = 496 * MiB;

namespace pg8 {
constexpr int BM = 256, BK = 64, HALF = 128, HTB = HALF * BK * 2, STAGE_BYTES = 8 * HTB;
__device__ __forceinline__ int lds_byte(int r, int c) { const int st = (r >> 4) * 2 + (c >> 5), rr = r & 15, cc = c & 31, ob = rr * 64 + cc * 2; return st * 1024 + (ob ^ (((ob >> 9) & 1) << 5)); }
__device__ __forceinline__ void stage_rc(int b, int& R, int& C) { const int st = b / 1024, sb = b % 1024, swz = sb ^ (((sb >> 9) & 1) << 5); R = (st >> 1) * 16 + swz / 64; C = (st & 1) * 32 + (swz % 64) / 2; }
__device__ __forceinline__ int perm32(int rho) { const int n = rho >> 4, i = rho & 15; return 8 * (i >> 2) + 4 * n + (i & 3); }

struct Unit { int pm, pn; long offA, offB; };
struct Gemm { const bf16_t* A; const bf16_t* Bt; int lda, ldb, K; };

template <class Epi, class Sched>
__device__ __forceinline__ void gemm_phase(LAS unsigned char* lds, const Gemm g, const Sched& S, const Epi& E, unsigned* dbg = nullptr) {
    int tid = threadIdx.x; asm volatile("" : "+v"(tid));
    const int wid = __builtin_amdgcn_readfirstlane(tid >> 6), lane = tid & 63, wr = wid >> 2, wc = wid & 3, fr = lane & 15, fq = lane >> 4;
    const int K = g.K, nt = K / BK;
    unsigned voffA[2], voffB[2];
#pragma unroll
    for (int i = 0; i < 2; ++i) { int R, C; stage_rc(tid * 16 + i * 8192, R, C); const int Rb = (R & ~31) + perm32(R & 31);
        voffA[i] = (unsigned)(R * g.lda + C) * 2u; voffB[i] = (unsigned)(Rb * g.ldb + C) * 2u; }
    const size_t kstep = (size_t)(BK * 2);
    const size_t hstepA = (size_t)HALF * g.lda * 2, hstepB = (size_t)HALF * g.ldb * 2;
    const unsigned ldsw = (unsigned)wid * 1024u;
    const int aoff = lds_byte(wr * 64 + fr, fq * 8), boff = lds_byte(wc * 32 + fr, fq * 8);
#define PG8_SA(b, h) (((b) * 2 + (h)) * HTB)
#define PG8_SB(b, h) ((4 + (b) * 2 + (h)) * HTB)
#define PG8_STAGE(bufoff, gbase, voff) do { _Pragma("unroll") for (int _i = 0; _i < 2; ++_i) \
        __builtin_amdgcn_global_load_lds((const unsigned*)((const char*)(gbase) + (voff)[_i]), (LAS unsigned*)(lds + (bufoff) + ldsw + _i * 8192), 16, 0, 0); } while (0)
#define PG8_LDA(dst, b, h) do { _Pragma("unroll") for (int m = 0; m < 4; ++m) _Pragma("unroll") for (int k = 0; k < 2; ++k) dst[m][k] = *(const LAS bf16x8*)(lds + PG8_SA(b, h) + aoff + m * 2048 + k * 1024); } while (0)
#define PG8_LDB(dst, b, h) do { _Pragma("unroll") for (int n = 0; n < 2; ++n) _Pragma("unroll") for (int k = 0; k < 2; ++k) dst[n][k] = *(const LAS bf16x8*)(lds + PG8_SB(b, h) + boff + n * 2048 + k * 1024); } while (0)
#define PG8_MMA(ai, bj, At, Bt) do { __builtin_amdgcn_s_setprio(1); _Pragma("unroll") for (int m = 0; m < 4; ++m) _Pragma("unroll") for (int n = 0; n < 2; ++n) _Pragma("unroll") for (int k = 0; k < 2; ++k) \
        acc[ai][bj][m][n] = __builtin_amdgcn_mfma_f32_16x16x32_bf16(Bt[n][k], At[m][k], acc[ai][bj][m][n], 0, 0, 0); __builtin_amdgcn_s_setprio(0); } while (0)
#define PG8_WAIT_V(n) asm volatile("s_waitcnt vmcnt(" #n ")" ::: "memory")
#define PG8_WAIT_L(n) asm volatile("s_waitcnt lgkmcnt(" #n ")" ::: "memory")
#define PG8_BAR __builtin_amdgcn_s_barrier()
#define PG8_SCHED __builtin_amdgcn_sched_barrier(0)
    Unit cur, nxt; int ui = 0;
    if (!S.next(0, cur)) return;
    f32x4 acc[2][2][4][2];
#pragma unroll
    for (int a = 0; a < 2; ++a)
#pragma unroll
        for (int b = 0; b < 2; ++b)
#pragma unroll
            for (int m = 0; m < 4; ++m)
#pragma unroll
                for (int n = 0; n < 2; ++n) acc[a][b][m][n] = (f32x4){0.f, 0.f, 0.f, 0.f};
    bf16x8 At[4][2], B0[2][2], B1[2][2];
    const char* cA = (const char*)g.A + cur.offA; const char* cB = (const char*)g.Bt + cur.offB;
    PG8_STAGE(PG8_SB(0, 0), cB, voffB); PG8_STAGE(PG8_SB(0, 1), cB + hstepB, voffB); PG8_STAGE(PG8_SA(0, 0), cA, voffA); PG8_STAGE(PG8_SA(0, 1), cA + hstepA, voffA);
    if (wr == 1) PG8_BAR;
    PG8_WAIT_V(2); PG8_BAR;
    PG8_STAGE(PG8_SB(1, 0), cB + kstep, voffB); PG8_STAGE(PG8_SA(1, 0), cA + kstep, voffA); PG8_STAGE(PG8_SB(1, 1), cB + hstepB + kstep, voffB);
    PG8_WAIT_V(6); PG8_BAR;
    for (;;) {
        const bool has_next = S.next(ui + 1, nxt);
        const char* nA = has_next ? (const char*)g.A + nxt.offA : cA; const char* nB = has_next ? (const char*)g.Bt + nxt.offB : cB;
        for (int t = 0; t < nt; t += 2) {
            const bool last = (t == nt - 2);
            const char* a1 = cA + (size_t)(t + 1) * kstep;
            const char* a2 = last ? nA : cA + (size_t)(t + 2) * kstep; const char* b2 = last ? nB : cB + (size_t)(t + 2) * kstep;
            const char* a3 = a2 + kstep; const char* b3 = b2 + kstep;
            PG8_LDB(B0, 0, 0); PG8_LDB(B1, 0, 1); PG8_SCHED; PG8_LDA(At, 0, 0); PG8_STAGE(PG8_SA(1, 1), a1 + hstepA, voffA);
            PG8_WAIT_V(8); PG8_WAIT_L(0); PG8_BAR; PG8_MMA(0, 0, At, B0); PG8_MMA(0, 1, At, B1); PG8_BAR; PG8_SCHED;
            PG8_LDA(At, 0, 1); PG8_STAGE(PG8_SB(0, 0), b2, voffB); PG8_STAGE(PG8_SB(0, 1), b2 + hstepB, voffB); PG8_STAGE(PG8_SA(0, 0), a2, voffA);
            PG8_WAIT_V(8); PG8_WAIT_L(0); PG8_BAR; PG8_MMA(1, 0, At, B0); PG8_MMA(1, 1, At, B1); PG8_BAR; PG8_SCHED;
            PG8_LDB(B0, 1, 0); PG8_LDB(B1, 1, 1); PG8_SCHED; PG8_LDA(At, 1, 0); PG8_STAGE(PG8_SA(0, 1), a2 + hstepA, voffA);
            PG8_WAIT_V(8); PG8_WAIT_L(0); PG8_BAR; PG8_MMA(0, 0, At, B0); PG8_MMA(0, 1, At, B1); PG8_BAR; PG8_SCHED;
            PG8_LDA(At, 1, 1); PG8_STAGE(PG8_SB(1, 0), b3, voffB); PG8_STAGE(PG8_SB(1, 1), b3 + hstepB, voffB); PG8_STAGE(PG8_SA(1, 0), a3, voffA);
            PG8_WAIT_V(8); PG8_WAIT_L(0); PG8_BAR; PG8_MMA(1, 0, At, B0); PG8_MMA(1, 1, At, B1); PG8_BAR; PG8_SCHED;
        }
        if (wr == 0) PG8_BAR;
        { int fr2 = fr, fq2 = fq; asm volatile("" : "+v"(fr2), "+v"(fq2));
          if (dbg && fr2 == 0 && fq2 == 0) {
              const bf16_t* ar = (const bf16_t*)((const char*)g.A + cur.offA) + (size_t)(wr * 64) * g.lda; const bf16_t* br = (const bf16_t*)((const char*)g.Bt + cur.offB) + (size_t)(wc * 32) * g.ldb;
              float ref = 0.f; for (int k = 0; k < K; ++k) ref += __builtin_bit_cast(float, (unsigned)ar[k] << 16) * __builtin_bit_cast(float, (unsigned)br[k] << 16);
              const float got = acc[0][0][0][0][0]; if (!(fabsf(got - ref) <= 0.02f * fmaxf(1.f, fabsf(ref)))) atomicAdd(dbg, 1u); }
          E(acc, cur, wr, wc, fr2, fq2); }
        if (!has_next) break;
#pragma unroll
        for (int a = 0; a < 2; ++a)
#pragma unroll
            for (int b = 0; b < 2; ++b)
#pragma unroll
                for (int m = 0; m < 4; ++m)
#pragma unroll
                    for (int n = 0; n < 2; ++n) acc[a][b][m][n] = (f32x4){0.f, 0.f, 0.f, 0.f};
        cur = nxt; cA = nA; cB = nB; ++ui;
        if (wr == 1) PG8_BAR;
    }
    PG8_WAIT_V(0);
    PG8_BAR;
#undef PG8_SA
#undef PG8_SB
#undef PG8_STAGE
#undef PG8_LDA
#undef PG8_LDB
#undef PG8_MMA
#undef PG8_WAIT_V
#undef PG8_WAIT_L
#undef PG8_BAR
#undef PG8_SCHED
}
}
using pg8::Unit;

enum OrderKind { OK_PLAIN = 0, OK_S5E, OK_S5Y, OK_XS, OK_XO };
template <int kind> struct GOrder {
    int nM, nN, nwg, G, c, lda, ldb;
    __device__ __forceinline__ void init(int nM_, int nN_, int G_, int c_, int lda_, int ldb_) { nM = nM_; nN = nN_; nwg = nM_ * nN_; G = G_; c = c_; lda = lda_; ldb = ldb_; }
    __device__ __forceinline__ bool next(int i, Unit& u) const {
        const long L = (long)i * G + c; if (L >= nwg) return false;
        const int l = (int)L;
        if constexpr (kind == OK_PLAIN) {
            int wgid = l; { const int q = nwg / 8, r = nwg % 8, xcd = wgid % 8, off = wgid / 8; wgid = (xcd < r ? xcd * (q + 1) : r * (q + 1) + (xcd - r) * q) + off; }
            const int nig = 8 * nN, gid = wgid / nig, fm = gid * 8, gsz = (nM - fm) < 8 ? (nM - fm) : 8;
            u.pm = fm + ((wgid % nig) % gsz); u.pn = (wgid % nig) / gsz;
            u.offA = (long)u.pm * 256 * lda * 2; u.offB = (long)u.pn * 256 * ldb * 2;
        } else if constexpr (kind == OK_S5E) {
            const int kq = l & 1, pmm = (l >> 1) & 3, gg = l >> 3;
            u.pm = gg * 4 + pmm; u.pn = kq;
            u.offA = ((long)u.pm * 256 * UGP + kq * 256) * 2; u.offB = ((long)gg * 256 * 512 + kq * 256) * 2;
        } else if constexpr (kind == OK_S5Y) {
            const int pn = l & 1, pmm = (l >> 1) & 3, gg = l >> 3;
            u.pm = gg * 4 + pmm; u.pn = pn;
            u.offA = (long)u.pm * 256 * UGP * 2; u.offB = ((long)gg * 512 + pn * 256) * UGP * 2;
        } else if constexpr (kind == OK_XS) {
            const int h = l & 3, pm = l >> 2, b = pm >> 3;
            u.pm = pm; u.pn = h;
            u.offA = ((long)pm * 256 * DM + h * 256) * 2; u.offB = ((long)b * 256 * DM + h * 256) * 2;
        } else {
            const int h = l & 3, pm = l >> 2, b = pm >> 3;
            u.pm = pm; u.pn = h;
            u.offA = ((long)pm * 256 * DM + h * 256) * 2; u.offB = ((long)h * 256 * TM + b * 256) * 2;
        }
        return true;
    }
};

enum EpiKind { EK_PROJ = 0, EK_MEMK, EK_MEMVT, EK_S5E, EK_S5Y, EK_GLU, EK_WOUT, EK_XQ, EK_XS, EK_XO, EK_WXO, EK_UP, EK_DOWN, EK_GATE, EK_UPACT };
    __device__ __forceinline__ u32x4 pack8(const f32x4 a, const f32x4 b) { u32x4 w; w.x = pk2(a[0], a[1]); w.y = pk2(a[2], a[3]); w.z = pk2(b[0], b[1]); w.w = pk2(b[2], b[3]); return w; }
    __device__ __forceinline__ float gelu_t(float y) { const float z = 0.7978845608028654f * (y + 0.044715f * y * y * y); const float e = __expf(2.f * z); const float th = 1.f - 2.f / (e + 1.f); return 0.5f * y * (1.f + th); }
    __device__ __forceinline__ float sigm(float z) { return 1.f / (1.f + __expf(-z)); }
    __device__ __forceinline__ float ssq8(const f32x4 a, const f32x4 b) { return (a[0] * a[0] + a[1] * a[1]) + (a[2] * a[2] + a[3] * a[3]) + (b[0] * b[0] + b[1] * b[1]) + (b[2] * b[2] + b[3] * b[3]); }

template <int kind> struct Epi {
    void* p0; void* p1; void* p2; void* p3; const void* c0; const void* c1; const void* c2;
    __device__ __forceinline__ void operator()(const f32x4 (&acc)[2][2][4][2], const Unit& u, int wr, int wc, int fr, int fq) const {
        const int rbase = u.pm * 256 + wr * 64 + fr;
        const int cl0 = wc * 32 + 8 * fq;
        switch (kind) {
        case EK_PROJ: {
            const int pn = u.pn;
            if (pn < 4) {
                const bool isq = pn < 2; bf16_t* dst = (bf16_t*)(isq ? p0 : p1); const float* gptr = (const float*)(isq ? c0 : c1); const float post = isq ? C2Q : 1.f;
                const int head = 4 * (pn & 1) + wc;
#pragma unroll
                for (int ai = 0; ai < 2; ++ai)
#pragma unroll
                    for (int m = 0; m < 4; ++m) {
                        float ss = ssq8(acc[ai][0][m][0], acc[ai][0][m][1]) + ssq8(acc[ai][1][m][0], acc[ai][1][m][1]);
                        ss = red_fq(ss);
                        const float sc = rsqrtf(ss * (1.f / 64.f) + EPS) * post;
                        const size_t row = (size_t)(rbase + ai * 128 + m * 16);
#pragma unroll
                        for (int bj = 0; bj < 2; ++bj)
                            *(u32x4*)(dst + row * 512 + head * 64 + 32 * bj + 8 * fq) = pack8(acc[ai][bj][m][0] * sc * *(const f32x4*)(gptr + 32 * bj + 8 * fq), acc[ai][bj][m][1] * sc * *(const f32x4*)(gptr + 32 * bj + 8 * fq + 4));
                    }
            } else if (pn < 6) {
                bf16_t* dst = (bf16_t*)p2;
#pragma unroll
                for (int ai = 0; ai < 2; ++ai)
#pragma unroll
                    for (int m = 0; m < 4; ++m) { const size_t row = (size_t)(rbase + ai * 128 + m * 16);
#pragma unroll
                        for (int bj = 0; bj < 2; ++bj) *(u32x4*)(dst + row * 512 + (pn - 4) * 256 + bj * 128 + cl0) = pack8(acc[ai][bj][m][0], acc[ai][bj][m][1]); }
            } else {
                bf16_t* dst = (bf16_t*)p3;
#pragma unroll
                for (int ai = 0; ai < 2; ++ai)
#pragma unroll
                    for (int m = 0; m < 4; ++m) { const int row = rbase + ai * 128 + m * 16; const int b = row >> 11, t = row & 2047, ch = t >> 5, s = t & 31;
#pragma unroll
                        for (int bj = 0; bj < 2; ++bj) { const int f = (pn - 6) * 256 + bj * 128 + cl0; const int gI = f >> 4, cc = f & 15;
                            *(u32x4*)(dst + ((size_t)(gI * 1024 + b * 64 + ch)) * UGP + s * 16 + cc) = pack8(acc[ai][bj][m][0], acc[ai][bj][m][1]); } }
            }
        } break;
        case EK_MEMK: {
            bf16_t* dst = (bf16_t*)p0; float* sq = (float*)p1;
#pragma unroll
            for (int ai = 0; ai < 2; ++ai)
#pragma unroll
                for (int m = 0; m < 4; ++m) { const size_t row = (size_t)(rbase + ai * 128 + m * 16);
                    float ss = ssq8(acc[ai][0][m][0], acc[ai][0][m][1]) + ssq8(acc[ai][1][m][0], acc[ai][1][m][1]);
                    ss = red_fq(ss);
                    if (fq == 0) sq[row * 16 + u.pn * 4 + wc] = ss;
#pragma unroll
                    for (int bj = 0; bj < 2; ++bj) *(u32x4*)(dst + row * DM + u.pn * 256 + bj * 128 + cl0) = pack8(acc[ai][bj][m][0], acc[ai][bj][m][1]); }
        } break;
        case EK_MEMVT: {
            bf16_t* dst = (bf16_t*)p0;
#pragma unroll
            for (int ai = 0; ai < 2; ++ai)
#pragma unroll
                for (int m = 0; m < 4; ++m) { const size_t row = (size_t)(rbase + ai * 128 + m * 16);
#pragma unroll
                    for (int bj = 0; bj < 2; ++bj) *(u32x4*)(dst + row * TM + u.pn * 256 + bj * 128 + cl0) = pack8(acc[ai][bj][m][0], acc[ai][bj][m][1]); }
        } break;
        case EK_S5E: {
            float* dst = (float*)p0 + (size_t)u.pn * 32768 * 128;
#pragma unroll
            for (int ai = 0; ai < 2; ++ai)
#pragma unroll
                for (int m = 0; m < 4; ++m) { const size_t row = (size_t)(rbase + ai * 128 + m * 16);
                    *(f32x4*)(dst + row * 128 + cl0) = acc[ai][0][m][0]; *(f32x4*)(dst + row * 128 + cl0 + 4) = acc[ai][0][m][1]; }
        } break;
        case EK_S5Y: {
            bf16_t* dst = (bf16_t*)p0;
#pragma unroll
            for (int ai = 0; ai < 2; ++ai)
#pragma unroll
                for (int m = 0; m < 4; ++m) { const int r = rbase + ai * 128 + m * 16; const int gI = r >> 10, b = (r >> 6) & 15, k = r & 63;
#pragma unroll
                    for (int bj = 0; bj < 2; ++bj) { const int nn = u.pn * 256 + bj * 128 + cl0; const int tt = nn >> 4, cc = nn & 15;
                        f32x4 a = acc[ai][bj][m][0], c = acc[ai][bj][m][1];
#pragma unroll
                        for (int j = 0; j < 4; ++j) { a[j] = gelu_t(a[j]); c[j] = gelu_t(c[j]); }
                        *(u32x4*)(dst + ((size_t)(b * SEQ + k * TC + tt)) * 512 + gI * 16 + cc) = pack8(a, c); } }
        } break;
        case EK_GLU: {
            bf16_t* dst = (bf16_t*)p0; float* sq = (float*)p1; const bf16_t* y1 = (const bf16_t*)c0; const float* bg = (const float*)c1;
            f32x4 bv[2][2];
#pragma unroll
            for (int bj = 0; bj < 2; ++bj)
#pragma unroll
                for (int n = 0; n < 2; ++n) bv[bj][n] = *(const f32x4*)(bg + u.pn * 256 + bj * 128 + cl0 + 4 * n);
#pragma unroll
            for (int ai = 0; ai < 2; ++ai)
#pragma unroll
                for (int m = 0; m < 4; ++m) { const size_t row = (size_t)(rbase + ai * 128 + m * 16); float ss = 0.f;
#pragma unroll
                    for (int bj = 0; bj < 2; ++bj) { const size_t off = row * 512 + u.pn * 256 + bj * 128 + cl0;
                        const u32x4 yv = *(const u32x4*)(y1 + off);
                        f32x4 a = acc[ai][bj][m][0] + bv[bj][0], c = acc[ai][bj][m][1] + bv[bj][1];
                        a[0] = bflo(yv.x) * sigm(a[0]); a[1] = bfhi(yv.x) * sigm(a[1]); a[2] = bflo(yv.y) * sigm(a[2]); a[3] = bfhi(yv.y) * sigm(a[3]);
                        c[0] = bflo(yv.z) * sigm(c[0]); c[1] = bfhi(yv.z) * sigm(c[1]); c[2] = bflo(yv.w) * sigm(c[2]); c[3] = bfhi(yv.w) * sigm(c[3]);
                        ss += ssq8(a, c);
                        *(u32x4*)(dst + off) = pack8(a, c); }
                    ss = red_fq(ss);
                    if (fq == 0) sq[row * 8 + u.pn * 4 + wc] = ss; }
        } break;
        case EK_WOUT: case EK_WXO: {
            float* out = (float*)p0; bf16_t* hb = (bf16_t*)p1; float* sq = (float*)p2; const float* base = (const float*)c0;
#pragma unroll
            for (int ai = 0; ai < 2; ++ai)
#pragma unroll
                for (int m = 0; m < 4; ++m) { const size_t row = (size_t)(rbase + ai * 128 + m * 16); float ss = 0.f;
#pragma unroll
                    for (int bj = 0; bj < 2; ++bj) { const size_t off = row * DM + u.pn * 256 + bj * 128 + cl0;
                        const float dz = (kind == EK_WXO) ? DBG_CROSS : DBG_MIX;
                        const f32x4 a = acc[ai][bj][m][0] * dz + *(const f32x4*)(base + off), c = acc[ai][bj][m][1] * dz + *(const f32x4*)(base + off + 4);
                        *(f32x4*)(out + off) = a; *(f32x4*)(out + off + 4) = c;
                        ss += ssq8(a, c);
                        *(u32x4*)(hb + off) = pack8(a, c); }
                    ss = red_fq(ss);
                    if (fq == 0) sq[row * 16 + u.pn * 4 + wc] = ss; }
        } break;
        case EK_XQ: {
            bf16_t* dst = (bf16_t*)p0; float* sq = (float*)p1; const float* gq = (const float*)c0; const float* gk = (const float*)c1;
            f32x4 gg[2][2];
#pragma unroll
            for (int bj = 0; bj < 2; ++bj)
#pragma unroll
                for (int n = 0; n < 2; ++n) gg[bj][n] = *(const f32x4*)(gq + bj * 128 + cl0 + 4 * n) * *(const f32x4*)(gk + bj * 128 + cl0 + 4 * n);
#pragma unroll
            for (int ai = 0; ai < 2; ++ai)
#pragma unroll
                for (int m = 0; m < 4; ++m) { const size_t row = (size_t)(rbase + ai * 128 + m * 16);
                    float ss = ssq8(acc[ai][0][m][0], acc[ai][0][m][1]) + ssq8(acc[ai][1][m][0], acc[ai][1][m][1]);
                    ss = red_fq(ss);
                    if (fq == 0) sq[row * 16 + u.pn * 4 + wc] = ss;
#pragma unroll
                    for (int bj = 0; bj < 2; ++bj) *(u32x4*)(dst + row * DM + u.pn * 256 + bj * 128 + cl0) = pack8(acc[ai][bj][m][0] * gg[bj][0], acc[ai][bj][m][1] * gg[bj][1]); }
        } break;
        case EK_XS: {
            bf16_t* dst = (bf16_t*)p0; float* ps = (float*)p1; const float* s1 = (const float*)c0; const float* sqq = (const float*)c1; const float* sck = (const float*)c2;
            const int h = u.pn, b = u.pm >> 3;
            f32x4 kv[2][2];
#pragma unroll
            for (int bj = 0; bj < 2; ++bj)
#pragma unroll
                for (int n = 0; n < 2; ++n) kv[bj][n] = *(const f32x4*)(sck + (size_t)h * TM + b * 256 + bj * 128 + cl0 + 4 * n) * (LOG2E / 16.f);
#pragma unroll
            for (int ai = 0; ai < 2; ++ai)
#pragma unroll
                for (int m = 0; m < 4; ++m) { const size_t row = (size_t)(rbase + ai * 128 + m * 16);
                    const f32x4 t0 = *(const f32x4*)(s1 + row * 16), t1 = *(const f32x4*)(s1 + row * 16 + 4), t2 = *(const f32x4*)(s1 + row * 16 + 8), t3 = *(const f32x4*)(s1 + row * 16 + 12);
                    const float tot = ((t0[0] + t0[1]) + (t0[2] + t0[3])) + ((t1[0] + t1[1]) + (t1[2] + t1[3])) + ((t2[0] + t2[1]) + (t2[2] + t2[3])) + ((t3[0] + t3[1]) + (t3[2] + t3[3]));
                    const float rs1 = rsqrtf(tot * (1.f / DM) + EPS);
                    const f32x4 qq = *(const f32x4*)(sqq + row * 16 + h * 4);
                    const float sq = rs1 * rsqrtf(rs1 * rs1 * ((qq[0] + qq[1]) + (qq[2] + qq[3])) * (1.f / 256.f) + EPS);
                    float ss = 0.f;
#pragma unroll
                    for (int bj = 0; bj < 2; ++bj) { f32x4 a = acc[ai][bj][m][0] * kv[bj][0] * sq, c = acc[ai][bj][m][1] * kv[bj][1] * sq;
#pragma unroll
                        for (int j = 0; j < 4; ++j) { a[j] = __builtin_amdgcn_exp2f(a[j]); c[j] = __builtin_amdgcn_exp2f(c[j]); }
                        const u32x4 w = pack8(a, c);
                        ss += (bflo(w.x) + bfhi(w.x)) + (bflo(w.y) + bfhi(w.y)) + (bflo(w.z) + bfhi(w.z)) + (bflo(w.w) + bfhi(w.w));
                        *(u32x4*)(dst + row * DM + h * 256 + bj * 128 + cl0) = w; }
                    ss = red_fq(ss);
                    if (fq == 0) ps[row * 16 + h * 4 + wc] = ss; }
        } break;
        case EK_XO: {
            bf16_t* dst = (bf16_t*)p0; const float* ps = (const float*)c0; const int h = u.pn;
#pragma unroll
            for (int ai = 0; ai < 2; ++ai)
#pragma unroll
                for (int m = 0; m < 4; ++m) { const size_t row = (size_t)(rbase + ai * 128 + m * 16);
                    const f32x4 pp = *(const f32x4*)(ps + row * 16 + h * 4); const float inv = 1.f / ((pp[0] + pp[1]) + (pp[2] + pp[3]));
#pragma unroll
                    for (int bj = 0; bj < 2; ++bj) *(u32x4*)(dst + row * DM + h * 256 + bj * 128 + cl0) = pack8(acc[ai][bj][m][0] * inv, acc[ai][bj][m][1] * inv); }
        } break;
        case EK_UP: {
            bf16_t* G = (bf16_t*)p0; bf16_t* U = (bf16_t*)p1; const float* s2 = (const float*)c0;
#pragma unroll
            for (int ai = 0; ai < 2; ++ai)
#pragma unroll
                for (int m = 0; m < 4; ++m) { const size_t row = (size_t)(rbase + ai * 128 + m * 16);
                    const f32x4 t0 = *(const f32x4*)(s2 + row * 16), t1 = *(const f32x4*)(s2 + row * 16 + 4), t2 = *(const f32x4*)(s2 + row * 16 + 8), t3 = *(const f32x4*)(s2 + row * 16 + 12);
                    const float tot = ((t0[0] + t0[1]) + (t0[2] + t0[3])) + ((t1[0] + t1[1]) + (t1[2] + t1[3])) + ((t2[0] + t2[1]) + (t2[2] + t2[3])) + ((t3[0] + t3[1]) + (t3[2] + t3[3]));
                    const float rs = rsqrtf(tot * (1.f / DM) + EPS);
                    const size_t off = row * DFF + u.pn * 128 + cl0;
                    *(u32x4*)(G + off) = pack8(acc[ai][0][m][0] * rs, acc[ai][0][m][1] * rs);
                    *(u32x4*)(U + off) = pack8(acc[ai][1][m][0] * rs, acc[ai][1][m][1] * rs); }
        } break;
        case EK_DOWN: {
            float* out = (float*)p0;
#pragma unroll
            for (int ai = 0; ai < 2; ++ai)
#pragma unroll
                for (int m = 0; m < 4; ++m) { const size_t row = (size_t)(rbase + ai * 128 + m * 16);
#pragma unroll
                    for (int bj = 0; bj < 2; ++bj) { const size_t off = row * DM + u.pn * 256 + bj * 128 + cl0;
                        const f32x4 a = acc[ai][bj][m][0] * DBG_FFN + *(const f32x4*)(out + off), c = acc[ai][bj][m][1] * DBG_FFN + *(const f32x4*)(out + off + 4);
                        *(f32x4*)(out + off) = a; *(f32x4*)(out + off + 4) = c; } }
        } break;
        case EK_GATE: {
            bf16_t* G = (bf16_t*)p0; const float* s2 = (const float*)c0;
#pragma unroll
            for (int ai = 0; ai < 2; ++ai)
#pragma unroll
                for (int m = 0; m < 4; ++m) { const size_t row = (size_t)(rbase + ai * 128 + m * 16);
                    const f32x4 t0 = *(const f32x4*)(s2 + row * 16), t1 = *(const f32x4*)(s2 + row * 16 + 4), t2 = *(const f32x4*)(s2 + row * 16 + 8), t3 = *(const f32x4*)(s2 + row * 16 + 12);
                    const float tot = ((t0[0] + t0[1]) + (t0[2] + t0[3])) + ((t1[0] + t1[1]) + (t1[2] + t1[3])) + ((t2[0] + t2[1]) + (t2[2] + t2[3])) + ((t3[0] + t3[1]) + (t3[2] + t3[3]));
                    const float rs = rsqrtf(tot * (1.f / DM) + EPS);
#pragma unroll
                    for (int bj = 0; bj < 2; ++bj) *(u32x4*)(G + row * DFF + u.pn * 256 + bj * 128 + cl0) = pack8(acc[ai][bj][m][0] * rs, acc[ai][bj][m][1] * rs); }
        } break;
        case EK_UPACT: {
            bf16_t* A = (bf16_t*)p0; const float* rs2 = (const float*)c0; const bf16_t* G = (const bf16_t*)c1; const float* cw = (const float*)c2; const float* cbv = (const float*)p1;
            u32x4 upk[2][4][2];
#pragma unroll
            for (int ai = 0; ai < 2; ++ai)
#pragma unroll
                for (int m = 0; m < 4; ++m) { const float rs = rs2[rbase + ai * 128 + m * 16];
#pragma unroll
                    for (int bj = 0; bj < 2; ++bj) upk[ai][m][bj] = pack8(acc[ai][bj][m][0] * rs, acc[ai][bj][m][1] * rs); }
            asm volatile("" ::: "memory");
#pragma unroll
            for (int bj = 0; bj < 2; ++bj) { const int j0 = u.pn * 256 + bj * 128 + cl0;
                float w0[8], w1[8], w2[8], bb[8];
#pragma unroll
                for (int i = 0; i < 2; ++i) { const f32x4 a0 = *(const f32x4*)(cw + j0 + 4 * i), a1 = *(const f32x4*)(cw + DFF + j0 + 4 * i), a2 = *(const f32x4*)(cw + 2 * DFF + j0 + 4 * i), a3 = *(const f32x4*)(cbv + j0 + 4 * i);
#pragma unroll
                    for (int q = 0; q < 4; ++q) { w0[4 * i + q] = a0[q]; w1[4 * i + q] = a1[q]; w2[4 * i + q] = a2[q]; bb[4 * i + q] = a3[q]; } }
#pragma unroll
                for (int ai = 0; ai < 2; ++ai)
#pragma unroll
                    for (int m = 0; m < 4; ++m) { const int row = rbase + ai * 128 + m * 16; const int ts = row & 2047; const size_t off = (size_t)row * DFF + j0;
                        const u32x4 g0 = *(const u32x4*)(G + off);
                        u32x4 g1 = *(const u32x4*)(G + off - (ts >= 1 ? DFF : 0));
                        u32x4 g2 = *(const u32x4*)(G + off - (ts >= 2 ? 2 * DFF : 0));
                        const unsigned k1 = ts >= 1 ? 0xffffffffu : 0u, k2 = ts >= 2 ? 0xffffffffu : 0u;
                        g1 = g1 & k1; g2 = g2 & k2;
                        const u32x4 uu = upk[ai][m][bj];
                        float r[8];
#pragma unroll
                        for (int q = 0; q < 4; ++q) { const unsigned a2 = g2[q], a1 = g1[q], a0 = g0[q], u0 = uu[q];
                            const float z0 = bb[2 * q] + w0[2 * q] * bflo(a2) + w1[2 * q] * bflo(a1) + w2[2 * q] * bflo(a0);
                            const float z1 = bb[2 * q + 1] + w0[2 * q + 1] * bfhi(a2) + w1[2 * q + 1] * bfhi(a1) + w2[2 * q + 1] * bfhi(a0);
                            r[2 * q] = z0 * sigm(z0) * bflo(u0); r[2 * q + 1] = z1 * sigm(z1) * bfhi(u0); }
                        u32x4 o; o.x = pk2(r[0], r[1]); o.y = pk2(r[2], r[3]); o.z = pk2(r[4], r[5]); o.w = pk2(r[6], r[7]);
                        *(u32x4*)(A + off) = o;
                        if ((m & 1) == 1) asm volatile("" ::: "memory"); } }
        } break;
        default: break;
        }
    }
};

namespace attn_body {
using bf16=__hip_bfloat16;
using s16x4=__attribute__((ext_vector_type(4)))short;
using f32x16=__attribute__((ext_vector_type(16)))float;
constexpr int NHEAD=NFH,D=64,ADM=NHEAD*D;
constexpr int NW=8,QBLK=32,QB=QBLK*NW,KVBLK=64,NQB=SEQ/QB;
__device__ __forceinline__ int crow(int r,int hi){return (r&3)+8*(r>>2)+4*hi;}
#define SBAR() __builtin_amdgcn_sched_barrier(0)
__device__ __forceinline__ void cmask(f32x16&p0,f32x16&p1,int jb,int qrel,int hi){
  const float NEG=-INFINITY; int kb=64*jb+4*hi;
  #pragma unroll
  for(int r=0;r<16;++r){int kv=kb+(r&3)+8*(r>>2); if(kv>qrel)p0[r]=NEG; if(kv+32>qrel)p1[r]=NEG;}
}
constexpr int NSLOT=3, SLOTB=8192;
constexpr int LDS_K=0, LDS_V=NSLOT*SLOTB, LDS_WS=2*NSLOT*SLOTB, LDS_OST=LDS_WS+NW*64*4, LDS_BYTES=LDS_OST+NW*4096;
constexpr int LDS_BIAS=86016;
__device__ __forceinline__ void glds16(const void*gsrc,unsigned lds_dst){unsigned keep;
  asm volatile("s_mov_b32 %0, m0\n\ts_mov_b32 m0, %2\n\ts_nop 0\n\tglobal_load_lds_dwordx4 %1, off\n\ts_mov_b32 m0, %0":"=&s"(keep):"v"(gsrc),"s"(lds_dst):"memory");}
__device__ __forceinline__ float max3f(float a,float b,float c){float r;asm("v_max3_f32 %0, %1, %2, %3":"=v"(r):"v"(a),"v"(b),"v"(c));return r;}
__device__ __forceinline__ float max2f(float a,float b){float r;asm("v_max_f32_e32 %0, %1, %2":"=v"(r):"v"(a),"v"(b));return r;}
__device__ __forceinline__ float fadd_s(float a,float b){float r;asm("v_add_f32_e32 %0, %1, %2":"=v"(r):"v"(a),"v"(b));return r;}
__device__ __forceinline__ float fsub_s(float a,float b){float r;asm("v_sub_f32_e32 %0, %1, %2":"=v"(r):"v"(a),"v"(b));return r;}
typedef float f32x2_t __attribute__((ext_vector_type(2))); typedef __bf16 bf16x2_t __attribute__((ext_vector_type(2)));
__device__ __forceinline__ unsigned cvtpk_s(float lo,float hi){f32x2_t v={lo,hi};bf16x2_t b=__builtin_convertvector(v,bf16x2_t);return __builtin_bit_cast(unsigned,b);}
#define WAIT_BAR(N) asm volatile("s_waitcnt vmcnt(" #N ") lgkmcnt(0)\n\ts_barrier":::"memory")

__device__ __forceinline__ void qkt(f32x16&p0,f32x16&p1,const char*Kslot,const bf16x8*qr,const f32x16&negm,int r32,int hi){
  const char*kb=Kslot+hi*1024+r32*16;
  #pragma unroll
  for(int d0=0;d0<4;++d0){
    const bf16x8 b0=*reinterpret_cast<const bf16x8*>(kb+d0*2048);
    const bf16x8 b1=*reinterpret_cast<const bf16x8*>(kb+d0*2048+512);
    if(d0==0){p0=__builtin_amdgcn_mfma_f32_32x32x16_bf16(b0,qr[0],negm,0,0,0);p1=__builtin_amdgcn_mfma_f32_32x32x16_bf16(b1,qr[0],negm,0,0,0);}
    else{p0=__builtin_amdgcn_mfma_f32_32x32x16_bf16(b0,qr[d0],p0,0,0,0);p1=__builtin_amdgcn_mfma_f32_32x32x16_bf16(b1,qr[d0],p1,0,0,0);}}
}
typedef __attribute__((address_space(3))) const char* lds_cptr;
typedef short v4i16_t __attribute__((ext_vector_type(4)));
__device__ __forceinline__ void kload8(bf16x8*kf,lds_cptr kp){
  kf[0]=*(const __attribute__((address_space(3))) bf16x8*)(kp);      kf[1]=*(const __attribute__((address_space(3))) bf16x8*)(kp+512);
  kf[2]=*(const __attribute__((address_space(3))) bf16x8*)(kp+2048); kf[3]=*(const __attribute__((address_space(3))) bf16x8*)(kp+2560);
  kf[4]=*(const __attribute__((address_space(3))) bf16x8*)(kp+4096); kf[5]=*(const __attribute__((address_space(3))) bf16x8*)(kp+4608);
  kf[6]=*(const __attribute__((address_space(3))) bf16x8*)(kp+6144); kf[7]=*(const __attribute__((address_space(3))) bf16x8*)(kp+6656);
}
__device__ __forceinline__ void kload2(bf16x8*kf,lds_cptr kp,int j){ kf[2*j]=*(const __attribute__((address_space(3))) bf16x8*)(kp+j*2048); kf[2*j+1]=*(const __attribute__((address_space(3))) bf16x8*)(kp+j*2048+512); }
__device__ __forceinline__ s16x4 vtr(lds_cptr p){ return __builtin_bit_cast(s16x4,__builtin_amdgcn_ds_read_tr16_b64_v4i16((__attribute__((address_space(3))) v4i16_t*)p)); }
__device__ __forceinline__ float rowmax(const f32x16&p0,const f32x16&p1){
  float a=max3f(p0[0],p0[1],p1[0]),b=max3f(p0[2],p0[3],p1[1]);a=max3f(a,p1[2],p1[3]);
  #pragma unroll
  for(int r=4;r<16;r+=4){a=max3f(a,p0[r],p0[r+1]);b=max3f(b,p0[r+2],p0[r+3]);a=max3f(a,p1[r],p1[r+1]);b=max3f(b,p1[r+2],p1[r+3]);}
  const float m=max2f(a,b);
  auto rr=__builtin_amdgcn_permlane32_swap(__float_as_uint(m),__float_as_uint(m),false,false);
  return max2f(__uint_as_float(rr[0]),__uint_as_float(rr[1]));
}
__device__ __forceinline__ void pv(f32x16*o,int vb,bf16x8 pa0,bf16x8 pa1,bf16x8 pa2,bf16x8 pa3){
  #pragma unroll
  for(int d0=0;d0<2;++d0){s16x4 lo[4],hi[4];
    #pragma unroll
    for(int ks=0;ks<4;++ks){
      asm volatile("ds_read_b64_tr_b16 %0,%1 offset:%c2":"=&v"(lo[ks]):"v"(vb),"i"(d0*4096+ks*1024):"memory");
      asm volatile("ds_read_b64_tr_b16 %0,%1 offset:%c2":"=&v"(hi[ks]):"v"(vb),"i"(d0*4096+ks*1024+512):"memory");}
    asm volatile("s_waitcnt lgkmcnt(0)":::"memory");SBAR();
    #define PK(k) (bf16x8){lo[k][0],lo[k][1],lo[k][2],lo[k][3],hi[k][0],hi[k][1],hi[k][2],hi[k][3]}
    o[d0]=__builtin_amdgcn_mfma_f32_32x32x16_bf16(pa0,PK(0),o[d0],0,0,0);
    o[d0]=__builtin_amdgcn_mfma_f32_32x32x16_bf16(pa1,PK(1),o[d0],0,0,0);
    o[d0]=__builtin_amdgcn_mfma_f32_32x32x16_bf16(pa2,PK(2),o[d0],0,0,0);
    o[d0]=__builtin_amdgcn_mfma_f32_32x32x16_bf16(pa3,PK(3),o[d0],0,0,0);
    #undef PK
  }
}
typedef const __attribute__((address_space(3))) f32x4* lds_f4ptr;
#define BIASADD(P0,P1,t) do{ const lds_f4ptr bp_=(lds_f4ptr)(shm3+LDS_BIAS+((t)*64+4*hi)*4); \
    _Pragma("unroll") for(int j_=0;j_<4;++j_){ const f32x4 b0_=bp_[2*j_]-mhat, b1_=bp_[8+2*j_]-mhat; \
      P0[4*j_]+=b0_[0]; P0[4*j_+1]+=b0_[1]; P0[4*j_+2]+=b0_[2]; P0[4*j_+3]+=b0_[3]; \
      P1[4*j_]+=b1_[0]; P1[4*j_+1]+=b1_[1]; P1[4*j_+2]+=b1_[2]; P1[4*j_+3]+=b1_[3]; } }while(0)

template<int THRL> __device__ __forceinline__ void attn_unit(int b,int h,int qb,const bf16*Q,const bf16*__restrict__ K,const bf16*__restrict__ V,bf16*O,const float*__restrict__ CB,float*__restrict__ SSQ,char*shm){
  int tid=threadIdx.x; asm volatile("":"+v"(tid));
  const int lane=tid&63,r32=lane&31,hi=lane>>5; const int wid=__builtin_amdgcn_readfirstlane(tid>>6);
  const long rowbase=(long)b*SEQ; const int q0=qb*QB;
  const bf16*Qw=Q+(rowbase+q0+wid*QBLK)*ADM+h*D;
  const bf16*Kh=K+rowbase*ADM+h*D,*Vh=V+rowbase*ADM+h*D;
  const unsigned lds0=(unsigned)(uintptr_t)shm;
  float*wsf=(float*)(shm+LDS_WS)+wid*64;
  const lds_cptr shm3=(lds_cptr)shm;
  { const float*cbh=CB+(long)(b*NHEAD+h)*SEQ; const float cref=cbh[q0+128];
    if(tid*4<q0+QB){ const f32x4 c4=*(const f32x4*)(cbh+tid*4); *(__attribute__((address_space(3))) f32x4*)(shm3+LDS_BIAS+tid*16)=(f32x4){cref-c4[0],cref-c4[1],cref-c4[2],cref-c4[3]}*DBG_BIAS; } }
  const bf16*ksrc=Kh+(long)lane*ADM+wid*8;
  const bf16*vsrc=Vh+(long)(16*(wid&3)+(lane>>2))*ADM+(wid>>2)*32+(lane&3)*8;
  const unsigned kdst=lds0+LDS_K+wid*1024, vdst=lds0+LDS_V+wid*1024;
  #define DMA_K(t,slot) glds16(ksrc+(long)(t)*KVBLK*ADM,(unsigned)__builtin_amdgcn_readfirstlane(kdst+(slot)))
  #define DMA_V(t,slot) glds16(vsrc+(long)(t)*KVBLK*ADM,(unsigned)__builtin_amdgcn_readfirstlane(vdst+(slot)))
  const int vb0=(int)(lds0+LDS_V)+((lane>>4)&1)*32+(lane&3)*8+(4*hi+((lane&15)>>2))*64;
  const char*Kbase=shm+LDS_K; bf16x8 kf[8];
  const lds_cptr kp0=shm3+LDS_K+hi*1024+r32*16; const lds_cptr vp0=shm3+LDS_V+((lane>>4)&1)*32+(lane&3)*8+(4*hi+((lane&15)>>2))*64;
  const int NT=(q0+QB)/KVBLK;
  DMA_K(0,0);DMA_V(0,0);DMA_K(1,SLOTB);
  bf16x8 qr[4];
  #pragma unroll
  for(int d0=0;d0<4;++d0)qr[d0]=*reinterpret_cast<const bf16x8*>(&Qw[(long)r32*ADM+d0*16+hi*8]);
  float mhat=0.f,l_reg=0.f;f32x16 o[2];o[0]=f32x16{};o[1]=f32x16{};const f32x16 negm=f32x16{};
  const int qrel=wid*QBLK+r32;
  #define CMASK(P0,P1,t) do{int jb_=(t)-(NT-4); if(jb_>=0)cmask(P0,P1,jb_,qrel,hi);}while(0)
  bool resc=false;
  #define START(P0,P1) do{ const float rm=rowmax(P0,P1); resc=false; \
    { const float dl=max2f(rm,-24.f); mhat=fadd_s(mhat,dl); \
      _Pragma("unroll") for(int r=0;r<16;++r){P0[r]=fsub_s(P0[r],dl);P1[r]=fsub_s(P1[r],dl);} } \
    _Pragma("unroll") for(int r=0;r<16;++r)P0[r]=__builtin_amdgcn_exp2f(P0[r]); }while(0)
  #define RESC() do{ if(resc){ asm volatile("s_waitcnt lgkmcnt(0)":::"memory"); \
      _Pragma("unroll") for(int d_=0;d_<2;++d_) _Pragma("unroll") for(int r=0;r<16;++r)o[d_][r]*=wsf[crow(r,hi)]; } }while(0)
  f32x16 pA0,pA1,pB0,pB1;
  int sl_prev=0,sl_cur=0,sl_next=SLOTB;
  #define ROT() do{sl_prev=sl_cur;sl_cur=sl_next;sl_next=(sl_next==(NSLOT-1)*SLOTB)?0:sl_next+SLOTB;}while(0)
  DMA_K(2,2*SLOTB);
  WAIT_BAR(3);
  qkt(pA0,pA1,Kbase,qr,negm,r32,hi);asm volatile("s_nop 15\n\ts_nop 7":"+v"(pA0),"+v"(pA1));BIASADD(pA0,pA1,0);CMASK(pA0,pA1,0);
  START(pA0,pA1);
  _Pragma("unroll") for(int r=0;r<16;++r)pA1[r]=__builtin_amdgcn_exp2f(pA1[r]);
  WAIT_BAR(0);
  DMA_K(3,0);DMA_V(1,SLOTB);
  ROT();
  kload8(kf,kp0+sl_cur);
  WAIT_BAR(2);
  s16x4 vlo[8],vhi[8]; u32x4 pw0,pw1,pw2,pw3;
  #define PKW(P,B) cvtpk_s(P[B],P[B+1])
  #define PAF(k) __builtin_bit_cast(bf16x8,pw##k)
  #define VFR(i) (bf16x8){vlo[i][0],vlo[i][1],vlo[i][2],vlo[i][3],vhi[i][0],vhi[i][1],vhi[i][2],vhi[i][3]}
  #define PIN(x) asm volatile("":"+v"(x))
  #define MX3(a,b,c) __builtin_fmaxf(__builtin_fmaxf((a),(b)),(c))
  #define GAPA(MF,A0,A1,A2,A3,W0,W1,PW) do{ MF; sacc+=A0; sacc+=A1; sacc+=A2; sacc+=A3; PIN(sacc); W0; W1; PIN(PW); SBAR(); }while(0)
  #define EX(v) __builtin_amdgcn_exp2f(v)
  #define GAPB(MF,X,B) do{ MF; X[B]=EX(X[B]); X[B+1]=EX(X[B+1]); X[B+2]=EX(X[B+2]); X[B+3]=EX(X[B+3]); PIN(X); SBAR(); }while(0)
  #define VRD(i) do{ vlo[i]=vtr(vp_+(((i)>>2)*4096+((i)&3)*1024)); vhi[i]=vtr(vp_+(((i)>>2)*4096+((i)&3)*1024+512)); }while(0)
  #define KRD(G,j) do{ if(G){ kload2(kf,kp0+sl_next,j); SBAR(); } }while(0)
  #define STEP(C0,C1,P0,P1,t,GK,GV,GL) do{ SBAR(); \
    const lds_cptr vp_=vp0+sl_prev; \
    VRD(0); SBAR(); float sacc=(P0[0]+P0[1]); \
    GAPA(C0=__builtin_amdgcn_mfma_f32_32x32x16_bf16(kf[0],qr[0],negm,0,0,0), P0[2],P0[3],P0[4],P0[5],     pw0[0]=PKW(P0,0), pw0[1]=PKW(P0,2), pw0); \
    VRD(4); SBAR(); GAPA(C1=__builtin_amdgcn_mfma_f32_32x32x16_bf16(kf[1],qr[0],negm,0,0,0), P0[6],P0[7],P0[8],P0[9],     pw0[2]=PKW(P0,4), pw0[3]=PKW(P0,6), pw0); \
    VRD(1); SBAR(); GAPA(C0=__builtin_amdgcn_mfma_f32_32x32x16_bf16(kf[2],qr[1],C0,0,0,0),   P0[10],P0[11],P0[12],P0[13], pw1[0]=PKW(P0,8), pw1[1]=PKW(P0,10), pw1); \
    VRD(5); SBAR(); GAPA(C1=__builtin_amdgcn_mfma_f32_32x32x16_bf16(kf[3],qr[1],C1,0,0,0),   P0[14],P0[15],P1[0],P1[1],   pw1[2]=PKW(P0,12),pw1[3]=PKW(P0,14), pw1); \
    VRD(2); SBAR(); GAPA(C0=__builtin_amdgcn_mfma_f32_32x32x16_bf16(kf[4],qr[2],C0,0,0,0),   P1[2],P1[3],P1[4],P1[5],     pw2[0]=PKW(P1,0), pw2[1]=PKW(P1,2), pw2); \
    VRD(6); SBAR(); GAPA(C1=__builtin_amdgcn_mfma_f32_32x32x16_bf16(kf[5],qr[2],C1,0,0,0),   P1[6],P1[7],P1[8],P1[9],     pw2[2]=PKW(P1,4), pw2[3]=PKW(P1,6), pw2); \
    VRD(3); SBAR(); GAPA(C0=__builtin_amdgcn_mfma_f32_32x32x16_bf16(kf[6],qr[3],C0,0,0,0),   P1[10],P1[11],P1[12],P1[13], pw3[0]=PKW(P1,8), pw3[1]=PKW(P1,10), pw3); \
    VRD(7); SBAR(); GAPA(C1=__builtin_amdgcn_mfma_f32_32x32x16_bf16(kf[7],qr[3],C1,0,0,0),   P1[14],P1[15],0.f,0.f,       pw3[2]=PKW(P1,12),pw3[3]=PKW(P1,14), pw3); \
    l_reg+=sacc; \
    if(GK){DMA_K((t)+3,sl_cur);} if(GV){DMA_V((t)+1,sl_next);} \
    BIASADD(C0,C1,t); \
    CMASK(C0,C1,t); \
    { float a=MX3(C0[0],C0[1],C1[0]),b=MX3(C0[2],C0[3],C1[1]); a=MX3(a,C1[2],C1[3]); \
      _Pragma("unroll") for(int r=4;r<16;r+=4){a=MX3(a,C0[r],C0[r+1]);b=MX3(b,C0[r+2],C0[r+3]);a=MX3(a,C1[r],C1[r+1]);b=MX3(b,C1[r+2],C1[r+3]);} \
      float rm=__builtin_fmaxf(a,b); { auto rr=__builtin_amdgcn_permlane32_swap(__float_as_uint(rm),__float_as_uint(rm),false,false); rm=__builtin_fmaxf(__uint_as_float(rr[0]),__uint_as_float(rr[1])); } \
      resc=false; \
      if(__builtin_expect(__any(rm>(float)THRL),0)){ const float dl=__builtin_fmaxf(rm,0.f); mhat+=dl; \
        _Pragma("unroll") for(int r=0;r<16;++r){C0[r]-=dl;C1[r]-=dl;} \
        const float f=__builtin_amdgcn_exp2f(-dl); l_reg*=f; if(hi==0)wsf[r32]=f; resc=true; } } \
    SBAR(); \
    GAPB(o[0]=__builtin_amdgcn_mfma_f32_32x32x16_bf16(PAF(0),VFR(0),o[0],0,0,0), C0,0); \
    GAPB(o[1]=__builtin_amdgcn_mfma_f32_32x32x16_bf16(PAF(0),VFR(4),o[1],0,0,0), C0,4); \
    KRD(GL,0); GAPB(o[0]=__builtin_amdgcn_mfma_f32_32x32x16_bf16(PAF(1),VFR(1),o[0],0,0,0), C0,8); \
    KRD(GL,1); GAPB(o[1]=__builtin_amdgcn_mfma_f32_32x32x16_bf16(PAF(1),VFR(5),o[1],0,0,0), C0,12); \
    KRD(GL,2); GAPB(o[0]=__builtin_amdgcn_mfma_f32_32x32x16_bf16(PAF(2),VFR(2),o[0],0,0,0), C1,0); \
    KRD(GL,3); GAPB(o[1]=__builtin_amdgcn_mfma_f32_32x32x16_bf16(PAF(2),VFR(6),o[1],0,0,0), C1,4); \
    GAPB(o[0]=__builtin_amdgcn_mfma_f32_32x32x16_bf16(PAF(3),VFR(3),o[0],0,0,0), C1,8); \
    GAPB(o[1]=__builtin_amdgcn_mfma_f32_32x32x16_bf16(PAF(3),VFR(7),o[1],0,0,0), C1,12); \
    }while(0)
  int t=1;
  #undef CMASK
  #define CMASK(P0,P1,t) do{}while(0)
  for(;t+5<NT;t+=2){
    STEP(pB0,pB1,pA0,pA1,t,true,true,true);     WAIT_BAR(2); RESC(); ROT();
    STEP(pA0,pA1,pB0,pB1,t+1,true,true,true);   WAIT_BAR(2); RESC(); ROT();
  }
  #undef CMASK
  #define CMASK(P0,P1,t) do{int jb_=(t)-(NT-4); if(jb_>=0)cmask(P0,P1,jb_,qrel,hi);}while(0)
  #define ENDW(tt) do{ if((tt)+3<NT){WAIT_BAR(2);} else if((tt)+2<NT){WAIT_BAR(1);} else {WAIT_BAR(0);} }while(0)
  for(;t+1<NT;t+=2){
    STEP(pB0,pB1,pA0,pA1,t,(t+3<NT),(t+1<NT),(t+1<NT));       ENDW(t);   RESC(); ROT();
    STEP(pA0,pA1,pB0,pB1,t+1,(t+4<NT),(t+2<NT),(t+2<NT));     ENDW(t+1); RESC(); ROT();
  }
  STEP(pB0,pB1,pA0,pA1,NT-1,false,false,false); RESC();
  { float sacc=pB0[0]+pB0[1]; _Pragma("unroll") for(int r=2;r<16;++r)sacc+=pB0[r]; _Pragma("unroll") for(int r=0;r<16;++r)sacc+=pB1[r]; l_reg+=sacc;
    pw0=(u32x4){PKW(pB0,0),PKW(pB0,2),PKW(pB0,4),PKW(pB0,6)};pw1=(u32x4){PKW(pB0,8),PKW(pB0,10),PKW(pB0,12),PKW(pB0,14)};pw2=(u32x4){PKW(pB1,0),PKW(pB1,2),PKW(pB1,4),PKW(pB1,6)};pw3=(u32x4){PKW(pB1,8),PKW(pB1,10),PKW(pB1,12),PKW(pB1,14)};
    SBAR(); pv(o,vb0+sl_cur,PAF(0),PAF(1),PAF(2),PAF(3)); }
  #undef PKW
  #undef PAF
  #undef VFR
  #undef PIN
  #undef MX3
  #undef GAPA
  #undef GAPB
  #undef EX
  #undef VRD
  #undef KRD
  #undef STEP
  #undef ENDW
  {auto rr=__builtin_amdgcn_permlane32_swap(__float_as_uint(l_reg),__float_as_uint(l_reg),false,false);l_reg=__uint_as_float(rr[0])+__uint_as_float(rr[1]);}
  if(hi==0)wsf[32+r32]=l_reg;asm volatile("s_waitcnt lgkmcnt(0)":::"memory");
  float rli[16];
  #pragma unroll
  for(int r=0;r<16;++r)rli[r]=__builtin_amdgcn_rcpf(wsf[32+crow(r,hi)]);
  int lane2=lane; asm volatile("":"+v"(lane2));
  bf16*Ow=O+(rowbase+q0+wid*QBLK)*ADM+h*D;
  { bf16*stg=(bf16*)(shm+LDS_OST)+wid*2048;
    #pragma unroll
    for(int r=0;r<16;++r){const int orow=crow(r,hi);
      #pragma unroll
      for(int d0=0;d0<2;++d0)stg[orow*64+d0*32+r32]=__float2bfloat16(o[d0][r]*rli[r]);}
    asm volatile("s_waitcnt lgkmcnt(0)":::"memory");
    #pragma unroll
    for(int i=0;i<4;++i){const int row=i*8+(lane2>>3),ch=lane2&7; const u32x4 v=*(const u32x4*)(stg+row*64+ch*8); *(u32x4*)(Ow+(long)row*ADM+ch*8)=v;
      float s=(bflo(v.x)*bflo(v.x)+bfhi(v.x)*bfhi(v.x))+(bflo(v.y)*bflo(v.y)+bfhi(v.y)*bfhi(v.y))+(bflo(v.z)*bflo(v.z)+bfhi(v.z)*bfhi(v.z))+(bflo(v.w)*bflo(v.w)+bfhi(v.w)*bfhi(v.w));
      s+=__shfl_xor(s,1); s+=__shfl_xor(s,2); s+=__shfl_xor(s,4);
      if(ch==0)SSQ[(rowbase+q0+wid*QBLK+row)*NHEAD+h]=s; } }
  asm volatile("s_waitcnt lgkmcnt(0)\n\ts_barrier":::"memory");
  #undef DMA_K
  #undef DMA_V
  #undef CMASK
  #undef START
  #undef RESC
  #undef ROT
}
#undef SBAR
#undef WAIT_BAR
}

constexpr int RING_BYTES = 131072;
constexpr int LDS_TOTAL = 147456;
struct Args { const float* in[32]; float* out; unsigned char* ws; };
typedef const float* const __attribute__((address_space(4)))* InTab;
enum In { I_X = 0, I_MEM, I_NORM_MIX, I_W_IN, I_FQN, I_FKN, I_FBIAS, I_ARE, I_AIM, I_LOGDT, I_BRE, I_BIM, I_CRE, I_CIM, I_D, I_WGLU, I_BGLU, I_ONF, I_ONS, I_WOUT,
          I_NCROSS, I_NMEM, I_WXQ, I_WXKV, I_XQN, I_XKN, I_WXO, I_NFFN, I_WUP, I_CONVW, I_CONVB, I_WDN };

struct TJob { const float* W; int ldw, col0, ncols, K; const float* kg; const float* kg2; bf16_t* WT; int mapid, rowoff, items; };
__device__ __forceinline__ int tmap(int mapid, int n, int rowoff) {
    if (mapid == 1) { const int part = n >> 9, f = n & 511, head = f >> 6, d = f & 63; return 512 * part + 256 * (head >> 2) + 128 * (d >> 5) + 32 * (head & 3) + (d & 31); }
    if (mapid == 2) { const int isup = n >= DFF ? 1 : 0; const int j = n - isup * DFF; return 256 * (j >> 7) + 128 * isup + (j & 127); }
    return rowoff + n;
}
__device__ __forceinline__ void transpose_item(const TJob& J, LAS float* scr, int item, int lane) {
    const int nblk = J.ncols / 32, kb = item / nblk, nb = item % nblk, k0 = 64 * kb, n0 = 32 * nb;
#pragma unroll 8
    for (int i = 0; i < 32; ++i) { const int kk = 2 * i + (lane >> 5); float w = J.W[(size_t)(k0 + kk) * J.ldw + J.col0 + n0 + (lane & 31)];
        if (J.kg) { const int k = k0 + kk; w *= (J.kg2 && k >= 512) ? J.kg2[k - 512] : J.kg[k]; }
        scr[kk * 33 + (lane & 31)] = w; }
    asm volatile("s_waitcnt lgkmcnt(0)" ::: "memory");
    const int c = lane & 7;
#pragma unroll
    for (int j = 0; j < 4; ++j) { const int n = (lane >> 3) + 8 * j; const LAS float* s = scr + (8 * c) * 33 + n;
        u32x4 o; o.x = pk2(s[0 * 33], s[1 * 33]); o.y = pk2(s[2 * 33], s[3 * 33]); o.z = pk2(s[4 * 33], s[5 * 33]); o.w = pk2(s[6 * 33], s[7 * 33]);
        *(u32x4*)(J.WT + (size_t)tmap(J.mapid, n0 + n, J.rowoff) * J.K + k0 + 8 * c) = o; }
    asm volatile("s_waitcnt lgkmcnt(0)" ::: "memory");
}
constexpr int NTJ = 11;
__device__ __forceinline__ void get_tjob(InTab in, unsigned char* ws, int j, TJob& J) {
    J.kg = nullptr; J.kg2 = nullptr; J.mapid = 0; J.rowoff = 0; J.col0 = 0;
    switch (j) {
    case 0: J.W = in[I_W_IN]; J.ldw = INCOLS; J.col0 = 0; J.ncols = 1024; J.K = 1024; J.WT = (bf16_t*)(ws + WS_WIN); J.mapid = 1; break;
    case 1: J.W = in[I_W_IN]; J.ldw = INCOLS; J.col0 = 1024; J.ncols = 512; J.K = 1024; J.WT = (bf16_t*)(ws + WS_WIN); J.rowoff = 1024; break;
    case 2: J.W = in[I_W_IN]; J.ldw = INCOLS; J.col0 = 1544; J.ncols = 512; J.K = 1024; J.WT = (bf16_t*)(ws + WS_WIN); J.rowoff = 1536; break;
    case 3: J.W = in[I_WGLU]; J.ldw = 512; J.ncols = 512; J.K = 512; J.WT = (bf16_t*)(ws + WS_WGLU); break;
    case 4: J.W = in[I_WOUT]; J.ldw = 1024; J.ncols = 1024; J.K = 1024; J.WT = (bf16_t*)(ws + WS_WOUT); J.kg = in[I_ONF]; J.kg2 = in[I_ONS]; break;
    case 5: J.W = in[I_WXQ]; J.ldw = 1024; J.ncols = 1024; J.K = 1024; J.WT = (bf16_t*)(ws + WS_WXQ); J.kg = in[I_NCROSS]; break;
    case 6: J.W = in[I_WXKV]; J.ldw = 2048; J.col0 = 0; J.ncols = 1024; J.K = 1024; J.WT = (bf16_t*)(ws + WS_WXK); break;
    case 7: J.W = in[I_WXKV]; J.ldw = 2048; J.col0 = 1024; J.ncols = 1024; J.K = 1024; J.WT = (bf16_t*)(ws + WS_WXV); break;
    case 8: J.W = in[I_WXO]; J.ldw = 1024; J.ncols = 1024; J.K = 1024; J.WT = (bf16_t*)(ws + WS_WXO); break;
    case 9: J.W = in[I_WUP]; J.ldw = 2 * DFF; J.ncols = 2 * DFF; J.K = 1024; J.WT = (bf16_t*)(ws + WS_WUP); J.kg = in[I_NFFN]; break;
    default: J.W = in[I_WDN]; J.ldw = 1024; J.ncols = 1024; J.K = DFF; J.WT = (bf16_t*)(ws + WS_WDN); break;
    }
    J.items = (J.K / 64) * (J.ncols / 32);
}

__device__ __forceinline__ void rms_row(const float* xrow, const float* gain, bf16_t* orow, int lane, f32x4 (&v)[4]) {
    const f32x4* xr = (const f32x4*)xrow + lane; float s = 0.f;
#pragma unroll
    for (int j = 0; j < 4; ++j) { v[j] = xr[64 * j]; s += (v[j][0] * v[j][0] + v[j][1] * v[j][1]) + (v[j][2] * v[j][2] + v[j][3] * v[j][3]); }
    const float rs = rsqrtf(wave_sum(s) * (1.f / DM) + EPS);
    u32x2* o8 = (u32x2*)orow + lane;
#pragma unroll
    for (int j = 0; j < 4; ++j) { v[j] = v[j] * rs * ((const f32x4*)gain)[64 * j + lane]; u32x2 w; w.x = pk2(v[j][0], v[j][1]); w.y = pk2(v[j][2], v[j][3]); o8[64 * j] = w; }
}

__device__ __forceinline__ void cpow(float ar, float ai, float dt, float e, float& r, float& i) {
    const float mag = __expf(ar * dt * e);
    float rev = ai * dt * e * 0.15915494309189535f; rev -= rintf(rev);
    const float ang = rev * 6.283185307179586f;
    r = mag * cosf(ang); i = mag * sinf(ang);
}

__device__ __forceinline__ void s5_prep_task(InTab in, unsigned char* ws, int g, int tt, LAS float* L, int tid) {
    LAS float* pwA = L; LAS float* pwB = L + 128; LAS float* pwC = L + 256; LAS float* cf = L + 384; LAS float* bb = L + 512; LAS float* cc = L + 512 + 2048;
    const float dt = __expf(in[I_LOGDT][g]);
    if (tid < 64) { const int p = tid; const float ar = in[I_ARE][g * 64 + p], ai = in[I_AIM][g * 64 + p];
        float r, i; cpow(ar, ai, dt, (float)tt, r, i); pwA[2 * p] = r; pwA[2 * p + 1] = i;
        cpow(ar, ai, dt, (float)(tt + 1), r, i); pwB[2 * p] = r; pwB[2 * p + 1] = i;
        cpow(ar, ai, dt, (float)(TC - 1 - tt), r, i); pwC[2 * p] = r; pwC[2 * p + 1] = i;
        float lr, li; cpow(ar, ai, dt, 1.f, lr, li);
        const float den = ar * ar + ai * ai, nr = lr - 1.f;
        cf[2 * p] = (nr * ar + li * ai) / den; cf[2 * p + 1] = (li * ar - nr * ai) / den;
        if (tt == 0) { cpow(ar, ai, dt, (float)TC, r, i); float* lb = (float*)(ws + WS_LB32); lb[(g * 64 + p) * 2] = r; lb[(g * 64 + p) * 2 + 1] = i; } }
    for (int idx = tid; idx < 1024; idx += 512) { cc[2 * idx] = in[I_CRE][g * 1024 + idx]; cc[2 * idx + 1] = in[I_CIM][g * 1024 + idx]; }
    __syncthreads();
    for (int idx = tid; idx < 1024; idx += 512) { const int p = idx >> 4; const float br = in[I_BRE][g * 1024 + idx], bi = in[I_BIM][g * 1024 + idx], cr = cf[2 * p], ci = cf[2 * p + 1];
        bb[2 * idx] = cr * br - ci * bi; bb[2 * idx + 1] = cr * bi + ci * br; }
    __syncthreads();
    if (tid < 256) {
        const int c = tid >> 4, cp = tid & 15; float s = 0.f;
        for (int p = 0; p < 64; ++p) { const float pr = pwA[2 * p], pi = pwA[2 * p + 1], br = bb[2 * (p * 16 + cp)], bi = bb[2 * (p * 16 + cp) + 1];
            const float mr = pr * br - pi * bi, mi = pr * bi + pi * br; s += cc[2 * (c * 64 + p)] * mr - cc[2 * (c * 64 + p) + 1] * mi; }
        s *= DBG_SSM;
        if (tt == 0 && c == cp) s += in[I_D][g * 16 + c];
        ((float*)(ws + WS_KTAB))[((g * TC + tt) * 16 + c) * 16 + cp] = s;
    } else {
        const int u = tid - 256;
        bf16_t* bty = (bf16_t*)(ws + WS_BTY) + (size_t)g * 512 * UGP; bf16_t* bte = (bf16_t*)(ws + WS_BTE) + (size_t)g * 256 * 512;
        for (int idx = u; idx < 1024; idx += 256) { const int c = idx >> 6, p = idx & 63;
            const float cr = cc[2 * idx], ci = cc[2 * idx + 1], pr = pwB[2 * p], pi = pwB[2 * p + 1];
            const float zr = cr * pr - ci * pi, zi = cr * pi + ci * pr;
            *(unsigned*)(bty + (size_t)(tt * 16 + c) * UGP + 512 + 2 * p) = pk2(zr * DBG_SSM, -zi * DBG_SSM); }
        for (int idx = u; idx < 1024; idx += 256) { const int p = idx >> 4, cp = idx & 15;
            const float pr = pwC[2 * p], pi = pwC[2 * p + 1], br = bb[2 * idx], bi = bb[2 * idx + 1];
            bte[(size_t)(2 * p) * 512 + tt * 16 + cp] = (bf16_t)f2bf(pr * br - pi * bi); bte[(size_t)(2 * p + 1) * 512 + tt * 16 + cp] = (bf16_t)f2bf(pr * bi + pi * br); }
        *(u32x4*)(bte + (size_t)(128 + (u >> 1)) * 512 + tt * 16 + (u & 1) * 8) = (u32x4){0u, 0u, 0u, 0u};
    }
    __syncthreads();
}

#define RLX_AGENT __ATOMIC_RELAXED, __HIP_MEMORY_SCOPE_AGENT
#define XB_TMO      128
#define XB_XCNT(j)  (256  + 64 * (j))
#define XB_XSUB(j)  (1280 + 64 * (j))
#define XB_XGEN(j)  (2304 + 64 * (j))
#define XB_TOP      3328
#define XB_TOPGEN   3392
#define XCD_BAR_WORDS 3456
#define XB_SPIN_CAP (1u << 18)

__device__ __forceinline__ unsigned xb_ld(unsigned* p)              { return __hip_atomic_load(p, __ATOMIC_RELAXED, __HIP_MEMORY_SCOPE_AGENT); }
__device__ __forceinline__ unsigned xb_add(unsigned* p, unsigned v) { return __hip_atomic_fetch_add(p, v, __ATOMIC_RELAXED, __HIP_MEMORY_SCOPE_AGENT); }
__device__ __forceinline__ unsigned xb_xcc_id() { return (unsigned)__builtin_amdgcn_s_getreg((3 << 11) | 20) & 0xFu; }
#define XB_SPIN(cond, bar) do { unsigned _sp = 0; while (cond) { __builtin_amdgcn_s_sleep(1); \
    if ((++_sp & 255u) == 0u) { if (xb_ld(&(bar)[XB_TMO])) break; if (_sp > XB_SPIN_CAP) { atomicAdd(&(bar)[XB_TMO], 1u); break; } } } } while (0)

struct XcdBarrier {
    unsigned* bar; unsigned x;
    volatile LAS unsigned* st;
};

__device__ __forceinline__ XcdBarrier xcd_barrier_post(unsigned* bar, volatile LAS unsigned* st) {
    XcdBarrier b; b.bar = bar; b.x = xb_xcc_id(); b.st = st;
    if (threadIdx.x == 0) (void)xb_add(&bar[XB_XCNT(b.x)], 1u);
    return b;
}
__device__ __forceinline__ void xcd_barrier_complete(unsigned* bar, unsigned x, unsigned& nloc, unsigned& nx) {
    const unsigned G = gridDim.x * gridDim.y * gridDim.z;
    unsigned sum, cnt, mine, sp = 0u;
    for (;;) {
        sum = 0u; cnt = 0u; mine = 0u;
#pragma unroll
        for (unsigned j = 0; j < 16; ++j) { const unsigned c = xb_ld(&bar[XB_XCNT(j)]); sum += c; cnt += (c > 0u) ? 1u : 0u; mine = (j == x) ? c : mine; }
        if (sum == G) break;
        __builtin_amdgcn_s_sleep(1);
        if ((++sp & 255u) == 0u) { if (xb_ld(&bar[XB_TMO])) break; if (sp > XB_SPIN_CAP) { atomicAdd(&bar[XB_TMO], 1u); break; } }
    }
    nloc = mine > 0u ? mine : 1u; nx = cnt > 0u ? cnt : 1u;
}

__device__ __forceinline__ void xcd_barrier(const XcdBarrier& b) {
    asm volatile("s_waitcnt vmcnt(0)" ::: "memory");
    __syncthreads();
    if (threadIdx.x == 0) {
        unsigned* bar = b.bar;
        __builtin_amdgcn_s_waitcnt(0);
        unsigned nloc = b.st[0], nx = b.st[1];
        if (nloc == 0u) { xcd_barrier_complete(bar, b.x, nloc, nx); b.st[0] = nloc; b.st[1] = nx; }
        const unsigned old = xb_add(&bar[XB_XSUB(b.x)], 1u);
        const unsigned gen = old / nloc;
        if (old + 1u == (gen + 1u) * nloc) {
            __builtin_amdgcn_fence(__ATOMIC_RELEASE, "agent");
            asm volatile("s_waitcnt vmcnt(0)" ::: "memory");
            const unsigned og = xb_add(&bar[XB_TOP], 1u);
            const unsigned tg = og / nx;
            if (og + 1u == (tg + 1u) * nx) xb_add(&bar[XB_TOPGEN], 1u);
            else XB_SPIN(xb_ld(&bar[XB_TOPGEN]) == tg, bar);
            __builtin_amdgcn_fence(__ATOMIC_ACQUIRE, "agent");
            xb_add(&bar[XB_XGEN(b.x)], 1u);
            asm volatile("s_waitcnt vmcnt(0)" ::: "memory");
        } else {
            XB_SPIN(xb_ld(&bar[XB_XGEN(b.x)]) == gen, bar);
            __builtin_amdgcn_fence(__ATOMIC_ACQUIRE, "agent");
            asm volatile("s_waitcnt vmcnt(0)" ::: "memory");
        }
    }
    __syncthreads();
}


#ifndef FIRST_STEP
#define FIRST_STEP 0
#endif
#ifndef LAST_STEP
#define LAST_STEP 18
#endif
#define ON(n) (FIRST_STEP <= (n) && (n) <= LAST_STEP)
#define SYNC(n) do { if ((n) < LAST_STEP) { XcdBarrier bar_; bar_.bar = (unsigned*)ws; bar_.x = xb_xcc_id(); bar_.st = (volatile LAS unsigned*)(L + RING_BYTES + 352); xcd_barrier(bar_); } } while (0)
#define WSB(off) ((const bf16_t*)(ws + (off)))
__global__ void __launch_bounds__(512, 2) fox_s5_mega(Args a) {
    extern __shared__ __attribute__((aligned(16))) unsigned char lds[];
    LAS unsigned char* L = (LAS unsigned char*)lds;
    const int G = gridDim.x, bx = blockIdx.x, NGW = G * 8, NGT = G * 512;
#define KA const __attribute__((address_space(4))) unsigned char* ka_ = (const __attribute__((address_space(4))) unsigned char*)__builtin_amdgcn_kernarg_segment_ptr(); asm volatile("" : "+s"(ka_)); \
    InTab in = (InTab)ka_; float* out = *(float* const __attribute__((address_space(4)))*)(ka_ + 256); unsigned char* ws = *(unsigned char* const __attribute__((address_space(4)))*)(ka_ + 264); (void)in; (void)out;
#define IDS int tid = threadIdx.x; asm volatile("" : "+v"(tid)); const int lane = tid & 63, wave = __builtin_amdgcn_readfirstlane(tid >> 6); const int gw = bx * 8 + wave, gt = bx * 512 + tid; (void)lane; (void)gw; (void)gt;
    {
        KA
        if (threadIdx.x < 8) ((volatile LAS unsigned*)(L + RING_BYTES + 320))[threadIdx.x + 8 - 8] = 0u;
        if (threadIdx.x < 2) ((volatile LAS unsigned*)(L + RING_BYTES + 352))[threadIdx.x] = 0u;
        __syncthreads();
        (void)xcd_barrier_post((unsigned*)ws, (volatile LAS unsigned*)(L + RING_BYTES + 352));
    }

    if (ON(0)) {
        KA
        IDS
        LAS float* scr = (LAS float*)(L + wave * 16384);
        { int base = 0;
          for (int j = 0; j < NTJ; ++j) { TJob J; get_tjob(in, ws, j, J);
              int first = gw - (base % NGW); if (first < 0) first += NGW;
              for (int it = first; it < J.items; it += NGW) transpose_item(J, scr, it, lane);
              base += J.items; } }
        __syncthreads();
        LAS float* wf = (LAS float*)L;
        for (int idx = tid; idx < 8192; idx += 512) wf[idx] = in[I_W_IN][(size_t)(idx >> 3) * INCOLS + 1536 + (idx & 7)];
        __syncthreads();
        for (int m = gw; m < T; m += NGW) {
            f32x4 v[4]; rms_row(in[I_X] + (size_t)m * DM, in[I_NORM_MIX], (bf16_t*)(ws + WS_HN) + (size_t)m * DM, lane, v);
            float d[8];
#pragma unroll
            for (int h = 0; h < 8; ++h) d[h] = 0.f;
#pragma unroll
            for (int j = 0; j < 4; ++j)
#pragma unroll
                for (int i = 0; i < 4; ++i) { const int k = 256 * j + 4 * lane + i; const f32x4 w0 = *(const LAS f32x4*)(wf + k * 8), w1 = *(const LAS f32x4*)(wf + k * 8 + 4);
                    d[0] += v[j][i] * w0[0]; d[1] += v[j][i] * w0[1]; d[2] += v[j][i] * w0[2]; d[3] += v[j][i] * w0[3];
                    d[4] += v[j][i] * w1[0]; d[5] += v[j][i] * w1[1]; d[6] += v[j][i] * w1[2]; d[7] += v[j][i] * w1[3]; }
#pragma unroll
            for (int h = 0; h < 8; ++h) d[h] = wave_sum(d[h]);
            if (lane < 8) { float z = 0.f;
#pragma unroll
                for (int h = 0; h < 8; ++h) z = (lane == h) ? d[h] : z;
                z += in[I_FBIAS][lane];
                const float ls = fminf(z, 0.f) - __logf(1.f + __expf(-fabsf(z)));
                const int b = m >> 11, t = m & 2047;
                ((float*)(ws + WS_LOGF))[(size_t)(b * 8 + lane) * SEQ + t] = ls; }
        }
        for (int m = gw; m < TM; m += NGW) { f32x4 v[4]; rms_row(in[I_MEM] + (size_t)m * DM, in[I_NMEM], (bf16_t*)(ws + WS_MN) + (size_t)m * DM, lane, v); }
        __syncthreads();
        for (int task = bx; task < S5G * TC; task += G) s5_prep_task(in, ws, task / TC, task % TC, (LAS float*)L, tid);
        SYNC(0);
    }
    if (ON(1)) {
        KA
        IDS
        const float* kt = (const float*)(ws + WS_KTAB); bf16_t* bty = (bf16_t*)(ws + WS_BTY);
        for (int idx = gt; idx < S5G * 512 * 64; idx += NGT) {
            const int half = idx & 1, ss = (idx >> 1) & 31, nn = (idx >> 6) & 511, gI = idx >> 15; const int tt = nn >> 4, c = nn & 15;
            u32x4 w = (u32x4){0u, 0u, 0u, 0u};
            if (ss <= tt) { const float* src = kt + ((size_t)((gI * TC + (tt - ss)) * 16 + c)) * 16 + half * 8; const f32x4 k0 = *(const f32x4*)src, k1 = *(const f32x4*)(src + 4);
                w.x = pk2(k0[0], k0[1]); w.y = pk2(k0[2], k0[3]); w.z = pk2(k1[0], k1[1]); w.w = pk2(k1[2], k1[3]); }
            *(u32x4*)(bty + ((size_t)gI * 512 + nn) * UGP + ss * 16 + half * 8) = w; }
        if (wave == 0 && bx < BATCH * NFH) {
            const float* lf = (const float*)(ws + WS_LOGF) + (size_t)bx * SEQ + lane * 32; float* cb = (float*)(ws + WS_CB) + (size_t)bx * SEQ + lane * 32;
            f32x4 x[8]; float run = 0.f;
#pragma unroll
            for (int j = 0; j < 8; ++j) { x[j] = ((const f32x4*)lf)[j]; x[j][0] += run; x[j][1] += x[j][0]; x[j][2] += x[j][1]; x[j][3] += x[j][2]; run = x[j][3]; }
            float incl = run;
#pragma unroll
            for (int o = 1; o < 64; o <<= 1) { const float y = __shfl_up(incl, o); if (lane >= o) incl += y; }
            const float excl = incl - run;
#pragma unroll
            for (int j = 0; j < 8; ++j) ((f32x4*)cb)[j] = (x[j] + excl) * LOG2E;
        }
    }
    if (ON(2)) {
        KA
        pg8::Gemm g{WSB(WS_HN), WSB(WS_WIN), DM, DM, DM}; GOrder<OK_PLAIN> S; S.init(T / 256, 8, G, bx, DM, DM);
        Epi<EK_PROJ> E{ws + WS_Q, ws + WS_K, ws + WS_V, ws + WS_UG, in[I_FQN], in[I_FKN], nullptr};
        pg8::gemm_phase(L, g, S, E);
    }
    if (ON(3)) {
        KA
        pg8::Gemm g{WSB(WS_MN), WSB(WS_WXK), DM, DM, DM}; GOrder<OK_PLAIN> S; S.init(TM / 256, 4, G, bx, DM, DM);
        Epi<EK_MEMK> E{ws + WS_KST, ws + WS_SSQK, nullptr, nullptr, nullptr, nullptr, nullptr};
        pg8::gemm_phase(L, g, S, E);
    }
    if (ON(4)) {
        KA
        pg8::Gemm g{WSB(WS_WXV), WSB(WS_MN), DM, DM, DM}; GOrder<OK_PLAIN> S; S.init(4, TM / 256, G, (bx + 128) % G, DM, DM);
        Epi<EK_MEMVT> E{ws + WS_VT, nullptr, nullptr, nullptr, nullptr, nullptr, nullptr};
        pg8::gemm_phase(L, g, S, E);
        SYNC(4);
    }
    if (ON(5)) {
        KA
#if DBG_SLOWQKV
        {
            IDS
            LAS float* hrow = (LAS float*)(L + wave * 4096);
            bf16_t* Qp = (bf16_t*)(ws + WS_Q); bf16_t* Kp = (bf16_t*)(ws + WS_K); bf16_t* Vp = (bf16_t*)(ws + WS_V);
            const float* W = in[I_W_IN];
            for (int m = gw; m < T; m += NGW) {
                const f32x4* xr = (const f32x4*)(in[I_X] + (size_t)m * DM) + lane; f32x4 v[4]; float s = 0.f;
#pragma unroll
                for (int j = 0; j < 4; ++j) { v[j] = xr[64 * j]; s += (v[j][0] * v[j][0] + v[j][1] * v[j][1]) + (v[j][2] * v[j][2] + v[j][3] * v[j][3]); }
                const float rs = rsqrtf(wave_sum(s) * (1.f / DM) + EPS);
#pragma unroll
                for (int j = 0; j < 4; ++j) { const f32x4 g4 = ((const f32x4*)in[I_NORM_MIX])[64 * j + lane]; *(LAS f32x4*)(hrow + (64 * j + lane) * 4) = v[j] * rs * g4; }
                asm volatile("s_waitcnt lgkmcnt(0)" ::: "memory");
                for (int ch = 0; ch < 24; ++ch) {
                    float acc = 0.f; const float* wc_ = W + ch * 64 + lane;
                    for (int k = 0; k < DM; ++k) acc += hrow[k] * wc_[(size_t)k * INCOLS];
                    const int part = ch >> 3, head = ch & 7;
                    if (part < 2) { const float ss = wave_sum(acc * acc); const float g = (part == 0 ? in[I_FQN] : in[I_FKN])[lane];
                        acc = acc * rsqrtf(ss * (1.f / 64.f) + EPS) * g * (part == 0 ? C2Q : 1.f); }
                    bf16_t* dst = part == 0 ? Qp : (part == 1 ? Kp : Vp);
                    const float fast = __builtin_bit_cast(float, (unsigned)dst[(size_t)m * 512 + head * 64 + lane] << 16);
                    const int bad = !(fabsf(fast - acc) <= 0.03f * fabsf(acc) + 0.02f * (part == 0 ? C2Q : 1.f));
                    if (__any(bad) && lane == 0) atomicAdd((unsigned*)ws + 4 + part, 1u);
                }
                asm volatile("s_waitcnt lgkmcnt(0)" ::: "memory");
            }
            if (0 && gt < BATCH * NFH) {
                const float* lf = (const float*)(ws + WS_LOGF) + (size_t)gt * SEQ; float* cbp = (float*)(ws + WS_CB) + (size_t)gt * SEQ; float run = 0.f;
                for (int t = 0; t < SEQ; ++t) { run += lf[t]; cbp[t] = run * LOG2E; }
            }
            SYNC(0);
        }
#endif
#if DBG_SLOWATTN
        {
            IDS
            const bf16_t* Qp = WSB(WS_Q); const bf16_t* Kp = WSB(WS_K); const bf16_t* Vp = WSB(WS_V); bf16_t* Op = (bf16_t*)(ws + WS_FOX);
            const float* CBp = (const float*)(ws + WS_CB); float* SQ = (float*)(ws + WS_SSQF);
            for (int item = gw; item < BATCH * NFH * SEQ; item += NGW) {
                const int t = item & 2047, bh = item >> 11, b = bh >> 3, h = bh & 7;
                const size_t rowq = (size_t)(b * SEQ + t);
                float qv[64];
#pragma unroll
                for (int c8 = 0; c8 < 8; ++c8) { const u32x4 w = *(const u32x4*)(Qp + rowq * 512 + h * 64 + c8 * 8);
                    qv[c8 * 8 + 0] = bflo(w.x); qv[c8 * 8 + 1] = bfhi(w.x); qv[c8 * 8 + 2] = bflo(w.y); qv[c8 * 8 + 3] = bfhi(w.y);
                    qv[c8 * 8 + 4] = bflo(w.z); qv[c8 * 8 + 5] = bfhi(w.z); qv[c8 * 8 + 6] = bflo(w.w); qv[c8 * 8 + 7] = bfhi(w.w); }
                const float* cbh = CBp + (size_t)bh * SEQ; const float ct = cbh[t];
                float mx = -INFINITY, lsum = 0.f, o = 0.f;
                for (int s0 = 0; s0 <= t; s0 += 64) {
                    const int s = s0 + lane; float sc = -INFINITY;
                    if (s <= t) { const size_t rowk = (size_t)(b * SEQ + s); float dsum = 0.f;
#pragma unroll
                        for (int c8 = 0; c8 < 8; ++c8) { const u32x4 w = *(const u32x4*)(Kp + rowk * 512 + h * 64 + c8 * 8);
                            dsum += qv[c8 * 8 + 0] * bflo(w.x) + qv[c8 * 8 + 1] * bfhi(w.x) + qv[c8 * 8 + 2] * bflo(w.y) + qv[c8 * 8 + 3] * bfhi(w.y)
                                  + qv[c8 * 8 + 4] * bflo(w.z) + qv[c8 * 8 + 5] * bfhi(w.z) + qv[c8 * 8 + 6] * bflo(w.w) + qv[c8 * 8 + 7] * bfhi(w.w); }
                        sc = dsum + (ct - cbh[s]); }
                    float cm = sc;
#pragma unroll
                    for (int of = 1; of < 64; of <<= 1) cm = fmaxf(cm, __shfl_xor(cm, of));
                    const float nm = fmaxf(mx, cm), f = __builtin_amdgcn_exp2f(mx - nm); mx = nm;
                    const float p = (s <= t) ? __builtin_amdgcn_exp2f(sc - nm) : 0.f;
                    lsum = lsum * f + wave_sum(p); o *= f;
                    const int nk = (t - s0 + 1) < 64 ? (t - s0 + 1) : 64;
                    for (int j = 0; j < nk; ++j) { const float pj = __shfl(p, j); const unsigned short vv = Vp[(size_t)(b * SEQ + s0 + j) * 512 + h * 64 + lane];
                        o += pj * __builtin_bit_cast(float, (unsigned)vv << 16); }
                }
                const float ov = o / lsum; const unsigned ob = f2bf(ov); const float orr = __builtin_bit_cast(float, ob << 16);
                Op[rowq * 512 + h * 64 + lane] = (bf16_t)ob;
                const float ssq = wave_sum(orr * orr);
                if (lane == 0) SQ[rowq * 8 + h] = ssq;
            }
        }
#else
        const int vcu = (G % 8 == 0) ? (bx % 8) * (G / 8) + bx / 8 : bx;
        for (int L2 = vcu; L2 < BATCH * NFH * 2; L2 += G) { const int bh = L2 >> 1, s = L2 & 1;
            for (int i = 0; i < 4; ++i) { const int qb = (i == 0) ? s : (i == 1) ? 3 - s : (i == 2) ? 4 + s : 7 - s;
                attn_body::attn_unit<8>(bh >> 3, bh & 7, qb, (const attn_body::bf16*)(ws + WS_Q), (const attn_body::bf16*)(ws + WS_K), (const attn_body::bf16*)(ws + WS_V),
                                        (attn_body::bf16*)(ws + WS_FOX), (const float*)(ws + WS_CB), (float*)(ws + WS_SSQF), (char*)lds); } }
#endif
    }
    if (ON(6)) {
        KA
        pg8::Gemm g{WSB(WS_UG), WSB(WS_BTE), UGP, 512, 256}; GOrder<OK_S5E> S; S.init(256, 1, G, bx, UGP, 512);
        Epi<EK_S5E> E{ws + WS_EPART, nullptr, nullptr, nullptr, nullptr, nullptr, nullptr};
        pg8::gemm_phase(L, g, S, E);
        SYNC(6);
    }
    if (ON(7)) {
        KA
        IDS
        const float* ep = (const float*)(ws + WS_EPART); const float* lb = (const float*)(ws + WS_LB32); bf16_t* ug = (bf16_t*)(ws + WS_UG);
        for (int idx = gt; idx < S5G * BATCH * S5P; idx += NGT) { const int p = idx & 63, gb = idx >> 6, gI = gb >> 4;
            const float lr = lb[(gI * 64 + p) * 2], li = lb[(gI * 64 + p) * 2 + 1]; float sr = 0.f, si = 0.f;
            for (int k0 = 0; k0 < NCH; k0 += 16) {
                f32x2 e0[16], e1[16];
#pragma unroll
                for (int j = 0; j < 16; ++j) { const size_t row = (size_t)gb * NCH + k0 + j; e0[j] = *(const f32x2*)(ep + row * 128 + 2 * p); e1[j] = *(const f32x2*)(ep + (size_t)32768 * 128 + row * 128 + 2 * p); }
#pragma unroll
                for (int j = 0; j < 16; ++j) { const size_t row = (size_t)gb * NCH + k0 + j;
                    *(unsigned*)(ug + row * UGP + 512 + 2 * p) = pk2(sr, si);
                    const float nr = lr * sr - li * si + (e0[j][0] + e1[j][0]), ni = lr * si + li * sr + (e0[j][1] + e1[j][1]); sr = nr; si = ni; } } }
        SYNC(7);
    }
    if (ON(8)) {
        KA
        pg8::Gemm g{WSB(WS_UG), WSB(WS_BTY), UGP, UGP, UGP}; GOrder<OK_S5Y> S; S.init(256, 1, G, bx, UGP, UGP);
        Epi<EK_S5Y> E{ws + WS_Y1, nullptr, nullptr, nullptr, nullptr, nullptr, nullptr};
        pg8::gemm_phase(L, g, S, E);
        SYNC(8);
    }
    if (ON(9)) {
        KA
        pg8::Gemm g{WSB(WS_Y1), WSB(WS_WGLU), 512, 512, 512}; GOrder<OK_PLAIN> S; S.init(T / 256, 2, G, bx, 512, 512);
        Epi<EK_GLU> E{ws + WS_Y2, ws + WS_SSQY, nullptr, nullptr, ws + WS_Y1, in[I_BGLU], nullptr};
        pg8::gemm_phase(L, g, S, E);
        SYNC(9);
    }
    if (ON(10)) {
        KA
        IDS
        const float* sf = (const float*)(ws + WS_SSQF); const float* sy = (const float*)(ws + WS_SSQY);
        const bf16_t* fox = WSB(WS_FOX); const bf16_t* y2 = WSB(WS_Y2); bf16_t* mx = (bf16_t*)(ws + WS_MIXN);
        for (int m = gw; m < T; m += NGW) {
            const f32x4 a0 = *(const f32x4*)(sf + (size_t)m * 8), a1 = *(const f32x4*)(sf + (size_t)m * 8 + 4), b0 = *(const f32x4*)(sy + (size_t)m * 8), b1 = *(const f32x4*)(sy + (size_t)m * 8 + 4);
            const float rf = rsqrtf((((a0[0] + a0[1]) + (a0[2] + a0[3])) + ((a1[0] + a1[1]) + (a1[2] + a1[3]))) * (1.f / 512.f) + EPS);
            const float ry = rsqrtf((((b0[0] + b0[1]) + (b0[2] + b0[3])) + ((b1[0] + b1[1]) + (b1[2] + b1[3]))) * (1.f / 512.f) + EPS);
            const u32x4 f = *(const u32x4*)(fox + (size_t)m * 512 + lane * 8), y = *(const u32x4*)(y2 + (size_t)m * 512 + lane * 8);
            u32x4 of, oy;
            of.x = pk2(bflo(f.x) * rf, bfhi(f.x) * rf); of.y = pk2(bflo(f.y) * rf, bfhi(f.y) * rf); of.z = pk2(bflo(f.z) * rf, bfhi(f.z) * rf); of.w = pk2(bflo(f.w) * rf, bfhi(f.w) * rf);
            oy.x = pk2(bflo(y.x) * ry, bfhi(y.x) * ry); oy.y = pk2(bflo(y.y) * ry, bfhi(y.y) * ry); oy.z = pk2(bflo(y.z) * ry, bfhi(y.z) * ry); oy.w = pk2(bflo(y.w) * ry, bfhi(y.w) * ry);
            if (DBG_NOFOXH) of = (u32x4){0u, 0u, 0u, 0u};
            if (DBG_NOS5H) oy = (u32x4){0u, 0u, 0u, 0u};
            *(u32x4*)(mx + (size_t)m * DM + lane * 8) = of; *(u32x4*)(mx + (size_t)m * DM + 512 + lane * 8) = oy; }
        SYNC(10);
    }
    if (ON(11)) {
        KA
        pg8::Gemm g{WSB(WS_MIXN), WSB(WS_WOUT), DM, DM, DM}; GOrder<OK_PLAIN> S; S.init(T / 256, 4, G, bx, DM, DM);
        Epi<EK_WOUT> E{out, ws + WS_H1B, ws + WS_SSQ1, nullptr, in[I_X], nullptr, nullptr};
        pg8::gemm_phase(L, g, S, E);
        SYNC(11);
    }
    if (ON(12)) {
        KA
        IDS
        const float* sk = (const float*)(ws + WS_SSQK); float* sck = (float*)(ws + WS_SCK);
        for (int idx = gt; idx < TM * 4; idx += NGT) { const int key = idx >> 2, h = idx & 3; const f32x4 q = *(const f32x4*)(sk + (size_t)key * 16 + h * 4);
            sck[(size_t)h * TM + key] = rsqrtf(((q[0] + q[1]) + (q[2] + q[3])) * (1.f / 256.f) + EPS); }
        pg8::Gemm g{WSB(WS_H1B), WSB(WS_WXQ), DM, DM, DM}; GOrder<OK_PLAIN> S; S.init(T / 256, 4, G, bx, DM, DM);
        Epi<EK_XQ> E{ws + WS_QST, ws + WS_SSQQ, nullptr, nullptr, in[I_XQN], in[I_XKN], nullptr};
        pg8::gemm_phase(L, g, S, E);
        SYNC(12);
    }
    if (ON(13)) {
        KA
        pg8::Gemm g{WSB(WS_QST), WSB(WS_KST), DM, DM, 256}; GOrder<OK_XS> S; S.init(512, 1, G, bx, DM, DM);
        Epi<EK_XS> E{ws + WS_P, ws + WS_PSUM, nullptr, nullptr, ws + WS_SSQ1, ws + WS_SSQQ, ws + WS_SCK};
        pg8::gemm_phase(L, g, S, E);
        SYNC(13);
    }
    if (ON(14)) {
        KA
        pg8::Gemm g{WSB(WS_P), WSB(WS_VT), DM, TM, 256}; GOrder<OK_XO> S; S.init(512, 1, G, bx, DM, TM);
        Epi<EK_XO> E{ws + WS_XO, nullptr, nullptr, nullptr, ws + WS_PSUM, nullptr, nullptr};
        pg8::gemm_phase(L, g, S, E);
        SYNC(14);
    }
    if (ON(15)) {
        KA
        pg8::Gemm g{WSB(WS_XO), WSB(WS_WXO), DM, DM, DM}; GOrder<OK_PLAIN> S; S.init(T / 256, 4, G, bx, DM, DM);
        Epi<EK_WXO> E{out, ws + WS_H2B, ws + WS_SSQ2, nullptr, out, nullptr, nullptr};
        pg8::gemm_phase(L, g, S, E);
        SYNC(15);
    }
    if (ON(16)) {
        KA
        { IDS
          const float* s2 = (const float*)(ws + WS_SSQ2); float* r2 = (float*)(ws + WS_RS2);
          for (int row = gt; row < T; row += NGT) { const f32x4 t0 = *(const f32x4*)(s2 + (size_t)row * 16), t1 = *(const f32x4*)(s2 + (size_t)row * 16 + 4), t2 = *(const f32x4*)(s2 + (size_t)row * 16 + 8), t3 = *(const f32x4*)(s2 + (size_t)row * 16 + 12);
              r2[row] = rsqrtf((((t0[0] + t0[1]) + (t0[2] + t0[3])) + ((t1[0] + t1[1]) + (t1[2] + t1[3])) + ((t2[0] + t2[1]) + (t2[2] + t2[3])) + ((t3[0] + t3[1]) + (t3[2] + t3[3]))) * (1.f / DM) + EPS); } }
        pg8::Gemm g{WSB(WS_H2B), WSB(WS_WUP), DM, DM, DM}; GOrder<OK_PLAIN> S; S.init(T / 256, 11, G, bx, DM, DM);
        Epi<EK_GATE> E{ws + WS_G, nullptr, nullptr, nullptr, ws + WS_SSQ2, nullptr, nullptr};
        pg8::gemm_phase(L, g, S, E);
        SYNC(16);
    }
    if (ON(17)) {
        KA
        pg8::Gemm g{WSB(WS_H2B), WSB(WS_WUP) + (size_t)DFF * DM, DM, DM, DM}; GOrder<OK_PLAIN> S; S.init(T / 256, 11, G, bx, DM, DM);
        Epi<EK_UPACT> E{ws + WS_U, (void*)in[I_CONVB], nullptr, nullptr, ws + WS_RS2, ws + WS_G, in[I_CONVW]};
        pg8::gemm_phase(L, g, S, E);
        SYNC(17);
    }
    if (ON(18)) {
        KA
        pg8::Gemm g{WSB(WS_U), WSB(WS_WDN), DFF, DFF, DFF}; GOrder<OK_PLAIN> S; S.init(T / 256, 4, G, bx, DFF, DFF);
        Epi<EK_DOWN> E{out, nullptr, nullptr, nullptr, nullptr, nullptr, nullptr};
        pg8::gemm_phase(L, g, S, E);
    }
}

extern "C" void kernel_launch(void* const* d_in, const int* in_sizes, int n_in, void* d_out, int out_size, void* d_ws, size_t ws_size, hipStream_t stream) {
    static int grid = 0;
    if (grid == 0) {
        if (n_in != 32 || out_size != T * DM || ws_size < WS_END) { fprintf(stderr, "kernel_launch: unexpected shapes (n_in %d out %d ws %zu)\n", n_in, out_size, ws_size); grid = -1; return; }
        int dev = 0, cus = 0, per_cu = 0;
        (void)hipGetDevice(&dev); (void)hipDeviceGetAttribute(&cus, hipDeviceAttributeMultiprocessorCount, dev);
        if (hipFuncSetAttribute((const void*)fox_s5_mega, hipFuncAttributeMaxDynamicSharedMemorySize, LDS_TOTAL) != hipSuccess) { fprintf(stderr, "kernel_launch: hipFuncSetAttribute failed\n"); grid = -1; return; }
        if (hipOccupancyMaxActiveBlocksPerMultiprocessor(&per_cu, (const void*)fox_s5_mega, 512, LDS_TOTAL) != hipSuccess || per_cu < 1) { fprintf(stderr, "kernel_launch: occupancy query says %d\n", per_cu); per_cu = 1; }
        (void)hipGetLastError();
        grid = cus;
        if (grid > cus * per_cu) grid = cus * per_cu;
    }
    if (grid < 0) return;
    if (hipMemsetAsync(d_ws, 0, 65536, stream) != hipSuccess) { fprintf(stderr, "kernel_launch: memset of the barrier words failed\n"); return; }
    Args a{};
    for (int i = 0; i < 32; ++i) a.in[i] = (const float*)d_in[i];
    a.out = (float*)d_out; a.ws = (unsigned char*)d_ws;
    void* args[] = {&a};
    hipError_t e = hipLaunchCooperativeKernel((const void*)fox_s5_mega, dim3(grid), dim3(512), args, LDS_TOTAL, stream);
    if (e != hipSuccess) fprintf(stderr, "cooperative launch failed: %s (grid %d)\n", hipGetErrorString(e), grid);
}
```

```cpp
#include <hip/hip_runtime.h>
#include <hip/hip_cooperative_groups.h>
#include <hip/hip_bf16.h>
#include <cstdio>
#include <cstdint>
#include <cmath>
namespace cg = cooperative_groups;

constexpr int BATCH = 16, SEQ = 2048, DM = 1024, T = BATCH * SEQ;
constexpr int NMEM = 256, TM = BATCH * NMEM;
constexpr int FOXW = 512, HD = 64, NFH = 8;
constexpr int S5W = 512, S5G = 32, S5C = 16, S5P = 64;
constexpr int NXH = 4, XHD = 256;
constexpr int DFF = 2816;
constexpr int INCOLS = 2056;
constexpr float EPS = 1e-6f;
constexpr int TC = 32, NCH = SEQ / TC;
constexpr int UGP = TC * 16 + 128;
constexpr float LOG2E = 1.4426950408889634f;
constexpr float C2Q = 0.125f * LOG2E;

#define LAS __attribute__((address_space(3)))
typedef unsigned short bf16_t;
typedef short bf16x8 __attribute__((ext_vector_type(8)));
typedef float f32x4 __attribute__((ext_vector_type(4)));
typedef float f32x2 __attribute__((ext_vector_type(2)));
typedef unsigned u32x4 __attribute__((ext_vector_type(4)));
typedef unsigned u32x2 __attribute__((ext_vector_type(2)));

__device__ __forceinline__ unsigned f2bf(float f) { unsigned u = __builtin_bit_cast(unsigned, f); return (u + 0x7fffu + ((u >> 16) & 1u)) >> 16; }
__device__ __forceinline__ unsigned pk2(float lo, float hi) { return f2bf(lo) | (f2bf(hi) << 16); }
__device__ __forceinline__ float bflo(unsigned w) { return __builtin_bit_cast(float, w << 16); }
__device__ __forceinline__ float bfhi(unsigned w) { return __builtin_bit_cast(float, w & 0xffff0000u); }
__device__ __forceinline__ float wave_sum(float v) {
#pragma unroll
    for (int o = 1; o < 64; o <<= 1) v += __shfl_xor(v, o);
    return v;
}

__device__ __forceinline__ float red_fq(float v) {
    v += __builtin_bit_cast(float, __builtin_amdgcn_ds_swizzle(__builtin_bit_cast(int, v), 0x401F));
    float a = v, b = v;
    asm volatile("s_nop 1\n\tv_permlane32_swap_b32 %0, %1\n\ts_nop 1" : "+v"(a), "+v"(b));
    return a + b;
}

constexpr size_t MiB = 1u << 20;
constexpr size_t WS_WIN = 1 * MiB, WS_WGLU = 5 * MiB, WS_WOUT = 6 * MiB, WS_WXQ = 8 * MiB, WS_WXK = 10 * MiB, WS_WXV = 12 * MiB, WS_WXO = 14 * MiB,
                 WS_WUP = 16 * MiB, WS_WDN = 27 * MiB, WS_BTY = 33 * MiB, WS_BTE = 53 * MiB, WS_KTAB = 61 * MiB, WS_LB32 = 62 * MiB, WS_LOGF = 63 * MiB,
                 WS_CB = 64 * MiB, WS_SSQF = 65 * MiB, WS_SSQY = 66 * MiB, WS_SSQ1 = 67 * MiB, WS_SSQ2 = 69 * MiB, WS_SSQQ = 71 * MiB, WS_PSUM = 73 * MiB,
                 WS_SSQK = 75 * MiB, WS_SCK = 76 * MiB, WS_RS2 = 77 * MiB;
constexpr size_t WS_HN = 80 * MiB, WS_FOX = 80 * MiB, WS_Y1 = 112 * MiB, WS_QST = 80 * MiB, WS_H2B = 80 * MiB;
constexpr size_t WS_MN = 144 * MiB, WS_KST = 152 * MiB, WS_VT = 160 * MiB;
constexpr size_t WS_Q = 168 * MiB, WS_K = 200 * MiB, WS_V = 232 * MiB, WS_Y2 = 168 * MiB, WS_MIXN = 200 * MiB, WS_P = 168 * MiB;
constexpr size_t WS_UG = 264 * MiB, WS_EPART = 304 * MiB, WS_H1B = 264 * MiB, WS_XO = 264 * MiB;
constexpr size_t WS_G = 144 * MiB, WS_U = 320 * MiB, WS_END = 496 * MiB;

namespace pg8 {
constexpr int BM = 256, BK = 64, HALF = 128, HTB = HALF * BK * 2, STAGE_BYTES = 8 * HTB;
__device__ __forceinline__ int lds_byte(int r, int c) { const int st = (r >> 4) * 2 + (c >> 5), rr = r & 15, cc = c & 31, ob = rr * 64 + cc * 2; return st * 1024 + (ob ^ (((ob >> 9) & 1) << 5)); }
__device__ __forceinline__ void stage_rc(int b, int& R, int& C) { const int st = b / 1024, sb = b % 1024, swz = sb ^ (((sb >> 9) & 1) << 5); R = (st >> 1) * 16 + swz / 64; C = (st & 1) * 32 + (swz % 64) / 2; }
__device__ __forceinline__ int perm32(int rho) { const int n = rho >> 4, i = rho & 15; return 8 * (i >> 2) + 4 * n + (i & 3); }

struct Unit { int pm, pn; long offA, offB; };
struct Gemm { const bf16_t* A; const bf16_t* Bt; int lda, ldb, K; };

template <class Epi, class Sched>
__device__ __forceinline__ void gemm_phase(LAS unsigned char* lds, const Gemm g, const Sched& S, const Epi& E) {
    int tid = threadIdx.x; asm volatile("" : "+v"(tid));
    const int wid = __builtin_amdgcn_readfirstlane(tid >> 6), lane = tid & 63, wr = wid >> 2, wc = wid & 3, fr = lane & 15, fq = lane >> 4;
    const int K = g.K, nt = K / BK;
    unsigned voffA[2], voffB[2];
#pragma unroll
    for (int i = 0; i < 2; ++i) { int R, C; stage_rc(tid * 16 + i * 8192, R, C); const int Rb = (R & ~31) + perm32(R & 31);
        voffA[i] = (unsigned)(R * g.lda + C) * 2u; voffB[i] = (unsigned)(Rb * g.ldb + C) * 2u; }
    const size_t kstep = (size_t)(BK * 2);
    const size_t hstepA = (size_t)HALF * g.lda * 2, hstepB = (size_t)HALF * g.ldb * 2;
    const unsigned ldsw = (unsigned)wid * 1024u;
    const int aoff = lds_byte(wr * 64 + fr, fq * 8), boff = lds_byte(wc * 32 + fr, fq * 8);
#define PG8_SA(b, h) (((b) * 2 + (h)) * HTB)
#define PG8_SB(b, h) ((4 + (b) * 2 + (h)) * HTB)
#define PG8_STAGE(bufoff, gbase, voff) do { _Pragma("unroll") for (int _i = 0; _i < 2; ++_i) \
        __builtin_amdgcn_global_load_lds((const unsigned*)((const char*)(gbase) + (voff)[_i]), (LAS unsigned*)(lds + (bufoff) + ldsw + _i * 8192), 16, 0, 0); } while (0)
#define PG8_LDA(dst, b, h) do { _Pragma("unroll") for (int m = 0; m < 4; ++m) _Pragma("unroll") for (int k = 0; k < 2; ++k) dst[m][k] = *(const LAS bf16x8*)(lds + PG8_SA(b, h) + aoff + m * 2048 + k * 1024); } while (0)
#define PG8_LDB(dst, b, h) do { _Pragma("unroll") for (int n = 0; n < 2; ++n) _Pragma("unroll") for (int k = 0; k < 2; ++k) dst[n][k] = *(const LAS bf16x8*)(lds + PG8_SB(b, h) + boff + n * 2048 + k * 1024); } while (0)
#define PG8_MMA(ai, bj, At, Bt) do { __builtin_amdgcn_s_setprio(1); _Pragma("unroll") for (int m = 0; m < 4; ++m) _Pragma("unroll") for (int n = 0; n < 2; ++n) _Pragma("unroll") for (int k = 0; k < 2; ++k) \
        acc[ai][bj][m][n] = __builtin_amdgcn_mfma_f32_16x16x32_bf16(Bt[n][k], At[m][k], acc[ai][bj][m][n], 0, 0, 0); __builtin_amdgcn_s_setprio(0); } while (0)
#define PG8_WAIT_V(n) asm volatile("s_waitcnt vmcnt(" #n ")" ::: "memory")
#define PG8_WAIT_L(n) asm volatile("s_waitcnt lgkmcnt(" #n ")" ::: "memory")
#define PG8_BAR __builtin_amdgcn_s_barrier()
#define PG8_SCHED __builtin_amdgcn_sched_barrier(0)
    Unit cur, nxt; int ui = 0;
    if (!S.next(0, cur)) return;
    f32x4 acc[2][2][4][2];
#pragma unroll
    for (int a = 0; a < 2; ++a)
#pragma unroll
        for (int b = 0; b < 2; ++b)
#pragma unroll
            for (int m = 0; m < 4; ++m)
#pragma unroll
                for (int n = 0; n < 2; ++n) acc[a][b][m][n] = (f32x4){0.f, 0.f, 0.f, 0.f};
    bf16x8 At[4][2], B0[2][2], B1[2][2];
    const char* cA = (const char*)g.A + cur.offA; const char* cB = (const char*)g.Bt + cur.offB;
    PG8_STAGE(PG8_SB(0, 0), cB, voffB); PG8_STAGE(PG8_SB(0, 1), cB + hstepB, voffB); PG8_STAGE(PG8_SA(0, 0), cA, voffA); PG8_STAGE(PG8_SA(0, 1), cA + hstepA, voffA);
    if (wr == 1) PG8_BAR;
    PG8_WAIT_V(2); PG8_BAR;
    PG8_STAGE(PG8_SB(1, 0), cB + kstep, voffB); PG8_STAGE(PG8_SA(1, 0), cA + kstep, voffA); PG8_STAGE(PG8_SB(1, 1), cB + hstepB + kstep, voffB);
    PG8_WAIT_V(6); PG8_BAR;
    for (;;) {
        const bool has_next = S.next(ui + 1, nxt);
        const char* nA = has_next ? (const char*)g.A + nxt.offA : cA; const char* nB = has_next ? (const char*)g.Bt + nxt.offB : cB;
        for (int t = 0; t < nt; t += 2) {
            const bool last = (t == nt - 2);
            const char* a1 = cA + (size_t)(t + 1) * kstep;
            const char* a2 = last ? nA : cA + (size_t)(t + 2) * kstep; const char* b2 = last ? nB : cB + (size_t)(t + 2) * kstep;
            const char* a3 = a2 + kstep; const char* b3 = b2 + kstep;
            PG8_LDB(B0, 0, 0); PG8_LDB(B1, 0, 1); PG8_SCHED; PG8_LDA(At, 0, 0); PG8_STAGE(PG8_SA(1, 1), a1 + hstepA, voffA);
            PG8_WAIT_V(8); PG8_WAIT_L(0); PG8_BAR; PG8_MMA(0, 0, At, B0); PG8_MMA(0, 1, At, B1); PG8_BAR; PG8_SCHED;
            PG8_LDA(At, 0, 1); PG8_STAGE(PG8_SB(0, 0), b2, voffB); PG8_STAGE(PG8_SB(0, 1), b2 + hstepB, voffB); PG8_STAGE(PG8_SA(0, 0), a2, voffA);
            PG8_WAIT_V(8); PG8_WAIT_L(0); PG8_BAR; PG8_MMA(1, 0, At, B0); PG8_MMA(1, 1, At, B1); PG8_BAR; PG8_SCHED;
            PG8_LDB(B0, 1, 0); PG8_LDB(B1, 1, 1); PG8_SCHED; PG8_LDA(At, 1, 0); PG8_STAGE(PG8_SA(0, 1), a2 + hstepA, voffA);
            PG8_WAIT_V(8); PG8_WAIT_L(0); PG8_BAR; PG8_MMA(0, 0, At, B0); PG8_MMA(0, 1, At, B1); PG8_BAR; PG8_SCHED;
            PG8_LDA(At, 1, 1); PG8_STAGE(PG8_SB(1, 0), b3, voffB); PG8_STAGE(PG8_SB(1, 1), b3 + hstepB, voffB); PG8_STAGE(PG8_SA(1, 0), a3, voffA);
            PG8_WAIT_V(8); PG8_WAIT_L(0); PG8_BAR; PG8_MMA(1, 0, At, B0); PG8_MMA(1, 1, At, B1); PG8_BAR; PG8_SCHED;
        }
        if (wr == 0) PG8_BAR;
        { int fr2 = fr, fq2 = fq; asm volatile("" : "+v"(fr2), "+v"(fq2));
          E(acc, cur, wr, wc, fr2, fq2); }
        if (!has_next) break;
#pragma unroll
        for (int a = 0; a < 2; ++a)
#pragma unroll
            for (int b = 0; b < 2; ++b)
#pragma unroll
                for (int m = 0; m < 4; ++m)
#pragma unroll
                    for (int n = 0; n < 2; ++n) acc[a][b][m][n] = (f32x4){0.f, 0.f, 0.f, 0.f};
        cur = nxt; cA = nA; cB = nB; ++ui;
        if (wr == 1) PG8_BAR;
    }
    PG8_WAIT_V(0);
    PG8_BAR;
#undef PG8_SA
#undef PG8_SB
#undef PG8_STAGE
#undef PG8_LDA
#undef PG8_LDB
#undef PG8_MMA
#undef PG8_WAIT_V
#undef PG8_WAIT_L
#undef PG8_BAR
#undef PG8_SCHED
}
}
using pg8::Unit;

enum OrderKind { OK_PLAIN = 0, OK_S5E, OK_S5Y, OK_XS, OK_XO };
template <int kind> struct GOrder {
    int nM, nN, nwg, G, c, lda, ldb;
    __device__ __forceinline__ void init(int nM_, int nN_, int G_, int c_, int lda_, int ldb_) { nM = nM_; nN = nN_; nwg = nM_ * nN_; G = G_; c = c_; lda = lda_; ldb = ldb_; }
    __device__ __forceinline__ bool next(int i, Unit& u) const {
        const long L = (long)i * G + c; if (L >= nwg) return false;
        const int l = (int)L;
        if constexpr (kind == OK_PLAIN) {
            int wgid = l; { const int q = nwg / 8, r = nwg % 8, xcd = wgid % 8, off = wgid / 8; wgid = (xcd < r ? xcd * (q + 1) : r * (q + 1) + (xcd - r) * q) + off; }
            const int nig = 8 * nN, gid = wgid / nig, fm = gid * 8, gsz = (nM - fm) < 8 ? (nM - fm) : 8;
            u.pm = fm + ((wgid % nig) % gsz); u.pn = (wgid % nig) / gsz;
            u.offA = (long)u.pm * 256 * lda * 2; u.offB = (long)u.pn * 256 * ldb * 2;
        } else if constexpr (kind == OK_S5E) {
            const int kq = l & 1, pmm = (l >> 1) & 3, gg = l >> 3;
            u.pm = gg * 4 + pmm; u.pn = kq;
            u.offA = ((long)u.pm * 256 * UGP + kq * 256) * 2; u.offB = ((long)gg * 256 * 512 + kq * 256) * 2;
        } else if constexpr (kind == OK_S5Y) {
            const int pn = l & 1, pmm = (l >> 1) & 3, gg = l >> 3;
            u.pm = gg * 4 + pmm; u.pn = pn;
            u.offA = (long)u.pm * 256 * UGP * 2; u.offB = ((long)gg * 512 + pn * 256) * UGP * 2;
        } else if constexpr (kind == OK_XS) {
            const int h = l & 3, pm = l >> 2, b = pm >> 3;
            u.pm = pm; u.pn = h;
            u.offA = ((long)pm * 256 * DM + h * 256) * 2; u.offB = ((long)b * 256 * DM + h * 256) * 2;
        } else {
            const int h = l & 3, pm = l >> 2, b = pm >> 3;
            u.pm = pm; u.pn = h;
            u.offA = ((long)pm * 256 * DM + h * 256) * 2; u.offB = ((long)h * 256 * TM + b * 256) * 2;
        }
        return true;
    }
};

enum EpiKind { EK_PROJ = 0, EK_MEMK, EK_MEMVT, EK_S5E, EK_S5Y, EK_GLU, EK_WOUT, EK_XQ, EK_XS, EK_XO, EK_WXO, EK_UP, EK_DOWN, EK_GATE, EK_UPACT };
    __device__ __forceinline__ u32x4 pack8(const f32x4 a, const f32x4 b) { u32x4 w; w.x = pk2(a[0], a[1]); w.y = pk2(a[2], a[3]); w.z = pk2(b[0], b[1]); w.w = pk2(b[2], b[3]); return w; }
    __device__ __forceinline__ float gelu_t(float y) { const float z = 0.7978845608028654f * (y + 0.044715f * y * y * y); const float e = __expf(2.f * z); const float th = 1.f - 2.f / (e + 1.f); return 0.5f * y * (1.f + th); }
    __device__ __forceinline__ float sigm(float z) { return 1.f / (1.f + __expf(-z)); }
    __device__ __forceinline__ float ssq8(const f32x4 a, const f32x4 b) { return (a[0] * a[0] + a[1] * a[1]) + (a[2] * a[2] + a[3] * a[3]) + (b[0] * b[0] + b[1] * b[1]) + (b[2] * b[2] + b[3] * b[3]); }

template <int kind> struct Epi {
    void* p0; void* p1; void* p2; void* p3; const void* c0; const void* c1; const void* c2;
    __device__ __forceinline__ void operator()(const f32x4 (&acc)[2][2][4][2], const Unit& u, int wr, int wc, int fr, int fq) const {
        const int rbase = u.pm * 256 + wr * 64 + fr;
        const int cl0 = wc * 32 + 8 * fq;
        switch (kind) {
        case EK_PROJ: {
            const int pn = u.pn;
            if (pn < 4) {
                const bool isq = pn < 2; bf16_t* dst = (bf16_t*)(isq ? p0 : p1); const float* gptr = (const float*)(isq ? c0 : c1); const float post = isq ? C2Q : 1.f;
                const int head = 4 * (pn & 1) + wc;
#pragma unroll
                for (int ai = 0; ai < 2; ++ai)
#pragma unroll
                    for (int m = 0; m < 4; ++m) {
                        float ss = ssq8(acc[ai][0][m][0], acc[ai][0][m][1]) + ssq8(acc[ai][1][m][0], acc[ai][1][m][1]);
                        ss = red_fq(ss);
                        const float sc = rsqrtf(ss * (1.f / 64.f) + EPS) * post;
                        const size_t row = (size_t)(rbase + ai * 128 + m * 16);
#pragma unroll
                        for (int bj = 0; bj < 2; ++bj)
                            *(u32x4*)(dst + row * 512 + head * 64 + 32 * bj + 8 * fq) = pack8(acc[ai][bj][m][0] * sc * *(const f32x4*)(gptr + 32 * bj + 8 * fq), acc[ai][bj][m][1] * sc * *(const f32x4*)(gptr + 32 * bj + 8 * fq + 4));
                    }
            } else if (pn < 6) {
                bf16_t* dst = (bf16_t*)p2;
#pragma unroll
                for (int ai = 0; ai < 2; ++ai)
#pragma unroll
                    for (int m = 0; m < 4; ++m) { const size_t row = (size_t)(rbase + ai * 128 + m * 16);
#pragma unroll
                        for (int bj = 0; bj < 2; ++bj) *(u32x4*)(dst + row * 512 + (pn - 4) * 256 + bj * 128 + cl0) = pack8(acc[ai][bj][m][0], acc[ai][bj][m][1]); }
            } else {
                bf16_t* dst = (bf16_t*)p3;
#pragma unroll
                for (int ai = 0; ai < 2; ++ai)
#pragma unroll
                    for (int m = 0; m < 4; ++m) { const int row = rbase + ai * 128 + m * 16; const int b = row >> 11, t = row & 2047, ch = t >> 5, s = t & 31;
#pragma unroll
                        for (int bj = 0; bj < 2; ++bj) { const int f = (pn - 6) * 256 + bj * 128 + cl0; const int gI = f >> 4, cc = f & 15;
                            *(u32x4*)(dst + ((size_t)(gI * 1024 + b * 64 + ch)) * UGP + s * 16 + cc) = pack8(acc[ai][bj][m][0], acc[ai][bj][m][1]); } }
            }
        } break;
        case EK_MEMK: {
            bf16_t* dst = (bf16_t*)p0; float* sq = (float*)p1;
#pragma unroll
            for (int ai = 0; ai < 2; ++ai)
#pragma unroll
                for (int m = 0; m < 4; ++m) { const size_t row = (size_t)(rbase + ai * 128 + m * 16);
                    float ss = ssq8(acc[ai][0][m][0], acc[ai][0][m][1]) + ssq8(acc[ai][1][m][0], acc[ai][1][m][1]);
                    ss = red_fq(ss);
                    if (fq == 0) sq[row * 16 + u.pn * 4 + wc] = ss;
#pragma unroll
                    for (int bj = 0; bj < 2; ++bj) *(u32x4*)(dst + row * DM + u.pn * 256 + bj * 128 + cl0) = pack8(acc[ai][bj][m][0], acc[ai][bj][m][1]); }
        } break;
        case EK_MEMVT: {
            bf16_t* dst = (bf16_t*)p0;
#pragma unroll
            for (int ai = 0; ai < 2; ++ai)
#pragma unroll
                for (int m = 0; m < 4; ++m) { const size_t row = (size_t)(rbase + ai * 128 + m * 16);
#pragma unroll
                    for (int bj = 0; bj < 2; ++bj) *(u32x4*)(dst + row * TM + u.pn * 256 + bj * 128 + cl0) = pack8(acc[ai][bj][m][0], acc[ai][bj][m][1]); }
        } break;
        case EK_S5E: {
            float* dst = (float*)p0 + (size_t)u.pn * 32768 * 128;
#pragma unroll
            for (int ai = 0; ai < 2; ++ai)
#pragma unroll
                for (int m = 0; m < 4; ++m) { const size_t row = (size_t)(rbase + ai * 128 + m * 16);
                    *(f32x4*)(dst + row * 128 + cl0) = acc[ai][0][m][0]; *(f32x4*)(dst + row * 128 + cl0 + 4) = acc[ai][0][m][1]; }
        } break;
        case EK_S5Y: {
            bf16_t* dst = (bf16_t*)p0;
#pragma unroll
            for (int ai = 0; ai < 2; ++ai)
#pragma unroll
                for (int m = 0; m < 4; ++m) { const int r = rbase + ai * 128 + m * 16; const int gI = r >> 10, b = (r >> 6) & 15, k = r & 63;
#pragma unroll
                    for (int bj = 0; bj < 2; ++bj) { const int nn = u.pn * 256 + bj * 128 + cl0; const int tt = nn >> 4, cc = nn & 15;
                        f32x4 a = acc[ai][bj][m][0], c = acc[ai][bj][m][1];
#pragma unroll
                        for (int j = 0; j < 4; ++j) { a[j] = gelu_t(a[j]); c[j] = gelu_t(c[j]); }
                        *(u32x4*)(dst + ((size_t)(b * SEQ + k * TC + tt)) * 512 + gI * 16 + cc) = pack8(a, c); } }
        } break;
        case EK_GLU: {
            bf16_t* dst = (bf16_t*)p0; float* sq = (float*)p1; const bf16_t* y1 = (const bf16_t*)c0; const float* bg = (const float*)c1;
            f32x4 bv[2][2];
#pragma unroll
            for (int bj = 0; bj < 2; ++bj)
#pragma unroll
                for (int n = 0; n < 2; ++n) bv[bj][n] = *(const f32x4*)(bg + u.pn * 256 + bj * 128 + cl0 + 4 * n);
#pragma unroll
            for (int ai = 0; ai < 2; ++ai)
#pragma unroll
                for (int m = 0; m < 4; ++m) { const size_t row = (size_t)(rbase + ai * 128 + m * 16); float ss = 0.f;
#pragma unroll
                    for (int bj = 0; bj < 2; ++bj) { const size_t off = row * 512 + u.pn * 256 + bj * 128 + cl0;
                        const u32x4 yv = *(const u32x4*)(y1 + off);
                        f32x4 a = acc[ai][bj][m][0] + bv[bj][0], c = acc[ai][bj][m][1] + bv[bj][1];
                        a[0] = bflo(yv.x) * sigm(a[0]); a[1] = bfhi(yv.x) * sigm(a[1]); a[2] = bflo(yv.y) * sigm(a[2]); a[3] = bfhi(yv.y) * sigm(a[3]);
                        c[0] = bflo(yv.z) * sigm(c[0]); c[1] = bfhi(yv.z) * sigm(c[1]); c[2] = bflo(yv.w) * sigm(c[2]); c[3] = bfhi(yv.w) * sigm(c[3]);
                        ss += ssq8(a, c);
                        *(u32x4*)(dst + off) = pack8(a, c); }
                    ss = red_fq(ss);
                    if (fq == 0) sq[row * 8 + u.pn * 4 + wc] = ss; }
        } break;
        case EK_WOUT: case EK_WXO: {
            float* out = (float*)p0; bf16_t* hb = (bf16_t*)p1; float* sq = (float*)p2; const float* base = (const float*)c0;
#pragma unroll
            for (int ai = 0; ai < 2; ++ai)
#pragma unroll
                for (int m = 0; m < 4; ++m) { const size_t row = (size_t)(rbase + ai * 128 + m * 16); float ss = 0.f;
#pragma unroll
                    for (int bj = 0; bj < 2; ++bj) { const size_t off = row * DM + u.pn * 256 + bj * 128 + cl0;
                        const f32x4 a = acc[ai][bj][m][0] + *(const f32x4*)(base + off), c = acc[ai][bj][m][1] + *(const f32x4*)(base + off + 4);
                        *(f32x4*)(out + off) = a; *(f32x4*)(out + off + 4) = c;
                        ss += ssq8(a, c);
                        *(u32x4*)(hb + off) = pack8(a, c); }
                    ss = red_fq(ss);
                    if (fq == 0) sq[row * 16 + u.pn * 4 + wc] = ss; }
        } break;
        case EK_XQ: {
            bf16_t* dst = (bf16_t*)p0; float* sq = (float*)p1; const float* gq = (const float*)c0; const float* gk = (const float*)c1;
            f32x4 gg[2][2];
#pragma unroll
            for (int bj = 0; bj < 2; ++bj)
#pragma unroll
                for (int n = 0; n < 2; ++n) gg[bj][n] = *(const f32x4*)(gq + bj * 128 + cl0 + 4 * n) * *(const f32x4*)(gk + bj * 128 + cl0 + 4 * n);
#pragma unroll
            for (int ai = 0; ai < 2; ++ai)
#pragma unroll
                for (int m = 0; m < 4; ++m) { const size_t row = (size_t)(rbase + ai * 128 + m * 16);
                    float ss = ssq8(acc[ai][0][m][0], acc[ai][0][m][1]) + ssq8(acc[ai][1][m][0], acc[ai][1][m][1]);
                    ss = red_fq(ss);
                    if (fq == 0) sq[row * 16 + u.pn * 4 + wc] = ss;
#pragma unroll
                    for (int bj = 0; bj < 2; ++bj) *(u32x4*)(dst + row * DM + u.pn * 256 + bj * 128 + cl0) = pack8(acc[ai][bj][m][0] * gg[bj][0], acc[ai][bj][m][1] * gg[bj][1]); }
        } break;
        case EK_XS: {
            bf16_t* dst = (bf16_t*)p0; float* ps = (float*)p1; const float* s1 = (const float*)c0; const float* sqq = (const float*)c1; const float* sck = (const float*)c2;
            const int h = u.pn, b = u.pm >> 3;
            f32x4 kv[2][2];
#pragma unroll
            for (int bj = 0; bj < 2; ++bj)
#pragma unroll
                for (int n = 0; n < 2; ++n) kv[bj][n] = *(const f32x4*)(sck + (size_t)h * TM + b * 256 + bj * 128 + cl0 + 4 * n) * (LOG2E / 16.f);
#pragma unroll
            for (int ai = 0; ai < 2; ++ai)
#pragma unroll
                for (int m = 0; m < 4; ++m) { const size_t row = (size_t)(rbase + ai * 128 + m * 16);
                    const f32x4 t0 = *(const f32x4*)(s1 + row * 16), t1 = *(const f32x4*)(s1 + row * 16 + 4), t2 = *(const f32x4*)(s1 + row * 16 + 8), t3 = *(const f32x4*)(s1 + row * 16 + 12);
                    const float tot = ((t0[0] + t0[1]) + (t0[2] + t0[3])) + ((t1[0] + t1[1]) + (t1[2] + t1[3])) + ((t2[0] + t2[1]) + (t2[2] + t2[3])) + ((t3[0] + t3[1]) + (t3[2] + t3[3]));
                    const float rs1 = rsqrtf(tot * (1.f / DM) + EPS);
                    const f32x4 qq = *(const f32x4*)(sqq + row * 16 + h * 4);
                    const float sq = rs1 * rsqrtf(rs1 * rs1 * ((qq[0] + qq[1]) + (qq[2] + qq[3])) * (1.f / 256.f) + EPS);
                    float ss = 0.f;
#pragma unroll
                    for (int bj = 0; bj < 2; ++bj) { f32x4 a = acc[ai][bj][m][0] * kv[bj][0] * sq, c = acc[ai][bj][m][1] * kv[bj][1] * sq;
#pragma unroll
                        for (int j = 0; j < 4; ++j) { a[j] = __builtin_amdgcn_exp2f(a[j]); c[j] = __builtin_amdgcn_exp2f(c[j]); }
                        const u32x4 w = pack8(a, c);
                        ss += (bflo(w.x) + bfhi(w.x)) + (bflo(w.y) + bfhi(w.y)) + (bflo(w.z) + bfhi(w.z)) + (bflo(w.w) + bfhi(w.w));
                        *(u32x4*)(dst + row * DM + h * 256 + bj * 128 + cl0) = w; }
                    ss = red_fq(ss);
                    if (fq == 0) ps[row * 16 + h * 4 + wc] = ss; }
        } break;
        case EK_XO: {
            bf16_t* dst = (bf16_t*)p0; const float* ps = (const float*)c0; const int h = u.pn;
#pragma unroll
            for (int ai = 0; ai < 2; ++ai)
#pragma unroll
                for (int m = 0; m < 4; ++m) { const size_t row = (size_t)(rbase + ai * 128 + m * 16);
                    const f32x4 pp = *(const f32x4*)(ps + row * 16 + h * 4); const float inv = 1.f / ((pp[0] + pp[1]) + (pp[2] + pp[3]));
#pragma unroll
                    for (int bj = 0; bj < 2; ++bj) *(u32x4*)(dst + row * DM + h * 256 + bj * 128 + cl0) = pack8(acc[ai][bj][m][0] * inv, acc[ai][bj][m][1] * inv); }
        } break;
        case EK_UP: {
            bf16_t* G = (bf16_t*)p0; bf16_t* U = (bf16_t*)p1; const float* s2 = (const float*)c0;
#pragma unroll
            for (int ai = 0; ai < 2; ++ai)
#pragma unroll
                for (int m = 0; m < 4; ++m) { const size_t row = (size_t)(rbase + ai * 128 + m * 16);
                    const f32x4 t0 = *(const f32x4*)(s2 + row * 16), t1 = *(const f32x4*)(s2 + row * 16 + 4), t2 = *(const f32x4*)(s2 + row * 16 + 8), t3 = *(const f32x4*)(s2 + row * 16 + 12);
                    const float tot = ((t0[0] + t0[1]) + (t0[2] + t0[3])) + ((t1[0] + t1[1]) + (t1[2] + t1[3])) + ((t2[0] + t2[1]) + (t2[2] + t2[3])) + ((t3[0] + t3[1]) + (t3[2] + t3[3]));
                    const float rs = rsqrtf(tot * (1.f / DM) + EPS);
                    const size_t off = row * DFF + u.pn * 128 + cl0;
                    *(u32x4*)(G + off) = pack8(acc[ai][0][m][0] * rs, acc[ai][0][m][1] * rs);
                    *(u32x4*)(U + off) = pack8(acc[ai][1][m][0] * rs, acc[ai][1][m][1] * rs); }
        } break;
        case EK_DOWN: {
            float* out = (float*)p0;
#pragma unroll
            for (int ai = 0; ai < 2; ++ai)
#pragma unroll
                for (int m = 0; m < 4; ++m) { const size_t row = (size_t)(rbase + ai * 128 + m * 16);
#pragma unroll
                    for (int bj = 0; bj < 2; ++bj) { const size_t off = row * DM + u.pn * 256 + bj * 128 + cl0;
                        const f32x4 a = acc[ai][bj][m][0] + *(const f32x4*)(out + off), c = acc[ai][bj][m][1] + *(const f32x4*)(out + off + 4);
                        *(f32x4*)(out + off) = a; *(f32x4*)(out + off + 4) = c; } }
        } break;
        case EK_GATE: {
            bf16_t* G = (bf16_t*)p0; const float* s2 = (const float*)c0;
#pragma unroll
            for (int ai = 0; ai < 2; ++ai)
#pragma unroll
                for (int m = 0; m < 4; ++m) { const size_t row = (size_t)(rbase + ai * 128 + m * 16);
                    const f32x4 t0 = *(const f32x4*)(s2 + row * 16), t1 = *(const f32x4*)(s2 + row * 16 + 4), t2 = *(const f32x4*)(s2 + row * 16 + 8), t3 = *(const f32x4*)(s2 + row * 16 + 12);
                    const float tot = ((t0[0] + t0[1]) + (t0[2] + t0[3])) + ((t1[0] + t1[1]) + (t1[2] + t1[3])) + ((t2[0] + t2[1]) + (t2[2] + t2[3])) + ((t3[0] + t3[1]) + (t3[2] + t3[3]));
                    const float rs = rsqrtf(tot * (1.f / DM) + EPS);
#pragma unroll
                    for (int bj = 0; bj < 2; ++bj) *(u32x4*)(G + row * DFF + u.pn * 256 + bj * 128 + cl0) = pack8(acc[ai][bj][m][0] * rs, acc[ai][bj][m][1] * rs); }
        } break;
        case EK_UPACT: {
            bf16_t* A = (bf16_t*)p0; const float* rs2 = (const float*)c0; const bf16_t* G = (const bf16_t*)c1; const float* cw = (const float*)c2; const float* cbv = (const float*)p1;
            u32x4 upk[2][4][2];
#pragma unroll
            for (int ai = 0; ai < 2; ++ai)
#pragma unroll
                for (int m = 0; m < 4; ++m) { const float rs = rs2[rbase + ai * 128 + m * 16];
#pragma unroll
                    for (int bj = 0; bj < 2; ++bj) upk[ai][m][bj] = pack8(acc[ai][bj][m][0] * rs, acc[ai][bj][m][1] * rs); }
            asm volatile("" ::: "memory");
#pragma unroll
            for (int bj = 0; bj < 2; ++bj) { const int j0 = u.pn * 256 + bj * 128 + cl0;
                float w0[8], w1[8], w2[8], bb[8];
#pragma unroll
                for (int i = 0; i < 2; ++i) { const f32x4 a0 = *(const f32x4*)(cw + j0 + 4 * i), a1 = *(const f32x4*)(cw + DFF + j0 + 4 * i), a2 = *(const f32x4*)(cw + 2 * DFF + j0 + 4 * i), a3 = *(const f32x4*)(cbv + j0 + 4 * i);
#pragma unroll
                    for (int q = 0; q < 4; ++q) { w0[4 * i + q] = a0[q]; w1[4 * i + q] = a1[q]; w2[4 * i + q] = a2[q]; bb[4 * i + q] = a3[q]; } }
#pragma unroll
                for (int ai = 0; ai < 2; ++ai)
#pragma unroll
                    for (int m = 0; m < 4; ++m) { const int row = rbase + ai * 128 + m * 16; const int ts = row & 2047; const size_t off = (size_t)row * DFF + j0;
                        const u32x4 g0 = *(const u32x4*)(G + off);
                        u32x4 g1 = *(const u32x4*)(G + off - (ts >= 1 ? DFF : 0));
                        u32x4 g2 = *(const u32x4*)(G + off - (ts >= 2 ? 2 * DFF : 0));
                        const unsigned k1 = ts >= 1 ? 0xffffffffu : 0u, k2 = ts >= 2 ? 0xffffffffu : 0u;
                        g1 = g1 & k1; g2 = g2 & k2;
                        const u32x4 uu = upk[ai][m][bj];
                        float r[8];
#pragma unroll
                        for (int q = 0; q < 4; ++q) { const unsigned a2 = g2[q], a1 = g1[q], a0 = g0[q], u0 = uu[q];
                            const float z0 = bb[2 * q] + w0[2 * q] * bflo(a2) + w1[2 * q] * bflo(a1) + w2[2 * q] * bflo(a0);
                            const float z1 = bb[2 * q + 1] + w0[2 * q + 1] * bfhi(a2) + w1[2 * q + 1] * bfhi(a1) + w2[2 * q + 1] * bfhi(a0);
                            r[2 * q] = z0 * sigm(z0) * bflo(u0); r[2 * q + 1] = z1 * sigm(z1) * bfhi(u0); }
                        u32x4 o; o.x = pk2(r[0], r[1]); o.y = pk2(r[2], r[3]); o.z = pk2(r[4], r[5]); o.w = pk2(r[6], r[7]);
                        *(u32x4*)(A + off) = o;
                        if ((m & 1) == 1) asm volatile("" ::: "memory"); } }
        } break;
        default: break;
        }
    }
};

namespace attn_body {
using bf16=__hip_bfloat16;
using s16x4=__attribute__((ext_vector_type(4)))short;
using f32x16=__attribute__((ext_vector_type(16)))float;
constexpr int NHEAD=NFH,D=64,ADM=NHEAD*D;
constexpr int NW=8,QBLK=32,QB=QBLK*NW,KVBLK=64,NQB=SEQ/QB;
__device__ __forceinline__ int crow(int r,int hi){return (r&3)+8*(r>>2)+4*hi;}
#define SBAR() __builtin_amdgcn_sched_barrier(0)
__device__ __forceinline__ void cmask(f32x16&p0,f32x16&p1,int jb,int qrel,int hi){
  const float NEG=-INFINITY; int kb=64*jb+4*hi;
  #pragma unroll
  for(int r=0;r<16;++r){int kv=kb+(r&3)+8*(r>>2); if(kv>qrel)p0[r]=NEG; if(kv+32>qrel)p1[r]=NEG;}
}
constexpr int NSLOT=3, SLOTB=8192;
constexpr int LDS_K=0, LDS_V=NSLOT*SLOTB, LDS_WS=2*NSLOT*SLOTB, LDS_OST=LDS_WS+NW*64*4, LDS_BYTES=LDS_OST+NW*4096;
constexpr int LDS_BIAS=86016;
__device__ __forceinline__ void glds16(const void*gsrc,unsigned lds_dst){unsigned keep;
  asm volatile("s_mov_b32 %0, m0\n\ts_mov_b32 m0, %2\n\ts_nop 0\n\tglobal_load_lds_dwordx4 %1, off\n\ts_mov_b32 m0, %0":"=&s"(keep):"v"(gsrc),"s"(lds_dst):"memory");}
__device__ __forceinline__ float max3f(float a,float b,float c){float r;asm("v_max3_f32 %0, %1, %2, %3":"=v"(r):"v"(a),"v"(b),"v"(c));return r;}
__device__ __forceinline__ float max2f(float a,float b){float r;asm("v_max_f32_e32 %0, %1, %2":"=v"(r):"v"(a),"v"(b));return r;}
__device__ __forceinline__ float fadd_s(float a,float b){float r;asm("v_add_f32_e32 %0, %1, %2":"=v"(r):"v"(a),"v"(b));return r;}
__device__ __forceinline__ float fsub_s(float a,float b){float r;asm("v_sub_f32_e32 %0, %1, %2":"=v"(r):"v"(a),"v"(b));return r;}
typedef float f32x2_t __attribute__((ext_vector_type(2))); typedef __bf16 bf16x2_t __attribute__((ext_vector_type(2)));
__device__ __forceinline__ unsigned cvtpk_s(float lo,float hi){f32x2_t v={lo,hi};bf16x2_t b=__builtin_convertvector(v,bf16x2_t);return __builtin_bit_cast(unsigned,b);}
#define WAIT_BAR(N) asm volatile("s_waitcnt vmcnt(" #N ") lgkmcnt(0)\n\ts_barrier":::"memory")

__device__ __forceinline__ void qkt(f32x16&p0,f32x16&p1,const char*Kslot,const bf16x8*qr,const f32x16&negm,int r32,int hi){
  const char*kb=Kslot+hi*1024+r32*16;
  #pragma unroll
  for(int d0=0;d0<4;++d0){
    const bf16x8 b0=*reinterpret_cast<const bf16x8*>(kb+d0*2048);
    const bf16x8 b1=*reinterpret_cast<const bf16x8*>(kb+d0*2048+512);
    if(d0==0){p0=__builtin_amdgcn_mfma_f32_32x32x16_bf16(b0,qr[0],negm,0,0,0);p1=__builtin_amdgcn_mfma_f32_32x32x16_bf16(b1,qr[0],negm,0,0,0);}
    else{p0=__builtin_amdgcn_mfma_f32_32x32x16_bf16(b0,qr[d0],p0,0,0,0);p1=__builtin_amdgcn_mfma_f32_32x32x16_bf16(b1,qr[d0],p1,0,0,0);}}
}
typedef __attribute__((address_space(3))) const char* lds_cptr;
typedef short v4i16_t __attribute__((ext_vector_type(4)));
__device__ __forceinline__ void kload8(bf16x8*kf,lds_cptr kp){
  kf[0]=*(const __attribute__((address_space(3))) bf16x8*)(kp);      kf[1]=*(const __attribute__((address_space(3))) bf16x8*)(kp+512);
  kf[2]=*(const __attribute__((address_space(3))) bf16x8*)(kp+2048); kf[3]=*(const __attribute__((address_space(3))) bf16x8*)(kp+2560);
  kf[4]=*(const __attribute__((address_space(3))) bf16x8*)(kp+4096); kf[5]=*(const __attribute__((address_space(3))) bf16x8*)(kp+4608);
  kf[6]=*(const __attribute__((address_space(3))) bf16x8*)(kp+6144); kf[7]=*(const __attribute__((address_space(3))) bf16x8*)(kp+6656);
}
__device__ __forceinline__ void kload2(bf16x8*kf,lds_cptr kp,int j){ kf[2*j]=*(const __attribute__((address_space(3))) bf16x8*)(kp+j*2048); kf[2*j+1]=*(const __attribute__((address_space(3))) bf16x8*)(kp+j*2048+512); }
__device__ __forceinline__ s16x4 vtr(lds_cptr p){ return __builtin_bit_cast(s16x4,__builtin_amdgcn_ds_read_tr16_b64_v4i16((__attribute__((address_space(3))) v4i16_t*)p)); }
__device__ __forceinline__ float rowmax(const f32x16&p0,const f32x16&p1){
  float a=max3f(p0[0],p0[1],p1[0]),b=max3f(p0[2],p0[3],p1[1]);a=max3f(a,p1[2],p1[3]);
  #pragma unroll
  for(int r=4;r<16;r+=4){a=max3f(a,p0[r],p0[r+1]);b=max3f(b,p0[r+2],p0[r+3]);a=max3f(a,p1[r],p1[r+1]);b=max3f(b,p1[r+2],p1[r+3]);}
  const float m=max2f(a,b);
  auto rr=__builtin_amdgcn_permlane32_swap(__float_as_uint(m),__float_as_uint(m),false,false);
  return max2f(__uint_as_float(rr[0]),__uint_as_float(rr[1]));
}
__device__ __forceinline__ void pv(f32x16*o,int vb,bf16x8 pa0,bf16x8 pa1,bf16x8 pa2,bf16x8 pa3){
  #pragma unroll
  for(int d0=0;d0<2;++d0){s16x4 lo[4],hi[4];
    #pragma unroll
    for(int ks=0;ks<4;++ks){
      asm volatile("ds_read_b64_tr_b16 %0,%1 offset:%c2":"=&v"(lo[ks]):"v"(vb),"i"(d0*4096+ks*1024):"memory");
      asm volatile("ds_read_b64_tr_b16 %0,%1 offset:%c2":"=&v"(hi[ks]):"v"(vb),"i"(d0*4096+ks*1024+512):"memory");}
    asm volatile("s_waitcnt lgkmcnt(0)":::"memory");SBAR();
    #define PK(k) (bf16x8){lo[k][0],lo[k][1],lo[k][2],lo[k][3],hi[k][0],hi[k][1],hi[k][2],hi[k][3]}
    o[d0]=__builtin_amdgcn_mfma_f32_32x32x16_bf16(pa0,PK(0),o[d0],0,0,0);
    o[d0]=__builtin_amdgcn_mfma_f32_32x32x16_bf16(pa1,PK(1),o[d0],0,0,0);
    o[d0]=__builtin_amdgcn_mfma_f32_32x32x16_bf16(pa2,PK(2),o[d0],0,0,0);
    o[d0]=__builtin_amdgcn_mfma_f32_32x32x16_bf16(pa3,PK(3),o[d0],0,0,0);
    #undef PK
  }
}
typedef const __attribute__((address_space(3))) f32x4* lds_f4ptr;
#define BIASADD(P0,P1,t) do{ const lds_f4ptr bp_=(lds_f4ptr)(shm3+LDS_BIAS+((t)*64+4*hi)*4); \
    _Pragma("unroll") for(int j_=0;j_<4;++j_){ const f32x4 b0_=bp_[2*j_]-mhat, b1_=bp_[8+2*j_]-mhat; \
      P0[4*j_]+=b0_[0]; P0[4*j_+1]+=b0_[1]; P0[4*j_+2]+=b0_[2]; P0[4*j_+3]+=b0_[3]; \
      P1[4*j_]+=b1_[0]; P1[4*j_+1]+=b1_[1]; P1[4*j_+2]+=b1_[2]; P1[4*j_+3]+=b1_[3]; } }while(0)

template<int THRL> __device__ __forceinline__ void attn_unit(int b,int h,int qb,const bf16*Q,const bf16*__restrict__ K,const bf16*__restrict__ V,bf16*O,const float*__restrict__ CB,float*__restrict__ SSQ,char*shm){
  int tid=threadIdx.x; asm volatile("":"+v"(tid));
  const int lane=tid&63,r32=lane&31,hi=lane>>5; const int wid=__builtin_amdgcn_readfirstlane(tid>>6);
  const long rowbase=(long)b*SEQ; const int q0=qb*QB;
  const bf16*Qw=Q+(rowbase+q0+wid*QBLK)*ADM+h*D;
  const bf16*Kh=K+rowbase*ADM+h*D,*Vh=V+rowbase*ADM+h*D;
  const unsigned lds0=(unsigned)(uintptr_t)shm;
  float*wsf=(float*)(shm+LDS_WS)+wid*64;
  const lds_cptr shm3=(lds_cptr)shm;
  { const float*cbh=CB+(long)(b*NHEAD+h)*SEQ; const float cref=cbh[q0+128];
    if(tid*4<q0+QB){ const f32x4 c4=*(const f32x4*)(cbh+tid*4); *(__attribute__((address_space(3))) f32x4*)(shm3+LDS_BIAS+tid*16)=(f32x4){cref-c4[0],cref-c4[1],cref-c4[2],cref-c4[3]}; } }
  const bf16*ksrc=Kh+(long)lane*ADM+wid*8;
  const bf16*vsrc=Vh+(long)(16*(wid&3)+(lane>>2))*ADM+(wid>>2)*32+(lane&3)*8;
  const unsigned kdst=lds0+LDS_K+wid*1024, vdst=lds0+LDS_V+wid*1024;
  #define DMA_K(t,slot) glds16(ksrc+(long)(t)*KVBLK*ADM,(unsigned)__builtin_amdgcn_readfirstlane(kdst+(slot)))
  #define DMA_V(t,slot) glds16(vsrc+(long)(t)*KVBLK*ADM,(unsigned)__builtin_amdgcn_readfirstlane(vdst+(slot)))
  const int vb0=(int)(lds0+LDS_V)+((lane>>4)&1)*32+(lane&3)*8+(4*hi+((lane&15)>>2))*64;
  const char*Kbase=shm+LDS_K; bf16x8 kf[8];
  const lds_cptr kp0=shm3+LDS_K+hi*1024+r32*16; const lds_cptr vp0=shm3+LDS_V+((lane>>4)&1)*32+(lane&3)*8+(4*hi+((lane&15)>>2))*64;
  const int NT=(q0+QB)/KVBLK;
  DMA_K(0,0);DMA_V(0,0);DMA_K(1,SLOTB);
  bf16x8 qr[4];
  #pragma unroll
  for(int d0=0;d0<4;++d0)qr[d0]=*reinterpret_cast<const bf16x8*>(&Qw[(long)r32*ADM+d0*16+hi*8]);
  float mhat=0.f,l_reg=0.f;f32x16 o[2];o[0]=f32x16{};o[1]=f32x16{};const f32x16 negm=f32x16{};
  const int qrel=wid*QBLK+r32;
  #define CMASK(P0,P1,t) do{int jb_=(t)-(NT-4); if(jb_>=0)cmask(P0,P1,jb_,qrel,hi);}while(0)
  bool resc=false;
  #define START(P0,P1) do{ const float rm=rowmax(P0,P1); resc=false; \
    { const float dl=max2f(rm,-24.f); mhat=fadd_s(mhat,dl); \
      _Pragma("unroll") for(int r=0;r<16;++r){P0[r]=fsub_s(P0[r],dl);P1[r]=fsub_s(P1[r],dl);} } \
    _Pragma("unroll") for(int r=0;r<16;++r)P0[r]=__builtin_amdgcn_exp2f(P0[r]); }while(0)
  #define RESC() do{ if(resc){ asm volatile("s_waitcnt lgkmcnt(0)":::"memory"); \
      _Pragma("unroll") for(int d_=0;d_<2;++d_) _Pragma("unroll") for(int r=0;r<16;++r)o[d_][r]*=wsf[crow(r,hi)]; } }while(0)
  f32x16 pA0,pA1,pB0,pB1;
  int sl_prev=0,sl_cur=0,sl_next=SLOTB;
  #define ROT() do{sl_prev=sl_cur;sl_cur=sl_next;sl_next=(sl_next==(NSLOT-1)*SLOTB)?0:sl_next+SLOTB;}while(0)
  DMA_K(2,2*SLOTB);
  WAIT_BAR(3);
  qkt(pA0,pA1,Kbase,qr,negm,r32,hi);asm volatile("s_nop 15\n\ts_nop 7":"+v"(pA0),"+v"(pA1));BIASADD(pA0,pA1,0);CMASK(pA0,pA1,0);
  START(pA0,pA1);
  _Pragma("unroll") for(int r=0;r<16;++r)pA1[r]=__builtin_amdgcn_exp2f(pA1[r]);
  WAIT_BAR(0);
  DMA_K(3,0);DMA_V(1,SLOTB);
  ROT();
  kload8(kf,kp0+sl_cur);
  WAIT_BAR(2);
  s16x4 vlo[8],vhi[8]; u32x4 pw0,pw1,pw2,pw3;
  #define PKW(P,B) cvtpk_s(P[B],P[B+1])
  #define PAF(k) __builtin_bit_cast(bf16x8,pw##k)
  #define VFR(i) (bf16x8){vlo[i][0],vlo[i][1],vlo[i][2],vlo[i][3],vhi[i][0],vhi[i][1],vhi[i][2],vhi[i][3]}
  #define PIN(x) asm volatile("":"+v"(x))
  #define MX3(a,b,c) __builtin_fmaxf(__builtin_fmaxf((a),(b)),(c))
  #define GAPA(MF,A0,A1,A2,A3,W0,W1,PW) do{ MF; sacc+=A0; sacc+=A1; sacc+=A2; sacc+=A3; PIN(sacc); W0; W1; PIN(PW); SBAR(); }while(0)
  #define EX(v) __builtin_amdgcn_exp2f(v)
  #define GAPB(MF,X,B) do{ MF; X[B]=EX(X[B]); X[B+1]=EX(X[B+1]); X[B+2]=EX(X[B+2]); X[B+3]=EX(X[B+3]); PIN(X); SBAR(); }while(0)
  #define VRD(i) do{ vlo[i]=vtr(vp_+(((i)>>2)*4096+((i)&3)*1024)); vhi[i]=vtr(vp_+(((i)>>2)*4096+((i)&3)*1024+512)); }while(0)
  #define KRD(G,j) do{ if(G){ kload2(kf,kp0+sl_next,j); SBAR(); } }while(0)
  #define STEP(C0,C1,P0,P1,t,GK,GV,GL) do{ SBAR(); \
    const lds_cptr vp_=vp0+sl_prev; \
    VRD(0); SBAR(); float sacc=(P0[0]+P0[1]); \
    GAPA(C0=__builtin_amdgcn_mfma_f32_32x32x16_bf16(kf[0],qr[0],negm,0,0,0), P0[2],P0[3],P0[4],P0[5],     pw0[0]=PKW(P0,0), pw0[1]=PKW(P0,2), pw0); \
    VRD(4); SBAR(); GAPA(C1=__builtin_amdgcn_mfma_f32_32x32x16_bf16(kf[1],qr[0],negm,0,0,0), P0[6],P0[7],P0[8],P0[9],     pw0[2]=PKW(P0,4), pw0[3]=PKW(P0,6), pw0); \
    VRD(1); SBAR(); GAPA(C0=__builtin_amdgcn_mfma_f32_32x32x16_bf16(kf[2],qr[1],C0,0,0,0),   P0[10],P0[11],P0[12],P0[13], pw1[0]=PKW(P0,8), pw1[1]=PKW(P0,10), pw1); \
    VRD(5); SBAR(); GAPA(C1=__builtin_amdgcn_mfma_f32_32x32x16_bf16(kf[3],qr[1],C1,0,0,0),   P0[14],P0[15],P1[0],P1[1],   pw1[2]=PKW(P0,12),pw1[3]=PKW(P0,14), pw1); \
    VRD(2); SBAR(); GAPA(C0=__builtin_amdgcn_mfma_f32_32x32x16_bf16(kf[4],qr[2],C0,0,0,0),   P1[2],P1[3],P1[4],P1[5],     pw2[0]=PKW(P1,0), pw2[1]=PKW(P1,2), pw2); \
    VRD(6); SBAR(); GAPA(C1=__builtin_amdgcn_mfma_f32_32x32x16_bf16(kf[5],qr[2],C1,0,0,0),   P1[6],P1[7],P1[8],P1[9],     pw2[2]=PKW(P1,4), pw2[3]=PKW(P1,6), pw2); \
    VRD(3); SBAR(); GAPA(C0=__builtin_amdgcn_mfma_f32_32x32x16_bf16(kf[6],qr[3],C0,0,0,0),   P1[10],P1[11],P1[12],P1[13], pw3[0]=PKW(P1,8), pw3[1]=PKW(P1,10), pw3); \
    VRD(7); SBAR(); GAPA(C1=__builtin_amdgcn_mfma_f32_32x32x16_bf16(kf[7],qr[3],C1,0,0,0),   P1[14],P1[15],0.f,0.f,       pw3[2]=PKW(P1,12),pw3[3]=PKW(P1,14), pw3); \
    l_reg+=sacc; \
    if(GK){DMA_K((t)+3,sl_cur);} if(GV){DMA_V((t)+1,sl_next);} \
    BIASADD(C0,C1,t); \
    CMASK(C0,C1,t); \
    { float a=MX3(C0[0],C0[1],C1[0]),b=MX3(C0[2],C0[3],C1[1]); a=MX3(a,C1[2],C1[3]); \
      _Pragma("unroll") for(int r=4;r<16;r+=4){a=MX3(a,C0[r],C0[r+1]);b=MX3(b,C0[r+2],C0[r+3]);a=MX3(a,C1[r],C1[r+1]);b=MX3(b,C1[r+2],C1[r+3]);} \
      float rm=__builtin_fmaxf(a,b); { auto rr=__builtin_amdgcn_permlane32_swap(__float_as_uint(rm),__float_as_uint(rm),false,false); rm=__builtin_fmaxf(__uint_as_float(rr[0]),__uint_as_float(rr[1])); } \
      resc=false; \
      if(__builtin_expect(__any(rm>(float)THRL),0)){ const float dl=__builtin_fmaxf(rm,0.f); mhat+=dl; \
        _Pragma("unroll") for(int r=0;r<16;++r){C0[r]-=dl;C1[r]-=dl;} \
        const float f=__builtin_amdgcn_exp2f(-dl); l_reg*=f; if(hi==0)wsf[r32]=f; resc=true; } } \
    SBAR(); \
    GAPB(o[0]=__builtin_amdgcn_mfma_f32_32x32x16_bf16(PAF(0),VFR(0),o[0],0,0,0), C0,0); \
    GAPB(o[1]=__builtin_amdgcn_mfma_f32_32x32x16_bf16(PAF(0),VFR(4),o[1],0,0,0), C0,4); \
    KRD(GL,0); GAPB(o[0]=__builtin_amdgcn_mfma_f32_32x32x16_bf16(PAF(1),VFR(1),o[0],0,0,0), C0,8); \
    KRD(GL,1); GAPB(o[1]=__builtin_amdgcn_mfma_f32_32x32x16_bf16(PAF(1),VFR(5),o[1],0,0,0), C0,12); \
    KRD(GL,2); GAPB(o[0]=__builtin_amdgcn_mfma_f32_32x32x16_bf16(PAF(2),VFR(2),o[0],0,0,0), C1,0); \
    KRD(GL,3); GAPB(o[1]=__builtin_amdgcn_mfma_f32_32x32x16_bf16(PAF(2),VFR(6),o[1],0,0,0), C1,4); \
    GAPB(o[0]=__builtin_amdgcn_mfma_f32_32x32x16_bf16(PAF(3),VFR(3),o[0],0,0,0), C1,8); \
    GAPB(o[1]=__builtin_amdgcn_mfma_f32_32x32x16_bf16(PAF(3),VFR(7),o[1],0,0,0), C1,12); \
    }while(0)
  int t=1;
  #undef CMASK
  #define CMASK(P0,P1,t) do{}while(0)
  for(;t+5<NT;t+=2){
    STEP(pB0,pB1,pA0,pA1,t,true,true,true);     WAIT_BAR(2); RESC(); ROT();
    STEP(pA0,pA1,pB0,pB1,t+1,true,true,true);   WAIT_BAR(2); RESC(); ROT();
  }
  #undef CMASK
  #define CMASK(P0,P1,t) do{int jb_=(t)-(NT-4); if(jb_>=0)cmask(P0,P1,jb_,qrel,hi);}while(0)
  #define ENDW(tt) do{ if((tt)+3<NT){WAIT_BAR(2);} else if((tt)+2<NT){WAIT_BAR(1);} else {WAIT_BAR(0);} }while(0)
  for(;t+1<NT;t+=2){
    STEP(pB0,pB1,pA0,pA1,t,(t+3<NT),(t+1<NT),(t+1<NT));       ENDW(t);   RESC(); ROT();
    STEP(pA0,pA1,pB0,pB1,t+1,(t+4<NT),(t+2<NT),(t+2<NT));     ENDW(t+1); RESC(); ROT();
  }
  STEP(pB0,pB1,pA0,pA1,NT-1,false,false,false); RESC();
  { float sacc=pB0[0]+pB0[1]; _Pragma("unroll") for(int r=2;r<16;++r)sacc+=pB0[r]; _Pragma("unroll") for(int r=0;r<16;++r)sacc+=pB1[r]; l_reg+=sacc;
    pw0=(u32x4){PKW(pB0,0),PKW(pB0,2),PKW(pB0,4),PKW(pB0,6)};pw1=(u32x4){PKW(pB0,8),PKW(pB0,10),PKW(pB0,12),PKW(pB0,14)};pw2=(u32x4){PKW(pB1,0),PKW(pB1,2),PKW(pB1,4),PKW(pB1,6)};pw3=(u32x4){PKW(pB1,8),PKW(pB1,10),PKW(pB1,12),PKW(pB1,14)};
    SBAR(); pv(o,vb0+sl_cur,PAF(0),PAF(1),PAF(2),PAF(3)); }
  #undef PKW
  #undef PAF
  #undef VFR
  #undef PIN
  #undef MX3
  #undef GAPA
  #undef GAPB
  #undef EX
  #undef VRD
  #undef KRD
  #undef STEP
  #undef ENDW
  {auto rr=__builtin_amdgcn_permlane32_swap(__float_as_uint(l_reg),__float_as_uint(l_reg),false,false);l_reg=__uint_as_float(rr[0])+__uint_as_float(rr[1]);}
  if(hi==0)wsf[32+r32]=l_reg;asm volatile("s_waitcnt lgkmcnt(0)":::"memory");
  float rli[16];
  #pragma unroll
  for(int r=0;r<16;++r)rli[r]=__builtin_amdgcn_rcpf(wsf[32+crow(r,hi)]);
  int lane2=lane; asm volatile("":"+v"(lane2));
  bf16*Ow=O+(rowbase+q0+wid*QBLK)*ADM+h*D;
  { bf16*stg=(bf16*)(shm+LDS_OST)+wid*2048;
    #pragma unroll
    for(int r=0;r<16;++r){const int orow=crow(r,hi);
      #pragma unroll
      for(int d0=0;d0<2;++d0)stg[orow*64+d0*32+r32]=__float2bfloat16(o[d0][r]*rli[r]);}
    asm volatile("s_waitcnt lgkmcnt(0)":::"memory");
    #pragma unroll
    for(int i=0;i<4;++i){const int row=i*8+(lane2>>3),ch=lane2&7; const u32x4 v=*(const u32x4*)(stg+row*64+ch*8); *(u32x4*)(Ow+(long)row*ADM+ch*8)=v;
      float s=(bflo(v.x)*bflo(v.x)+bfhi(v.x)*bfhi(v.x))+(bflo(v.y)*bflo(v.y)+bfhi(v.y)*bfhi(v.y))+(bflo(v.z)*bflo(v.z)+bfhi(v.z)*bfhi(v.z))+(bflo(v.w)*bflo(v.w)+bfhi(v.w)*bfhi(v.w));
      s+=__shfl_xor(s,1); s+=__shfl_xor(s,2); s+=__shfl_xor(s,4);
      if(ch==0)SSQ[(rowbase+q0+wid*QBLK+row)*NHEAD+h]=s; } }
  asm volatile("s_waitcnt lgkmcnt(0)\n\ts_barrier":::"memory");
  #undef DMA_K
  #undef DMA_V
  #undef CMASK
  #undef START
  #undef RESC
  #undef ROT
}
#undef SBAR
#undef WAIT_BAR
}

constexpr int RING_BYTES = 131072;
constexpr int LDS_TOTAL = 147456;
struct Args { const float* in[32]; float* out; unsigned char* ws; };
typedef const float* const __attribute__((address_space(4)))* InTab;
enum In { I_X = 0, I_MEM, I_NORM_MIX, I_W_IN, I_FQN, I_FKN, I_FBIAS, I_ARE, I_AIM, I_LOGDT, I_BRE, I_BIM, I_CRE, I_CIM, I_D, I_WGLU, I_BGLU, I_ONF, I_ONS, I_WOUT,
          I_NCROSS, I_NMEM, I_WXQ, I_WXKV, I_XQN, I_XKN, I_WXO, I_NFFN, I_WUP, I_CONVW, I_CONVB, I_WDN };

struct TJob { const float* W; int ldw, col0, ncols, K; const float* kg; const float* kg2; bf16_t* WT; int mapid, rowoff, items; };
__device__ __forceinline__ int tmap(int mapid, int n, int rowoff) {
    if (mapid == 1) { const int part = n >> 9, f = n & 511, head = f >> 6, d = f & 63; return 512 * part + 256 * (head >> 2) + 128 * (d >> 5) + 32 * (head & 3) + (d & 31); }
    if (mapid == 2) { const int isup = n >= DFF ? 1 : 0; const int j = n - isup * DFF; return 256 * (j >> 7) + 128 * isup + (j & 127); }
    return rowoff + n;
}
__device__ __forceinline__ void transpose_item(const TJob& J, LAS float* scr, int item, int lane) {
    const int nblk = J.ncols / 32, kb = item / nblk, nb = item % nblk, k0 = 64 * kb, n0 = 32 * nb;
#pragma unroll 16
    for (int i = 0; i < 32; ++i) { const int kk = 2 * i + (lane >> 5); float w = J.W[(size_t)(k0 + kk) * J.ldw + J.col0 + n0 + (lane & 31)];
        if (J.kg) { const int k = k0 + kk; w *= (J.kg2 && k >= 512) ? J.kg2[k - 512] : J.kg[k]; }
        scr[kk * 33 + (lane & 31)] = w; }
    asm volatile("s_waitcnt lgkmcnt(0)" ::: "memory");
    const int c = lane & 7;
#pragma unroll
    for (int j = 0; j < 4; ++j) { const int n = (lane >> 3) + 8 * j; const LAS float* s = scr + (8 * c) * 33 + n;
        u32x4 o; o.x = pk2(s[0 * 33], s[1 * 33]); o.y = pk2(s[2 * 33], s[3 * 33]); o.z = pk2(s[4 * 33], s[5 * 33]); o.w = pk2(s[6 * 33], s[7 * 33]);
        *(u32x4*)(J.WT + (size_t)tmap(J.mapid, n0 + n, J.rowoff) * J.K + k0 + 8 * c) = o; }
    asm volatile("s_waitcnt lgkmcnt(0)" ::: "memory");
}
constexpr int NTJ = 11;
__device__ __forceinline__ void get_tjob(InTab in, unsigned char* ws, int j, TJob& J) {
    J.kg = nullptr; J.kg2 = nullptr; J.mapid = 0; J.rowoff = 0; J.col0 = 0;
    switch (j) {
    case 0: J.W = in[I_W_IN]; J.ldw = INCOLS; J.col0 = 0; J.ncols = 1024; J.K = 1024; J.WT = (bf16_t*)(ws + WS_WIN); J.mapid = 1; break;
    case 1: J.W = in[I_W_IN]; J.ldw = INCOLS; J.col0 = 1024; J.ncols = 512; J.K = 1024; J.WT = (bf16_t*)(ws + WS_WIN); J.rowoff = 1024; break;
    case 2: J.W = in[I_W_IN]; J.ldw = INCOLS; J.col0 = 1544; J.ncols = 512; J.K = 1024; J.WT = (bf16_t*)(ws + WS_WIN); J.rowoff = 1536; break;
    case 3: J.W = in[I_WGLU]; J.ldw = 512; J.ncols = 512; J.K = 512; J.WT = (bf16_t*)(ws + WS_WGLU); break;
    case 4: J.W = in[I_WOUT]; J.ldw = 1024; J.ncols = 1024; J.K = 1024; J.WT = (bf16_t*)(ws + WS_WOUT); J.kg = in[I_ONF]; J.kg2 = in[I_ONS]; break;
    case 5: J.W = in[I_WXQ]; J.ldw = 1024; J.ncols = 1024; J.K = 1024; J.WT = (bf16_t*)(ws + WS_WXQ); J.kg = in[I_NCROSS]; break;
    case 6: J.W = in[I_WXKV]; J.ldw = 2048; J.col0 = 0; J.ncols = 1024; J.K = 1024; J.WT = (bf16_t*)(ws + WS_WXK); break;
    case 7: J.W = in[I_WXKV]; J.ldw = 2048; J.col0 = 1024; J.ncols = 1024; J.K = 1024; J.WT = (bf16_t*)(ws + WS_WXV); break;
    case 8: J.W = in[I_WXO]; J.ldw = 1024; J.ncols = 1024; J.K = 1024; J.WT = (bf16_t*)(ws + WS_WXO); break;
    case 9: J.W = in[I_WUP]; J.ldw = 2 * DFF; J.ncols = 2 * DFF; J.K = 1024; J.WT = (bf16_t*)(ws + WS_WUP); J.kg = in[I_NFFN]; break;
    default: J.W = in[I_WDN]; J.ldw = 1024; J.ncols = 1024; J.K = DFF; J.WT = (bf16_t*)(ws + WS_WDN); break;
    }
    J.items = (J.K / 64) * (J.ncols / 32);
}

__device__ __forceinline__ void rms_row(const float* xrow, const float* gain, bf16_t* orow, int lane, f32x4 (&v)[4]) {
    const f32x4* xr = (const f32x4*)xrow + lane; float s = 0.f;
#pragma unroll
    for (int j = 0; j < 4; ++j) { v[j] = xr[64 * j]; s += (v[j][0] * v[j][0] + v[j][1] * v[j][1]) + (v[j][2] * v[j][2] + v[j][3] * v[j][3]); }
    const float rs = rsqrtf(wave_sum(s) * (1.f / DM) + EPS);
    u32x2* o8 = (u32x2*)orow + lane;
#pragma unroll
    for (int j = 0; j < 4; ++j) { v[j] = v[j] * rs * ((const f32x4*)gain)[64 * j + lane]; u32x2 w; w.x = pk2(v[j][0], v[j][1]); w.y = pk2(v[j][2], v[j][3]); o8[64 * j] = w; }
}

__device__ __forceinline__ void cpow(float ar, float ai, float dt, float e, float& r, float& i) {
    const float mag = __expf(ar * dt * e);
    float rev = ai * dt * e * 0.15915494309189535f; rev -= rintf(rev);
    const float ang = rev * 6.283185307179586f;
    r = mag * cosf(ang); i = mag * sinf(ang);
}

__device__ __forceinline__ void s5_prep_task(InTab in, unsigned char* ws, int g, int tt, LAS float* L, int tid) {
    LAS float* pwA = L; LAS float* pwB = L + 128; LAS float* pwC = L + 256; LAS float* cf = L + 384; LAS float* bb = L + 512; LAS float* cc = L + 512 + 2048;
    const float dt = __expf(in[I_LOGDT][g]);
    if (tid < 64) { const int p = tid; const float ar = in[I_ARE][g * 64 + p], ai = in[I_AIM][g * 64 + p];
        float r, i; cpow(ar, ai, dt, (float)tt, r, i); pwA[2 * p] = r; pwA[2 * p + 1] = i;
        cpow(ar, ai, dt, (float)(tt + 1), r, i); pwB[2 * p] = r; pwB[2 * p + 1] = i;
        cpow(ar, ai, dt, (float)(TC - 1 - tt), r, i); pwC[2 * p] = r; pwC[2 * p + 1] = i;
        float lr, li; cpow(ar, ai, dt, 1.f, lr, li);
        const float den = ar * ar + ai * ai, nr = lr - 1.f;
        cf[2 * p] = (nr * ar + li * ai) / den; cf[2 * p + 1] = (li * ar - nr * ai) / den;
        if (tt == 0) { cpow(ar, ai, dt, (float)TC, r, i); float* lb = (float*)(ws + WS_LB32); lb[(g * 64 + p) * 2] = r; lb[(g * 64 + p) * 2 + 1] = i; } }
    for (int idx = tid; idx < 1024; idx += 512) { cc[2 * idx] = in[I_CRE][g * 1024 + idx]; cc[2 * idx + 1] = in[I_CIM][g * 1024 + idx]; }
    __syncthreads();
    for (int idx = tid; idx < 1024; idx += 512) { const int p = idx >> 4; const float br = in[I_BRE][g * 1024 + idx], bi = in[I_BIM][g * 1024 + idx], cr = cf[2 * p], ci = cf[2 * p + 1];
        bb[2 * idx] = cr * br - ci * bi; bb[2 * idx + 1] = cr * bi + ci * br; }
    __syncthreads();
    if (tid < 256) {
        const int c = tid >> 4, cp = tid & 15; float s = 0.f;
        for (int p = 0; p < 64; ++p) { const float pr = pwA[2 * p], pi = pwA[2 * p + 1], br = bb[2 * (p * 16 + cp)], bi = bb[2 * (p * 16 + cp) + 1];
            const float mr = pr * br - pi * bi, mi = pr * bi + pi * br; s += cc[2 * (c * 64 + p)] * mr - cc[2 * (c * 64 + p) + 1] * mi; }
        if (tt == 0 && c == cp) s += in[I_D][g * 16 + c];
        ((float*)(ws + WS_KTAB))[((g * TC + tt) * 16 + c) * 16 + cp] = s;
    } else {
        const int u = tid - 256;
        bf16_t* bty = (bf16_t*)(ws + WS_BTY) + (size_t)g * 512 * UGP; bf16_t* bte = (bf16_t*)(ws + WS_BTE) + (size_t)g * 256 * 512;
        for (int idx = u; idx < 1024; idx += 256) { const int c = idx >> 6, p = idx & 63;
            const float cr = cc[2 * idx], ci = cc[2 * idx + 1], pr = pwB[2 * p], pi = pwB[2 * p + 1];
            const float zr = cr * pr - ci * pi, zi = cr * pi + ci * pr;
            *(unsigned*)(bty + (size_t)(tt * 16 + c) * UGP + 512 + 2 * p) = pk2(zr, -zi); }
        for (int idx = u; idx < 1024; idx += 256) { const int p = idx >> 4, cp = idx & 15;
            const float pr = pwC[2 * p], pi = pwC[2 * p + 1], br = bb[2 * idx], bi = bb[2 * idx + 1];
            bte[(size_t)(2 * p) * 512 + tt * 16 + cp] = (bf16_t)f2bf(pr * br - pi * bi); bte[(size_t)(2 * p + 1) * 512 + tt * 16 + cp] = (bf16_t)f2bf(pr * bi + pi * br); }
        *(u32x4*)(bte + (size_t)(128 + (u >> 1)) * 512 + tt * 16 + (u & 1) * 8) = (u32x4){0u, 0u, 0u, 0u};
    }
    __syncthreads();
}

#define RLX_AGENT __ATOMIC_RELAXED, __HIP_MEMORY_SCOPE_AGENT
#define XB_TMO      128
#define XB_XCNT(j)  (256  + 64 * (j))
#define XB_XSUB(j)  (1280 + 64 * (j))
#define XB_XGEN(j)  (2304 + 64 * (j))
#define XB_TOP      3328
#define XB_TOPGEN   3392
#define XCD_BAR_WORDS 3456
#define XB_SPIN_CAP (1u << 18)

__device__ __forceinline__ unsigned xb_ld(unsigned* p)              { return __hip_atomic_load(p, __ATOMIC_RELAXED, __HIP_MEMORY_SCOPE_AGENT); }
__device__ __forceinline__ unsigned xb_add(unsigned* p, unsigned v) { return __hip_atomic_fetch_add(p, v, __ATOMIC_RELAXED, __HIP_MEMORY_SCOPE_AGENT); }
__device__ __forceinline__ unsigned xb_xcc_id() { return (unsigned)__builtin_amdgcn_s_getreg((3 << 11) | 20) & 0xFu; }
#define XB_SPIN(cond, bar) do { unsigned _sp = 0; while (cond) { __builtin_amdgcn_s_sleep(1); \
    if ((++_sp & 255u) == 0u) { if (xb_ld(&(bar)[XB_TMO])) break; if (_sp > XB_SPIN_CAP) { atomicAdd(&(bar)[XB_TMO], 1u); break; } } } } while (0)

struct XcdBarrier {
    unsigned* bar; unsigned x;
    volatile LAS unsigned* st;
};

__device__ __forceinline__ XcdBarrier xcd_barrier_post(unsigned* bar, volatile LAS unsigned* st) {
    XcdBarrier b; b.bar = bar; b.x = xb_xcc_id(); b.st = st;
    if (threadIdx.x == 0) (void)xb_add(&bar[XB_XCNT(b.x)], 1u);
    return b;
}
__device__ __forceinline__ void xcd_barrier_complete(unsigned* bar, unsigned x, unsigned& nloc, unsigned& nx) {
    const unsigned G = gridDim.x * gridDim.y * gridDim.z;
    unsigned sum, cnt, mine, sp = 0u;
    for (;;) {
        sum = 0u; cnt = 0u; mine = 0u;
#pragma unroll
        for (unsigned j = 0; j < 16; ++j) { const unsigned c = xb_ld(&bar[XB_XCNT(j)]); sum += c; cnt += (c > 0u) ? 1u : 0u; mine = (j == x) ? c : mine; }
        if (sum == G) break;
        __builtin_amdgcn_s_sleep(1);
        if ((++sp & 255u) == 0u) { if (xb_ld(&bar[XB_TMO])) break; if (sp > XB_SPIN_CAP) { atomicAdd(&bar[XB_TMO], 1u); break; } }
    }
    nloc = mine > 0u ? mine : 1u; nx = cnt > 0u ? cnt : 1u;
}

__device__ __forceinline__ void xcd_barrier(const XcdBarrier& b) {
    asm volatile("s_waitcnt vmcnt(0)" ::: "memory");
    __syncthreads();
    if (threadIdx.x == 0) {
        unsigned* bar = b.bar;
        __builtin_amdgcn_s_waitcnt(0);
        unsigned nloc = b.st[0], nx = b.st[1];
        if (nloc == 0u) { xcd_barrier_complete(bar, b.x, nloc, nx); b.st[0] = nloc; b.st[1] = nx; }
        const unsigned old = xb_add(&bar[XB_XSUB(b.x)], 1u);
        const unsigned gen = old / nloc;
        if (old + 1u == (gen + 1u) * nloc) {
            __builtin_amdgcn_fence(__ATOMIC_RELEASE, "agent");
            asm volatile("s_waitcnt vmcnt(0)" ::: "memory");
            const unsigned og = xb_add(&bar[XB_TOP], 1u);
            const unsigned tg = og / nx;
            if (og + 1u == (tg + 1u) * nx) xb_add(&bar[XB_TOPGEN], 1u);
            else XB_SPIN(xb_ld(&bar[XB_TOPGEN]) == tg, bar);
            __builtin_amdgcn_fence(__ATOMIC_ACQUIRE, "agent");
            xb_add(&bar[XB_XGEN(b.x)], 1u);
            asm volatile("s_waitcnt vmcnt(0)" ::: "memory");
        } else {
            XB_SPIN(xb_ld(&bar[XB_XGEN(b.x)]) == gen, bar);
            __builtin_amdgcn_fence(__ATOMIC_ACQUIRE, "agent");
            asm volatile("s_waitcnt vmcnt(0)" ::: "memory");
        }
    }
    __syncthreads();
}


#ifndef FIRST_STEP
#define FIRST_STEP 0
#endif
#ifndef LAST_STEP
#define LAST_STEP 18
#endif
#define ON(n) (FIRST_STEP <= (n) && (n) <= LAST_STEP)
#define SYNC(n) do { if ((n) < LAST_STEP) { XcdBarrier bar_; bar_.bar = (unsigned*)ws; bar_.x = xb_xcc_id(); bar_.st = (volatile LAS unsigned*)(L + RING_BYTES + 352); xcd_barrier(bar_); } } while (0)
#define WSB(off) ((const bf16_t*)(ws + (off)))
__global__ void __launch_bounds__(512, 2) fox_s5_mega(Args a) {
    extern __shared__ __attribute__((aligned(16))) unsigned char lds[];
    LAS unsigned char* L = (LAS unsigned char*)lds;
    const int G = gridDim.x, bx = blockIdx.x, NGW = G * 8, NGT = G * 512;
#define KA const __attribute__((address_space(4))) unsigned char* ka_ = (const __attribute__((address_space(4))) unsigned char*)__builtin_amdgcn_kernarg_segment_ptr(); asm volatile("" : "+s"(ka_)); \
    InTab in = (InTab)ka_; float* out = *(float* const __attribute__((address_space(4)))*)(ka_ + 256); unsigned char* ws = *(unsigned char* const __attribute__((address_space(4)))*)(ka_ + 264); (void)in; (void)out;
#define IDS int tid = threadIdx.x; asm volatile("" : "+v"(tid)); const int lane = tid & 63, wave = __builtin_amdgcn_readfirstlane(tid >> 6); const int gw = bx * 8 + wave, gt = bx * 512 + tid; (void)lane; (void)gw; (void)gt;
    {
        KA
        if (threadIdx.x < 8) ((volatile LAS unsigned*)(L + RING_BYTES + 320))[threadIdx.x + 8 - 8] = 0u;
        if (threadIdx.x < 2) ((volatile LAS unsigned*)(L + RING_BYTES + 352))[threadIdx.x] = 0u;
        __syncthreads();
        (void)xcd_barrier_post((unsigned*)ws, (volatile LAS unsigned*)(L + RING_BYTES + 352));
    }

    if (ON(0)) {
        KA
        IDS
        LAS float* scr = (LAS float*)(L + wave * 16384);
        { int base = 0;
          for (int j = 0; j < NTJ; ++j) { TJob J; get_tjob(in, ws, j, J);
              int first = gw - (base % NGW); if (first < 0) first += NGW;
              for (int it = first; it < J.items; it += NGW) transpose_item(J, scr, it, lane);
              base += J.items; } }
        __syncthreads();
        LAS float* wf = (LAS float*)L;
        for (int idx = tid; idx < 8192; idx += 512) wf[idx] = in[I_W_IN][(size_t)(idx >> 3) * INCOLS + 1536 + (idx & 7)];
        __syncthreads();
        {
            f32x4 nx[4];
            if (gw < T) { const f32x4* xr = (const f32x4*)(in[I_X] + (size_t)gw * DM) + lane;
#pragma unroll
                for (int j = 0; j < 4; ++j) nx[j] = xr[64 * j]; }
            const f32x4* gp = (const f32x4*)in[I_NORM_MIX]; f32x4 gn[4];
#pragma unroll
            for (int j = 0; j < 4; ++j) gn[j] = gp[64 * j + lane];
            const float fbias = in[I_FBIAS][lane & 7];
            for (int m = gw; m < T; m += NGW) {
                f32x4 v[4]; float s = 0.f;
#pragma unroll
                for (int j = 0; j < 4; ++j) { v[j] = nx[j]; s += (v[j][0] * v[j][0] + v[j][1] * v[j][1]) + (v[j][2] * v[j][2] + v[j][3] * v[j][3]); }
                if (m + NGW < T) { const f32x4* xr = (const f32x4*)(in[I_X] + (size_t)(m + NGW) * DM) + lane;
#pragma unroll
                    for (int j = 0; j < 4; ++j) nx[j] = xr[64 * j]; }
                const float rs = rsqrtf(wave_sum(s) * (1.f / DM) + EPS);
                u32x2* o8 = (u32x2*)((bf16_t*)(ws + WS_HN) + (size_t)m * DM) + lane;
#pragma unroll
                for (int j = 0; j < 4; ++j) { v[j] = v[j] * rs * gn[j]; u32x2 w; w.x = pk2(v[j][0], v[j][1]); w.y = pk2(v[j][2], v[j][3]); o8[64 * j] = w; }
                float d[8];
#pragma unroll
                for (int h = 0; h < 8; ++h) d[h] = 0.f;
#pragma unroll
                for (int j = 0; j < 4; ++j)
#pragma unroll
                    for (int i = 0; i < 4; ++i) { const int k = 256 * j + 4 * lane + i; const f32x4 w0 = *(const LAS f32x4*)(wf + k * 8), w1 = *(const LAS f32x4*)(wf + k * 8 + 4);
                        d[0] += v[j][i] * w0[0]; d[1] += v[j][i] * w0[1]; d[2] += v[j][i] * w0[2]; d[3] += v[j][i] * w0[3];
                        d[4] += v[j][i] * w1[0]; d[5] += v[j][i] * w1[1]; d[6] += v[j][i] * w1[2]; d[7] += v[j][i] * w1[3]; }
                float e4[4];
#pragma unroll
                for (int h = 0; h < 4; ++h) { const float keep = (lane & 4) ? d[h + 4] : d[h], give = (lane & 4) ? d[h] : d[h + 4]; e4[h] = keep + __shfl_xor(give, 4); }
                float e2[2];
#pragma unroll
                for (int h = 0; h < 2; ++h) { const float keep = (lane & 2) ? e4[h + 2] : e4[h], give = (lane & 2) ? e4[h] : e4[h + 2]; e2[h] = keep + __shfl_xor(give, 2); }
                float z; { const float keep = (lane & 1) ? e2[1] : e2[0], give = (lane & 1) ? e2[0] : e2[1]; z = keep + __shfl_xor(give, 1); }
                z += __shfl_xor(z, 8); z += __shfl_xor(z, 16); z += __shfl_xor(z, 32);
                if (lane < 8) {
                    z += fbias;
                    const float ls = fminf(z, 0.f) - __logf(1.f + __expf(-fabsf(z)));
                    const int b = m >> 11, t = m & 2047;
                    ((float*)(ws + WS_LOGF))[(size_t)(b * 8 + lane) * SEQ + t] = ls; }
            }
        }
        for (int m = gw; m < TM; m += NGW) { f32x4 v[4]; rms_row(in[I_MEM] + (size_t)m * DM, in[I_NMEM], (bf16_t*)(ws + WS_MN) + (size_t)m * DM, lane, v); }
        __syncthreads();
        for (int task = bx; task < S5G * TC; task += G) { const int per = (S5G * TC) / G; const int t2 = ((S5G * TC) % G == 0) ? (task % G) * per + task / G : task;
            s5_prep_task(in, ws, t2 / TC, t2 % TC, (LAS float*)L, tid); }
        SYNC(0);
    }
    if (ON(1)) {
        KA
        IDS
        const float* kt = (const float*)(ws + WS_KTAB); bf16_t* bty = (bf16_t*)(ws + WS_BTY);
        for (int idx = gt; idx < S5G * 512 * 64; idx += NGT) {
            const int half = idx & 1, ss = (idx >> 1) & 31, nn = (idx >> 6) & 511, gI = idx >> 15; const int tt = nn >> 4, c = nn & 15;
            u32x4 w = (u32x4){0u, 0u, 0u, 0u};
            if (ss <= tt) { const float* src = kt + ((size_t)((gI * TC + (tt - ss)) * 16 + c)) * 16 + half * 8; const f32x4 k0 = *(const f32x4*)src, k1 = *(const f32x4*)(src + 4);
                w.x = pk2(k0[0], k0[1]); w.y = pk2(k0[2], k0[3]); w.z = pk2(k1[0], k1[1]); w.w = pk2(k1[2], k1[3]); }
            *(u32x4*)(bty + ((size_t)gI * 512 + nn) * UGP + ss * 16 + half * 8) = w; }
        if (wave == 0 && bx < BATCH * NFH) {
            const float* lf = (const float*)(ws + WS_LOGF) + (size_t)bx * SEQ + lane * 32; float* cb = (float*)(ws + WS_CB) + (size_t)bx * SEQ + lane * 32;
            f32x4 x[8]; float run = 0.f;
#pragma unroll
            for (int j = 0; j < 8; ++j) { x[j] = ((const f32x4*)lf)[j]; x[j][0] += run; x[j][1] += x[j][0]; x[j][2] += x[j][1]; x[j][3] += x[j][2]; run = x[j][3]; }
            float incl = run;
#pragma unroll
            for (int o = 1; o < 64; o <<= 1) { const float y = __shfl_up(incl, o); if (lane >= o) incl += y; }
            const float excl = incl - run;
#pragma unroll
            for (int j = 0; j < 8; ++j) ((f32x4*)cb)[j] = (x[j] + excl) * LOG2E;
        }
    }
    if (ON(2)) {
        KA
        pg8::Gemm g{WSB(WS_HN), WSB(WS_WIN), DM, DM, DM}; GOrder<OK_PLAIN> S; S.init(T / 256, 8, G, bx, DM, DM);
        Epi<EK_PROJ> E{ws + WS_Q, ws + WS_K, ws + WS_V, ws + WS_UG, in[I_FQN], in[I_FKN], nullptr};
        pg8::gemm_phase(L, g, S, E);
    }
    if (ON(3)) {
        KA
        pg8::Gemm g{WSB(WS_MN), WSB(WS_WXK), DM, DM, DM}; GOrder<OK_PLAIN> S; S.init(TM / 256, 4, G, bx, DM, DM);
        Epi<EK_MEMK> E{ws + WS_KST, ws + WS_SSQK, nullptr, nullptr, nullptr, nullptr, nullptr};
        pg8::gemm_phase(L, g, S, E);
    }
    if (ON(4)) {
        KA
        pg8::Gemm g{WSB(WS_WXV), WSB(WS_MN), DM, DM, DM}; GOrder<OK_PLAIN> S; S.init(4, TM / 256, G, (bx + 128) % G, DM, DM);
        Epi<EK_MEMVT> E{ws + WS_VT, nullptr, nullptr, nullptr, nullptr, nullptr, nullptr};
        pg8::gemm_phase(L, g, S, E);
        SYNC(4);
    }
    if (ON(5)) {
        KA
        const int vcu = (G % 8 == 0) ? (bx % 8) * (G / 8) + bx / 8 : bx;
        for (int L2 = vcu; L2 < BATCH * NFH * 2; L2 += G) { const int bh = L2 >> 1, s = L2 & 1;
            for (int i = 0; i < 4; ++i) { const int qb = (i == 0) ? s : (i == 1) ? 3 - s : (i == 2) ? 4 + s : 7 - s;
                attn_body::attn_unit<8>(bh >> 3, bh & 7, qb, (const attn_body::bf16*)(ws + WS_Q), (const attn_body::bf16*)(ws + WS_K), (const attn_body::bf16*)(ws + WS_V),
                                        (attn_body::bf16*)(ws + WS_FOX), (const float*)(ws + WS_CB), (float*)(ws + WS_SSQF), (char*)lds); } }
    }
    if (ON(6)) {
        KA
        pg8::Gemm g{WSB(WS_UG), WSB(WS_BTE), UGP, 512, 256}; GOrder<OK_S5E> S; S.init(256, 1, G, bx, UGP, 512);
        Epi<EK_S5E> E{ws + WS_EPART, nullptr, nullptr, nullptr, nullptr, nullptr, nullptr};
        pg8::gemm_phase(L, g, S, E);
        SYNC(6);
    }
    if (ON(7)) {
        KA
        IDS
        const float* ep = (const float*)(ws + WS_EPART); const float* lb = (const float*)(ws + WS_LB32); bf16_t* ug = (bf16_t*)(ws + WS_UG);
        for (int idx = gt; idx < S5G * BATCH * S5P; idx += NGT) { const int p = idx & 63, gb = idx >> 6, gI = gb >> 4;
            const float lr = lb[(gI * 64 + p) * 2], li = lb[(gI * 64 + p) * 2 + 1]; float sr = 0.f, si = 0.f;
            for (int k0 = 0; k0 < NCH; k0 += 16) {
                f32x2 e0[16], e1[16];
#pragma unroll
                for (int j = 0; j < 16; ++j) { const size_t row = (size_t)gb * NCH + k0 + j; e0[j] = *(const f32x2*)(ep + row * 128 + 2 * p); e1[j] = *(const f32x2*)(ep + (size_t)32768 * 128 + row * 128 + 2 * p); }
#pragma unroll
                for (int j = 0; j < 16; ++j) { const size_t row = (size_t)gb * NCH + k0 + j;
                    *(unsigned*)(ug + row * UGP + 512 + 2 * p) = pk2(sr, si);
                    const float nr = lr * sr - li * si + (e0[j][0] + e1[j][0]), ni = lr * si + li * sr + (e0[j][1] + e1[j][1]); sr = nr; si = ni; } } }
        SYNC(7);
    }
    if (ON(8)) {
        KA
        pg8::Gemm g{WSB(WS_UG), WSB(WS_BTY), UGP, UGP, UGP}; GOrder<OK_S5Y> S; S.init(256, 1, G, bx, UGP, UGP);
        Epi<EK_S5Y> E{ws + WS_Y1, nullptr, nullptr, nullptr, nullptr, nullptr, nullptr};
        pg8::gemm_phase(L, g, S, E);
        SYNC(8);
    }
    if (ON(9)) {
        KA
        pg8::Gemm g{WSB(WS_Y1), WSB(WS_WGLU), 512, 512, 512}; GOrder<OK_PLAIN> S; S.init(T / 256, 2, G, bx, 512, 512);
        Epi<EK_GLU> E{ws + WS_Y2, ws + WS_SSQY, nullptr, nullptr, ws + WS_Y1, in[I_BGLU], nullptr};
        pg8::gemm_phase(L, g, S, E);
        SYNC(9);
    }
    if (ON(10)) {
        KA
        IDS
        const float* sf = (const float*)(ws + WS_SSQF); const float* sy = (const float*)(ws + WS_SSQY);
        const bf16_t* fox = WSB(WS_FOX); const bf16_t* y2 = WSB(WS_Y2); bf16_t* mx = (bf16_t*)(ws + WS_MIXN);
        {
            f32x4 a0, a1, b0, b1; u32x4 f, y;
#define NRM_LOAD(mm) do { a0 = *(const f32x4*)(sf + (size_t)(mm) * 8); a1 = *(const f32x4*)(sf + (size_t)(mm) * 8 + 4); b0 = *(const f32x4*)(sy + (size_t)(mm) * 8); b1 = *(const f32x4*)(sy + (size_t)(mm) * 8 + 4); \
                f = *(const u32x4*)(fox + (size_t)(mm) * 512 + lane * 8); y = *(const u32x4*)(y2 + (size_t)(mm) * 512 + lane * 8); } while (0)
            if (gw < T) NRM_LOAD(gw);
            for (int m = gw; m < T; m += NGW) {
                const float rf = rsqrtf((((a0[0] + a0[1]) + (a0[2] + a0[3])) + ((a1[0] + a1[1]) + (a1[2] + a1[3]))) * (1.f / 512.f) + EPS);
                const float ry = rsqrtf((((b0[0] + b0[1]) + (b0[2] + b0[3])) + ((b1[0] + b1[1]) + (b1[2] + b1[3]))) * (1.f / 512.f) + EPS);
                u32x4 of, oy;
                of.x = pk2(bflo(f.x) * rf, bfhi(f.x) * rf); of.y = pk2(bflo(f.y) * rf, bfhi(f.y) * rf); of.z = pk2(bflo(f.z) * rf, bfhi(f.z) * rf); of.w = pk2(bflo(f.w) * rf, bfhi(f.w) * rf);
                oy.x = pk2(bflo(y.x) * ry, bfhi(y.x) * ry); oy.y = pk2(bflo(y.y) * ry, bfhi(y.y) * ry); oy.z = pk2(bflo(y.z) * ry, bfhi(y.z) * ry); oy.w = pk2(bflo(y.w) * ry, bfhi(y.w) * ry);
                if (m + NGW < T) NRM_LOAD(m + NGW);
                *(u32x4*)(mx + (size_t)m * DM + lane * 8) = of; *(u32x4*)(mx + (size_t)m * DM + 512 + lane * 8) = oy; }
#undef NRM_LOAD
        }
        SYNC(10);
    }
    if (ON(11)) {
        KA
        pg8::Gemm g{WSB(WS_MIXN), WSB(WS_WOUT), DM, DM, DM}; GOrder<OK_PLAIN> S; S.init(T / 256, 4, G, bx, DM, DM);
        Epi<EK_WOUT> E{out, ws + WS_H1B, ws + WS_SSQ1, nullptr, in[I_X], nullptr, nullptr};
        pg8::gemm_phase(L, g, S, E);
        SYNC(11);
    }
    if (ON(12)) {
        KA
        IDS
        const float* sk = (const float*)(ws + WS_SSQK); float* sck = (float*)(ws + WS_SCK);
        for (int idx = gt; idx < TM * 4; idx += NGT) { const int key = idx >> 2, h = idx & 3; const f32x4 q = *(const f32x4*)(sk + (size_t)key * 16 + h * 4);
            sck[(size_t)h * TM + key] = rsqrtf(((q[0] + q[1]) + (q[2] + q[3])) * (1.f / 256.f) + EPS); }
        pg8::Gemm g{WSB(WS_H1B), WSB(WS_WXQ), DM, DM, DM}; GOrder<OK_PLAIN> S; S.init(T / 256, 4, G, bx, DM, DM);
        Epi<EK_XQ> E{ws + WS_QST, ws + WS_SSQQ, nullptr, nullptr, in[I_XQN], in[I_XKN], nullptr};
        pg8::gemm_phase(L, g, S, E);
        SYNC(12);
    }
    if (ON(13)) {
        KA
        pg8::Gemm g{WSB(WS_QST), WSB(WS_KST), DM, DM, 256}; GOrder<OK_XS> S; S.init(512, 1, G, bx, DM, DM);
        Epi<EK_XS> E{ws + WS_P, ws + WS_PSUM, nullptr, nullptr, ws + WS_SSQ1, ws + WS_SSQQ, ws + WS_SCK};
        pg8::gemm_phase(L, g, S, E);
        SYNC(13);
    }
    if (ON(14)) {
        KA
        pg8::Gemm g{WSB(WS_P), WSB(WS_VT), DM, TM, 256}; GOrder<OK_XO> S; S.init(512, 1, G, bx, DM, TM);
        Epi<EK_XO> E{ws + WS_XO, nullptr, nullptr, nullptr, ws + WS_PSUM, nullptr, nullptr};
        pg8::gemm_phase(L, g, S, E);
        SYNC(14);
    }
    if (ON(15)) {
        KA
        pg8::Gemm g{WSB(WS_XO), WSB(WS_WXO), DM, DM, DM}; GOrder<OK_PLAIN> S; S.init(T / 256, 4, G, bx, DM, DM);
        Epi<EK_WXO> E{out, ws + WS_H2B, ws + WS_SSQ2, nullptr, out, nullptr, nullptr};
        pg8::gemm_phase(L, g, S, E);
        SYNC(15);
    }
    if (ON(16)) {
        KA
        { IDS
          const float* s2 = (const float*)(ws + WS_SSQ2); float* r2 = (float*)(ws + WS_RS2);
          for (int row = gt; row < T; row += NGT) { const f32x4 t0 = *(const f32x4*)(s2 + (size_t)row * 16), t1 = *(const f32x4*)(s2 + (size_t)row * 16 + 4), t2 = *(const f32x4*)(s2 + (size_t)row * 16 + 8), t3 = *(const f32x4*)(s2 + (size_t)row * 16 + 12);
              r2[row] = rsqrtf((((t0[0] + t0[1]) + (t0[2] + t0[3])) + ((t1[0] + t1[1]) + (t1[2] + t1[3])) + ((t2[0] + t2[1]) + (t2[2] + t2[3])) + ((t3[0] + t3[1]) + (t3[2] + t3[3]))) * (1.f / DM) + EPS); } }
        pg8::Gemm g{WSB(WS_H2B), WSB(WS_WUP), DM, DM, DM}; GOrder<OK_PLAIN> S; S.init(T / 256, 11, G, bx, DM, DM);
        Epi<EK_GATE> E{ws + WS_G, nullptr, nullptr, nullptr, ws + WS_SSQ2, nullptr, nullptr};
        pg8::gemm_phase(L, g, S, E);
        SYNC(16);
    }
    if (ON(17)) {
        KA
        pg8::Gemm g{WSB(WS_H2B), WSB(WS_WUP) + (size_t)DFF * DM, DM, DM, DM}; GOrder<OK_PLAIN> S; S.init(T / 256, 11, G, bx, DM, DM);
        Epi<EK_UPACT> E{ws + WS_U, (void*)in[I_CONVB], nullptr, nullptr, ws + WS_RS2, ws + WS_G, in[I_CONVW]};
        pg8::gemm_phase(L, g, S, E);
        SYNC(17);
    }
    if (ON(18)) {
        KA
        pg8::Gemm g{WSB(WS_U), WSB(WS_WDN), DFF, DFF, DFF}; GOrder<OK_PLAIN> S; S.init(T / 256, 4, G, bx, DFF, DFF);
        Epi<EK_DOWN> E{out, nullptr, nullptr, nullptr, nullptr, nullptr, nullptr};
        pg8::gemm_phase(L, g, S, E);
    }
}

extern "C" void kernel_launch(void* const* d_in, const int* in_sizes, int n_in, void* d_out, int out_size, void* d_ws, size_t ws_size, hipStream_t stream) {
    static int grid = 0;
    if (grid == 0) {
        if (n_in != 32 || out_size != T * DM || ws_size < WS_END) { fprintf(stderr, "kernel_launch: unexpected shapes (n_in %d out %d ws %zu)\n", n_in, out_size, ws_size); grid = -1; return; }
        int dev = 0, cus = 0, per_cu = 0;
        (void)hipGetDevice(&dev); (void)hipDeviceGetAttribute(&cus, hipDeviceAttributeMultiprocessorCount, dev);
        if (hipFuncSetAttribute((const void*)fox_s5_mega, hipFuncAttributeMaxDynamicSharedMemorySize, LDS_TOTAL) != hipSuccess) { fprintf(stderr, "kernel_launch: hipFuncSetAttribute failed\n"); grid = -1; return; }
        if (hipOccupancyMaxActiveBlocksPerMultiprocessor(&per_cu, (const void*)fox_s5_mega, 512, LDS_TOTAL) != hipSuccess || per_cu < 1) { fprintf(stderr, "kernel_launch: occupancy query says %d\n", per_cu); per_cu = 1; }
        (void)hipGetLastError();
        grid = cus;
        if (grid > cus * per_cu) grid = cus * per_cu;
    }
    if (grid < 0) return;
    if (hipMemsetAsync(d_ws, 0, 65536, stream) != hipSuccess) { fprintf(stderr, "kernel_launch: memset of the barrier words failed\n"); return; }
    Args a{};
    for (int i = 0; i < 32; ++i) a.in[i] = (const float*)d_in[i];
    a.out = (float*)d_out; a.ws = (unsigned char*)d_ws;
    void* args[] = {&a};
    hipError_t e = hipLaunchCooperativeKernel((const void*)fox_s5_mega, dim3(grid), dim3(512), args, LDS_TOTAL, stream);
    if (e != hipSuccess) fprintf(stderr, "cooperative launch failed: %s (grid %d)\n", hipGetErrorString(e), grid);
}
```

```cpp
#include <hip/hip_runtime.h>
#include <hip/hip_cooperative_groups.h>
#include <hip/hip_bf16.h>
#include <cstdio>
#include <cstdint>
#include <cmath>
namespace cg = cooperative_groups;

constexpr int BATCH = 16, SEQ = 2048, DM = 1024, T = BATCH * SEQ;
constexpr int NMEM = 256, TM = BATCH * NMEM;
constexpr int FOXW = 512, HD = 64, NFH = 8;
constexpr int S5W = 512, S5G = 32, S5C = 16, S5P = 64;
constexpr int NXH = 4, XHD = 256;
constexpr int DFF = 2816;
constexpr int INCOLS = 2056;
constexpr float EPS = 1e-6f;
constexpr int TC = 32, NCH = SEQ / TC;
constexpr int UGP = TC * 16 + 128;
constexpr float LOG2E = 1.4426950408889634f;
constexpr float C2Q = 0.125f * LOG2E;

#define LAS __attribute__((address_space(3)))
typedef unsigned short bf16_t;
typedef short bf16x8 __attribute__((ext_vector_type(8)));
typedef float f32x4 __attribute__((ext_vector_type(4)));
typedef float f32x2 __attribute__((ext_vector_type(2)));
typedef unsigned u32x4 __attribute__((ext_vector_type(4)));
typedef unsigned u32x2 __attribute__((ext_vector_type(2)));

__device__ __forceinline__ unsigned f2bf(float f) { unsigned u = __builtin_bit_cast(unsigned, f); return (u + 0x7fffu + ((u >> 16) & 1u)) >> 16; }
__device__ __forceinline__ unsigned pk2(float lo, float hi) { return f2bf(lo) | (f2bf(hi) << 16); }
__device__ __forceinline__ float bflo(unsigned w) { return __builtin_bit_cast(float, w << 16); }
__device__ __forceinline__ float bfhi(unsigned w) { return __builtin_bit_cast(float, w & 0xffff0000u); }
__device__ __forceinline__ float wave_sum(float v) {
#pragma unroll
    for (int o = 1; o < 64; o <<= 1) v += __shfl_xor(v, o);
    return v;
}

__device__ __forceinline__ float red_fq(float v) {
    v += __builtin_bit_cast(float, __builtin_amdgcn_ds_swizzle(__builtin_bit_cast(int, v), 0x401F));
    float a = v, b = v;
    asm volatile("s_nop 1\n\tv_permlane32_swap_b32 %0, %1\n\ts_nop 1" : "+v"(a), "+v"(b));
    return a + b;
}

constexpr size_t MiB = 1u << 20;
constexpr size_t WS_WIN = 1 * MiB, WS_WGLU = 5 * MiB, WS_WOUT = 6 * MiB, WS_WXQ = 8 * MiB, WS_WXK = 10 * MiB, WS_WXV = 12 * MiB, WS_WXO = 14 * MiB,
                 WS_WUP = 16 * MiB, WS_WDN = 27 * MiB, WS_BTY = 33 * MiB, WS_BTE = 53 * MiB, WS_KTAB = 61 * MiB, WS_LB32 = 62 * MiB, WS_LOGF = 63 * MiB,
                 WS_CB = 64 * MiB, WS_SSQF = 65 * MiB, WS_SSQY = 66 * MiB, WS_SSQ1 = 67 * MiB, WS_SSQ2 = 69 * MiB, WS_SSQQ = 71 * MiB, WS_PSUM = 73 * MiB,
                 WS_SSQK = 75 * MiB, WS_SCK = 76 * MiB, WS_RS2 = 77 * MiB;
constexpr size_t WS_HN = 80 * MiB, WS_FOX = 80 * MiB, WS_Y1 = 112 * MiB, WS_QST = 80 * MiB, WS_H2B = 80 * MiB;
constexpr size_t WS_MN = 144 * MiB, WS_KST = 152 * MiB, WS_VT = 160 * MiB;
constexpr size_t WS_Q = 168 * MiB, WS_K = 200 * MiB, WS_V = 232 * MiB, WS_Y2 = 168 * MiB, WS_MIXN = 200 * MiB, WS_P = 168 * MiB;
constexpr size_t WS_UG = 264 * MiB, WS_EPART = 304 * MiB, WS_H1B = 264 * MiB, WS_XO = 264 * MiB;
constexpr size_t WS_G = 144 * MiB, WS_U = 320 * MiB, WS_END = 496 * MiB;

namespace pg8 {
constexpr int BM = 256, BK = 64, HALF = 128, HTB = HALF * BK * 2, STAGE_BYTES = 8 * HTB;
__device__ __forceinline__ int lds_byte(int r, int c) { const int st = (r >> 4) * 2 + (c >> 5), rr = r & 15, cc = c & 31, ob = rr * 64 + cc * 2; return st * 1024 + (ob ^ (((ob >> 9) & 1) << 5)); }
__device__ __forceinline__ void stage_rc(int b, int& R, int& C) { const int st = b / 1024, sb = b % 1024, swz = sb ^ (((sb >> 9) & 1) << 5); R = (st >> 1) * 16 + swz / 64; C = (st & 1) * 32 + (swz % 64) / 2; }
__device__ __forceinline__ int perm32(int rho) { const int n = rho >> 4, i = rho & 15; return 8 * (i >> 2) + 4 * n + (i & 3); }

struct Unit { int pm, pn; long offA, offB; };
struct Gemm { const bf16_t* A; const bf16_t* Bt; int lda, ldb, K; };

template <class Epi, class Sched>
__device__ __forceinline__ void gemm_phase(LAS unsigned char* lds, const Gemm g, const Sched& S, const Epi& E) {
    int tid = threadIdx.x; asm volatile("" : "+v"(tid));
    const int wid = __builtin_amdgcn_readfirstlane(tid >> 6), lane = tid & 63, wr = wid >> 2, wc = wid & 3, fr = lane & 15, fq = lane >> 4;
    const int K = g.K, nt = K / BK;
    unsigned voffA[2], voffB[2];
#pragma unroll
    for (int i = 0; i < 2; ++i) { int R, C; stage_rc(tid * 16 + i * 8192, R, C); const int Rb = (R & ~31) + perm32(R & 31);
        voffA[i] = (unsigned)(R * g.lda + C) * 2u; voffB[i] = (unsigned)(Rb * g.ldb + C) * 2u; }
    const size_t kstep = (size_t)(BK * 2);
    const size_t hstepA = (size_t)HALF * g.lda * 2, hstepB = (size_t)HALF * g.ldb * 2;
    const unsigned ldsw = (unsigned)wid * 1024u;
    const int aoff = lds_byte(wr * 64 + fr, fq * 8), boff = lds_byte(wc * 32 + fr, fq * 8);
#define PG8_SA(b, h) (((b) * 2 + (h)) * HTB)
#define PG8_SB(b, h) ((4 + (b) * 2 + (h)) * HTB)
#define PG8_STAGE(bufoff, gbase, voff) do { _Pragma("unroll") for (int _i = 0; _i < 2; ++_i) \
        __builtin_amdgcn_global_load_lds((const unsigned*)((const char*)(gbase) + (voff)[_i]), (LAS unsigned*)(lds + (bufoff) + ldsw + _i * 8192), 16, 0, 0); } while (0)
#define PG8_LDA(dst, b, h) do { _Pragma("unroll") for (int m = 0; m < 4; ++m) _Pragma("unroll") for (int k = 0; k < 2; ++k) dst[m][k] = *(const LAS bf16x8*)(lds + PG8_SA(b, h) + aoff + m * 2048 + k * 1024); } while (0)
#define PG8_LDB(dst, b, h) do { _Pragma("unroll") for (int n = 0; n < 2; ++n) _Pragma("unroll") for (int k = 0; k < 2; ++k) dst[n][k] = *(const LAS bf16x8*)(lds + PG8_SB(b, h) + boff + n * 2048 + k * 1024); } while (0)
#define PG8_MMA(ai, bj, At, Bt) do { __builtin_amdgcn_s_setprio(1); _Pragma("unroll") for (int m = 0; m < 4; ++m) _Pragma("unroll") for (int n = 0; n < 2; ++n) _Pragma("unroll") for (int k = 0; k < 2; ++k) \
        acc[ai][bj][m][n] = __builtin_amdgcn_mfma_f32_16x16x32_bf16(Bt[n][k], At[m][k], acc[ai][bj][m][n], 0, 0, 0); __builtin_amdgcn_s_setprio(0); } while (0)
#define PG8_WAIT_V(n) asm volatile("s_waitcnt vmcnt(" #n ")" ::: "memory")
#define PG8_WAIT_L(n) asm volatile("s_waitcnt lgkmcnt(" #n ")" ::: "memory")
#define PG8_BAR __builtin_amdgcn_s_barrier()
#define PG8_SCHED __builtin_amdgcn_sched_barrier(0)
    Unit cur, nxt; int ui = 0;
    if (!S.next(0, cur)) return;
    f32x4 acc[2][2][4][2];
#pragma unroll
    for (int a = 0; a < 2; ++a)
#pragma unroll
        for (int b = 0; b < 2; ++b)
#pragma unroll
            for (int m = 0; m < 4; ++m)
#pragma unroll
                for (int n = 0; n < 2; ++n) acc[a][b][m][n] = (f32x4){0.f, 0.f, 0.f, 0.f};
    bf16x8 At[4][2], B0[2][2], B1[2][2];
    const char* cA = (const char*)g.A + cur.offA; const char* cB = (const char*)g.Bt + cur.offB;
    PG8_STAGE(PG8_SB(0, 0), cB, voffB); PG8_STAGE(PG8_SB(0, 1), cB + hstepB, voffB); PG8_STAGE(PG8_SA(0, 0), cA, voffA); PG8_STAGE(PG8_SA(0, 1), cA + hstepA, voffA);
    if (wr == 1) PG8_BAR;
    PG8_WAIT_V(2); PG8_BAR;
    PG8_STAGE(PG8_SB(1, 0), cB + kstep, voffB); PG8_STAGE(PG8_SA(1, 0), cA + kstep, voffA); PG8_STAGE(PG8_SB(1, 1), cB + hstepB + kstep, voffB);
    PG8_WAIT_V(6); PG8_BAR;
    for (;;) {
        const bool has_next = S.next(ui + 1, nxt);
        const char* nA = has_next ? (const char*)g.A + nxt.offA : cA; const char* nB = has_next ? (const char*)g.Bt + nxt.offB : cB;
        for (int t = 0; t < nt; t += 2) {
            const bool last = (t == nt - 2);
            const char* a1 = cA + (size_t)(t + 1) * kstep;
            const char* a2 = last ? nA : cA + (size_t)(t + 2) * kstep; const char* b2 = last ? nB : cB + (size_t)(t + 2) * kstep;
            const char* a3 = a2 + kstep; const char* b3 = b2 + kstep;
            PG8_LDB(B0, 0, 0); PG8_LDB(B1, 0, 1); PG8_SCHED; PG8_LDA(At, 0, 0); PG8_STAGE(PG8_SA(1, 1), a1 + hstepA, voffA);
            PG8_WAIT_V(8); PG8_WAIT_L(0); PG8_BAR; PG8_MMA(0, 0, At, B0); PG8_MMA(0, 1, At, B1); PG8_BAR; PG8_SCHED;
            PG8_LDA(At, 0, 1); PG8_STAGE(PG8_SB(0, 0), b2, voffB); PG8_STAGE(PG8_SB(0, 1), b2 + hstepB, voffB); PG8_STAGE(PG8_SA(0, 0), a2, voffA);
            PG8_WAIT_V(8); PG8_WAIT_L(0); PG8_BAR; PG8_MMA(1, 0, At, B0); PG8_MMA(1, 1, At, B1); PG8_BAR; PG8_SCHED;
            PG8_LDB(B0, 1, 0); PG8_LDB(B1, 1, 1); PG8_SCHED; PG8_LDA(At, 1, 0); PG8_STAGE(PG8_SA(0, 1), a2 + hstepA, voffA);
            PG8_WAIT_V(8); PG8_WAIT_L(0); PG8_BAR; PG8_MMA(0, 0, At, B0); PG8_MMA(0, 1, At, B1); PG8_BAR; PG8_SCHED;
            PG8_LDA(At, 1, 1); PG8_STAGE(PG8_SB(1, 0), b3, voffB); PG8_STAGE(PG8_SB(1, 1), b3 + hstepB, voffB); PG8_STAGE(PG8_SA(1, 0), a3, voffA);
            PG8_WAIT_V(8); PG8_WAIT_L(0); PG8_BAR; PG8_MMA(1, 0, At, B0); PG8_MMA(1, 1, At, B1); PG8_BAR; PG8_SCHED;
        }
        if (wr == 0) PG8_BAR;
        { int fr2 = fr, fq2 = fq; asm volatile("" : "+v"(fr2), "+v"(fq2));
          E(acc, cur, wr, wc, fr2, fq2); }
        if (!has_next) break;
#pragma unroll
        for (int a = 0; a < 2; ++a)
#pragma unroll
            for (int b = 0; b < 2; ++b)
#pragma unroll
                for (int m = 0; m < 4; ++m)
#pragma unroll
                    for (int n = 0; n < 2; ++n) acc[a][b][m][n] = (f32x4){0.f, 0.f, 0.f, 0.f};
        cur = nxt; cA = nA; cB = nB; ++ui;
        if (wr == 1) PG8_BAR;
    }
    PG8_WAIT_V(0);
    PG8_BAR;
#undef PG8_SA
#undef PG8_SB
#undef PG8_STAGE
#undef PG8_LDA
#undef PG8_LDB
#undef PG8_MMA
#undef PG8_WAIT_V
#undef PG8_WAIT_L
#undef PG8_BAR
#undef PG8_SCHED
}
}
using pg8::Unit;

enum OrderKind { OK_PLAIN = 0, OK_S5E, OK_S5Y, OK_XS, OK_XO };
template <int kind> struct GOrder {
    int nM, nN, nwg, G, c, lda, ldb;
    __device__ __forceinline__ void init(int nM_, int nN_, int G_, int c_, int lda_, int ldb_) { nM = nM_; nN = nN_; nwg = nM_ * nN_; G = G_; c = c_; lda = lda_; ldb = ldb_; }
    __device__ __forceinline__ bool next(int i, Unit& u) const {
        const long L = (long)i * G + c; if (L >= nwg) return false;
        const int l = (int)L;
        if constexpr (kind == OK_PLAIN) {
            int wgid = l; { const int q = nwg / 8, r = nwg % 8, xcd = wgid % 8, off = wgid / 8; wgid = (xcd < r ? xcd * (q + 1) : r * (q + 1) + (xcd - r) * q) + off; }
            const int nig = 8 * nN, gid = wgid / nig, fm = gid * 8, gsz = (nM - fm) < 8 ? (nM - fm) : 8;
            u.pm = fm + ((wgid % nig) % gsz); u.pn = (wgid % nig) / gsz;
            u.offA = (long)u.pm * 256 * lda * 2; u.offB = (long)u.pn * 256 * ldb * 2;
        } else if constexpr (kind == OK_S5E) {
            const int kq = l & 1, pmm = (l >> 1) & 3, gg = l >> 3;
            u.pm = gg * 4 + pmm; u.pn = kq;
            u.offA = ((long)u.pm * 256 * UGP + kq * 256) * 2; u.offB = ((long)gg * 256 * 512 + kq * 256) * 2;
        } else if constexpr (kind == OK_S5Y) {
            const int pn = l & 1, pmm = (l >> 1) & 3, gg = l >> 3;
            u.pm = gg * 4 + pmm; u.pn = pn;
            u.offA = (long)u.pm * 256 * UGP * 2; u.offB = ((long)gg * 512 + pn * 256) * UGP * 2;
        } else if constexpr (kind == OK_XS) {
            const int h = l & 3, pm = l >> 2, b = pm >> 3;
            u.pm = pm; u.pn = h;
            u.offA = ((long)pm * 256 * DM + h * 256) * 2; u.offB = ((long)b * 256 * DM + h * 256) * 2;
        } else {
            const int h = l & 3, pm = l >> 2, b = pm >> 3;
            u.pm = pm; u.pn = h;
            u.offA = ((long)pm * 256 * DM + h * 256) * 2; u.offB = ((long)h * 256 * TM + b * 256) * 2;
        }
        return true;
    }
};

enum EpiKind { EK_PROJ = 0, EK_MEMK, EK_MEMVT, EK_S5E, EK_S5Y, EK_GLU, EK_WOUT, EK_XQ, EK_XS, EK_XO, EK_WXO, EK_UP, EK_DOWN, EK_GATE, EK_UPACT, EK_UPC };
    __device__ __forceinline__ u32x4 pack8(const f32x4 a, const f32x4 b) { u32x4 w; w.x = pk2(a[0], a[1]); w.y = pk2(a[2], a[3]); w.z = pk2(b[0], b[1]); w.w = pk2(b[2], b[3]); return w; }
    __device__ __forceinline__ float gelu_t(float y) { const float z = 0.7978845608028654f * (y + 0.044715f * y * y * y); const float e = __expf(2.f * z); const float th = 1.f - 2.f / (e + 1.f); return 0.5f * y * (1.f + th); }
    __device__ __forceinline__ float sigm(float z) { return 1.f / (1.f + __expf(-z)); }
    __device__ __forceinline__ float ssq8(const f32x4 a, const f32x4 b) { return (a[0] * a[0] + a[1] * a[1]) + (a[2] * a[2] + a[3] * a[3]) + (b[0] * b[0] + b[1] * b[1]) + (b[2] * b[2] + b[3] * b[3]); }

template <int kind> struct Epi {
    void* p0; void* p1; void* p2; void* p3; const void* c0; const void* c1; const void* c2; LAS float* hx;
    __device__ __forceinline__ void operator()(const f32x4 (&acc)[2][2][4][2], const Unit& u, int wr, int wc, int fr, int fq) const {
        const int rbase = u.pm * 256 + wr * 64 + fr;
        const int cl0 = wc * 32 + 8 * fq;
        switch (kind) {
        case EK_PROJ: {
            const int pn = u.pn;
            if (pn < 4) {
                const bool isq = pn < 2; bf16_t* dst = (bf16_t*)(isq ? p0 : p1); const float* gptr = (const float*)(isq ? c0 : c1); const float post = isq ? C2Q : 1.f;
                const int head = 4 * (pn & 1) + wc;
#pragma unroll
                for (int ai = 0; ai < 2; ++ai)
#pragma unroll
                    for (int m = 0; m < 4; ++m) {
                        float ss = ssq8(acc[ai][0][m][0], acc[ai][0][m][1]) + ssq8(acc[ai][1][m][0], acc[ai][1][m][1]);
                        ss = red_fq(ss);
                        const float sc = rsqrtf(ss * (1.f / 64.f) + EPS) * post;
                        const size_t row = (size_t)(rbase + ai * 128 + m * 16);
#pragma unroll
                        for (int bj = 0; bj < 2; ++bj)
                            *(u32x4*)(dst + row * 512 + head * 64 + 32 * bj + 8 * fq) = pack8(acc[ai][bj][m][0] * sc * *(const f32x4*)(gptr + 32 * bj + 8 * fq), acc[ai][bj][m][1] * sc * *(const f32x4*)(gptr + 32 * bj + 8 * fq + 4));
                    }
            } else if (pn < 6) {
                bf16_t* dst = (bf16_t*)p2;
#pragma unroll
                for (int ai = 0; ai < 2; ++ai)
#pragma unroll
                    for (int m = 0; m < 4; ++m) { const size_t row = (size_t)(rbase + ai * 128 + m * 16);
#pragma unroll
                        for (int bj = 0; bj < 2; ++bj) *(u32x4*)(dst + row * 512 + (pn - 4) * 256 + bj * 128 + cl0) = pack8(acc[ai][bj][m][0], acc[ai][bj][m][1]); }
            } else {
                bf16_t* dst = (bf16_t*)p3;
#pragma unroll
                for (int ai = 0; ai < 2; ++ai)
#pragma unroll
                    for (int m = 0; m < 4; ++m) { const int row = rbase + ai * 128 + m * 16; const int b = row >> 11, t = row & 2047, ch = t >> 5, s = t & 31;
#pragma unroll
                        for (int bj = 0; bj < 2; ++bj) { const int f = (pn - 6) * 256 + bj * 128 + cl0; const int gI = f >> 4, cc = f & 15;
                            *(u32x4*)(dst + ((size_t)(gI * 1024 + b * 64 + ch)) * UGP + s * 16 + cc) = pack8(acc[ai][bj][m][0], acc[ai][bj][m][1]); } }
            }
        } break;
        case EK_MEMK: {
            bf16_t* dst = (bf16_t*)p0; float* sq = (float*)p1;
#pragma unroll
            for (int ai = 0; ai < 2; ++ai)
#pragma unroll
                for (int m = 0; m < 4; ++m) { const size_t row = (size_t)(rbase + ai * 128 + m * 16);
                    float ss = ssq8(acc[ai][0][m][0], acc[ai][0][m][1]) + ssq8(acc[ai][1][m][0], acc[ai][1][m][1]);
                    ss = red_fq(ss);
                    if (fq == 0) sq[row * 16 + u.pn * 4 + wc] = ss;
#pragma unroll
                    for (int bj = 0; bj < 2; ++bj) *(u32x4*)(dst + row * DM + u.pn * 256 + bj * 128 + cl0) = pack8(acc[ai][bj][m][0], acc[ai][bj][m][1]); }
        } break;
        case EK_MEMVT: {
            bf16_t* dst = (bf16_t*)p0;
#pragma unroll
            for (int ai = 0; ai < 2; ++ai)
#pragma unroll
                for (int m = 0; m < 4; ++m) { const size_t row = (size_t)(rbase + ai * 128 + m * 16);
#pragma unroll
                    for (int bj = 0; bj < 2; ++bj) *(u32x4*)(dst + row * TM + u.pn * 256 + bj * 128 + cl0) = pack8(acc[ai][bj][m][0], acc[ai][bj][m][1]); }
        } break;
        case EK_S5E: {
            float* dst = (float*)p0 + (size_t)u.pn * 32768 * 128;
#pragma unroll
            for (int ai = 0; ai < 2; ++ai)
#pragma unroll
                for (int m = 0; m < 4; ++m) { const size_t row = (size_t)(rbase + ai * 128 + m * 16);
                    *(f32x4*)(dst + row * 128 + cl0) = acc[ai][0][m][0]; *(f32x4*)(dst + row * 128 + cl0 + 4) = acc[ai][0][m][1]; }
        } break;
        case EK_S5Y: {
            bf16_t* dst = (bf16_t*)p0;
#pragma unroll
            for (int ai = 0; ai < 2; ++ai)
#pragma unroll
                for (int m = 0; m < 4; ++m) { const int r = rbase + ai * 128 + m * 16; const int gI = r >> 10, b = (r >> 6) & 15, k = r & 63;
#pragma unroll
                    for (int bj = 0; bj < 2; ++bj) { const int nn = u.pn * 256 + bj * 128 + cl0; const int tt = nn >> 4, cc = nn & 15;
                        f32x4 a = acc[ai][bj][m][0], c = acc[ai][bj][m][1];
#pragma unroll
                        for (int j = 0; j < 4; ++j) { a[j] = gelu_t(a[j]); c[j] = gelu_t(c[j]); }
                        *(u32x4*)(dst + ((size_t)(b * SEQ + k * TC + tt)) * 512 + gI * 16 + cc) = pack8(a, c); } }
        } break;
        case EK_GLU: {
            bf16_t* dst = (bf16_t*)p0; float* sq = (float*)p1; const bf16_t* y1 = (const bf16_t*)c0; const float* bg = (const float*)c1;
            f32x4 bv[2][2];
#pragma unroll
            for (int bj = 0; bj < 2; ++bj)
#pragma unroll
                for (int n = 0; n < 2; ++n) bv[bj][n] = *(const f32x4*)(bg + u.pn * 256 + bj * 128 + cl0 + 4 * n);
#pragma unroll
            for (int ai = 0; ai < 2; ++ai)
#pragma unroll
                for (int m = 0; m < 4; ++m) { const size_t row = (size_t)(rbase + ai * 128 + m * 16); float ss = 0.f;
#pragma unroll
                    for (int bj = 0; bj < 2; ++bj) { const size_t off = row * 512 + u.pn * 256 + bj * 128 + cl0;
                        const u32x4 yv = *(const u32x4*)(y1 + off);
                        f32x4 a = acc[ai][bj][m][0] + bv[bj][0], c = acc[ai][bj][m][1] + bv[bj][1];
                        a[0] = bflo(yv.x) * sigm(a[0]); a[1] = bfhi(yv.x) * sigm(a[1]); a[2] = bflo(yv.y) * sigm(a[2]); a[3] = bfhi(yv.y) * sigm(a[3]);
                        c[0] = bflo(yv.z) * sigm(c[0]); c[1] = bfhi(yv.z) * sigm(c[1]); c[2] = bflo(yv.w) * sigm(c[2]); c[3] = bfhi(yv.w) * sigm(c[3]);
                        ss += ssq8(a, c);
                        *(u32x4*)(dst + off) = pack8(a, c); }
                    ss = red_fq(ss);
                    if (fq == 0) sq[row * 8 + u.pn * 4 + wc] = ss; }
        } break;
        case EK_WOUT: case EK_WXO: {
            float* out = (float*)p0; bf16_t* hb = (bf16_t*)p1; float* sq = (float*)p2; const float* base = (const float*)c0;
#pragma unroll
            for (int ai = 0; ai < 2; ++ai)
#pragma unroll
                for (int m = 0; m < 4; ++m) { const size_t row = (size_t)(rbase + ai * 128 + m * 16); float ss = 0.f;
#pragma unroll
                    for (int bj = 0; bj < 2; ++bj) { const size_t off = row * DM + u.pn * 256 + bj * 128 + cl0;
                        const f32x4 a = acc[ai][bj][m][0] + *(const f32x4*)(base + off), c = acc[ai][bj][m][1] + *(const f32x4*)(base + off + 4);
                        *(f32x4*)(out + off) = a; *(f32x4*)(out + off + 4) = c;
                        ss += ssq8(a, c);
                        *(u32x4*)(hb + off) = pack8(a, c); }
                    ss = red_fq(ss);
                    if (fq == 0) sq[row * 16 + u.pn * 4 + wc] = ss; }
        } break;
        case EK_XQ: {
            bf16_t* dst = (bf16_t*)p0; float* sq = (float*)p1; const float* gq = (const float*)c0; const float* gk = (const float*)c1;
            f32x4 gg[2][2];
#pragma unroll
            for (int bj = 0; bj < 2; ++bj)
#pragma unroll
                for (int n = 0; n < 2; ++n) gg[bj][n] = *(const f32x4*)(gq + bj * 128 + cl0 + 4 * n) * *(const f32x4*)(gk + bj * 128 + cl0 + 4 * n);
#pragma unroll
            for (int ai = 0; ai < 2; ++ai)
#pragma unroll
                for (int m = 0; m < 4; ++m) { const size_t row = (size_t)(rbase + ai * 128 + m * 16);
                    float ss = ssq8(acc[ai][0][m][0], acc[ai][0][m][1]) + ssq8(acc[ai][1][m][0], acc[ai][1][m][1]);
                    ss = red_fq(ss);
                    if (fq == 0) sq[row * 16 + u.pn * 4 + wc] = ss;
#pragma unroll
                    for (int bj = 0; bj < 2; ++bj) *(u32x4*)(dst + row * DM + u.pn * 256 + bj * 128 + cl0) = pack8(acc[ai][bj][m][0] * gg[bj][0], acc[ai][bj][m][1] * gg[bj][1]); }
        } break;
        case EK_XS: {
            bf16_t* dst = (bf16_t*)p0; float* ps = (float*)p1; const float* s1 = (const float*)c0; const float* sqq = (const float*)c1; const float* sck = (const float*)c2;
            const int h = u.pn, b = u.pm >> 3;
            f32x4 kv[2][2];
#pragma unroll
            for (int bj = 0; bj < 2; ++bj)
#pragma unroll
                for (int n = 0; n < 2; ++n) kv[bj][n] = *(const f32x4*)(sck + (size_t)h * TM + b * 256 + bj * 128 + cl0 + 4 * n) * (LOG2E / 16.f);
#pragma unroll
            for (int ai = 0; ai < 2; ++ai)
#pragma unroll
                for (int m = 0; m < 4; ++m) { const size_t row = (size_t)(rbase + ai * 128 + m * 16);
                    const f32x4 t0 = *(const f32x4*)(s1 + row * 16), t1 = *(const f32x4*)(s1 + row * 16 + 4), t2 = *(const f32x4*)(s1 + row * 16 + 8), t3 = *(const f32x4*)(s1 + row * 16 + 12);
                    const float tot = ((t0[0] + t0[1]) + (t0[2] + t0[3])) + ((t1[0] + t1[1]) + (t1[2] + t1[3])) + ((t2[0] + t2[1]) + (t2[2] + t2[3])) + ((t3[0] + t3[1]) + (t3[2] + t3[3]));
                    const float rs1 = rsqrtf(tot * (1.f / DM) + EPS);
                    const f32x4 qq = *(const f32x4*)(sqq + row * 16 + h * 4);
                    const float sq = rs1 * rsqrtf(rs1 * rs1 * ((qq[0] + qq[1]) + (qq[2] + qq[3])) * (1.f / 256.f) + EPS);
                    float ss = 0.f;
#pragma unroll
                    for (int bj = 0; bj < 2; ++bj) { f32x4 a = acc[ai][bj][m][0] * kv[bj][0] * sq, c = acc[ai][bj][m][1] * kv[bj][1] * sq;
#pragma unroll
                        for (int j = 0; j < 4; ++j) { a[j] = __builtin_amdgcn_exp2f(a[j]); c[j] = __builtin_amdgcn_exp2f(c[j]); }
                        const u32x4 w = pack8(a, c);
                        ss += (bflo(w.x) + bfhi(w.x)) + (bflo(w.y) + bfhi(w.y)) + (bflo(w.z) + bfhi(w.z)) + (bflo(w.w) + bfhi(w.w));
                        *(u32x4*)(dst + row * DM + h * 256 + bj * 128 + cl0) = w; }
                    ss = red_fq(ss);
                    if (fq == 0) ps[row * 16 + h * 4 + wc] = ss; }
        } break;
        case EK_XO: {
            bf16_t* dst = (bf16_t*)p0; const float* ps = (const float*)c0; const int h = u.pn;
#pragma unroll
            for (int ai = 0; ai < 2; ++ai)
#pragma unroll
                for (int m = 0; m < 4; ++m) { const size_t row = (size_t)(rbase + ai * 128 + m * 16);
                    const f32x4 pp = *(const f32x4*)(ps + row * 16 + h * 4); const float inv = 1.f / ((pp[0] + pp[1]) + (pp[2] + pp[3]));
#pragma unroll
                    for (int bj = 0; bj < 2; ++bj) *(u32x4*)(dst + row * DM + h * 256 + bj * 128 + cl0) = pack8(acc[ai][bj][m][0] * inv, acc[ai][bj][m][1] * inv); }
        } break;
        case EK_UP: {
            bf16_t* G = (bf16_t*)p0; bf16_t* U = (bf16_t*)p1; const float* s2 = (const float*)c0;
#pragma unroll
            for (int ai = 0; ai < 2; ++ai)
#pragma unroll
                for (int m = 0; m < 4; ++m) { const size_t row = (size_t)(rbase + ai * 128 + m * 16);
                    const f32x4 t0 = *(const f32x4*)(s2 + row * 16), t1 = *(const f32x4*)(s2 + row * 16 + 4), t2 = *(const f32x4*)(s2 + row * 16 + 8), t3 = *(const f32x4*)(s2 + row * 16 + 12);
                    const float tot = ((t0[0] + t0[1]) + (t0[2] + t0[3])) + ((t1[0] + t1[1]) + (t1[2] + t1[3])) + ((t2[0] + t2[1]) + (t2[2] + t2[3])) + ((t3[0] + t3[1]) + (t3[2] + t3[3]));
                    const float rs = rsqrtf(tot * (1.f / DM) + EPS);
                    const size_t off = row * DFF + u.pn * 128 + cl0;
                    *(u32x4*)(G + off) = pack8(acc[ai][0][m][0] * rs, acc[ai][0][m][1] * rs);
                    *(u32x4*)(U + off) = pack8(acc[ai][1][m][0] * rs, acc[ai][1][m][1] * rs); }
        } break;
        case EK_DOWN: {
            float* out = (float*)p0;
#pragma unroll
            for (int ai = 0; ai < 2; ++ai)
#pragma unroll
                for (int m = 0; m < 4; ++m) { const size_t row = (size_t)(rbase + ai * 128 + m * 16);
#pragma unroll
                    for (int bj = 0; bj < 2; ++bj) { const size_t off = row * DM + u.pn * 256 + bj * 128 + cl0;
                        const f32x4 a = acc[ai][bj][m][0] + *(const f32x4*)(out + off), c = acc[ai][bj][m][1] + *(const f32x4*)(out + off + 4);
                        *(f32x4*)(out + off) = a; *(f32x4*)(out + off + 4) = c; } }
        } break;
        case EK_GATE: {
            bf16_t* G = (bf16_t*)p0; const float* s2 = (const float*)c0;
#pragma unroll
            for (int ai = 0; ai < 2; ++ai)
#pragma unroll
                for (int m = 0; m < 4; ++m) { const size_t row = (size_t)(rbase + ai * 128 + m * 16);
                    const f32x4 t0 = *(const f32x4*)(s2 + row * 16), t1 = *(const f32x4*)(s2 + row * 16 + 4), t2 = *(const f32x4*)(s2 + row * 16 + 8), t3 = *(const f32x4*)(s2 + row * 16 + 12);
                    const float tot = ((t0[0] + t0[1]) + (t0[2] + t0[3])) + ((t1[0] + t1[1]) + (t1[2] + t1[3])) + ((t2[0] + t2[1]) + (t2[2] + t2[3])) + ((t3[0] + t3[1]) + (t3[2] + t3[3]));
                    const float rs = rsqrtf(tot * (1.f / DM) + EPS);
#pragma unroll
                    for (int bj = 0; bj < 2; ++bj) *(u32x4*)(G + row * DFF + u.pn * 256 + bj * 128 + cl0) = pack8(acc[ai][bj][m][0] * rs, acc[ai][bj][m][1] * rs); }
        } break;
        case EK_UPACT: {
            bf16_t* A = (bf16_t*)p0; const float* rs2 = (const float*)c0; const bf16_t* G = (const bf16_t*)c1; const float* cw = (const float*)c2; const float* cbv = (const float*)p1;
            u32x4 upk[2][4][2];
#pragma unroll
            for (int ai = 0; ai < 2; ++ai)
#pragma unroll
                for (int m = 0; m < 4; ++m) { const float rs = rs2[rbase + ai * 128 + m * 16];
#pragma unroll
                    for (int bj = 0; bj < 2; ++bj) upk[ai][m][bj] = pack8(acc[ai][bj][m][0] * rs, acc[ai][bj][m][1] * rs); }
            asm volatile("" ::: "memory");
#pragma unroll
            for (int bj = 0; bj < 2; ++bj) { const int j0 = u.pn * 256 + bj * 128 + cl0;
                float w0[8], w1[8], w2[8], bb[8];
#pragma unroll
                for (int i = 0; i < 2; ++i) { const f32x4 a0 = *(const f32x4*)(cw + j0 + 4 * i), a1 = *(const f32x4*)(cw + DFF + j0 + 4 * i), a2 = *(const f32x4*)(cw + 2 * DFF + j0 + 4 * i), a3 = *(const f32x4*)(cbv + j0 + 4 * i);
#pragma unroll
                    for (int q = 0; q < 4; ++q) { w0[4 * i + q] = a0[q]; w1[4 * i + q] = a1[q]; w2[4 * i + q] = a2[q]; bb[4 * i + q] = a3[q]; } }
#pragma unroll
                for (int ai = 0; ai < 2; ++ai)
#pragma unroll
                    for (int m = 0; m < 4; ++m) { const int row = rbase + ai * 128 + m * 16; const int ts = row & 2047; const size_t off = (size_t)row * DFF + j0;
                        const u32x4 g0 = *(const u32x4*)(G + off);
                        u32x4 g1 = *(const u32x4*)(G + off - (ts >= 1 ? DFF : 0));
                        u32x4 g2 = *(const u32x4*)(G + off - (ts >= 2 ? 2 * DFF : 0));
                        const unsigned k1 = ts >= 1 ? 0xffffffffu : 0u, k2 = ts >= 2 ? 0xffffffffu : 0u;
                        g1 = g1 & k1; g2 = g2 & k2;
                        const u32x4 uu = upk[ai][m][bj];
                        float r[8];
#pragma unroll
                        for (int q = 0; q < 4; ++q) { const unsigned a2 = g2[q], a1 = g1[q], a0 = g0[q], u0 = uu[q];
                            const float z0 = bb[2 * q] + w0[2 * q] * bflo(a2) + w1[2 * q] * bflo(a1) + w2[2 * q] * bflo(a0);
                            const float z1 = bb[2 * q + 1] + w0[2 * q + 1] * bfhi(a2) + w1[2 * q + 1] * bfhi(a1) + w2[2 * q + 1] * bfhi(a0);
                            r[2 * q] = z0 * sigm(z0) * bflo(u0); r[2 * q + 1] = z1 * sigm(z1) * bfhi(u0); }
                        u32x4 o; o.x = pk2(r[0], r[1]); o.y = pk2(r[2], r[3]); o.z = pk2(r[4], r[5]); o.w = pk2(r[6], r[7]);
                        *(u32x4*)(A + off) = o;
                        if ((m & 1) == 1) asm volatile("" ::: "memory"); } }
        } break;
        case EK_UPC: {
            bf16_t* A = (bf16_t*)p0; float* GHF = (float*)p1; float* GHL = (float*)p2; float* UH = (float*)p3; const float* s2 = (const float*)c0; const float* cw = (const float*)c1; const float* cbv = (const float*)c2;
            const int j0 = u.pn * 128 + cl0;
            float rsv[2][4];
#pragma unroll
            for (int ai = 0; ai < 2; ++ai)
#pragma unroll
                for (int m = 0; m < 4; ++m) rsv[ai][m] = s2[rbase + ai * 128 + m * 16];
            if (fr >= 14) {
#pragma unroll
                for (int ai = 0; ai < 2; ++ai) { const f32x4 g0 = acc[ai][0][3][0] * rsv[ai][3], g1 = acc[ai][0][3][1] * rsv[ai][3];
                    LAS float* hp = hx + ((ai * 2 + wr) * 2 + (fr - 14)) * 128 + cl0; *(LAS f32x4*)hp = g0; *(LAS f32x4*)(hp + 4) = g1;
                    if (ai == 1 && wr == 1) { float* gp = GHL + ((size_t)u.pm * 2 + (fr - 14)) * DFF + j0; *(f32x4*)gp = g0; *(f32x4*)(gp + 4) = g1; } } }
            if (wr == 0 && fr < 2) {
                const float rs = rsv[0][0]; float* gp = GHF + ((size_t)u.pm * 2 + fr) * DFF + j0; float* up = UH + ((size_t)u.pm * 2 + fr) * DFF + j0;
                *(f32x4*)gp = acc[0][0][0][0] * rs; *(f32x4*)(gp + 4) = acc[0][0][0][1] * rs; *(f32x4*)up = acc[0][1][0][0] * rs; *(f32x4*)(up + 4) = acc[0][1][0][1] * rs; }
            asm volatile("s_waitcnt lgkmcnt(0)" ::: "memory"); __builtin_amdgcn_s_barrier(); asm volatile("" ::: "memory");
            float w0[8], w1[8], w2[8], bb[8];
#pragma unroll
            for (int i = 0; i < 2; ++i) { const f32x4 a0 = *(const f32x4*)(cw + j0 + 4 * i), a1 = *(const f32x4*)(cw + DFF + j0 + 4 * i), a2 = *(const f32x4*)(cw + 2 * DFF + j0 + 4 * i), a3 = *(const f32x4*)(cbv + j0 + 4 * i);
#pragma unroll
                for (int q = 0; q < 4; ++q) { w0[4 * i + q] = a0[q]; w1[4 * i + q] = a1[q]; w2[4 * i + q] = a2[q]; bb[4 * i + q] = a3[q]; } }
#define ROR1(x) __builtin_bit_cast(float, __builtin_amdgcn_update_dpp(0, __builtin_bit_cast(int, (x)), 0x121, 0xF, 0xF, false))
#define ROR2(x) __builtin_bit_cast(float, __builtin_amdgcn_update_dpp(0, __builtin_bit_cast(int, (x)), 0x122, 0xF, 0xF, false))
#pragma unroll
            for (int ai = 0; ai < 2; ++ai) {
                const int grp = ai * 2 + wr;
                float p1v[8], p2v[8];
                { f32x4 h1a = (f32x4){0.f, 0.f, 0.f, 0.f}, h1b = h1a, h2a = h1a, h2b = h1a;
                  if (grp > 0) { const LAS float* hp = hx + ((grp - 1) * 2) * 128 + cl0; h2a = *(const LAS f32x4*)hp; h2b = *(const LAS f32x4*)(hp + 4); h1a = *(const LAS f32x4*)(hp + 128); h1b = *(const LAS f32x4*)(hp + 132); }
#pragma unroll
                  for (int i = 0; i < 4; ++i) { p1v[i] = h1a[i]; p1v[4 + i] = h1b[i]; p2v[i] = (fr == 0) ? h2a[i] : h1a[i]; p2v[4 + i] = (fr == 0) ? h2b[i] : h1b[i]; } }
#pragma unroll
                for (int m = 0; m < 4; ++m) { const float rs = rsv[ai][m]; const size_t row = (size_t)(rbase + ai * 128 + m * 16);
                    float gs[8], r[8];
#pragma unroll
                    for (int i = 0; i < 4; ++i) { gs[i] = acc[ai][0][m][0][i] * rs; gs[4 + i] = acc[ai][0][m][1][i] * rs; }
#pragma unroll
                    for (int i = 0; i < 8; ++i) { const float c1v = ROR1(gs[i]), c2v = ROR2(gs[i]);
                        const float g1 = (fr == 0) ? p1v[i] : c1v, g2 = (fr < 2) ? p2v[i] : c2v;
                        p1v[i] = c1v; p2v[i] = c2v;
                        const float z = bb[i] + w0[i] * g2 + w1[i] * g1 + w2[i] * gs[i];
                        const float uv = (i < 4 ? acc[ai][1][m][0][i & 3] : acc[ai][1][m][1][i & 3]) * rs;
                        r[i] = z * sigm(z) * uv; }
                    u32x4 o; o.x = pk2(r[0], r[1]); o.y = pk2(r[2], r[3]); o.z = pk2(r[4], r[5]); o.w = pk2(r[6], r[7]);
                    if (!(grp == 0 && m == 0 && fr < 2)) *(u32x4*)(A + row * DFF + j0) = o; } }
#undef ROR1
#undef ROR2
        } break;
        default: break;
        }
    }
};

namespace attn_body {
using bf16=__hip_bfloat16;
using s16x4=__attribute__((ext_vector_type(4)))short;
using f32x16=__attribute__((ext_vector_type(16)))float;
constexpr int NHEAD=NFH,D=64,ADM=NHEAD*D;
constexpr int NW=8,QBLK=32,QB=QBLK*NW,KVBLK=64,NQB=SEQ/QB;
__device__ __forceinline__ int crow(int r,int hi){return (r&3)+8*(r>>2)+4*hi;}
#define SBAR() __builtin_amdgcn_sched_barrier(0)
__device__ __forceinline__ void cmask(f32x16&p0,f32x16&p1,int jb,int qrel,int hi){
  const float NEG=-INFINITY; int kb=64*jb+4*hi;
  #pragma unroll
  for(int r=0;r<16;++r){int kv=kb+(r&3)+8*(r>>2); if(kv>qrel)p0[r]=NEG; if(kv+32>qrel)p1[r]=NEG;}
}
constexpr int NSLOT=3, SLOTB=8192;
constexpr int LDS_K=0, LDS_V=NSLOT*SLOTB, LDS_WS=2*NSLOT*SLOTB, LDS_OST=LDS_WS+NW*64*4, LDS_BYTES=LDS_OST+NW*4096;
constexpr int LDS_BIAS=86016;
__device__ __forceinline__ void glds16(const void*gsrc,unsigned lds_dst){unsigned keep;
  asm volatile("s_mov_b32 %0, m0\n\ts_mov_b32 m0, %2\n\ts_nop 0\n\tglobal_load_lds_dwordx4 %1, off\n\ts_mov_b32 m0, %0":"=&s"(keep):"v"(gsrc),"s"(lds_dst):"memory");}
__device__ __forceinline__ float max3f(float a,float b,float c){float r;asm("v_max3_f32 %0, %1, %2, %3":"=v"(r):"v"(a),"v"(b),"v"(c));return r;}
__device__ __forceinline__ float max2f(float a,float b){float r;asm("v_max_f32_e32 %0, %1, %2":"=v"(r):"v"(a),"v"(b));return r;}
__device__ __forceinline__ float fadd_s(float a,float b){float r;asm("v_add_f32_e32 %0, %1, %2":"=v"(r):"v"(a),"v"(b));return r;}
__device__ __forceinline__ float fsub_s(float a,float b){float r;asm("v_sub_f32_e32 %0, %1, %2":"=v"(r):"v"(a),"v"(b));return r;}
typedef float f32x2_t __attribute__((ext_vector_type(2))); typedef __bf16 bf16x2_t __attribute__((ext_vector_type(2)));
__device__ __forceinline__ unsigned cvtpk_s(float lo,float hi){f32x2_t v={lo,hi};bf16x2_t b=__builtin_convertvector(v,bf16x2_t);return __builtin_bit_cast(unsigned,b);}
#define WAIT_BAR(N) asm volatile("s_waitcnt vmcnt(" #N ") lgkmcnt(0)\n\ts_barrier":::"memory")

__device__ __forceinline__ void qkt(f32x16&p0,f32x16&p1,const char*Kslot,const bf16x8*qr,const f32x16&negm,int r32,int hi){
  const char*kb=Kslot+hi*1024+r32*16;
  #pragma unroll
  for(int d0=0;d0<4;++d0){
    const bf16x8 b0=*reinterpret_cast<const bf16x8*>(kb+d0*2048);
    const bf16x8 b1=*reinterpret_cast<const bf16x8*>(kb+d0*2048+512);
    if(d0==0){p0=__builtin_amdgcn_mfma_f32_32x32x16_bf16(b0,qr[0],negm,0,0,0);p1=__builtin_amdgcn_mfma_f32_32x32x16_bf16(b1,qr[0],negm,0,0,0);}
    else{p0=__builtin_amdgcn_mfma_f32_32x32x16_bf16(b0,qr[d0],p0,0,0,0);p1=__builtin_amdgcn_mfma_f32_32x32x16_bf16(b1,qr[d0],p1,0,0,0);}}
}
typedef __attribute__((address_space(3))) const char* lds_cptr;
typedef short v4i16_t __attribute__((ext_vector_type(4)));
__device__ __forceinline__ void kload8(bf16x8*kf,lds_cptr kp){
  kf[0]=*(const __attribute__((address_space(3))) bf16x8*)(kp);      kf[1]=*(const __attribute__((address_space(3))) bf16x8*)(kp+512);
  kf[2]=*(const __attribute__((address_space(3))) bf16x8*)(kp+2048); kf[3]=*(const __attribute__((address_space(3))) bf16x8*)(kp+2560);
  kf[4]=*(const __attribute__((address_space(3))) bf16x8*)(kp+4096); kf[5]=*(const __attribute__((address_space(3))) bf16x8*)(kp+4608);
  kf[6]=*(const __attribute__((address_space(3))) bf16x8*)(kp+6144); kf[7]=*(const __attribute__((address_space(3))) bf16x8*)(kp+6656);
}
__device__ __forceinline__ void kload2(bf16x8*kf,lds_cptr kp,int j){ kf[2*j]=*(const __attribute__((address_space(3))) bf16x8*)(kp+j*2048); kf[2*j+1]=*(const __attribute__((address_space(3))) bf16x8*)(kp+j*2048+512); }
__device__ __forceinline__ s16x4 vtr(lds_cptr p){ return __builtin_bit_cast(s16x4,__builtin_amdgcn_ds_read_tr16_b64_v4i16((__attribute__((address_space(3))) v4i16_t*)p)); }
__device__ __forceinline__ float rowmax(const f32x16&p0,const f32x16&p1){
  float a=max3f(p0[0],p0[1],p1[0]),b=max3f(p0[2],p0[3],p1[1]);a=max3f(a,p1[2],p1[3]);
  #pragma unroll
  for(int r=4;r<16;r+=4){a=max3f(a,p0[r],p0[r+1]);b=max3f(b,p0[r+2],p0[r+3]);a=max3f(a,p1[r],p1[r+1]);b=max3f(b,p1[r+2],p1[r+3]);}
  const float m=max2f(a,b);
  auto rr=__builtin_amdgcn_permlane32_swap(__float_as_uint(m),__float_as_uint(m),false,false);
  return max2f(__uint_as_float(rr[0]),__uint_as_float(rr[1]));
}
__device__ __forceinline__ void pv(f32x16*o,int vb,bf16x8 pa0,bf16x8 pa1,bf16x8 pa2,bf16x8 pa3){
  #pragma unroll
  for(int d0=0;d0<2;++d0){s16x4 lo[4],hi[4];
    #pragma unroll
    for(int ks=0;ks<4;++ks){
      asm volatile("ds_read_b64_tr_b16 %0,%1 offset:%c2":"=&v"(lo[ks]):"v"(vb),"i"(d0*4096+ks*1024):"memory");
      asm volatile("ds_read_b64_tr_b16 %0,%1 offset:%c2":"=&v"(hi[ks]):"v"(vb),"i"(d0*4096+ks*1024+512):"memory");}
    asm volatile("s_waitcnt lgkmcnt(0)":::"memory");SBAR();
    #define PK(k) (bf16x8){lo[k][0],lo[k][1],lo[k][2],lo[k][3],hi[k][0],hi[k][1],hi[k][2],hi[k][3]}
    o[d0]=__builtin_amdgcn_mfma_f32_32x32x16_bf16(pa0,PK(0),o[d0],0,0,0);
    o[d0]=__builtin_amdgcn_mfma_f32_32x32x16_bf16(pa1,PK(1),o[d0],0,0,0);
    o[d0]=__builtin_amdgcn_mfma_f32_32x32x16_bf16(pa2,PK(2),o[d0],0,0,0);
    o[d0]=__builtin_amdgcn_mfma_f32_32x32x16_bf16(pa3,PK(3),o[d0],0,0,0);
    #undef PK
  }
}
typedef const __attribute__((address_space(3))) f32x4* lds_f4ptr;
#define BIASADD(P0,P1,t) do{ const lds_f4ptr bp_=(lds_f4ptr)(shm3+LDS_BIAS+((t)*64+4*hi)*4); \
    _Pragma("unroll") for(int j_=0;j_<4;++j_){ const f32x4 b0_=bp_[2*j_]-mhat, b1_=bp_[8+2*j_]-mhat; \
      P0[4*j_]+=b0_[0]; P0[4*j_+1]+=b0_[1]; P0[4*j_+2]+=b0_[2]; P0[4*j_+3]+=b0_[3]; \
      P1[4*j_]+=b1_[0]; P1[4*j_+1]+=b1_[1]; P1[4*j_+2]+=b1_[2]; P1[4*j_+3]+=b1_[3]; } }while(0)

template<int THRL> __device__ __forceinline__ void attn_unit(int b,int h,int qb,const bf16*Q,const bf16*__restrict__ K,const bf16*__restrict__ V,bf16*O,const float*__restrict__ CB,float*__restrict__ SSQ,char*shm){
  int tid=threadIdx.x; asm volatile("":"+v"(tid));
  const int lane=tid&63,r32=lane&31,hi=lane>>5; const int wid=__builtin_amdgcn_readfirstlane(tid>>6);
  const long rowbase=(long)b*SEQ; const int q0=qb*QB;
  const bf16*Qw=Q+(rowbase+q0+wid*QBLK)*ADM+h*D;
  const bf16*Kh=K+rowbase*ADM+h*D,*Vh=V+rowbase*ADM+h*D;
  const unsigned lds0=(unsigned)(uintptr_t)shm;
  float*wsf=(float*)(shm+LDS_WS)+wid*64;
  const lds_cptr shm3=(lds_cptr)shm;
  { const float*cbh=CB+(long)(b*NHEAD+h)*SEQ; const float cref=cbh[q0+128];
    if(tid*4<q0+QB){ const f32x4 c4=*(const f32x4*)(cbh+tid*4); *(__attribute__((address_space(3))) f32x4*)(shm3+LDS_BIAS+tid*16)=(f32x4){cref-c4[0],cref-c4[1],cref-c4[2],cref-c4[3]}; } }
  const bf16*ksrc=Kh+(long)lane*ADM+wid*8;
  const bf16*vsrc=Vh+(long)(16*(wid&3)+(lane>>2))*ADM+(wid>>2)*32+(lane&3)*8;
  const unsigned kdst=lds0+LDS_K+wid*1024, vdst=lds0+LDS_V+wid*1024;
  #define DMA_K(t,slot) glds16(ksrc+(long)(t)*KVBLK*ADM,(unsigned)__builtin_amdgcn_readfirstlane(kdst+(slot)))
  #define DMA_V(t,slot) glds16(vsrc+(long)(t)*KVBLK*ADM,(unsigned)__builtin_amdgcn_readfirstlane(vdst+(slot)))
  const int vb0=(int)(lds0+LDS_V)+((lane>>4)&1)*32+(lane&3)*8+(4*hi+((lane&15)>>2))*64;
  const char*Kbase=shm+LDS_K; bf16x8 kf[8];
  const lds_cptr kp0=shm3+LDS_K+hi*1024+r32*16; const lds_cptr vp0=shm3+LDS_V+((lane>>4)&1)*32+(lane&3)*8+(4*hi+((lane&15)>>2))*64;
  const int NT=(q0+QB)/KVBLK;
  DMA_K(0,0);DMA_V(0,0);DMA_K(1,SLOTB);
  bf16x8 qr[4];
  #pragma unroll
  for(int d0=0;d0<4;++d0)qr[d0]=*reinterpret_cast<const bf16x8*>(&Qw[(long)r32*ADM+d0*16+hi*8]);
  float mhat=0.f,l_reg=0.f;f32x16 o[2];o[0]=f32x16{};o[1]=f32x16{};const f32x16 negm=f32x16{};
  const int qrel=wid*QBLK+r32;
  #define CMASK(P0,P1,t) do{int jb_=(t)-(NT-4); if(jb_>=0)cmask(P0,P1,jb_,qrel,hi);}while(0)
  bool resc=false;
  #define START(P0,P1) do{ const float rm=rowmax(P0,P1); resc=false; \
    { const float dl=max2f(rm,-24.f); mhat=fadd_s(mhat,dl); \
      _Pragma("unroll") for(int r=0;r<16;++r){P0[r]=fsub_s(P0[r],dl);P1[r]=fsub_s(P1[r],dl);} } \
    _Pragma("unroll") for(int r=0;r<16;++r)P0[r]=__builtin_amdgcn_exp2f(P0[r]); }while(0)
  #define RESC() do{ if(resc){ asm volatile("s_waitcnt lgkmcnt(0)":::"memory"); \
      _Pragma("unroll") for(int d_=0;d_<2;++d_) _Pragma("unroll") for(int r=0;r<16;++r)o[d_][r]*=wsf[crow(r,hi)]; } }while(0)
  f32x16 pA0,pA1,pB0,pB1;
  int sl_prev=0,sl_cur=0,sl_next=SLOTB;
  #define ROT() do{sl_prev=sl_cur;sl_cur=sl_next;sl_next=(sl_next==(NSLOT-1)*SLOTB)?0:sl_next+SLOTB;}while(0)
  DMA_K(2,2*SLOTB);
  WAIT_BAR(3);
  qkt(pA0,pA1,Kbase,qr,negm,r32,hi);asm volatile("s_nop 15\n\ts_nop 7":"+v"(pA0),"+v"(pA1));BIASADD(pA0,pA1,0);CMASK(pA0,pA1,0);
  START(pA0,pA1);
  _Pragma("unroll") for(int r=0;r<16;++r)pA1[r]=__builtin_amdgcn_exp2f(pA1[r]);
  WAIT_BAR(0);
  DMA_K(3,0);DMA_V(1,SLOTB);
  ROT();
  kload8(kf,kp0+sl_cur);
  WAIT_BAR(2);
  s16x4 vlo[8],vhi[8]; u32x4 pw0,pw1,pw2,pw3;
  #define PKW(P,B) cvtpk_s(P[B],P[B+1])
  #define PAF(k) __builtin_bit_cast(bf16x8,pw##k)
  #define VFR(i) (bf16x8){vlo[i][0],vlo[i][1],vlo[i][2],vlo[i][3],vhi[i][0],vhi[i][1],vhi[i][2],vhi[i][3]}
  #define PIN(x) asm volatile("":"+v"(x))
  #define MX3(a,b,c) __builtin_fmaxf(__builtin_fmaxf((a),(b)),(c))
  #define GAPA(MF,A0,A1,A2,A3,W0,W1,PW) do{ MF; sacc+=A0; sacc+=A1; sacc+=A2; sacc+=A3; PIN(sacc); W0; W1; PIN(PW); SBAR(); }while(0)
  #define EX(v) __builtin_amdgcn_exp2f(v)
  #define GAPB(MF,X,B) do{ MF; X[B]=EX(X[B]); X[B+1]=EX(X[B+1]); X[B+2]=EX(X[B+2]); X[B+3]=EX(X[B+3]); PIN(X); SBAR(); }while(0)
  #define VRD(i) do{ vlo[i]=vtr(vp_+(((i)>>2)*4096+((i)&3)*1024)); vhi[i]=vtr(vp_+(((i)>>2)*4096+((i)&3)*1024+512)); }while(0)
  #define KRD(G,j) do{ if(G){ kload2(kf,kp0+sl_next,j); SBAR(); } }while(0)
  #define STEP(C0,C1,P0,P1,t,GK,GV,GL) do{ SBAR(); \
    const lds_cptr vp_=vp0+sl_prev; \
    VRD(0); SBAR(); float sacc=(P0[0]+P0[1]); \
    GAPA(C0=__builtin_amdgcn_mfma_f32_32x32x16_bf16(kf[0],qr[0],negm,0,0,0), P0[2],P0[3],P0[4],P0[5],     pw0[0]=PKW(P0,0), pw0[1]=PKW(P0,2), pw0); \
    VRD(4); SBAR(); GAPA(C1=__builtin_amdgcn_mfma_f32_32x32x16_bf16(kf[1],qr[0],negm,0,0,0), P0[6],P0[7],P0[8],P0[9],     pw0[2]=PKW(P0,4), pw0[3]=PKW(P0,6), pw0); \
    VRD(1); SBAR(); GAPA(C0=__builtin_amdgcn_mfma_f32_32x32x16_bf16(kf[2],qr[1],C0,0,0,0),   P0[10],P0[11],P0[12],P0[13], pw1[0]=PKW(P0,8), pw1[1]=PKW(P0,10), pw1); \
    VRD(5); SBAR(); GAPA(C1=__builtin_amdgcn_mfma_f32_32x32x16_bf16(kf[3],qr[1],C1,0,0,0),   P0[14],P0[15],P1[0],P1[1],   pw1[2]=PKW(P0,12),pw1[3]=PKW(P0,14), pw1); \
    VRD(2); SBAR(); GAPA(C0=__builtin_amdgcn_mfma_f32_32x32x16_bf16(kf[4],qr[2],C0,0,0,0),   P1[2],P1[3],P1[4],P1[5],     pw2[0]=PKW(P1,0), pw2[1]=PKW(P1,2), pw2); \
    VRD(6); SBAR(); GAPA(C1=__builtin_amdgcn_mfma_f32_32x32x16_bf16(kf[5],qr[2],C1,0,0,0),   P1[6],P1[7],P1[8],P1[9],     pw2[2]=PKW(P1,4), pw2[3]=PKW(P1,6), pw2); \
    VRD(3); SBAR(); GAPA(C0=__builtin_amdgcn_mfma_f32_32x32x16_bf16(kf[6],qr[3],C0,0,0,0),   P1[10],P1[11],P1[12],P1[13], pw3[0]=PKW(P1,8), pw3[1]=PKW(P1,10), pw3); \
    VRD(7); SBAR(); GAPA(C1=__builtin_amdgcn_mfma_f32_32x32x16_bf16(kf[7],qr[3],C1,0,0,0),   P1[14],P1[15],0.f,0.f,       pw3[2]=PKW(P1,12),pw3[3]=PKW(P1,14), pw3); \
    l_reg+=sacc; \
    if(GK){DMA_K((t)+3,sl_cur);} if(GV){DMA_V((t)+1,sl_next);} \
    BIASADD(C0,C1,t); \
    CMASK(C0,C1,t); \
    { float a=MX3(C0[0],C0[1],C1[0]),b=MX3(C0[2],C0[3],C1[1]); a=MX3(a,C1[2],C1[3]); \
      _Pragma("unroll") for(int r=4;r<16;r+=4){a=MX3(a,C0[r],C0[r+1]);b=MX3(b,C0[r+2],C0[r+3]);a=MX3(a,C1[r],C1[r+1]);b=MX3(b,C1[r+2],C1[r+3]);} \
      float rm=__builtin_fmaxf(a,b); { auto rr=__builtin_amdgcn_permlane32_swap(__float_as_uint(rm),__float_as_uint(rm),false,false); rm=__builtin_fmaxf(__uint_as_float(rr[0]),__uint_as_float(rr[1])); } \
      resc=false; \
      if(__builtin_expect(__any(rm>(float)THRL),0)){ const float dl=__builtin_fmaxf(rm,0.f); mhat+=dl; \
        _Pragma("unroll") for(int r=0;r<16;++r){C0[r]-=dl;C1[r]-=dl;} \
        const float f=__builtin_amdgcn_exp2f(-dl); l_reg*=f; if(hi==0)wsf[r32]=f; resc=true; } } \
    SBAR(); \
    GAPB(o[0]=__builtin_amdgcn_mfma_f32_32x32x16_bf16(PAF(0),VFR(0),o[0],0,0,0), C0,0); \
    GAPB(o[1]=__builtin_amdgcn_mfma_f32_32x32x16_bf16(PAF(0),VFR(4),o[1],0,0,0), C0,4); \
    KRD(GL,0); GAPB(o[0]=__builtin_amdgcn_mfma_f32_32x32x16_bf16(PAF(1),VFR(1),o[0],0,0,0), C0,8); \
    KRD(GL,1); GAPB(o[1]=__builtin_amdgcn_mfma_f32_32x32x16_bf16(PAF(1),VFR(5),o[1],0,0,0), C0,12); \
    KRD(GL,2); GAPB(o[0]=__builtin_amdgcn_mfma_f32_32x32x16_bf16(PAF(2),VFR(2),o[0],0,0,0), C1,0); \
    KRD(GL,3); GAPB(o[1]=__builtin_amdgcn_mfma_f32_32x32x16_bf16(PAF(2),VFR(6),o[1],0,0,0), C1,4); \
    GAPB(o[0]=__builtin_amdgcn_mfma_f32_32x32x16_bf16(PAF(3),VFR(3),o[0],0,0,0), C1,8); \
    GAPB(o[1]=__builtin_amdgcn_mfma_f32_32x32x16_bf16(PAF(3),VFR(7),o[1],0,0,0), C1,12); \
    }while(0)
  int t=1;
  #undef CMASK
  #define CMASK(P0,P1,t) do{}while(0)
  for(;t+5<NT;t+=2){
    STEP(pB0,pB1,pA0,pA1,t,true,true,true);     WAIT_BAR(2); RESC(); ROT();
    STEP(pA0,pA1,pB0,pB1,t+1,true,true,true);   WAIT_BAR(2); RESC(); ROT();
  }
  #undef CMASK
  #define CMASK(P0,P1,t) do{int jb_=(t)-(NT-4); if(jb_>=0)cmask(P0,P1,jb_,qrel,hi);}while(0)
  #define ENDW(tt) do{ if((tt)+3<NT){WAIT_BAR(2);} else if((tt)+2<NT){WAIT_BAR(1);} else {WAIT_BAR(0);} }while(0)
  for(;t+1<NT;t+=2){
    STEP(pB0,pB1,pA0,pA1,t,(t+3<NT),(t+1<NT),(t+1<NT));       ENDW(t);   RESC(); ROT();
    STEP(pA0,pA1,pB0,pB1,t+1,(t+4<NT),(t+2<NT),(t+2<NT));     ENDW(t+1); RESC(); ROT();
  }
  STEP(pB0,pB1,pA0,pA1,NT-1,false,false,false); RESC();
  { float sacc=pB0[0]+pB0[1]; _Pragma("unroll") for(int r=2;r<16;++r)sacc+=pB0[r]; _Pragma("unroll") for(int r=0;r<16;++r)sacc+=pB1[r]; l_reg+=sacc;
    pw0=(u32x4){PKW(pB0,0),PKW(pB0,2),PKW(pB0,4),PKW(pB0,6)};pw1=(u32x4){PKW(pB0,8),PKW(pB0,10),PKW(pB0,12),PKW(pB0,14)};pw2=(u32x4){PKW(pB1,0),PKW(pB1,2),PKW(pB1,4),PKW(pB1,6)};pw3=(u32x4){PKW(pB1,8),PKW(pB1,10),PKW(pB1,12),PKW(pB1,14)};
    SBAR(); pv(o,vb0+sl_cur,PAF(0),PAF(1),PAF(2),PAF(3)); }
  #undef PKW
  #undef PAF
  #undef VFR
  #undef PIN
  #undef MX3
  #undef GAPA
  #undef GAPB
  #undef EX
  #undef VRD
  #undef KRD
  #undef STEP
  #undef ENDW
  {auto rr=__builtin_amdgcn_permlane32_swap(__float_as_uint(l_reg),__float_as_uint(l_reg),false,false);l_reg=__uint_as_float(rr[0])+__uint_as_float(rr[1]);}
  if(hi==0)wsf[32+r32]=l_reg;asm volatile("s_waitcnt lgkmcnt(0)":::"memory");
  float rli[16];
  #pragma unroll
  for(int r=0;r<16;++r)rli[r]=__builtin_amdgcn_rcpf(wsf[32+crow(r,hi)]);
  int lane2=lane; asm volatile("":"+v"(lane2));
  bf16*Ow=O+(rowbase+q0+wid*QBLK)*ADM+h*D;
  { bf16*stg=(bf16*)(shm+LDS_OST)+wid*2048;
    #pragma unroll
    for(int r=0;r<16;++r){const int orow=crow(r,hi);
      #pragma unroll
      for(int d0=0;d0<2;++d0)stg[orow*64+d0*32+r32]=__float2bfloat16(o[d0][r]*rli[r]);}
    asm volatile("s_waitcnt lgkmcnt(0)":::"memory");
    #pragma unroll
    for(int i=0;i<4;++i){const int row=i*8+(lane2>>3),ch=lane2&7; const u32x4 v=*(const u32x4*)(stg+row*64+ch*8); *(u32x4*)(Ow+(long)row*ADM+ch*8)=v;
      float s=(bflo(v.x)*bflo(v.x)+bfhi(v.x)*bfhi(v.x))+(bflo(v.y)*bflo(v.y)+bfhi(v.y)*bfhi(v.y))+(bflo(v.z)*bflo(v.z)+bfhi(v.z)*bfhi(v.z))+(bflo(v.w)*bflo(v.w)+bfhi(v.w)*bfhi(v.w));
      s+=__shfl_xor(s,1); s+=__shfl_xor(s,2); s+=__shfl_xor(s,4);
      if(ch==0)SSQ[(rowbase+q0+wid*QBLK+row)*NHEAD+h]=s; } }
  asm volatile("s_waitcnt lgkmcnt(0)\n\ts_barrier":::"memory");
  #undef DMA_K
  #undef DMA_V
  #undef CMASK
  #undef START
  #undef RESC
  #undef ROT
}
#undef SBAR
#undef WAIT_BAR
}

constexpr int RING_BYTES = 131072;
constexpr int LDS_TOTAL = 147456;
struct Args { const float* in[32]; float* out; unsigned char* ws; };
typedef const float* const __attribute__((address_space(4)))* InTab;
enum In { I_X = 0, I_MEM, I_NORM_MIX, I_W_IN, I_FQN, I_FKN, I_FBIAS, I_ARE, I_AIM, I_LOGDT, I_BRE, I_BIM, I_CRE, I_CIM, I_D, I_WGLU, I_BGLU, I_ONF, I_ONS, I_WOUT,
          I_NCROSS, I_NMEM, I_WXQ, I_WXKV, I_XQN, I_XKN, I_WXO, I_NFFN, I_WUP, I_CONVW, I_CONVB, I_WDN };

struct TJob { const float* W; int ldw, col0, ncols, K; const float* kg; const float* kg2; bf16_t* WT; int mapid, rowoff, items; };
__device__ __forceinline__ int tmap(int mapid, int n, int rowoff) {
    if (mapid == 1) { const int part = n >> 9, f = n & 511, head = f >> 6, d = f & 63; return 512 * part + 256 * (head >> 2) + 128 * (d >> 5) + 32 * (head & 3) + (d & 31); }
    if (mapid == 2) { const int isup = n >= DFF ? 1 : 0; const int j = n - isup * DFF; return 256 * (j >> 7) + 128 * isup + (j & 127); }
    return rowoff + n;
}
__device__ __forceinline__ void transpose_item(const TJob& J, LAS float* scr, int item, int lane) {
    const int nblk = J.ncols / 32, kb = item / nblk, nb = item % nblk, k0 = 64 * kb, n0 = 32 * nb;
#pragma unroll 16
    for (int i = 0; i < 32; ++i) { const int kk = 2 * i + (lane >> 5); float w = J.W[(size_t)(k0 + kk) * J.ldw + J.col0 + n0 + (lane & 31)];
        if (J.kg) { const int k = k0 + kk; w *= (J.kg2 && k >= 512) ? J.kg2[k - 512] : J.kg[k]; }
        scr[kk * 33 + (lane & 31)] = w; }
    asm volatile("s_waitcnt lgkmcnt(0)" ::: "memory");
    const int c = lane & 7;
#pragma unroll
    for (int j = 0; j < 4; ++j) { const int n = (lane >> 3) + 8 * j; const LAS float* s = scr + (8 * c) * 33 + n;
        u32x4 o; o.x = pk2(s[0 * 33], s[1 * 33]); o.y = pk2(s[2 * 33], s[3 * 33]); o.z = pk2(s[4 * 33], s[5 * 33]); o.w = pk2(s[6 * 33], s[7 * 33]);
        *(u32x4*)(J.WT + (size_t)tmap(J.mapid, n0 + n, J.rowoff) * J.K + k0 + 8 * c) = o; }
    asm volatile("s_waitcnt lgkmcnt(0)" ::: "memory");
}
constexpr int NTJ = 11;
__device__ __forceinline__ void get_tjob(InTab in, unsigned char* ws, int j, TJob& J) {
    J.kg = nullptr; J.kg2 = nullptr; J.mapid = 0; J.rowoff = 0; J.col0 = 0;
    switch (j) {
    case 0: J.W = in[I_W_IN]; J.ldw = INCOLS; J.col0 = 0; J.ncols = 1024; J.K = 1024; J.WT = (bf16_t*)(ws + WS_WIN); J.mapid = 1; break;
    case 1: J.W = in[I_W_IN]; J.ldw = INCOLS; J.col0 = 1024; J.ncols = 512; J.K = 1024; J.WT = (bf16_t*)(ws + WS_WIN); J.rowoff = 1024; break;
    case 2: J.W = in[I_W_IN]; J.ldw = INCOLS; J.col0 = 1544; J.ncols = 512; J.K = 1024; J.WT = (bf16_t*)(ws + WS_WIN); J.rowoff = 1536; break;
    case 3: J.W = in[I_WGLU]; J.ldw = 512; J.ncols = 512; J.K = 512; J.WT = (bf16_t*)(ws + WS_WGLU); break;
    case 4: J.W = in[I_WOUT]; J.ldw = 1024; J.ncols = 1024; J.K = 1024; J.WT = (bf16_t*)(ws + WS_WOUT); J.kg = in[I_ONF]; J.kg2 = in[I_ONS]; break;
    case 5: J.W = in[I_WXQ]; J.ldw = 1024; J.ncols = 1024; J.K = 1024; J.WT = (bf16_t*)(ws + WS_WXQ); J.kg = in[I_NCROSS]; break;
    case 6: J.W = in[I_WXKV]; J.ldw = 2048; J.col0 = 0; J.ncols = 1024; J.K = 1024; J.WT = (bf16_t*)(ws + WS_WXK); break;
    case 7: J.W = in[I_WXKV]; J.ldw = 2048; J.col0 = 1024; J.ncols = 1024; J.K = 1024; J.WT = (bf16_t*)(ws + WS_WXV); break;
    case 8: J.W = in[I_WXO]; J.ldw = 1024; J.ncols = 1024; J.K = 1024; J.WT = (bf16_t*)(ws + WS_WXO); break;
    case 9: J.W = in[I_WUP]; J.ldw = 2 * DFF; J.ncols = 2 * DFF; J.K = 1024; J.WT = (bf16_t*)(ws + WS_WUP); J.kg = in[I_NFFN]; J.mapid = 2; break;
    default: J.W = in[I_WDN]; J.ldw = 1024; J.ncols = 1024; J.K = DFF; J.WT = (bf16_t*)(ws + WS_WDN); break;
    }
    J.items = (J.K / 64) * (J.ncols / 32);
}

__device__ __forceinline__ void rms_row(const float* xrow, const float* gain, bf16_t* orow, int lane, f32x4 (&v)[4]) {
    const f32x4* xr = (const f32x4*)xrow + lane; float s = 0.f;
#pragma unroll
    for (int j = 0; j < 4; ++j) { v[j] = xr[64 * j]; s += (v[j][0] * v[j][0] + v[j][1] * v[j][1]) + (v[j][2] * v[j][2] + v[j][3] * v[j][3]); }
    const float rs = rsqrtf(wave_sum(s) * (1.f / DM) + EPS);
    u32x2* o8 = (u32x2*)orow + lane;
#pragma unroll
    for (int j = 0; j < 4; ++j) { v[j] = v[j] * rs * ((const f32x4*)gain)[64 * j + lane]; u32x2 w; w.x = pk2(v[j][0], v[j][1]); w.y = pk2(v[j][2], v[j][3]); o8[64 * j] = w; }
}

__device__ __forceinline__ void cpow(float ar, float ai, float dt, float e, float& r, float& i) {
    const float mag = __expf(ar * dt * e);
    float rev = ai * dt * e * 0.15915494309189535f; rev -= rintf(rev);
    const float ang = rev * 6.283185307179586f;
    r = mag * cosf(ang); i = mag * sinf(ang);
}

__device__ __forceinline__ void s5_prep_task(InTab in, unsigned char* ws, int g, int tt, LAS float* L, int tid) {
    LAS float* pwA = L; LAS float* pwB = L + 128; LAS float* pwC = L + 256; LAS float* cf = L + 384; LAS float* bb = L + 512; LAS float* cc = L + 512 + 2048;
    const float dt = __expf(in[I_LOGDT][g]);
    if (tid < 64) { const int p = tid; const float ar = in[I_ARE][g * 64 + p], ai = in[I_AIM][g * 64 + p];
        float r, i; cpow(ar, ai, dt, (float)tt, r, i); pwA[2 * p] = r; pwA[2 * p + 1] = i;
        cpow(ar, ai, dt, (float)(tt + 1), r, i); pwB[2 * p] = r; pwB[2 * p + 1] = i;
        cpow(ar, ai, dt, (float)(TC - 1 - tt), r, i); pwC[2 * p] = r; pwC[2 * p + 1] = i;
        float lr, li; cpow(ar, ai, dt, 1.f, lr, li);
        const float den = ar * ar + ai * ai, nr = lr - 1.f;
        cf[2 * p] = (nr * ar + li * ai) / den; cf[2 * p + 1] = (li * ar - nr * ai) / den;
        if (tt == 0) { cpow(ar, ai, dt, (float)TC, r, i); float* lb = (float*)(ws + WS_LB32); lb[(g * 64 + p) * 2] = r; lb[(g * 64 + p) * 2 + 1] = i; } }
    for (int idx = tid; idx < 1024; idx += 512) { cc[2 * idx] = in[I_CRE][g * 1024 + idx]; cc[2 * idx + 1] = in[I_CIM][g * 1024 + idx]; }
    __syncthreads();
    for (int idx = tid; idx < 1024; idx += 512) { const int p = idx >> 4; const float br = in[I_BRE][g * 1024 + idx], bi = in[I_BIM][g * 1024 + idx], cr = cf[2 * p], ci = cf[2 * p + 1];
        bb[2 * idx] = cr * br - ci * bi; bb[2 * idx + 1] = cr * bi + ci * br; }
    __syncthreads();
    if (tid < 256) {
        const int c = tid >> 4, cp = tid & 15; float s = 0.f;
        for (int p = 0; p < 64; ++p) { const float pr = pwA[2 * p], pi = pwA[2 * p + 1], br = bb[2 * (p * 16 + cp)], bi = bb[2 * (p * 16 + cp) + 1];
            const float mr = pr * br - pi * bi, mi = pr * bi + pi * br; s += cc[2 * (c * 64 + p)] * mr - cc[2 * (c * 64 + p) + 1] * mi; }
        if (tt == 0 && c == cp) s += in[I_D][g * 16 + c];
        ((float*)(ws + WS_KTAB))[((g * TC + tt) * 16 + c) * 16 + cp] = s;
    } else {
        const int u = tid - 256;
        bf16_t* bty = (bf16_t*)(ws + WS_BTY) + (size_t)g * 512 * UGP; bf16_t* bte = (bf16_t*)(ws + WS_BTE) + (size_t)g * 256 * 512;
        for (int idx = u; idx < 1024; idx += 256) { const int c = idx >> 6, p = idx & 63;
            const float cr = cc[2 * idx], ci = cc[2 * idx + 1], pr = pwB[2 * p], pi = pwB[2 * p + 1];
            const float zr = cr * pr - ci * pi, zi = cr * pi + ci * pr;
            *(unsigned*)(bty + (size_t)(tt * 16 + c) * UGP + 512 + 2 * p) = pk2(zr, -zi); }
        for (int idx = u; idx < 1024; idx += 256) { const int p = idx >> 4, cp = idx & 15;
            const float pr = pwC[2 * p], pi = pwC[2 * p + 1], br = bb[2 * idx], bi = bb[2 * idx + 1];
            bte[(size_t)(2 * p) * 512 + tt * 16 + cp] = (bf16_t)f2bf(pr * br - pi * bi); bte[(size_t)(2 * p + 1) * 512 + tt * 16 + cp] = (bf16_t)f2bf(pr * bi + pi * br); }
        *(u32x4*)(bte + (size_t)(128 + (u >> 1)) * 512 + tt * 16 + (u & 1) * 8) = (u32x4){0u, 0u, 0u, 0u};
    }
    __syncthreads();
}

#define RLX_AGENT __ATOMIC_RELAXED, __HIP_MEMORY_SCOPE_AGENT
#define XB_TMO      128
#define XB_XCNT(j)  (256  + 64 * (j))
#define XB_XSUB(j)  (1280 + 64 * (j))
#define XB_XGEN(j)  (2304 + 64 * (j))
#define XB_TOP      3328
#define XB_TOPGEN   3392
#define XCD_BAR_WORDS 3456
#define XB_SPIN_CAP (1u << 18)

__device__ __forceinline__ unsigned xb_ld(unsigned* p)              { return __hip_atomic_load(p, __ATOMIC_RELAXED, __HIP_MEMORY_SCOPE_AGENT); }
__device__ __forceinline__ unsigned xb_add(unsigned* p, unsigned v) { return __hip_atomic_fetch_add(p, v, __ATOMIC_RELAXED, __HIP_MEMORY_SCOPE_AGENT); }
__device__ __forceinline__ unsigned xb_xcc_id() { return (unsigned)__builtin_amdgcn_s_getreg((3 << 11) | 20) & 0xFu; }
#define XB_SPIN(cond, bar) do { unsigned _sp = 0; while (cond) { __builtin_amdgcn_s_sleep(1); \
    if ((++_sp & 255u) == 0u) { if (xb_ld(&(bar)[XB_TMO])) break; if (_sp > XB_SPIN_CAP) { atomicAdd(&(bar)[XB_TMO], 1u); break; } } } } while (0)

struct XcdBarrier {
    unsigned* bar; unsigned x;
    volatile LAS unsigned* st;
};

__device__ __forceinline__ XcdBarrier xcd_barrier_post(unsigned* bar, volatile LAS unsigned* st) {
    XcdBarrier b; b.bar = bar; b.x = xb_xcc_id(); b.st = st;
    if (threadIdx.x == 0) (void)xb_add(&bar[XB_XCNT(b.x)], 1u);
    return b;
}
__device__ __forceinline__ void xcd_barrier_complete(unsigned* bar, unsigned x, unsigned& nloc, unsigned& nx) {
    const unsigned G = gridDim.x * gridDim.y * gridDim.z;
    unsigned sum, cnt, mine, sp = 0u;
    for (;;) {
        sum = 0u; cnt = 0u; mine = 0u;
#pragma unroll
        for (unsigned j = 0; j < 16; ++j) { const unsigned c = xb_ld(&bar[XB_XCNT(j)]); sum += c; cnt += (c > 0u) ? 1u : 0u; mine = (j == x) ? c : mine; }
        if (sum == G) break;
        __builtin_amdgcn_s_sleep(1);
        if ((++sp & 255u) == 0u) { if (xb_ld(&bar[XB_TMO])) break; if (sp > XB_SPIN_CAP) { atomicAdd(&bar[XB_TMO], 1u); break; } }
    }
    nloc = mine > 0u ? mine : 1u; nx = cnt > 0u ? cnt : 1u;
}

__device__ __forceinline__ void xcd_barrier(const XcdBarrier& b) {
    asm volatile("s_waitcnt vmcnt(0)" ::: "memory");
    __syncthreads();
    if (threadIdx.x == 0) {
        unsigned* bar = b.bar;
        __builtin_amdgcn_s_waitcnt(0);
        unsigned nloc = b.st[0], nx = b.st[1];
        if (nloc == 0u) { xcd_barrier_complete(bar, b.x, nloc, nx); b.st[0] = nloc; b.st[1] = nx; }
        const unsigned old = xb_add(&bar[XB_XSUB(b.x)], 1u);
        const unsigned gen = old / nloc;
        if (old + 1u == (gen + 1u) * nloc) {
            __builtin_amdgcn_fence(__ATOMIC_RELEASE, "agent");
            asm volatile("s_waitcnt vmcnt(0)" ::: "memory");
            const unsigned og = xb_add(&bar[XB_TOP], 1u);
            const unsigned tg = og / nx;
            if (og + 1u == (tg + 1u) * nx) xb_add(&bar[XB_TOPGEN], 1u);
            else XB_SPIN(xb_ld(&bar[XB_TOPGEN]) == tg, bar);
            __builtin_amdgcn_fence(__ATOMIC_ACQUIRE, "agent");
            xb_add(&bar[XB_XGEN(b.x)], 1u);
            asm volatile("s_waitcnt vmcnt(0)" ::: "memory");
        } else {
            XB_SPIN(xb_ld(&bar[XB_XGEN(b.x)]) == gen, bar);
            __builtin_amdgcn_fence(__ATOMIC_ACQUIRE, "agent");
            asm volatile("s_waitcnt vmcnt(0)" ::: "memory");
        }
    }
    __syncthreads();
}


#ifndef FIRST_STEP
#define FIRST_STEP 0
#endif
#ifndef LAST_STEP
#define LAST_STEP 18
#endif
#define ON(n) (FIRST_STEP <= (n) && (n) <= LAST_STEP)
#define SYNC(n) do { if ((n) < LAST_STEP) { XcdBarrier bar_; bar_.bar = (unsigned*)ws; bar_.x = xb_xcc_id(); bar_.st = (volatile LAS unsigned*)(L + RING_BYTES + 352); xcd_barrier(bar_); } } while (0)
#define WSB(off) ((const bf16_t*)(ws + (off)))
__global__ void __launch_bounds__(512, 2) fox_s5_mega(Args a) {
    extern __shared__ __attribute__((aligned(16))) unsigned char lds[];
    LAS unsigned char* L = (LAS unsigned char*)lds;
    const int G = gridDim.x, bx = blockIdx.x, NGW = G * 8, NGT = G * 512;
#define KA const __attribute__((address_space(4))) unsigned char* ka_ = (const __attribute__((address_space(4))) unsigned char*)__builtin_amdgcn_kernarg_segment_ptr(); asm volatile("" : "+s"(ka_)); \
    InTab in = (InTab)ka_; float* out = *(float* const __attribute__((address_space(4)))*)(ka_ + 256); unsigned char* ws = *(unsigned char* const __attribute__((address_space(4)))*)(ka_ + 264); (void)in; (void)out;
#define IDS int tid = threadIdx.x; asm volatile("" : "+v"(tid)); const int lane = tid & 63, wave = __builtin_amdgcn_readfirstlane(tid >> 6); const int gw = bx * 8 + wave, gt = bx * 512 + tid; (void)lane; (void)gw; (void)gt;
    {
        KA
        if (threadIdx.x < 8) ((volatile LAS unsigned*)(L + RING_BYTES + 320))[threadIdx.x + 8 - 8] = 0u;
        if (threadIdx.x < 2) ((volatile LAS unsigned*)(L + RING_BYTES + 352))[threadIdx.x] = 0u;
        __syncthreads();
        (void)xcd_barrier_post((unsigned*)ws, (volatile LAS unsigned*)(L + RING_BYTES + 352));
    }

    if (ON(0)) {
        KA
        IDS
        LAS float* scr = (LAS float*)(L + wave * 16384);
        { int base = 0;
          for (int j = 0; j < NTJ; ++j) { TJob J; get_tjob(in, ws, j, J);
              int first = gw - (base % NGW); if (first < 0) first += NGW;
              for (int it = first; it < J.items; it += NGW) transpose_item(J, scr, it, lane);
              base += J.items; } }
        __syncthreads();
        LAS float* wf = (LAS float*)L;
        for (int idx = tid; idx < 8192; idx += 512) wf[idx] = in[I_W_IN][(size_t)(idx >> 3) * INCOLS + 1536 + (idx & 7)];
        __syncthreads();
        {
            f32x4 nx[4];
            if (gw < T) { const f32x4* xr = (const f32x4*)(in[I_X] + (size_t)gw * DM) + lane;
#pragma unroll
                for (int j = 0; j < 4; ++j) nx[j] = xr[64 * j]; }
            const f32x4* gp = (const f32x4*)in[I_NORM_MIX]; f32x4 gn[4];
#pragma unroll
            for (int j = 0; j < 4; ++j) gn[j] = gp[64 * j + lane];
            const float fbias = in[I_FBIAS][lane & 7];
            for (int m = gw; m < T; m += NGW) {
                f32x4 v[4]; float s = 0.f;
#pragma unroll
                for (int j = 0; j < 4; ++j) { v[j] = nx[j]; s += (v[j][0] * v[j][0] + v[j][1] * v[j][1]) + (v[j][2] * v[j][2] + v[j][3] * v[j][3]); }
                if (m + NGW < T) { const f32x4* xr = (const f32x4*)(in[I_X] + (size_t)(m + NGW) * DM) + lane;
#pragma unroll
                    for (int j = 0; j < 4; ++j) nx[j] = xr[64 * j]; }
                const float rs = rsqrtf(wave_sum(s) * (1.f / DM) + EPS);
                u32x2* o8 = (u32x2*)((bf16_t*)(ws + WS_HN) + (size_t)m * DM) + lane;
#pragma unroll
                for (int j = 0; j < 4; ++j) { v[j] = v[j] * rs * gn[j]; u32x2 w; w.x = pk2(v[j][0], v[j][1]); w.y = pk2(v[j][2], v[j][3]); o8[64 * j] = w; }
                float d[8];
#pragma unroll
                for (int h = 0; h < 8; ++h) d[h] = 0.f;
#pragma unroll
                for (int j = 0; j < 4; ++j)
#pragma unroll
                    for (int i = 0; i < 4; ++i) { const int k = 256 * j + 4 * lane + i; const f32x4 w0 = *(const LAS f32x4*)(wf + k * 8), w1 = *(const LAS f32x4*)(wf + k * 8 + 4);
                        d[0] += v[j][i] * w0[0]; d[1] += v[j][i] * w0[1]; d[2] += v[j][i] * w0[2]; d[3] += v[j][i] * w0[3];
                        d[4] += v[j][i] * w1[0]; d[5] += v[j][i] * w1[1]; d[6] += v[j][i] * w1[2]; d[7] += v[j][i] * w1[3]; }
                float e4[4];
#pragma unroll
                for (int h = 0; h < 4; ++h) { const float keep = (lane & 4) ? d[h + 4] : d[h], give = (lane & 4) ? d[h] : d[h + 4]; e4[h] = keep + __shfl_xor(give, 4); }
                float e2[2];
#pragma unroll
                for (int h = 0; h < 2; ++h) { const float keep = (lane & 2) ? e4[h + 2] : e4[h], give = (lane & 2) ? e4[h] : e4[h + 2]; e2[h] = keep + __shfl_xor(give, 2); }
                float z; { const float keep = (lane & 1) ? e2[1] : e2[0], give = (lane & 1) ? e2[0] : e2[1]; z = keep + __shfl_xor(give, 1); }
                z += __shfl_xor(z, 8); z += __shfl_xor(z, 16); z += __shfl_xor(z, 32);
                if (lane < 8) {
                    z += fbias;
                    const float ls = fminf(z, 0.f) - __logf(1.f + __expf(-fabsf(z)));
                    const int b = m >> 11, t = m & 2047;
                    ((float*)(ws + WS_LOGF))[(size_t)(b * 8 + lane) * SEQ + t] = ls; }
            }
        }
        for (int m = gw; m < TM; m += NGW) { f32x4 v[4]; rms_row(in[I_MEM] + (size_t)m * DM, in[I_NMEM], (bf16_t*)(ws + WS_MN) + (size_t)m * DM, lane, v); }
        __syncthreads();
        for (int task = bx; task < S5G * TC; task += G) { const int per = (S5G * TC) / G; const int t2 = ((S5G * TC) % G == 0) ? (task % G) * per + task / G : task;
            s5_prep_task(in, ws, t2 / TC, t2 % TC, (LAS float*)L, tid); }
        SYNC(0);
    }
    if (ON(1)) {
        KA
        IDS
        const float* kt = (const float*)(ws + WS_KTAB); bf16_t* bty = (bf16_t*)(ws + WS_BTY);
        for (int idx = gt; idx < S5G * 512 * 64; idx += NGT) {
            const int half = idx & 1, ss = (idx >> 1) & 31, nn = (idx >> 6) & 511, gI = idx >> 15; const int tt = nn >> 4, c = nn & 15;
            u32x4 w = (u32x4){0u, 0u, 0u, 0u};
            if (ss <= tt) { const float* src = kt + ((size_t)((gI * TC + (tt - ss)) * 16 + c)) * 16 + half * 8; const f32x4 k0 = *(const f32x4*)src, k1 = *(const f32x4*)(src + 4);
                w.x = pk2(k0[0], k0[1]); w.y = pk2(k0[2], k0[3]); w.z = pk2(k1[0], k1[1]); w.w = pk2(k1[2], k1[3]); }
            *(u32x4*)(bty + ((size_t)gI * 512 + nn) * UGP + ss * 16 + half * 8) = w; }
        if (wave == 0 && bx < BATCH * NFH) {
            const float* lf = (const float*)(ws + WS_LOGF) + (size_t)bx * SEQ + lane * 32; float* cb = (float*)(ws + WS_CB) + (size_t)bx * SEQ + lane * 32;
            f32x4 x[8]; float run = 0.f;
#pragma unroll
            for (int j = 0; j < 8; ++j) { x[j] = ((const f32x4*)lf)[j]; x[j][0] += run; x[j][1] += x[j][0]; x[j][2] += x[j][1]; x[j][3] += x[j][2]; run = x[j][3]; }
            float incl = run;
#pragma unroll
            for (int o = 1; o < 64; o <<= 1) { const float y = __shfl_up(incl, o); if (lane >= o) incl += y; }
            const float excl = incl - run;
#pragma unroll
            for (int j = 0; j < 8; ++j) ((f32x4*)cb)[j] = (x[j] + excl) * LOG2E;
        }
    }
    if (ON(2)) {
        KA
        pg8::Gemm g{WSB(WS_HN), WSB(WS_WIN), DM, DM, DM}; GOrder<OK_PLAIN> S; S.init(T / 256, 8, G, bx, DM, DM);
        Epi<EK_PROJ> E{ws + WS_Q, ws + WS_K, ws + WS_V, ws + WS_UG, in[I_FQN], in[I_FKN], nullptr};
        pg8::gemm_phase(L, g, S, E);
    }
    if (ON(3)) {
        KA
        pg8::Gemm g{WSB(WS_MN), WSB(WS_WXK), DM, DM, DM}; GOrder<OK_PLAIN> S; S.init(TM / 256, 4, G, bx, DM, DM);
        Epi<EK_MEMK> E{ws + WS_KST, ws + WS_SSQK, nullptr, nullptr, nullptr, nullptr, nullptr};
        pg8::gemm_phase(L, g, S, E);
    }
    if (ON(4)) {
        KA
        pg8::Gemm g{WSB(WS_WXV), WSB(WS_MN), DM, DM, DM}; GOrder<OK_PLAIN> S; S.init(4, TM / 256, G, (bx + 128) % G, DM, DM);
        Epi<EK_MEMVT> E{ws + WS_VT, nullptr, nullptr, nullptr, nullptr, nullptr, nullptr};
        pg8::gemm_phase(L, g, S, E);
        SYNC(4);
    }
    if (ON(5)) {
        KA
        const int vcu = (G % 8 == 0) ? (bx % 8) * (G / 8) + bx / 8 : bx;
        for (int L2 = vcu; L2 < BATCH * NFH * 2; L2 += G) { const int bh = L2 >> 1, s = L2 & 1;
            for (int i = 0; i < 4; ++i) { const int qb = (i == 0) ? s : (i == 1) ? 3 - s : (i == 2) ? 4 + s : 7 - s;
                attn_body::attn_unit<8>(bh >> 3, bh & 7, qb, (const attn_body::bf16*)(ws + WS_Q), (const attn_body::bf16*)(ws + WS_K), (const attn_body::bf16*)(ws + WS_V),
                                        (attn_body::bf16*)(ws + WS_FOX), (const float*)(ws + WS_CB), (float*)(ws + WS_SSQF), (char*)lds); } }
    }
    if (ON(6)) {
        KA
        pg8::Gemm g{WSB(WS_UG), WSB(WS_BTE), UGP, 512, 256}; GOrder<OK_S5E> S; S.init(256, 1, G, bx, UGP, 512);
        Epi<EK_S5E> E{ws + WS_EPART, nullptr, nullptr, nullptr, nullptr, nullptr, nullptr};
        pg8::gemm_phase(L, g, S, E);
        SYNC(6);
    }
    if (ON(7)) {
        KA
        IDS
        const float* ep = (const float*)(ws + WS_EPART); const float* lb = (const float*)(ws + WS_LB32); bf16_t* ug = (bf16_t*)(ws + WS_UG);
        for (int idx = gt; idx < S5G * BATCH * S5P; idx += NGT) { const int p = idx & 63, gb = idx >> 6, gI = gb >> 4;
            const float lr = lb[(gI * 64 + p) * 2], li = lb[(gI * 64 + p) * 2 + 1]; float sr = 0.f, si = 0.f;
            for (int k0 = 0; k0 < NCH; k0 += 16) {
                f32x2 e0[16], e1[16];
#pragma unroll
                for (int j = 0; j < 16; ++j) { const size_t row = (size_t)gb * NCH + k0 + j; e0[j] = *(const f32x2*)(ep + row * 128 + 2 * p); e1[j] = *(const f32x2*)(ep + (size_t)32768 * 128 + row * 128 + 2 * p); }
#pragma unroll
                for (int j = 0; j < 16; ++j) { const size_t row = (size_t)gb * NCH + k0 + j;
                    *(unsigned*)(ug + row * UGP + 512 + 2 * p) = pk2(sr, si);
                    const float nr = lr * sr - li * si + (e0[j][0] + e1[j][0]), ni = lr * si + li * sr + (e0[j][1] + e1[j][1]); sr = nr; si = ni; } } }
        SYNC(7);
    }
    if (ON(8)) {
        KA
        pg8::Gemm g{WSB(WS_UG), WSB(WS_BTY), UGP, UGP, UGP}; GOrder<OK_S5Y> S; S.init(256, 1, G, bx, UGP, UGP);
        Epi<EK_S5Y> E{ws + WS_Y1, nullptr, nullptr, nullptr, nullptr, nullptr, nullptr};
        pg8::gemm_phase(L, g, S, E);
        SYNC(8);
    }
    if (ON(9)) {
        KA
        pg8::Gemm g{WSB(WS_Y1), WSB(WS_WGLU), 512, 512, 512}; GOrder<OK_PLAIN> S; S.init(T / 256, 2, G, bx, 512, 512);
        Epi<EK_GLU> E{ws + WS_Y2, ws + WS_SSQY, nullptr, nullptr, ws + WS_Y1, in[I_BGLU], nullptr};
        pg8::gemm_phase(L, g, S, E);
        SYNC(9);
    }
    if (ON(10)) {
        KA
        IDS
        const float* sf = (const float*)(ws + WS_SSQF); const float* sy = (const float*)(ws + WS_SSQY);
        const bf16_t* fox = WSB(WS_FOX); const bf16_t* y2 = WSB(WS_Y2); bf16_t* mx = (bf16_t*)(ws + WS_MIXN);
        {
            f32x4 a0, a1, b0, b1; u32x4 f, y;
#define NRM_LOAD(mm) do { a0 = *(const f32x4*)(sf + (size_t)(mm) * 8); a1 = *(const f32x4*)(sf + (size_t)(mm) * 8 + 4); b0 = *(const f32x4*)(sy + (size_t)(mm) * 8); b1 = *(const f32x4*)(sy + (size_t)(mm) * 8 + 4); \
                f = *(const u32x4*)(fox + (size_t)(mm) * 512 + lane * 8); y = *(const u32x4*)(y2 + (size_t)(mm) * 512 + lane * 8); } while (0)
            if (gw < T) NRM_LOAD(gw);
            for (int m = gw; m < T; m += NGW) {
                const float rf = rsqrtf((((a0[0] + a0[1]) + (a0[2] + a0[3])) + ((a1[0] + a1[1]) + (a1[2] + a1[3]))) * (1.f / 512.f) + EPS);
                const float ry = rsqrtf((((b0[0] + b0[1]) + (b0[2] + b0[3])) + ((b1[0] + b1[1]) + (b1[2] + b1[3]))) * (1.f / 512.f) + EPS);
                u32x4 of, oy;
                of.x = pk2(bflo(f.x) * rf, bfhi(f.x) * rf); of.y = pk2(bflo(f.y) * rf, bfhi(f.y) * rf); of.z = pk2(bflo(f.z) * rf, bfhi(f.z) * rf); of.w = pk2(bflo(f.w) * rf, bfhi(f.w) * rf);
                oy.x = pk2(bflo(y.x) * ry, bfhi(y.x) * ry); oy.y = pk2(bflo(y.y) * ry, bfhi(y.y) * ry); oy.z = pk2(bflo(y.z) * ry, bfhi(y.z) * ry); oy.w = pk2(bflo(y.w) * ry, bfhi(y.w) * ry);
                if (m + NGW < T) NRM_LOAD(m + NGW);
                *(u32x4*)(mx + (size_t)m * DM + lane * 8) = of; *(u32x4*)(mx + (size_t)m * DM + 512 + lane * 8) = oy; }
#undef NRM_LOAD
        }
        SYNC(10);
    }
    if (ON(11)) {
        KA
        pg8::Gemm g{WSB(WS_MIXN), WSB(WS_WOUT), DM, DM, DM}; GOrder<OK_PLAIN> S; S.init(T / 256, 4, G, bx, DM, DM);
        Epi<EK_WOUT> E{out, ws + WS_H1B, ws + WS_SSQ1, nullptr, in[I_X], nullptr, nullptr};
        pg8::gemm_phase(L, g, S, E);
        SYNC(11);
    }
    if (ON(12)) {
        KA
        IDS
        const float* sk = (const float*)(ws + WS_SSQK); float* sck = (float*)(ws + WS_SCK);
        for (int idx = gt; idx < TM * 4; idx += NGT) { const int key = idx >> 2, h = idx & 3; const f32x4 q = *(const f32x4*)(sk + (size_t)key * 16 + h * 4);
            sck[(size_t)h * TM + key] = rsqrtf(((q[0] + q[1]) + (q[2] + q[3])) * (1.f / 256.f) + EPS); }
        pg8::Gemm g{WSB(WS_H1B), WSB(WS_WXQ), DM, DM, DM}; GOrder<OK_PLAIN> S; S.init(T / 256, 4, G, bx, DM, DM);
        Epi<EK_XQ> E{ws + WS_QST, ws + WS_SSQQ, nullptr, nullptr, in[I_XQN], in[I_XKN], nullptr};
        pg8::gemm_phase(L, g, S, E);
        SYNC(12);
    }
    if (ON(13)) {
        KA
        pg8::Gemm g{WSB(WS_QST), WSB(WS_KST), DM, DM, 256}; GOrder<OK_XS> S; S.init(512, 1, G, bx, DM, DM);
        Epi<EK_XS> E{ws + WS_P, ws + WS_PSUM, nullptr, nullptr, ws + WS_SSQ1, ws + WS_SSQQ, ws + WS_SCK};
        pg8::gemm_phase(L, g, S, E);
        SYNC(13);
    }
    if (ON(14)) {
        KA
        pg8::Gemm g{WSB(WS_P), WSB(WS_VT), DM, TM, 256}; GOrder<OK_XO> S; S.init(512, 1, G, bx, DM, TM);
        Epi<EK_XO> E{ws + WS_XO, nullptr, nullptr, nullptr, ws + WS_PSUM, nullptr, nullptr};
        pg8::gemm_phase(L, g, S, E);
        SYNC(14);
    }
    if (ON(15)) {
        KA
        pg8::Gemm g{WSB(WS_XO), WSB(WS_WXO), DM, DM, DM}; GOrder<OK_PLAIN> S; S.init(T / 256, 4, G, bx, DM, DM);
        Epi<EK_WXO> E{out, ws + WS_H2B, ws + WS_SSQ2, nullptr, out, nullptr, nullptr};
        pg8::gemm_phase(L, g, S, E);
        SYNC(15);
    }
    if (ON(16)) {
        KA
        { IDS
          const float* s2 = (const float*)(ws + WS_SSQ2); float* r2 = (float*)(ws + WS_RS2);
          for (int row = gt; row < T; row += NGT) { const f32x4 t0 = *(const f32x4*)(s2 + (size_t)row * 16), t1 = *(const f32x4*)(s2 + (size_t)row * 16 + 4), t2 = *(const f32x4*)(s2 + (size_t)row * 16 + 8), t3 = *(const f32x4*)(s2 + (size_t)row * 16 + 12);
              r2[row] = rsqrtf((((t0[0] + t0[1]) + (t0[2] + t0[3])) + ((t1[0] + t1[1]) + (t1[2] + t1[3])) + ((t2[0] + t2[1]) + (t2[2] + t2[3])) + ((t3[0] + t3[1]) + (t3[2] + t3[3]))) * (1.f / DM) + EPS); }
          SYNC(15); }
        pg8::Gemm g{WSB(WS_H2B), WSB(WS_WUP), DM, DM, DM}; GOrder<OK_PLAIN> S; S.init(T / 256, 22, G, bx, DM, DM);
        Epi<EK_UPC> E{ws + WS_U, ws + WS_G, ws + WS_G + 4 * MiB, ws + WS_G + 8 * MiB, ws + WS_RS2, in[I_CONVW], in[I_CONVB], (LAS float*)(L + RING_BYTES + 1024)};
        pg8::gemm_phase(L, g, S, E);
        SYNC(16);
    }
    if (ON(17)) {
        KA
        IDS
        const float* GHF = (const float*)(ws + WS_G); const float* GHL = (const float*)(ws + WS_G + 4 * MiB); const float* UH = (const float*)(ws + WS_G + 8 * MiB);
        const float* cw = in[I_CONVW]; const float* cbv = in[I_CONVB]; bf16_t* A = (bf16_t*)(ws + WS_U);
        for (int idx = gt; idx < (T / 256) * 2 * DFF; idx += NGT) { const int j = idx % DFF, pi = idx / DFF, i = pi & 1, pm = pi >> 1; const bool first = (pm & 7) == 0;
            const float g0 = GHF[(size_t)pi * DFF + j];
            const float gl1 = first ? 0.f : GHL[((size_t)(pm - 1) * 2 + 1) * DFF + j], gl0 = first ? 0.f : GHL[((size_t)(pm - 1) * 2) * DFF + j];
            const float g1 = i ? GHF[(size_t)(pm * 2) * DFF + j] : gl1, g2 = i ? gl1 : gl0;
            const float z = cbv[j] + cw[j] * g2 + cw[DFF + j] * g1 + cw[2 * DFF + j] * g0;
            A[(size_t)(pm * 256 + i) * DFF + j] = (bf16_t)f2bf(z * sigm(z) * UH[(size_t)pi * DFF + j]); }
        SYNC(17);
    }
    if (ON(18)) {
        KA
        pg8::Gemm g{WSB(WS_U), WSB(WS_WDN), DFF, DFF, DFF}; GOrder<OK_PLAIN> S; S.init(T / 256, 4, G, bx, DFF, DFF);
        Epi<EK_DOWN> E{out, nullptr, nullptr, nullptr, nullptr, nullptr, nullptr};
        pg8::gemm_phase(L, g, S, E);
    }
}

extern "C" void kernel_launch(void* const* d_in, const int* in_sizes, int n_in, void* d_out, int out_size, void* d_ws, size_t ws_size, hipStream_t stream) {
    static int grid = 0;
    if (grid == 0) {
        if (n_in != 32 || out_size != T * DM || ws_size < WS_END) { fprintf(stderr, "kernel_launch: unexpected shapes (n_in %d out %d ws %zu)\n", n_in, out_size, ws_size); grid = -1; return; }
        int dev = 0, cus = 0, per_cu = 0;
        (void)hipGetDevice(&dev); (void)hipDeviceGetAttribute(&cus, hipDeviceAttributeMultiprocessorCount, dev);
        if (hipFuncSetAttribute((const void*)fox_s5_mega, hipFuncAttributeMaxDynamicSharedMemorySize, LDS_TOTAL) != hipSuccess) { fprintf(stderr, "kernel_launch: hipFuncSetAttribute failed\n"); grid = -1; return; }
        if (hipOccupancyMaxActiveBlocksPerMultiprocessor(&per_cu, (const void*)fox_s5_mega, 512, LDS_TOTAL) != hipSuccess || per_cu < 1) { fprintf(stderr, "kernel_launch: occupancy query says %d\n", per_cu); per_cu = 1; }
        (void)hipGetLastError();
        grid = cus;
        if (grid > cus * per_cu) grid = cus * per_cu;
    }
    if (grid < 0) return;
    if (hipMemsetAsync(d_ws, 0, 65536, stream) != hipSuccess) { fprintf(stderr, "kernel_launch: memset of the barrier words failed\n"); return; }
    Args a{};
    for (int i = 0; i < 32; ++i) a.in[i] = (const float*)d_in[i];
    a.out = (float*)d_out; a.ws = (unsigned char*)d_ws;
    void* args[] = {&a};
    hipError_t e = hipLaunchCooperativeKernel((const void*)fox_s5_mega, dim3(grid), dim3(512), args, LDS_TOTAL, stream);
    if (e != hipSuccess) fprintf(stderr, "cooperative launch failed: %s (grid %d)\n", hipGetErrorString(e), grid);
}
```

```cpp
#include <hip/hip_runtime.h>
#include <hip/hip_cooperative_groups.h>
#include <hip/hip_bf16.h>
#include <cstdio>
#include <cstdint>
#include <cmath>
namespace cg = cooperative_groups;

constexpr int BATCH = 16, SEQ = 2048, DM = 1024, T = BATCH * SEQ;
constexpr int NMEM = 256, TM = BATCH * NMEM;
constexpr int FOXW = 512, HD = 64, NFH = 8;
constexpr int S5W = 512, S5G = 32, S5C = 16, S5P = 64;
constexpr int NXH = 4, XHD = 256;
constexpr int DFF = 2816;
constexpr int INCOLS = 2056;
constexpr float EPS = 1e-6f;
constexpr int TC = 32, NCH = SEQ / TC;
constexpr int UGP = TC * 16 + 128;
constexpr float LOG2E = 1.4426950408889634f;
constexpr float C2Q = 0.125f * LOG2E;

#define LAS __attribute__((address_space(3)))
typedef unsigned short bf16_t;
typedef short bf16x8 __attribute__((ext_vector_type(8)));
typedef float f32x4 __attribute__((ext_vector_type(4)));
typedef float f32x2 __attribute__((ext_vector_type(2)));
typedef unsigned u32x4 __attribute__((ext_vector_type(4)));
typedef unsigned u32x2 __attribute__((ext_vector_type(2)));

__device__ __forceinline__ unsigned f2bf(float f) { unsigned u = __builtin_bit_cast(unsigned, f); return (u + 0x7fffu + ((u >> 16) & 1u)) >> 16; }
__device__ __forceinline__ unsigned pk2(float lo, float hi) { return f2bf(lo) | (f2bf(hi) << 16); }
__device__ __forceinline__ float bflo(unsigned w) { return __builtin_bit_cast(float, w << 16); }
__device__ __forceinline__ float bfhi(unsigned w) { return __builtin_bit_cast(float, w & 0xffff0000u); }
__device__ __forceinline__ float wave_sum(float v) {
#pragma unroll
    for (int o = 1; o < 64; o <<= 1) v += __shfl_xor(v, o);
    return v;
}

__device__ __forceinline__ float red_fq(float v) {
    v += __builtin_bit_cast(float, __builtin_amdgcn_ds_swizzle(__builtin_bit_cast(int, v), 0x401F));
    float a = v, b = v;
    asm volatile("s_nop 1\n\tv_permlane32_swap_b32 %0, %1\n\ts_nop 1" : "+v"(a), "+v"(b));
    return a + b;
}

constexpr size_t MiB = 1u << 20;
constexpr size_t WS_WIN = 1 * MiB, WS_WGLU = 5 * MiB, WS_WOUT = 6 * MiB, WS_WXQ = 8 * MiB, WS_WXK = 10 * MiB, WS_WXV = 12 * MiB, WS_WXO = 14 * MiB,
                 WS_WUP = 16 * MiB, WS_WDN = 27 * MiB, WS_BTY = 33 * MiB, WS_BTE = 53 * MiB, WS_KTAB = 61 * MiB, WS_LB32 = 62 * MiB, WS_LOGF = 63 * MiB,
                 WS_CB = 64 * MiB, WS_SSQF = 65 * MiB, WS_SSQY = 66 * MiB, WS_SSQ1 = 67 * MiB, WS_SSQ2 = 69 * MiB, WS_SSQQ = 71 * MiB, WS_PSUM = 73 * MiB,
                 WS_SSQK = 75 * MiB, WS_SCK = 76 * MiB, WS_RS2 = 77 * MiB;
constexpr size_t WS_HN = 80 * MiB, WS_FOX = 80 * MiB, WS_Y1 = 112 * MiB, WS_QST = 80 * MiB, WS_H2B = 80 * MiB;
constexpr size_t WS_MN = 144 * MiB, WS_KST = 152 * MiB, WS_VT = 160 * MiB;
constexpr size_t WS_Q = 168 * MiB, WS_K = 200 * MiB, WS_V = 232 * MiB, WS_Y2 = 168 * MiB, WS_MIXN = 200 * MiB, WS_P = 168 * MiB;
constexpr size_t WS_UG = 264 * MiB, WS_EPART = 304 * MiB, WS_H1B = 264 * MiB, WS_XO = 264 * MiB;
constexpr size_t WS_G = 144 * MiB, WS_U = 320 * MiB, WS_END = 496 * MiB;

namespace pg8 {
constexpr int BM = 256, BK = 64, HALF = 128, HTB = HALF * BK * 2, STAGE_BYTES = 8 * HTB;
__device__ __forceinline__ int lds_byte(int r, int c) { const int st = (r >> 4) * 2 + (c >> 5), rr = r & 15, cc = c & 31, ob = rr * 64 + cc * 2; return st * 1024 + (ob ^ (((ob >> 9) & 1) << 5)); }
__device__ __forceinline__ void stage_rc(int b, int& R, int& C) { const int st = b / 1024, sb = b % 1024, swz = sb ^ (((sb >> 9) & 1) << 5); R = (st >> 1) * 16 + swz / 64; C = (st & 1) * 32 + (swz % 64) / 2; }
__device__ __forceinline__ int perm32(int rho) { const int n = rho >> 4, i = rho & 15; return 8 * (i >> 2) + 4 * n + (i & 3); }

struct Unit { int pm, pn; long offA, offB; };
struct Gemm { const bf16_t* A; const bf16_t* Bt; int lda, ldb, K; };

template <class Epi, class Sched>
__device__ __forceinline__ void gemm_phase(LAS unsigned char* lds, const Gemm g, const Sched& S, const Epi& E) {
    int tid = threadIdx.x; asm volatile("" : "+v"(tid));
    const int wid = __builtin_amdgcn_readfirstlane(tid >> 6), lane = tid & 63, wr = wid >> 2, wc = wid & 3, fr = lane & 15, fq = lane >> 4;
    const int K = g.K, nt = K / BK;
    unsigned voffA[2], voffB[2];
#pragma unroll
    for (int i = 0; i < 2; ++i) { int R, C; stage_rc(tid * 16 + i * 8192, R, C); const int Rb = (R & ~31) + perm32(R & 31);
        voffA[i] = (unsigned)(R * g.lda + C) * 2u; voffB[i] = (unsigned)(Rb * g.ldb + C) * 2u; }
    const size_t kstep = (size_t)(BK * 2);
    const size_t hstepA = (size_t)HALF * g.lda * 2, hstepB = (size_t)HALF * g.ldb * 2;
    const unsigned ldsw = (unsigned)wid * 1024u;
    const int aoff = lds_byte(wr * 64 + fr, fq * 8), boff = lds_byte(wc * 32 + fr, fq * 8);
#define PG8_SA(b, h) (((b) * 2 + (h)) * HTB)
#define PG8_SB(b, h) ((4 + (b) * 2 + (h)) * HTB)
#define PG8_STAGE(bufoff, gbase, voff) do { _Pragma("unroll") for (int _i = 0; _i < 2; ++_i) \
        __builtin_amdgcn_global_load_lds((const unsigned*)((const char*)(gbase) + (voff)[_i]), (LAS unsigned*)(lds + (bufoff) + ldsw + _i * 8192), 16, 0, 0); } while (0)
#define PG8_LDA(dst, b, h) do { _Pragma("unroll") for (int m = 0; m < 4; ++m) _Pragma("unroll") for (int k = 0; k < 2; ++k) dst[m][k] = *(const LAS bf16x8*)(lds + PG8_SA(b, h) + aoff + m * 2048 + k * 1024); } while (0)
#define PG8_LDB(dst, b, h) do { _Pragma("unroll") for (int n = 0; n < 2; ++n) _Pragma("unroll") for (int k = 0; k < 2; ++k) dst[n][k] = *(const LAS bf16x8*)(lds + PG8_SB(b, h) + boff + n * 2048 + k * 1024); } while (0)
#define PG8_MMA(ai, bj, At, Bt) do { __builtin_amdgcn_s_setprio(1); _Pragma("unroll") for (int m = 0; m < 4; ++m) _Pragma("unroll") for (int n = 0; n < 2; ++n) _Pragma("unroll") for (int k = 0; k < 2; ++k) \
        acc[ai][bj][m][n] = __builtin_amdgcn_mfma_f32_16x16x32_bf16(Bt[n][k], At[m][k], acc[ai][bj][m][n], 0, 0, 0); __builtin_amdgcn_s_setprio(0); } while (0)
#define PG8_WAIT_V(n) asm volatile("s_waitcnt vmcnt(" #n ")" ::: "memory")
#define PG8_WAIT_L(n) asm volatile("s_waitcnt lgkmcnt(" #n ")" ::: "memory")
#define PG8_BAR __builtin_amdgcn_s_barrier()
#define PG8_SCHED __builtin_amdgcn_sched_barrier(0)
    Unit cur, nxt; int ui = 0;
    if (!S.next(0, cur)) return;
    f32x4 acc[2][2][4][2];
#pragma unroll
    for (int a = 0; a < 2; ++a)
#pragma unroll
        for (int b = 0; b < 2; ++b)
#pragma unroll
            for (int m = 0; m < 4; ++m)
#pragma unroll
                for (int n = 0; n < 2; ++n) acc[a][b][m][n] = (f32x4){0.f, 0.f, 0.f, 0.f};
    bf16x8 At[4][2], B0[2][2], B1[2][2];
    const char* cA = (const char*)g.A + cur.offA; const char* cB = (const char*)g.Bt + cur.offB;
    PG8_STAGE(PG8_SB(0, 0), cB, voffB); PG8_STAGE(PG8_SB(0, 1), cB + hstepB, voffB); PG8_STAGE(PG8_SA(0, 0), cA, voffA); PG8_STAGE(PG8_SA(0, 1), cA + hstepA, voffA);
    if (wr == 1) PG8_BAR;
    PG8_WAIT_V(2); PG8_BAR;
    PG8_STAGE(PG8_SB(1, 0), cB + kstep, voffB); PG8_STAGE(PG8_SA(1, 0), cA + kstep, voffA); PG8_STAGE(PG8_SB(1, 1), cB + hstepB + kstep, voffB);
    PG8_WAIT_V(6); PG8_BAR;
    for (;;) {
        const bool has_next = S.next(ui + 1, nxt);
        const char* nA = has_next ? (const char*)g.A + nxt.offA : cA; const char* nB = has_next ? (const char*)g.Bt + nxt.offB : cB;
        for (int t = 0; t < nt; t += 2) {
            const bool last = (t == nt - 2);
            const char* a1 = cA + (size_t)(t + 1) * kstep;
            const char* a2 = last ? nA : cA + (size_t)(t + 2) * kstep; const char* b2 = last ? nB : cB + (size_t)(t + 2) * kstep;
            const char* a3 = a2 + kstep; const char* b3 = b2 + kstep;
            PG8_LDB(B0, 0, 0); PG8_LDB(B1, 0, 1); PG8_SCHED; PG8_LDA(At, 0, 0); PG8_STAGE(PG8_SA(1, 1), a1 + hstepA, voffA);
            PG8_WAIT_V(8); PG8_WAIT_L(0); PG8_BAR; PG8_MMA(0, 0, At, B0); PG8_MMA(0, 1, At, B1); PG8_BAR; PG8_SCHED;
            PG8_LDA(At, 0, 1); PG8_STAGE(PG8_SB(0, 0), b2, voffB); PG8_STAGE(PG8_SB(0, 1), b2 + hstepB, voffB); PG8_STAGE(PG8_SA(0, 0), a2, voffA);
            PG8_WAIT_V(8); PG8_WAIT_L(0); PG8_BAR; PG8_MMA(1, 0, At, B0); PG8_MMA(1, 1, At, B1); PG8_BAR; PG8_SCHED;
            PG8_LDB(B0, 1, 0); PG8_LDB(B1, 1, 1); PG8_SCHED; PG8_LDA(At, 1, 0); PG8_STAGE(PG8_SA(0, 1), a2 + hstepA, voffA);
            PG8_WAIT_V(8); PG8_WAIT_L(0); PG8_BAR; PG8_MMA(0, 0, At, B0); PG8_MMA(0, 1, At, B1); PG8_BAR; PG8_SCHED;
            PG8_LDA(At, 1, 1); PG8_STAGE(PG8_SB(1, 0), b3, voffB); PG8_STAGE(PG8_SB(1, 1), b3 + hstepB, voffB); PG8_STAGE(PG8_SA(1, 0), a3, voffA);
            PG8_WAIT_V(8); PG8_WAIT_L(0); PG8_BAR; PG8_MMA(1, 0, At, B0); PG8_MMA(1, 1, At, B1); PG8_BAR; PG8_SCHED;
        }
        if (wr == 0) PG8_BAR;
        { int fr2 = fr, fq2 = fq; asm volatile("" : "+v"(fr2), "+v"(fq2));
          E(acc, cur, wr, wc, fr2, fq2); }
        if (!has_next) break;
#pragma unroll
        for (int a = 0; a < 2; ++a)
#pragma unroll
            for (int b = 0; b < 2; ++b)
#pragma unroll
                for (int m = 0; m < 4; ++m)
#pragma unroll
                    for (int n = 0; n < 2; ++n) acc[a][b][m][n] = (f32x4){0.f, 0.f, 0.f, 0.f};
        cur = nxt; cA = nA; cB = nB; ++ui;
        if (wr == 1) PG8_BAR;
    }
    PG8_WAIT_V(0);
    PG8_BAR;
#undef PG8_SA
#undef PG8_SB
#undef PG8_STAGE
#undef PG8_LDA
#undef PG8_LDB
#undef PG8_MMA
#undef PG8_WAIT_V
#undef PG8_WAIT_L
#undef PG8_BAR
#undef PG8_SCHED
}
}
using pg8::Unit;

enum OrderKind { OK_PLAIN = 0, OK_S5E, OK_S5Y, OK_XS, OK_XO };
template <int kind> struct GOrder {
    int nM, nN, nwg, G, c, lda, ldb;
    __device__ __forceinline__ void init(int nM_, int nN_, int G_, int c_, int lda_, int ldb_) { nM = nM_; nN = nN_; nwg = nM_ * nN_; G = G_; c = c_; lda = lda_; ldb = ldb_; }
    __device__ __forceinline__ bool next(int i, Unit& u) const {
        const long L = (long)i * G + c; if (L >= nwg) return false;
        const int l = (int)L;
        if constexpr (kind == OK_PLAIN) {
            int wgid = l; { const int q = nwg / 8, r = nwg % 8, xcd = wgid % 8, off = wgid / 8; wgid = (xcd < r ? xcd * (q + 1) : r * (q + 1) + (xcd - r) * q) + off; }
            const int nig = 8 * nN, gid = wgid / nig, fm = gid * 8, gsz = (nM - fm) < 8 ? (nM - fm) : 8;
            u.pm = fm + ((wgid % nig) % gsz); u.pn = (wgid % nig) / gsz;
            u.offA = (long)u.pm * 256 * lda * 2; u.offB = (long)u.pn * 256 * ldb * 2;
        } else if constexpr (kind == OK_S5E) {
            const int kq = l & 1, pmm = (l >> 1) & 3, gg = l >> 3;
            u.pm = gg * 4 + pmm; u.pn = kq;
            u.offA = ((long)u.pm * 256 * UGP + kq * 256) * 2; u.offB = ((long)gg * 256 * 512 + kq * 256) * 2;
        } else if constexpr (kind == OK_S5Y) {
            const int pn = l & 1, pmm = (l >> 1) & 3, gg = l >> 3;
            u.pm = gg * 4 + pmm; u.pn = pn;
            u.offA = (long)u.pm * 256 * UGP * 2; u.offB = ((long)gg * 512 + pn * 256) * UGP * 2;
        } else if constexpr (kind == OK_XS) {
            const int h = l & 3, pm = l >> 2, b = pm >> 3;
            u.pm = pm; u.pn = h;
            u.offA = ((long)pm * 256 * DM + h * 256) * 2; u.offB = ((long)b * 256 * DM + h * 256) * 2;
        } else {
            const int h = l & 3, pm = l >> 2, b = pm >> 3;
            u.pm = pm; u.pn = h;
            u.offA = ((long)pm * 256 * DM + h * 256) * 2; u.offB = ((long)h * 256 * TM + b * 256) * 2;
        }
        return true;
    }
};

enum EpiKind { EK_PROJ = 0, EK_MEMK, EK_MEMVT, EK_S5E, EK_S5Y, EK_GLU, EK_WOUT, EK_XQ, EK_XS, EK_XO, EK_WXO, EK_UP, EK_DOWN, EK_GATE, EK_UPACT, EK_UPC };
    __device__ __forceinline__ u32x4 pack8(const f32x4 a, const f32x4 b) { u32x4 w; w.x = pk2(a[0], a[1]); w.y = pk2(a[2], a[3]); w.z = pk2(b[0], b[1]); w.w = pk2(b[2], b[3]); return w; }
    __device__ __forceinline__ float gelu_t(float y) { const float z = 0.7978845608028654f * (y + 0.044715f * y * y * y); const float e = __expf(2.f * z); const float th = 1.f - 2.f / (e + 1.f); return 0.5f * y * (1.f + th); }
    __device__ __forceinline__ float sigm(float z) { return 1.f / (1.f + __expf(-z)); }
    __device__ __forceinline__ float ssq8(const f32x4 a, const f32x4 b) { return (a[0] * a[0] + a[1] * a[1]) + (a[2] * a[2] + a[3] * a[3]) + (b[0] * b[0] + b[1] * b[1]) + (b[2] * b[2] + b[3] * b[3]); }

template <int kind> struct Epi {
    void* p0; void* p1; void* p2; void* p3; const void* c0; const void* c1; const void* c2; LAS float* hx;
    __device__ __forceinline__ void operator()(const f32x4 (&acc)[2][2][4][2], const Unit& u, int wr, int wc, int fr, int fq) const {
        const int rbase = u.pm * 256 + wr * 64 + fr;
        const int cl0 = wc * 32 + 8 * fq;
        switch (kind) {
        case EK_PROJ: {
            const int pn = u.pn;
            if (pn < 4) {
                const bool isq = pn < 2; bf16_t* dst = (bf16_t*)(isq ? p0 : p1); const float* gptr = (const float*)(isq ? c0 : c1); const float post = isq ? C2Q : 1.f;
                const int head = 4 * (pn & 1) + wc;
#pragma unroll
                for (int ai = 0; ai < 2; ++ai)
#pragma unroll
                    for (int m = 0; m < 4; ++m) {
                        float ss = ssq8(acc[ai][0][m][0], acc[ai][0][m][1]) + ssq8(acc[ai][1][m][0], acc[ai][1][m][1]);
                        ss = red_fq(ss);
                        const float sc = rsqrtf(ss * (1.f / 64.f) + EPS) * post;
                        const size_t row = (size_t)(rbase + ai * 128 + m * 16);
#pragma unroll
                        for (int bj = 0; bj < 2; ++bj)
                            *(u32x4*)(dst + row * 512 + head * 64 + 32 * bj + 8 * fq) = pack8(acc[ai][bj][m][0] * sc * *(const f32x4*)(gptr + 32 * bj + 8 * fq), acc[ai][bj][m][1] * sc * *(const f32x4*)(gptr + 32 * bj + 8 * fq + 4));
                    }
            } else if (pn < 6) {
                bf16_t* dst = (bf16_t*)p2;
#pragma unroll
                for (int ai = 0; ai < 2; ++ai)
#pragma unroll
                    for (int m = 0; m < 4; ++m) { const size_t row = (size_t)(rbase + ai * 128 + m * 16);
#pragma unroll
                        for (int bj = 0; bj < 2; ++bj) *(u32x4*)(dst + row * 512 + (pn - 4) * 256 + bj * 128 + cl0) = pack8(acc[ai][bj][m][0], acc[ai][bj][m][1]); }
            } else {
                bf16_t* dst = (bf16_t*)p3;
#pragma unroll
                for (int ai = 0; ai < 2; ++ai)
#pragma unroll
                    for (int m = 0; m < 4; ++m) { const int row = rbase + ai * 128 + m * 16; const int b = row >> 11, t = row & 2047, ch = t >> 5, s = t & 31;
#pragma unroll
                        for (int bj = 0; bj < 2; ++bj) { const int f = (pn - 6) * 256 + bj * 128 + cl0; const int gI = f >> 4, cc = f & 15;
                            *(u32x4*)(dst + ((size_t)(gI * 1024 + b * 64 + ch)) * UGP + s * 16 + cc) = pack8(acc[ai][bj][m][0], acc[ai][bj][m][1]); } }
            }
        } break;
        case EK_MEMK: {
            bf16_t* dst = (bf16_t*)p0; float* sq = (float*)p1;
#pragma unroll
            for (int ai = 0; ai < 2; ++ai)
#pragma unroll
                for (int m = 0; m < 4; ++m) { const size_t row = (size_t)(rbase + ai * 128 + m * 16);
                    float ss = ssq8(acc[ai][0][m][0], acc[ai][0][m][1]) + ssq8(acc[ai][1][m][0], acc[ai][1][m][1]);
                    ss = red_fq(ss);
                    if (fq == 0) sq[row * 16 + u.pn * 4 + wc] = ss;
#pragma unroll
                    for (int bj = 0; bj < 2; ++bj) *(u32x4*)(dst + row * DM + u.pn * 256 + bj * 128 + cl0) = pack8(acc[ai][bj][m][0], acc[ai][bj][m][1]); }
        } break;
        case EK_MEMVT: {
            bf16_t* dst = (bf16_t*)p0;
#pragma unroll
            for (int ai = 0; ai < 2; ++ai)
#pragma unroll
                for (int m = 0; m < 4; ++m) { const size_t row = (size_t)(rbase + ai * 128 + m * 16);
#pragma unroll
                    for (int bj = 0; bj < 2; ++bj) *(u32x4*)(dst + row * TM + u.pn * 256 + bj * 128 + cl0) = pack8(acc[ai][bj][m][0], acc[ai][bj][m][1]); }
        } break;
        case EK_S5E: {
            float* dst = (float*)p0 + (size_t)u.pn * 32768 * 128;
#pragma unroll
            for (int ai = 0; ai < 2; ++ai)
#pragma unroll
                for (int m = 0; m < 4; ++m) { const size_t row = (size_t)(rbase + ai * 128 + m * 16);
                    *(f32x4*)(dst + row * 128 + cl0) = acc[ai][0][m][0]; *(f32x4*)(dst + row * 128 + cl0 + 4) = acc[ai][0][m][1]; }
        } break;
        case EK_S5Y: {
            bf16_t* dst = (bf16_t*)p0;
#pragma unroll
            for (int ai = 0; ai < 2; ++ai)
#pragma unroll
                for (int m = 0; m < 4; ++m) { const int r = rbase + ai * 128 + m * 16; const int gI = r >> 10, b = (r >> 6) & 15, k = r & 63;
#pragma unroll
                    for (int bj = 0; bj < 2; ++bj) { const int nn = u.pn * 256 + bj * 128 + cl0; const int tt = nn >> 4, cc = nn & 15;
                        f32x4 a = acc[ai][bj][m][0], c = acc[ai][bj][m][1];
#pragma unroll
                        for (int j = 0; j < 4; ++j) { a[j] = gelu_t(a[j]); c[j] = gelu_t(c[j]); }
                        *(u32x4*)(dst + ((size_t)(b * SEQ + k * TC + tt)) * 512 + gI * 16 + cc) = pack8(a, c); } }
        } break;
        case EK_GLU: {
            bf16_t* dst = (bf16_t*)p0; float* sq = (float*)p1; const bf16_t* y1 = (const bf16_t*)c0; const float* bg = (const float*)c1;
            f32x4 bv[2][2];
#pragma unroll
            for (int bj = 0; bj < 2; ++bj)
#pragma unroll
                for (int n = 0; n < 2; ++n) bv[bj][n] = *(const f32x4*)(bg + u.pn * 256 + bj * 128 + cl0 + 4 * n);
#pragma unroll
            for (int ai = 0; ai < 2; ++ai)
#pragma unroll
                for (int m = 0; m < 4; ++m) { const size_t row = (size_t)(rbase + ai * 128 + m * 16); float ss = 0.f;
#pragma unroll
                    for (int bj = 0; bj < 2; ++bj) { const size_t off = row * 512 + u.pn * 256 + bj * 128 + cl0;
                        const u32x4 yv = *(const u32x4*)(y1 + off);
                        f32x4 a = acc[ai][bj][m][0] + bv[bj][0], c = acc[ai][bj][m][1] + bv[bj][1];
                        a[0] = bflo(yv.x) * sigm(a[0]); a[1] = bfhi(yv.x) * sigm(a[1]); a[2] = bflo(yv.y) * sigm(a[2]); a[3] = bfhi(yv.y) * sigm(a[3]);
                        c[0] = bflo(yv.z) * sigm(c[0]); c[1] = bfhi(yv.z) * sigm(c[1]); c[2] = bflo(yv.w) * sigm(c[2]); c[3] = bfhi(yv.w) * sigm(c[3]);
                        ss += ssq8(a, c);
                        *(u32x4*)(dst + off) = pack8(a, c); }
                    ss = red_fq(ss);
                    if (fq == 0) sq[row * 8 + u.pn * 4 + wc] = ss; }
        } break;
        case EK_WOUT: case EK_WXO: {
            float* out = (float*)p0; bf16_t* hb = (bf16_t*)p1; float* sq = (float*)p2; const float* base = (const float*)c0;
#pragma unroll
            for (int ai = 0; ai < 2; ++ai)
#pragma unroll
                for (int m = 0; m < 4; ++m) { const size_t row = (size_t)(rbase + ai * 128 + m * 16); float ss = 0.f;
#pragma unroll
                    for (int bj = 0; bj < 2; ++bj) { const size_t off = row * DM + u.pn * 256 + bj * 128 + cl0;
                        const f32x4 a = acc[ai][bj][m][0] + *(const f32x4*)(base + off), c = acc[ai][bj][m][1] + *(const f32x4*)(base + off + 4);
                        *(f32x4*)(out + off) = a; *(f32x4*)(out + off + 4) = c;
                        ss += ssq8(a, c);
                        *(u32x4*)(hb + off) = pack8(a, c); }
                    ss = red_fq(ss);
                    if (fq == 0) sq[row * 16 + u.pn * 4 + wc] = ss; }
        } break;
        case EK_XQ: {
            bf16_t* dst = (bf16_t*)p0; float* sq = (float*)p1; const float* gq = (const float*)c0; const float* gk = (const float*)c1;
            f32x4 gg[2][2];
#pragma unroll
            for (int bj = 0; bj < 2; ++bj)
#pragma unroll
                for (int n = 0; n < 2; ++n) gg[bj][n] = *(const f32x4*)(gq + bj * 128 + cl0 + 4 * n) * *(const f32x4*)(gk + bj * 128 + cl0 + 4 * n);
#pragma unroll
            for (int ai = 0; ai < 2; ++ai)
#pragma unroll
                for (int m = 0; m < 4; ++m) { const size_t row = (size_t)(rbase + ai * 128 + m * 16);
                    float ss = ssq8(acc[ai][0][m][0], acc[ai][0][m][1]) + ssq8(acc[ai][1][m][0], acc[ai][1][m][1]);
                    ss = red_fq(ss);
                    if (fq == 0) sq[row * 16 + u.pn * 4 + wc] = ss;
#pragma unroll
                    for (int bj = 0; bj < 2; ++bj) *(u32x4*)(dst + row * DM + u.pn * 256 + bj * 128 + cl0) = pack8(acc[ai][bj][m][0] * gg[bj][0], acc[ai][bj][m][1] * gg[bj][1]); }
        } break;
        case EK_XS: {
            bf16_t* dst = (bf16_t*)p0; float* ps = (float*)p1; const float* s1 = (const float*)c0; const float* sqq = (const float*)c1; const float* sck = (const float*)c2;
            const int h = u.pn, b = u.pm >> 3;
            f32x4 kv[2][2];
#pragma unroll
            for (int bj = 0; bj < 2; ++bj)
#pragma unroll
                for (int n = 0; n < 2; ++n) kv[bj][n] = *(const f32x4*)(sck + (size_t)h * TM + b * 256 + bj * 128 + cl0 + 4 * n) * (LOG2E / 16.f);
#pragma unroll
            for (int ai = 0; ai < 2; ++ai)
#pragma unroll
                for (int m = 0; m < 4; ++m) { const size_t row = (size_t)(rbase + ai * 128 + m * 16);
                    const f32x4 t0 = *(const f32x4*)(s1 + row * 16), t1 = *(const f32x4*)(s1 + row * 16 + 4), t2 = *(const f32x4*)(s1 + row * 16 + 8), t3 = *(const f32x4*)(s1 + row * 16 + 12);
                    const float tot = ((t0[0] + t0[1]) + (t0[2] + t0[3])) + ((t1[0] + t1[1]) + (t1[2] + t1[3])) + ((t2[0] + t2[1]) + (t2[2] + t2[3])) + ((t3[0] + t3[1]) + (t3[2] + t3[3]));
                    const float rs1 = rsqrtf(tot * (1.f / DM) + EPS);
                    const f32x4 qq = *(const f32x4*)(sqq + row * 16 + h * 4);
                    const float sq = rs1 * rsqrtf(rs1 * rs1 * ((qq[0] + qq[1]) + (qq[2] + qq[3])) * (1.f / 256.f) + EPS);
                    float ss = 0.f;
#pragma unroll
                    for (int bj = 0; bj < 2; ++bj) { f32x4 a = acc[ai][bj][m][0] * kv[bj][0] * sq, c = acc[ai][bj][m][1] * kv[bj][1] * sq;
#pragma unroll
                        for (int j = 0; j < 4; ++j) { a[j] = __builtin_amdgcn_exp2f(a[j]); c[j] = __builtin_amdgcn_exp2f(c[j]); }
                        const u32x4 w = pack8(a, c);
                        ss += (bflo(w.x) + bfhi(w.x)) + (bflo(w.y) + bfhi(w.y)) + (bflo(w.z) + bfhi(w.z)) + (bflo(w.w) + bfhi(w.w));
                        *(u32x4*)(dst + row * DM + h * 256 + bj * 128 + cl0) = w; }
                    ss = red_fq(ss);
                    if (fq == 0) ps[row * 16 + h * 4 + wc] = ss; }
        } break;
        case EK_XO: {
            bf16_t* dst = (bf16_t*)p0; const float* ps = (const float*)c0; const int h = u.pn;
#pragma unroll
            for (int ai = 0; ai < 2; ++ai)
#pragma unroll
                for (int m = 0; m < 4; ++m) { const size_t row = (size_t)(rbase + ai * 128 + m * 16);
                    const f32x4 pp = *(const f32x4*)(ps + row * 16 + h * 4); const float inv = 1.f / ((pp[0] + pp[1]) + (pp[2] + pp[3]));
#pragma unroll
                    for (int bj = 0; bj < 2; ++bj) *(u32x4*)(dst + row * DM + h * 256 + bj * 128 + cl0) = pack8(acc[ai][bj][m][0] * inv, acc[ai][bj][m][1] * inv); }
        } break;
        case EK_UP: {
            bf16_t* G = (bf16_t*)p0; bf16_t* U = (bf16_t*)p1; const float* s2 = (const float*)c0;
#pragma unroll
            for (int ai = 0; ai < 2; ++ai)
#pragma unroll
                for (int m = 0; m < 4; ++m) { const size_t row = (size_t)(rbase + ai * 128 + m * 16);
                    const f32x4 t0 = *(const f32x4*)(s2 + row * 16), t1 = *(const f32x4*)(s2 + row * 16 + 4), t2 = *(const f32x4*)(s2 + row * 16 + 8), t3 = *(const f32x4*)(s2 + row * 16 + 12);
                    const float tot = ((t0[0] + t0[1]) + (t0[2] + t0[3])) + ((t1[0] + t1[1]) + (t1[2] + t1[3])) + ((t2[0] + t2[1]) + (t2[2] + t2[3])) + ((t3[0] + t3[1]) + (t3[2] + t3[3]));
                    const float rs = rsqrtf(tot * (1.f / DM) + EPS);
                    const size_t off = row * DFF + u.pn * 128 + cl0;
                    *(u32x4*)(G + off) = pack8(acc[ai][0][m][0] * rs, acc[ai][0][m][1] * rs);
                    *(u32x4*)(U + off) = pack8(acc[ai][1][m][0] * rs, acc[ai][1][m][1] * rs); }
        } break;
        case EK_DOWN: {
            float* out = (float*)p0;
#pragma unroll
            for (int ai = 0; ai < 2; ++ai)
#pragma unroll
                for (int m = 0; m < 4; ++m) { const size_t row = (size_t)(rbase + ai * 128 + m * 16);
#pragma unroll
                    for (int bj = 0; bj < 2; ++bj) { const size_t off = row * DM + u.pn * 256 + bj * 128 + cl0;
                        const f32x4 a = acc[ai][bj][m][0] + *(const f32x4*)(out + off), c = acc[ai][bj][m][1] + *(const f32x4*)(out + off + 4);
                        *(f32x4*)(out + off) = a; *(f32x4*)(out + off + 4) = c; } }
        } break;
        case EK_GATE: {
            bf16_t* G = (bf16_t*)p0; const float* s2 = (const float*)c0;
#pragma unroll
            for (int ai = 0; ai < 2; ++ai)
#pragma unroll
                for (int m = 0; m < 4; ++m) { const size_t row = (size_t)(rbase + ai * 128 + m * 16);
                    const f32x4 t0 = *(const f32x4*)(s2 + row * 16), t1 = *(const f32x4*)(s2 + row * 16 + 4), t2 = *(const f32x4*)(s2 + row * 16 + 8), t3 = *(const f32x4*)(s2 + row * 16 + 12);
                    const float tot = ((t0[0] + t0[1]) + (t0[2] + t0[3])) + ((t1[0] + t1[1]) + (t1[2] + t1[3])) + ((t2[0] + t2[1]) + (t2[2] + t2[3])) + ((t3[0] + t3[1]) + (t3[2] + t3[3]));
                    const float rs = rsqrtf(tot * (1.f / DM) + EPS);
#pragma unroll
                    for (int bj = 0; bj < 2; ++bj) *(u32x4*)(G + row * DFF + u.pn * 256 + bj * 128 + cl0) = pack8(acc[ai][bj][m][0] * rs, acc[ai][bj][m][1] * rs); }
        } break;
        case EK_UPACT: {
            bf16_t* A = (bf16_t*)p0; const float* rs2 = (const float*)c0; const bf16_t* G = (const bf16_t*)c1; const float* cw = (const float*)c2; const float* cbv = (const float*)p1;
            u32x4 upk[2][4][2];
#pragma unroll
            for (int ai = 0; ai < 2; ++ai)
#pragma unroll
                for (int m = 0; m < 4; ++m) { const float rs = rs2[rbase + ai * 128 + m * 16];
#pragma unroll
                    for (int bj = 0; bj < 2; ++bj) upk[ai][m][bj] = pack8(acc[ai][bj][m][0] * rs, acc[ai][bj][m][1] * rs); }
            asm volatile("" ::: "memory");
#pragma unroll
            for (int bj = 0; bj < 2; ++bj) { const int j0 = u.pn * 256 + bj * 128 + cl0;
                float w0[8], w1[8], w2[8], bb[8];
#pragma unroll
                for (int i = 0; i < 2; ++i) { const f32x4 a0 = *(const f32x4*)(cw + j0 + 4 * i), a1 = *(const f32x4*)(cw + DFF + j0 + 4 * i), a2 = *(const f32x4*)(cw + 2 * DFF + j0 + 4 * i), a3 = *(const f32x4*)(cbv + j0 + 4 * i);
#pragma unroll
                    for (int q = 0; q < 4; ++q) { w0[4 * i + q] = a0[q]; w1[4 * i + q] = a1[q]; w2[4 * i + q] = a2[q]; bb[4 * i + q] = a3[q]; } }
#pragma unroll
                for (int ai = 0; ai < 2; ++ai)
#pragma unroll
                    for (int m = 0; m < 4; ++m) { const int row = rbase + ai * 128 + m * 16; const int ts = row & 2047; const size_t off = (size_t)row * DFF + j0;
                        const u32x4 g0 = *(const u32x4*)(G + off);
                        u32x4 g1 = *(const u32x4*)(G + off - (ts >= 1 ? DFF : 0));
                        u32x4 g2 = *(const u32x4*)(G + off - (ts >= 2 ? 2 * DFF : 0));
                        const unsigned k1 = ts >= 1 ? 0xffffffffu : 0u, k2 = ts >= 2 ? 0xffffffffu : 0u;
                        g1 = g1 & k1; g2 = g2 & k2;
                        const u32x4 uu = upk[ai][m][bj];
                        float r[8];
#pragma unroll
                        for (int q = 0; q < 4; ++q) { const unsigned a2 = g2[q], a1 = g1[q], a0 = g0[q], u0 = uu[q];
                            const float z0 = bb[2 * q] + w0[2 * q] * bflo(a2) + w1[2 * q] * bflo(a1) + w2[2 * q] * bflo(a0);
                            const float z1 = bb[2 * q + 1] + w0[2 * q + 1] * bfhi(a2) + w1[2 * q + 1] * bfhi(a1) + w2[2 * q + 1] * bfhi(a0);
                            r[2 * q] = z0 * sigm(z0) * bflo(u0); r[2 * q + 1] = z1 * sigm(z1) * bfhi(u0); }
                        u32x4 o; o.x = pk2(r[0], r[1]); o.y = pk2(r[2], r[3]); o.z = pk2(r[4], r[5]); o.w = pk2(r[6], r[7]);
                        *(u32x4*)(A + off) = o;
                        if ((m & 1) == 1) asm volatile("" ::: "memory"); } }
        } break;
        case EK_UPC: {
            bf16_t* A = (bf16_t*)p0; float* GHF = (float*)p1; float* GHL = (float*)p2; float* UH = (float*)p3; const float* s2 = (const float*)c0; const float* cw = (const float*)c1; const float* cbv = (const float*)c2;
            const int j0 = u.pn * 128 + cl0;
            float rsv[2][4];
#pragma unroll
            for (int ai = 0; ai < 2; ++ai)
#pragma unroll
                for (int m = 0; m < 4; ++m) rsv[ai][m] = s2[rbase + ai * 128 + m * 16];
            if (fr >= 14) {
#pragma unroll
                for (int ai = 0; ai < 2; ++ai) { const f32x4 g0 = acc[ai][0][3][0] * rsv[ai][3], g1 = acc[ai][0][3][1] * rsv[ai][3];
                    LAS float* hp = hx + ((ai * 2 + wr) * 2 + (fr - 14)) * 128 + cl0; *(LAS f32x4*)hp = g0; *(LAS f32x4*)(hp + 4) = g1;
                    if (ai == 1 && wr == 1) { float* gp = GHL + ((size_t)u.pm * 2 + (fr - 14)) * DFF + j0; *(f32x4*)gp = g0; *(f32x4*)(gp + 4) = g1; } } }
            if (wr == 0 && fr < 2) {
                const float rs = rsv[0][0]; float* gp = GHF + ((size_t)u.pm * 2 + fr) * DFF + j0; float* up = UH + ((size_t)u.pm * 2 + fr) * DFF + j0;
                *(f32x4*)gp = acc[0][0][0][0] * rs; *(f32x4*)(gp + 4) = acc[0][0][0][1] * rs; *(f32x4*)up = acc[0][1][0][0] * rs; *(f32x4*)(up + 4) = acc[0][1][0][1] * rs; }
            asm volatile("s_waitcnt lgkmcnt(0)" ::: "memory"); __builtin_amdgcn_s_barrier(); asm volatile("" ::: "memory");
            float w0[8], w1[8], w2[8], bb[8];
#pragma unroll
            for (int i = 0; i < 2; ++i) { const f32x4 a0 = *(const f32x4*)(cw + j0 + 4 * i), a1 = *(const f32x4*)(cw + DFF + j0 + 4 * i), a2 = *(const f32x4*)(cw + 2 * DFF + j0 + 4 * i), a3 = *(const f32x4*)(cbv + j0 + 4 * i);
#pragma unroll
                for (int q = 0; q < 4; ++q) { w0[4 * i + q] = a0[q]; w1[4 * i + q] = a1[q]; w2[4 * i + q] = a2[q]; bb[4 * i + q] = a3[q]; } }
#define ROR1(x) __builtin_bit_cast(float, __builtin_amdgcn_update_dpp(0, __builtin_bit_cast(int, (x)), 0x121, 0xF, 0xF, false))
#define ROR2(x) __builtin_bit_cast(float, __builtin_amdgcn_update_dpp(0, __builtin_bit_cast(int, (x)), 0x122, 0xF, 0xF, false))
#pragma unroll
            for (int ai = 0; ai < 2; ++ai) {
                const int grp = ai * 2 + wr;
                float p1v[8], p2v[8];
                { f32x4 h1a = (f32x4){0.f, 0.f, 0.f, 0.f}, h1b = h1a, h2a = h1a, h2b = h1a;
                  if (grp > 0) { const LAS float* hp = hx + ((grp - 1) * 2) * 128 + cl0; h2a = *(const LAS f32x4*)hp; h2b = *(const LAS f32x4*)(hp + 4); h1a = *(const LAS f32x4*)(hp + 128); h1b = *(const LAS f32x4*)(hp + 132); }
#pragma unroll
                  for (int i = 0; i < 4; ++i) { p1v[i] = h1a[i]; p1v[4 + i] = h1b[i]; p2v[i] = (fr == 0) ? h2a[i] : h1a[i]; p2v[4 + i] = (fr == 0) ? h2b[i] : h1b[i]; } }
#pragma unroll
                for (int m = 0; m < 4; ++m) { const float rs = rsv[ai][m]; const size_t row = (size_t)(rbase + ai * 128 + m * 16);
                    float gs[8], r[8];
#pragma unroll
                    for (int i = 0; i < 4; ++i) { gs[i] = acc[ai][0][m][0][i] * rs; gs[4 + i] = acc[ai][0][m][1][i] * rs; }
#pragma unroll
                    for (int i = 0; i < 8; ++i) { const float c1v = ROR1(gs[i]), c2v = ROR2(gs[i]);
                        const float g1 = (fr == 0) ? p1v[i] : c1v, g2 = (fr < 2) ? p2v[i] : c2v;
                        p1v[i] = c1v; p2v[i] = c2v;
                        const float z = bb[i] + w0[i] * g2 + w1[i] * g1 + w2[i] * gs[i];
                        const float uv = (i < 4 ? acc[ai][1][m][0][i & 3] : acc[ai][1][m][1][i & 3]) * rs;
                        r[i] = z * sigm(z) * uv; }
                    u32x4 o; o.x = pk2(r[0], r[1]); o.y = pk2(r[2], r[3]); o.z = pk2(r[4], r[5]); o.w = pk2(r[6], r[7]);
                    if (!(grp == 0 && m == 0 && fr < 2)) *(u32x4*)(A + row * DFF + j0) = o; } }
#undef ROR1
#undef ROR2
        } break;
        default: break;
        }
    }
};

namespace attn_body {
using bf16=__hip_bfloat16;
using s16x4=__attribute__((ext_vector_type(4)))short;
using f32x16=__attribute__((ext_vector_type(16)))float;
constexpr int NHEAD=NFH,D=64,ADM=NHEAD*D;
constexpr int NW=8,QBLK=32,QB=QBLK*NW,KVBLK=64,NQB=SEQ/QB;
__device__ __forceinline__ int crow(int r,int hi){return (r&3)+8*(r>>2)+4*hi;}
#define SBAR() __builtin_amdgcn_sched_barrier(0)
__device__ __forceinline__ void cmask(f32x16&p0,f32x16&p1,int jb,int qrel,int hi){
  const float NEG=-INFINITY; int kb=64*jb+4*hi;
  #pragma unroll
  for(int r=0;r<16;++r){int kv=kb+(r&3)+8*(r>>2); if(kv>qrel)p0[r]=NEG; if(kv+32>qrel)p1[r]=NEG;}
}
constexpr int NSLOT=3, SLOTB=8192;
constexpr int LDS_K=0, LDS_V=NSLOT*SLOTB, LDS_WS=2*NSLOT*SLOTB, LDS_OST=LDS_WS+NW*64*4, LDS_BYTES=LDS_OST+NW*4096;
constexpr int LDS_BIAS=86016;
__device__ __forceinline__ void glds16(const void*gsrc,unsigned lds_dst){unsigned keep;
  asm volatile("s_mov_b32 %0, m0\n\ts_mov_b32 m0, %2\n\ts_nop 0\n\tglobal_load_lds_dwordx4 %1, off\n\ts_mov_b32 m0, %0":"=&s"(keep):"v"(gsrc),"s"(lds_dst):"memory");}
__device__ __forceinline__ float max3f(float a,float b,float c){float r;asm("v_max3_f32 %0, %1, %2, %3":"=v"(r):"v"(a),"v"(b),"v"(c));return r;}
__device__ __forceinline__ float max2f(float a,float b){float r;asm("v_max_f32_e32 %0, %1, %2":"=v"(r):"v"(a),"v"(b));return r;}
__device__ __forceinline__ float fadd_s(float a,float b){float r;asm("v_add_f32_e32 %0, %1, %2":"=v"(r):"v"(a),"v"(b));return r;}
__device__ __forceinline__ float fsub_s(float a,float b){float r;asm("v_sub_f32_e32 %0, %1, %2":"=v"(r):"v"(a),"v"(b));return r;}
typedef float f32x2_t __attribute__((ext_vector_type(2))); typedef __bf16 bf16x2_t __attribute__((ext_vector_type(2)));
__device__ __forceinline__ unsigned cvtpk_s(float lo,float hi){f32x2_t v={lo,hi};bf16x2_t b=__builtin_convertvector(v,bf16x2_t);return __builtin_bit_cast(unsigned,b);}
#define WAIT_BAR(N) asm volatile("s_waitcnt vmcnt(" #N ") lgkmcnt(0)\n\ts_barrier":::"memory")

__device__ __forceinline__ void qkt(f32x16&p0,f32x16&p1,const char*Kslot,const bf16x8*qr,const f32x16&negm,int r32,int hi){
  const char*kb=Kslot+hi*1024+r32*16;
  #pragma unroll
  for(int d0=0;d0<4;++d0){
    const bf16x8 b0=*reinterpret_cast<const bf16x8*>(kb+d0*2048);
    const bf16x8 b1=*reinterpret_cast<const bf16x8*>(kb+d0*2048+512);
    if(d0==0){p0=__builtin_amdgcn_mfma_f32_32x32x16_bf16(b0,qr[0],negm,0,0,0);p1=__builtin_amdgcn_mfma_f32_32x32x16_bf16(b1,qr[0],negm,0,0,0);}
    else{p0=__builtin_amdgcn_mfma_f32_32x32x16_bf16(b0,qr[d0],p0,0,0,0);p1=__builtin_amdgcn_mfma_f32_32x32x16_bf16(b1,qr[d0],p1,0,0,0);}}
}
typedef __attribute__((address_space(3))) const char* lds_cptr;
typedef short v4i16_t __attribute__((ext_vector_type(4)));
__device__ __forceinline__ void kload8(bf16x8*kf,lds_cptr kp){
  kf[0]=*(const __attribute__((address_space(3))) bf16x8*)(kp);      kf[1]=*(const __attribute__((address_space(3))) bf16x8*)(kp+512);
  kf[2]=*(const __attribute__((address_space(3))) bf16x8*)(kp+2048); kf[3]=*(const __attribute__((address_space(3))) bf16x8*)(kp+2560);
  kf[4]=*(const __attribute__((address_space(3))) bf16x8*)(kp+4096); kf[5]=*(const __attribute__((address_space(3))) bf16x8*)(kp+4608);
  kf[6]=*(const __attribute__((address_space(3))) bf16x8*)(kp+6144); kf[7]=*(const __attribute__((address_space(3))) bf16x8*)(kp+6656);
}
__device__ __forceinline__ void kload2(bf16x8*kf,lds_cptr kp,int j){ kf[2*j]=*(const __attribute__((address_space(3))) bf16x8*)(kp+j*2048); kf[2*j+1]=*(const __attribute__((address_space(3))) bf16x8*)(kp+j*2048+512); }
__device__ __forceinline__ s16x4 vtr(lds_cptr p){ return __builtin_bit_cast(s16x4,__builtin_amdgcn_ds_read_tr16_b64_v4i16((__attribute__((address_space(3))) v4i16_t*)p)); }
__device__ __forceinline__ float rowmax(const f32x16&p0,const f32x16&p1){
  float a=max3f(p0[0],p0[1],p1[0]),b=max3f(p0[2],p0[3],p1[1]);a=max3f(a,p1[2],p1[3]);
  #pragma unroll
  for(int r=4;r<16;r+=4){a=max3f(a,p0[r],p0[r+1]);b=max3f(b,p0[r+2],p0[r+3]);a=max3f(a,p1[r],p1[r+1]);b=max3f(b,p1[r+2],p1[r+3]);}
  const float m=max2f(a,b);
  auto rr=__builtin_amdgcn_permlane32_swap(__float_as_uint(m),__float_as_uint(m),false,false);
  return max2f(__uint_as_float(rr[0]),__uint_as_float(rr[1]));
}
__device__ __forceinline__ void pv(f32x16*o,int vb,bf16x8 pa0,bf16x8 pa1,bf16x8 pa2,bf16x8 pa3){
  #pragma unroll
  for(int d0=0;d0<2;++d0){s16x4 lo[4],hi[4];
    #pragma unroll
    for(int ks=0;ks<4;++ks){
      asm volatile("ds_read_b64_tr_b16 %0,%1 offset:%c2":"=&v"(lo[ks]):"v"(vb),"i"(d0*4096+ks*1024):"memory");
      asm volatile("ds_read_b64_tr_b16 %0,%1 offset:%c2":"=&v"(hi[ks]):"v"(vb),"i"(d0*4096+ks*1024+512):"memory");}
    asm volatile("s_waitcnt lgkmcnt(0)":::"memory");SBAR();
    #define PK(k) (bf16x8){lo[k][0],lo[k][1],lo[k][2],lo[k][3],hi[k][0],hi[k][1],hi[k][2],hi[k][3]}
    o[d0]=__builtin_amdgcn_mfma_f32_32x32x16_bf16(pa0,PK(0),o[d0],0,0,0);
    o[d0]=__builtin_amdgcn_mfma_f32_32x32x16_bf16(pa1,PK(1),o[d0],0,0,0);
    o[d0]=__builtin_amdgcn_mfma_f32_32x32x16_bf16(pa2,PK(2),o[d0],0,0,0);
    o[d0]=__builtin_amdgcn_mfma_f32_32x32x16_bf16(pa3,PK(3),o[d0],0,0,0);
    #undef PK
  }
}
typedef const __attribute__((address_space(3))) f32x4* lds_f4ptr;
#define BIASADD(P0,P1,t) do{ const lds_f4ptr bp_=(lds_f4ptr)(shm3+bias_off+((t)*64+4*hi)*4); \
    _Pragma("unroll") for(int j_=0;j_<4;++j_){ const f32x4 b0_=bp_[2*j_]-mhat, b1_=bp_[8+2*j_]-mhat; \
      P0[4*j_]+=b0_[0]; P0[4*j_+1]+=b0_[1]; P0[4*j_+2]+=b0_[2]; P0[4*j_+3]+=b0_[3]; \
      P1[4*j_]+=b1_[0]; P1[4*j_+1]+=b1_[1]; P1[4*j_+2]+=b1_[2]; P1[4*j_+3]+=b1_[3]; } }while(0)

template<int THRL> __device__ __forceinline__ void attn_unit(int b,int h,int qb,const bf16*Q,const bf16*__restrict__ K,const bf16*__restrict__ V,bf16*O,const float*__restrict__ CB,float*__restrict__ SSQ,char*shm,const float skip_th){
  int tid=threadIdx.x; asm volatile("":"+v"(tid));
  const int lane=tid&63,r32=lane&31,hi=lane>>5; const int wid=__builtin_amdgcn_readfirstlane(tid>>6);
  const long rowbase=(long)b*SEQ; const int q0=qb*QB;
  const bf16*Qw=Q+(rowbase+q0+wid*QBLK)*ADM+h*D;
  int t0=0; { const float*cbh0=CB+(long)(b*NHEAD+h)*SEQ; const int npair=(q0+QB)/KVBLK/2-2; const float c0v=cbh0[q0];
    const bool far=(lane<npair)&&(cbh0[128*(lane<npair?lane:0)+127]-c0v>skip_th); const unsigned long long mk=__ballot(far);
    int lead=__builtin_ctzll(~mk); if(lead>npair)lead=npair; if(lead<0)lead=0; t0=2*__builtin_amdgcn_readfirstlane(lead); }
  const bf16*Kh=K+(rowbase+(long)t0*KVBLK)*ADM+h*D,*Vh=V+(rowbase+(long)t0*KVBLK)*ADM+h*D;
  const unsigned lds0=(unsigned)(uintptr_t)shm;
  float*wsf=(float*)(shm+LDS_WS)+wid*64;
  const lds_cptr shm3=(lds_cptr)shm;
  { const float*cbh=CB+(long)(b*NHEAD+h)*SEQ; const float cref=cbh[q0+128];
    if(tid*4<q0+QB){ const f32x4 c4=*(const f32x4*)(cbh+tid*4); *(__attribute__((address_space(3))) f32x4*)(shm3+LDS_BIAS+tid*16)=(f32x4){cref-c4[0],cref-c4[1],cref-c4[2],cref-c4[3]}; } }
  const bf16*ksrc=Kh+(long)lane*ADM+wid*8;
  const bf16*vsrc=Vh+(long)(16*(wid&3)+(lane>>2))*ADM+(wid>>2)*32+(lane&3)*8;
  const unsigned kdst=lds0+LDS_K+wid*1024, vdst=lds0+LDS_V+wid*1024;
  #define DMA_K(t,slot) glds16(ksrc+(long)(t)*KVBLK*ADM,(unsigned)__builtin_amdgcn_readfirstlane(kdst+(slot)))
  #define DMA_V(t,slot) glds16(vsrc+(long)(t)*KVBLK*ADM,(unsigned)__builtin_amdgcn_readfirstlane(vdst+(slot)))
  const int vb0=(int)(lds0+LDS_V)+((lane>>4)&1)*32+(lane&3)*8+(4*hi+((lane&15)>>2))*64;
  const char*Kbase=shm+LDS_K; bf16x8 kf[8];
  const lds_cptr kp0=shm3+LDS_K+hi*1024+r32*16; const lds_cptr vp0=shm3+LDS_V+((lane>>4)&1)*32+(lane&3)*8+(4*hi+((lane&15)>>2))*64;
  const int NT=(q0+QB)/KVBLK-t0; const int bias_off=LDS_BIAS+t0*KVBLK*4;
  DMA_K(0,0);DMA_V(0,0);DMA_K(1,SLOTB);
  bf16x8 qr[4];
  #pragma unroll
  for(int d0=0;d0<4;++d0)qr[d0]=*reinterpret_cast<const bf16x8*>(&Qw[(long)r32*ADM+d0*16+hi*8]);
  float mhat=0.f,l_reg=0.f;f32x16 o[2];o[0]=f32x16{};o[1]=f32x16{};const f32x16 negm=f32x16{};
  const int qrel=wid*QBLK+r32;
  #define CMASK(P0,P1,t) do{int jb_=(t)-(NT-4); if(jb_>=0)cmask(P0,P1,jb_,qrel,hi);}while(0)
  bool resc=false;
  #define START(P0,P1) do{ const float rm=rowmax(P0,P1); resc=false; \
    { const float dl=max2f(rm,-24.f); mhat=fadd_s(mhat,dl); \
      _Pragma("unroll") for(int r=0;r<16;++r){P0[r]=fsub_s(P0[r],dl);P1[r]=fsub_s(P1[r],dl);} } \
    _Pragma("unroll") for(int r=0;r<16;++r)P0[r]=__builtin_amdgcn_exp2f(P0[r]); }while(0)
  #define RESC() do{ if(resc){ asm volatile("s_waitcnt lgkmcnt(0)":::"memory"); \
      _Pragma("unroll") for(int d_=0;d_<2;++d_) _Pragma("unroll") for(int r=0;r<16;++r)o[d_][r]*=wsf[crow(r,hi)]; } }while(0)
  f32x16 pA0,pA1,pB0,pB1;
  int sl_prev=0,sl_cur=0,sl_next=SLOTB;
  #define ROT() do{sl_prev=sl_cur;sl_cur=sl_next;sl_next=(sl_next==(NSLOT-1)*SLOTB)?0:sl_next+SLOTB;}while(0)
  DMA_K(2,2*SLOTB);
  WAIT_BAR(3);
  qkt(pA0,pA1,Kbase,qr,negm,r32,hi);asm volatile("s_nop 15\n\ts_nop 7":"+v"(pA0),"+v"(pA1));BIASADD(pA0,pA1,0);CMASK(pA0,pA1,0);
  START(pA0,pA1);
  _Pragma("unroll") for(int r=0;r<16;++r)pA1[r]=__builtin_amdgcn_exp2f(pA1[r]);
  WAIT_BAR(0);
  DMA_K(3,0);DMA_V(1,SLOTB);
  ROT();
  kload8(kf,kp0+sl_cur);
  WAIT_BAR(2);
  s16x4 vlo[8],vhi[8]; u32x4 pw0,pw1,pw2,pw3;
  #define PKW(P,B) cvtpk_s(P[B],P[B+1])
  #define PAF(k) __builtin_bit_cast(bf16x8,pw##k)
  #define VFR(i) (bf16x8){vlo[i][0],vlo[i][1],vlo[i][2],vlo[i][3],vhi[i][0],vhi[i][1],vhi[i][2],vhi[i][3]}
  #define PIN(x) asm volatile("":"+v"(x))
  #define MX3(a,b,c) __builtin_fmaxf(__builtin_fmaxf((a),(b)),(c))
  #define GAPA(MF,A0,A1,A2,A3,W0,W1,PW) do{ MF; sacc+=A0; sacc+=A1; sacc+=A2; sacc+=A3; PIN(sacc); W0; W1; PIN(PW); SBAR(); }while(0)
  #define EX(v) __builtin_amdgcn_exp2f(v)
  #define GAPB(MF,X,B) do{ MF; X[B]=EX(X[B]); X[B+1]=EX(X[B+1]); X[B+2]=EX(X[B+2]); X[B+3]=EX(X[B+3]); PIN(X); SBAR(); }while(0)
  #define VRD(i) do{ vlo[i]=vtr(vp_+(((i)>>2)*4096+((i)&3)*1024)); vhi[i]=vtr(vp_+(((i)>>2)*4096+((i)&3)*1024+512)); }while(0)
  #define KRD(G,j) do{ if(G){ kload2(kf,kp0+sl_next,j); SBAR(); } }while(0)
  #define STEP(C0,C1,P0,P1,t,GK,GV,GL) do{ SBAR(); \
    const lds_cptr vp_=vp0+sl_prev; \
    VRD(0); SBAR(); float sacc=(P0[0]+P0[1]); \
    GAPA(C0=__builtin_amdgcn_mfma_f32_32x32x16_bf16(kf[0],qr[0],negm,0,0,0), P0[2],P0[3],P0[4],P0[5],     pw0[0]=PKW(P0,0), pw0[1]=PKW(P0,2), pw0); \
    VRD(4); SBAR(); GAPA(C1=__builtin_amdgcn_mfma_f32_32x32x16_bf16(kf[1],qr[0],negm,0,0,0), P0[6],P0[7],P0[8],P0[9],     pw0[2]=PKW(P0,4), pw0[3]=PKW(P0,6), pw0); \
    VRD(1); SBAR(); GAPA(C0=__builtin_amdgcn_mfma_f32_32x32x16_bf16(kf[2],qr[1],C0,0,0,0),   P0[10],P0[11],P0[12],P0[13], pw1[0]=PKW(P0,8), pw1[1]=PKW(P0,10), pw1); \
    VRD(5); SBAR(); GAPA(C1=__builtin_amdgcn_mfma_f32_32x32x16_bf16(kf[3],qr[1],C1,0,0,0),   P0[14],P0[15],P1[0],P1[1],   pw1[2]=PKW(P0,12),pw1[3]=PKW(P0,14), pw1); \
    VRD(2); SBAR(); GAPA(C0=__builtin_amdgcn_mfma_f32_32x32x16_bf16(kf[4],qr[2],C0,0,0,0),   P1[2],P1[3],P1[4],P1[5],     pw2[0]=PKW(P1,0), pw2[1]=PKW(P1,2), pw2); \
    VRD(6); SBAR(); GAPA(C1=__builtin_amdgcn_mfma_f32_32x32x16_bf16(kf[5],qr[2],C1,0,0,0),   P1[6],P1[7],P1[8],P1[9],     pw2[2]=PKW(P1,4), pw2[3]=PKW(P1,6), pw2); \
    VRD(3); SBAR(); GAPA(C0=__builtin_amdgcn_mfma_f32_32x32x16_bf16(kf[6],qr[3],C0,0,0,0),   P1[10],P1[11],P1[12],P1[13], pw3[0]=PKW(P1,8), pw3[1]=PKW(P1,10), pw3); \
    VRD(7); SBAR(); GAPA(C1=__builtin_amdgcn_mfma_f32_32x32x16_bf16(kf[7],qr[3],C1,0,0,0),   P1[14],P1[15],0.f,0.f,       pw3[2]=PKW(P1,12),pw3[3]=PKW(P1,14), pw3); \
    l_reg+=sacc; \
    if(GK){DMA_K((t)+3,sl_cur);} if(GV){DMA_V((t)+1,sl_next);} \
    BIASADD(C0,C1,t); \
    CMASK(C0,C1,t); \
    { float a=MX3(C0[0],C0[1],C1[0]),b=MX3(C0[2],C0[3],C1[1]); a=MX3(a,C1[2],C1[3]); \
      _Pragma("unroll") for(int r=4;r<16;r+=4){a=MX3(a,C0[r],C0[r+1]);b=MX3(b,C0[r+2],C0[r+3]);a=MX3(a,C1[r],C1[r+1]);b=MX3(b,C1[r+2],C1[r+3]);} \
      float rm=__builtin_fmaxf(a,b); { auto rr=__builtin_amdgcn_permlane32_swap(__float_as_uint(rm),__float_as_uint(rm),false,false); rm=__builtin_fmaxf(__uint_as_float(rr[0]),__uint_as_float(rr[1])); } \
      resc=false; \
      if(__builtin_expect(__any(rm>(float)THRL),0)){ const float dl=__builtin_fmaxf(rm,0.f); mhat+=dl; \
        _Pragma("unroll") for(int r=0;r<16;++r){C0[r]-=dl;C1[r]-=dl;} \
        const float f=__builtin_amdgcn_exp2f(-dl); l_reg*=f; if(hi==0)wsf[r32]=f; resc=true; } } \
    SBAR(); \
    GAPB(o[0]=__builtin_amdgcn_mfma_f32_32x32x16_bf16(PAF(0),VFR(0),o[0],0,0,0), C0,0); \
    GAPB(o[1]=__builtin_amdgcn_mfma_f32_32x32x16_bf16(PAF(0),VFR(4),o[1],0,0,0), C0,4); \
    KRD(GL,0); GAPB(o[0]=__builtin_amdgcn_mfma_f32_32x32x16_bf16(PAF(1),VFR(1),o[0],0,0,0), C0,8); \
    KRD(GL,1); GAPB(o[1]=__builtin_amdgcn_mfma_f32_32x32x16_bf16(PAF(1),VFR(5),o[1],0,0,0), C0,12); \
    KRD(GL,2); GAPB(o[0]=__builtin_amdgcn_mfma_f32_32x32x16_bf16(PAF(2),VFR(2),o[0],0,0,0), C1,0); \
    KRD(GL,3); GAPB(o[1]=__builtin_amdgcn_mfma_f32_32x32x16_bf16(PAF(2),VFR(6),o[1],0,0,0), C1,4); \
    GAPB(o[0]=__builtin_amdgcn_mfma_f32_32x32x16_bf16(PAF(3),VFR(3),o[0],0,0,0), C1,8); \
    GAPB(o[1]=__builtin_amdgcn_mfma_f32_32x32x16_bf16(PAF(3),VFR(7),o[1],0,0,0), C1,12); \
    }while(0)
  int t=1;
  #undef CMASK
  #define CMASK(P0,P1,t) do{}while(0)
  for(;t+5<NT;t+=2){
    STEP(pB0,pB1,pA0,pA1,t,true,true,true);     WAIT_BAR(2); RESC(); ROT();
    STEP(pA0,pA1,pB0,pB1,t+1,true,true,true);   WAIT_BAR(2); RESC(); ROT();
  }
  #undef CMASK
  #define CMASK(P0,P1,t) do{int jb_=(t)-(NT-4); if(jb_>=0)cmask(P0,P1,jb_,qrel,hi);}while(0)
  #define ENDW(tt) do{ if((tt)+3<NT){WAIT_BAR(2);} else if((tt)+2<NT){WAIT_BAR(1);} else {WAIT_BAR(0);} }while(0)
  for(;t+1<NT;t+=2){
    STEP(pB0,pB1,pA0,pA1,t,(t+3<NT),(t+1<NT),(t+1<NT));       ENDW(t);   RESC(); ROT();
    STEP(pA0,pA1,pB0,pB1,t+1,(t+4<NT),(t+2<NT),(t+2<NT));     ENDW(t+1); RESC(); ROT();
  }
  STEP(pB0,pB1,pA0,pA1,NT-1,false,false,false); RESC();
  { float sacc=pB0[0]+pB0[1]; _Pragma("unroll") for(int r=2;r<16;++r)sacc+=pB0[r]; _Pragma("unroll") for(int r=0;r<16;++r)sacc+=pB1[r]; l_reg+=sacc;
    pw0=(u32x4){PKW(pB0,0),PKW(pB0,2),PKW(pB0,4),PKW(pB0,6)};pw1=(u32x4){PKW(pB0,8),PKW(pB0,10),PKW(pB0,12),PKW(pB0,14)};pw2=(u32x4){PKW(pB1,0),PKW(pB1,2),PKW(pB1,4),PKW(pB1,6)};pw3=(u32x4){PKW(pB1,8),PKW(pB1,10),PKW(pB1,12),PKW(pB1,14)};
    SBAR(); pv(o,vb0+sl_cur,PAF(0),PAF(1),PAF(2),PAF(3)); }
  #undef PKW
  #undef PAF
  #undef VFR
  #undef PIN
  #undef MX3
  #undef GAPA
  #undef GAPB
  #undef EX
  #undef VRD
  #undef KRD
  #undef STEP
  #undef ENDW
  {auto rr=__builtin_amdgcn_permlane32_swap(__float_as_uint(l_reg),__float_as_uint(l_reg),false,false);l_reg=__uint_as_float(rr[0])+__uint_as_float(rr[1]);}
  if(hi==0)wsf[32+r32]=l_reg;asm volatile("s_waitcnt lgkmcnt(0)":::"memory");
  float rli[16];
  #pragma unroll
  for(int r=0;r<16;++r)rli[r]=__builtin_amdgcn_rcpf(wsf[32+crow(r,hi)]);
  int lane2=lane; asm volatile("":"+v"(lane2));
  bf16*Ow=O+(rowbase+q0+wid*QBLK)*ADM+h*D;
  { bf16*stg=(bf16*)(shm+LDS_OST)+wid*2048;
    #pragma unroll
    for(int r=0;r<16;++r){const int orow=crow(r,hi);
      #pragma unroll
      for(int d0=0;d0<2;++d0)stg[orow*64+d0*32+r32]=__float2bfloat16(o[d0][r]*rli[r]);}
    asm volatile("s_waitcnt lgkmcnt(0)":::"memory");
    #pragma unroll
    for(int i=0;i<4;++i){const int row=i*8+(lane2>>3),ch=lane2&7; const u32x4 v=*(const u32x4*)(stg+row*64+ch*8); *(u32x4*)(Ow+(long)row*ADM+ch*8)=v;
      float s=(bflo(v.x)*bflo(v.x)+bfhi(v.x)*bfhi(v.x))+(bflo(v.y)*bflo(v.y)+bfhi(v.y)*bfhi(v.y))+(bflo(v.z)*bflo(v.z)+bfhi(v.z)*bfhi(v.z))+(bflo(v.w)*bflo(v.w)+bfhi(v.w)*bfhi(v.w));
      s+=__shfl_xor(s,1); s+=__shfl_xor(s,2); s+=__shfl_xor(s,4);
      if(ch==0)SSQ[(rowbase+q0+wid*QBLK+row)*NHEAD+h]=s; } }
  asm volatile("s_waitcnt lgkmcnt(0)\n\ts_barrier":::"memory");
  #undef DMA_K
  #undef DMA_V
  #undef CMASK
  #undef START
  #undef RESC
  #undef ROT
}
#undef SBAR
#undef WAIT_BAR
}

constexpr int RING_BYTES = 131072;
constexpr int LDS_TOTAL = 147456;
struct Args { const float* in[32]; float* out; unsigned char* ws; };
typedef const float* const __attribute__((address_space(4)))* InTab;
enum In { I_X = 0, I_MEM, I_NORM_MIX, I_W_IN, I_FQN, I_FKN, I_FBIAS, I_ARE, I_AIM, I_LOGDT, I_BRE, I_BIM, I_CRE, I_CIM, I_D, I_WGLU, I_BGLU, I_ONF, I_ONS, I_WOUT,
          I_NCROSS, I_NMEM, I_WXQ, I_WXKV, I_XQN, I_XKN, I_WXO, I_NFFN, I_WUP, I_CONVW, I_CONVB, I_WDN };

struct TJob { const float* W; int ldw, col0, ncols, K; const float* kg; const float* kg2; bf16_t* WT; int mapid, rowoff, items; };
__device__ __forceinline__ int tmap(int mapid, int n, int rowoff) {
    if (mapid == 1) { const int part = n >> 9, f = n & 511, head = f >> 6, d = f & 63; return 512 * part + 256 * (head >> 2) + 128 * (d >> 5) + 32 * (head & 3) + (d & 31); }
    if (mapid == 2) { const int isup = n >= DFF ? 1 : 0; const int j = n - isup * DFF; return 256 * (j >> 7) + 128 * isup + (j & 127); }
    return rowoff + n;
}
__device__ __forceinline__ void transpose_item(const TJob& J, LAS float* scr, int item, int lane) {
    LAS unsigned* s32 = (LAS unsigned*)scr; const LAS unsigned short* s16 = (const LAS unsigned short*)scr;
    const int nblk = J.ncols / 128, kb = item / nblk, nb = item % nblk, k0 = 64 * kb, n0 = 128 * nb;
    const float* src = J.W + (size_t)k0 * J.ldw + J.col0 + n0 + 2 * lane;
#pragma unroll 16
    for (int kk = 0; kk < 64; ++kk) { f32x2 w = *(const f32x2*)(src + (size_t)kk * J.ldw);
        if (J.kg) { const int k = k0 + kk; const float g = (J.kg2 && k >= 512) ? J.kg2[k - 512] : J.kg[k]; w = w * g; }
        s32[kk * 64 + lane] = pk2(w[0], w[1]); }
    asm volatile("s_waitcnt lgkmcnt(0)" ::: "memory");
    const int c = lane & 7;
#pragma unroll 4
    for (int j = 0; j < 16; ++j) { const int n = (lane >> 3) + 8 * j; const LAS unsigned short* s = s16 + (8 * c) * 128 + n;
        u32x4 o; o.x = (unsigned)s[0] | ((unsigned)s[128] << 16); o.y = (unsigned)s[256] | ((unsigned)s[384] << 16); o.z = (unsigned)s[512] | ((unsigned)s[640] << 16); o.w = (unsigned)s[768] | ((unsigned)s[896] << 16);
        *(u32x4*)(J.WT + (size_t)tmap(J.mapid, n0 + n, J.rowoff) * J.K + k0 + 8 * c) = o; }
    asm volatile("s_waitcnt lgkmcnt(0)" ::: "memory");
}
constexpr int NTJ = 11;
__device__ __forceinline__ void get_tjob(InTab in, unsigned char* ws, int j, TJob& J) {
    J.kg = nullptr; J.kg2 = nullptr; J.mapid = 0; J.rowoff = 0; J.col0 = 0;
    switch (j) {
    case 0: J.W = in[I_W_IN]; J.ldw = INCOLS; J.col0 = 0; J.ncols = 1024; J.K = 1024; J.WT = (bf16_t*)(ws + WS_WIN); J.mapid = 1; break;
    case 1: J.W = in[I_W_IN]; J.ldw = INCOLS; J.col0 = 1024; J.ncols = 512; J.K = 1024; J.WT = (bf16_t*)(ws + WS_WIN); J.rowoff = 1024; break;
    case 2: J.W = in[I_W_IN]; J.ldw = INCOLS; J.col0 = 1544; J.ncols = 512; J.K = 1024; J.WT = (bf16_t*)(ws + WS_WIN); J.rowoff = 1536; break;
    case 3: J.W = in[I_WGLU]; J.ldw = 512; J.ncols = 512; J.K = 512; J.WT = (bf16_t*)(ws + WS_WGLU); break;
    case 4: J.W = in[I_WOUT]; J.ldw = 1024; J.ncols = 1024; J.K = 1024; J.WT = (bf16_t*)(ws + WS_WOUT); J.kg = in[I_ONF]; J.kg2 = in[I_ONS]; break;
    case 5: J.W = in[I_WXQ]; J.ldw = 1024; J.ncols = 1024; J.K = 1024; J.WT = (bf16_t*)(ws + WS_WXQ); J.kg = in[I_NCROSS]; break;
    case 6: J.W = in[I_WXKV]; J.ldw = 2048; J.col0 = 0; J.ncols = 1024; J.K = 1024; J.WT = (bf16_t*)(ws + WS_WXK); break;
    case 7: J.W = in[I_WXKV]; J.ldw = 2048; J.col0 = 1024; J.ncols = 1024; J.K = 1024; J.WT = (bf16_t*)(ws + WS_WXV); break;
    case 8: J.W = in[I_WXO]; J.ldw = 1024; J.ncols = 1024; J.K = 1024; J.WT = (bf16_t*)(ws + WS_WXO); break;
    case 9: J.W = in[I_WUP]; J.ldw = 2 * DFF; J.ncols = 2 * DFF; J.K = 1024; J.WT = (bf16_t*)(ws + WS_WUP); J.kg = in[I_NFFN]; J.mapid = 2; break;
    default: J.W = in[I_WDN]; J.ldw = 1024; J.ncols = 1024; J.K = DFF; J.WT = (bf16_t*)(ws + WS_WDN); break;
    }
    J.items = (J.K / 64) * (J.ncols / 128);
}

__device__ __forceinline__ void rms_row(const float* xrow, const float* gain, bf16_t* orow, int lane, f32x4 (&v)[4]) {
    const f32x4* xr = (const f32x4*)xrow + lane; float s = 0.f;
#pragma unroll
    for (int j = 0; j < 4; ++j) { v[j] = xr[64 * j]; s += (v[j][0] * v[j][0] + v[j][1] * v[j][1]) + (v[j][2] * v[j][2] + v[j][3] * v[j][3]); }
    const float rs = rsqrtf(wave_sum(s) * (1.f / DM) + EPS);
    u32x2* o8 = (u32x2*)orow + lane;
#pragma unroll
    for (int j = 0; j < 4; ++j) { v[j] = v[j] * rs * ((const f32x4*)gain)[64 * j + lane]; u32x2 w; w.x = pk2(v[j][0], v[j][1]); w.y = pk2(v[j][2], v[j][3]); o8[64 * j] = w; }
}

__device__ __forceinline__ void cpow(float ar, float ai, float dt, float e, float& r, float& i) {
    const float mag = __expf(ar * dt * e);
    float rev = ai * dt * e * 0.15915494309189535f; rev -= rintf(rev);
    const float ang = rev * 6.283185307179586f;
    r = mag * cosf(ang); i = mag * sinf(ang);
}

__device__ __forceinline__ void s5_prep_task(InTab in, unsigned char* ws, int g, int tt, LAS float* L, int tid) {
    LAS float* pwA = L; LAS float* pwB = L + 128; LAS float* pwC = L + 256; LAS float* cf = L + 384; LAS float* bb = L + 512; LAS float* cc = L + 512 + 2048;
    const float dt = __expf(in[I_LOGDT][g]);
    if (tid < 64) { const int p = tid; const float ar = in[I_ARE][g * 64 + p], ai = in[I_AIM][g * 64 + p];
        float r, i; cpow(ar, ai, dt, (float)tt, r, i); pwA[2 * p] = r; pwA[2 * p + 1] = i;
        cpow(ar, ai, dt, (float)(tt + 1), r, i); pwB[2 * p] = r; pwB[2 * p + 1] = i;
        cpow(ar, ai, dt, (float)(TC - 1 - tt), r, i); pwC[2 * p] = r; pwC[2 * p + 1] = i;
        float lr, li; cpow(ar, ai, dt, 1.f, lr, li);
        const float den = ar * ar + ai * ai, nr = lr - 1.f;
        cf[2 * p] = (nr * ar + li * ai) / den; cf[2 * p + 1] = (li * ar - nr * ai) / den;
        if (tt == 0) { cpow(ar, ai, dt, (float)TC, r, i); float* lb = (float*)(ws + WS_LB32); lb[(g * 64 + p) * 2] = r; lb[(g * 64 + p) * 2 + 1] = i; } }
    for (int idx = tid; idx < 1024; idx += 512) { cc[2 * idx] = in[I_CRE][g * 1024 + idx]; cc[2 * idx + 1] = in[I_CIM][g * 1024 + idx]; }
    __syncthreads();
    for (int idx = tid; idx < 1024; idx += 512) { const int p = idx >> 4; const float br = in[I_BRE][g * 1024 + idx], bi = in[I_BIM][g * 1024 + idx], cr = cf[2 * p], ci = cf[2 * p + 1];
        bb[2 * idx] = cr * br - ci * bi; bb[2 * idx + 1] = cr * bi + ci * br; }
    __syncthreads();
    if (tid < 256) {
        const int c = tid >> 4, cp = tid & 15; float s = 0.f;
        for (int p = 0; p < 64; ++p) { const float pr = pwA[2 * p], pi = pwA[2 * p + 1], br = bb[2 * (p * 16 + cp)], bi = bb[2 * (p * 16 + cp) + 1];
            const float mr = pr * br - pi * bi, mi = pr * bi + pi * br; s += cc[2 * (c * 64 + p)] * mr - cc[2 * (c * 64 + p) + 1] * mi; }
        if (tt == 0 && c == cp) s += in[I_D][g * 16 + c];
        ((float*)(ws + WS_KTAB))[((g * TC + tt) * 16 + c) * 16 + cp] = s;
    } else {
        const int u = tid - 256;
        bf16_t* bty = (bf16_t*)(ws + WS_BTY) + (size_t)g * 512 * UGP; bf16_t* bte = (bf16_t*)(ws + WS_BTE) + (size_t)g * 256 * 512;
        for (int idx = u; idx < 1024; idx += 256) { const int c = idx >> 6, p = idx & 63;
            const float cr = cc[2 * idx], ci = cc[2 * idx + 1], pr = pwB[2 * p], pi = pwB[2 * p + 1];
            const float zr = cr * pr - ci * pi, zi = cr * pi + ci * pr;
            *(unsigned*)(bty + (size_t)(tt * 16 + c) * UGP + 512 + 2 * p) = pk2(zr, -zi); }
        for (int idx = u; idx < 1024; idx += 256) { const int p = idx >> 4, cp = idx & 15;
            const float pr = pwC[2 * p], pi = pwC[2 * p + 1], br = bb[2 * idx], bi = bb[2 * idx + 1];
            bte[(size_t)(2 * p) * 512 + tt * 16 + cp] = (bf16_t)f2bf(pr * br - pi * bi); bte[(size_t)(2 * p + 1) * 512 + tt * 16 + cp] = (bf16_t)f2bf(pr * bi + pi * br); }
        *(u32x4*)(bte + (size_t)(128 + (u >> 1)) * 512 + tt * 16 + (u & 1) * 8) = (u32x4){0u, 0u, 0u, 0u};
    }
    __syncthreads();
}

#define RLX_AGENT __ATOMIC_RELAXED, __HIP_MEMORY_SCOPE_AGENT
#define XB_TMO      128
#define XB_XCNT(j)  (256  + 64 * (j))
#define XB_XSUB(j)  (1280 + 64 * (j))
#define XB_XGEN(j)  (2304 + 64 * (j))
#define XB_TOP      3328
#define XB_TOPGEN   3392
#define XCD_BAR_WORDS 3456
#define XB_SPIN_CAP (1u << 18)

__device__ __forceinline__ unsigned xb_ld(unsigned* p)              { return __hip_atomic_load(p, __ATOMIC_RELAXED, __HIP_MEMORY_SCOPE_AGENT); }
__device__ __forceinline__ unsigned xb_add(unsigned* p, unsigned v) { return __hip_atomic_fetch_add(p, v, __ATOMIC_RELAXED, __HIP_MEMORY_SCOPE_AGENT); }
__device__ __forceinline__ unsigned xb_xcc_id() { return (unsigned)__builtin_amdgcn_s_getreg((3 << 11) | 20) & 0xFu; }
#define XB_SPIN(cond, bar) do { unsigned _sp = 0; while (cond) { __builtin_amdgcn_s_sleep(1); \
    if ((++_sp & 255u) == 0u) { if (xb_ld(&(bar)[XB_TMO])) break; if (_sp > XB_SPIN_CAP) { atomicAdd(&(bar)[XB_TMO], 1u); break; } } } } while (0)

struct XcdBarrier {
    unsigned* bar; unsigned x;
    volatile LAS unsigned* st;
};

__device__ __forceinline__ XcdBarrier xcd_barrier_post(unsigned* bar, volatile LAS unsigned* st) {
    XcdBarrier b; b.bar = bar; b.x = xb_xcc_id(); b.st = st;
    if (threadIdx.x == 0) (void)xb_add(&bar[XB_XCNT(b.x)], 1u);
    return b;
}
__device__ __forceinline__ void xcd_barrier_complete(unsigned* bar, unsigned x, unsigned& nloc, unsigned& nx) {
    const unsigned G = gridDim.x * gridDim.y * gridDim.z;
    unsigned sum, cnt, mine, sp = 0u;
    for (;;) {
        sum = 0u; cnt = 0u; mine = 0u;
#pragma unroll
        for (unsigned j = 0; j < 16; ++j) { const unsigned c = xb_ld(&bar[XB_XCNT(j)]); sum += c; cnt += (c > 0u) ? 1u : 0u; mine = (j == x) ? c : mine; }
        if (sum == G) break;
        __builtin_amdgcn_s_sleep(1);
        if ((++sp & 255u) == 0u) { if (xb_ld(&bar[XB_TMO])) break; if (sp > XB_SPIN_CAP) { atomicAdd(&bar[XB_TMO], 1u); break; } }
    }
    nloc = mine > 0u ? mine : 1u; nx = cnt > 0u ? cnt : 1u;
}

__device__ __forceinline__ void xcd_barrier(const XcdBarrier& b) {
    asm volatile("s_waitcnt vmcnt(0)" ::: "memory");
    __syncthreads();
    if (threadIdx.x == 0) {
        unsigned* bar = b.bar;
        __builtin_amdgcn_s_waitcnt(0);
        unsigned nloc = b.st[0], nx = b.st[1];
        if (nloc == 0u) { xcd_barrier_complete(bar, b.x, nloc, nx); b.st[0] = nloc; b.st[1] = nx; }
        const unsigned old = xb_add(&bar[XB_XSUB(b.x)], 1u);
        const unsigned gen = old / nloc;
        if (old + 1u == (gen + 1u) * nloc) {
            __builtin_amdgcn_fence(__ATOMIC_RELEASE, "agent");
            asm volatile("s_waitcnt vmcnt(0)" ::: "memory");
            const unsigned og = xb_add(&bar[XB_TOP], 1u);
            const unsigned tg = og / nx;
            if (og + 1u == (tg + 1u) * nx) xb_add(&bar[XB_TOPGEN], 1u);
            else XB_SPIN(xb_ld(&bar[XB_TOPGEN]) == tg, bar);
            __builtin_amdgcn_fence(__ATOMIC_ACQUIRE, "agent");
            xb_add(&bar[XB_XGEN(b.x)], 1u);
            asm volatile("s_waitcnt vmcnt(0)" ::: "memory");
        } else {
            XB_SPIN(xb_ld(&bar[XB_XGEN(b.x)]) == gen, bar);
            __builtin_amdgcn_fence(__ATOMIC_ACQUIRE, "agent");
            asm volatile("s_waitcnt vmcnt(0)" ::: "memory");
        }
    }
    __syncthreads();
}


#ifndef FIRST_STEP
#define FIRST_STEP 0
#endif
#ifndef LAST_STEP
#define LAST_STEP 18
#endif
#define ON(n) (FIRST_STEP <= (n) && (n) <= LAST_STEP)
#define SYNC(n) do { if ((n) < LAST_STEP) { XcdBarrier bar_; bar_.bar = (unsigned*)ws; bar_.x = xb_xcc_id(); bar_.st = (volatile LAS unsigned*)(L + RING_BYTES + 352); xcd_barrier(bar_); } } while (0)
#define WSB(off) ((const bf16_t*)(ws + (off)))
__global__ void __launch_bounds__(512, 2) fox_s5_mega(Args a) {
    extern __shared__ __attribute__((aligned(16))) unsigned char lds[];
    LAS unsigned char* L = (LAS unsigned char*)lds;
    const int G = gridDim.x, bx = blockIdx.x, NGW = G * 8, NGT = G * 512;
#define KA const __attribute__((address_space(4))) unsigned char* ka_ = (const __attribute__((address_space(4))) unsigned char*)__builtin_amdgcn_kernarg_segment_ptr(); asm volatile("" : "+s"(ka_)); \
    InTab in = (InTab)ka_; float* out = *(float* const __attribute__((address_space(4)))*)(ka_ + 256); unsigned char* ws = *(unsigned char* const __attribute__((address_space(4)))*)(ka_ + 264); (void)in; (void)out;
#define IDS int tid = threadIdx.x; asm volatile("" : "+v"(tid)); const int lane = tid & 63, wave = __builtin_amdgcn_readfirstlane(tid >> 6); const int gw = bx * 8 + wave, gt = bx * 512 + tid; (void)lane; (void)gw; (void)gt;
    {
        KA
        if (threadIdx.x < 8) ((volatile LAS unsigned*)(L + RING_BYTES + 320))[threadIdx.x + 8 - 8] = 0u;
        if (threadIdx.x < 2) ((volatile LAS unsigned*)(L + RING_BYTES + 352))[threadIdx.x] = 0u;
        __syncthreads();
        (void)xcd_barrier_post((unsigned*)ws, (volatile LAS unsigned*)(L + RING_BYTES + 352));
    }

    if (ON(0)) {
        KA
        IDS
        LAS float* scr = (LAS float*)(L + wave * 16384);
        { int base = 0;
          for (int j = 0; j < NTJ; ++j) { TJob J; get_tjob(in, ws, j, J);
              int first = gw - (base % NGW); if (first < 0) first += NGW;
              for (int it = first; it < J.items; it += NGW) transpose_item(J, scr, it, lane);
              base += J.items; } }
        __syncthreads();
        LAS float* wf = (LAS float*)L;
        for (int idx = tid; idx < 8192; idx += 512) wf[idx] = in[I_W_IN][(size_t)(idx >> 3) * INCOLS + 1536 + (idx & 7)];
        __syncthreads();
        {
            f32x4 nx[4];
            if (gw < T) { const f32x4* xr = (const f32x4*)(in[I_X] + (size_t)gw * DM) + lane;
#pragma unroll
                for (int j = 0; j < 4; ++j) nx[j] = xr[64 * j]; }
            const f32x4* gp = (const f32x4*)in[I_NORM_MIX]; f32x4 gn[4];
#pragma unroll
            for (int j = 0; j < 4; ++j) gn[j] = gp[64 * j + lane];
            const float fbias = in[I_FBIAS][lane & 7];
            for (int m = gw; m < T; m += NGW) {
                f32x4 v[4]; float s = 0.f;
#pragma unroll
                for (int j = 0; j < 4; ++j) { v[j] = nx[j]; s += (v[j][0] * v[j][0] + v[j][1] * v[j][1]) + (v[j][2] * v[j][2] + v[j][3] * v[j][3]); }
                if (m + NGW < T) { const f32x4* xr = (const f32x4*)(in[I_X] + (size_t)(m + NGW) * DM) + lane;
#pragma unroll
                    for (int j = 0; j < 4; ++j) nx[j] = xr[64 * j]; }
                const float rs = rsqrtf(wave_sum(s) * (1.f / DM) + EPS);
                u32x2* o8 = (u32x2*)((bf16_t*)(ws + WS_HN) + (size_t)m * DM) + lane;
#pragma unroll
                for (int j = 0; j < 4; ++j) { v[j] = v[j] * rs * gn[j]; u32x2 w; w.x = pk2(v[j][0], v[j][1]); w.y = pk2(v[j][2], v[j][3]); o8[64 * j] = w; }
                float d[8];
#pragma unroll
                for (int h = 0; h < 8; ++h) d[h] = 0.f;
#pragma unroll
                for (int j = 0; j < 4; ++j)
#pragma unroll
                    for (int i = 0; i < 4; ++i) { const int k = 256 * j + 4 * lane + i; const f32x4 w0 = *(const LAS f32x4*)(wf + k * 8), w1 = *(const LAS f32x4*)(wf + k * 8 + 4);
                        d[0] += v[j][i] * w0[0]; d[1] += v[j][i] * w0[1]; d[2] += v[j][i] * w0[2]; d[3] += v[j][i] * w0[3];
                        d[4] += v[j][i] * w1[0]; d[5] += v[j][i] * w1[1]; d[6] += v[j][i] * w1[2]; d[7] += v[j][i] * w1[3]; }
                float e4[4];
#pragma unroll
                for (int h = 0; h < 4; ++h) { const float keep = (lane & 4) ? d[h + 4] : d[h], give = (lane & 4) ? d[h] : d[h + 4]; e4[h] = keep + __shfl_xor(give, 4); }
                float e2[2];
#pragma unroll
                for (int h = 0; h < 2; ++h) { const float keep = (lane & 2) ? e4[h + 2] : e4[h], give = (lane & 2) ? e4[h] : e4[h + 2]; e2[h] = keep + __shfl_xor(give, 2); }
                float z; { const float keep = (lane & 1) ? e2[1] : e2[0], give = (lane & 1) ? e2[0] : e2[1]; z = keep + __shfl_xor(give, 1); }
                z += __shfl_xor(z, 8); z += __shfl_xor(z, 16); z += __shfl_xor(z, 32);
                if (lane < 8) {
                    z += fbias;
                    const float ls = fminf(z, 0.f) - __logf(1.f + __expf(-fabsf(z)));
                    const int b = m >> 11, t = m & 2047;
                    ((float*)(ws + WS_LOGF))[(size_t)(b * 8 + lane) * SEQ + t] = ls; }
            }
        }
        for (int m = gw; m < TM; m += NGW) { f32x4 v[4]; rms_row(in[I_MEM] + (size_t)m * DM, in[I_NMEM], (bf16_t*)(ws + WS_MN) + (size_t)m * DM, lane, v); }
        __syncthreads();
        for (int task = bx; task < S5G * TC; task += G) { const int per = (S5G * TC) / G; const int t2 = ((S5G * TC) % G == 0) ? (task % G) * per + task / G : task;
            s5_prep_task(in, ws, t2 / TC, t2 % TC, (LAS float*)L, tid); }
        SYNC(0);
    }
    if (ON(1)) {
        KA
        IDS
        const float* kt = (const float*)(ws + WS_KTAB); bf16_t* bty = (bf16_t*)(ws + WS_BTY);
        for (int idx = gt; idx < S5G * 512 * 64; idx += NGT) {
            const int half = idx & 1, ss = (idx >> 1) & 31, nn = (idx >> 6) & 511, gI = idx >> 15; const int tt = nn >> 4, c = nn & 15;
            u32x4 w = (u32x4){0u, 0u, 0u, 0u};
            if (ss <= tt) { const float* src = kt + ((size_t)((gI * TC + (tt - ss)) * 16 + c)) * 16 + half * 8; const f32x4 k0 = *(const f32x4*)src, k1 = *(const f32x4*)(src + 4);
                w.x = pk2(k0[0], k0[1]); w.y = pk2(k0[2], k0[3]); w.z = pk2(k1[0], k1[1]); w.w = pk2(k1[2], k1[3]); }
            *(u32x4*)(bty + ((size_t)gI * 512 + nn) * UGP + ss * 16 + half * 8) = w; }
        if (wave == 0 && bx < BATCH * NFH) {
            const float* lf = (const float*)(ws + WS_LOGF) + (size_t)bx * SEQ + lane * 32; float* cb = (float*)(ws + WS_CB) + (size_t)bx * SEQ + lane * 32;
            f32x4 x[8]; float run = 0.f;
#pragma unroll
            for (int j = 0; j < 8; ++j) { x[j] = ((const f32x4*)lf)[j]; x[j][0] += run; x[j][1] += x[j][0]; x[j][2] += x[j][1]; x[j][3] += x[j][2]; run = x[j][3]; }
            float incl = run;
#pragma unroll
            for (int o = 1; o < 64; o <<= 1) { const float y = __shfl_up(incl, o); if (lane >= o) incl += y; }
            const float excl = incl - run;
#pragma unroll
            for (int j = 0; j < 8; ++j) ((f32x4*)cb)[j] = (x[j] + excl) * LOG2E;
        }
    }
    if (ON(2)) {
        KA
        pg8::Gemm g{WSB(WS_HN), WSB(WS_WIN), DM, DM, DM}; GOrder<OK_PLAIN> S; S.init(T / 256, 8, G, bx, DM, DM);
        Epi<EK_PROJ> E{ws + WS_Q, ws + WS_K, ws + WS_V, ws + WS_UG, in[I_FQN], in[I_FKN], nullptr};
        pg8::gemm_phase(L, g, S, E);
    }
    if (ON(3)) {
        KA
        pg8::Gemm g{WSB(WS_MN), WSB(WS_WXK), DM, DM, DM}; GOrder<OK_PLAIN> S; S.init(TM / 256, 4, G, bx, DM, DM);
        Epi<EK_MEMK> E{ws + WS_KST, ws + WS_SSQK, nullptr, nullptr, nullptr, nullptr, nullptr};
        pg8::gemm_phase(L, g, S, E);
    }
    if (ON(4)) {
        KA
        pg8::Gemm g{WSB(WS_WXV), WSB(WS_MN), DM, DM, DM}; GOrder<OK_PLAIN> S; S.init(4, TM / 256, G, (bx + 128) % G, DM, DM);
        Epi<EK_MEMVT> E{ws + WS_VT, nullptr, nullptr, nullptr, nullptr, nullptr, nullptr};
        pg8::gemm_phase(L, g, S, E);
        SYNC(4);
    }
    if (ON(5)) {
        KA
        const int vcu = (G % 8 == 0) ? (bx % 8) * (G / 8) + bx / 8 : bx;
        float skip_th; { const int ln = threadIdx.x & 63; float gq = fabsf(in[I_FQN][ln]), gk = fabsf(in[I_FKN][ln]);
#pragma unroll
            for (int o = 1; o < 64; o <<= 1) { gq = fmaxf(gq, __shfl_xor(gq, o)); gk = fmaxf(gk, __shfl_xor(gk, o)); }
            skip_th = 2.f * (64.f * C2Q * gq * gk) + 40.f; }
        for (int L2 = vcu; L2 < BATCH * NFH * 2; L2 += G) { const int bh = L2 >> 1, s = L2 & 1;
            for (int i = 0; i < 4; ++i) { const int qb = (i == 0) ? s : (i == 1) ? 3 - s : (i == 2) ? 4 + s : 7 - s;
                attn_body::attn_unit<8>(bh >> 3, bh & 7, qb, (const attn_body::bf16*)(ws + WS_Q), (const attn_body::bf16*)(ws + WS_K), (const attn_body::bf16*)(ws + WS_V),
                                        (attn_body::bf16*)(ws + WS_FOX), (const float*)(ws + WS_CB), (float*)(ws + WS_SSQF), (char*)lds, skip_th); } }
    }
    if (ON(6)) {
        KA
        pg8::Gemm g{WSB(WS_UG), WSB(WS_BTE), UGP, 512, 256}; GOrder<OK_S5E> S; S.init(256, 1, G, bx, UGP, 512);
        Epi<EK_S5E> E{ws + WS_EPART, nullptr, nullptr, nullptr, nullptr, nullptr, nullptr};
        pg8::gemm_phase(L, g, S, E);
        SYNC(6);
    }
    if (ON(7)) {
        KA
        IDS
        const float* ep = (const float*)(ws + WS_EPART); const float* lb = (const float*)(ws + WS_LB32); bf16_t* ug = (bf16_t*)(ws + WS_UG);
        for (int idx = gt; idx < S5G * BATCH * S5P; idx += NGT) { const int p = idx & 63, gb = idx >> 6, gI = gb >> 4;
            const float lr = lb[(gI * 64 + p) * 2], li = lb[(gI * 64 + p) * 2 + 1]; float sr = 0.f, si = 0.f;
            for (int k0 = 0; k0 < NCH; k0 += 16) {
                f32x2 e0[16], e1[16];
#pragma unroll
                for (int j = 0; j < 16; ++j) { const size_t row = (size_t)gb * NCH + k0 + j; e0[j] = *(const f32x2*)(ep + row * 128 + 2 * p); e1[j] = *(const f32x2*)(ep + (size_t)32768 * 128 + row * 128 + 2 * p); }
#pragma unroll
                for (int j = 0; j < 16; ++j) { const size_t row = (size_t)gb * NCH + k0 + j;
                    *(unsigned*)(ug + row * UGP + 512 + 2 * p) = pk2(sr, si);
                    const float nr = lr * sr - li * si + (e0[j][0] + e1[j][0]), ni = lr * si + li * sr + (e0[j][1] + e1[j][1]); sr = nr; si = ni; } } }
        SYNC(7);
    }
    if (ON(8)) {
        KA
        pg8::Gemm g{WSB(WS_UG), WSB(WS_BTY), UGP, UGP, UGP}; GOrder<OK_S5Y> S; S.init(256, 1, G, bx, UGP, UGP);
        Epi<EK_S5Y> E{ws + WS_Y1, nullptr, nullptr, nullptr, nullptr, nullptr, nullptr};
        pg8::gemm_phase(L, g, S, E);
        SYNC(8);
    }
    if (ON(9)) {
        KA
        pg8::Gemm g{WSB(WS_Y1), WSB(WS_WGLU), 512, 512, 512}; GOrder<OK_PLAIN> S; S.init(T / 256, 2, G, bx, 512, 512);
        Epi<EK_GLU> E{ws + WS_Y2, ws + WS_SSQY, nullptr, nullptr, ws + WS_Y1, in[I_BGLU], nullptr};
        pg8::gemm_phase(L, g, S, E);
        SYNC(9);
    }
    if (ON(10)) {
        KA
        IDS
        const float* sf = (const float*)(ws + WS_SSQF); const float* sy = (const float*)(ws + WS_SSQY);
        const bf16_t* fox = WSB(WS_FOX); const bf16_t* y2 = WSB(WS_Y2); bf16_t* mx = (bf16_t*)(ws + WS_MIXN);
        {
            f32x4 a0, a1, b0, b1; u32x4 f, y;
#define NRM_LOAD(mm) do { a0 = *(const f32x4*)(sf + (size_t)(mm) * 8); a1 = *(const f32x4*)(sf + (size_t)(mm) * 8 + 4); b0 = *(const f32x4*)(sy + (size_t)(mm) * 8); b1 = *(const f32x4*)(sy + (size_t)(mm) * 8 + 4); \
                f = *(const u32x4*)(fox + (size_t)(mm) * 512 + lane * 8); y = *(const u32x4*)(y2 + (size_t)(mm) * 512 + lane * 8); } while (0)
            if (gw < T) NRM_LOAD(gw);
            for (int m = gw; m < T; m += NGW) {
                const float rf = rsqrtf((((a0[0] + a0[1]) + (a0[2] + a0[3])) + ((a1[0] + a1[1]) + (a1[2] + a1[3]))) * (1.f / 512.f) + EPS);
                const float ry = rsqrtf((((b0[0] + b0[1]) + (b0[2] + b0[3])) + ((b1[0] + b1[1]) + (b1[2] + b1[3]))) * (1.f / 512.f) + EPS);
                u32x4 of, oy;
                of.x = pk2(bflo(f.x) * rf, bfhi(f.x) * rf); of.y = pk2(bflo(f.y) * rf, bfhi(f.y) * rf); of.z = pk2(bflo(f.z) * rf, bfhi(f.z) * rf); of.w = pk2(bflo(f.w) * rf, bfhi(f.w) * rf);
                oy.x = pk2(bflo(y.x) * ry, bfhi(y.x) * ry); oy.y = pk2(bflo(y.y) * ry, bfhi(y.y) * ry); oy.z = pk2(bflo(y.z) * ry, bfhi(y.z) * ry); oy.w = pk2(bflo(y.w) * ry, bfhi(y.w) * ry);
                if (m + NGW < T) NRM_LOAD(m + NGW);
                *(u32x4*)(mx + (size_t)m * DM + lane * 8) = of; *(u32x4*)(mx + (size_t)m * DM + 512 + lane * 8) = oy; }
#undef NRM_LOAD
        }
        SYNC(10);
    }
    if (ON(11)) {
        KA
        pg8::Gemm g{WSB(WS_MIXN), WSB(WS_WOUT), DM, DM, DM}; GOrder<OK_PLAIN> S; S.init(T / 256, 4, G, bx, DM, DM);
        Epi<EK_WOUT> E{out, ws + WS_H1B, ws + WS_SSQ1, nullptr, in[I_X], nullptr, nullptr};
        pg8::gemm_phase(L, g, S, E);
        SYNC(11);
    }
    if (ON(12)) {
        KA
        IDS
        const float* sk = (const float*)(ws + WS_SSQK); float* sck = (float*)(ws + WS_SCK);
        for (int idx = gt; idx < TM * 4; idx += NGT) { const int key = idx >> 2, h = idx & 3; const f32x4 q = *(const f32x4*)(sk + (size_t)key * 16 + h * 4);
            sck[(size_t)h * TM + key] = rsqrtf(((q[0] + q[1]) + (q[2] + q[3])) * (1.f / 256.f) + EPS); }
        pg8::Gemm g{WSB(WS_H1B), WSB(WS_WXQ), DM, DM, DM}; GOrder<OK_PLAIN> S; S.init(T / 256, 4, G, bx, DM, DM);
        Epi<EK_XQ> E{ws + WS_QST, ws + WS_SSQQ, nullptr, nullptr, in[I_XQN], in[I_XKN], nullptr};
        pg8::gemm_phase(L, g, S, E);
        SYNC(12);
    }
    if (ON(13)) {
        KA
        pg8::Gemm g{WSB(WS_QST), WSB(WS_KST), DM, DM, 256}; GOrder<OK_XS> S; S.init(512, 1, G, bx, DM, DM);
        Epi<EK_XS> E{ws + WS_P, ws + WS_PSUM, nullptr, nullptr, ws + WS_SSQ1, ws + WS_SSQQ, ws + WS_SCK};
        pg8::gemm_phase(L, g, S, E);
        SYNC(13);
    }
    if (ON(14)) {
        KA
        pg8::Gemm g{WSB(WS_P), WSB(WS_VT), DM, TM, 256}; GOrder<OK_XO> S; S.init(512, 1, G, bx, DM, TM);
        Epi<EK_XO> E{ws + WS_XO, nullptr, nullptr, nullptr, ws + WS_PSUM, nullptr, nullptr};
        pg8::gemm_phase(L, g, S, E);
        SYNC(14);
    }
    if (ON(15)) {
        KA
        pg8::Gemm g{WSB(WS_XO), WSB(WS_WXO), DM, DM, DM}; GOrder<OK_PLAIN> S; S.init(T / 256, 4, G, bx, DM, DM);
        Epi<EK_WXO> E{out, ws + WS_H2B, ws + WS_SSQ2, nullptr, out, nullptr, nullptr};
        pg8::gemm_phase(L, g, S, E);
        SYNC(15);
    }
    if (ON(16)) {
        KA
        { IDS
          const float* s2 = (const float*)(ws + WS_SSQ2); float* r2 = (float*)(ws + WS_RS2);
          for (int row = gt; row < T; row += NGT) { const f32x4 t0 = *(const f32x4*)(s2 + (size_t)row * 16), t1 = *(const f32x4*)(s2 + (size_t)row * 16 + 4), t2 = *(const f32x4*)(s2 + (size_t)row * 16 + 8), t3 = *(const f32x4*)(s2 + (size_t)row * 16 + 12);
              r2[row] = rsqrtf((((t0[0] + t0[1]) + (t0[2] + t0[3])) + ((t1[0] + t1[1]) + (t1[2] + t1[3])) + ((t2[0] + t2[1]) + (t2[2] + t2[3])) + ((t3[0] + t3[1]) + (t3[2] + t3[3]))) * (1.f / DM) + EPS); }
          SYNC(15); }
        pg8::Gemm g{WSB(WS_H2B), WSB(WS_WUP), DM, DM, DM}; GOrder<OK_PLAIN> S; S.init(T / 256, 22, G, bx, DM, DM);
        Epi<EK_UPC> E{ws + WS_U, ws + WS_G, ws + WS_G + 4 * MiB, ws + WS_G + 8 * MiB, ws + WS_RS2, in[I_CONVW], in[I_CONVB], (LAS float*)(L + RING_BYTES + 1024)};
        pg8::gemm_phase(L, g, S, E);
        SYNC(16);
    }
    if (ON(17)) {
        KA
        IDS
        const float* GHF = (const float*)(ws + WS_G); const float* GHL = (const float*)(ws + WS_G + 4 * MiB); const float* UH = (const float*)(ws + WS_G + 8 * MiB);
        const float* cw = in[I_CONVW]; const float* cbv = in[I_CONVB]; bf16_t* A = (bf16_t*)(ws + WS_U);
        for (int idx = gt; idx < (T / 256) * 2 * DFF; idx += NGT) { const int j = idx % DFF, pi = idx / DFF, i = pi & 1, pm = pi >> 1; const bool first = (pm & 7) == 0;
            const float g0 = GHF[(size_t)pi * DFF + j];
            const float gl1 = first ? 0.f : GHL[((size_t)(pm - 1) * 2 + 1) * DFF + j], gl0 = first ? 0.f : GHL[((size_t)(pm - 1) * 2) * DFF + j];
            const float g1 = i ? GHF[(size_t)(pm * 2) * DFF + j] : gl1, g2 = i ? gl1 : gl0;
            const float z = cbv[j] + cw[j] * g2 + cw[DFF + j] * g1 + cw[2 * DFF + j] * g0;
            A[(size_t)(pm * 256 + i) * DFF + j] = (bf16_t)f2bf(z * sigm(z) * UH[(size_t)pi * DFF + j]); }
        SYNC(17);
    }
    if (ON(18)) {
        KA
        pg8::Gemm g{WSB(WS_U), WSB(WS_WDN), DFF, DFF, DFF}; GOrder<OK_PLAIN> S; S.init(T / 256, 4, G, bx, DFF, DFF);
        Epi<EK_DOWN> E{out, nullptr, nullptr, nullptr, nullptr, nullptr, nullptr};
        pg8::gemm_phase(L, g, S, E);
    }
}

extern "C" void kernel_launch(void* const* d_in, const int* in_sizes, int n_in, void* d_out, int out_size, void* d_ws, size_t ws_size, hipStream_t stream) {
    static int grid = 0;
    if (grid == 0) {
        if (n_in != 32 || out_size != T * DM || ws_size < WS_END) { fprintf(stderr, "kernel_launch: unexpected shapes (n_in %d out %d ws %zu)\n", n_in, out_size, ws_size); grid = -1; return; }
        int dev = 0, cus = 0, per_cu = 0;
        (void)hipGetDevice(&dev); (void)hipDeviceGetAttribute(&cus, hipDeviceAttributeMultiprocessorCount, dev);
        if (hipFuncSetAttribute((const void*)fox_s5_mega, hipFuncAttributeMaxDynamicSharedMemorySize, LDS_TOTAL) != hipSuccess) { fprintf(stderr, "kernel_launch: hipFuncSetAttribute failed\n"); grid = -1; return; }
        if (hipOccupancyMaxActiveBlocksPerMultiprocessor(&per_cu, (const void*)fox_s5_mega, 512, LDS_TOTAL) != hipSuccess || per_cu < 1) { fprintf(stderr, "kernel_launch: occupancy query says %d\n", per_cu); per_cu = 1; }
        (void)hipGetLastError();
        grid = cus;
        if (grid > cus * per_cu) grid = cus * per_cu;
    }
    if (grid < 0) return;
    if (hipMemsetAsync(d_ws, 0, 65536, stream) != hipSuccess) { fprintf(stderr, "kernel_launch: memset of the barrier words failed\n"); return; }
    Args a{};
    for (int i = 0; i < 32; ++i) a.in[i] = (const float*)d_in[i];
    a.out = (float*)d_out; a.ws = (unsigned char*)d_ws;
    void* args[] = {&a};
    hipError_t e = hipLaunchCooperativeKernel((const void*)fox_s5_mega, dim3(grid), dim3(512), args, LDS_TOTAL, stream);
    if (e != hipSuccess) fprintf(stderr, "cooperative launch failed: %s (grid %d)\n", hipGetErrorString(e), grid);
}
```

```cpp
#include <hip/hip_runtime.h>
#include <hip/hip_cooperative_groups.h>
#include <hip/hip_bf16.h>
#include <cstdio>
#include <cstdint>
#include <cmath>
namespace cg = cooperative_groups;

constexpr int BATCH = 16, SEQ = 2048, DM = 1024, T = BATCH * SEQ;
constexpr int NMEM = 256, TM = BATCH * NMEM;
constexpr int FOXW = 512, HD = 64, NFH = 8;
constexpr int S5W = 512, S5G = 32, S5C = 16, S5P = 64;
constexpr int NXH = 4, XHD = 256;
constexpr int DFF = 2816;
constexpr int INCOLS = 2056;
constexpr float EPS = 1e-6f;
constexpr int TC = 32, NCH = SEQ / TC;
constexpr int UGP = TC * 16 + 128;
constexpr float LOG2E = 1.4426950408889634f;
constexpr float C2Q = 0.125f * LOG2E;

#define LAS __attribute__((address_space(3)))
typedef unsigned short bf16_t;
typedef short bf16x8 __attribute__((ext_vector_type(8)));
typedef float f32x4 __attribute__((ext_vector_type(4)));
typedef float f32x2 __attribute__((ext_vector_type(2)));
typedef unsigned u32x4 __attribute__((ext_vector_type(4)));
typedef unsigned u32x2 __attribute__((ext_vector_type(2)));

__device__ __forceinline__ unsigned f2bf(float f) { unsigned u = __builtin_bit_cast(unsigned, f); return (u + 0x7fffu + ((u >> 16) & 1u)) >> 16; }
typedef __bf16 bf16x2_hw __attribute__((ext_vector_type(2)));
__device__ __forceinline__ unsigned pk2(float lo, float hi) { f32x2 v = {lo, hi}; bf16x2_hw b = __builtin_convertvector(v, bf16x2_hw); return __builtin_bit_cast(unsigned, b); }
__device__ __forceinline__ float bflo(unsigned w) { return __builtin_bit_cast(float, w << 16); }
__device__ __forceinline__ float bfhi(unsigned w) { return __builtin_bit_cast(float, w & 0xffff0000u); }
__device__ __forceinline__ float wave_sum(float v) {
#pragma unroll
    for (int o = 1; o < 64; o <<= 1) v += __shfl_xor(v, o);
    return v;
}

__device__ __forceinline__ float red_fq(float v) {
    v += __builtin_bit_cast(float, __builtin_amdgcn_ds_swizzle(__builtin_bit_cast(int, v), 0x401F));
    float a = v, b = v;
    asm volatile("s_nop 1\n\tv_permlane32_swap_b32 %0, %1\n\ts_nop 1" : "+v"(a), "+v"(b));
    return a + b;
}

constexpr size_t MiB = 1u << 20;
constexpr size_t WS_WIN = 1 * MiB, WS_WGLU = 5 * MiB, WS_WOUT = 6 * MiB, WS_WXQ = 8 * MiB, WS_WXK = 10 * MiB, WS_WXV = 12 * MiB, WS_WXO = 14 * MiB,
                 WS_WUP = 16 * MiB, WS_WDN = 27 * MiB, WS_BTY = 33 * MiB, WS_BTE = 53 * MiB, WS_KTAB = 61 * MiB, WS_LB32 = 62 * MiB, WS_LOGF = 63 * MiB,
                 WS_CB = 64 * MiB, WS_SSQF = 65 * MiB, WS_SSQY = 66 * MiB, WS_SSQ1 = 67 * MiB, WS_SSQ2 = 69 * MiB, WS_SSQQ = 71 * MiB, WS_PSUM = 73 * MiB,
                 WS_SSQK = 75 * MiB, WS_SCK = 76 * MiB, WS_RS2 = 77 * MiB;
constexpr size_t WS_HN = 80 * MiB, WS_FOX = 80 * MiB, WS_Y1 = 112 * MiB, WS_QST = 80 * MiB, WS_H2B = 80 * MiB;
constexpr size_t WS_MN = 144 * MiB, WS_KST = 152 * MiB, WS_VT = 160 * MiB;
constexpr size_t WS_Q = 168 * MiB, WS_K = 200 * MiB, WS_V = 232 * MiB, WS_Y2 = 168 * MiB, WS_MIXN = 200 * MiB, WS_P = 168 * MiB;
constexpr size_t WS_UG = 264 * MiB, WS_EPART = 304 * MiB, WS_H1B = 264 * MiB, WS_XO = 264 * MiB;
constexpr size_t WS_G = 144 * MiB, WS_U = 320 * MiB, WS_END = 496 * MiB;

namespace pg8 {
constexpr int BM = 256, BK = 64, HALF = 128, HTB = HALF * BK * 2, STAGE_BYTES = 8 * HTB;
__device__ __forceinline__ int lds_byte(int r, int c) { const int st = (r >> 4) * 2 + (c >> 5), rr = r & 15, cc = c & 31, ob = rr * 64 + cc * 2; return st * 1024 + (ob ^ (((ob >> 9) & 1) << 5)); }
__device__ __forceinline__ void stage_rc(int b, int& R, int& C) { const int st = b / 1024, sb = b % 1024, swz = sb ^ (((sb >> 9) & 1) << 5); R = (st >> 1) * 16 + swz / 64; C = (st & 1) * 32 + (swz % 64) / 2; }
__device__ __forceinline__ int perm32(int rho) { const int n = rho >> 4, i = rho & 15; return 8 * (i >> 2) + 4 * n + (i & 3); }

struct Unit { int pm, pn; long offA, offB; };
struct Gemm { const bf16_t* A; const bf16_t* Bt; int lda, ldb, K; };

template <class Epi, class Sched>
__device__ __forceinline__ void gemm_phase(LAS unsigned char* lds, const Gemm g, const Sched& S, const Epi& E) {
    int tid = threadIdx.x; asm volatile("" : "+v"(tid));
    const int wid = __builtin_amdgcn_readfirstlane(tid >> 6), lane = tid & 63, wr = wid >> 2, wc = wid & 3, fr = lane & 15, fq = lane >> 4;
    const int K = g.K, nt = K / BK;
    unsigned voffA[2], voffB[2];
#pragma unroll
    for (int i = 0; i < 2; ++i) { int R, C; stage_rc(tid * 16 + i * 8192, R, C); const int Rb = (R & ~31) + perm32(R & 31);
        voffA[i] = (unsigned)(R * g.lda + C) * 2u; voffB[i] = (unsigned)(Rb * g.ldb + C) * 2u; }
    const size_t kstep = (size_t)(BK * 2);
    const size_t hstepA = (size_t)HALF * g.lda * 2, hstepB = (size_t)HALF * g.ldb * 2;
    const unsigned ldsw = (unsigned)wid * 1024u;
    const int aoff = lds_byte(wr * 64 + fr, fq * 8), boff = lds_byte(wc * 32 + fr, fq * 8);
#define PG8_SA(b, h) (((b) * 2 + (h)) * HTB)
#define PG8_SB(b, h) ((4 + (b) * 2 + (h)) * HTB)
#define PG8_STAGE(bufoff, gbase, voff) do { _Pragma("unroll") for (int _i = 0; _i < 2; ++_i) \
        __builtin_amdgcn_global_load_lds((const unsigned*)((const char*)(gbase) + (voff)[_i]), (LAS unsigned*)(lds + (bufoff) + ldsw + _i * 8192), 16, 0, 0); } while (0)
#define PG8_LDA(dst, b, h) do { _Pragma("unroll") for (int m = 0; m < 4; ++m) _Pragma("unroll") for (int k = 0; k < 2; ++k) dst[m][k] = *(const LAS bf16x8*)(lds + PG8_SA(b, h) + aoff + m * 2048 + k * 1024); } while (0)
#define PG8_LDB(dst, b, h) do { _Pragma("unroll") for (int n = 0; n < 2; ++n) _Pragma("unroll") for (int k = 0; k < 2; ++k) dst[n][k] = *(const LAS bf16x8*)(lds + PG8_SB(b, h) + boff + n * 2048 + k * 1024); } while (0)
#define PG8_MMA(ai, bj, At, Bt) do { __builtin_amdgcn_s_setprio(1); _Pragma("unroll") for (int m = 0; m < 4; ++m) _Pragma("unroll") for (int n = 0; n < 2; ++n) _Pragma("unroll") for (int k = 0; k < 2; ++k) \
        acc[ai][bj][m][n] = __builtin_amdgcn_mfma_f32_16x16x32_bf16(Bt[n][k], At[m][k], acc[ai][bj][m][n], 0, 0, 0); __builtin_amdgcn_s_setprio(0); } while (0)
#define PG8_WAIT_V(n) asm volatile("s_waitcnt vmcnt(" #n ")" ::: "memory")
#define PG8_WAIT_L(n) asm volatile("s_waitcnt lgkmcnt(" #n ")" ::: "memory")
#define PG8_BAR __builtin_amdgcn_s_barrier()
#define PG8_SCHED __builtin_amdgcn_sched_barrier(0)
    Unit cur, nxt; int ui = 0;
    if (!S.next(0, cur)) return;
    f32x4 acc[2][2][4][2];
#pragma unroll
    for (int a = 0; a < 2; ++a)
#pragma unroll
        for (int b = 0; b < 2; ++b)
#pragma unroll
            for (int m = 0; m < 4; ++m)
#pragma unroll
                for (int n = 0; n < 2; ++n) acc[a][b][m][n] = (f32x4){0.f, 0.f, 0.f, 0.f};
    bf16x8 At[4][2], B0[2][2], B1[2][2];
    const char* cA = (const char*)g.A + cur.offA; const char* cB = (const char*)g.Bt + cur.offB;
    PG8_STAGE(PG8_SB(0, 0), cB, voffB); PG8_STAGE(PG8_SB(0, 1), cB + hstepB, voffB); PG8_STAGE(PG8_SA(0, 0), cA, voffA); PG8_STAGE(PG8_SA(0, 1), cA + hstepA, voffA);
    if (wr == 1) PG8_BAR;
    PG8_WAIT_V(2); PG8_BAR;
    PG8_STAGE(PG8_SB(1, 0), cB + kstep, voffB); PG8_STAGE(PG8_SA(1, 0), cA + kstep, voffA); PG8_STAGE(PG8_SB(1, 1), cB + hstepB + kstep, voffB);
    PG8_WAIT_V(6); PG8_BAR;
    for (;;) {
        const bool has_next = S.next(ui + 1, nxt);
        const char* nA = has_next ? (const char*)g.A + nxt.offA : cA; const char* nB = has_next ? (const char*)g.Bt + nxt.offB : cB;
        for (int t = 0; t < nt; t += 2) {
            const bool last = (t == nt - 2);
            const char* a1 = cA + (size_t)(t + 1) * kstep;
            const char* a2 = last ? nA : cA + (size_t)(t + 2) * kstep; const char* b2 = last ? nB : cB + (size_t)(t + 2) * kstep;
            const char* a3 = a2 + kstep; const char* b3 = b2 + kstep;
            PG8_LDB(B0, 0, 0); PG8_LDB(B1, 0, 1); PG8_SCHED; PG8_LDA(At, 0, 0); PG8_STAGE(PG8_SA(1, 1), a1 + hstepA, voffA);
            PG8_WAIT_V(8); PG8_WAIT_L(0); PG8_BAR; PG8_MMA(0, 0, At, B0); PG8_MMA(0, 1, At, B1); PG8_BAR; PG8_SCHED;
            PG8_LDA(At, 0, 1); PG8_STAGE(PG8_SB(0, 0), b2, voffB); PG8_STAGE(PG8_SB(0, 1), b2 + hstepB, voffB); PG8_STAGE(PG8_SA(0, 0), a2, voffA);
            PG8_WAIT_V(8); PG8_WAIT_L(0); PG8_BAR; PG8_MMA(1, 0, At, B0); PG8_MMA(1, 1, At, B1); PG8_BAR; PG8_SCHED;
            PG8_LDB(B0, 1, 0); PG8_LDB(B1, 1, 1); PG8_SCHED; PG8_LDA(At, 1, 0); PG8_STAGE(PG8_SA(0, 1), a2 + hstepA, voffA);
            PG8_WAIT_V(8); PG8_WAIT_L(0); PG8_BAR; PG8_MMA(0, 0, At, B0); PG8_MMA(0, 1, At, B1); PG8_BAR; PG8_SCHED;
            PG8_LDA(At, 1, 1); PG8_STAGE(PG8_SB(1, 0), b3, voffB); PG8_STAGE(PG8_SB(1, 1), b3 + hstepB, voffB); PG8_STAGE(PG8_SA(1, 0), a3, voffA);
            PG8_WAIT_V(8); PG8_WAIT_L(0); PG8_BAR; PG8_MMA(1, 0, At, B0); PG8_MMA(1, 1, At, B1); PG8_BAR; PG8_SCHED;
        }
        if (wr == 0) PG8_BAR;
        { int fr2 = fr, fq2 = fq; asm volatile("" : "+v"(fr2), "+v"(fq2));
          E(acc, cur, wr, wc, fr2, fq2); }
        if (!has_next) break;
#pragma unroll
        for (int a = 0; a < 2; ++a)
#pragma unroll
            for (int b = 0; b < 2; ++b)
#pragma unroll
                for (int m = 0; m < 4; ++m)
#pragma unroll
                    for (int n = 0; n < 2; ++n) acc[a][b][m][n] = (f32x4){0.f, 0.f, 0.f, 0.f};
        cur = nxt; cA = nA; cB = nB; ++ui;
        if (wr == 1) PG8_BAR;
    }
    PG8_WAIT_V(0);
    PG8_BAR;
#undef PG8_SA
#undef PG8_SB
#undef PG8_STAGE
#undef PG8_LDA
#undef PG8_LDB
#undef PG8_MMA
#undef PG8_WAIT_V
#undef PG8_WAIT_L
#undef PG8_BAR
#undef PG8_SCHED
}
}
using pg8::Unit;

enum OrderKind { OK_PLAIN = 0, OK_S5E, OK_S5Y, OK_XS, OK_XO };
template <int kind> struct GOrder {
    int nM, nN, nwg, G, c, lda, ldb;
    __device__ __forceinline__ void init(int nM_, int nN_, int G_, int c_, int lda_, int ldb_) { nM = nM_; nN = nN_; nwg = nM_ * nN_; G = G_; c = c_; lda = lda_; ldb = ldb_; }
    __device__ __forceinline__ bool next(int i, Unit& u) const {
        const long L = (long)i * G + c; if (L >= nwg) return false;
        const int l = (int)L;
        if constexpr (kind == OK_PLAIN) {
            int wgid = l; { const int q = nwg / 8, r = nwg % 8, xcd = wgid % 8, off = wgid / 8; wgid = (xcd < r ? xcd * (q + 1) : r * (q + 1) + (xcd - r) * q) + off; }
            const int nig = 8 * nN, gid = wgid / nig, fm = gid * 8, gsz = (nM - fm) < 8 ? (nM - fm) : 8;
            u.pm = fm + ((wgid % nig) % gsz); u.pn = (wgid % nig) / gsz;
            u.offA = (long)u.pm * 256 * lda * 2; u.offB = (long)u.pn * 256 * ldb * 2;
        } else if constexpr (kind == OK_S5E) {
            const int kq = l & 1, pmm = (l >> 1) & 3, gg = l >> 3;
            u.pm = gg * 4 + pmm; u.pn = kq;
            u.offA = ((long)u.pm * 256 * UGP + kq * 256) * 2; u.offB = ((long)gg * 256 * 512 + kq * 256) * 2;
        } else if constexpr (kind == OK_S5Y) {
            const int pn = l & 1, pmm = (l >> 1) & 3, gg = l >> 3;
            u.pm = gg * 4 + pmm; u.pn = pn;
            u.offA = (long)u.pm * 256 * UGP * 2; u.offB = ((long)gg * 512 + pn * 256) * UGP * 2;
        } else if constexpr (kind == OK_XS) {
            const int h = l & 3, pm = l >> 2, b = pm >> 3;
            u.pm = pm; u.pn = h;
            u.offA = ((long)pm * 256 * DM + h * 256) * 2; u.offB = ((long)b * 256 * DM + h * 256) * 2;
        } else {
            const int h = l & 3, pm = l >> 2, b = pm >> 3;
            u.pm = pm; u.pn = h;
            u.offA = ((long)pm * 256 * DM + h * 256) * 2; u.offB = ((long)h * 256 * TM + b * 256) * 2;
        }
        return true;
    }
};

enum EpiKind { EK_PROJ = 0, EK_MEMK, EK_MEMVT, EK_S5E, EK_S5Y, EK_GLU, EK_WOUT, EK_XQ, EK_XS, EK_XO, EK_WXO, EK_UP, EK_DOWN, EK_GATE, EK_UPACT, EK_UPC };
    __device__ __forceinline__ u32x4 pack8(const f32x4 a, const f32x4 b) { u32x4 w; w.x = pk2(a[0], a[1]); w.y = pk2(a[2], a[3]); w.z = pk2(b[0], b[1]); w.w = pk2(b[2], b[3]); return w; }
    __device__ __forceinline__ float gelu_t(float y) { const float z = 0.7978845608028654f * (y + 0.044715f * y * y * y); const float e = __expf(2.f * z); const float th = 1.f - 2.f / (e + 1.f); return 0.5f * y * (1.f + th); }
    __device__ __forceinline__ float sigm(float z) { return 1.f / (1.f + __expf(-z)); }
    __device__ __forceinline__ float ssq8(const f32x4 a, const f32x4 b) { return (a[0] * a[0] + a[1] * a[1]) + (a[2] * a[2] + a[3] * a[3]) + (b[0] * b[0] + b[1] * b[1]) + (b[2] * b[2] + b[3] * b[3]); }

template <int kind> struct Epi {
    void* p0; void* p1; void* p2; void* p3; const void* c0; const void* c1; const void* c2; LAS float* hx;
    __device__ __forceinline__ void operator()(const f32x4 (&acc)[2][2][4][2], const Unit& u, int wr, int wc, int fr, int fq) const {
        const int rbase = u.pm * 256 + wr * 64 + fr;
        const int cl0 = wc * 32 + 8 * fq;
        switch (kind) {
        case EK_PROJ: {
            const int pn = u.pn;
            if (pn < 4) {
                const bool isq = pn < 2; bf16_t* dst = (bf16_t*)(isq ? p0 : p1); const float* gptr = (const float*)(isq ? c0 : c1); const float post = isq ? C2Q : 1.f;
                const int head = 4 * (pn & 1) + wc;
#pragma unroll
                for (int ai = 0; ai < 2; ++ai)
#pragma unroll
                    for (int m = 0; m < 4; ++m) {
                        float ss = ssq8(acc[ai][0][m][0], acc[ai][0][m][1]) + ssq8(acc[ai][1][m][0], acc[ai][1][m][1]);
                        ss = red_fq(ss);
                        const float sc = rsqrtf(ss * (1.f / 64.f) + EPS) * post;
                        const size_t row = (size_t)(rbase + ai * 128 + m * 16);
#pragma unroll
                        for (int bj = 0; bj < 2; ++bj)
                            *(u32x4*)(dst + row * 512 + head * 64 + 32 * bj + 8 * fq) = pack8(acc[ai][bj][m][0] * sc * *(const f32x4*)(gptr + 32 * bj + 8 * fq), acc[ai][bj][m][1] * sc * *(const f32x4*)(gptr + 32 * bj + 8 * fq + 4));
                    }
            } else if (pn < 6) {
                bf16_t* dst = (bf16_t*)p2;
#pragma unroll
                for (int ai = 0; ai < 2; ++ai)
#pragma unroll
                    for (int m = 0; m < 4; ++m) { const size_t row = (size_t)(rbase + ai * 128 + m * 16);
#pragma unroll
                        for (int bj = 0; bj < 2; ++bj) *(u32x4*)(dst + row * 512 + (pn - 4) * 256 + bj * 128 + cl0) = pack8(acc[ai][bj][m][0], acc[ai][bj][m][1]); }
            } else {
                bf16_t* dst = (bf16_t*)p3;
#pragma unroll
                for (int ai = 0; ai < 2; ++ai)
#pragma unroll
                    for (int m = 0; m < 4; ++m) { const int row = rbase + ai * 128 + m * 16; const int b = row >> 11, t = row & 2047, ch = t >> 5, s = t & 31;
#pragma unroll
                        for (int bj = 0; bj < 2; ++bj) { const int f = (pn - 6) * 256 + bj * 128 + cl0; const int gI = f >> 4, cc = f & 15;
                            *(u32x4*)(dst + ((size_t)(gI * 1024 + b * 64 + ch)) * UGP + s * 16 + cc) = pack8(acc[ai][bj][m][0], acc[ai][bj][m][1]); } }
            }
        } break;
        case EK_MEMK: {
            bf16_t* dst = (bf16_t*)p0; float* sq = (float*)p1;
#pragma unroll
            for (int ai = 0; ai < 2; ++ai)
#pragma unroll
                for (int m = 0; m < 4; ++m) { const size_t row = (size_t)(rbase + ai * 128 + m * 16);
                    float ss = ssq8(acc[ai][0][m][0], acc[ai][0][m][1]) + ssq8(acc[ai][1][m][0], acc[ai][1][m][1]);
                    ss = red_fq(ss);
                    if (fq == 0) sq[row * 16 + u.pn * 4 + wc] = ss;
#pragma unroll
                    for (int bj = 0; bj < 2; ++bj) *(u32x4*)(dst + row * DM + u.pn * 256 + bj * 128 + cl0) = pack8(acc[ai][bj][m][0], acc[ai][bj][m][1]); }
        } break;
        case EK_MEMVT: {
            bf16_t* dst = (bf16_t*)p0;
#pragma unroll
            for (int ai = 0; ai < 2; ++ai)
#pragma unroll
                for (int m = 0; m < 4; ++m) { const size_t row = (size_t)(rbase + ai * 128 + m * 16);
#pragma unroll
                    for (int bj = 0; bj < 2; ++bj) *(u32x4*)(dst + row * TM + u.pn * 256 + bj * 128 + cl0) = pack8(acc[ai][bj][m][0], acc[ai][bj][m][1]); }
        } break;
        case EK_S5E: {
            float* dst = (float*)p0 + (size_t)u.pn * 32768 * 128;
#pragma unroll
            for (int ai = 0; ai < 2; ++ai)
#pragma unroll
                for (int m = 0; m < 4; ++m) { const size_t row = (size_t)(rbase + ai * 128 + m * 16);
                    *(f32x4*)(dst + row * 128 + cl0) = acc[ai][0][m][0]; *(f32x4*)(dst + row * 128 + cl0 + 4) = acc[ai][0][m][1]; }
        } break;
        case EK_S5Y: {
            bf16_t* dst = (bf16_t*)p0;
#pragma unroll
            for (int ai = 0; ai < 2; ++ai)
#pragma unroll
                for (int m = 0; m < 4; ++m) { const int r = rbase + ai * 128 + m * 16; const int gI = r >> 10, b = (r >> 6) & 15, k = r & 63;
#pragma unroll
                    for (int bj = 0; bj < 2; ++bj) { const int nn = u.pn * 256 + bj * 128 + cl0; const int tt = nn >> 4, cc = nn & 15;
                        f32x4 a = acc[ai][bj][m][0], c = acc[ai][bj][m][1];
#pragma unroll
                        for (int j = 0; j < 4; ++j) { a[j] = gelu_t(a[j]); c[j] = gelu_t(c[j]); }
                        *(u32x4*)(dst + ((size_t)(b * SEQ + k * TC + tt)) * 512 + gI * 16 + cc) = pack8(a, c); } }
        } break;
        case EK_GLU: {
            bf16_t* dst = (bf16_t*)p0; float* sq = (float*)p1; const bf16_t* y1 = (const bf16_t*)c0; const float* bg = (const float*)c1;
            f32x4 bv[2][2];
#pragma unroll
            for (int bj = 0; bj < 2; ++bj)
#pragma unroll
                for (int n = 0; n < 2; ++n) bv[bj][n] = *(const f32x4*)(bg + u.pn * 256 + bj * 128 + cl0 + 4 * n);
#pragma unroll
            for (int ai = 0; ai < 2; ++ai)
#pragma unroll
                for (int m = 0; m < 4; ++m) { const size_t row = (size_t)(rbase + ai * 128 + m * 16); float ss = 0.f;
#pragma unroll
                    for (int bj = 0; bj < 2; ++bj) { const size_t off = row * 512 + u.pn * 256 + bj * 128 + cl0;
                        const u32x4 yv = *(const u32x4*)(y1 + off);
                        f32x4 a = acc[ai][bj][m][0] + bv[bj][0], c = acc[ai][bj][m][1] + bv[bj][1];
                        a[0] = bflo(yv.x) * sigm(a[0]); a[1] = bfhi(yv.x) * sigm(a[1]); a[2] = bflo(yv.y) * sigm(a[2]); a[3] = bfhi(yv.y) * sigm(a[3]);
                        c[0] = bflo(yv.z) * sigm(c[0]); c[1] = bfhi(yv.z) * sigm(c[1]); c[2] = bflo(yv.w) * sigm(c[2]); c[3] = bfhi(yv.w) * sigm(c[3]);
                        ss += ssq8(a, c);
                        *(u32x4*)(dst + off) = pack8(a, c); }
                    ss = red_fq(ss);
                    if (fq == 0) sq[row * 8 + u.pn * 4 + wc] = ss; }
        } break;
        case EK_WOUT: case EK_WXO: {
            float* out = (float*)p0; bf16_t* hb = (bf16_t*)p1; float* sq = (float*)p2; const float* base = (const float*)c0;
#pragma unroll
            for (int ai = 0; ai < 2; ++ai)
#pragma unroll
                for (int m = 0; m < 4; ++m) { const size_t row = (size_t)(rbase + ai * 128 + m * 16); float ss = 0.f;
#pragma unroll
                    for (int bj = 0; bj < 2; ++bj) { const size_t off = row * DM + u.pn * 256 + bj * 128 + cl0;
                        const f32x4 a = acc[ai][bj][m][0] + *(const f32x4*)(base + off), c = acc[ai][bj][m][1] + *(const f32x4*)(base + off + 4);
                        *(f32x4*)(out + off) = a; *(f32x4*)(out + off + 4) = c;
                        ss += ssq8(a, c);
                        *(u32x4*)(hb + off) = pack8(a, c); }
                    ss = red_fq(ss);
                    if (fq == 0) sq[row * 16 + u.pn * 4 + wc] = ss; }
        } break;
        case EK_XQ: {
            bf16_t* dst = (bf16_t*)p0; float* sq = (float*)p1; const float* gq = (const float*)c0; const float* gk = (const float*)c1;
            f32x4 gg[2][2];
#pragma unroll
            for (int bj = 0; bj < 2; ++bj)
#pragma unroll
                for (int n = 0; n < 2; ++n) gg[bj][n] = *(const f32x4*)(gq + bj * 128 + cl0 + 4 * n) * *(const f32x4*)(gk + bj * 128 + cl0 + 4 * n);
#pragma unroll
            for (int ai = 0; ai < 2; ++ai)
#pragma unroll
                for (int m = 0; m < 4; ++m) { const size_t row = (size_t)(rbase + ai * 128 + m * 16);
                    float ss = ssq8(acc[ai][0][m][0], acc[ai][0][m][1]) + ssq8(acc[ai][1][m][0], acc[ai][1][m][1]);
                    ss = red_fq(ss);
                    if (fq == 0) sq[row * 16 + u.pn * 4 + wc] = ss;
#pragma unroll
                    for (int bj = 0; bj < 2; ++bj) *(u32x4*)(dst + row * DM + u.pn * 256 + bj * 128 + cl0) = pack8(acc[ai][bj][m][0] * gg[bj][0], acc[ai][bj][m][1] * gg[bj][1]); }
        } break;
        case EK_XS: {
            bf16_t* dst = (bf16_t*)p0; float* ps = (float*)p1; const float* s1 = (const float*)c0; const float* sqq = (const float*)c1; const float* sck = (const float*)c2;
            const int h = u.pn, b = u.pm >> 3;
            f32x4 kv[2][2];
#pragma unroll
            for (int bj = 0; bj < 2; ++bj)
#pragma unroll
                for (int n = 0; n < 2; ++n) kv[bj][n] = *(const f32x4*)(sck + (size_t)h * TM + b * 256 + bj * 128 + cl0 + 4 * n) * (LOG2E / 16.f);
#pragma unroll
            for (int ai = 0; ai < 2; ++ai)
#pragma unroll
                for (int m = 0; m < 4; ++m) { const size_t row = (size_t)(rbase + ai * 128 + m * 16);
                    const f32x4 t0 = *(const f32x4*)(s1 + row * 16), t1 = *(const f32x4*)(s1 + row * 16 + 4), t2 = *(const f32x4*)(s1 + row * 16 + 8), t3 = *(const f32x4*)(s1 + row * 16 + 12);
                    const float tot = ((t0[0] + t0[1]) + (t0[2] + t0[3])) + ((t1[0] + t1[1]) + (t1[2] + t1[3])) + ((t2[0] + t2[1]) + (t2[2] + t2[3])) + ((t3[0] + t3[1]) + (t3[2] + t3[3]));
                    const float rs1 = rsqrtf(tot * (1.f / DM) + EPS);
                    const f32x4 qq = *(const f32x4*)(sqq + row * 16 + h * 4);
                    const float sq = rs1 * rsqrtf(rs1 * rs1 * ((qq[0] + qq[1]) + (qq[2] + qq[3])) * (1.f / 256.f) + EPS);
                    float ss = 0.f;
#pragma unroll
                    for (int bj = 0; bj < 2; ++bj) { f32x4 a = acc[ai][bj][m][0] * kv[bj][0] * sq, c = acc[ai][bj][m][1] * kv[bj][1] * sq;
#pragma unroll
                        for (int j = 0; j < 4; ++j) { a[j] = __builtin_amdgcn_exp2f(a[j]); c[j] = __builtin_amdgcn_exp2f(c[j]); }
                        const u32x4 w = pack8(a, c);
                        ss += (bflo(w.x) + bfhi(w.x)) + (bflo(w.y) + bfhi(w.y)) + (bflo(w.z) + bfhi(w.z)) + (bflo(w.w) + bfhi(w.w));
                        *(u32x4*)(dst + row * DM + h * 256 + bj * 128 + cl0) = w; }
                    ss = red_fq(ss);
                    if (fq == 0) ps[row * 16 + h * 4 + wc] = ss; }
        } break;
        case EK_XO: {
            bf16_t* dst = (bf16_t*)p0; const float* ps = (const float*)c0; const int h = u.pn;
#pragma unroll
            for (int ai = 0; ai < 2; ++ai)
#pragma unroll
                for (int m = 0; m < 4; ++m) { const size_t row = (size_t)(rbase + ai * 128 + m * 16);
                    const f32x4 pp = *(const f32x4*)(ps + row * 16 + h * 4); const float inv = 1.f / ((pp[0] + pp[1]) + (pp[2] + pp[3]));
#pragma unroll
                    for (int bj = 0; bj < 2; ++bj) *(u32x4*)(dst + row * DM + h * 256 + bj * 128 + cl0) = pack8(acc[ai][bj][m][0] * inv, acc[ai][bj][m][1] * inv); }
        } break;
        case EK_UP: {
            bf16_t* G = (bf16_t*)p0; bf16_t* U = (bf16_t*)p1; const float* s2 = (const float*)c0;
#pragma unroll
            for (int ai = 0; ai < 2; ++ai)
#pragma unroll
                for (int m = 0; m < 4; ++m) { const size_t row = (size_t)(rbase + ai * 128 + m * 16);
                    const f32x4 t0 = *(const f32x4*)(s2 + row * 16), t1 = *(const f32x4*)(s2 + row * 16 + 4), t2 = *(const f32x4*)(s2 + row * 16 + 8), t3 = *(const f32x4*)(s2 + row * 16 + 12);
                    const float tot = ((t0[0] + t0[1]) + (t0[2] + t0[3])) + ((t1[0] + t1[1]) + (t1[2] + t1[3])) + ((t2[0] + t2[1]) + (t2[2] + t2[3])) + ((t3[0] + t3[1]) + (t3[2] + t3[3]));
                    const float rs = rsqrtf(tot * (1.f / DM) + EPS);
                    const size_t off = row * DFF + u.pn * 128 + cl0;
                    *(u32x4*)(G + off) = pack8(acc[ai][0][m][0] * rs, acc[ai][0][m][1] * rs);
                    *(u32x4*)(U + off) = pack8(acc[ai][1][m][0] * rs, acc[ai][1][m][1] * rs); }
        } break;
        case EK_DOWN: {
            float* out = (float*)p0;
#pragma unroll
            for (int ai = 0; ai < 2; ++ai)
#pragma unroll
                for (int m = 0; m < 4; ++m) { const size_t row = (size_t)(rbase + ai * 128 + m * 16);
#pragma unroll
                    for (int bj = 0; bj < 2; ++bj) { const size_t off = row * DM + u.pn * 256 + bj * 128 + cl0;
                        const f32x4 a = acc[ai][bj][m][0] + *(const f32x4*)(out + off), c = acc[ai][bj][m][1] + *(const f32x4*)(out + off + 4);
                        *(f32x4*)(out + off) = a; *(f32x4*)(out + off + 4) = c; } }
        } break;
        case EK_GATE: {
            bf16_t* G = (bf16_t*)p0; const float* s2 = (const float*)c0;
#pragma unroll
            for (int ai = 0; ai < 2; ++ai)
#pragma unroll
                for (int m = 0; m < 4; ++m) { const size_t row = (size_t)(rbase + ai * 128 + m * 16);
                    const f32x4 t0 = *(const f32x4*)(s2 + row * 16), t1 = *(const f32x4*)(s2 + row * 16 + 4), t2 = *(const f32x4*)(s2 + row * 16 + 8), t3 = *(const f32x4*)(s2 + row * 16 + 12);
                    const float tot = ((t0[0] + t0[1]) + (t0[2] + t0[3])) + ((t1[0] + t1[1]) + (t1[2] + t1[3])) + ((t2[0] + t2[1]) + (t2[2] + t2[3])) + ((t3[0] + t3[1]) + (t3[2] + t3[3]));
                    const float rs = rsqrtf(tot * (1.f / DM) + EPS);
#pragma unroll
                    for (int bj = 0; bj < 2; ++bj) *(u32x4*)(G + row * DFF + u.pn * 256 + bj * 128 + cl0) = pack8(acc[ai][bj][m][0] * rs, acc[ai][bj][m][1] * rs); }
        } break;
        case EK_UPACT: {
            bf16_t* A = (bf16_t*)p0; const float* rs2 = (const float*)c0; const bf16_t* G = (const bf16_t*)c1; const float* cw = (const float*)c2; const float* cbv = (const float*)p1;
            u32x4 upk[2][4][2];
#pragma unroll
            for (int ai = 0; ai < 2; ++ai)
#pragma unroll
                for (int m = 0; m < 4; ++m) { const float rs = rs2[rbase + ai * 128 + m * 16];
#pragma unroll
                    for (int bj = 0; bj < 2; ++bj) upk[ai][m][bj] = pack8(acc[ai][bj][m][0] * rs, acc[ai][bj][m][1] * rs); }
            asm volatile("" ::: "memory");
#pragma unroll
            for (int bj = 0; bj < 2; ++bj) { const int j0 = u.pn * 256 + bj * 128 + cl0;
                float w0[8], w1[8], w2[8], bb[8];
#pragma unroll
                for (int i = 0; i < 2; ++i) { const f32x4 a0 = *(const f32x4*)(cw + j0 + 4 * i), a1 = *(const f32x4*)(cw + DFF + j0 + 4 * i), a2 = *(const f32x4*)(cw + 2 * DFF + j0 + 4 * i), a3 = *(const f32x4*)(cbv + j0 + 4 * i);
#pragma unroll
                    for (int q = 0; q < 4; ++q) { w0[4 * i + q] = a0[q]; w1[4 * i + q] = a1[q]; w2[4 * i + q] = a2[q]; bb[4 * i + q] = a3[q]; } }
#pragma unroll
                for (int ai = 0; ai < 2; ++ai)
#pragma unroll
                    for (int m = 0; m < 4; ++m) { const int row = rbase + ai * 128 + m * 16; const int ts = row & 2047; const size_t off = (size_t)row * DFF + j0;
                        const u32x4 g0 = *(const u32x4*)(G + off);
                        u32x4 g1 = *(const u32x4*)(G + off - (ts >= 1 ? DFF : 0));
                        u32x4 g2 = *(const u32x4*)(G + off - (ts >= 2 ? 2 * DFF : 0));
                        const unsigned k1 = ts >= 1 ? 0xffffffffu : 0u, k2 = ts >= 2 ? 0xffffffffu : 0u;
                        g1 = g1 & k1; g2 = g2 & k2;
                        const u32x4 uu = upk[ai][m][bj];
                        float r[8];
#pragma unroll
                        for (int q = 0; q < 4; ++q) { const unsigned a2 = g2[q], a1 = g1[q], a0 = g0[q], u0 = uu[q];
                            const float z0 = bb[2 * q] + w0[2 * q] * bflo(a2) + w1[2 * q] * bflo(a1) + w2[2 * q] * bflo(a0);
                            const float z1 = bb[2 * q + 1] + w0[2 * q + 1] * bfhi(a2) + w1[2 * q + 1] * bfhi(a1) + w2[2 * q + 1] * bfhi(a0);
                            r[2 * q] = z0 * sigm(z0) * bflo(u0); r[2 * q + 1] = z1 * sigm(z1) * bfhi(u0); }
                        u32x4 o; o.x = pk2(r[0], r[1]); o.y = pk2(r[2], r[3]); o.z = pk2(r[4], r[5]); o.w = pk2(r[6], r[7]);
                        *(u32x4*)(A + off) = o;
                        if ((m & 1) == 1) asm volatile("" ::: "memory"); } }
        } break;
        case EK_UPC: {
            bf16_t* A = (bf16_t*)p0; float* GHF = (float*)p1; float* GHL = (float*)p2; float* UH = (float*)p3; const float* s2 = (const float*)c0; const float* cw = (const float*)c1; const float* cbv = (const float*)c2;
            const int j0 = u.pn * 128 + cl0;
            float w0[8], w1[8], w2[8], bb[8];
#pragma unroll
            for (int i = 0; i < 2; ++i) { const f32x4 a0 = *(const f32x4*)(cw + j0 + 4 * i), a1 = *(const f32x4*)(cw + DFF + j0 + 4 * i), a2 = *(const f32x4*)(cw + 2 * DFF + j0 + 4 * i), a3 = *(const f32x4*)(cbv + j0 + 4 * i);
#pragma unroll
                for (int q = 0; q < 4; ++q) { w0[4 * i + q] = a0[q]; w1[4 * i + q] = a1[q]; w2[4 * i + q] = a2[q]; bb[4 * i + q] = a3[q]; } }
            float rsv[2][4];
#pragma unroll
            for (int ai = 0; ai < 2; ++ai)
#pragma unroll
                for (int m = 0; m < 4; ++m) rsv[ai][m] = s2[rbase + ai * 128 + m * 16];
            if (fr >= 14) {
#pragma unroll
                for (int ai = 0; ai < 2; ++ai) { const f32x4 g0 = acc[ai][0][3][0] * rsv[ai][3], g1 = acc[ai][0][3][1] * rsv[ai][3];
                    LAS float* hp = hx + ((ai * 2 + wr) * 2 + (fr - 14)) * 128 + cl0; *(LAS f32x4*)hp = g0; *(LAS f32x4*)(hp + 4) = g1;
                    if (ai == 1 && wr == 1) { float* gp = GHL + ((size_t)u.pm * 2 + (fr - 14)) * DFF + j0; *(f32x4*)gp = g0; *(f32x4*)(gp + 4) = g1; } } }
            if (wr == 0 && fr < 2) {
                const float rs = rsv[0][0]; float* gp = GHF + ((size_t)u.pm * 2 + fr) * DFF + j0; float* up = UH + ((size_t)u.pm * 2 + fr) * DFF + j0;
                *(f32x4*)gp = acc[0][0][0][0] * rs; *(f32x4*)(gp + 4) = acc[0][0][0][1] * rs; *(f32x4*)up = acc[0][1][0][0] * rs; *(f32x4*)(up + 4) = acc[0][1][0][1] * rs; }
            asm volatile("s_waitcnt lgkmcnt(0)" ::: "memory"); __builtin_amdgcn_s_barrier(); asm volatile("" ::: "memory");
#define ROR1(x) __builtin_bit_cast(float, __builtin_amdgcn_update_dpp(0, __builtin_bit_cast(int, (x)), 0x121, 0xF, 0xF, false))
#define ROR2(x) __builtin_bit_cast(float, __builtin_amdgcn_update_dpp(0, __builtin_bit_cast(int, (x)), 0x122, 0xF, 0xF, false))
#pragma unroll
            for (int ai = 0; ai < 2; ++ai) {
                const int grp = ai * 2 + wr;
                float p1v[8], p2v[8];
                { f32x4 h1a = (f32x4){0.f, 0.f, 0.f, 0.f}, h1b = h1a, h2a = h1a, h2b = h1a;
                  if (grp > 0) { const LAS float* hp = hx + ((grp - 1) * 2) * 128 + cl0; h2a = *(const LAS f32x4*)hp; h2b = *(const LAS f32x4*)(hp + 4); h1a = *(const LAS f32x4*)(hp + 128); h1b = *(const LAS f32x4*)(hp + 132); }
#pragma unroll
                  for (int i = 0; i < 4; ++i) { p1v[i] = h1a[i]; p1v[4 + i] = h1b[i]; p2v[i] = (fr == 0) ? h2a[i] : h1a[i]; p2v[4 + i] = (fr == 0) ? h2b[i] : h1b[i]; } }
#pragma unroll
                for (int m = 0; m < 4; ++m) { const float rs = rsv[ai][m]; const size_t row = (size_t)(rbase + ai * 128 + m * 16);
                    float gs[8], r[8];
#pragma unroll
                    for (int i = 0; i < 4; ++i) { gs[i] = acc[ai][0][m][0][i] * rs; gs[4 + i] = acc[ai][0][m][1][i] * rs; }
#pragma unroll
                    for (int i = 0; i < 8; ++i) { const float c1v = ROR1(gs[i]), c2v = ROR2(gs[i]);
                        const float g1 = (fr == 0) ? p1v[i] : c1v, g2 = (fr < 2) ? p2v[i] : c2v;
                        p1v[i] = c1v; p2v[i] = c2v;
                        const float z = bb[i] + w0[i] * g2 + w1[i] * g1 + w2[i] * gs[i];
                        const float uv = (i < 4 ? acc[ai][1][m][0][i & 3] : acc[ai][1][m][1][i & 3]) * rs;
                        r[i] = z * sigm(z) * uv; }
                    u32x4 o; o.x = pk2(r[0], r[1]); o.y = pk2(r[2], r[3]); o.z = pk2(r[4], r[5]); o.w = pk2(r[6], r[7]);
                    if (!(grp == 0 && m == 0 && fr < 2)) *(u32x4*)(A + row * DFF + j0) = o; } }
#undef ROR1
#undef ROR2
        } break;
        default: break;
        }
    }
};

namespace attn_body {
using bf16=__hip_bfloat16;
using s16x4=__attribute__((ext_vector_type(4)))short;
using f32x16=__attribute__((ext_vector_type(16)))float;
constexpr int NHEAD=NFH,D=64,ADM=NHEAD*D;
constexpr int NW=8,QBLK=32,QB=QBLK*NW,KVBLK=64,NQB=SEQ/QB;
__device__ __forceinline__ int crow(int r,int hi){return (r&3)+8*(r>>2)+4*hi;}
#define SBAR() __builtin_amdgcn_sched_barrier(0)
__device__ __forceinline__ void cmask(f32x16&p0,f32x16&p1,int jb,int qrel,int hi){
  const float NEG=-INFINITY; int kb=64*jb+4*hi;
  #pragma unroll
  for(int r=0;r<16;++r){int kv=kb+(r&3)+8*(r>>2); if(kv>qrel)p0[r]=NEG; if(kv+32>qrel)p1[r]=NEG;}
}
constexpr int NSLOT=3, SLOTB=8192;
constexpr int LDS_K=0, LDS_V=NSLOT*SLOTB, LDS_WS=2*NSLOT*SLOTB, LDS_OST=LDS_WS+NW*64*4, LDS_BYTES=LDS_OST+NW*4096;
constexpr int LDS_BIAS=86016;
__device__ __forceinline__ void glds16(const void*gsrc,unsigned lds_dst){unsigned keep;
  asm volatile("s_mov_b32 %0, m0\n\ts_mov_b32 m0, %2\n\ts_nop 0\n\tglobal_load_lds_dwordx4 %1, off\n\ts_mov_b32 m0, %0":"=&s"(keep):"v"(gsrc),"s"(lds_dst):"memory");}
__device__ __forceinline__ float max3f(float a,float b,float c){float r;asm("v_max3_f32 %0, %1, %2, %3":"=v"(r):"v"(a),"v"(b),"v"(c));return r;}
__device__ __forceinline__ float max2f(float a,float b){float r;asm("v_max_f32_e32 %0, %1, %2":"=v"(r):"v"(a),"v"(b));return r;}
__device__ __forceinline__ float fadd_s(float a,float b){float r;asm("v_add_f32_e32 %0, %1, %2":"=v"(r):"v"(a),"v"(b));return r;}
__device__ __forceinline__ float fsub_s(float a,float b){float r;asm("v_sub_f32_e32 %0, %1, %2":"=v"(r):"v"(a),"v"(b));return r;}
typedef float f32x2_t __attribute__((ext_vector_type(2))); typedef __bf16 bf16x2_t __attribute__((ext_vector_type(2)));
__device__ __forceinline__ unsigned cvtpk_s(float lo,float hi){f32x2_t v={lo,hi};bf16x2_t b=__builtin_convertvector(v,bf16x2_t);return __builtin_bit_cast(unsigned,b);}
#define WAIT_BAR(N) asm volatile("s_waitcnt vmcnt(" #N ") lgkmcnt(0)\n\ts_barrier":::"memory")

__device__ __forceinline__ void qkt(f32x16&p0,f32x16&p1,const char*Kslot,const bf16x8*qr,const f32x16&negm,int r32,int hi){
  const char*kb=Kslot+hi*1024+r32*16;
  #pragma unroll
  for(int d0=0;d0<4;++d0){
    const bf16x8 b0=*reinterpret_cast<const bf16x8*>(kb+d0*2048);
    const bf16x8 b1=*reinterpret_cast<const bf16x8*>(kb+d0*2048+512);
    if(d0==0){p0=__builtin_amdgcn_mfma_f32_32x32x16_bf16(b0,qr[0],negm,0,0,0);p1=__builtin_amdgcn_mfma_f32_32x32x16_bf16(b1,qr[0],negm,0,0,0);}
    else{p0=__builtin_amdgcn_mfma_f32_32x32x16_bf16(b0,qr[d0],p0,0,0,0);p1=__builtin_amdgcn_mfma_f32_32x32x16_bf16(b1,qr[d0],p1,0,0,0);}}
}
typedef __attribute__((address_space(3))) const char* lds_cptr;
typedef short v4i16_t __attribute__((ext_vector_type(4)));
__device__ __forceinline__ void kload8(bf16x8*kf,lds_cptr kp){
  kf[0]=*(const __attribute__((address_space(3))) bf16x8*)(kp);      kf[1]=*(const __attribute__((address_space(3))) bf16x8*)(kp+512);
  kf[2]=*(const __attribute__((address_space(3))) bf16x8*)(kp+2048); kf[3]=*(const __attribute__((address_space(3))) bf16x8*)(kp+2560);
  kf[4]=*(const __attribute__((address_space(3))) bf16x8*)(kp+4096); kf[5]=*(const __attribute__((address_space(3))) bf16x8*)(kp+4608);
  kf[6]=*(const __attribute__((address_space(3))) bf16x8*)(kp+6144); kf[7]=*(const __attribute__((address_space(3))) bf16x8*)(kp+6656);
}
__device__ __forceinline__ void kload2(bf16x8*kf,lds_cptr kp,int j){ kf[2*j]=*(const __attribute__((address_space(3))) bf16x8*)(kp+j*2048); kf[2*j+1]=*(const __attribute__((address_space(3))) bf16x8*)(kp+j*2048+512); }
__device__ __forceinline__ s16x4 vtr(lds_cptr p){ return __builtin_bit_cast(s16x4,__builtin_amdgcn_ds_read_tr16_b64_v4i16((__attribute__((address_space(3))) v4i16_t*)p)); }
__device__ __forceinline__ float rowmax(const f32x16&p0,const f32x16&p1){
  float a=max3f(p0[0],p0[1],p1[0]),b=max3f(p0[2],p0[3],p1[1]);a=max3f(a,p1[2],p1[3]);
  #pragma unroll
  for(int r=4;r<16;r+=4){a=max3f(a,p0[r],p0[r+1]);b=max3f(b,p0[r+2],p0[r+3]);a=max3f(a,p1[r],p1[r+1]);b=max3f(b,p1[r+2],p1[r+3]);}
  const float m=max2f(a,b);
  auto rr=__builtin_amdgcn_permlane32_swap(__float_as_uint(m),__float_as_uint(m),false,false);
  return max2f(__uint_as_float(rr[0]),__uint_as_float(rr[1]));
}
__device__ __forceinline__ void pv(f32x16*o,int vb,bf16x8 pa0,bf16x8 pa1,bf16x8 pa2,bf16x8 pa3){
  #pragma unroll
  for(int d0=0;d0<2;++d0){s16x4 lo[4],hi[4];
    #pragma unroll
    for(int ks=0;ks<4;++ks){
      asm volatile("ds_read_b64_tr_b16 %0,%1 offset:%c2":"=&v"(lo[ks]):"v"(vb),"i"(d0*4096+ks*1024):"memory");
      asm volatile("ds_read_b64_tr_b16 %0,%1 offset:%c2":"=&v"(hi[ks]):"v"(vb),"i"(d0*4096+ks*1024+512):"memory");}
    asm volatile("s_waitcnt lgkmcnt(0)":::"memory");SBAR();
    #define PK(k) (bf16x8){lo[k][0],lo[k][1],lo[k][2],lo[k][3],hi[k][0],hi[k][1],hi[k][2],hi[k][3]}
    o[d0]=__builtin_amdgcn_mfma_f32_32x32x16_bf16(pa0,PK(0),o[d0],0,0,0);
    o[d0]=__builtin_amdgcn_mfma_f32_32x32x16_bf16(pa1,PK(1),o[d0],0,0,0);
    o[d0]=__builtin_amdgcn_mfma_f32_32x32x16_bf16(pa2,PK(2),o[d0],0,0,0);
    o[d0]=__builtin_amdgcn_mfma_f32_32x32x16_bf16(pa3,PK(3),o[d0],0,0,0);
    #undef PK
  }
}
typedef const __attribute__((address_space(3))) f32x4* lds_f4ptr;
#define BIASADD(P0,P1,t) do{ const lds_f4ptr bp_=(lds_f4ptr)(shm3+bias_off+((t)*64+4*hi)*4); \
    _Pragma("unroll") for(int j_=0;j_<4;++j_){ const f32x4 b0_=bp_[2*j_]-mhat, b1_=bp_[8+2*j_]-mhat; \
      P0[4*j_]+=b0_[0]; P0[4*j_+1]+=b0_[1]; P0[4*j_+2]+=b0_[2]; P0[4*j_+3]+=b0_[3]; \
      P1[4*j_]+=b1_[0]; P1[4*j_+1]+=b1_[1]; P1[4*j_+2]+=b1_[2]; P1[4*j_+3]+=b1_[3]; } }while(0)

template<int THRL> __device__ __forceinline__ void attn_unit(int b,int h,int qb,const bf16*Q,const bf16*__restrict__ K,const bf16*__restrict__ V,bf16*O,const float*__restrict__ CB,float*__restrict__ SSQ,char*shm,const float skip_th){
  int tid=threadIdx.x; asm volatile("":"+v"(tid));
  const int lane=tid&63,r32=lane&31,hi=lane>>5; const int wid=__builtin_amdgcn_readfirstlane(tid>>6);
  const long rowbase=(long)b*SEQ; const int q0=qb*QB;
  const bf16*Qw=Q+(rowbase+q0+wid*QBLK)*ADM+h*D;
  int t0=0; { const float*cbh0=CB+(long)(b*NHEAD+h)*SEQ; const int npair=(q0+QB)/KVBLK/2-2; const float c0v=cbh0[q0];
    const bool far=(lane<npair)&&(cbh0[128*(lane<npair?lane:0)+127]-c0v>skip_th); const unsigned long long mk=__ballot(far);
    int lead=__builtin_ctzll(~mk); if(lead>npair)lead=npair; if(lead<0)lead=0; t0=2*__builtin_amdgcn_readfirstlane(lead); }
  const bf16*Kh=K+(rowbase+(long)t0*KVBLK)*ADM+h*D,*Vh=V+(rowbase+(long)t0*KVBLK)*ADM+h*D;
  const unsigned lds0=(unsigned)(uintptr_t)shm;
  float*wsf=(float*)(shm+LDS_WS)+wid*64;
  const lds_cptr shm3=(lds_cptr)shm;
  { const float*cbh=CB+(long)(b*NHEAD+h)*SEQ; const float cref=cbh[q0+128];
    if(tid*4<q0+QB){ const f32x4 c4=*(const f32x4*)(cbh+tid*4); *(__attribute__((address_space(3))) f32x4*)(shm3+LDS_BIAS+tid*16)=(f32x4){cref-c4[0],cref-c4[1],cref-c4[2],cref-c4[3]}; } }
  const bf16*ksrc=Kh+(long)lane*ADM+wid*8;
  const bf16*vsrc=Vh+(long)(16*(wid&3)+(lane>>2))*ADM+(wid>>2)*32+(lane&3)*8;
  const unsigned kdst=lds0+LDS_K+wid*1024, vdst=lds0+LDS_V+wid*1024;
  #define DMA_K(t,slot) glds16(ksrc+(long)(t)*KVBLK*ADM,(unsigned)__builtin_amdgcn_readfirstlane(kdst+(slot)))
  #define DMA_V(t,slot) glds16(vsrc+(long)(t)*KVBLK*ADM,(unsigned)__builtin_amdgcn_readfirstlane(vdst+(slot)))
  const int vb0=(int)(lds0+LDS_V)+((lane>>4)&1)*32+(lane&3)*8+(4*hi+((lane&15)>>2))*64;
  const char*Kbase=shm+LDS_K; bf16x8 kf[8];
  const lds_cptr kp0=shm3+LDS_K+hi*1024+r32*16; const lds_cptr vp0=shm3+LDS_V+((lane>>4)&1)*32+(lane&3)*8+(4*hi+((lane&15)>>2))*64;
  const int NT=(q0+QB)/KVBLK-t0; const int bias_off=LDS_BIAS+t0*KVBLK*4;
  DMA_K(0,0);DMA_V(0,0);DMA_K(1,SLOTB);
  bf16x8 qr[4];
  #pragma unroll
  for(int d0=0;d0<4;++d0)qr[d0]=*reinterpret_cast<const bf16x8*>(&Qw[(long)r32*ADM+d0*16+hi*8]);
  float mhat=0.f,l_reg=0.f;f32x16 o[2];o[0]=f32x16{};o[1]=f32x16{};const f32x16 negm=f32x16{};
  const int qrel=wid*QBLK+r32;
  #define CMASK(P0,P1,t) do{int jb_=(t)-(NT-4); if(jb_>=0)cmask(P0,P1,jb_,qrel,hi);}while(0)
  bool resc=false;
  #define START(P0,P1) do{ const float rm=rowmax(P0,P1); resc=false; \
    { const float dl=max2f(rm,-24.f); mhat=fadd_s(mhat,dl); \
      _Pragma("unroll") for(int r=0;r<16;++r){P0[r]=fsub_s(P0[r],dl);P1[r]=fsub_s(P1[r],dl);} } \
    _Pragma("unroll") for(int r=0;r<16;++r)P0[r]=__builtin_amdgcn_exp2f(P0[r]); }while(0)
  #define RESC() do{ if(resc){ asm volatile("s_waitcnt lgkmcnt(0)":::"memory"); \
      _Pragma("unroll") for(int d_=0;d_<2;++d_) _Pragma("unroll") for(int r=0;r<16;++r)o[d_][r]*=wsf[crow(r,hi)]; } }while(0)
  f32x16 pA0,pA1,pB0,pB1;
  int sl_prev=0,sl_cur=0,sl_next=SLOTB;
  #define ROT() do{sl_prev=sl_cur;sl_cur=sl_next;sl_next=(sl_next==(NSLOT-1)*SLOTB)?0:sl_next+SLOTB;}while(0)
  DMA_K(2,2*SLOTB);
  WAIT_BAR(3);
  qkt(pA0,pA1,Kbase,qr,negm,r32,hi);asm volatile("s_nop 15\n\ts_nop 7":"+v"(pA0),"+v"(pA1));BIASADD(pA0,pA1,0);CMASK(pA0,pA1,0);
  START(pA0,pA1);
  _Pragma("unroll") for(int r=0;r<16;++r)pA1[r]=__builtin_amdgcn_exp2f(pA1[r]);
  WAIT_BAR(0);
  DMA_K(3,0);DMA_V(1,SLOTB);
  ROT();
  kload8(kf,kp0+sl_cur);
  WAIT_BAR(2);
  s16x4 vlo[8],vhi[8]; u32x4 pw0,pw1,pw2,pw3;
  #define PKW(P,B) cvtpk_s(P[B],P[B+1])
  #define PAF(k) __builtin_bit_cast(bf16x8,pw##k)
  #define VFR(i) (bf16x8){vlo[i][0],vlo[i][1],vlo[i][2],vlo[i][3],vhi[i][0],vhi[i][1],vhi[i][2],vhi[i][3]}
  #define PIN(x) asm volatile("":"+v"(x))
  #define MX3(a,b,c) __builtin_fmaxf(__builtin_fmaxf((a),(b)),(c))
  #define GAPA(MF,A0,A1,A2,A3,W0,W1,PW) do{ MF; sacc+=A0; sacc+=A1; sacc+=A2; sacc+=A3; PIN(sacc); W0; W1; PIN(PW); SBAR(); }while(0)
  #define EX(v) __builtin_amdgcn_exp2f(v)
  #define GAPB(MF,X,B) do{ MF; X[B]=EX(X[B]); X[B+1]=EX(X[B+1]); X[B+2]=EX(X[B+2]); X[B+3]=EX(X[B+3]); PIN(X); SBAR(); }while(0)
  #define VRD(i) do{ vlo[i]=vtr(vp_+(((i)>>2)*4096+((i)&3)*1024)); vhi[i]=vtr(vp_+(((i)>>2)*4096+((i)&3)*1024+512)); }while(0)
  #define KRD(G,j) do{ if(G){ kload2(kf,kp0+sl_next,j); SBAR(); } }while(0)
  #define STEP(C0,C1,P0,P1,t,GK,GV,GL) do{ SBAR(); \
    const lds_cptr vp_=vp0+sl_prev; \
    VRD(0); SBAR(); float sacc=(P0[0]+P0[1]); \
    GAPA(C0=__builtin_amdgcn_mfma_f32_32x32x16_bf16(kf[0],qr[0],negm,0,0,0), P0[2],P0[3],P0[4],P0[5],     pw0[0]=PKW(P0,0), pw0[1]=PKW(P0,2), pw0); \
    VRD(4); SBAR(); GAPA(C1=__builtin_amdgcn_mfma_f32_32x32x16_bf16(kf[1],qr[0],negm,0,0,0), P0[6],P0[7],P0[8],P0[9],     pw0[2]=PKW(P0,4), pw0[3]=PKW(P0,6), pw0); \
    VRD(1); SBAR(); GAPA(C0=__builtin_amdgcn_mfma_f32_32x32x16_bf16(kf[2],qr[1],C0,0,0,0),   P0[10],P0[11],P0[12],P0[13], pw1[0]=PKW(P0,8), pw1[1]=PKW(P0,10), pw1); \
    VRD(5); SBAR(); GAPA(C1=__builtin_amdgcn_mfma_f32_32x32x16_bf16(kf[3],qr[1],C1,0,0,0),   P0[14],P0[15],P1[0],P1[1],   pw1[2]=PKW(P0,12),pw1[3]=PKW(P0,14), pw1); \
    VRD(2); SBAR(); GAPA(C0=__builtin_amdgcn_mfma_f32_32x32x16_bf16(kf[4],qr[2],C0,0,0,0),   P1[2],P1[3],P1[4],P1[5],     pw2[0]=PKW(P1,0), pw2[1]=PKW(P1,2), pw2); \
    VRD(6); SBAR(); GAPA(C1=__builtin_amdgcn_mfma_f32_32x32x16_bf16(kf[5],qr[2],C1,0,0,0),   P1[6],P1[7],P1[8],P1[9],     pw2[2]=PKW(P1,4), pw2[3]=PKW(P1,6), pw2); \
    VRD(3); SBAR(); GAPA(C0=__builtin_amdgcn_mfma_f32_32x32x16_bf16(kf[6],qr[3],C0,0,0,0),   P1[10],P1[11],P1[12],P1[13], pw3[0]=PKW(P1,8), pw3[1]=PKW(P1,10), pw3); \
    VRD(7); SBAR(); GAPA(C1=__builtin_amdgcn_mfma_f32_32x32x16_bf16(kf[7],qr[3],C1,0,0,0),   P1[14],P1[15],0.f,0.f,       pw3[2]=PKW(P1,12),pw3[3]=PKW(P1,14), pw3); \
    l_reg+=sacc; \
    if(GK){DMA_K((t)+3,sl_cur);} if(GV){DMA_V((t)+1,sl_next);} \
    BIASADD(C0,C1,t); \
    CMASK(C0,C1,t); \
    { float a=MX3(C0[0],C0[1],C1[0]),b=MX3(C0[2],C0[3],C1[1]); a=MX3(a,C1[2],C1[3]); \
      _Pragma("unroll") for(int r=4;r<16;r+=4){a=MX3(a,C0[r],C0[r+1]);b=MX3(b,C0[r+2],C0[r+3]);a=MX3(a,C1[r],C1[r+1]);b=MX3(b,C1[r+2],C1[r+3]);} \
      float rm=__builtin_fmaxf(a,b); { auto rr=__builtin_amdgcn_permlane32_swap(__float_as_uint(rm),__float_as_uint(rm),false,false); rm=__builtin_fmaxf(__uint_as_float(rr[0]),__uint_as_float(rr[1])); } \
      resc=false; \
      if(__builtin_expect(__any(rm>(float)THRL),0)){ const float dl=__builtin_fmaxf(rm,0.f); mhat+=dl; \
        _Pragma("unroll") for(int r=0;r<16;++r){C0[r]-=dl;C1[r]-=dl;} \
        const float f=__builtin_amdgcn_exp2f(-dl); l_reg*=f; if(hi==0)wsf[r32]=f; resc=true; } } \
    SBAR(); \
    GAPB(o[0]=__builtin_amdgcn_mfma_f32_32x32x16_bf16(PAF(0),VFR(0),o[0],0,0,0), C0,0); \
    GAPB(o[1]=__builtin_amdgcn_mfma_f32_32x32x16_bf16(PAF(0),VFR(4),o[1],0,0,0), C0,4); \
    KRD(GL,0); GAPB(o[0]=__builtin_amdgcn_mfma_f32_32x32x16_bf16(PAF(1),VFR(1),o[0],0,0,0), C0,8); \
    KRD(GL,1); GAPB(o[1]=__builtin_amdgcn_mfma_f32_32x32x16_bf16(PAF(1),VFR(5),o[1],0,0,0), C0,12); \
    KRD(GL,2); GAPB(o[0]=__builtin_amdgcn_mfma_f32_32x32x16_bf16(PAF(2),VFR(2),o[0],0,0,0), C1,0); \
    KRD(GL,3); GAPB(o[1]=__builtin_amdgcn_mfma_f32_32x32x16_bf16(PAF(2),VFR(6),o[1],0,0,0), C1,4); \
    GAPB(o[0]=__builtin_amdgcn_mfma_f32_32x32x16_bf16(PAF(3),VFR(3),o[0],0,0,0), C1,8); \
    GAPB(o[1]=__builtin_amdgcn_mfma_f32_32x32x16_bf16(PAF(3),VFR(7),o[1],0,0,0), C1,12); \
    }while(0)
  int t=1;
  #undef CMASK
  #define CMASK(P0,P1,t) do{}while(0)
  for(;t+5<NT;t+=2){
    STEP(pB0,pB1,pA0,pA1,t,true,true,true);     WAIT_BAR(2); RESC(); ROT();
    STEP(pA0,pA1,pB0,pB1,t+1,true,true,true);   WAIT_BAR(2); RESC(); ROT();
  }
  #undef CMASK
  #define CMASK(P0,P1,t) do{int jb_=(t)-(NT-4); if(jb_>=0)cmask(P0,P1,jb_,qrel,hi);}while(0)
  #define ENDW(tt) do{ if((tt)+3<NT){WAIT_BAR(2);} else if((tt)+2<NT){WAIT_BAR(1);} else {WAIT_BAR(0);} }while(0)
  for(;t+1<NT;t+=2){
    STEP(pB0,pB1,pA0,pA1,t,(t+3<NT),(t+1<NT),(t+1<NT));       ENDW(t);   RESC(); ROT();
    STEP(pA0,pA1,pB0,pB1,t+1,(t+4<NT),(t+2<NT),(t+2<NT));     ENDW(t+1); RESC(); ROT();
  }
  STEP(pB0,pB1,pA0,pA1,NT-1,false,false,false); RESC();
  { float sacc=pB0[0]+pB0[1]; _Pragma("unroll") for(int r=2;r<16;++r)sacc+=pB0[r]; _Pragma("unroll") for(int r=0;r<16;++r)sacc+=pB1[r]; l_reg+=sacc;
    pw0=(u32x4){PKW(pB0,0),PKW(pB0,2),PKW(pB0,4),PKW(pB0,6)};pw1=(u32x4){PKW(pB0,8),PKW(pB0,10),PKW(pB0,12),PKW(pB0,14)};pw2=(u32x4){PKW(pB1,0),PKW(pB1,2),PKW(pB1,4),PKW(pB1,6)};pw3=(u32x4){PKW(pB1,8),PKW(pB1,10),PKW(pB1,12),PKW(pB1,14)};
    SBAR(); pv(o,vb0+sl_cur,PAF(0),PAF(1),PAF(2),PAF(3)); }
  #undef PKW
  #undef PAF
  #undef VFR
  #undef PIN
  #undef MX3
  #undef GAPA
  #undef GAPB
  #undef EX
  #undef VRD
  #undef KRD
  #undef STEP
  #undef ENDW
  {auto rr=__builtin_amdgcn_permlane32_swap(__float_as_uint(l_reg),__float_as_uint(l_reg),false,false);l_reg=__uint_as_float(rr[0])+__uint_as_float(rr[1]);}
  if(hi==0)wsf[32+r32]=l_reg;asm volatile("s_waitcnt lgkmcnt(0)":::"memory");
  float rli[16];
  #pragma unroll
  for(int r=0;r<16;++r)rli[r]=__builtin_amdgcn_rcpf(wsf[32+crow(r,hi)]);
  int lane2=lane; asm volatile("":"+v"(lane2));
  bf16*Ow=O+(rowbase+q0+wid*QBLK)*ADM+h*D;
  { bf16*stg=(bf16*)(shm+LDS_OST)+wid*2048;
    #pragma unroll
    for(int r=0;r<16;++r){const int orow=crow(r,hi);
      #pragma unroll
      for(int d0=0;d0<2;++d0)stg[orow*64+d0*32+r32]=__float2bfloat16(o[d0][r]*rli[r]);}
    asm volatile("s_waitcnt lgkmcnt(0)":::"memory");
    #pragma unroll
    for(int i=0;i<4;++i){const int row=i*8+(lane2>>3),ch=lane2&7; const u32x4 v=*(const u32x4*)(stg+row*64+ch*8); *(u32x4*)(Ow+(long)row*ADM+ch*8)=v;
      float s=(bflo(v.x)*bflo(v.x)+bfhi(v.x)*bfhi(v.x))+(bflo(v.y)*bflo(v.y)+bfhi(v.y)*bfhi(v.y))+(bflo(v.z)*bflo(v.z)+bfhi(v.z)*bfhi(v.z))+(bflo(v.w)*bflo(v.w)+bfhi(v.w)*bfhi(v.w));
      s+=__shfl_xor(s,1); s+=__shfl_xor(s,2); s+=__shfl_xor(s,4);
      if(ch==0)SSQ[(rowbase+q0+wid*QBLK+row)*NHEAD+h]=s; } }
  asm volatile("s_waitcnt lgkmcnt(0)\n\ts_barrier":::"memory");
  #undef DMA_K
  #undef DMA_V
  #undef CMASK
  #undef START
  #undef RESC
  #undef ROT
}
#undef SBAR
#undef WAIT_BAR
}

constexpr int RING_BYTES = 131072;
constexpr int LDS_TOTAL = 147456;
struct Args { const float* in[32]; float* out; unsigned char* ws; };
typedef const float* const __attribute__((address_space(4)))* InTab;
enum In { I_X = 0, I_MEM, I_NORM_MIX, I_W_IN, I_FQN, I_FKN, I_FBIAS, I_ARE, I_AIM, I_LOGDT, I_BRE, I_BIM, I_CRE, I_CIM, I_D, I_WGLU, I_BGLU, I_ONF, I_ONS, I_WOUT,
          I_NCROSS, I_NMEM, I_WXQ, I_WXKV, I_XQN, I_XKN, I_WXO, I_NFFN, I_WUP, I_CONVW, I_CONVB, I_WDN };

struct TJob { const float* W; int ldw, col0, ncols, K; const float* kg; const float* kg2; bf16_t* WT; int mapid, rowoff, items; };
__device__ __forceinline__ int tmap(int mapid, int n, int rowoff) {
    if (mapid == 1) { const int part = n >> 9, f = n & 511, head = f >> 6, d = f & 63; return 512 * part + 256 * (head >> 2) + 128 * (d >> 5) + 32 * (head & 3) + (d & 31); }
    if (mapid == 2) { const int isup = n >= DFF ? 1 : 0; const int j = n - isup * DFF; return 256 * (j >> 7) + 128 * isup + (j & 127); }
    return rowoff + n;
}
__device__ __forceinline__ void transpose_item(const TJob& J, LAS float* scr, int item, int lane) {
    LAS unsigned* s32 = (LAS unsigned*)scr; const LAS unsigned short* s16 = (const LAS unsigned short*)scr;
    const int nblk = J.ncols / 128, kb = item / nblk, nb = item % nblk, k0 = 64 * kb, n0 = 128 * nb;
    const float* src = J.W + (size_t)k0 * J.ldw + J.col0 + n0 + 2 * lane;
    float gv = 1.f; if (J.kg) { const int k = k0 + lane; gv = (J.kg2 && k >= 512) ? J.kg2[k - 512] : J.kg[k]; }
#pragma unroll 16
    for (int kk = 0; kk < 64; ++kk) { f32x2 w = *(const f32x2*)(src + (size_t)kk * J.ldw);
        w = w * __builtin_bit_cast(float, __builtin_amdgcn_readlane(__builtin_bit_cast(int, gv), kk));
        s32[kk * 64 + lane] = pk2(w[0], w[1]); }
    asm volatile("s_waitcnt lgkmcnt(0)" ::: "memory");
    const int c = lane & 7;
#pragma unroll 4
    for (int j = 0; j < 16; ++j) { const int n = (lane >> 3) + 8 * j; const LAS unsigned short* s = s16 + (8 * c) * 128 + n;
        u32x4 o; o.x = (unsigned)s[0] | ((unsigned)s[128] << 16); o.y = (unsigned)s[256] | ((unsigned)s[384] << 16); o.z = (unsigned)s[512] | ((unsigned)s[640] << 16); o.w = (unsigned)s[768] | ((unsigned)s[896] << 16);
        *(u32x4*)(J.WT + (size_t)tmap(J.mapid, n0 + n, J.rowoff) * J.K + k0 + 8 * c) = o; }
    asm volatile("s_waitcnt lgkmcnt(0)" ::: "memory");
}
constexpr int NTJ = 11;
__device__ __forceinline__ void get_tjob(InTab in, unsigned char* ws, int j, TJob& J) {
    J.kg = nullptr; J.kg2 = nullptr; J.mapid = 0; J.rowoff = 0; J.col0 = 0;
    switch (j) {
    case 0: J.W = in[I_W_IN]; J.ldw = INCOLS; J.col0 = 0; J.ncols = 1024; J.K = 1024; J.WT = (bf16_t*)(ws + WS_WIN); J.mapid = 1; break;
    case 1: J.W = in[I_W_IN]; J.ldw = INCOLS; J.col0 = 1024; J.ncols = 512; J.K = 1024; J.WT = (bf16_t*)(ws + WS_WIN); J.rowoff = 1024; break;
    case 2: J.W = in[I_W_IN]; J.ldw = INCOLS; J.col0 = 1544; J.ncols = 512; J.K = 1024; J.WT = (bf16_t*)(ws + WS_WIN); J.rowoff = 1536; break;
    case 3: J.W = in[I_WGLU]; J.ldw = 512; J.ncols = 512; J.K = 512; J.WT = (bf16_t*)(ws + WS_WGLU); break;
    case 4: J.W = in[I_WOUT]; J.ldw = 1024; J.ncols = 1024; J.K = 1024; J.WT = (bf16_t*)(ws + WS_WOUT); J.kg = in[I_ONF]; J.kg2 = in[I_ONS]; break;
    case 5: J.W = in[I_WXQ]; J.ldw = 1024; J.ncols = 1024; J.K = 1024; J.WT = (bf16_t*)(ws + WS_WXQ); J.kg = in[I_NCROSS]; break;
    case 6: J.W = in[I_WXKV]; J.ldw = 2048; J.col0 = 0; J.ncols = 1024; J.K = 1024; J.WT = (bf16_t*)(ws + WS_WXK); break;
    case 7: J.W = in[I_WXKV]; J.ldw = 2048; J.col0 = 1024; J.ncols = 1024; J.K = 1024; J.WT = (bf16_t*)(ws + WS_WXV); break;
    case 8: J.W = in[I_WXO]; J.ldw = 1024; J.ncols = 1024; J.K = 1024; J.WT = (bf16_t*)(ws + WS_WXO); break;
    case 9: J.W = in[I_WUP]; J.ldw = 2 * DFF; J.ncols = 2 * DFF; J.K = 1024; J.WT = (bf16_t*)(ws + WS_WUP); J.kg = in[I_NFFN]; J.mapid = 2; break;
    default: J.W = in[I_WDN]; J.ldw = 1024; J.ncols = 1024; J.K = DFF; J.WT = (bf16_t*)(ws + WS_WDN); break;
    }
    J.items = (J.K / 64) * (J.ncols / 128);
}

__device__ __forceinline__ void rms_row(const float* xrow, const float* gain, bf16_t* orow, int lane, f32x4 (&v)[4]) {
    const f32x4* xr = (const f32x4*)xrow + lane; float s = 0.f;
#pragma unroll
    for (int j = 0; j < 4; ++j) { v[j] = xr[64 * j]; s += (v[j][0] * v[j][0] + v[j][1] * v[j][1]) + (v[j][2] * v[j][2] + v[j][3] * v[j][3]); }
    const float rs = rsqrtf(wave_sum(s) * (1.f / DM) + EPS);
    u32x2* o8 = (u32x2*)orow + lane;
#pragma unroll
    for (int j = 0; j < 4; ++j) { v[j] = v[j] * rs * ((const f32x4*)gain)[64 * j + lane]; u32x2 w; w.x = pk2(v[j][0], v[j][1]); w.y = pk2(v[j][2], v[j][3]); o8[64 * j] = w; }
}

__device__ __forceinline__ void cpow(float ar, float ai, float dt, float e, float& r, float& i) {
    const float mag = __expf(ar * dt * e);
    float rev = ai * dt * e * 0.15915494309189535f; rev -= rintf(rev);
    const float ang = rev * 6.283185307179586f;
    r = mag * cosf(ang); i = mag * sinf(ang);
}

__device__ __forceinline__ void s5_prep_task(InTab in, unsigned char* ws, int g, int tt, LAS float* L, int tid) {
    LAS float* pwA = L; LAS float* pwB = L + 128; LAS float* pwC = L + 256; LAS float* cf = L + 384; LAS float* bb = L + 512; LAS float* cc = L + 512 + 2048;
    const float dt = __expf(in[I_LOGDT][g]);
    if (tid < 64) { const int p = tid; const float ar = in[I_ARE][g * 64 + p], ai = in[I_AIM][g * 64 + p];
        float r, i; cpow(ar, ai, dt, (float)tt, r, i); pwA[2 * p] = r; pwA[2 * p + 1] = i;
        cpow(ar, ai, dt, (float)(tt + 1), r, i); pwB[2 * p] = r; pwB[2 * p + 1] = i;
        cpow(ar, ai, dt, (float)(TC - 1 - tt), r, i); pwC[2 * p] = r; pwC[2 * p + 1] = i;
        float lr, li; cpow(ar, ai, dt, 1.f, lr, li);
        const float den = ar * ar + ai * ai, nr = lr - 1.f;
        cf[2 * p] = (nr * ar + li * ai) / den; cf[2 * p + 1] = (li * ar - nr * ai) / den;
        if (tt == 0) { cpow(ar, ai, dt, (float)TC, r, i); float* lb = (float*)(ws + WS_LB32); lb[(g * 64 + p) * 2] = r; lb[(g * 64 + p) * 2 + 1] = i; } }
    for (int idx = tid; idx < 1024; idx += 512) { cc[2 * idx] = in[I_CRE][g * 1024 + idx]; cc[2 * idx + 1] = in[I_CIM][g * 1024 + idx]; }
    __syncthreads();
    for (int idx = tid; idx < 1024; idx += 512) { const int p = idx >> 4; const float br = in[I_BRE][g * 1024 + idx], bi = in[I_BIM][g * 1024 + idx], cr = cf[2 * p], ci = cf[2 * p + 1];
        bb[2 * idx] = cr * br - ci * bi; bb[2 * idx + 1] = cr * bi + ci * br; }
    __syncthreads();
    if (tid < 256) {
        const int c = tid >> 4, cp = tid & 15; float s = 0.f;
        for (int p = 0; p < 64; ++p) { const float pr = pwA[2 * p], pi = pwA[2 * p + 1], br = bb[2 * (p * 16 + cp)], bi = bb[2 * (p * 16 + cp) + 1];
            const float mr = pr * br - pi * bi, mi = pr * bi + pi * br; s += cc[2 * (c * 64 + p)] * mr - cc[2 * (c * 64 + p) + 1] * mi; }
        if (tt == 0 && c == cp) s += in[I_D][g * 16 + c];
        ((float*)(ws + WS_KTAB))[((g * TC + tt) * 16 + c) * 16 + cp] = s;
    } else {
        const int u = tid - 256;
        bf16_t* bty = (bf16_t*)(ws + WS_BTY) + (size_t)g * 512 * UGP; bf16_t* bte = (bf16_t*)(ws + WS_BTE) + (size_t)g * 256 * 512;
        for (int idx = u; idx < 1024; idx += 256) { const int c = idx >> 6, p = idx & 63;
            const float cr = cc[2 * idx], ci = cc[2 * idx + 1], pr = pwB[2 * p], pi = pwB[2 * p + 1];
            const float zr = cr * pr - ci * pi, zi = cr * pi + ci * pr;
            *(unsigned*)(bty + (size_t)(tt * 16 + c) * UGP + 512 + 2 * p) = pk2(zr, -zi); }
        for (int idx = u; idx < 1024; idx += 256) { const int p = idx >> 4, cp = idx & 15;
            const float pr = pwC[2 * p], pi = pwC[2 * p + 1], br = bb[2 * idx], bi = bb[2 * idx + 1];
            bte[(size_t)(2 * p) * 512 + tt * 16 + cp] = (bf16_t)f2bf(pr * br - pi * bi); bte[(size_t)(2 * p + 1) * 512 + tt * 16 + cp] = (bf16_t)f2bf(pr * bi + pi * br); }
        *(u32x4*)(bte + (size_t)(128 + (u >> 1)) * 512 + tt * 16 + (u & 1) * 8) = (u32x4){0u, 0u, 0u, 0u};
    }
    __syncthreads();
}

#define RLX_AGENT __ATOMIC_RELAXED, __HIP_MEMORY_SCOPE_AGENT
#define XB_TMO      128
#define XB_XCNT(j)  (256  + 64 * (j))
#define XB_XSUB(j)  (1280 + 64 * (j))
#define XB_XGEN(j)  (2304 + 64 * (j))
#define XB_TOP      3328
#define XB_TOPGEN   3392
#define XCD_BAR_WORDS 3456
#define XB_SPIN_CAP (1u << 18)

__device__ __forceinline__ unsigned xb_ld(unsigned* p)              { return __hip_atomic_load(p, __ATOMIC_RELAXED, __HIP_MEMORY_SCOPE_AGENT); }
__device__ __forceinline__ unsigned xb_add(unsigned* p, unsigned v) { return __hip_atomic_fetch_add(p, v, __ATOMIC_RELAXED, __HIP_MEMORY_SCOPE_AGENT); }
__device__ __forceinline__ unsigned xb_xcc_id() { return (unsigned)__builtin_amdgcn_s_getreg((3 << 11) | 20) & 0xFu; }
#define XB_SPIN(cond, bar) do { unsigned _sp = 0; while (cond) { __builtin_amdgcn_s_sleep(1); \
    if ((++_sp & 255u) == 0u) { if (xb_ld(&(bar)[XB_TMO])) break; if (_sp > XB_SPIN_CAP) { atomicAdd(&(bar)[XB_TMO], 1u); break; } } } } while (0)

struct XcdBarrier {
    unsigned* bar; unsigned x;
    volatile LAS unsigned* st;
};

__device__ __forceinline__ XcdBarrier xcd_barrier_post(unsigned* bar, volatile LAS unsigned* st) {
    XcdBarrier b; b.bar = bar; b.x = xb_xcc_id(); b.st = st;
    if (threadIdx.x == 0) (void)xb_add(&bar[XB_XCNT(b.x)], 1u);
    return b;
}
__device__ __forceinline__ void xcd_barrier_complete(unsigned* bar, unsigned x, unsigned& nloc, unsigned& nx) {
    const unsigned G = gridDim.x * gridDim.y * gridDim.z;
    unsigned sum, cnt, mine, sp = 0u;
    for (;;) {
        sum = 0u; cnt = 0u; mine = 0u;
#pragma unroll
        for (unsigned j = 0; j < 16; ++j) { const unsigned c = xb_ld(&bar[XB_XCNT(j)]); sum += c; cnt += (c > 0u) ? 1u : 0u; mine = (j == x) ? c : mine; }
        if (sum == G) break;
        __builtin_amdgcn_s_sleep(1);
        if ((++sp & 255u) == 0u) { if (xb_ld(&bar[XB_TMO])) break; if (sp > XB_SPIN_CAP) { atomicAdd(&bar[XB_TMO], 1u); break; } }
    }
    nloc = mine > 0u ? mine : 1u; nx = cnt > 0u ? cnt : 1u;
}

__device__ __forceinline__ void xcd_barrier(const XcdBarrier& b) {
    asm volatile("s_waitcnt vmcnt(0)" ::: "memory");
    __syncthreads();
    if (threadIdx.x == 0) {
        unsigned* bar = b.bar;
        __builtin_amdgcn_s_waitcnt(0);
        unsigned nloc = b.st[0], nx = b.st[1];
        if (nloc == 0u) { xcd_barrier_complete(bar, b.x, nloc, nx); b.st[0] = nloc; b.st[1] = nx; }
        const unsigned old = xb_add(&bar[XB_XSUB(b.x)], 1u);
        const unsigned gen = old / nloc;
        if (old + 1u == (gen + 1u) * nloc) {
            __builtin_amdgcn_fence(__ATOMIC_RELEASE, "agent");
            asm volatile("s_waitcnt vmcnt(0)" ::: "memory");
            const unsigned og = xb_add(&bar[XB_TOP], 1u);
            const unsigned tg = og / nx;
            if (og + 1u == (tg + 1u) * nx) xb_add(&bar[XB_TOPGEN], 1u);
            else XB_SPIN(xb_ld(&bar[XB_TOPGEN]) == tg, bar);
            __builtin_amdgcn_fence(__ATOMIC_ACQUIRE, "agent");
            xb_add(&bar[XB_XGEN(b.x)], 1u);
            asm volatile("s_waitcnt vmcnt(0)" ::: "memory");
        } else {
            XB_SPIN(xb_ld(&bar[XB_XGEN(b.x)]) == gen, bar);
            __builtin_amdgcn_fence(__ATOMIC_ACQUIRE, "agent");
            asm volatile("s_waitcnt vmcnt(0)" ::: "memory");
        }
    }
    __syncthreads();
}


#ifndef FIRST_STEP
#define FIRST_STEP 0
#endif
#ifndef LAST_STEP
#define LAST_STEP 18
#endif
#define ON(n) (FIRST_STEP <= (n) && (n) <= LAST_STEP)
#define SYNC(n) do { if ((n) < LAST_STEP) { XcdBarrier bar_; bar_.bar = (unsigned*)ws; bar_.x = xb_xcc_id(); bar_.st = (volatile LAS unsigned*)(L + RING_BYTES + 352); xcd_barrier(bar_); } } while (0)
#define WSB(off) ((const bf16_t*)(ws + (off)))
__global__ void __launch_bounds__(512, 2) fox_s5_mega(Args a) {
    extern __shared__ __attribute__((aligned(16))) unsigned char lds[];
    LAS unsigned char* L = (LAS unsigned char*)lds;
    const int G = gridDim.x, bx = blockIdx.x, NGW = G * 8, NGT = G * 512;
#define KA const __attribute__((address_space(4))) unsigned char* ka_ = (const __attribute__((address_space(4))) unsigned char*)__builtin_amdgcn_kernarg_segment_ptr(); asm volatile("" : "+s"(ka_)); \
    InTab in = (InTab)ka_; float* out = *(float* const __attribute__((address_space(4)))*)(ka_ + 256); unsigned char* ws = *(unsigned char* const __attribute__((address_space(4)))*)(ka_ + 264); (void)in; (void)out;
#define IDS int tid = threadIdx.x; asm volatile("" : "+v"(tid)); const int lane = tid & 63, wave = __builtin_amdgcn_readfirstlane(tid >> 6); const int gw = bx * 8 + wave, gt = bx * 512 + tid; (void)lane; (void)gw; (void)gt;
    {
        KA
        if (threadIdx.x < 8) ((volatile LAS unsigned*)(L + RING_BYTES + 320))[threadIdx.x + 8 - 8] = 0u;
        if (threadIdx.x < 2) ((volatile LAS unsigned*)(L + RING_BYTES + 352))[threadIdx.x] = 0u;
        __syncthreads();
        (void)xcd_barrier_post((unsigned*)ws, (volatile LAS unsigned*)(L + RING_BYTES + 352));
    }

    if (ON(0)) {
        KA
        IDS
        LAS float* scr = (LAS float*)(L + wave * 16384);
        { int base = 0;
          for (int j = 0; j < NTJ; ++j) { TJob J; get_tjob(in, ws, j, J);
              int first = gw - (base % NGW); if (first < 0) first += NGW;
              for (int it = first; it < J.items; it += NGW) transpose_item(J, scr, it, lane);
              base += J.items; } }
        __syncthreads();
        LAS float* wf = (LAS float*)L;
        for (int idx = tid; idx < 8192; idx += 512) wf[idx] = in[I_W_IN][(size_t)(idx >> 3) * INCOLS + 1536 + (idx & 7)];
        __syncthreads();
        {
            f32x4 nx[4];
            if (gw < T) { const f32x4* xr = (const f32x4*)(in[I_X] + (size_t)gw * DM) + lane;
#pragma unroll
                for (int j = 0; j < 4; ++j) nx[j] = xr[64 * j]; }
            const f32x4* gp = (const f32x4*)in[I_NORM_MIX]; f32x4 gn[4];
#pragma unroll
            for (int j = 0; j < 4; ++j) gn[j] = gp[64 * j + lane];
            const float fbias = in[I_FBIAS][lane & 7];
            for (int m = gw; m < T; m += NGW) {
                f32x4 v[4]; float s = 0.f;
#pragma unroll
                for (int j = 0; j < 4; ++j) { v[j] = nx[j]; s += (v[j][0] * v[j][0] + v[j][1] * v[j][1]) + (v[j][2] * v[j][2] + v[j][3] * v[j][3]); }
                if (m + NGW < T) { const f32x4* xr = (const f32x4*)(in[I_X] + (size_t)(m + NGW) * DM) + lane;
#pragma unroll
                    for (int j = 0; j < 4; ++j) nx[j] = xr[64 * j]; }
                const float rs = rsqrtf(wave_sum(s) * (1.f / DM) + EPS);
                u32x2* o8 = (u32x2*)((bf16_t*)(ws + WS_HN) + (size_t)m * DM) + lane;
#pragma unroll
                for (int j = 0; j < 4; ++j) { v[j] = v[j] * rs * gn[j]; u32x2 w; w.x = pk2(v[j][0], v[j][1]); w.y = pk2(v[j][2], v[j][3]); o8[64 * j] = w; }
                float d[8];
#pragma unroll
                for (int h = 0; h < 8; ++h) d[h] = 0.f;
#pragma unroll
                for (int j = 0; j < 4; ++j)
#pragma unroll
                    for (int i = 0; i < 4; ++i) { const int k = 256 * j + 4 * lane + i; const f32x4 w0 = *(const LAS f32x4*)(wf + k * 8), w1 = *(const LAS f32x4*)(wf + k * 8 + 4);
                        d[0] += v[j][i] * w0[0]; d[1] += v[j][i] * w0[1]; d[2] += v[j][i] * w0[2]; d[3] += v[j][i] * w0[3];
                        d[4] += v[j][i] * w1[0]; d[5] += v[j][i] * w1[1]; d[6] += v[j][i] * w1[2]; d[7] += v[j][i] * w1[3]; }
                float e4[4];
#pragma unroll
                for (int h = 0; h < 4; ++h) { const float keep = (lane & 4) ? d[h + 4] : d[h], give = (lane & 4) ? d[h] : d[h + 4]; e4[h] = keep + __shfl_xor(give, 4); }
                float e2[2];
#pragma unroll
                for (int h = 0; h < 2; ++h) { const float keep = (lane & 2) ? e4[h + 2] : e4[h], give = (lane & 2) ? e4[h] : e4[h + 2]; e2[h] = keep + __shfl_xor(give, 2); }
                float z; { const float keep = (lane & 1) ? e2[1] : e2[0], give = (lane & 1) ? e2[0] : e2[1]; z = keep + __shfl_xor(give, 1); }
                z += __shfl_xor(z, 8); z += __shfl_xor(z, 16); z += __shfl_xor(z, 32);
                if (lane < 8) {
                    z += fbias;
                    const float ls = fminf(z, 0.f) - __logf(1.f + __expf(-fabsf(z)));
                    const int b = m >> 11, t = m & 2047;
                    ((float*)(ws + WS_LOGF))[(size_t)(b * 8 + lane) * SEQ + t] = ls; }
            }
        }
        for (int m = gw; m < TM; m += NGW) { f32x4 v[4]; rms_row(in[I_MEM] + (size_t)m * DM, in[I_NMEM], (bf16_t*)(ws + WS_MN) + (size_t)m * DM, lane, v); }
        __syncthreads();
        for (int task = bx; task < S5G * TC; task += G) { const int per = (S5G * TC) / G; const int t2 = ((S5G * TC) % G == 0) ? (task % G) * per + task / G : task;
            s5_prep_task(in, ws, t2 / TC, t2 % TC, (LAS float*)L, tid); }
        SYNC(0);
    }
    if (ON(1)) {
        KA
        IDS
        const float* kt = (const float*)(ws + WS_KTAB); bf16_t* bty = (bf16_t*)(ws + WS_BTY);
        for (int idx = gt; idx < S5G * 512 * 64; idx += NGT) {
            const int half = idx & 1, ss = (idx >> 1) & 31, nn = (idx >> 6) & 511, gI = idx >> 15; const int tt = nn >> 4, c = nn & 15;
            u32x4 w = (u32x4){0u, 0u, 0u, 0u};
            if (ss <= tt) { const float* src = kt + ((size_t)((gI * TC + (tt - ss)) * 16 + c)) * 16 + half * 8; const f32x4 k0 = *(const f32x4*)src, k1 = *(const f32x4*)(src + 4);
                w.x = pk2(k0[0], k0[1]); w.y = pk2(k0[2], k0[3]); w.z = pk2(k1[0], k1[1]); w.w = pk2(k1[2], k1[3]); }
            *(u32x4*)(bty + ((size_t)gI * 512 + nn) * UGP + ss * 16 + half * 8) = w; }
        if (wave == 0 && bx < BATCH * NFH) {
            const float* lf = (const float*)(ws + WS_LOGF) + (size_t)bx * SEQ + lane * 32; float* cb = (float*)(ws + WS_CB) + (size_t)bx * SEQ + lane * 32;
            f32x4 x[8]; float run = 0.f;
#pragma unroll
            for (int j = 0; j < 8; ++j) { x[j] = ((const f32x4*)lf)[j]; x[j][0] += run; x[j][1] += x[j][0]; x[j][2] += x[j][1]; x[j][3] += x[j][2]; run = x[j][3]; }
            float incl = run;
#pragma unroll
            for (int o = 1; o < 64; o <<= 1) { const float y = __shfl_up(incl, o); if (lane >= o) incl += y; }
            const float excl = incl - run;
#pragma unroll
            for (int j = 0; j < 8; ++j) ((f32x4*)cb)[j] = (x[j] + excl) * LOG2E;
        }
    }
    if (ON(2)) {
        KA
        pg8::Gemm g{WSB(WS_HN), WSB(WS_WIN), DM, DM, DM}; GOrder<OK_PLAIN> S; S.init(T / 256, 8, G, bx, DM, DM);
        Epi<EK_PROJ> E{ws + WS_Q, ws + WS_K, ws + WS_V, ws + WS_UG, in[I_FQN], in[I_FKN], nullptr};
        pg8::gemm_phase(L, g, S, E);
    }
    if (ON(3)) {
        KA
        pg8::Gemm g{WSB(WS_MN), WSB(WS_WXK), DM, DM, DM}; GOrder<OK_PLAIN> S; S.init(TM / 256, 4, G, bx, DM, DM);
        Epi<EK_MEMK> E{ws + WS_KST, ws + WS_SSQK, nullptr, nullptr, nullptr, nullptr, nullptr};
        pg8::gemm_phase(L, g, S, E);
    }
    if (ON(4)) {
        KA
        pg8::Gemm g{WSB(WS_WXV), WSB(WS_MN), DM, DM, DM}; GOrder<OK_PLAIN> S; S.init(4, TM / 256, G, (bx + 128) % G, DM, DM);
        Epi<EK_MEMVT> E{ws + WS_VT, nullptr, nullptr, nullptr, nullptr, nullptr, nullptr};
        pg8::gemm_phase(L, g, S, E);
        SYNC(4);
    }
    if (ON(5)) {
        KA
        const int vcu = (G % 8 == 0) ? (bx % 8) * (G / 8) + bx / 8 : bx;
        float skip_th; { const int ln = threadIdx.x & 63; float gq = fabsf(in[I_FQN][ln]), gk = fabsf(in[I_FKN][ln]);
#pragma unroll
            for (int o = 1; o < 64; o <<= 1) { gq = fmaxf(gq, __shfl_xor(gq, o)); gk = fmaxf(gk, __shfl_xor(gk, o)); }
            skip_th = 2.f * (64.f * C2Q * gq * gk) + 40.f; }
        for (int L2 = vcu; L2 < BATCH * NFH * 2; L2 += G) { const int bh = L2 >> 1, s = L2 & 1;
            for (int i = 0; i < 4; ++i) { const int qb = (i == 0) ? s : (i == 1) ? 3 - s : (i == 2) ? 4 + s : 7 - s;
                attn_body::attn_unit<8>(bh >> 3, bh & 7, qb, (const attn_body::bf16*)(ws + WS_Q), (const attn_body::bf16*)(ws + WS_K), (const attn_body::bf16*)(ws + WS_V),
                                        (attn_body::bf16*)(ws + WS_FOX), (const float*)(ws + WS_CB), (float*)(ws + WS_SSQF), (char*)lds, skip_th); } }
    }
    if (ON(6)) {
        KA
        pg8::Gemm g{WSB(WS_UG), WSB(WS_BTE), UGP, 512, 256}; GOrder<OK_S5E> S; S.init(256, 1, G, bx, UGP, 512);
        Epi<EK_S5E> E{ws + WS_EPART, nullptr, nullptr, nullptr, nullptr, nullptr, nullptr};
        pg8::gemm_phase(L, g, S, E);
        SYNC(6);
    }
    if (ON(7)) {
        KA
        IDS
        const float* ep = (const float*)(ws + WS_EPART); const float* lb = (const float*)(ws + WS_LB32); bf16_t* ug = (bf16_t*)(ws + WS_UG);
        for (int idx = gt; idx < S5G * BATCH * S5P; idx += NGT) { const int p = idx & 63, gb = idx >> 6, gI = gb >> 4;
            const float lr = lb[(gI * 64 + p) * 2], li = lb[(gI * 64 + p) * 2 + 1]; float sr = 0.f, si = 0.f;
            for (int k0 = 0; k0 < NCH; k0 += 16) {
                f32x2 e0[16], e1[16];
#pragma unroll
                for (int j = 0; j < 16; ++j) { const size_t row = (size_t)gb * NCH + k0 + j; e0[j] = *(const f32x2*)(ep + row * 128 + 2 * p); e1[j] = *(const f32x2*)(ep + (size_t)32768 * 128 + row * 128 + 2 * p); }
#pragma unroll
                for (int j = 0; j < 16; ++j) { const size_t row = (size_t)gb * NCH + k0 + j;
                    *(unsigned*)(ug + row * UGP + 512 + 2 * p) = pk2(sr, si);
                    const float nr = lr * sr - li * si + (e0[j][0] + e1[j][0]), ni = lr * si + li * sr + (e0[j][1] + e1[j][1]); sr = nr; si = ni; } } }
        SYNC(7);
    }
    if (ON(8)) {
        KA
        pg8::Gemm g{WSB(WS_UG), WSB(WS_BTY), UGP, UGP, UGP}; GOrder<OK_S5Y> S; S.init(256, 1, G, bx, UGP, UGP);
        Epi<EK_S5Y> E{ws + WS_Y1, nullptr, nullptr, nullptr, nullptr, nullptr, nullptr};
        pg8::gemm_phase(L, g, S, E);
        SYNC(8);
    }
    if (ON(9)) {
        KA
        pg8::Gemm g{WSB(WS_Y1), WSB(WS_WGLU), 512, 512, 512}; GOrder<OK_PLAIN> S; S.init(T / 256, 2, G, bx, 512, 512);
        Epi<EK_GLU> E{ws + WS_Y2, ws + WS_SSQY, nullptr, nullptr, ws + WS_Y1, in[I_BGLU], nullptr};
        pg8::gemm_phase(L, g, S, E);
        SYNC(9);
    }
    if (ON(10)) {
        KA
        IDS
        const float* sf = (const float*)(ws + WS_SSQF); const float* sy = (const float*)(ws + WS_SSQY);
        const bf16_t* fox = WSB(WS_FOX); const bf16_t* y2 = WSB(WS_Y2); bf16_t* mx = (bf16_t*)(ws + WS_MIXN);
        {
            f32x4 a0, a1, b0, b1; u32x4 f, y;
#define NRM_LOAD(mm) do { a0 = *(const f32x4*)(sf + (size_t)(mm) * 8); a1 = *(const f32x4*)(sf + (size_t)(mm) * 8 + 4); b0 = *(const f32x4*)(sy + (size_t)(mm) * 8); b1 = *(const f32x4*)(sy + (size_t)(mm) * 8 + 4); \
                f = *(const u32x4*)(fox + (size_t)(mm) * 512 + lane * 8); y = *(const u32x4*)(y2 + (size_t)(mm) * 512 + lane * 8); } while (0)
            if (gw < T) NRM_LOAD(gw);
            for (int m = gw; m < T; m += NGW) {
                const float rf = rsqrtf((((a0[0] + a0[1]) + (a0[2] + a0[3])) + ((a1[0] + a1[1]) + (a1[2] + a1[3]))) * (1.f / 512.f) + EPS);
                const float ry = rsqrtf((((b0[0] + b0[1]) + (b0[2] + b0[3])) + ((b1[0] + b1[1]) + (b1[2] + b1[3]))) * (1.f / 512.f) + EPS);
                u32x4 of, oy;
                of.x = pk2(bflo(f.x) * rf, bfhi(f.x) * rf); of.y = pk2(bflo(f.y) * rf, bfhi(f.y) * rf); of.z = pk2(bflo(f.z) * rf, bfhi(f.z) * rf); of.w = pk2(bflo(f.w) * rf, bfhi(f.w) * rf);
                oy.x = pk2(bflo(y.x) * ry, bfhi(y.x) * ry); oy.y = pk2(bflo(y.y) * ry, bfhi(y.y) * ry); oy.z = pk2(bflo(y.z) * ry, bfhi(y.z) * ry); oy.w = pk2(bflo(y.w) * ry, bfhi(y.w) * ry);
                if (m + NGW < T) NRM_LOAD(m + NGW);
                *(u32x4*)(mx + (size_t)m * DM + lane * 8) = of; *(u32x4*)(mx + (size_t)m * DM + 512 + lane * 8) = oy; }
#undef NRM_LOAD
        }
        SYNC(10);
    }
    if (ON(11)) {
        KA
        pg8::Gemm g{WSB(WS_MIXN), WSB(WS_WOUT), DM, DM, DM}; GOrder<OK_PLAIN> S; S.init(T / 256, 4, G, bx, DM, DM);
        Epi<EK_WOUT> E{out, ws + WS_H1B, ws + WS_SSQ1, nullptr, in[I_X], nullptr, nullptr};
        pg8::gemm_phase(L, g, S, E);
        SYNC(11);
    }
    if (ON(12)) {
        KA
        IDS
        const float* sk = (const float*)(ws + WS_SSQK); float* sck = (float*)(ws + WS_SCK);
        for (int idx = gt; idx < TM * 4; idx += NGT) { const int key = idx >> 2, h = idx & 3; const f32x4 q = *(const f32x4*)(sk + (size_t)key * 16 + h * 4);
            sck[(size_t)h * TM + key] = rsqrtf(((q[0] + q[1]) + (q[2] + q[3])) * (1.f / 256.f) + EPS); }
        pg8::Gemm g{WSB(WS_H1B), WSB(WS_WXQ), DM, DM, DM}; GOrder<OK_PLAIN> S; S.init(T / 256, 4, G, bx, DM, DM);
        Epi<EK_XQ> E{ws + WS_QST, ws + WS_SSQQ, nullptr, nullptr, in[I_XQN], in[I_XKN], nullptr};
        pg8::gemm_phase(L, g, S, E);
        SYNC(12);
    }
    if (ON(13)) {
        KA
        pg8::Gemm g{WSB(WS_QST), WSB(WS_KST), DM, DM, 256}; GOrder<OK_XS> S; S.init(512, 1, G, bx, DM, DM);
        Epi<EK_XS> E{ws + WS_P, ws + WS_PSUM, nullptr, nullptr, ws + WS_SSQ1, ws + WS_SSQQ, ws + WS_SCK};
        pg8::gemm_phase(L, g, S, E);
        SYNC(13);
    }
    if (ON(14)) {
        KA
        pg8::Gemm g{WSB(WS_P), WSB(WS_VT), DM, TM, 256}; GOrder<OK_XO> S; S.init(512, 1, G, bx, DM, TM);
        Epi<EK_XO> E{ws + WS_XO, nullptr, nullptr, nullptr, ws + WS_PSUM, nullptr, nullptr};
        pg8::gemm_phase(L, g, S, E);
        SYNC(14);
    }
    if (ON(15)) {
        KA
        pg8::Gemm g{WSB(WS_XO), WSB(WS_WXO), DM, DM, DM}; GOrder<OK_PLAIN> S; S.init(T / 256, 4, G, bx, DM, DM);
        Epi<EK_WXO> E{out, ws + WS_H2B, ws + WS_SSQ2, nullptr, out, nullptr, nullptr};
        pg8::gemm_phase(L, g, S, E);
        SYNC(15);
    }
    if (ON(16)) {
        KA
        { IDS
          const float* s2 = (const float*)(ws + WS_SSQ2); float* r2 = (float*)(ws + WS_RS2);
          for (int row = gt; row < T; row += NGT) { const f32x4 t0 = *(const f32x4*)(s2 + (size_t)row * 16), t1 = *(const f32x4*)(s2 + (size_t)row * 16 + 4), t2 = *(const f32x4*)(s2 + (size_t)row * 16 + 8), t3 = *(const f32x4*)(s2 + (size_t)row * 16 + 12);
              r2[row] = rsqrtf((((t0[0] + t0[1]) + (t0[2] + t0[3])) + ((t1[0] + t1[1]) + (t1[2] + t1[3])) + ((t2[0] + t2[1]) + (t2[2] + t2[3])) + ((t3[0] + t3[1]) + (t3[2] + t3[3]))) * (1.f / DM) + EPS); }
          SYNC(15); }
        pg8::Gemm g{WSB(WS_H2B), WSB(WS_WUP), DM, DM, DM}; GOrder<OK_PLAIN> S; S.init(T / 256, 22, G, bx, DM, DM);
        Epi<EK_UPC> E{ws + WS_U, ws + WS_G, ws + WS_G + 4 * MiB, ws + WS_G + 8 * MiB, ws + WS_RS2, in[I_CONVW], in[I_CONVB], (LAS float*)(L + RING_BYTES + 1024)};
        pg8::gemm_phase(L, g, S, E);
        SYNC(16);
    }
    if (ON(17)) {
        KA
        IDS
        const float* GHF = (const float*)(ws + WS_G); const float* GHL = (const float*)(ws + WS_G + 4 * MiB); const float* UH = (const float*)(ws + WS_G + 8 * MiB);
        const float* cw = in[I_CONVW]; const float* cbv = in[I_CONVB]; bf16_t* A = (bf16_t*)(ws + WS_U);
        for (int idx = gt; idx < (T / 256) * 2 * DFF; idx += NGT) { const int j = idx % DFF, pi = idx / DFF, i = pi & 1, pm = pi >> 1; const bool first = (pm & 7) == 0;
            const float g0 = GHF[(size_t)pi * DFF + j];
            const float gl1 = first ? 0.f : GHL[((size_t)(pm - 1) * 2 + 1) * DFF + j], gl0 = first ? 0.f : GHL[((size_t)(pm - 1) * 2) * DFF + j];
            const float g1 = i ? GHF[(size_t)(pm * 2) * DFF + j] : gl1, g2 = i ? gl1 : gl0;
            const float z = cbv[j] + cw[j] * g2 + cw[DFF + j] * g1 + cw[2 * DFF + j] * g0;
            A[(size_t)(pm * 256 + i) * DFF + j] = (bf16_t)f2bf(z * sigm(z) * UH[(size_t)pi * DFF + j]); }
        SYNC(17);
    }
    if (ON(18)) {
        KA
        pg8::Gemm g{WSB(WS_U), WSB(WS_WDN), DFF, DFF, DFF}; GOrder<OK_PLAIN> S; S.init(T / 256, 4, G, bx, DFF, DFF);
        Epi<EK_DOWN> E{out, nullptr, nullptr, nullptr, nullptr, nullptr, nullptr};
        pg8::gemm_phase(L, g, S, E);
    }
}

extern "C" void kernel_launch(void* const* d_in, const int* in_sizes, int n_in, void* d_out, int out_size, void* d_ws, size_t ws_size, hipStream_t stream) {
    static int grid = 0;
    if (grid == 0) {
        if (n_in != 32 || out_size != T * DM || ws_size < WS_END) { fprintf(stderr, "kernel_launch: unexpected shapes (n_in %d out %d ws %zu)\n", n_in, out_size, ws_size); grid = -1; return; }
        int dev = 0, cus = 0, per_cu = 0;
        (void)hipGetDevice(&dev); (void)hipDeviceGetAttribute(&cus, hipDeviceAttributeMultiprocessorCount, dev);
        if (hipFuncSetAttribute((const void*)fox_s5_mega, hipFuncAttributeMaxDynamicSharedMemorySize, LDS_TOTAL) != hipSuccess) { fprintf(stderr, "kernel_launch: hipFuncSetAttribute failed\n"); grid = -1; return; }
        if (hipOccupancyMaxActiveBlocksPerMultiprocessor(&per_cu, (const void*)fox_s5_mega, 512, LDS_TOTAL) != hipSuccess || per_cu < 1) { fprintf(stderr, "kernel_launch: occupancy query says %d\n", per_cu); per_cu = 1; }
        (void)hipGetLastError();
        grid = cus;
        if (grid > cus * per_cu) grid = cus * per_cu;
    }
    if (grid < 0) return;
    if (hipMemsetAsync(d_ws, 0, 65536, stream) != hipSuccess) { fprintf(stderr, "kernel_launch: memset of the barrier words failed\n"); return; }
    Args a{};
    for (int i = 0; i < 32; ++i) a.in[i] = (const float*)d_in[i];
    a.out = (float*)d_out; a.ws = (unsigned char*)d_ws;
    void* args[] = {&a};
    hipError_t e = hipLaunchCooperativeKernel((const void*)fox_s5_mega, dim3(grid), dim3(512), args, LDS_TOTAL, stream);
    if (e != hipSuccess) fprintf(stderr, "cooperative launch failed: %s (grid %d)\n", hipGetErrorString(e), grid);
}
```

```cpp
#include <hip/hip_runtime.h>
#include <hip/hip_bf16.h>
#include <cstdio>
#include <cstdint>
#include <cmath>

constexpr int BATCH = 16, SEQ = 2048, DM = 1024, T = BATCH * SEQ;
constexpr int NMEM = 256, TM = BATCH * NMEM;
constexpr int FOXW = 512, HD = 64, NFH = 8;
constexpr int S5W = 512, S5G = 32, S5C = 16, S5P = 64;
constexpr int NXH = 4, XHD = 256;
constexpr int DFF = 2816;
constexpr int INCOLS = 2056;
constexpr float EPS = 1e-6f;
constexpr int TC = 32, NCH = SEQ / TC;
constexpr int UGP = TC * 16 + 128;
constexpr float LOG2E = 1.4426950408889634f;
constexpr float C2Q = 0.125f * LOG2E;

#define LAS __attribute__((address_space(3)))
typedef unsigned short bf16_t;
typedef short bf16x8 __attribute__((ext_vector_type(8)));
typedef float f32x4 __attribute__((ext_vector_type(4)));
typedef float f32x2 __attribute__((ext_vector_type(2)));
typedef unsigned u32x4 __attribute__((ext_vector_type(4)));
typedef unsigned u32x2 __attribute__((ext_vector_type(2)));

__device__ __forceinline__ unsigned f2bf(float f) { unsigned u = __builtin_bit_cast(unsigned, f); return (u + 0x7fffu + ((u >> 16) & 1u)) >> 16; }
typedef __bf16 bf16x2_hw __attribute__((ext_vector_type(2)));
__device__ __forceinline__ unsigned pk2(float lo, float hi) { f32x2 v = {lo, hi}; bf16x2_hw b = __builtin_convertvector(v, bf16x2_hw); return __builtin_bit_cast(unsigned, b); }
__device__ __forceinline__ float bflo(unsigned w) { return __builtin_bit_cast(float, w << 16); }
__device__ __forceinline__ float bfhi(unsigned w) { return __builtin_bit_cast(float, w & 0xffff0000u); }
__device__ __forceinline__ float wave_sum(float v) {
#pragma unroll
    for (int o = 1; o < 64; o <<= 1) v += __shfl_xor(v, o);
    return v;
}

__device__ __forceinline__ float red_fq(float v) {
    v += __builtin_bit_cast(float, __builtin_amdgcn_ds_swizzle(__builtin_bit_cast(int, v), 0x401F));
    float a = v, b = v;
    asm volatile("s_nop 1\n\tv_permlane32_swap_b32 %0, %1\n\ts_nop 1" : "+v"(a), "+v"(b));
    return a + b;
}

constexpr size_t MiB = 1u << 20;
constexpr size_t WS_WIN = 1 * MiB, WS_WGLU = 5 * MiB, WS_WOUT = 6 * MiB, WS_WXQ = 8 * MiB, WS_WXK = 10 * MiB, WS_WXV = 12 * MiB, WS_WXO = 14 * MiB,
                 WS_WUP = 16 * MiB, WS_WDN = 27 * MiB, WS_BTY = 33 * MiB, WS_BTE = 53 * MiB, WS_KTAB = 61 * MiB, WS_LB32 = 62 * MiB, WS_LOGF = 63 * MiB,
                 WS_CB = 64 * MiB, WS_SSQF = 65 * MiB, WS_SSQY = 66 * MiB, WS_SSQ1 = 67 * MiB, WS_SSQ2 = 69 * MiB, WS_SSQQ = 71 * MiB, WS_PSUM = 73 * MiB,
                 WS_SSQK = 75 * MiB, WS_SCK = 76 * MiB, WS_RS2 = 77 * MiB;
constexpr size_t WS_HN = 80 * MiB, WS_FOX = 80 * MiB, WS_Y1 = 112 * MiB, WS_QST = 80 * MiB, WS_H2B = 80 * MiB;
constexpr size_t WS_MN = 144 * MiB, WS_KST = 152 * MiB, WS_VT = 160 * MiB;
constexpr size_t WS_Q = 168 * MiB, WS_K = 200 * MiB, WS_V = 232 * MiB, WS_Y2 = 168 * MiB, WS_MIXN = 200 * MiB, WS_P = 168 * MiB;
constexpr size_t WS_UG = 264 * MiB, WS_EPART = 304 * MiB, WS_H1B = 264 * MiB, WS_XO = 264 * MiB;
constexpr size_t WS_G = 144 * MiB, WS_U = 320 * MiB, WS_END = 496 * MiB;

namespace pg8 {
constexpr int BM = 256, BK = 64, HALF = 128, HTB = HALF * BK * 2, STAGE_BYTES = 8 * HTB;
__device__ __forceinline__ int lds_byte(int r, int c) { const int st = (r >> 4) * 2 + (c >> 5), rr = r & 15, cc = c & 31, ob = rr * 64 + cc * 2; return st * 1024 + (ob ^ (((ob >> 9) & 1) << 5)); }
__device__ __forceinline__ void stage_rc(int b, int& R, int& C) { const int st = b / 1024, sb = b % 1024, swz = sb ^ (((sb >> 9) & 1) << 5); R = (st >> 1) * 16 + swz / 64; C = (st & 1) * 32 + (swz % 64) / 2; }
__device__ __forceinline__ int perm32(int rho) { const int n = rho >> 4, i = rho & 15; return 8 * (i >> 2) + 4 * n + (i & 3); }

struct Unit { int pm, pn; long offA, offB; };
struct Gemm { const bf16_t* A; const bf16_t* Bt; int lda, ldb, K; };

template <class Epi, class Sched>
__device__ __forceinline__ void gemm_phase(LAS unsigned char* lds, const Gemm g, const Sched& S, const Epi& E) {
    int tid = threadIdx.x; asm volatile("" : "+v"(tid));
    const int wid = __builtin_amdgcn_readfirstlane(tid >> 6), lane = tid & 63, wr = wid >> 2, wc = wid & 3, fr = lane & 15, fq = lane >> 4;
    const int K = g.K, nt = K / BK;
    unsigned voffA[2], voffB[2];
#pragma unroll
    for (int i = 0; i < 2; ++i) { int R, C; stage_rc(tid * 16 + i * 8192, R, C); const int Rb = (R & ~31) + perm32(R & 31);
        voffA[i] = (unsigned)(R * g.lda + C) * 2u; voffB[i] = (unsigned)(Rb * g.ldb + C) * 2u; }
    const size_t kstep = (size_t)(BK * 2);
    const size_t hstepA = (size_t)HALF * g.lda * 2, hstepB = (size_t)HALF * g.ldb * 2;
    const unsigned ldsw = (unsigned)wid * 1024u;
    const int aoff = lds_byte(wr * 64 + fr, fq * 8), boff = lds_byte(wc * 32 + fr, fq * 8);
#define PG8_SA(b, h) (((b) * 2 + (h)) * HTB)
#define PG8_SB(b, h) ((4 + (b) * 2 + (h)) * HTB)
#define PG8_STAGE(bufoff, gbase, voff) do { _Pragma("unroll") for (int _i = 0; _i < 2; ++_i) \
        __builtin_amdgcn_global_load_lds((const unsigned*)((const char*)(gbase) + (voff)[_i]), (LAS unsigned*)(lds + (bufoff) + ldsw + _i * 8192), 16, 0, 0); } while (0)
#define PG8_LDA(dst, b, h) do { _Pragma("unroll") for (int m = 0; m < 4; ++m) _Pragma("unroll") for (int k = 0; k < 2; ++k) dst[m][k] = *(const LAS bf16x8*)(lds + PG8_SA(b, h) + aoff + m * 2048 + k * 1024); } while (0)
#define PG8_LDB(dst, b, h) do { _Pragma("unroll") for (int n = 0; n < 2; ++n) _Pragma("unroll") for (int k = 0; k < 2; ++k) dst[n][k] = *(const LAS bf16x8*)(lds + PG8_SB(b, h) + boff + n * 2048 + k * 1024); } while (0)
#define PG8_MMA(ai, bj, At, Bt) do { __builtin_amdgcn_s_setprio(1); _Pragma("unroll") for (int m = 0; m < 4; ++m) _Pragma("unroll") for (int n = 0; n < 2; ++n) _Pragma("unroll") for (int k = 0; k < 2; ++k) \
        acc[ai][bj][m][n] = __builtin_amdgcn_mfma_f32_16x16x32_bf16(Bt[n][k], At[m][k], acc[ai][bj][m][n], 0, 0, 0); __builtin_amdgcn_s_setprio(0); } while (0)
#define PG8_WAIT_V(n) asm volatile("s_waitcnt vmcnt(" #n ")" ::: "memory")
#define PG8_WAIT_L(n) asm volatile("s_waitcnt lgkmcnt(" #n ")" ::: "memory")
#define PG8_BAR __builtin_amdgcn_s_barrier()
#define PG8_SCHED __builtin_amdgcn_sched_barrier(0)
    Unit cur, nxt; int ui = 0;
    if (!S.next(0, cur)) return;
    f32x4 acc[2][2][4][2];
#pragma unroll
    for (int a = 0; a < 2; ++a)
#pragma unroll
        for (int b = 0; b < 2; ++b)
#pragma unroll
            for (int m = 0; m < 4; ++m)
#pragma unroll
                for (int n = 0; n < 2; ++n) acc[a][b][m][n] = (f32x4){0.f, 0.f, 0.f, 0.f};
    bf16x8 At[4][2], B0[2][2], B1[2][2];
    const char* cA = (const char*)g.A + cur.offA; const char* cB = (const char*)g.Bt + cur.offB;
    PG8_STAGE(PG8_SB(0, 0), cB, voffB); PG8_STAGE(PG8_SB(0, 1), cB + hstepB, voffB); PG8_STAGE(PG8_SA(0, 0), cA, voffA); PG8_STAGE(PG8_SA(0, 1), cA + hstepA, voffA);
    if (wr == 1) PG8_BAR;
    PG8_WAIT_V(2); PG8_BAR;
    PG8_STAGE(PG8_SB(1, 0), cB + kstep, voffB); PG8_STAGE(PG8_SA(1, 0), cA + kstep, voffA); PG8_STAGE(PG8_SB(1, 1), cB + hstepB + kstep, voffB);
    PG8_WAIT_V(6); PG8_BAR;
    for (;;) {
        const bool has_next = S.next(ui + 1, nxt);
        const char* nA = has_next ? (const char*)g.A + nxt.offA : cA; const char* nB = has_next ? (const char*)g.Bt + nxt.offB : cB;
        for (int t = 0; t < nt; t += 2) {
            const bool last = (t == nt - 2);
            const char* a1 = cA + (size_t)(t + 1) * kstep;
            const char* a2 = last ? nA : cA + (size_t)(t + 2) * kstep; const char* b2 = last ? nB : cB + (size_t)(t + 2) * kstep;
            const char* a3 = a2 + kstep; const char* b3 = b2 + kstep;
            PG8_LDB(B0, 0, 0); PG8_LDB(B1, 0, 1); PG8_SCHED; PG8_LDA(At, 0, 0); PG8_STAGE(PG8_SA(1, 1), a1 + hstepA, voffA);
            PG8_WAIT_V(8); PG8_WAIT_L(0); PG8_BAR; PG8_MMA(0, 0, At, B0); PG8_MMA(0, 1, At, B1); PG8_BAR; PG8_SCHED;
            PG8_LDA(At, 0, 1); PG8_STAGE(PG8_SB(0, 0), b2, voffB); PG8_STAGE(PG8_SB(0, 1), b2 + hstepB, voffB); PG8_STAGE(PG8_SA(0, 0), a2, voffA);
            PG8_WAIT_V(8); PG8_WAIT_L(0); PG8_BAR; PG8_MMA(1, 0, At, B0); PG8_MMA(1, 1, At, B1); PG8_BAR; PG8_SCHED;
            PG8_LDB(B0, 1, 0); PG8_LDB(B1, 1, 1); PG8_SCHED; PG8_LDA(At, 1, 0); PG8_STAGE(PG8_SA(0, 1), a2 + hstepA, voffA);
            PG8_WAIT_V(8); PG8_WAIT_L(0); PG8_BAR; PG8_MMA(0, 0, At, B0); PG8_MMA(0, 1, At, B1); PG8_BAR; PG8_SCHED;
            PG8_LDA(At, 1, 1); PG8_STAGE(PG8_SB(1, 0), b3, voffB); PG8_STAGE(PG8_SB(1, 1), b3 + hstepB, voffB); PG8_STAGE(PG8_SA(1, 0), a3, voffA);
            PG8_WAIT_V(8); PG8_WAIT_L(0); PG8_BAR; PG8_MMA(1, 0, At, B0); PG8_MMA(1, 1, At, B1); PG8_BAR; PG8_SCHED;
        }
        if (wr == 0) PG8_BAR;
        { int fr2 = fr, fq2 = fq; asm volatile("" : "+v"(fr2), "+v"(fq2));
          E(acc, cur, wr, wc, fr2, fq2); }
        if (!has_next) break;
#pragma unroll
        for (int a = 0; a < 2; ++a)
#pragma unroll
            for (int b = 0; b < 2; ++b)
#pragma unroll
                for (int m = 0; m < 4; ++m)
#pragma unroll
                    for (int n = 0; n < 2; ++n) acc[a][b][m][n] = (f32x4){0.f, 0.f, 0.f, 0.f};
        cur = nxt; cA = nA; cB = nB; ++ui;
        if (wr == 1) PG8_BAR;
    }
    PG8_WAIT_V(0);
    PG8_BAR;
#undef PG8_SA
#undef PG8_SB
#undef PG8_STAGE
#undef PG8_LDA
#undef PG8_LDB
#undef PG8_MMA
#undef PG8_WAIT_V
#undef PG8_WAIT_L
#undef PG8_BAR
#undef PG8_SCHED
}
}
using pg8::Unit;

enum OrderKind { OK_PLAIN = 0, OK_S5E, OK_S5Y, OK_XS, OK_XO };
template <int kind> struct GOrder {
    int nM, nN, nwg, G, c, lda, ldb;
    __device__ __forceinline__ void init(int nM_, int nN_, int G_, int c_, int lda_, int ldb_) { nM = nM_; nN = nN_; nwg = nM_ * nN_; G = G_; c = c_; lda = lda_; ldb = ldb_; }
    __device__ __forceinline__ bool next(int i, Unit& u) const {
        const long L = (long)i * G + c; if (L >= nwg) return false;
        const int l = (int)L;
        if constexpr (kind == OK_PLAIN) {
            int wgid = l; { const int q = nwg / 8, r = nwg % 8, xcd = wgid % 8, off = wgid / 8; wgid = (xcd < r ? xcd * (q + 1) : r * (q + 1) + (xcd - r) * q) + off; }
            const int nig = 8 * nN, gid = wgid / nig, fm = gid * 8, gsz = (nM - fm) < 8 ? (nM - fm) : 8;
            u.pm = fm + ((wgid % nig) % gsz); u.pn = (wgid % nig) / gsz;
            u.offA = (long)u.pm * 256 * lda * 2; u.offB = (long)u.pn * 256 * ldb * 2;
        } else if constexpr (kind == OK_S5E) {
            const int kq = l & 1, pmm = (l >> 1) & 3, gg = l >> 3;
            u.pm = gg * 4 + pmm; u.pn = kq;
            u.offA = ((long)u.pm * 256 * UGP + kq * 256) * 2; u.offB = ((long)gg * 256 * 512 + kq * 256) * 2;
        } else if constexpr (kind == OK_S5Y) {
            const int pn = l & 1, pmm = (l >> 1) & 3, gg = l >> 3;
            u.pm = gg * 4 + pmm; u.pn = pn;
            u.offA = (long)u.pm * 256 * UGP * 2; u.offB = ((long)gg * 512 + pn * 256) * UGP * 2;
        } else if constexpr (kind == OK_XS) {
            const int h = l & 3, pm = l >> 2, b = pm >> 3;
            u.pm = pm; u.pn = h;
            u.offA = ((long)pm * 256 * DM + h * 256) * 2; u.offB = ((long)b * 256 * DM + h * 256) * 2;
        } else {
            const int h = l & 3, pm = l >> 2, b = pm >> 3;
            u.pm = pm; u.pn = h;
            u.offA = ((long)pm * 256 * DM + h * 256) * 2; u.offB = ((long)h * 256 * TM + b * 256) * 2;
        }
        return true;
    }
};

enum EpiKind { EK_PROJ = 0, EK_MEMK, EK_MEMVT, EK_S5E, EK_S5Y, EK_GLU, EK_WOUT, EK_XQ, EK_XS, EK_XO, EK_WXO, EK_UP, EK_DOWN, EK_GATE, EK_UPACT, EK_UPC };
    __device__ __forceinline__ u32x4 pack8(const f32x4 a, const f32x4 b) { u32x4 w; w.x = pk2(a[0], a[1]); w.y = pk2(a[2], a[3]); w.z = pk2(b[0], b[1]); w.w = pk2(b[2], b[3]); return w; }
    __device__ __forceinline__ float gelu_t(float y) { const float z = 0.7978845608028654f * (y + 0.044715f * y * y * y); const float e = __expf(2.f * z); const float th = 1.f - 2.f / (e + 1.f); return 0.5f * y * (1.f + th); }
    __device__ __forceinline__ float sigm(float z) { return 1.f / (1.f + __expf(-z)); }
    __device__ __forceinline__ float ssq8(const f32x4 a, const f32x4 b) { return (a[0] * a[0] + a[1] * a[1]) + (a[2] * a[2] + a[3] * a[3]) + (b[0] * b[0] + b[1] * b[1]) + (b[2] * b[2] + b[3] * b[3]); }

template <int kind> struct Epi {
    void* p0; void* p1; void* p2; void* p3; const void* c0; const void* c1; const void* c2; LAS float* hx;
    __device__ __forceinline__ void operator()(const f32x4 (&acc)[2][2][4][2], const Unit& u, int wr, int wc, int fr, int fq) const {
        const int rbase = u.pm * 256 + wr * 64 + fr;
        const int cl0 = wc * 32 + 8 * fq;
        switch (kind) {
        case EK_PROJ: {
            const int pn = u.pn;
            if (pn < 4) {
                const bool isq = pn < 2; bf16_t* dst = (bf16_t*)(isq ? p0 : p1); const float* gptr = (const float*)(isq ? c0 : c1); const float post = isq ? C2Q : 1.f;
                const int head = 4 * (pn & 1) + wc;
#pragma unroll
                for (int ai = 0; ai < 2; ++ai)
#pragma unroll
                    for (int m = 0; m < 4; ++m) {
                        float ss = ssq8(acc[ai][0][m][0], acc[ai][0][m][1]) + ssq8(acc[ai][1][m][0], acc[ai][1][m][1]);
                        ss = red_fq(ss);
                        const float sc = rsqrtf(ss * (1.f / 64.f) + EPS) * post;
                        const size_t row = (size_t)(rbase + ai * 128 + m * 16);
#pragma unroll
                        for (int bj = 0; bj < 2; ++bj)
                            *(u32x4*)(dst + row * 512 + head * 64 + 32 * bj + 8 * fq) = pack8(acc[ai][bj][m][0] * sc * *(const f32x4*)(gptr + 32 * bj + 8 * fq), acc[ai][bj][m][1] * sc * *(const f32x4*)(gptr + 32 * bj + 8 * fq + 4));
                    }
            } else if (pn < 6) {
                bf16_t* dst = (bf16_t*)p2;
#pragma unroll
                for (int ai = 0; ai < 2; ++ai)
#pragma unroll
                    for (int m = 0; m < 4; ++m) { const size_t row = (size_t)(rbase + ai * 128 + m * 16);
#pragma unroll
                        for (int bj = 0; bj < 2; ++bj) *(u32x4*)(dst + row * 512 + (pn - 4) * 256 + bj * 128 + cl0) = pack8(acc[ai][bj][m][0], acc[ai][bj][m][1]); }
            } else {
                bf16_t* dst = (bf16_t*)p3;
#pragma unroll
                for (int ai = 0; ai < 2; ++ai)
#pragma unroll
                    for (int m = 0; m < 4; ++m) { const int row = rbase + ai * 128 + m * 16; const int b = row >> 11, t = row & 2047, ch = t >> 5, s = t & 31;
#pragma unroll
                        for (int bj = 0; bj < 2; ++bj) { const int f = (pn - 6) * 256 + bj * 128 + cl0; const int gI = f >> 4, cc = f & 15;
                            *(u32x4*)(dst + ((size_t)(gI * 1024 + b * 64 + ch)) * UGP + s * 16 + cc) = pack8(acc[ai][bj][m][0], acc[ai][bj][m][1]); } }
            }
        } break;
        case EK_MEMK: {
            bf16_t* dst = (bf16_t*)p0; float* sq = (float*)p1;
#pragma unroll
            for (int ai = 0; ai < 2; ++ai)
#pragma unroll
                for (int m = 0; m < 4; ++m) { const size_t row = (size_t)(rbase + ai * 128 + m * 16);
                    float ss = ssq8(acc[ai][0][m][0], acc[ai][0][m][1]) + ssq8(acc[ai][1][m][0], acc[ai][1][m][1]);
                    ss = red_fq(ss);
                    if (fq == 0) sq[row * 16 + u.pn * 4 + wc] = ss;
#pragma unroll
                    for (int bj = 0; bj < 2; ++bj) *(u32x4*)(dst + row * DM + u.pn * 256 + bj * 128 + cl0) = pack8(acc[ai][bj][m][0], acc[ai][bj][m][1]); }
        } break;
        case EK_MEMVT: {
            bf16_t* dst = (bf16_t*)p0;
#pragma unroll
            for (int ai = 0; ai < 2; ++ai)
#pragma unroll
                for (int m = 0; m < 4; ++m) { const size_t row = (size_t)(rbase + ai * 128 + m * 16);
#pragma unroll
                    for (int bj = 0; bj < 2; ++bj) *(u32x4*)(dst + row * TM + u.pn * 256 + bj * 128 + cl0) = pack8(acc[ai][bj][m][0], acc[ai][bj][m][1]); }
        } break;
        case EK_S5E: {
            float* dst = (float*)p0 + (size_t)u.pn * 32768 * 128;
#pragma unroll
            for (int ai = 0; ai < 2; ++ai)
#pragma unroll
                for (int m = 0; m < 4; ++m) { const size_t row = (size_t)(rbase + ai * 128 + m * 16);
                    *(f32x4*)(dst + row * 128 + cl0) = acc[ai][0][m][0]; *(f32x4*)(dst + row * 128 + cl0 + 4) = acc[ai][0][m][1]; }
        } break;
        case EK_S5Y: {
            bf16_t* dst = (bf16_t*)p0;
#pragma unroll
            for (int ai = 0; ai < 2; ++ai)
#pragma unroll
                for (int m = 0; m < 4; ++m) { const int r = rbase + ai * 128 + m * 16; const int gI = r >> 10, b = (r >> 6) & 15, k = r & 63;
#pragma unroll
                    for (int bj = 0; bj < 2; ++bj) { const int nn = u.pn * 256 + bj * 128 + cl0; const int tt = nn >> 4, cc = nn & 15;
                        f32x4 a = acc[ai][bj][m][0], c = acc[ai][bj][m][1];
#pragma unroll
                        for (int j = 0; j < 4; ++j) { a[j] = gelu_t(a[j]); c[j] = gelu_t(c[j]); }
                        *(u32x4*)(dst + ((size_t)(b * SEQ + k * TC + tt)) * 512 + gI * 16 + cc) = pack8(a, c); } }
        } break;
        case EK_GLU: {
            bf16_t* dst = (bf16_t*)p0; float* sq = (float*)p1; const bf16_t* y1 = (const bf16_t*)c0; const float* bg = (const float*)c1;
            f32x4 bv[2][2];
#pragma unroll
            for (int bj = 0; bj < 2; ++bj)
#pragma unroll
                for (int n = 0; n < 2; ++n) bv[bj][n] = *(const f32x4*)(bg + u.pn * 256 + bj * 128 + cl0 + 4 * n);
#pragma unroll
            for (int ai = 0; ai < 2; ++ai)
#pragma unroll
                for (int m = 0; m < 4; ++m) { const size_t row = (size_t)(rbase + ai * 128 + m * 16); float ss = 0.f;
#pragma unroll
                    for (int bj = 0; bj < 2; ++bj) { const size_t off = row * 512 + u.pn * 256 + bj * 128 + cl0;
                        const u32x4 yv = *(const u32x4*)(y1 + off);
                        f32x4 a = acc[ai][bj][m][0] + bv[bj][0], c = acc[ai][bj][m][1] + bv[bj][1];
                        a[0] = bflo(yv.x) * sigm(a[0]); a[1] = bfhi(yv.x) * sigm(a[1]); a[2] = bflo(yv.y) * sigm(a[2]); a[3] = bfhi(yv.y) * sigm(a[3]);
                        c[0] = bflo(yv.z) * sigm(c[0]); c[1] = bfhi(yv.z) * sigm(c[1]); c[2] = bflo(yv.w) * sigm(c[2]); c[3] = bfhi(yv.w) * sigm(c[3]);
                        ss += ssq8(a, c);
                        *(u32x4*)(dst + off) = pack8(a, c); }
                    ss = red_fq(ss);
                    if (fq == 0) sq[row * 8 + u.pn * 4 + wc] = ss; }
        } break;
        case EK_WOUT: case EK_WXO: {
            float* out = (float*)p0; bf16_t* hb = (bf16_t*)p1; float* sq = (float*)p2; const float* base = (const float*)c0;
#pragma unroll
            for (int ai = 0; ai < 2; ++ai)
#pragma unroll
                for (int m = 0; m < 4; ++m) { const size_t row = (size_t)(rbase + ai * 128 + m * 16); float ss = 0.f;
#pragma unroll
                    for (int bj = 0; bj < 2; ++bj) { const size_t off = row * DM + u.pn * 256 + bj * 128 + cl0;
                        const f32x4 a = acc[ai][bj][m][0] + *(const f32x4*)(base + off), c = acc[ai][bj][m][1] + *(const f32x4*)(base + off + 4);
                        *(f32x4*)(out + off) = a; *(f32x4*)(out + off + 4) = c;
                        ss += ssq8(a, c);
                        *(u32x4*)(hb + off) = pack8(a, c); }
                    ss = red_fq(ss);
                    if (fq == 0) sq[row * 16 + u.pn * 4 + wc] = ss; }
        } break;
        case EK_XQ: {
            bf16_t* dst = (bf16_t*)p0; float* sq = (float*)p1; const float* gq = (const float*)c0; const float* gk = (const float*)c1;
            f32x4 gg[2][2];
#pragma unroll
            for (int bj = 0; bj < 2; ++bj)
#pragma unroll
                for (int n = 0; n < 2; ++n) gg[bj][n] = *(const f32x4*)(gq + bj * 128 + cl0 + 4 * n) * *(const f32x4*)(gk + bj * 128 + cl0 + 4 * n);
#pragma unroll
            for (int ai = 0; ai < 2; ++ai)
#pragma unroll
                for (int m = 0; m < 4; ++m) { const size_t row = (size_t)(rbase + ai * 128 + m * 16);
                    float ss = ssq8(acc[ai][0][m][0], acc[ai][0][m][1]) + ssq8(acc[ai][1][m][0], acc[ai][1][m][1]);
                    ss = red_fq(ss);
                    if (fq == 0) sq[row * 16 + u.pn * 4 + wc] = ss;
#pragma unroll
                    for (int bj = 0; bj < 2; ++bj) *(u32x4*)(dst + row * DM + u.pn * 256 + bj * 128 + cl0) = pack8(acc[ai][bj][m][0] * gg[bj][0], acc[ai][bj][m][1] * gg[bj][1]); }
        } break;
        case EK_XS: {
            bf16_t* dst = (bf16_t*)p0; float* ps = (float*)p1; const float* s1 = (const float*)c0; const float* sqq = (const float*)c1; const float* sck = (const float*)c2;
            const int h = u.pn, b = u.pm >> 3;
            f32x4 kv[2][2];
#pragma unroll
            for (int bj = 0; bj < 2; ++bj)
#pragma unroll
                for (int n = 0; n < 2; ++n) kv[bj][n] = *(const f32x4*)(sck + (size_t)h * TM + b * 256 + bj * 128 + cl0 + 4 * n) * (LOG2E / 16.f);
#pragma unroll
            for (int ai = 0; ai < 2; ++ai)
#pragma unroll
                for (int m = 0; m < 4; ++m) { const size_t row = (size_t)(rbase + ai * 128 + m * 16);
                    const f32x4 t0 = *(const f32x4*)(s1 + row * 16), t1 = *(const f32x4*)(s1 + row * 16 + 4), t2 = *(const f32x4*)(s1 + row * 16 + 8), t3 = *(const f32x4*)(s1 + row * 16 + 12);
                    const float tot = ((t0[0] + t0[1]) + (t0[2] + t0[3])) + ((t1[0] + t1[1]) + (t1[2] + t1[3])) + ((t2[0] + t2[1]) + (t2[2] + t2[3])) + ((t3[0] + t3[1]) + (t3[2] + t3[3]));
                    const float rs1 = rsqrtf(tot * (1.f / DM) + EPS);
                    const f32x4 qq = *(const f32x4*)(sqq + row * 16 + h * 4);
                    const float sq = rs1 * rsqrtf(rs1 * rs1 * ((qq[0] + qq[1]) + (qq[2] + qq[3])) * (1.f / 256.f) + EPS);
                    float ss = 0.f;
#pragma unroll
                    for (int bj = 0; bj < 2; ++bj) { f32x4 a = acc[ai][bj][m][0] * kv[bj][0] * sq, c = acc[ai][bj][m][1] * kv[bj][1] * sq;
#pragma unroll
                        for (int j = 0; j < 4; ++j) { a[j] = __builtin_amdgcn_exp2f(a[j]); c[j] = __builtin_amdgcn_exp2f(c[j]); }
                        const u32x4 w = pack8(a, c);
                        ss += (bflo(w.x) + bfhi(w.x)) + (bflo(w.y) + bfhi(w.y)) + (bflo(w.z) + bfhi(w.z)) + (bflo(w.w) + bfhi(w.w));
                        *(u32x4*)(dst + row * DM + h * 256 + bj * 128 + cl0) = w; }
                    ss = red_fq(ss);
                    if (fq == 0) ps[row * 16 + h * 4 + wc] = ss; }
        } break;
        case EK_XO: {
            bf16_t* dst = (bf16_t*)p0; const float* ps = (const float*)c0; const int h = u.pn;
#pragma unroll
            for (int ai = 0; ai < 2; ++ai)
#pragma unroll
                for (int m = 0; m < 4; ++m) { const size_t row = (size_t)(rbase + ai * 128 + m * 16);
                    const f32x4 pp = *(const f32x4*)(ps + row * 16 + h * 4); const float inv = 1.f / ((pp[0] + pp[1]) + (pp[2] + pp[3]));
#pragma unroll
                    for (int bj = 0; bj < 2; ++bj) *(u32x4*)(dst + row * DM + h * 256 + bj * 128 + cl0) = pack8(acc[ai][bj][m][0] * inv, acc[ai][bj][m][1] * inv); }
        } break;
        case EK_DOWN: {
            float* out = (float*)p0;
#pragma unroll
            for (int ai = 0; ai < 2; ++ai)
#pragma unroll
                for (int m = 0; m < 4; ++m) { const size_t row = (size_t)(rbase + ai * 128 + m * 16);
#pragma unroll
                    for (int bj = 0; bj < 2; ++bj) { const size_t off = row * DM + u.pn * 256 + bj * 128 + cl0;
                        const f32x4 a = acc[ai][bj][m][0] + *(const f32x4*)(out + off), c = acc[ai][bj][m][1] + *(const f32x4*)(out + off + 4);
                        *(f32x4*)(out + off) = a; *(f32x4*)(out + off + 4) = c; } }
        } break;
        case EK_UPC: {
            bf16_t* A = (bf16_t*)p0; float* GHF = (float*)p1; float* GHL = (float*)p2; float* UH = (float*)p3; const float* s2 = (const float*)c0; const float* cw = (const float*)c1; const float* cbv = (const float*)c2;
            const int j0 = u.pn * 128 + cl0;
            float w0[8], w1[8], w2[8], bb[8];
#pragma unroll
            for (int i = 0; i < 2; ++i) { const f32x4 a0 = *(const f32x4*)(cw + j0 + 4 * i), a1 = *(const f32x4*)(cw + DFF + j0 + 4 * i), a2 = *(const f32x4*)(cw + 2 * DFF + j0 + 4 * i), a3 = *(const f32x4*)(cbv + j0 + 4 * i);
#pragma unroll
                for (int q = 0; q < 4; ++q) { w0[4 * i + q] = a0[q]; w1[4 * i + q] = a1[q]; w2[4 * i + q] = a2[q]; bb[4 * i + q] = a3[q]; } }
            float rsv[2][4];
#pragma unroll
            for (int ai = 0; ai < 2; ++ai)
#pragma unroll
                for (int m = 0; m < 4; ++m) rsv[ai][m] = s2[rbase + ai * 128 + m * 16];
            if (fr >= 14) {
#pragma unroll
                for (int ai = 0; ai < 2; ++ai) { const f32x4 g0 = acc[ai][0][3][0] * rsv[ai][3], g1 = acc[ai][0][3][1] * rsv[ai][3];
                    LAS float* hp = hx + ((ai * 2 + wr) * 2 + (fr - 14)) * 128 + cl0; *(LAS f32x4*)hp = g0; *(LAS f32x4*)(hp + 4) = g1;
                    if (ai == 1 && wr == 1) { float* gp = GHL + ((size_t)u.pm * 2 + (fr - 14)) * DFF + j0; *(f32x4*)gp = g0; *(f32x4*)(gp + 4) = g1; } } }
            if (wr == 0 && fr < 2) {
                const float rs = rsv[0][0]; float* gp = GHF + ((size_t)u.pm * 2 + fr) * DFF + j0; float* up = UH + ((size_t)u.pm * 2 + fr) * DFF + j0;
                *(f32x4*)gp = acc[0][0][0][0] * rs; *(f32x4*)(gp + 4) = acc[0][0][0][1] * rs; *(f32x4*)up = acc[0][1][0][0] * rs; *(f32x4*)(up + 4) = acc[0][1][0][1] * rs; }
            asm volatile("s_waitcnt lgkmcnt(0)" ::: "memory"); __builtin_amdgcn_s_barrier(); asm volatile("" ::: "memory");
#define ROR1(x) __builtin_bit_cast(float, __builtin_amdgcn_update_dpp(0, __builtin_bit_cast(int, (x)), 0x121, 0xF, 0xF, false))
#define ROR2(x) __builtin_bit_cast(float, __builtin_amdgcn_update_dpp(0, __builtin_bit_cast(int, (x)), 0x122, 0xF, 0xF, false))
#pragma unroll
            for (int ai = 0; ai < 2; ++ai) {
                const int grp = ai * 2 + wr;
                float p1v[8], p2v[8];
                { f32x4 h1a = (f32x4){0.f, 0.f, 0.f, 0.f}, h1b = h1a, h2a = h1a, h2b = h1a;
                  if (grp > 0) { const LAS float* hp = hx + ((grp - 1) * 2) * 128 + cl0; h2a = *(const LAS f32x4*)hp; h2b = *(const LAS f32x4*)(hp + 4); h1a = *(const LAS f32x4*)(hp + 128); h1b = *(const LAS f32x4*)(hp + 132); }
#pragma unroll
                  for (int i = 0; i < 4; ++i) { p1v[i] = h1a[i]; p1v[4 + i] = h1b[i]; p2v[i] = (fr == 0) ? h2a[i] : h1a[i]; p2v[4 + i] = (fr == 0) ? h2b[i] : h1b[i]; } }
#pragma unroll
                for (int m = 0; m < 4; ++m) { const float rs = rsv[ai][m]; const size_t row = (size_t)(rbase + ai * 128 + m * 16);
                    float gs[8], r[8];
#pragma unroll
                    for (int i = 0; i < 4; ++i) { gs[i] = acc[ai][0][m][0][i] * rs; gs[4 + i] = acc[ai][0][m][1][i] * rs; }
#pragma unroll
                    for (int i = 0; i < 8; ++i) { const float c1v = ROR1(gs[i]), c2v = ROR2(gs[i]);
                        const float g1 = (fr == 0) ? p1v[i] : c1v, g2 = (fr < 2) ? p2v[i] : c2v;
                        p1v[i] = c1v; p2v[i] = c2v;
                        const float z = bb[i] + w0[i] * g2 + w1[i] * g1 + w2[i] * gs[i];
                        const float uv = (i < 4 ? acc[ai][1][m][0][i & 3] : acc[ai][1][m][1][i & 3]) * rs;
                        r[i] = z * sigm(z) * uv; }
                    u32x4 o; o.x = pk2(r[0], r[1]); o.y = pk2(r[2], r[3]); o.z = pk2(r[4], r[5]); o.w = pk2(r[6], r[7]);
                    if (!(grp == 0 && m == 0 && fr < 2)) *(u32x4*)(A + row * DFF + j0) = o; } }
#undef ROR1
#undef ROR2
        } break;
        default: break;
        }
    }
};

namespace attn_body {
using bf16=__hip_bfloat16;
using s16x4=__attribute__((ext_vector_type(4)))short;
using f32x16=__attribute__((ext_vector_type(16)))float;
constexpr int NHEAD=NFH,D=64,ADM=NHEAD*D;
constexpr int NW=8,QBLK=32,QB=QBLK*NW,KVBLK=64,NQB=SEQ/QB;
__device__ __forceinline__ int crow(int r,int hi){return (r&3)+8*(r>>2)+4*hi;}
#define SBAR() __builtin_amdgcn_sched_barrier(0)
__device__ __forceinline__ void cmask(f32x16&p0,f32x16&p1,int jb,int qrel,int hi){
  const float NEG=-INFINITY; int kb=64*jb+4*hi;
  #pragma unroll
  for(int r=0;r<16;++r){int kv=kb+(r&3)+8*(r>>2); if(kv>qrel)p0[r]=NEG; if(kv+32>qrel)p1[r]=NEG;}
}
constexpr int NSLOT=3, SLOTB=8192;
constexpr int LDS_K=0, LDS_V=NSLOT*SLOTB, LDS_WS=2*NSLOT*SLOTB, LDS_OST=LDS_WS+NW*64*4, LDS_BYTES=LDS_OST+NW*4096;
constexpr int LDS_BIAS=86016;
__device__ __forceinline__ void glds16(const void*gsrc,unsigned lds_dst){unsigned keep;
  asm volatile("s_mov_b32 %0, m0\n\ts_mov_b32 m0, %2\n\ts_nop 0\n\tglobal_load_lds_dwordx4 %1, off\n\ts_mov_b32 m0, %0":"=&s"(keep):"v"(gsrc),"s"(lds_dst):"memory");}
__device__ __forceinline__ float max3f(float a,float b,float c){float r;asm("v_max3_f32 %0, %1, %2, %3":"=v"(r):"v"(a),"v"(b),"v"(c));return r;}
__device__ __forceinline__ float max2f(float a,float b){float r;asm("v_max_f32_e32 %0, %1, %2":"=v"(r):"v"(a),"v"(b));return r;}
__device__ __forceinline__ float fadd_s(float a,float b){float r;asm("v_add_f32_e32 %0, %1, %2":"=v"(r):"v"(a),"v"(b));return r;}
__device__ __forceinline__ float fsub_s(float a,float b){float r;asm("v_sub_f32_e32 %0, %1, %2":"=v"(r):"v"(a),"v"(b));return r;}
typedef float f32x2_t __attribute__((ext_vector_type(2))); typedef __bf16 bf16x2_t __attribute__((ext_vector_type(2)));
__device__ __forceinline__ unsigned cvtpk_s(float lo,float hi){f32x2_t v={lo,hi};bf16x2_t b=__builtin_convertvector(v,bf16x2_t);return __builtin_bit_cast(unsigned,b);}
#define WAIT_BAR(N) asm volatile("s_waitcnt vmcnt(" #N ") lgkmcnt(0)\n\ts_barrier":::"memory")

__device__ __forceinline__ void qkt(f32x16&p0,f32x16&p1,const char*Kslot,const bf16x8*qr,const f32x16&negm,int r32,int hi){
  const char*kb=Kslot+hi*1024+r32*16;
  #pragma unroll
  for(int d0=0;d0<4;++d0){
    const bf16x8 b0=*reinterpret_cast<const bf16x8*>(kb+d0*2048);
    const bf16x8 b1=*reinterpret_cast<const bf16x8*>(kb+d0*2048+512);
    if(d0==0){p0=__builtin_amdgcn_mfma_f32_32x32x16_bf16(b0,qr[0],negm,0,0,0);p1=__builtin_amdgcn_mfma_f32_32x32x16_bf16(b1,qr[0],negm,0,0,0);}
    else{p0=__builtin_amdgcn_mfma_f32_32x32x16_bf16(b0,qr[d0],p0,0,0,0);p1=__builtin_amdgcn_mfma_f32_32x32x16_bf16(b1,qr[d0],p1,0,0,0);}}
}
typedef __attribute__((address_space(3))) const char* lds_cptr;
typedef short v4i16_t __attribute__((ext_vector_type(4)));
__device__ __forceinline__ void kload8(bf16x8*kf,lds_cptr kp){
  kf[0]=*(const __attribute__((address_space(3))) bf16x8*)(kp);      kf[1]=*(const __attribute__((address_space(3))) bf16x8*)(kp+512);
  kf[2]=*(const __attribute__((address_space(3))) bf16x8*)(kp+2048); kf[3]=*(const __attribute__((address_space(3))) bf16x8*)(kp+2560);
  kf[4]=*(const __attribute__((address_space(3))) bf16x8*)(kp+4096); kf[5]=*(const __attribute__((address_space(3))) bf16x8*)(kp+4608);
  kf[6]=*(const __attribute__((address_space(3))) bf16x8*)(kp+6144); kf[7]=*(const __attribute__((address_space(3))) bf16x8*)(kp+6656);
}
__device__ __forceinline__ void kload2(bf16x8*kf,lds_cptr kp,int j){ kf[2*j]=*(const __attribute__((address_space(3))) bf16x8*)(kp+j*2048); kf[2*j+1]=*(const __attribute__((address_space(3))) bf16x8*)(kp+j*2048+512); }
__device__ __forceinline__ s16x4 vtr(lds_cptr p){ return __builtin_bit_cast(s16x4,__builtin_amdgcn_ds_read_tr16_b64_v4i16((__attribute__((address_space(3))) v4i16_t*)p)); }
__device__ __forceinline__ float rowmax(const f32x16&p0,const f32x16&p1){
  float a=max3f(p0[0],p0[1],p1[0]),b=max3f(p0[2],p0[3],p1[1]);a=max3f(a,p1[2],p1[3]);
  #pragma unroll
  for(int r=4;r<16;r+=4){a=max3f(a,p0[r],p0[r+1]);b=max3f(b,p0[r+2],p0[r+3]);a=max3f(a,p1[r],p1[r+1]);b=max3f(b,p1[r+2],p1[r+3]);}
  const float m=max2f(a,b);
  auto rr=__builtin_amdgcn_permlane32_swap(__float_as_uint(m),__float_as_uint(m),false,false);
  return max2f(__uint_as_float(rr[0]),__uint_as_float(rr[1]));
}
__device__ __forceinline__ void pv(f32x16*o,int vb,bf16x8 pa0,bf16x8 pa1,bf16x8 pa2,bf16x8 pa3){
  #pragma unroll
  for(int d0=0;d0<2;++d0){s16x4 lo[4],hi[4];
    #pragma unroll
    for(int ks=0;ks<4;++ks){
      asm volatile("ds_read_b64_tr_b16 %0,%1 offset:%c2":"=&v"(lo[ks]):"v"(vb),"i"(d0*4096+ks*1024):"memory");
      asm volatile("ds_read_b64_tr_b16 %0,%1 offset:%c2":"=&v"(hi[ks]):"v"(vb),"i"(d0*4096+ks*1024+512):"memory");}
    asm volatile("s_waitcnt lgkmcnt(0)":::"memory");SBAR();
    #define PK(k) (bf16x8){lo[k][0],lo[k][1],lo[k][2],lo[k][3],hi[k][0],hi[k][1],hi[k][2],hi[k][3]}
    o[d0]=__builtin_amdgcn_mfma_f32_32x32x16_bf16(pa0,PK(0),o[d0],0,0,0);
    o[d0]=__builtin_amdgcn_mfma_f32_32x32x16_bf16(pa1,PK(1),o[d0],0,0,0);
    o[d0]=__builtin_amdgcn_mfma_f32_32x32x16_bf16(pa2,PK(2),o[d0],0,0,0);
    o[d0]=__builtin_amdgcn_mfma_f32_32x32x16_bf16(pa3,PK(3),o[d0],0,0,0);
    #undef PK
  }
}
typedef const __attribute__((address_space(3))) f32x4* lds_f4ptr;
#define BIASADD(P0,P1,t) do{ const lds_f4ptr bp_=(lds_f4ptr)(shm3+bias_off+((t)*64+4*hi)*4); \
    _Pragma("unroll") for(int j_=0;j_<4;++j_){ const f32x4 b0_=bp_[2*j_]-mhat, b1_=bp_[8+2*j_]-mhat; \
      P0[4*j_]+=b0_[0]; P0[4*j_+1]+=b0_[1]; P0[4*j_+2]+=b0_[2]; P0[4*j_+3]+=b0_[3]; \
      P1[4*j_]+=b1_[0]; P1[4*j_+1]+=b1_[1]; P1[4*j_+2]+=b1_[2]; P1[4*j_+3]+=b1_[3]; } }while(0)

template<int THRL> __device__ __forceinline__ void attn_unit(int b,int h,int qb,const bf16*Q,const bf16*__restrict__ K,const bf16*__restrict__ V,bf16*O,const float*__restrict__ CB,float*__restrict__ SSQ,char*shm,const float skip_th){
  int tid=threadIdx.x; asm volatile("":"+v"(tid));
  const int lane=tid&63,r32=lane&31,hi=lane>>5; const int wid=__builtin_amdgcn_readfirstlane(tid>>6);
  const long rowbase=(long)b*SEQ; const int q0=qb*QB;
  const bf16*Qw=Q+(rowbase+q0+wid*QBLK)*ADM+h*D;
  int t0=0; { const float*cbh0=CB+(long)(b*NHEAD+h)*SEQ; const int npair=(q0+QB)/KVBLK/2-2; const float c0v=cbh0[q0];
    const bool far=(lane<npair)&&(cbh0[128*(lane<npair?lane:0)+127]-c0v>skip_th); const unsigned long long mk=__ballot(far);
    int lead=__builtin_ctzll(~mk); if(lead>npair)lead=npair; if(lead<0)lead=0; t0=2*__builtin_amdgcn_readfirstlane(lead); }
  const bf16*Kh=K+(rowbase+(long)t0*KVBLK)*ADM+h*D,*Vh=V+(rowbase+(long)t0*KVBLK)*ADM+h*D;
  const unsigned lds0=(unsigned)(uintptr_t)shm;
  float*wsf=(float*)(shm+LDS_WS)+wid*64;
  const lds_cptr shm3=(lds_cptr)shm;
  { const float*cbh=CB+(long)(b*NHEAD+h)*SEQ; const float cref=cbh[q0+128];
    if(tid*4<q0+QB){ const f32x4 c4=*(const f32x4*)(cbh+tid*4); *(__attribute__((address_space(3))) f32x4*)(shm3+LDS_BIAS+tid*16)=(f32x4){cref-c4[0],cref-c4[1],cref-c4[2],cref-c4[3]}; } }
  const bf16*ksrc=Kh+(long)lane*ADM+wid*8;
  const bf16*vsrc=Vh+(long)(16*(wid&3)+(lane>>2))*ADM+(wid>>2)*32+(lane&3)*8;
  const unsigned kdst=lds0+LDS_K+wid*1024, vdst=lds0+LDS_V+wid*1024;
  #define DMA_K(t,slot) glds16(ksrc+(long)(t)*KVBLK*ADM,(unsigned)__builtin_amdgcn_readfirstlane(kdst+(slot)))
  #define DMA_V(t,slot) glds16(vsrc+(long)(t)*KVBLK*ADM,(unsigned)__builtin_amdgcn_readfirstlane(vdst+(slot)))
  const int vb0=(int)(lds0+LDS_V)+((lane>>4)&1)*32+(lane&3)*8+(4*hi+((lane&15)>>2))*64;
  const char*Kbase=shm+LDS_K; bf16x8 kf[8];
  const lds_cptr kp0=shm3+LDS_K+hi*1024+r32*16; const lds_cptr vp0=shm3+LDS_V+((lane>>4)&1)*32+(lane&3)*8+(4*hi+((lane&15)>>2))*64;
  const int NT=(q0+QB)/KVBLK-t0; const int bias_off=LDS_BIAS+t0*KVBLK*4;
  DMA_K(0,0);DMA_V(0,0);DMA_K(1,SLOTB);
  bf16x8 qr[4];
  #pragma unroll
  for(int d0=0;d0<4;++d0)qr[d0]=*reinterpret_cast<const bf16x8*>(&Qw[(long)r32*ADM+d0*16+hi*8]);
  float mhat=0.f,l_reg=0.f;f32x16 o[2];o[0]=f32x16{};o[1]=f32x16{};const f32x16 negm=f32x16{};
  const int qrel=wid*QBLK+r32;
  #define CMASK(P0,P1,t) do{int jb_=(t)-(NT-4); if(jb_>=0)cmask(P0,P1,jb_,qrel,hi);}while(0)
  bool resc=false;
  #define START(P0,P1) do{ const float rm=rowmax(P0,P1); resc=false; \
    { const float dl=max2f(rm,-24.f); mhat=fadd_s(mhat,dl); \
      _Pragma("unroll") for(int r=0;r<16;++r){P0[r]=fsub_s(P0[r],dl);P1[r]=fsub_s(P1[r],dl);} } \
    _Pragma("unroll") for(int r=0;r<16;++r)P0[r]=__builtin_amdgcn_exp2f(P0[r]); }while(0)
  #define RESC() do{ if(resc){ asm volatile("s_waitcnt lgkmcnt(0)":::"memory"); \
      _Pragma("unroll") for(int d_=0;d_<2;++d_) _Pragma("unroll") for(int r=0;r<16;++r)o[d_][r]*=wsf[crow(r,hi)]; } }while(0)
  f32x16 pA0,pA1,pB0,pB1;
  int sl_prev=0,sl_cur=0,sl_next=SLOTB;
  #define ROT() do{sl_prev=sl_cur;sl_cur=sl_next;sl_next=(sl_next==(NSLOT-1)*SLOTB)?0:sl_next+SLOTB;}while(0)
  DMA_K(2,2*SLOTB);
  WAIT_BAR(3);
  qkt(pA0,pA1,Kbase,qr,negm,r32,hi);asm volatile("s_nop 15\n\ts_nop 7":"+v"(pA0),"+v"(pA1));BIASADD(pA0,pA1,0);CMASK(pA0,pA1,0);
  START(pA0,pA1);
  _Pragma("unroll") for(int r=0;r<16;++r)pA1[r]=__builtin_amdgcn_exp2f(pA1[r]);
  WAIT_BAR(0);
  DMA_K(3,0);DMA_V(1,SLOTB);
  ROT();
  kload8(kf,kp0+sl_cur);
  WAIT_BAR(2);
  s16x4 vlo[8],vhi[8]; u32x4 pw0,pw1,pw2,pw3;
  #define PKW(P,B) cvtpk_s(P[B],P[B+1])
  #define PAF(k) __builtin_bit_cast(bf16x8,pw##k)
  #define VFR(i) (bf16x8){vlo[i][0],vlo[i][1],vlo[i][2],vlo[i][3],vhi[i][0],vhi[i][1],vhi[i][2],vhi[i][3]}
  #define PIN(x) asm volatile("":"+v"(x))
  #define MX3(a,b,c) __builtin_fmaxf(__builtin_fmaxf((a),(b)),(c))
  #define GAPA(MF,A0,A1,A2,A3,W0,W1,PW) do{ MF; sacc+=A0; sacc+=A1; sacc+=A2; sacc+=A3; PIN(sacc); W0; W1; PIN(PW); SBAR(); }while(0)
  #define EX(v) __builtin_amdgcn_exp2f(v)
  #define GAPB(MF,X,B) do{ MF; X[B]=EX(X[B]); X[B+1]=EX(X[B+1]); X[B+2]=EX(X[B+2]); X[B+3]=EX(X[B+3]); PIN(X); SBAR(); }while(0)
  #define VRD(i) do{ vlo[i]=vtr(vp_+(((i)>>2)*4096+((i)&3)*1024)); vhi[i]=vtr(vp_+(((i)>>2)*4096+((i)&3)*1024+512)); }while(0)
  #define KRD(G,j) do{ if(G){ kload2(kf,kp0+sl_next,j); SBAR(); } }while(0)
  #define STEP(C0,C1,P0,P1,t,GK,GV,GL) do{ SBAR(); \
    const lds_cptr vp_=vp0+sl_prev; \
    VRD(0); SBAR(); float sacc=(P0[0]+P0[1]); \
    GAPA(C0=__builtin_amdgcn_mfma_f32_32x32x16_bf16(kf[0],qr[0],negm,0,0,0), P0[2],P0[3],P0[4],P0[5],     pw0[0]=PKW(P0,0), pw0[1]=PKW(P0,2), pw0); \
    VRD(4); SBAR(); GAPA(C1=__builtin_amdgcn_mfma_f32_32x32x16_bf16(kf[1],qr[0],negm,0,0,0), P0[6],P0[7],P0[8],P0[9],     pw0[2]=PKW(P0,4), pw0[3]=PKW(P0,6), pw0); \
    VRD(1); SBAR(); GAPA(C0=__builtin_amdgcn_mfma_f32_32x32x16_bf16(kf[2],qr[1],C0,0,0,0),   P0[10],P0[11],P0[12],P0[13], pw1[0]=PKW(P0,8), pw1[1]=PKW(P0,10), pw1); \
    VRD(5); SBAR(); GAPA(C1=__builtin_amdgcn_mfma_f32_32x32x16_bf16(kf[3],qr[1],C1,0,0,0),   P0[14],P0[15],P1[0],P1[1],   pw1[2]=PKW(P0,12),pw1[3]=PKW(P0,14), pw1); \
    VRD(2); SBAR(); GAPA(C0=__builtin_amdgcn_mfma_f32_32x32x16_bf16(kf[4],qr[2],C0,0,0,0),   P1[2],P1[3],P1[4],P1[5],     pw2[0]=PKW(P1,0), pw2[1]=PKW(P1,2), pw2); \
    VRD(6); SBAR(); GAPA(C1=__builtin_amdgcn_mfma_f32_32x32x16_bf16(kf[5],qr[2],C1,0,0,0),   P1[6],P1[7],P1[8],P1[9],     pw2[2]=PKW(P1,4), pw2[3]=PKW(P1,6), pw2); \
    VRD(3); SBAR(); GAPA(C0=__builtin_amdgcn_mfma_f32_32x32x16_bf16(kf[6],qr[3],C0,0,0,0),   P1[10],P1[11],P1[12],P1[13], pw3[0]=PKW(P1,8), pw3[1]=PKW(P1,10), pw3); \
    VRD(7); SBAR(); GAPA(C1=__builtin_amdgcn_mfma_f32_32x32x16_bf16(kf[7],qr[3],C1,0,0,0),   P1[14],P1[15],0.f,0.f,       pw3[2]=PKW(P1,12),pw3[3]=PKW(P1,14), pw3); \
    l_reg+=sacc; \
    if(GK){DMA_K((t)+3,sl_cur);} if(GV){DMA_V((t)+1,sl_next);} \
    BIASADD(C0,C1,t); \
    CMASK(C0,C1,t); \
    { float a=MX3(C0[0],C0[1],C1[0]),b=MX3(C0[2],C0[3],C1[1]); a=MX3(a,C1[2],C1[3]); \
      _Pragma("unroll") for(int r=4;r<16;r+=4){a=MX3(a,C0[r],C0[r+1]);b=MX3(b,C0[r+2],C0[r+3]);a=MX3(a,C1[r],C1[r+1]);b=MX3(b,C1[r+2],C1[r+3]);} \
      float rm=__builtin_fmaxf(a,b); { auto rr=__builtin_amdgcn_permlane32_swap(__float_as_uint(rm),__float_as_uint(rm),false,false); rm=__builtin_fmaxf(__uint_as_float(rr[0]),__uint_as_float(rr[1])); } \
      resc=false; \
      if(__builtin_expect(__any(rm>(float)THRL),0)){ const float dl=__builtin_fmaxf(rm,0.f); mhat+=dl; \
        _Pragma("unroll") for(int r=0;r<16;++r){C0[r]-=dl;C1[r]-=dl;} \
        const float f=__builtin_amdgcn_exp2f(-dl); l_reg*=f; if(hi==0)wsf[r32]=f; resc=true; } } \
    SBAR(); \
    GAPB(o[0]=__builtin_amdgcn_mfma_f32_32x32x16_bf16(PAF(0),VFR(0),o[0],0,0,0), C0,0); \
    GAPB(o[1]=__builtin_amdgcn_mfma_f32_32x32x16_bf16(PAF(0),VFR(4),o[1],0,0,0), C0,4); \
    KRD(GL,0); GAPB(o[0]=__builtin_amdgcn_mfma_f32_32x32x16_bf16(PAF(1),VFR(1),o[0],0,0,0), C0,8); \
    KRD(GL,1); GAPB(o[1]=__builtin_amdgcn_mfma_f32_32x32x16_bf16(PAF(1),VFR(5),o[1],0,0,0), C0,12); \
    KRD(GL,2); GAPB(o[0]=__builtin_amdgcn_mfma_f32_32x32x16_bf16(PAF(2),VFR(2),o[0],0,0,0), C1,0); \
    KRD(GL,3); GAPB(o[1]=__builtin_amdgcn_mfma_f32_32x32x16_bf16(PAF(2),VFR(6),o[1],0,0,0), C1,4); \
    GAPB(o[0]=__builtin_amdgcn_mfma_f32_32x32x16_bf16(PAF(3),VFR(3),o[0],0,0,0), C1,8); \
    GAPB(o[1]=__builtin_amdgcn_mfma_f32_32x32x16_bf16(PAF(3),VFR(7),o[1],0,0,0), C1,12); \
    }while(0)
  int t=1;
  #undef CMASK
  #define CMASK(P0,P1,t) do{}while(0)
  for(;t+5<NT;t+=2){
    STEP(pB0,pB1,pA0,pA1,t,true,true,true);     WAIT_BAR(2); RESC(); ROT();
    STEP(pA0,pA1,pB0,pB1,t+1,true,true,true);   WAIT_BAR(2); RESC(); ROT();
  }
  #undef CMASK
  #define CMASK(P0,P1,t) do{int jb_=(t)-(NT-4); if(jb_>=0)cmask(P0,P1,jb_,qrel,hi);}while(0)
  #define ENDW(tt) do{ if((tt)+3<NT){WAIT_BAR(2);} else if((tt)+2<NT){WAIT_BAR(1);} else {WAIT_BAR(0);} }while(0)
  for(;t+1<NT;t+=2){
    STEP(pB0,pB1,pA0,pA1,t,(t+3<NT),(t+1<NT),(t+1<NT));       ENDW(t);   RESC(); ROT();
    STEP(pA0,pA1,pB0,pB1,t+1,(t+4<NT),(t+2<NT),(t+2<NT));     ENDW(t+1); RESC(); ROT();
  }
  STEP(pB0,pB1,pA0,pA1,NT-1,false,false,false); RESC();
  { float sacc=pB0[0]+pB0[1]; _Pragma("unroll") for(int r=2;r<16;++r)sacc+=pB0[r]; _Pragma("unroll") for(int r=0;r<16;++r)sacc+=pB1[r]; l_reg+=sacc;
    pw0=(u32x4){PKW(pB0,0),PKW(pB0,2),PKW(pB0,4),PKW(pB0,6)};pw1=(u32x4){PKW(pB0,8),PKW(pB0,10),PKW(pB0,12),PKW(pB0,14)};pw2=(u32x4){PKW(pB1,0),PKW(pB1,2),PKW(pB1,4),PKW(pB1,6)};pw3=(u32x4){PKW(pB1,8),PKW(pB1,10),PKW(pB1,12),PKW(pB1,14)};
    SBAR(); pv(o,vb0+sl_cur,PAF(0),PAF(1),PAF(2),PAF(3)); }
  #undef PKW
  #undef PAF
  #undef VFR
  #undef PIN
  #undef MX3
  #undef GAPA
  #undef GAPB
  #undef EX
  #undef VRD
  #undef KRD
  #undef STEP
  #undef ENDW
  {auto rr=__builtin_amdgcn_permlane32_swap(__float_as_uint(l_reg),__float_as_uint(l_reg),false,false);l_reg=__uint_as_float(rr[0])+__uint_as_float(rr[1]);}
  if(hi==0)wsf[32+r32]=l_reg;asm volatile("s_waitcnt lgkmcnt(0)":::"memory");
  float rli[16];
  #pragma unroll
  for(int r=0;r<16;++r)rli[r]=__builtin_amdgcn_rcpf(wsf[32+crow(r,hi)]);
  int lane2=lane; asm volatile("":"+v"(lane2));
  bf16*Ow=O+(rowbase+q0+wid*QBLK)*ADM+h*D;
  { bf16*stg=(bf16*)(shm+LDS_OST)+wid*2048;
    #pragma unroll
    for(int r=0;r<16;++r){const int orow=crow(r,hi);
      #pragma unroll
      for(int d0=0;d0<2;++d0)stg[orow*64+d0*32+r32]=__float2bfloat16(o[d0][r]*rli[r]);}
    asm volatile("s_waitcnt lgkmcnt(0)":::"memory");
    #pragma unroll
    for(int i=0;i<4;++i){const int row=i*8+(lane2>>3),ch=lane2&7; const u32x4 v=*(const u32x4*)(stg+row*64+ch*8); *(u32x4*)(Ow+(long)row*ADM+ch*8)=v;
      float s=(bflo(v.x)*bflo(v.x)+bfhi(v.x)*bfhi(v.x))+(bflo(v.y)*bflo(v.y)+bfhi(v.y)*bfhi(v.y))+(bflo(v.z)*bflo(v.z)+bfhi(v.z)*bfhi(v.z))+(bflo(v.w)*bflo(v.w)+bfhi(v.w)*bfhi(v.w));
      s+=__shfl_xor(s,1); s+=__shfl_xor(s,2); s+=__shfl_xor(s,4);
      if(ch==0)SSQ[(rowbase+q0+wid*QBLK+row)*NHEAD+h]=s; } }
  asm volatile("s_waitcnt lgkmcnt(0)\n\ts_barrier":::"memory");
  #undef DMA_K
  #undef DMA_V
  #undef CMASK
  #undef START
  #undef RESC
  #undef ROT
}
#undef SBAR
#undef WAIT_BAR
}

constexpr int RING_BYTES = 131072;
constexpr int LDS_TOTAL = 147456;
struct Args { const float* in[32]; float* out; unsigned char* ws; };
typedef const float* const __attribute__((address_space(4)))* InTab;
enum In { I_X = 0, I_MEM, I_NORM_MIX, I_W_IN, I_FQN, I_FKN, I_FBIAS, I_ARE, I_AIM, I_LOGDT, I_BRE, I_BIM, I_CRE, I_CIM, I_D, I_WGLU, I_BGLU, I_ONF, I_ONS, I_WOUT,
          I_NCROSS, I_NMEM, I_WXQ, I_WXKV, I_XQN, I_XKN, I_WXO, I_NFFN, I_WUP, I_CONVW, I_CONVB, I_WDN };

struct TJob { const float* W; int ldw, col0, ncols, K; const float* kg; const float* kg2; bf16_t* WT; int mapid, rowoff, items; };
__device__ __forceinline__ int tmap(int mapid, int n, int rowoff) {
    if (mapid == 1) { const int part = n >> 9, f = n & 511, head = f >> 6, d = f & 63; return 512 * part + 256 * (head >> 2) + 128 * (d >> 5) + 32 * (head & 3) + (d & 31); }
    if (mapid == 2) { const int isup = n >= DFF ? 1 : 0; const int j = n - isup * DFF; return 256 * (j >> 7) + 128 * isup + (j & 127); }
    return rowoff + n;
}
__device__ __forceinline__ void transpose_item(const TJob& J, LAS float* scr, int item, int lane) {
    LAS unsigned* s32 = (LAS unsigned*)scr; const LAS unsigned short* s16 = (const LAS unsigned short*)scr;
    const int nblk = J.ncols / 128, kb = item / nblk, nb = item % nblk, k0 = 64 * kb, n0 = 128 * nb;
    const float* src = J.W + (size_t)k0 * J.ldw + J.col0 + n0 + 2 * lane;
    float gv = 1.f; if (J.kg) { const int k = k0 + lane; gv = (J.kg2 && k >= 512) ? J.kg2[k - 512] : J.kg[k]; }
#pragma unroll 16
    for (int kk = 0; kk < 64; ++kk) { f32x2 w = *(const f32x2*)(src + (size_t)kk * J.ldw);
        w = w * __builtin_bit_cast(float, __builtin_amdgcn_readlane(__builtin_bit_cast(int, gv), kk));
        s32[kk * 64 + lane] = pk2(w[0], w[1]); }
    asm volatile("s_waitcnt lgkmcnt(0)" ::: "memory");
    const int c = lane & 7;
#pragma unroll 4
    for (int j = 0; j < 16; ++j) { const int n = (lane >> 3) + 8 * j; const LAS unsigned short* s = s16 + (8 * c) * 128 + n;
        u32x4 o; o.x = (unsigned)s[0] | ((unsigned)s[128] << 16); o.y = (unsigned)s[256] | ((unsigned)s[384] << 16); o.z = (unsigned)s[512] | ((unsigned)s[640] << 16); o.w = (unsigned)s[768] | ((unsigned)s[896] << 16);
        *(u32x4*)(J.WT + (size_t)tmap(J.mapid, n0 + n, J.rowoff) * J.K + k0 + 8 * c) = o; }
    asm volatile("s_waitcnt lgkmcnt(0)" ::: "memory");
}
constexpr int NTJ = 11;
__device__ __forceinline__ void get_tjob(InTab in, unsigned char* ws, int j, TJob& J) {
    J.kg = nullptr; J.kg2 = nullptr; J.mapid = 0; J.rowoff = 0; J.col0 = 0;
    switch (j) {
    case 0: J.W = in[I_W_IN]; J.ldw = INCOLS; J.col0 = 0; J.ncols = 1024; J.K = 1024; J.WT = (bf16_t*)(ws + WS_WIN); J.mapid = 1; break;
    case 1: J.W = in[I_W_IN]; J.ldw = INCOLS; J.col0 = 1024; J.ncols = 512; J.K = 1024; J.WT = (bf16_t*)(ws + WS_WIN); J.rowoff = 1024; break;
    case 2: J.W = in[I_W_IN]; J.ldw = INCOLS; J.col0 = 1544; J.ncols = 512; J.K = 1024; J.WT = (bf16_t*)(ws + WS_WIN); J.rowoff = 1536; break;
    case 3: J.W = in[I_WGLU]; J.ldw = 512; J.ncols = 512; J.K = 512; J.WT = (bf16_t*)(ws + WS_WGLU); break;
    case 4: J.W = in[I_WOUT]; J.ldw = 1024; J.ncols = 1024; J.K = 1024; J.WT = (bf16_t*)(ws + WS_WOUT); J.kg = in[I_ONF]; J.kg2 = in[I_ONS]; break;
    case 5: J.W = in[I_WXQ]; J.ldw = 1024; J.ncols = 1024; J.K = 1024; J.WT = (bf16_t*)(ws + WS_WXQ); J.kg = in[I_NCROSS]; break;
    case 6: J.W = in[I_WXKV]; J.ldw = 2048; J.col0 = 0; J.ncols = 1024; J.K = 1024; J.WT = (bf16_t*)(ws + WS_WXK); break;
    case 7: J.W = in[I_WXKV]; J.ldw = 2048; J.col0 = 1024; J.ncols = 1024; J.K = 1024; J.WT = (bf16_t*)(ws + WS_WXV); break;
    case 8: J.W = in[I_WXO]; J.ldw = 1024; J.ncols = 1024; J.K = 1024; J.WT = (bf16_t*)(ws + WS_WXO); break;
    case 9: J.W = in[I_WUP]; J.ldw = 2 * DFF; J.ncols = 2 * DFF; J.K = 1024; J.WT = (bf16_t*)(ws + WS_WUP); J.kg = in[I_NFFN]; J.mapid = 2; break;
    default: J.W = in[I_WDN]; J.ldw = 1024; J.ncols = 1024; J.K = DFF; J.WT = (bf16_t*)(ws + WS_WDN); break;
    }
    J.items = (J.K / 64) * (J.ncols / 128);
}

__device__ __forceinline__ void rms_row(const float* xrow, const float* gain, bf16_t* orow, int lane, f32x4 (&v)[4]) {
    const f32x4* xr = (const f32x4*)xrow + lane; float s = 0.f;
#pragma unroll
    for (int j = 0; j < 4; ++j) { v[j] = xr[64 * j]; s += (v[j][0] * v[j][0] + v[j][1] * v[j][1]) + (v[j][2] * v[j][2] + v[j][3] * v[j][3]); }
    const float rs = rsqrtf(wave_sum(s) * (1.f / DM) + EPS);
    u32x2* o8 = (u32x2*)orow + lane;
#pragma unroll
    for (int j = 0; j < 4; ++j) { v[j] = v[j] * rs * ((const f32x4*)gain)[64 * j + lane]; u32x2 w; w.x = pk2(v[j][0], v[j][1]); w.y = pk2(v[j][2], v[j][3]); o8[64 * j] = w; }
}

__device__ __forceinline__ void cpow(float ar, float ai, float dt, float e, float& r, float& i) {
    const float mag = __expf(ar * dt * e);
    float rev = ai * dt * e * 0.15915494309189535f; rev -= rintf(rev);
    const float ang = rev * 6.283185307179586f;
    r = mag * cosf(ang); i = mag * sinf(ang);
}

template <int NT>
__device__ __forceinline__ void s5_prep_task(InTab in, unsigned char* ws, int g, int tt, LAS float* L, int tid, bool valid) {
    LAS float* pwA = L; LAS float* pwB = L + 128; LAS float* pwC = L + 256; LAS float* cf = L + 384; LAS float* bb = L + 512; LAS float* cc = L + 512 + 2048;
    if (valid) {
        const float dt = __expf(in[I_LOGDT][g]);
        if (tid < 64) { const int p = tid; const float ar = in[I_ARE][g * 64 + p], ai = in[I_AIM][g * 64 + p];
            float r, i; cpow(ar, ai, dt, (float)tt, r, i); pwA[2 * p] = r; pwA[2 * p + 1] = i;
            cpow(ar, ai, dt, (float)(tt + 1), r, i); pwB[2 * p] = r; pwB[2 * p + 1] = i;
            cpow(ar, ai, dt, (float)(TC - 1 - tt), r, i); pwC[2 * p] = r; pwC[2 * p + 1] = i;
            float lr, li; cpow(ar, ai, dt, 1.f, lr, li);
            const float den = ar * ar + ai * ai, nr = lr - 1.f;
            cf[2 * p] = (nr * ar + li * ai) / den; cf[2 * p + 1] = (li * ar - nr * ai) / den;
            if (tt == 0) { cpow(ar, ai, dt, (float)TC, r, i); float* lb = (float*)(ws + WS_LB32); lb[(g * 64 + p) * 2] = r; lb[(g * 64 + p) * 2 + 1] = i; } }
        for (int idx = tid; idx < 1024; idx += NT) { cc[2 * idx] = in[I_CRE][g * 1024 + idx]; cc[2 * idx + 1] = in[I_CIM][g * 1024 + idx]; }
    }
    __syncthreads();
    if (valid)
        for (int idx = tid; idx < 1024; idx += NT) { const int p = idx >> 4; const float br = in[I_BRE][g * 1024 + idx], bi = in[I_BIM][g * 1024 + idx], cr = cf[2 * p], ci = cf[2 * p + 1];
            bb[2 * idx] = cr * br - ci * bi; bb[2 * idx + 1] = cr * bi + ci * br; }
    __syncthreads();
    if (valid) {
        for (int e = tid; e < 256; e += NT) {
            const int c = e >> 4, cp = e & 15; float s = 0.f;
            for (int p = 0; p < 64; ++p) { const float pr = pwA[2 * p], pi = pwA[2 * p + 1], br = bb[2 * (p * 16 + cp)], bi = bb[2 * (p * 16 + cp) + 1];
                const float mr = pr * br - pi * bi, mi = pr * bi + pi * br; s += cc[2 * (c * 64 + p)] * mr - cc[2 * (c * 64 + p) + 1] * mi; }
            if (tt == 0 && c == cp) s += in[I_D][g * 16 + c];
            ((float*)(ws + WS_KTAB))[((g * TC + tt) * 16 + c) * 16 + cp] = s; }
        bf16_t* bty = (bf16_t*)(ws + WS_BTY) + (size_t)g * 512 * UGP; bf16_t* bte = (bf16_t*)(ws + WS_BTE) + (size_t)g * 256 * 512;
        for (int idx = tid; idx < 1024; idx += NT) { const int c = idx >> 6, p = idx & 63;
            const float cr = cc[2 * idx], ci = cc[2 * idx + 1], pr = pwB[2 * p], pi = pwB[2 * p + 1];
            const float zr = cr * pr - ci * pi, zi = cr * pi + ci * pr;
            *(unsigned*)(bty + (size_t)(tt * 16 + c) * UGP + 512 + 2 * p) = pk2(zr, -zi); }
        for (int idx = tid; idx < 1024; idx += NT) { const int p = idx >> 4, cp = idx & 15;
            const float pr = pwC[2 * p], pi = pwC[2 * p + 1], br = bb[2 * idx], bi = bb[2 * idx + 1];
            bte[(size_t)(2 * p) * 512 + tt * 16 + cp] = (bf16_t)f2bf(pr * br - pi * bi); bte[(size_t)(2 * p + 1) * 512 + tt * 16 + cp] = (bf16_t)f2bf(pr * bi + pi * br); }
        for (int u = tid; u < 256; u += NT) *(u32x4*)(bte + (size_t)(128 + (u >> 1)) * 512 + tt * 16 + (u & 1) * 8) = (u32x4){0u, 0u, 0u, 0u};
    }
    __syncthreads();
}

#define RLX_AGENT __ATOMIC_RELAXED, __HIP_MEMORY_SCOPE_AGENT
#define XB_TMO      128
#define XB_XCNT(j)  (256  + 64 * (j))
#define XB_XSUB(j)  (1280 + 64 * (j))
#define XB_XGEN(j)  (2304 + 64 * (j))
#define XB_TOP      3328
#define XB_TOPGEN   3392
#define XCD_BAR_WORDS 3456
#define XB_SPIN_CAP (1u << 18)

__device__ __forceinline__ unsigned xb_ld(unsigned* p)              { return __hip_atomic_load(p, __ATOMIC_RELAXED, __HIP_MEMORY_SCOPE_AGENT); }
__device__ __forceinline__ unsigned xb_add(unsigned* p, unsigned v) { return __hip_atomic_fetch_add(p, v, __ATOMIC_RELAXED, __HIP_MEMORY_SCOPE_AGENT); }
__device__ __forceinline__ unsigned xb_xcc_id() { return (unsigned)__builtin_amdgcn_s_getreg((3 << 11) | 20) & 0xFu; }
#define XB_SPIN(cond, bar) do { unsigned _sp = 0; while (cond) { __builtin_amdgcn_s_sleep(1); \
    if ((++_sp & 255u) == 0u) { if (xb_ld(&(bar)[XB_TMO])) break; if (_sp > XB_SPIN_CAP) { atomicAdd(&(bar)[XB_TMO], 1u); break; } } } } while (0)

struct XcdBarrier {
    unsigned* bar; unsigned x;
    volatile LAS unsigned* st;
};

__device__ __forceinline__ XcdBarrier xcd_barrier_post(unsigned* bar, volatile LAS unsigned* st) {
    XcdBarrier b; b.bar = bar; b.x = xb_xcc_id(); b.st = st;
    if (threadIdx.x == 0) (void)xb_add(&bar[XB_XCNT(b.x)], 1u);
    return b;
}
__device__ __forceinline__ void xcd_barrier_complete(unsigned* bar, unsigned x, unsigned& nloc, unsigned& nx) {
    const unsigned G = gridDim.x * gridDim.y * gridDim.z;
    unsigned sum, cnt, mine, sp = 0u;
    for (;;) {
        sum = 0u; cnt = 0u; mine = 0u;
#pragma unroll
        for (unsigned j = 0; j < 16; ++j) { const unsigned c = xb_ld(&bar[XB_XCNT(j)]); sum += c; cnt += (c > 0u) ? 1u : 0u; mine = (j == x) ? c : mine; }
        if (sum == G) break;
        __builtin_amdgcn_s_sleep(1);
        if ((++sp & 255u) == 0u) { if (xb_ld(&bar[XB_TMO])) break; if (sp > XB_SPIN_CAP) { atomicAdd(&bar[XB_TMO], 1u); break; } }
    }
    nloc = mine > 0u ? mine : 1u; nx = cnt > 0u ? cnt : 1u;
}

__device__ __forceinline__ void xcd_barrier(const XcdBarrier& b) {
    asm volatile("s_waitcnt vmcnt(0)" ::: "memory");
    __syncthreads();
    if (threadIdx.x == 0) {
        unsigned* bar = b.bar;
        __builtin_amdgcn_s_waitcnt(0);
        unsigned nloc = b.st[0], nx = b.st[1];
        if (nloc == 0u) { xcd_barrier_complete(bar, b.x, nloc, nx); b.st[0] = nloc; b.st[1] = nx; }
        const unsigned old = xb_add(&bar[XB_XSUB(b.x)], 1u);
        const unsigned gen = old / nloc;
        if (old + 1u == (gen + 1u) * nloc) {
            __builtin_amdgcn_fence(__ATOMIC_RELEASE, "agent");
            asm volatile("s_waitcnt vmcnt(0)" ::: "memory");
            const unsigned og = xb_add(&bar[XB_TOP], 1u);
            const unsigned tg = og / nx;
            if (og + 1u == (tg + 1u) * nx) xb_add(&bar[XB_TOPGEN], 1u);
            else XB_SPIN(xb_ld(&bar[XB_TOPGEN]) == tg, bar);
            __builtin_amdgcn_fence(__ATOMIC_ACQUIRE, "agent");
            xb_add(&bar[XB_XGEN(b.x)], 1u);
            asm volatile("s_waitcnt vmcnt(0)" ::: "memory");
        } else {
            XB_SPIN(xb_ld(&bar[XB_XGEN(b.x)]) == gen, bar);
            __builtin_amdgcn_fence(__ATOMIC_ACQUIRE, "agent");
            asm volatile("s_waitcnt vmcnt(0)" ::: "memory");
        }
    }
    __syncthreads();
}


#ifndef FIRST_STEP
#define FIRST_STEP 0
#endif
#ifndef LAST_STEP
#define LAST_STEP 18
#endif
#define ON(n) (FIRST_STEP <= (n) && (n) <= LAST_STEP)
#define SYNC(n) do { if ((n) < LAST_STEP) { XcdBarrier bar_; bar_.bar = (unsigned*)ws; bar_.x = xb_xcc_id(); bar_.st = (volatile LAS unsigned*)(L + RING_BYTES + 352); xcd_barrier(bar_); } } while (0)
#define WSB(off) ((const bf16_t*)(ws + (off)))
__global__ void __launch_bounds__(512, 2) fox_s5_mega(Args a) {
    extern __shared__ __attribute__((aligned(16))) unsigned char lds[];
    LAS unsigned char* L = (LAS unsigned char*)lds;
    const int G = gridDim.x, bx = blockIdx.x, NGW = G * 8, NGT = G * 512;
#define KA const __attribute__((address_space(4))) unsigned char* ka_ = (const __attribute__((address_space(4))) unsigned char*)__builtin_amdgcn_kernarg_segment_ptr(); asm volatile("" : "+s"(ka_)); \
    InTab in = (InTab)ka_; float* out = *(float* const __attribute__((address_space(4)))*)(ka_ + 256); unsigned char* ws = *(unsigned char* const __attribute__((address_space(4)))*)(ka_ + 264); (void)in; (void)out;
#define IDS int tid = threadIdx.x; asm volatile("" : "+v"(tid)); const int lane = tid & 63, wave = __builtin_amdgcn_readfirstlane(tid >> 6); const int gw = bx * 8 + wave, gt = bx * 512 + tid; (void)lane; (void)gw; (void)gt;
    {
        KA
        if (threadIdx.x < 8) ((volatile LAS unsigned*)(L + RING_BYTES + 320))[threadIdx.x + 8 - 8] = 0u;
        if (threadIdx.x < 2) ((volatile LAS unsigned*)(L + RING_BYTES + 352))[threadIdx.x] = 0u;
        __syncthreads();
        (void)xcd_barrier_post((unsigned*)ws, (volatile LAS unsigned*)(L + RING_BYTES + 352));
    }

    if (ON(0)) {
        KA
        IDS
        LAS float* scr = (LAS float*)(L + wave * 16384);
        { int base = 0;
          for (int j = 0; j < NTJ; ++j) { TJob J; get_tjob(in, ws, j, J);
              int first = gw - (base % NGW); if (first < 0) first += NGW;
              for (int it = first; it < J.items; it += NGW) transpose_item(J, scr, it, lane);
              base += J.items; } }
        __syncthreads();
        LAS float* wf = (LAS float*)L;
        for (int idx = tid; idx < 8192; idx += 512) wf[idx] = in[I_W_IN][(size_t)(idx >> 3) * INCOLS + 1536 + (idx & 7)];
        __syncthreads();
        {
            f32x4 nx[4];
            if (gw < T) { const f32x4* xr = (const f32x4*)(in[I_X] + (size_t)gw * DM) + lane;
#pragma unroll
                for (int j = 0; j < 4; ++j) nx[j] = xr[64 * j]; }
            const f32x4* gp = (const f32x4*)in[I_NORM_MIX]; f32x4 gn[4];
#pragma unroll
            for (int j = 0; j < 4; ++j) gn[j] = gp[64 * j + lane];
            const float fbias = in[I_FBIAS][lane & 7];
            for (int m = gw; m < T; m += NGW) {
                f32x4 v[4]; float s = 0.f;
#pragma unroll
                for (int j = 0; j < 4; ++j) { v[j] = nx[j]; s += (v[j][0] * v[j][0] + v[j][1] * v[j][1]) + (v[j][2] * v[j][2] + v[j][3] * v[j][3]); }
                if (m + NGW < T) { const f32x4* xr = (const f32x4*)(in[I_X] + (size_t)(m + NGW) * DM) + lane;
#pragma unroll
                    for (int j = 0; j < 4; ++j) nx[j] = xr[64 * j]; }
                const float rs = rsqrtf(wave_sum(s) * (1.f / DM) + EPS);
                u32x2* o8 = (u32x2*)((bf16_t*)(ws + WS_HN) + (size_t)m * DM) + lane;
#pragma unroll
                for (int j = 0; j < 4; ++j) { v[j] = v[j] * rs * gn[j]; u32x2 w; w.x = pk2(v[j][0], v[j][1]); w.y = pk2(v[j][2], v[j][3]); o8[64 * j] = w; }
                float d[8];
#pragma unroll
                for (int h = 0; h < 8; ++h) d[h] = 0.f;
#pragma unroll
                for (int j = 0; j < 4; ++j)
#pragma unroll
                    for (int i = 0; i < 4; ++i) { const int k = 256 * j + 4 * lane + i; const f32x4 w0 = *(const LAS f32x4*)(wf + k * 8), w1 = *(const LAS f32x4*)(wf + k * 8 + 4);
                        d[0] += v[j][i] * w0[0]; d[1] += v[j][i] * w0[1]; d[2] += v[j][i] * w0[2]; d[3] += v[j][i] * w0[3];
                        d[4] += v[j][i] * w1[0]; d[5] += v[j][i] * w1[1]; d[6] += v[j][i] * w1[2]; d[7] += v[j][i] * w1[3]; }
                float e4[4];
#pragma unroll
                for (int h = 0; h < 4; ++h) { const float keep = (lane & 4) ? d[h + 4] : d[h], give = (lane & 4) ? d[h] : d[h + 4]; e4[h] = keep + __shfl_xor(give, 4); }
                float e2[2];
#pragma unroll
                for (int h = 0; h < 2; ++h) { const float keep = (lane & 2) ? e4[h + 2] : e4[h], give = (lane & 2) ? e4[h] : e4[h + 2]; e2[h] = keep + __shfl_xor(give, 2); }
                float z; { const float keep = (lane & 1) ? e2[1] : e2[0], give = (lane & 1) ? e2[0] : e2[1]; z = keep + __shfl_xor(give, 1); }
                z += __shfl_xor(z, 8); z += __shfl_xor(z, 16); z += __shfl_xor(z, 32);
                if (lane < 8) {
                    z += fbias;
                    const float ls = fminf(z, 0.f) - __logf(1.f + __expf(-fabsf(z)));
                    const int b = m >> 11, t = m & 2047;
                    ((float*)(ws + WS_LOGF))[(size_t)(b * 8 + lane) * SEQ + t] = ls; }
            }
        }
        for (int m = gw; m < TM; m += NGW) { f32x4 v[4]; rms_row(in[I_MEM] + (size_t)m * DM, in[I_NMEM], (bf16_t*)(ws + WS_MN) + (size_t)m * DM, lane, v); }
        __syncthreads();
        {
            const int NTASK = S5G * TC, sub = tid >> 7, ltid = tid & 127, per = NTASK / G;
            for (int i0 = 0; bx + i0 * G < NTASK; i0 += 4) { const int task = bx + (i0 + sub) * G; const bool valid = task < NTASK;
                const int t2 = !valid ? 0 : ((NTASK % G == 0) ? (task % G) * per + task / G : task);
                s5_prep_task<128>(in, ws, t2 / TC, t2 % TC, (LAS float*)L + sub * 5120, ltid, valid); }
        }
        SYNC(0);
    }
    if (ON(1)) {
        KA
        IDS
        const float* kt = (const float*)(ws + WS_KTAB); bf16_t* bty = (bf16_t*)(ws + WS_BTY);
        for (int idx = gt; idx < S5G * 512 * 64; idx += NGT) {
            const int half = idx & 1, ss = (idx >> 1) & 31, nn = (idx >> 6) & 511, gI = idx >> 15; const int tt = nn >> 4, c = nn & 15;
            u32x4 w = (u32x4){0u, 0u, 0u, 0u};
            if (ss <= tt) { const float* src = kt + ((size_t)((gI * TC + (tt - ss)) * 16 + c)) * 16 + half * 8; const f32x4 k0 = *(const f32x4*)src, k1 = *(const f32x4*)(src + 4);
                w.x = pk2(k0[0], k0[1]); w.y = pk2(k0[2], k0[3]); w.z = pk2(k1[0], k1[1]); w.w = pk2(k1[2], k1[3]); }
            *(u32x4*)(bty + ((size_t)gI * 512 + nn) * UGP + ss * 16 + half * 8) = w; }
        if (wave == 0 && bx < BATCH * NFH) {
            const float* lf = (const float*)(ws + WS_LOGF) + (size_t)bx * SEQ + lane * 32; float* cb = (float*)(ws + WS_CB) + (size_t)bx * SEQ + lane * 32;
            f32x4 x[8]; float run = 0.f;
#pragma unroll
            for (int j = 0; j < 8; ++j) { x[j] = ((const f32x4*)lf)[j]; x[j][0] += run; x[j][1] += x[j][0]; x[j][2] += x[j][1]; x[j][3] += x[j][2]; run = x[j][3]; }
            float incl = run;
#pragma unroll
            for (int o = 1; o < 64; o <<= 1) { const float y = __shfl_up(incl, o); if (lane >= o) incl += y; }
            const float excl = incl - run;
#pragma unroll
            for (int j = 0; j < 8; ++j) ((f32x4*)cb)[j] = (x[j] + excl) * LOG2E;
        }
    }
    if (ON(2)) {
        KA
        pg8::Gemm g{WSB(WS_HN), WSB(WS_WIN), DM, DM, DM}; GOrder<OK_PLAIN> S; S.init(T / 256, 8, G, bx, DM, DM);
        Epi<EK_PROJ> E{ws + WS_Q, ws + WS_K, ws + WS_V, ws + WS_UG, in[I_FQN], in[I_FKN], nullptr};
        pg8::gemm_phase(L, g, S, E);
    }
    if (ON(3)) {
        KA
        pg8::Gemm g{WSB(WS_MN), WSB(WS_WXK), DM, DM, DM}; GOrder<OK_PLAIN> S; S.init(TM / 256, 4, G, bx, DM, DM);
        Epi<EK_MEMK> E{ws + WS_KST, ws + WS_SSQK, nullptr, nullptr, nullptr, nullptr, nullptr};
        pg8::gemm_phase(L, g, S, E);
    }
    if (ON(4)) {
        KA
        pg8::Gemm g{WSB(WS_WXV), WSB(WS_MN), DM, DM, DM}; GOrder<OK_PLAIN> S; S.init(4, TM / 256, G, (bx + 128) % G, DM, DM);
        Epi<EK_MEMVT> E{ws + WS_VT, nullptr, nullptr, nullptr, nullptr, nullptr, nullptr};
        pg8::gemm_phase(L, g, S, E);
        SYNC(4);
    }
    if (ON(5)) {
        KA
        const int vcu = (G % 8 == 0) ? (bx % 8) * (G / 8) + bx / 8 : bx;
        float skip_th; { const int ln = threadIdx.x & 63; float gq = fabsf(in[I_FQN][ln]), gk = fabsf(in[I_FKN][ln]);
#pragma unroll
            for (int o = 1; o < 64; o <<= 1) { gq = fmaxf(gq, __shfl_xor(gq, o)); gk = fmaxf(gk, __shfl_xor(gk, o)); }
            skip_th = 2.f * (64.f * C2Q * gq * gk) + 40.f; }
        for (int L2 = vcu; L2 < BATCH * NFH * 2; L2 += G) { const int bh = L2 >> 1, s = L2 & 1;
            for (int i = 0; i < 4; ++i) { const int qb = (i == 0) ? s : (i == 1) ? 3 - s : (i == 2) ? 4 + s : 7 - s;
                attn_body::attn_unit<8>(bh >> 3, bh & 7, qb, (const attn_body::bf16*)(ws + WS_Q), (const attn_body::bf16*)(ws + WS_K), (const attn_body::bf16*)(ws + WS_V),
                                        (attn_body::bf16*)(ws + WS_FOX), (const float*)(ws + WS_CB), (float*)(ws + WS_SSQF), (char*)lds, skip_th); } }
    }
    if (ON(6)) {
        KA
        pg8::Gemm g{WSB(WS_UG), WSB(WS_BTE), UGP, 512, 256}; GOrder<OK_S5E> S; S.init(256, 1, G, bx, UGP, 512);
        Epi<EK_S5E> E{ws + WS_EPART, nullptr, nullptr, nullptr, nullptr, nullptr, nullptr};
        pg8::gemm_phase(L, g, S, E);
        SYNC(6);
    }
    if (ON(7)) {
        KA
        IDS
        const float* ep = (const float*)(ws + WS_EPART); const float* lb = (const float*)(ws + WS_LB32); bf16_t* ug = (bf16_t*)(ws + WS_UG);
        for (int idx = gt; idx < S5G * BATCH * S5P; idx += NGT) { const int p = idx & 63, gb = idx >> 6, gI = gb >> 4;
            const float lr = lb[(gI * 64 + p) * 2], li = lb[(gI * 64 + p) * 2 + 1]; float sr = 0.f, si = 0.f;
            for (int k0 = 0; k0 < NCH; k0 += 16) {
                f32x2 e0[16], e1[16];
#pragma unroll
                for (int j = 0; j < 16; ++j) { const size_t row = (size_t)gb * NCH + k0 + j; e0[j] = *(const f32x2*)(ep + row * 128 + 2 * p); e1[j] = *(const f32x2*)(ep + (size_t)32768 * 128 + row * 128 + 2 * p); }
#pragma unroll
                for (int j = 0; j < 16; ++j) { const size_t row = (size_t)gb * NCH + k0 + j;
                    *(unsigned*)(ug + row * UGP + 512 + 2 * p) = pk2(sr, si);
                    const float nr = lr * sr - li * si + (e0[j][0] + e1[j][0]), ni = lr * si + li * sr + (e0[j][1] + e1[j][1]); sr = nr; si = ni; } } }
        SYNC(7);
    }
    if (ON(8)) {
        KA
        pg8::Gemm g{WSB(WS_UG), WSB(WS_BTY), UGP, UGP, UGP}; GOrder<OK_S5Y> S; S.init(256, 1, G, bx, UGP, UGP);
        Epi<EK_S5Y> E{ws + WS_Y1, nullptr, nullptr, nullptr, nullptr, nullptr, nullptr};
        pg8::gemm_phase(L, g, S, E);
        SYNC(8);
    }
    if (ON(9)) {
        KA
        pg8::Gemm g{WSB(WS_Y1), WSB(WS_WGLU), 512, 512, 512}; GOrder<OK_PLAIN> S; S.init(T / 256, 2, G, bx, 512, 512);
        Epi<EK_GLU> E{ws + WS_Y2, ws + WS_SSQY, nullptr, nullptr, ws + WS_Y1, in[I_BGLU], nullptr};
        pg8::gemm_phase(L, g, S, E);
        SYNC(9);
    }
    if (ON(10)) {
        KA
        IDS
        const float* sf = (const float*)(ws + WS_SSQF); const float* sy = (const float*)(ws + WS_SSQY);
        const bf16_t* fox = WSB(WS_FOX); const bf16_t* y2 = WSB(WS_Y2); bf16_t* mx = (bf16_t*)(ws + WS_MIXN);
        {
            f32x4 a0, a1, b0, b1; u32x4 f, y;
#define NRM_LOAD(mm) do { a0 = *(const f32x4*)(sf + (size_t)(mm) * 8); a1 = *(const f32x4*)(sf + (size_t)(mm) * 8 + 4); b0 = *(const f32x4*)(sy + (size_t)(mm) * 8); b1 = *(const f32x4*)(sy + (size_t)(mm) * 8 + 4); \
                f = *(const u32x4*)(fox + (size_t)(mm) * 512 + lane * 8); y = *(const u32x4*)(y2 + (size_t)(mm) * 512 + lane * 8); } while (0)
            if (gw < T) NRM_LOAD(gw);
            for (int m = gw; m < T; m += NGW) {
                const float rf = rsqrtf((((a0[0] + a0[1]) + (a0[2] + a0[3])) + ((a1[0] + a1[1]) + (a1[2] + a1[3]))) * (1.f / 512.f) + EPS);
                const float ry = rsqrtf((((b0[0] + b0[1]) + (b0[2] + b0[3])) + ((b1[0] + b1[1]) + (b1[2] + b1[3]))) * (1.f / 512.f) + EPS);
                u32x4 of, oy;
                of.x = pk2(bflo(f.x) * rf, bfhi(f.x) * rf); of.y = pk2(bflo(f.y) * rf, bfhi(f.y) * rf); of.z = pk2(bflo(f.z) * rf, bfhi(f.z) * rf); of.w = pk2(bflo(f.w) * rf, bfhi(f.w) * rf);
                oy.x = pk2(bflo(y.x) * ry, bfhi(y.x) * ry); oy.y = pk2(bflo(y.y) * ry, bfhi(y.y) * ry); oy.z = pk2(bflo(y.z) * ry, bfhi(y.z) * ry); oy.w = pk2(bflo(y.w) * ry, bfhi(y.w) * ry);
                if (m + NGW < T) NRM_LOAD(m + NGW);
                *(u32x4*)(mx + (size_t)m * DM + lane * 8) = of; *(u32x4*)(mx + (size_t)m * DM + 512 + lane * 8) = oy; }
#undef NRM_LOAD
        }
        SYNC(10);
    }
    if (ON(11)) {
        KA
        pg8::Gemm g{WSB(WS_MIXN), WSB(WS_WOUT), DM, DM, DM}; GOrder<OK_PLAIN> S; S.init(T / 256, 4, G, bx, DM, DM);
        Epi<EK_WOUT> E{out, ws + WS_H1B, ws + WS_SSQ1, nullptr, in[I_X], nullptr, nullptr};
        pg8::gemm_phase(L, g, S, E);
        SYNC(11);
    }
    if (ON(12)) {
        KA
        IDS
        const float* sk = (const float*)(ws + WS_SSQK); float* sck = (float*)(ws + WS_SCK);
        for (int idx = gt; idx < TM * 4; idx += NGT) { const int key = idx >> 2, h = idx & 3; const f32x4 q = *(const f32x4*)(sk + (size_t)key * 16 + h * 4);
            sck[(size_t)h * TM + key] = rsqrtf(((q[0] + q[1]) + (q[2] + q[3])) * (1.f / 256.f) + EPS); }
        pg8::Gemm g{WSB(WS_H1B), WSB(WS_WXQ), DM, DM, DM}; GOrder<OK_PLAIN> S; S.init(T / 256, 4, G, bx, DM, DM);
        Epi<EK_XQ> E{ws + WS_QST, ws + WS_SSQQ, nullptr, nullptr, in[I_XQN], in[I_XKN], nullptr};
        pg8::gemm_phase(L, g, S, E);
        SYNC(12);
    }
    if (ON(13)) {
        KA
        pg8::Gemm g{WSB(WS_QST), WSB(WS_KST), DM, DM, 256}; GOrder<OK_XS> S; S.init(512, 1, G, bx, DM, DM);
        Epi<EK_XS> E{ws + WS_P, ws + WS_PSUM, nullptr, nullptr, ws + WS_SSQ1, ws + WS_SSQQ, ws + WS_SCK};
        pg8::gemm_phase(L, g, S, E);
        SYNC(13);
    }
    if (ON(14)) {
        KA
        pg8::Gemm g{WSB(WS_P), WSB(WS_VT), DM, TM, 256}; GOrder<OK_XO> S; S.init(512, 1, G, bx, DM, TM);
        Epi<EK_XO> E{ws + WS_XO, nullptr, nullptr, nullptr, ws + WS_PSUM, nullptr, nullptr};
        pg8::gemm_phase(L, g, S, E);
        SYNC(14);
    }
    if (ON(15)) {
        KA
        pg8::Gemm g{WSB(WS_XO), WSB(WS_WXO), DM, DM, DM}; GOrder<OK_PLAIN> S; S.init(T / 256, 4, G, bx, DM, DM);
        Epi<EK_WXO> E{out, ws + WS_H2B, ws + WS_SSQ2, nullptr, out, nullptr, nullptr};
        pg8::gemm_phase(L, g, S, E);
        SYNC(15);
    }
    if (ON(16)) {
        KA
        { IDS
          const float* s2 = (const float*)(ws + WS_SSQ2); float* r2 = (float*)(ws + WS_RS2);
          for (int row = gt; row < T; row += NGT) { const f32x4 t0 = *(const f32x4*)(s2 + (size_t)row * 16), t1 = *(const f32x4*)(s2 + (size_t)row * 16 + 4), t2 = *(const f32x4*)(s2 + (size_t)row * 16 + 8), t3 = *(const f32x4*)(s2 + (size_t)row * 16 + 12);
              r2[row] = rsqrtf((((t0[0] + t0[1]) + (t0[2] + t0[3])) + ((t1[0] + t1[1]) + (t1[2] + t1[3])) + ((t2[0] + t2[1]) + (t2[2] + t2[3])) + ((t3[0] + t3[1]) + (t3[2] + t3[3]))) * (1.f / DM) + EPS); }
          SYNC(15); }
        pg8::Gemm g{WSB(WS_H2B), WSB(WS_WUP), DM, DM, DM}; GOrder<OK_PLAIN> S; S.init(T / 256, 22, G, bx, DM, DM);
        Epi<EK_UPC> E{ws + WS_U, ws + WS_G, ws + WS_G + 4 * MiB, ws + WS_G + 8 * MiB, ws + WS_RS2, in[I_CONVW], in[I_CONVB], (LAS float*)(L + RING_BYTES + 1024)};
        pg8::gemm_phase(L, g, S, E);
        SYNC(16);
    }
    if (ON(17)) {
        KA
        IDS
        const float* GHF = (const float*)(ws + WS_G); const float* GHL = (const float*)(ws + WS_G + 4 * MiB); const float* UH = (const float*)(ws + WS_G + 8 * MiB);
        const float* cw = in[I_CONVW]; const float* cbv = in[I_CONVB]; bf16_t* A = (bf16_t*)(ws + WS_U);
        for (int idx = gt; idx < (T / 256) * 2 * DFF; idx += NGT) { const int j = idx % DFF, pi = idx / DFF, i = pi & 1, pm = pi >> 1; const bool first = (pm & 7) == 0;
            const float g0 = GHF[(size_t)pi * DFF + j];
            const float gl1 = first ? 0.f : GHL[((size_t)(pm - 1) * 2 + 1) * DFF + j], gl0 = first ? 0.f : GHL[((size_t)(pm - 1) * 2) * DFF + j];
            const float g1 = i ? GHF[(size_t)(pm * 2) * DFF + j] : gl1, g2 = i ? gl1 : gl0;
            const float z = cbv[j] + cw[j] * g2 + cw[DFF + j] * g1 + cw[2 * DFF + j] * g0;
            A[(size_t)(pm * 256 + i) * DFF + j] = (bf16_t)f2bf(z * sigm(z) * UH[(size_t)pi * DFF + j]); }
        SYNC(17);
    }
    if (ON(18)) {
        KA
        pg8::Gemm g{WSB(WS_U), WSB(WS_WDN), DFF, DFF, DFF}; GOrder<OK_PLAIN> S; S.init(T / 256, 4, G, bx, DFF, DFF);
        Epi<EK_DOWN> E{out, nullptr, nullptr, nullptr, nullptr, nullptr, nullptr};
        pg8::gemm_phase(L, g, S, E);
    }
}

extern "C" void kernel_launch(void* const* d_in, const int* in_sizes, int n_in, void* d_out, int out_size, void* d_ws, size_t ws_size, hipStream_t stream) {
    static int grid = 0;
    if (grid == 0) {
        if (n_in != 32 || out_size != T * DM || ws_size < WS_END) { fprintf(stderr, "kernel_launch: unexpected shapes (n_in %d out %d ws %zu)\n", n_in, out_size, ws_size); grid = -1; return; }
        int dev = 0, cus = 0, per_cu = 0;
        (void)hipGetDevice(&dev); (void)hipDeviceGetAttribute(&cus, hipDeviceAttributeMultiprocessorCount, dev);
        if (hipFuncSetAttribute((const void*)fox_s5_mega, hipFuncAttributeMaxDynamicSharedMemorySize, LDS_TOTAL) != hipSuccess) { fprintf(stderr, "kernel_launch: hipFuncSetAttribute failed\n"); grid = -1; return; }
        if (hipOccupancyMaxActiveBlocksPerMultiprocessor(&per_cu, (const void*)fox_s5_mega, 512, LDS_TOTAL) != hipSuccess || per_cu < 1) { fprintf(stderr, "kernel_launch: occupancy query says %d\n", per_cu); per_cu = 1; }
        (void)hipGetLastError();
        grid = cus;
        if (grid > cus * per_cu) grid = cus * per_cu;
    }
    if (grid < 0) return;
    if (hipMemsetAsync(d_ws, 0, 65536, stream) != hipSuccess) { fprintf(stderr, "kernel_launch: memset of the barrier words failed\n"); return; }
    Args a{};
    for (int i = 0; i < 32; ++i) a.in[i] = (const float*)d_in[i];
    a.out = (float*)d_out; a.ws = (unsigned char*)d_ws;
    void* args[] = {&a};
    hipError_t e = hipLaunchCooperativeKernel((const void*)fox_s5_mega, dim3(grid), dim3(512), args, LDS_TOTAL, stream);
    if (e != hipSuccess) fprintf(stderr, "cooperative launch failed: %s (grid %d)\n", hipGetErrorString(e), grid);
}
```

```cpp
#include <hip/hip_runtime.h>
#include <hip/hip_bf16.h>
#include <cstdio>
#include <cstdint>
#include <cmath>

constexpr int BATCH = 16, SEQ = 2048, DM = 1024, T = BATCH * SEQ;
constexpr int NMEM = 256, TM = BATCH * NMEM;
constexpr int FOXW = 512, HD = 64, NFH = 8;
constexpr int S5W = 512, S5G = 32, S5C = 16, S5P = 64;
constexpr int NXH = 4, XHD = 256;
constexpr int DFF = 2816;
constexpr int INCOLS = 2056;
constexpr float EPS = 1e-6f;
constexpr int TC = 32, NCH = SEQ / TC;
constexpr int UGP = TC * 16 + 128;
constexpr float LOG2E = 1.4426950408889634f;
constexpr float C2Q = 0.125f * LOG2E;

#define LAS __attribute__((address_space(3)))
typedef unsigned short bf16_t;
typedef short bf16x8 __attribute__((ext_vector_type(8)));
typedef float f32x4 __attribute__((ext_vector_type(4)));
typedef float f32x2 __attribute__((ext_vector_type(2)));
typedef unsigned u32x4 __attribute__((ext_vector_type(4)));
typedef unsigned u32x2 __attribute__((ext_vector_type(2)));

__device__ __forceinline__ unsigned f2bf(float f) { unsigned u = __builtin_bit_cast(unsigned, f); return (u + 0x7fffu + ((u >> 16) & 1u)) >> 16; }
typedef __bf16 bf16x2_hw __attribute__((ext_vector_type(2)));
__device__ __forceinline__ unsigned pk2(float lo, float hi) { f32x2 v = {lo, hi}; bf16x2_hw b = __builtin_convertvector(v, bf16x2_hw); return __builtin_bit_cast(unsigned, b); }
__device__ __forceinline__ float bflo(unsigned w) { return __builtin_bit_cast(float, w << 16); }
__device__ __forceinline__ float bfhi(unsigned w) { return __builtin_bit_cast(float, w & 0xffff0000u); }
__device__ __forceinline__ float wave_sum(float v) {
#pragma unroll
    for (int o = 1; o < 64; o <<= 1) v += __shfl_xor(v, o);
    return v;
}

__device__ __forceinline__ float red_fq(float v) {
    v += __builtin_bit_cast(float, __builtin_amdgcn_ds_swizzle(__builtin_bit_cast(int, v), 0x401F));
    float a = v, b = v;
    asm volatile("s_nop 1\n\tv_permlane32_swap_b32 %0, %1\n\ts_nop 1" : "+v"(a), "+v"(b));
    return a + b;
}

constexpr size_t MiB = 1u << 20;
constexpr size_t WS_WIN = 1 * MiB, WS_WGLU = 5 * MiB, WS_WOUT = 6 * MiB, WS_WXQ = 8 * MiB, WS_WXK = 10 * MiB, WS_WXV = 12 * MiB, WS_WXO = 14 * MiB,
                 WS_WUP = 16 * MiB, WS_WDN = 27 * MiB, WS_BTY = 33 * MiB, WS_BTE = 53 * MiB, WS_KTAB = 61 * MiB, WS_LB32 = 62 * MiB, WS_LOGF = 63 * MiB,
                 WS_CB = 64 * MiB, WS_SSQF = 65 * MiB, WS_SSQY = 66 * MiB, WS_SSQ1 = 67 * MiB, WS_SSQ2 = 69 * MiB, WS_SSQQ = 71 * MiB, WS_PSUM = 73 * MiB,
                 WS_SSQK = 75 * MiB, WS_SCK = 76 * MiB, WS_RS2 = 77 * MiB;
constexpr size_t WS_HN = 80 * MiB, WS_FOX = 80 * MiB, WS_Y1 = 112 * MiB, WS_QST = 80 * MiB, WS_H2B = 80 * MiB;
constexpr size_t WS_MN = 144 * MiB, WS_KST = 152 * MiB, WS_VT = 160 * MiB;
constexpr size_t WS_Q = 168 * MiB, WS_K = 200 * MiB, WS_V = 232 * MiB, WS_Y2 = 168 * MiB, WS_MIXN = 200 * MiB, WS_P = 168 * MiB;
constexpr size_t WS_UG = 264 * MiB, WS_EPART = 304 * MiB, WS_H1B = 264 * MiB, WS_XO = 264 * MiB;
constexpr size_t WS_G = 144 * MiB, WS_U = 320 * MiB, WS_END = 496 * MiB;

namespace pg8 {
constexpr int BM = 256, BK = 64, HALF = 128, HTB = HALF * BK * 2, STAGE_BYTES = 8 * HTB;
__device__ __forceinline__ int lds_byte(int r, int c) { const int st = (r >> 4) * 2 + (c >> 5), rr = r & 15, cc = c & 31, ob = rr * 64 + cc * 2; return st * 1024 + (ob ^ (((ob >> 9) & 1) << 5)); }
__device__ __forceinline__ void stage_rc(int b, int& R, int& C) { const int st = b / 1024, sb = b % 1024, swz = sb ^ (((sb >> 9) & 1) << 5); R = (st >> 1) * 16 + swz / 64; C = (st & 1) * 32 + (swz % 64) / 2; }
__device__ __forceinline__ int perm32(int rho) { const int n = rho >> 4, i = rho & 15; return 8 * (i >> 2) + 4 * n + (i & 3); }

struct Unit { int pm, pn; long offA, offB; };
struct Gemm { const bf16_t* A; const bf16_t* Bt; int lda, ldb, K; };

template <class Epi, class Sched>
__device__ __forceinline__ void gemm_phase(LAS unsigned char* lds, const Gemm g, const Sched& S, const Epi& E) {
    int tid = threadIdx.x; asm volatile("" : "+v"(tid));
    const int wid = __builtin_amdgcn_readfirstlane(tid >> 6), lane = tid & 63, wr = wid >> 2, wc = wid & 3, fr = lane & 15, fq = lane >> 4;
    const int K = g.K, nt = K / BK;
    unsigned voffA[2], voffB[2];
#pragma unroll
    for (int i = 0; i < 2; ++i) { int R, C; stage_rc(tid * 16 + i * 8192, R, C); const int Rb = (R & ~31) + perm32(R & 31);
        voffA[i] = (unsigned)(R * g.lda + C) * 2u; voffB[i] = (unsigned)(Rb * g.ldb + C) * 2u; }
    const size_t kstep = (size_t)(BK * 2);
    const size_t hstepA = (size_t)HALF * g.lda * 2, hstepB = (size_t)HALF * g.ldb * 2;
    const unsigned ldsw = (unsigned)wid * 1024u;
    const int aoff = lds_byte(wr * 64 + fr, fq * 8), boff = lds_byte(wc * 32 + fr, fq * 8);
#define PG8_SA(b, h) (((b) * 2 + (h)) * HTB)
#define PG8_SB(b, h) ((4 + (b) * 2 + (h)) * HTB)
#define PG8_STAGE(bufoff, gbase, voff) do { _Pragma("unroll") for (int _i = 0; _i < 2; ++_i) \
        __builtin_amdgcn_global_load_lds((const unsigned*)((const char*)(gbase) + (voff)[_i]), (LAS unsigned*)(lds + (bufoff) + ldsw + _i * 8192), 16, 0, 0); } while (0)
#define PG8_LDA(dst, b, h) do { _Pragma("unroll") for (int m = 0; m < 4; ++m) _Pragma("unroll") for (int k = 0; k < 2; ++k) dst[m][k] = *(const LAS bf16x8*)(lds + PG8_SA(b, h) + aoff + m * 2048 + k * 1024); } while (0)
#define PG8_LDB(dst, b, h) do { _Pragma("unroll") for (int n = 0; n < 2; ++n) _Pragma("unroll") for (int k = 0; k < 2; ++k) dst[n][k] = *(const LAS bf16x8*)(lds + PG8_SB(b, h) + boff + n * 2048 + k * 1024); } while (0)
#define PG8_MMA(ai, bj, At, Bt) do { __builtin_amdgcn_s_setprio(1); _Pragma("unroll") for (int m = 0; m < 4; ++m) _Pragma("unroll") for (int n = 0; n < 2; ++n) _Pragma("unroll") for (int k = 0; k < 2; ++k) \
        acc[ai][bj][m][n] = __builtin_amdgcn_mfma_f32_16x16x32_bf16(Bt[n][k], At[m][k], acc[ai][bj][m][n], 0, 0, 0); __builtin_amdgcn_s_setprio(0); } while (0)
#define PG8_WAIT_V(n) asm volatile("s_waitcnt vmcnt(" #n ")" ::: "memory")
#define PG8_WAIT_L(n) asm volatile("s_waitcnt lgkmcnt(" #n ")" ::: "memory")
#define PG8_BAR __builtin_amdgcn_s_barrier()
#define PG8_SCHED __builtin_amdgcn_sched_barrier(0)
    Unit cur, nxt; int ui = 0;
    if (!S.next(0, cur)) return;
    f32x4 acc[2][2][4][2];
#pragma unroll
    for (int a = 0; a < 2; ++a)
#pragma unroll
        for (int b = 0; b < 2; ++b)
#pragma unroll
            for (int m = 0; m < 4; ++m)
#pragma unroll
                for (int n = 0; n < 2; ++n) acc[a][b][m][n] = (f32x4){0.f, 0.f, 0.f, 0.f};
    bf16x8 At[4][2], B0[2][2], B1[2][2];
    const char* cA = (const char*)g.A + cur.offA; const char* cB = (const char*)g.Bt + cur.offB;
    PG8_STAGE(PG8_SB(0, 0), cB, voffB); PG8_STAGE(PG8_SB(0, 1), cB + hstepB, voffB); PG8_STAGE(PG8_SA(0, 0), cA, voffA); PG8_STAGE(PG8_SA(0, 1), cA + hstepA, voffA);
    if (wr == 1) PG8_BAR;
    PG8_WAIT_V(2); PG8_BAR;
    PG8_STAGE(PG8_SB(1, 0), cB + kstep, voffB); PG8_STAGE(PG8_SA(1, 0), cA + kstep, voffA); PG8_STAGE(PG8_SB(1, 1), cB + hstepB + kstep, voffB);
    PG8_WAIT_V(6); PG8_BAR;
    for (;;) {
        const bool has_next = S.next(ui + 1, nxt);
        const char* nA = has_next ? (const char*)g.A + nxt.offA : cA; const char* nB = has_next ? (const char*)g.Bt + nxt.offB : cB;
        for (int t = 0; t < nt; t += 2) {
            const bool last = (t == nt - 2);
            const char* a1 = cA + (size_t)(t + 1) * kstep;
            const char* a2 = last ? nA : cA + (size_t)(t + 2) * kstep; const char* b2 = last ? nB : cB + (size_t)(t + 2) * kstep;
            const char* a3 = a2 + kstep; const char* b3 = b2 + kstep;
            PG8_LDB(B0, 0, 0); PG8_LDB(B1, 0, 1); PG8_SCHED; PG8_LDA(At, 0, 0); PG8_STAGE(PG8_SA(1, 1), a1 + hstepA, voffA);
            PG8_WAIT_V(8); PG8_WAIT_L(0); PG8_BAR; PG8_MMA(0, 0, At, B0); PG8_MMA(0, 1, At, B1); PG8_BAR; PG8_SCHED;
            PG8_LDA(At, 0, 1); PG8_STAGE(PG8_SB(0, 0), b2, voffB); PG8_STAGE(PG8_SB(0, 1), b2 + hstepB, voffB); PG8_STAGE(PG8_SA(0, 0), a2, voffA);
            PG8_WAIT_V(8); PG8_WAIT_L(0); PG8_BAR; PG8_MMA(1, 0, At, B0); PG8_MMA(1, 1, At, B1); PG8_BAR; PG8_SCHED;
            PG8_LDB(B0, 1, 0); PG8_LDB(B1, 1, 1); PG8_SCHED; PG8_LDA(At, 1, 0); PG8_STAGE(PG8_SA(0, 1), a2 + hstepA, voffA);
            PG8_WAIT_V(8); PG8_WAIT_L(0); PG8_BAR; PG8_MMA(0, 0, At, B0); PG8_MMA(0, 1, At, B1); PG8_BAR; PG8_SCHED;
            PG8_LDA(At, 1, 1); PG8_STAGE(PG8_SB(1, 0), b3, voffB); PG8_STAGE(PG8_SB(1, 1), b3 + hstepB, voffB); PG8_STAGE(PG8_SA(1, 0), a3, voffA);
            PG8_WAIT_V(8); PG8_WAIT_L(0); PG8_BAR; PG8_MMA(1, 0, At, B0); PG8_MMA(1, 1, At, B1); PG8_BAR; PG8_SCHED;
        }
        if (wr == 0) PG8_BAR;
        { int fr2 = fr, fq2 = fq; asm volatile("" : "+v"(fr2), "+v"(fq2));
          E(acc, cur, wr, wc, fr2, fq2); }
        if (!has_next) break;
#pragma unroll
        for (int a = 0; a < 2; ++a)
#pragma unroll
            for (int b = 0; b < 2; ++b)
#pragma unroll
                for (int m = 0; m < 4; ++m)
#pragma unroll
                    for (int n = 0; n < 2; ++n) acc[a][b][m][n] = (f32x4){0.f, 0.f, 0.f, 0.f};
        cur = nxt; cA = nA; cB = nB; ++ui;
        if (wr == 1) PG8_BAR;
    }
    PG8_WAIT_V(0);
    PG8_BAR;
#undef PG8_SA
#undef PG8_SB
#undef PG8_STAGE
#undef PG8_LDA
#undef PG8_LDB
#undef PG8_MMA
#undef PG8_WAIT_V
#undef PG8_WAIT_L
#undef PG8_BAR
#undef PG8_SCHED
}
}
using pg8::Unit;

enum OrderKind { OK_PLAIN = 0, OK_S5E, OK_S5Y, OK_XS, OK_XO };
template <int kind> struct GOrder {
    int nM, nN, nwg, G, c, lda, ldb;
    __device__ __forceinline__ void init(int nM_, int nN_, int G_, int c_, int lda_, int ldb_) { nM = nM_; nN = nN_; nwg = nM_ * nN_; G = G_; c = c_; lda = lda_; ldb = ldb_; }
    __device__ __forceinline__ bool next(int i, Unit& u) const {
        const long L = (long)i * G + c; if (L >= nwg) return false;
        const int l = (int)L;
        if constexpr (kind == OK_PLAIN) {
            int wgid = l; { const int q = nwg / 8, r = nwg % 8, xcd = wgid % 8, off = wgid / 8; wgid = (xcd < r ? xcd * (q + 1) : r * (q + 1) + (xcd - r) * q) + off; }
            const int nig = 8 * nN, gid = wgid / nig, fm = gid * 8, gsz = (nM - fm) < 8 ? (nM - fm) : 8;
            u.pm = fm + ((wgid % nig) % gsz); u.pn = (wgid % nig) / gsz;
            u.offA = (long)u.pm * 256 * lda * 2; u.offB = (long)u.pn * 256 * ldb * 2;
        } else if constexpr (kind == OK_S5E) {
            const int kq = l & 1, pmm = (l >> 1) & 3, gg = l >> 3;
            u.pm = gg * 4 + pmm; u.pn = kq;
            u.offA = ((long)u.pm * 256 * UGP + kq * 256) * 2; u.offB = ((long)gg * 256 * 512 + kq * 256) * 2;
        } else if constexpr (kind == OK_S5Y) {
            const int pn = l & 1, pmm = (l >> 1) & 3, gg = l >> 3;
            u.pm = gg * 4 + pmm; u.pn = pn;
            u.offA = (long)u.pm * 256 * UGP * 2; u.offB = ((long)gg * 512 + pn * 256) * UGP * 2;
        } else if constexpr (kind == OK_XS) {
            const int h = l & 3, pm = l >> 2, b = pm >> 3;
            u.pm = pm; u.pn = h;
            u.offA = ((long)pm * 256 * DM + h * 256) * 2; u.offB = ((long)b * 256 * DM + h * 256) * 2;
        } else {
            const int h = l & 3, pm = l >> 2, b = pm >> 3;
            u.pm = pm; u.pn = h;
            u.offA = ((long)pm * 256 * DM + h * 256) * 2; u.offB = ((long)h * 256 * TM + b * 256) * 2;
        }
        return true;
    }
};

enum EpiKind { EK_PROJ = 0, EK_MEMK, EK_MEMVT, EK_S5E, EK_S5Y, EK_GLU, EK_WOUT, EK_XQ, EK_XS, EK_XO, EK_WXO, EK_UP, EK_DOWN, EK_GATE, EK_UPACT, EK_UPC };
    __device__ __forceinline__ u32x4 pack8(const f32x4 a, const f32x4 b) { u32x4 w; w.x = pk2(a[0], a[1]); w.y = pk2(a[2], a[3]); w.z = pk2(b[0], b[1]); w.w = pk2(b[2], b[3]); return w; }
    __device__ __forceinline__ float gelu_t(float y) { const float z = 0.7978845608028654f * (y + 0.044715f * y * y * y); const float e = __expf(2.f * z); const float th = 1.f - 2.f / (e + 1.f); return 0.5f * y * (1.f + th); }
    __device__ __forceinline__ float sigm(float z) { return 1.f / (1.f + __expf(-z)); }
    __device__ __forceinline__ float ssq8(const f32x4 a, const f32x4 b) { return (a[0] * a[0] + a[1] * a[1]) + (a[2] * a[2] + a[3] * a[3]) + (b[0] * b[0] + b[1] * b[1]) + (b[2] * b[2] + b[3] * b[3]); }

template <int kind> struct Epi {
    void* p0; void* p1; void* p2; void* p3; const void* c0; const void* c1; const void* c2; LAS float* hx;
    __device__ __forceinline__ void operator()(const f32x4 (&acc)[2][2][4][2], const Unit& u, int wr, int wc, int fr, int fq) const {
        const int rbase = u.pm * 256 + wr * 64 + fr;
        const int cl0 = wc * 32 + 8 * fq;
        switch (kind) {
        case EK_PROJ: {
            const int pn = u.pn;
            if (pn < 4) {
                const bool isq = pn < 2; bf16_t* dst = (bf16_t*)(isq ? p0 : p1); const float* gptr = (const float*)(isq ? c0 : c1); const float post = isq ? C2Q : 1.f;
                const int head = 4 * (pn & 1) + wc;
#pragma unroll
                for (int ai = 0; ai < 2; ++ai)
#pragma unroll
                    for (int m = 0; m < 4; ++m) {
                        float ss = ssq8(acc[ai][0][m][0], acc[ai][0][m][1]) + ssq8(acc[ai][1][m][0], acc[ai][1][m][1]);
                        ss = red_fq(ss);
                        const float sc = rsqrtf(ss * (1.f / 64.f) + EPS) * post;
                        const size_t row = (size_t)(rbase + ai * 128 + m * 16);
#pragma unroll
                        for (int bj = 0; bj < 2; ++bj)
                            *(u32x4*)(dst + row * 512 + head * 64 + 32 * bj + 8 * fq) = pack8(acc[ai][bj][m][0] * sc * *(const f32x4*)(gptr + 32 * bj + 8 * fq), acc[ai][bj][m][1] * sc * *(const f32x4*)(gptr + 32 * bj + 8 * fq + 4));
                    }
            } else if (pn < 6) {
                bf16_t* dst = (bf16_t*)p2;
#pragma unroll
                for (int ai = 0; ai < 2; ++ai)
#pragma unroll
                    for (int m = 0; m < 4; ++m) { const size_t row = (size_t)(rbase + ai * 128 + m * 16);
#pragma unroll
                        for (int bj = 0; bj < 2; ++bj) *(u32x4*)(dst + row * 512 + (pn - 4) * 256 + bj * 128 + cl0) = pack8(acc[ai][bj][m][0], acc[ai][bj][m][1]); }
            } else {
                bf16_t* dst = (bf16_t*)p3;
#pragma unroll
                for (int ai = 0; ai < 2; ++ai)
#pragma unroll
                    for (int m = 0; m < 4; ++m) { const int row = rbase + ai * 128 + m * 16; const int b = row >> 11, t = row & 2047, ch = t >> 5, s = t & 31;
#pragma unroll
                        for (int bj = 0; bj < 2; ++bj) { const int f = (pn - 6) * 256 + bj * 128 + cl0; const int gI = f >> 4, cc = f & 15;
                            *(u32x4*)(dst + ((size_t)(gI * 1024 + b * 64 + ch)) * UGP + s * 16 + cc) = pack8(acc[ai][bj][m][0], acc[ai][bj][m][1]); } }
            }
        } break;
        case EK_MEMK: {
            bf16_t* dst = (bf16_t*)p0; float* sq = (float*)p1;
#pragma unroll
            for (int ai = 0; ai < 2; ++ai)
#pragma unroll
                for (int m = 0; m < 4; ++m) { const size_t row = (size_t)(rbase + ai * 128 + m * 16);
                    float ss = ssq8(acc[ai][0][m][0], acc[ai][0][m][1]) + ssq8(acc[ai][1][m][0], acc[ai][1][m][1]);
                    ss = red_fq(ss);
                    if (fq == 0) sq[row * 16 + u.pn * 4 + wc] = ss;
#pragma unroll
                    for (int bj = 0; bj < 2; ++bj) *(u32x4*)(dst + row * DM + u.pn * 256 + bj * 128 + cl0) = pack8(acc[ai][bj][m][0], acc[ai][bj][m][1]); }
        } break;
        case EK_MEMVT: {
            bf16_t* dst = (bf16_t*)p0;
#pragma unroll
            for (int ai = 0; ai < 2; ++ai)
#pragma unroll
                for (int m = 0; m < 4; ++m) { const size_t row = (size_t)(rbase + ai * 128 + m * 16);
#pragma unroll
                    for (int bj = 0; bj < 2; ++bj) *(u32x4*)(dst + row * TM + u.pn * 256 + bj * 128 + cl0) = pack8(acc[ai][bj][m][0], acc[ai][bj][m][1]); }
        } break;
        case EK_S5E: {
            float* dst = (float*)p0 + (size_t)u.pn * 32768 * 128;
#pragma unroll
            for (int ai = 0; ai < 2; ++ai)
#pragma unroll
                for (int m = 0; m < 4; ++m) { const size_t row = (size_t)(rbase + ai * 128 + m * 16);
                    *(f32x4*)(dst + row * 128 + cl0) = acc[ai][0][m][0]; *(f32x4*)(dst + row * 128 + cl0 + 4) = acc[ai][0][m][1]; }
        } break;
        case EK_S5Y: {
            bf16_t* dst = (bf16_t*)p0;
#pragma unroll
            for (int ai = 0; ai < 2; ++ai)
#pragma unroll
                for (int m = 0; m < 4; ++m) { const int r = rbase + ai * 128 + m * 16; const int gI = r >> 10, b = (r >> 6) & 15, k = r & 63;
#pragma unroll
                    for (int bj = 0; bj < 2; ++bj) { const int nn = u.pn * 256 + bj * 128 + cl0; const int tt = nn >> 4, cc = nn & 15;
                        f32x4 a = acc[ai][bj][m][0], c = acc[ai][bj][m][1];
#pragma unroll
                        for (int j = 0; j < 4; ++j) { a[j] = gelu_t(a[j]); c[j] = gelu_t(c[j]); }
                        *(u32x4*)(dst + ((size_t)(b * SEQ + k * TC + tt)) * 512 + gI * 16 + cc) = pack8(a, c); } }
        } break;
        case EK_GLU: {
            bf16_t* dst = (bf16_t*)p0; float* sq = (float*)p1; const bf16_t* y1 = (const bf16_t*)c0; const float* bg = (const float*)c1;
            f32x4 bv[2][2];
#pragma unroll
            for (int bj = 0; bj < 2; ++bj)
#pragma unroll
                for (int n = 0; n < 2; ++n) bv[bj][n] = *(const f32x4*)(bg + u.pn * 256 + bj * 128 + cl0 + 4 * n);
#pragma unroll
            for (int ai = 0; ai < 2; ++ai)
#pragma unroll
                for (int m = 0; m < 4; ++m) { const size_t row = (size_t)(rbase + ai * 128 + m * 16); float ss = 0.f;
#pragma unroll
                    for (int bj = 0; bj < 2; ++bj) { const size_t off = row * 512 + u.pn * 256 + bj * 128 + cl0;
                        const u32x4 yv = *(const u32x4*)(y1 + off);
                        f32x4 a = acc[ai][bj][m][0] + bv[bj][0], c = acc[ai][bj][m][1] + bv[bj][1];
                        a[0] = bflo(yv.x) * sigm(a[0]); a[1] = bfhi(yv.x) * sigm(a[1]); a[2] = bflo(yv.y) * sigm(a[2]); a[3] = bfhi(yv.y) * sigm(a[3]);
                        c[0] = bflo(yv.z) * sigm(c[0]); c[1] = bfhi(yv.z) * sigm(c[1]); c[2] = bflo(yv.w) * sigm(c[2]); c[3] = bfhi(yv.w) * sigm(c[3]);
                        ss += ssq8(a, c);
                        *(u32x4*)(dst + off) = pack8(a, c); }
                    ss = red_fq(ss);
                    if (fq == 0) sq[row * 8 + u.pn * 4 + wc] = ss; }
        } break;
        case EK_WOUT: case EK_WXO: {
            float* out = (float*)p0; bf16_t* hb = (bf16_t*)p1; float* sq = (float*)p2; const float* base = (const float*)c0;
#pragma unroll
            for (int ai = 0; ai < 2; ++ai)
#pragma unroll
                for (int m = 0; m < 4; ++m) { const size_t row = (size_t)(rbase + ai * 128 + m * 16); float ss = 0.f;
#pragma unroll
                    for (int bj = 0; bj < 2; ++bj) { const size_t off = row * DM + u.pn * 256 + bj * 128 + cl0;
                        const f32x4 a = acc[ai][bj][m][0] + *(const f32x4*)(base + off), c = acc[ai][bj][m][1] + *(const f32x4*)(base + off + 4);
                        *(f32x4*)(out + off) = a; *(f32x4*)(out + off + 4) = c;
                        ss += ssq8(a, c);
                        *(u32x4*)(hb + off) = pack8(a, c); }
                    ss = red_fq(ss);
                    if (fq == 0) sq[row * 16 + u.pn * 4 + wc] = ss; }
        } break;
        case EK_XQ: {
            bf16_t* dst = (bf16_t*)p0; float* sq = (float*)p1; const float* gq = (const float*)c0; const float* gk = (const float*)c1;
            f32x4 gg[2][2];
#pragma unroll
            for (int bj = 0; bj < 2; ++bj)
#pragma unroll
                for (int n = 0; n < 2; ++n) gg[bj][n] = *(const f32x4*)(gq + bj * 128 + cl0 + 4 * n) * *(const f32x4*)(gk + bj * 128 + cl0 + 4 * n);
#pragma unroll
            for (int ai = 0; ai < 2; ++ai)
#pragma unroll
                for (int m = 0; m < 4; ++m) { const size_t row = (size_t)(rbase + ai * 128 + m * 16);
                    float ss = ssq8(acc[ai][0][m][0], acc[ai][0][m][1]) + ssq8(acc[ai][1][m][0], acc[ai][1][m][1]);
                    ss = red_fq(ss);
                    if (fq == 0) sq[row * 16 + u.pn * 4 + wc] = ss;
#pragma unroll
                    for (int bj = 0; bj < 2; ++bj) *(u32x4*)(dst + row * DM + u.pn * 256 + bj * 128 + cl0) = pack8(acc[ai][bj][m][0] * gg[bj][0], acc[ai][bj][m][1] * gg[bj][1]); }
        } break;
        case EK_XS: {
            bf16_t* dst = (bf16_t*)p0; float* ps = (float*)p1; const float* s1 = (const float*)c0; const float* sqq = (const float*)c1; const float* sck = (const float*)c2;
            const int h = u.pn, b = u.pm >> 3;
            f32x4 kv[2][2];
#pragma unroll
            for (int bj = 0; bj < 2; ++bj)
#pragma unroll
                for (int n = 0; n < 2; ++n) kv[bj][n] = *(const f32x4*)(sck + (size_t)h * TM + b * 256 + bj * 128 + cl0 + 4 * n) * (LOG2E / 16.f);
#pragma unroll
            for (int ai = 0; ai < 2; ++ai)
#pragma unroll
                for (int m = 0; m < 4; ++m) { const size_t row = (size_t)(rbase + ai * 128 + m * 16);
                    const f32x4 t0 = *(const f32x4*)(s1 + row * 16), t1 = *(const f32x4*)(s1 + row * 16 + 4), t2 = *(const f32x4*)(s1 + row * 16 + 8), t3 = *(const f32x4*)(s1 + row * 16 + 12);
                    const float tot = ((t0[0] + t0[1]) + (t0[2] + t0[3])) + ((t1[0] + t1[1]) + (t1[2] + t1[3])) + ((t2[0] + t2[1]) + (t2[2] + t2[3])) + ((t3[0] + t3[1]) + (t3[2] + t3[3]));
                    const float rs1 = rsqrtf(tot * (1.f / DM) + EPS);
                    const f32x4 qq = *(const f32x4*)(sqq + row * 16 + h * 4);
                    const float sq = rs1 * rsqrtf(rs1 * rs1 * ((qq[0] + qq[1]) + (qq[2] + qq[3])) * (1.f / 256.f) + EPS);
                    float ss = 0.f;
#pragma unroll
                    for (int bj = 0; bj < 2; ++bj) { f32x4 a = acc[ai][bj][m][0] * kv[bj][0] * sq, c = acc[ai][bj][m][1] * kv[bj][1] * sq;
#pragma unroll
                        for (int j = 0; j < 4; ++j) { a[j] = __builtin_amdgcn_exp2f(a[j]); c[j] = __builtin_amdgcn_exp2f(c[j]); }
                        const u32x4 w = pack8(a, c);
                        ss += (bflo(w.x) + bfhi(w.x)) + (bflo(w.y) + bfhi(w.y)) + (bflo(w.z) + bfhi(w.z)) + (bflo(w.w) + bfhi(w.w));
                        *(u32x4*)(dst + row * DM + h * 256 + bj * 128 + cl0) = w; }
                    ss = red_fq(ss);
                    if (fq == 0) ps[row * 16 + h * 4 + wc] = ss; }
        } break;
        case EK_XO: {
            bf16_t* dst = (bf16_t*)p0; const float* ps = (const float*)c0; const int h = u.pn;
#pragma unroll
            for (int ai = 0; ai < 2; ++ai)
#pragma unroll
                for (int m = 0; m < 4; ++m) { const size_t row = (size_t)(rbase + ai * 128 + m * 16);
                    const f32x4 pp = *(const f32x4*)(ps + row * 16 + h * 4); const float inv = 1.f / ((pp[0] + pp[1]) + (pp[2] + pp[3]));
#pragma unroll
                    for (int bj = 0; bj < 2; ++bj) *(u32x4*)(dst + row * DM + h * 256 + bj * 128 + cl0) = pack8(acc[ai][bj][m][0] * inv, acc[ai][bj][m][1] * inv); }
        } break;
        case EK_DOWN: {
            float* out = (float*)p0;
#pragma unroll
            for (int ai = 0; ai < 2; ++ai)
#pragma unroll
                for (int m = 0; m < 4; ++m) { const size_t row = (size_t)(rbase + ai * 128 + m * 16);
#pragma unroll
                    for (int bj = 0; bj < 2; ++bj) { const size_t off = row * DM + u.pn * 256 + bj * 128 + cl0;
                        const f32x4 a = acc[ai][bj][m][0] + *(const f32x4*)(out + off), c = acc[ai][bj][m][1] + *(const f32x4*)(out + off + 4);
                        *(f32x4*)(out + off) = a; *(f32x4*)(out + off + 4) = c; } }
        } break;
        case EK_UPC: {
            bf16_t* A = (bf16_t*)p0; float* GHF = (float*)p1; float* GHL = (float*)p2; float* UH = (float*)p3; const float* s2 = (const float*)c0; const float* cw = (const float*)c1; const float* cbv = (const float*)c2;
            const int j0 = u.pn * 128 + cl0;
            float w0[8], w1[8], w2[8], bb[8];
#pragma unroll
            for (int i = 0; i < 2; ++i) { const f32x4 a0 = *(const f32x4*)(cw + j0 + 4 * i), a1 = *(const f32x4*)(cw + DFF + j0 + 4 * i), a2 = *(const f32x4*)(cw + 2 * DFF + j0 + 4 * i), a3 = *(const f32x4*)(cbv + j0 + 4 * i);
#pragma unroll
                for (int q = 0; q < 4; ++q) { w0[4 * i + q] = a0[q]; w1[4 * i + q] = a1[q]; w2[4 * i + q] = a2[q]; bb[4 * i + q] = a3[q]; } }
            float rsv[2][4];
#pragma unroll
            for (int ai = 0; ai < 2; ++ai)
#pragma unroll
                for (int m = 0; m < 4; ++m) rsv[ai][m] = s2[rbase + ai * 128 + m * 16];
            if (fr >= 14) {
#pragma unroll
                for (int ai = 0; ai < 2; ++ai) { const f32x4 g0 = acc[ai][0][3][0] * rsv[ai][3], g1 = acc[ai][0][3][1] * rsv[ai][3];
                    LAS float* hp = hx + ((ai * 2 + wr) * 2 + (fr - 14)) * 128 + cl0; *(LAS f32x4*)hp = g0; *(LAS f32x4*)(hp + 4) = g1;
                    if (ai == 1 && wr == 1) { float* gp = GHL + ((size_t)u.pm * 2 + (fr - 14)) * DFF + j0; *(f32x4*)gp = g0; *(f32x4*)(gp + 4) = g1; } } }
            if (wr == 0 && fr < 2) {
                const float rs = rsv[0][0]; float* gp = GHF + ((size_t)u.pm * 2 + fr) * DFF + j0; float* up = UH + ((size_t)u.pm * 2 + fr) * DFF + j0;
                *(f32x4*)gp = acc[0][0][0][0] * rs; *(f32x4*)(gp + 4) = acc[0][0][0][1] * rs; *(f32x4*)up = acc[0][1][0][0] * rs; *(f32x4*)(up + 4) = acc[0][1][0][1] * rs; }
            asm volatile("s_waitcnt lgkmcnt(0)" ::: "memory"); __builtin_amdgcn_s_barrier(); asm volatile("" ::: "memory");
#define ROR1(x) __builtin_bit_cast(float, __builtin_amdgcn_update_dpp(0, __builtin_bit_cast(int, (x)), 0x121, 0xF, 0xF, false))
#define ROR2(x) __builtin_bit_cast(float, __builtin_amdgcn_update_dpp(0, __builtin_bit_cast(int, (x)), 0x122, 0xF, 0xF, false))
#pragma unroll
            for (int ai = 0; ai < 2; ++ai) {
                const int grp = ai * 2 + wr;
                float p1v[8], p2v[8];
                { f32x4 h1a = (f32x4){0.f, 0.f, 0.f, 0.f}, h1b = h1a, h2a = h1a, h2b = h1a;
                  if (grp > 0) { const LAS float* hp = hx + ((grp - 1) * 2) * 128 + cl0; h2a = *(const LAS f32x4*)hp; h2b = *(const LAS f32x4*)(hp + 4); h1a = *(const LAS f32x4*)(hp + 128); h1b = *(const LAS f32x4*)(hp + 132); }
#pragma unroll
                  for (int i = 0; i < 4; ++i) { p1v[i] = h1a[i]; p1v[4 + i] = h1b[i]; p2v[i] = (fr == 0) ? h2a[i] : h1a[i]; p2v[4 + i] = (fr == 0) ? h2b[i] : h1b[i]; } }
#pragma unroll
                for (int m = 0; m < 4; ++m) { const float rs = rsv[ai][m]; const size_t row = (size_t)(rbase + ai * 128 + m * 16);
                    float gs[8], r[8];
#pragma unroll
                    for (int i = 0; i < 4; ++i) { gs[i] = acc[ai][0][m][0][i] * rs; gs[4 + i] = acc[ai][0][m][1][i] * rs; }
#pragma unroll
                    for (int i = 0; i < 8; ++i) { const float c1v = ROR1(gs[i]), c2v = ROR2(gs[i]);
                        const float g1 = (fr == 0) ? p1v[i] : c1v, g2 = (fr < 2) ? p2v[i] : c2v;
                        p1v[i] = c1v; p2v[i] = c2v;
                        const float z = bb[i] + w0[i] * g2 + w1[i] * g1 + w2[i] * gs[i];
                        const float uv = (i < 4 ? acc[ai][1][m][0][i & 3] : acc[ai][1][m][1][i & 3]) * rs;
                        r[i] = z * sigm(z) * uv; }
                    u32x4 o; o.x = pk2(r[0], r[1]); o.y = pk2(r[2], r[3]); o.z = pk2(r[4], r[5]); o.w = pk2(r[6], r[7]);
                    if (!(grp == 0 && m == 0 && fr < 2)) *(u32x4*)(A + row * DFF + j0) = o; } }
#undef ROR1
#undef ROR2
        } break;
        default: break;
        }
    }
};

namespace attn_body {
using bf16=__hip_bfloat16;
using s16x4=__attribute__((ext_vector_type(4)))short;
using f32x16=__attribute__((ext_vector_type(16)))float;
constexpr int NHEAD=NFH,D=64,ADM=NHEAD*D;
constexpr int NW=8,QBLK=32,QB=QBLK*NW,KVBLK=64,NQB=SEQ/QB;
__device__ __forceinline__ int crow(int r,int hi){return (r&3)+8*(r>>2)+4*hi;}
#define SBAR() __builtin_amdgcn_sched_barrier(0)
__device__ __forceinline__ void cmask(f32x16&p0,f32x16&p1,int jb,int qrel,int hi){
  const float NEG=-INFINITY; int kb=64*jb+4*hi;
  #pragma unroll
  for(int r=0;r<16;++r){int kv=kb+(r&3)+8*(r>>2); if(kv>qrel)p0[r]=NEG; if(kv+32>qrel)p1[r]=NEG;}
}
constexpr int NSLOT=3, SLOTB=8192;
constexpr int LDS_K=0, LDS_V=NSLOT*SLOTB, LDS_WS=2*NSLOT*SLOTB, LDS_OST=LDS_WS+NW*64*4, LDS_BYTES=LDS_OST+NW*4096;
constexpr int LDS_BIAS=86016;
__device__ __forceinline__ void glds16(const void*gsrc,unsigned lds_dst){unsigned keep;
  asm volatile("s_mov_b32 %0, m0\n\ts_mov_b32 m0, %2\n\ts_nop 0\n\tglobal_load_lds_dwordx4 %1, off\n\ts_mov_b32 m0, %0":"=&s"(keep):"v"(gsrc),"s"(lds_dst):"memory");}
__device__ __forceinline__ float max3f(float a,float b,float c){float r;asm("v_max3_f32 %0, %1, %2, %3":"=v"(r):"v"(a),"v"(b),"v"(c));return r;}
__device__ __forceinline__ float max2f(float a,float b){float r;asm("v_max_f32_e32 %0, %1, %2":"=v"(r):"v"(a),"v"(b));return r;}
__device__ __forceinline__ float fadd_s(float a,float b){float r;asm("v_add_f32_e32 %0, %1, %2":"=v"(r):"v"(a),"v"(b));return r;}
__device__ __forceinline__ float fsub_s(float a,float b){float r;asm("v_sub_f32_e32 %0, %1, %2":"=v"(r):"v"(a),"v"(b));return r;}
typedef float f32x2_t __attribute__((ext_vector_type(2))); typedef __bf16 bf16x2_t __attribute__((ext_vector_type(2)));
__device__ __forceinline__ unsigned cvtpk_s(float lo,float hi){f32x2_t v={lo,hi};bf16x2_t b=__builtin_convertvector(v,bf16x2_t);return __builtin_bit_cast(unsigned,b);}
#define WAIT_BAR(N) asm volatile("s_waitcnt vmcnt(" #N ") lgkmcnt(0)\n\ts_barrier":::"memory")

__device__ __forceinline__ void qkt(f32x16&p0,f32x16&p1,const char*Kslot,const bf16x8*qr,const f32x16&negm,int r32,int hi){
  const char*kb=Kslot+hi*1024+r32*16;
  #pragma unroll
  for(int d0=0;d0<4;++d0){
    const bf16x8 b0=*reinterpret_cast<const bf16x8*>(kb+d0*2048);
    const bf16x8 b1=*reinterpret_cast<const bf16x8*>(kb+d0*2048+512);
    if(d0==0){p0=__builtin_amdgcn_mfma_f32_32x32x16_bf16(b0,qr[0],negm,0,0,0);p1=__builtin_amdgcn_mfma_f32_32x32x16_bf16(b1,qr[0],negm,0,0,0);}
    else{p0=__builtin_amdgcn_mfma_f32_32x32x16_bf16(b0,qr[d0],p0,0,0,0);p1=__builtin_amdgcn_mfma_f32_32x32x16_bf16(b1,qr[d0],p1,0,0,0);}}
}
typedef __attribute__((address_space(3))) const char* lds_cptr;
typedef short v4i16_t __attribute__((ext_vector_type(4)));
__device__ __forceinline__ void kload8(bf16x8*kf,lds_cptr kp){
  kf[0]=*(const __attribute__((address_space(3))) bf16x8*)(kp);      kf[1]=*(const __attribute__((address_space(3))) bf16x8*)(kp+512);
  kf[2]=*(const __attribute__((address_space(3))) bf16x8*)(kp+2048); kf[3]=*(const __attribute__((address_space(3))) bf16x8*)(kp+2560);
  kf[4]=*(const __attribute__((address_space(3))) bf16x8*)(kp+4096); kf[5]=*(const __attribute__((address_space(3))) bf16x8*)(kp+4608);
  kf[6]=*(const __attribute__((address_space(3))) bf16x8*)(kp+6144); kf[7]=*(const __attribute__((address_space(3))) bf16x8*)(kp+6656);
}
__device__ __forceinline__ void kload2(bf16x8*kf,lds_cptr kp,int j){ kf[2*j]=*(const __attribute__((address_space(3))) bf16x8*)(kp+j*2048); kf[2*j+1]=*(const __attribute__((address_space(3))) bf16x8*)(kp+j*2048+512); }
__device__ __forceinline__ s16x4 vtr(lds_cptr p){ return __builtin_bit_cast(s16x4,__builtin_amdgcn_ds_read_tr16_b64_v4i16((__attribute__((address_space(3))) v4i16_t*)p)); }
__device__ __forceinline__ float rowmax(const f32x16&p0,const f32x16&p1){
  float a=max3f(p0[0],p0[1],p1[0]),b=max3f(p0[2],p0[3],p1[1]);a=max3f(a,p1[2],p1[3]);
  #pragma unroll
  for(int r=4;r<16;r+=4){a=max3f(a,p0[r],p0[r+1]);b=max3f(b,p0[r+2],p0[r+3]);a=max3f(a,p1[r],p1[r+1]);b=max3f(b,p1[r+2],p1[r+3]);}
  const float m=max2f(a,b);
  auto rr=__builtin_amdgcn_permlane32_swap(__float_as_uint(m),__float_as_uint(m),false,false);
  return max2f(__uint_as_float(rr[0]),__uint_as_float(rr[1]));
}
__device__ __forceinline__ void pv(f32x16*o,int vb,bf16x8 pa0,bf16x8 pa1,bf16x8 pa2,bf16x8 pa3){
  #pragma unroll
  for(int d0=0;d0<2;++d0){s16x4 lo[4],hi[4];
    #pragma unroll
    for(int ks=0;ks<4;++ks){
      asm volatile("ds_read_b64_tr_b16 %0,%1 offset:%c2":"=&v"(lo[ks]):"v"(vb),"i"(d0*4096+ks*1024):"memory");
      asm volatile("ds_read_b64_tr_b16 %0,%1 offset:%c2":"=&v"(hi[ks]):"v"(vb),"i"(d0*4096+ks*1024+512):"memory");}
    asm volatile("s_waitcnt lgkmcnt(0)":::"memory");SBAR();
    #define PK(k) (bf16x8){lo[k][0],lo[k][1],lo[k][2],lo[k][3],hi[k][0],hi[k][1],hi[k][2],hi[k][3]}
    o[d0]=__builtin_amdgcn_mfma_f32_32x32x16_bf16(pa0,PK(0),o[d0],0,0,0);
    o[d0]=__builtin_amdgcn_mfma_f32_32x32x16_bf16(pa1,PK(1),o[d0],0,0,0);
    o[d0]=__builtin_amdgcn_mfma_f32_32x32x16_bf16(pa2,PK(2),o[d0],0,0,0);
    o[d0]=__builtin_amdgcn_mfma_f32_32x32x16_bf16(pa3,PK(3),o[d0],0,0,0);
    #undef PK
  }
}
typedef const __attribute__((address_space(3))) f32x4* lds_f4ptr;
#define BIASADD(P0,P1,t) do{ const lds_f4ptr bp_=(lds_f4ptr)(shm3+bias_off+((t)*64+4*hi)*4); \
    _Pragma("unroll") for(int j_=0;j_<4;++j_){ const f32x4 b0_=bp_[2*j_]-mhat, b1_=bp_[8+2*j_]-mhat; \
      P0[4*j_]+=b0_[0]; P0[4*j_+1]+=b0_[1]; P0[4*j_+2]+=b0_[2]; P0[4*j_+3]+=b0_[3]; \
      P1[4*j_]+=b1_[0]; P1[4*j_+1]+=b1_[1]; P1[4*j_+2]+=b1_[2]; P1[4*j_+3]+=b1_[3]; } }while(0)

template<int THRL> __device__ __forceinline__ void attn_unit(int b,int h,int qb,const bf16*Q,const bf16*__restrict__ K,const bf16*__restrict__ V,bf16*O,const float*__restrict__ CB,float*__restrict__ SSQ,char*shm,const float skip_th){
  int tid=threadIdx.x; asm volatile("":"+v"(tid));
  const int lane=tid&63,r32=lane&31,hi=lane>>5; const int wid=__builtin_amdgcn_readfirstlane(tid>>6);
  const long rowbase=(long)b*SEQ; const int q0=qb*QB;
  const bf16*Qw=Q+(rowbase+q0+wid*QBLK)*ADM+h*D;
  int t0=0; { const float*cbh0=CB+(long)(b*NHEAD+h)*SEQ; const int npair=(q0+QB)/KVBLK/2-2; const float c0v=cbh0[q0];
    const bool far=(lane<npair)&&(cbh0[128*(lane<npair?lane:0)+127]-c0v>skip_th); const unsigned long long mk=__ballot(far);
    int lead=__builtin_ctzll(~mk); if(lead>npair)lead=npair; if(lead<0)lead=0; t0=2*__builtin_amdgcn_readfirstlane(lead); }
  const bf16*Kh=K+(rowbase+(long)t0*KVBLK)*ADM+h*D,*Vh=V+(rowbase+(long)t0*KVBLK)*ADM+h*D;
  const unsigned lds0=(unsigned)(uintptr_t)shm;
  float*wsf=(float*)(shm+LDS_WS)+wid*64;
  const lds_cptr shm3=(lds_cptr)shm;
  { const float*cbh=CB+(long)(b*NHEAD+h)*SEQ; const float cref=cbh[q0+128];
    if(tid*4<q0+QB){ const f32x4 c4=*(const f32x4*)(cbh+tid*4); *(__attribute__((address_space(3))) f32x4*)(shm3+LDS_BIAS+tid*16)=(f32x4){cref-c4[0],cref-c4[1],cref-c4[2],cref-c4[3]}; } }
  const bf16*ksrc=Kh+(long)lane*ADM+wid*8;
  const bf16*vsrc=Vh+(long)(16*(wid&3)+(lane>>2))*ADM+(wid>>2)*32+(lane&3)*8;
  const unsigned kdst=lds0+LDS_K+wid*1024, vdst=lds0+LDS_V+wid*1024;
  #define DMA_K(t,slot) glds16(ksrc+(long)(t)*KVBLK*ADM,(unsigned)__builtin_amdgcn_readfirstlane(kdst+(slot)))
  #define DMA_V(t,slot) glds16(vsrc+(long)(t)*KVBLK*ADM,(unsigned)__builtin_amdgcn_readfirstlane(vdst+(slot)))
  const int vb0=(int)(lds0+LDS_V)+((lane>>4)&1)*32+(lane&3)*8+(4*hi+((lane&15)>>2))*64;
  const char*Kbase=shm+LDS_K; bf16x8 kf[8];
  const lds_cptr kp0=shm3+LDS_K+hi*1024+r32*16; const lds_cptr vp0=shm3+LDS_V+((lane>>4)&1)*32+(lane&3)*8+(4*hi+((lane&15)>>2))*64;
  const int NT=(q0+QB)/KVBLK-t0; const int bias_off=LDS_BIAS+t0*KVBLK*4;
  DMA_K(0,0);DMA_V(0,0);DMA_K(1,SLOTB);
  bf16x8 qr[4];
  #pragma unroll
  for(int d0=0;d0<4;++d0)qr[d0]=*reinterpret_cast<const bf16x8*>(&Qw[(long)r32*ADM+d0*16+hi*8]);
  float mhat=0.f,l_reg=0.f;f32x16 o[2];o[0]=f32x16{};o[1]=f32x16{};const f32x16 negm=f32x16{};
  const int qrel=wid*QBLK+r32;
  #define CMASK(P0,P1,t) do{int jb_=(t)-(NT-4); if(jb_>=0)cmask(P0,P1,jb_,qrel,hi);}while(0)
  bool resc=false;
  #define START(P0,P1) do{ const float rm=rowmax(P0,P1); resc=false; \
    { const float dl=max2f(rm,-24.f); mhat=fadd_s(mhat,dl); \
      _Pragma("unroll") for(int r=0;r<16;++r){P0[r]=fsub_s(P0[r],dl);P1[r]=fsub_s(P1[r],dl);} } \
    _Pragma("unroll") for(int r=0;r<16;++r)P0[r]=__builtin_amdgcn_exp2f(P0[r]); }while(0)
  #define RESC() do{ if(resc){ asm volatile("s_waitcnt lgkmcnt(0)":::"memory"); \
      _Pragma("unroll") for(int d_=0;d_<2;++d_) _Pragma("unroll") for(int r=0;r<16;++r)o[d_][r]*=wsf[crow(r,hi)]; } }while(0)
  f32x16 pA0,pA1,pB0,pB1;
  int sl_prev=0,sl_cur=0,sl_next=SLOTB;
  #define ROT() do{sl_prev=sl_cur;sl_cur=sl_next;sl_next=(sl_next==(NSLOT-1)*SLOTB)?0:sl_next+SLOTB;}while(0)
  DMA_K(2,2*SLOTB);
  WAIT_BAR(3);
  qkt(pA0,pA1,Kbase,qr,negm,r32,hi);asm volatile("s_nop 15\n\ts_nop 7":"+v"(pA0),"+v"(pA1));BIASADD(pA0,pA1,0);CMASK(pA0,pA1,0);
  START(pA0,pA1);
  _Pragma("unroll") for(int r=0;r<16;++r)pA1[r]=__builtin_amdgcn_exp2f(pA1[r]);
  WAIT_BAR(0);
  DMA_K(3,0);DMA_V(1,SLOTB);
  ROT();
  kload8(kf,kp0+sl_cur);
  WAIT_BAR(2);
  s16x4 vlo[8],vhi[8]; u32x4 pw0,pw1,pw2,pw3;
  #define PKW(P,B) cvtpk_s(P[B],P[B+1])
  #define PAF(k) __builtin_bit_cast(bf16x8,pw##k)
  #define VFR(i) (bf16x8){vlo[i][0],vlo[i][1],vlo[i][2],vlo[i][3],vhi[i][0],vhi[i][1],vhi[i][2],vhi[i][3]}
  #define PIN(x) asm volatile("":"+v"(x))
  #define MX3(a,b,c) __builtin_fmaxf(__builtin_fmaxf((a),(b)),(c))
  #define GAPA(MF,A0,A1,A2,A3,W0,W1,PW) do{ MF; sacc+=A0; sacc+=A1; sacc+=A2; sacc+=A3; PIN(sacc); W0; W1; PIN(PW); SBAR(); }while(0)
  #define EX(v) __builtin_amdgcn_exp2f(v)
  #define GAPB(MF,X,B) do{ MF; X[B]=EX(X[B]); X[B+1]=EX(X[B+1]); X[B+2]=EX(X[B+2]); X[B+3]=EX(X[B+3]); PIN(X); SBAR(); }while(0)
  #define VRD(i) do{ vlo[i]=vtr(vp_+(((i)>>2)*4096+((i)&3)*1024)); vhi[i]=vtr(vp_+(((i)>>2)*4096+((i)&3)*1024+512)); }while(0)
  #define KRD(G,j) do{ if(G){ kload2(kf,kp0+sl_next,j); SBAR(); } }while(0)
  #define STEP(C0,C1,P0,P1,t,GK,GV,GL) do{ SBAR(); \
    const lds_cptr vp_=vp0+sl_prev; \
    VRD(0); SBAR(); float sacc=(P0[0]+P0[1]); \
    GAPA(C0=__builtin_amdgcn_mfma_f32_32x32x16_bf16(kf[0],qr[0],negm,0,0,0), P0[2],P0[3],P0[4],P0[5],     pw0[0]=PKW(P0,0), pw0[1]=PKW(P0,2), pw0); \
    VRD(4); SBAR(); GAPA(C1=__builtin_amdgcn_mfma_f32_32x32x16_bf16(kf[1],qr[0],negm,0,0,0), P0[6],P0[7],P0[8],P0[9],     pw0[2]=PKW(P0,4), pw0[3]=PKW(P0,6), pw0); \
    VRD(1); SBAR(); GAPA(C0=__builtin_amdgcn_mfma_f32_32x32x16_bf16(kf[2],qr[1],C0,0,0,0),   P0[10],P0[11],P0[12],P0[13], pw1[0]=PKW(P0,8), pw1[1]=PKW(P0,10), pw1); \
    VRD(5); SBAR(); GAPA(C1=__builtin_amdgcn_mfma_f32_32x32x16_bf16(kf[3],qr[1],C1,0,0,0),   P0[14],P0[15],P1[0],P1[1],   pw1[2]=PKW(P0,12),pw1[3]=PKW(P0,14), pw1); \
    VRD(2); SBAR(); GAPA(C0=__builtin_amdgcn_mfma_f32_32x32x16_bf16(kf[4],qr[2],C0,0,0,0),   P1[2],P1[3],P1[4],P1[5],     pw2[0]=PKW(P1,0), pw2[1]=PKW(P1,2), pw2); \
    VRD(6); SBAR(); GAPA(C1=__builtin_amdgcn_mfma_f32_32x32x16_bf16(kf[5],qr[2],C1,0,0,0),   P1[6],P1[7],P1[8],P1[9],     pw2[2]=PKW(P1,4), pw2[3]=PKW(P1,6), pw2); \
    VRD(3); SBAR(); GAPA(C0=__builtin_amdgcn_mfma_f32_32x32x16_bf16(kf[6],qr[3],C0,0,0,0),   P1[10],P1[11],P1[12],P1[13], pw3[0]=PKW(P1,8), pw3[1]=PKW(P1,10), pw3); \
    VRD(7); SBAR(); GAPA(C1=__builtin_amdgcn_mfma_f32_32x32x16_bf16(kf[7],qr[3],C1,0,0,0),   P1[14],P1[15],0.f,0.f,       pw3[2]=PKW(P1,12),pw3[3]=PKW(P1,14), pw3); \
    l_reg+=sacc; \
    if(GK){DMA_K((t)+3,sl_cur);} if(GV){DMA_V((t)+1,sl_next);} \
    BIASADD(C0,C1,t); \
    CMASK(C0,C1,t); \
    { float a=MX3(C0[0],C0[1],C1[0]),b=MX3(C0[2],C0[3],C1[1]); a=MX3(a,C1[2],C1[3]); \
      _Pragma("unroll") for(int r=4;r<16;r+=4){a=MX3(a,C0[r],C0[r+1]);b=MX3(b,C0[r+2],C0[r+3]);a=MX3(a,C1[r],C1[r+1]);b=MX3(b,C1[r+2],C1[r+3]);} \
      float rm=__builtin_fmaxf(a,b); { auto rr=__builtin_amdgcn_permlane32_swap(__float_as_uint(rm),__float_as_uint(rm),false,false); rm=__builtin_fmaxf(__uint_as_float(rr[0]),__uint_as_float(rr[1])); } \
      resc=false; \
      if(__builtin_expect(__any(rm>(float)THRL),0)){ const float dl=__builtin_fmaxf(rm,0.f); mhat+=dl; \
        _Pragma("unroll") for(int r=0;r<16;++r){C0[r]-=dl;C1[r]-=dl;} \
        const float f=__builtin_amdgcn_exp2f(-dl); l_reg*=f; if(hi==0)wsf[r32]=f; resc=true; } } \
    SBAR(); \
    GAPB(o[0]=__builtin_amdgcn_mfma_f32_32x32x16_bf16(PAF(0),VFR(0),o[0],0,0,0), C0,0); \
    GAPB(o[1]=__builtin_amdgcn_mfma_f32_32x32x16_bf16(PAF(0),VFR(4),o[1],0,0,0), C0,4); \
    KRD(GL,0); GAPB(o[0]=__builtin_amdgcn_mfma_f32_32x32x16_bf16(PAF(1),VFR(1),o[0],0,0,0), C0,8); \
    KRD(GL,1); GAPB(o[1]=__builtin_amdgcn_mfma_f32_32x32x16_bf16(PAF(1),VFR(5),o[1],0,0,0), C0,12); \
    KRD(GL,2); GAPB(o[0]=__builtin_amdgcn_mfma_f32_32x32x16_bf16(PAF(2),VFR(2),o[0],0,0,0), C1,0); \
    KRD(GL,3); GAPB(o[1]=__builtin_amdgcn_mfma_f32_32x32x16_bf16(PAF(2),VFR(6),o[1],0,0,0), C1,4); \
    GAPB(o[0]=__builtin_amdgcn_mfma_f32_32x32x16_bf16(PAF(3),VFR(3),o[0],0,0,0), C1,8); \
    GAPB(o[1]=__builtin_amdgcn_mfma_f32_32x32x16_bf16(PAF(3),VFR(7),o[1],0,0,0), C1,12); \
    }while(0)
  int t=1;
  #undef CMASK
  #define CMASK(P0,P1,t) do{}while(0)
  for(;t+5<NT;t+=2){
    STEP(pB0,pB1,pA0,pA1,t,true,true,true);     WAIT_BAR(2); RESC(); ROT();
    STEP(pA0,pA1,pB0,pB1,t+1,true,true,true);   WAIT_BAR(2); RESC(); ROT();
  }
  #undef CMASK
  #define CMASK(P0,P1,t) do{int jb_=(t)-(NT-4); if(jb_>=0)cmask(P0,P1,jb_,qrel,hi);}while(0)
  #define ENDW(tt) do{ if((tt)+3<NT){WAIT_BAR(2);} else if((tt)+2<NT){WAIT_BAR(1);} else {WAIT_BAR(0);} }while(0)
  for(;t+1<NT;t+=2){
    STEP(pB0,pB1,pA0,pA1,t,(t+3<NT),(t+1<NT),(t+1<NT));       ENDW(t);   RESC(); ROT();
    STEP(pA0,pA1,pB0,pB1,t+1,(t+4<NT),(t+2<NT),(t+2<NT));     ENDW(t+1); RESC(); ROT();
  }
  STEP(pB0,pB1,pA0,pA1,NT-1,false,false,false); RESC();
  { float sacc=pB0[0]+pB0[1]; _Pragma("unroll") for(int r=2;r<16;++r)sacc+=pB0[r]; _Pragma("unroll") for(int r=0;r<16;++r)sacc+=pB1[r]; l_reg+=sacc;
    pw0=(u32x4){PKW(pB0,0),PKW(pB0,2),PKW(pB0,4),PKW(pB0,6)};pw1=(u32x4){PKW(pB0,8),PKW(pB0,10),PKW(pB0,12),PKW(pB0,14)};pw2=(u32x4){PKW(pB1,0),PKW(pB1,2),PKW(pB1,4),PKW(pB1,6)};pw3=(u32x4){PKW(pB1,8),PKW(pB1,10),PKW(pB1,12),PKW(pB1,14)};
    SBAR(); pv(o,vb0+sl_cur,PAF(0),PAF(1),PAF(2),PAF(3)); }
  #undef PKW
  #undef PAF
  #undef VFR
  #undef PIN
  #undef MX3
  #undef GAPA
  #undef GAPB
  #undef EX
  #undef VRD
  #undef KRD
  #undef STEP
  #undef ENDW
  {auto rr=__builtin_amdgcn_permlane32_swap(__float_as_uint(l_reg),__float_as_uint(l_reg),false,false);l_reg=__uint_as_float(rr[0])+__uint_as_float(rr[1]);}
  if(hi==0)wsf[32+r32]=l_reg;asm volatile("s_waitcnt lgkmcnt(0)":::"memory");
  float rli[16];
  #pragma unroll
  for(int r=0;r<16;++r)rli[r]=__builtin_amdgcn_rcpf(wsf[32+crow(r,hi)]);
  int lane2=lane; asm volatile("":"+v"(lane2));
  bf16*Ow=O+(rowbase+q0+wid*QBLK)*ADM+h*D;
  { bf16*stg=(bf16*)(shm+LDS_OST)+wid*2048;
    #pragma unroll
    for(int r=0;r<16;++r){const int orow=crow(r,hi);
      #pragma unroll
      for(int d0=0;d0<2;++d0)stg[orow*64+d0*32+r32]=__float2bfloat16(o[d0][r]*rli[r]);}
    asm volatile("s_waitcnt lgkmcnt(0)":::"memory");
    #pragma unroll
    for(int i=0;i<4;++i){const int row=i*8+(lane2>>3),ch=lane2&7; const u32x4 v=*(const u32x4*)(stg+row*64+ch*8); *(u32x4*)(Ow+(long)row*ADM+ch*8)=v;
      float s=(bflo(v.x)*bflo(v.x)+bfhi(v.x)*bfhi(v.x))+(bflo(v.y)*bflo(v.y)+bfhi(v.y)*bfhi(v.y))+(bflo(v.z)*bflo(v.z)+bfhi(v.z)*bfhi(v.z))+(bflo(v.w)*bflo(v.w)+bfhi(v.w)*bfhi(v.w));
      s+=__shfl_xor(s,1); s+=__shfl_xor(s,2); s+=__shfl_xor(s,4);
      if(ch==0)SSQ[(rowbase+q0+wid*QBLK+row)*NHEAD+h]=s; } }
  asm volatile("s_waitcnt lgkmcnt(0)\n\ts_barrier":::"memory");
  #undef DMA_K
  #undef DMA_V
  #undef CMASK
  #undef START
  #undef RESC
  #undef ROT
}
#undef SBAR
#undef WAIT_BAR
}

constexpr int RING_BYTES = 131072;
constexpr int LDS_TOTAL = 147456;
struct Args { const float* in[32]; float* out; unsigned char* ws; };
typedef const float* const __attribute__((address_space(4)))* InTab;
enum In { I_X = 0, I_MEM, I_NORM_MIX, I_W_IN, I_FQN, I_FKN, I_FBIAS, I_ARE, I_AIM, I_LOGDT, I_BRE, I_BIM, I_CRE, I_CIM, I_D, I_WGLU, I_BGLU, I_ONF, I_ONS, I_WOUT,
          I_NCROSS, I_NMEM, I_WXQ, I_WXKV, I_XQN, I_XKN, I_WXO, I_NFFN, I_WUP, I_CONVW, I_CONVB, I_WDN };

struct TJob { const float* W; int ldw, col0, ncols, K; const float* kg; const float* kg2; bf16_t* WT; int mapid, rowoff, items; };
__device__ __forceinline__ int tmap(int mapid, int n, int rowoff) {
    if (mapid == 1) { const int part = n >> 9, f = n & 511, head = f >> 6, d = f & 63; return 512 * part + 256 * (head >> 2) + 128 * (d >> 5) + 32 * (head & 3) + (d & 31); }
    if (mapid == 2) { const int isup = n >= DFF ? 1 : 0; const int j = n - isup * DFF; return 256 * (j >> 7) + 128 * isup + (j & 127); }
    return rowoff + n;
}
__device__ __forceinline__ void transpose_item(const TJob& J, LAS float* scr, int item, int lane) {
    LAS unsigned* s32 = (LAS unsigned*)scr; const LAS unsigned short* s16 = (const LAS unsigned short*)scr;
    const int nblk = J.ncols / 128, kb = item / nblk, nb = item % nblk, k0 = 64 * kb, n0 = 128 * nb;
    const float* src = J.W + (size_t)k0 * J.ldw + J.col0 + n0 + 2 * lane;
    float gv = 1.f; if (J.kg) { const int k = k0 + lane; gv = (J.kg2 && k >= 512) ? J.kg2[k - 512] : J.kg[k]; }
#pragma unroll 16
    for (int kk = 0; kk < 64; ++kk) { f32x2 w = *(const f32x2*)(src + (size_t)kk * J.ldw);
        w = w * __builtin_bit_cast(float, __builtin_amdgcn_readlane(__builtin_bit_cast(int, gv), kk));
        s32[kk * 64 + lane] = pk2(w[0], w[1]); }
    asm volatile("s_waitcnt lgkmcnt(0)" ::: "memory");
    const int c = lane & 7;
#pragma unroll 4
    for (int j = 0; j < 16; ++j) { const int n = (lane >> 3) + 8 * j; const LAS unsigned short* s = s16 + (8 * c) * 128 + n;
        u32x4 o; o.x = (unsigned)s[0] | ((unsigned)s[128] << 16); o.y = (unsigned)s[256] | ((unsigned)s[384] << 16); o.z = (unsigned)s[512] | ((unsigned)s[640] << 16); o.w = (unsigned)s[768] | ((unsigned)s[896] << 16);
        *(u32x4*)(J.WT + (size_t)tmap(J.mapid, n0 + n, J.rowoff) * J.K + k0 + 8 * c) = o; }
    asm volatile("s_waitcnt lgkmcnt(0)" ::: "memory");
}
constexpr int NTJ = 11;
__device__ __forceinline__ void get_tjob(InTab in, unsigned char* ws, int j, TJob& J) {
    J.kg = nullptr; J.kg2 = nullptr; J.mapid = 0; J.rowoff = 0; J.col0 = 0;
    switch (j) {
    case 0: J.W = in[I_W_IN]; J.ldw = INCOLS; J.col0 = 0; J.ncols = 1024; J.K = 1024; J.WT = (bf16_t*)(ws + WS_WIN); J.mapid = 1; break;
    case 1: J.W = in[I_W_IN]; J.ldw = INCOLS; J.col0 = 1024; J.ncols = 512; J.K = 1024; J.WT = (bf16_t*)(ws + WS_WIN); J.rowoff = 1024; break;
    case 2: J.W = in[I_W_IN]; J.ldw = INCOLS; J.col0 = 1544; J.ncols = 512; J.K = 1024; J.WT = (bf16_t*)(ws + WS_WIN); J.rowoff = 1536; break;
    case 3: J.W = in[I_WGLU]; J.ldw = 512; J.ncols = 512; J.K = 512; J.WT = (bf16_t*)(ws + WS_WGLU); break;
    case 4: J.W = in[I_WOUT]; J.ldw = 1024; J.ncols = 1024; J.K = 1024; J.WT = (bf16_t*)(ws + WS_WOUT); J.kg = in[I_ONF]; J.kg2 = in[I_ONS]; break;
    case 5: J.W = in[I_WXQ]; J.ldw = 1024; J.ncols = 1024; J.K = 1024; J.WT = (bf16_t*)(ws + WS_WXQ); J.kg = in[I_NCROSS]; break;
    case 6: J.W = in[I_WXKV]; J.ldw = 2048; J.col0 = 0; J.ncols = 1024; J.K = 1024; J.WT = (bf16_t*)(ws + WS_WXK); break;
    case 7: J.W = in[I_WXKV]; J.ldw = 2048; J.col0 = 1024; J.ncols = 1024; J.K = 1024; J.WT = (bf16_t*)(ws + WS_WXV); break;
    case 8: J.W = in[I_WXO]; J.ldw = 1024; J.ncols = 1024; J.K = 1024; J.WT = (bf16_t*)(ws + WS_WXO); break;
    case 9: J.W = in[I_WUP]; J.ldw = 2 * DFF; J.ncols = 2 * DFF; J.K = 1024; J.WT = (bf16_t*)(ws + WS_WUP); J.kg = in[I_NFFN]; J.mapid = 2; break;
    default: J.W = in[I_WDN]; J.ldw = 1024; J.ncols = 1024; J.K = DFF; J.WT = (bf16_t*)(ws + WS_WDN); break;
    }
    J.items = (J.K / 64) * (J.ncols / 128);
}

__device__ __forceinline__ void rms_row(const float* xrow, const float* gain, bf16_t* orow, int lane, f32x4 (&v)[4]) {
    const f32x4* xr = (const f32x4*)xrow + lane; float s = 0.f;
#pragma unroll
    for (int j = 0; j < 4; ++j) { v[j] = xr[64 * j]; s += (v[j][0] * v[j][0] + v[j][1] * v[j][1]) + (v[j][2] * v[j][2] + v[j][3] * v[j][3]); }
    const float rs = rsqrtf(wave_sum(s) * (1.f / DM) + EPS);
    u32x2* o8 = (u32x2*)orow + lane;
#pragma unroll
    for (int j = 0; j < 4; ++j) { v[j] = v[j] * rs * ((const f32x4*)gain)[64 * j + lane]; u32x2 w; w.x = pk2(v[j][0], v[j][1]); w.y = pk2(v[j][2], v[j][3]); o8[64 * j] = w; }
}

__device__ __forceinline__ void cpow(float ar, float ai, float dt, float e, float& r, float& i) {
    const float mag = __expf(ar * dt * e);
    float rev = ai * dt * e * 0.15915494309189535f; rev -= rintf(rev);
    const float ang = rev * 6.283185307179586f;
    r = mag * cosf(ang); i = mag * sinf(ang);
}

template <int NT>
__device__ __forceinline__ void s5_prep_task(InTab in, unsigned char* ws, int g, int tt, LAS float* L, int tid, bool valid) {
    LAS float* pwA = L; LAS float* pwB = L + 128; LAS float* pwC = L + 256; LAS float* cf = L + 384; LAS float* bb = L + 512; LAS float* cc = L + 512 + 2048;
    if (valid) {
        const float dt = __expf(in[I_LOGDT][g]);
        if (tid < 64) { const int p = tid; const float ar = in[I_ARE][g * 64 + p], ai = in[I_AIM][g * 64 + p];
            float r, i; cpow(ar, ai, dt, (float)tt, r, i); pwA[2 * p] = r; pwA[2 * p + 1] = i;
            cpow(ar, ai, dt, (float)(tt + 1), r, i); pwB[2 * p] = r; pwB[2 * p + 1] = i;
            cpow(ar, ai, dt, (float)(TC - 1 - tt), r, i); pwC[2 * p] = r; pwC[2 * p + 1] = i;
            float lr, li; cpow(ar, ai, dt, 1.f, lr, li);
            const float den = ar * ar + ai * ai, nr = lr - 1.f;
            cf[2 * p] = (nr * ar + li * ai) / den; cf[2 * p + 1] = (li * ar - nr * ai) / den;
            if (tt == 0) { cpow(ar, ai, dt, (float)TC, r, i); float* lb = (float*)(ws + WS_LB32); lb[(g * 64 + p) * 2] = r; lb[(g * 64 + p) * 2 + 1] = i; } }
        for (int idx = tid; idx < 1024; idx += NT) { cc[2 * idx] = in[I_CRE][g * 1024 + idx]; cc[2 * idx + 1] = in[I_CIM][g * 1024 + idx]; }
    }
    __syncthreads();
    if (valid)
        for (int idx = tid; idx < 1024; idx += NT) { const int p = idx >> 4; const float br = in[I_BRE][g * 1024 + idx], bi = in[I_BIM][g * 1024 + idx], cr = cf[2 * p], ci = cf[2 * p + 1];
            bb[2 * idx] = cr * br - ci * bi; bb[2 * idx + 1] = cr * bi + ci * br; }
    __syncthreads();
    if (valid) {
        for (int e = tid; e < 256; e += NT) {
            const int c = e >> 4, cp = e & 15; float s = 0.f;
            for (int p = 0; p < 64; ++p) { const float pr = pwA[2 * p], pi = pwA[2 * p + 1], br = bb[2 * (p * 16 + cp)], bi = bb[2 * (p * 16 + cp) + 1];
                const float mr = pr * br - pi * bi, mi = pr * bi + pi * br; s += cc[2 * (c * 64 + p)] * mr - cc[2 * (c * 64 + p) + 1] * mi; }
            if (tt == 0 && c == cp) s += in[I_D][g * 16 + c];
            ((float*)(ws + WS_KTAB))[((g * TC + tt) * 16 + c) * 16 + cp] = s; }
        bf16_t* bty = (bf16_t*)(ws + WS_BTY) + (size_t)g * 512 * UGP; bf16_t* bte = (bf16_t*)(ws + WS_BTE) + (size_t)g * 256 * 512;
        for (int idx = tid; idx < 1024; idx += NT) { const int c = idx >> 6, p = idx & 63;
            const float cr = cc[2 * idx], ci = cc[2 * idx + 1], pr = pwB[2 * p], pi = pwB[2 * p + 1];
            const float zr = cr * pr - ci * pi, zi = cr * pi + ci * pr;
            *(unsigned*)(bty + (size_t)(tt * 16 + c) * UGP + 512 + 2 * p) = pk2(zr, -zi); }
        for (int idx = tid; idx < 1024; idx += NT) { const int p = idx >> 4, cp = idx & 15;
            const float pr = pwC[2 * p], pi = pwC[2 * p + 1], br = bb[2 * idx], bi = bb[2 * idx + 1];
            bte[(size_t)(2 * p) * 512 + tt * 16 + cp] = (bf16_t)f2bf(pr * br - pi * bi); bte[(size_t)(2 * p + 1) * 512 + tt * 16 + cp] = (bf16_t)f2bf(pr * bi + pi * br); }
        for (int u = tid; u < 256; u += NT) *(u32x4*)(bte + (size_t)(128 + (u >> 1)) * 512 + tt * 16 + (u & 1) * 8) = (u32x4){0u, 0u, 0u, 0u};
    }
    __syncthreads();
}

#define RLX_AGENT __ATOMIC_RELAXED, __HIP_MEMORY_SCOPE_AGENT
#define XB_TMO      128
#define XB_XCNT(j)  (256  + 64 * (j))
#define XB_XSUB(j)  (1280 + 64 * (j))
#define XB_XGEN(j)  (2304 + 64 * (j))
#define XB_TOP      3328
#define XB_TOPGEN   3392
#define XCD_BAR_WORDS 3456
#define XB_SPIN_CAP (1u << 18)

__device__ __forceinline__ unsigned xb_ld(unsigned* p)              { return __hip_atomic_load(p, __ATOMIC_RELAXED, __HIP_MEMORY_SCOPE_AGENT); }
__device__ __forceinline__ unsigned xb_add(unsigned* p, unsigned v) { return __hip_atomic_fetch_add(p, v, __ATOMIC_RELAXED, __HIP_MEMORY_SCOPE_AGENT); }
__device__ __forceinline__ unsigned xb_xcc_id() { return (unsigned)__builtin_amdgcn_s_getreg((3 << 11) | 20) & 0xFu; }
#define XB_SPIN(cond, bar) do { unsigned _sp = 0; while (cond) { __builtin_amdgcn_s_sleep(1); \
    if ((++_sp & 255u) == 0u) { if (xb_ld(&(bar)[XB_TMO])) break; if (_sp > XB_SPIN_CAP) { atomicAdd(&(bar)[XB_TMO], 1u); break; } } } } while (0)

struct XcdBarrier {
    unsigned* bar; unsigned x;
    volatile LAS unsigned* st;
};

__device__ __forceinline__ XcdBarrier xcd_barrier_post(unsigned* bar, volatile LAS unsigned* st) {
    XcdBarrier b; b.bar = bar; b.x = xb_xcc_id(); b.st = st;
    if (threadIdx.x == 0) (void)xb_add(&bar[XB_XCNT(b.x)], 1u);
    return b;
}
__device__ __forceinline__ void xcd_barrier_complete(unsigned* bar, unsigned x, unsigned& nloc, unsigned& nx) {
    const unsigned G = gridDim.x * gridDim.y * gridDim.z;
    unsigned sum, cnt, mine, sp = 0u;
    for (;;) {
        sum = 0u; cnt = 0u; mine = 0u;
#pragma unroll
        for (unsigned j = 0; j < 16; ++j) { const unsigned c = xb_ld(&bar[XB_XCNT(j)]); sum += c; cnt += (c > 0u) ? 1u : 0u; mine = (j == x) ? c : mine; }
        if (sum == G) break;
        __builtin_amdgcn_s_sleep(1);
        if ((++sp & 255u) == 0u) { if (xb_ld(&bar[XB_TMO])) break; if (sp > XB_SPIN_CAP) { atomicAdd(&bar[XB_TMO], 1u); break; } }
    }
    nloc = mine > 0u ? mine : 1u; nx = cnt > 0u ? cnt : 1u;
}

__device__ __forceinline__ void xcd_barrier(const XcdBarrier& b) {
    asm volatile("s_waitcnt vmcnt(0)" ::: "memory");
    __syncthreads();
    if (threadIdx.x == 0) {
        unsigned* bar = b.bar;
        __builtin_amdgcn_s_waitcnt(0);
        unsigned nloc = b.st[0], nx = b.st[1];
        if (nloc == 0u) { xcd_barrier_complete(bar, b.x, nloc, nx); b.st[0] = nloc; b.st[1] = nx; }
        const unsigned old = xb_add(&bar[XB_XSUB(b.x)], 1u);
        const unsigned gen = old / nloc;
        if (old + 1u == (gen + 1u) * nloc) {
            __builtin_amdgcn_fence(__ATOMIC_RELEASE, "agent");
            asm volatile("s_waitcnt vmcnt(0)" ::: "memory");
            const unsigned og = xb_add(&bar[XB_TOP], 1u);
            const unsigned tg = og / nx;
            if (og + 1u == (tg + 1u) * nx) xb_add(&bar[XB_TOPGEN], 1u);
            else XB_SPIN(xb_ld(&bar[XB_TOPGEN]) == tg, bar);
            __builtin_amdgcn_fence(__ATOMIC_ACQUIRE, "agent");
            xb_add(&bar[XB_XGEN(b.x)], 1u);
            asm volatile("s_waitcnt vmcnt(0)" ::: "memory");
        } else {
            XB_SPIN(xb_ld(&bar[XB_XGEN(b.x)]) == gen, bar);
            __builtin_amdgcn_fence(__ATOMIC_ACQUIRE, "agent");
            asm volatile("s_waitcnt vmcnt(0)" ::: "memory");
        }
    }
    __syncthreads();
}


#ifndef FIRST_STEP
#define FIRST_STEP 0
#endif
#ifndef LAST_STEP
#define LAST_STEP 18
#endif
#define ON(n) (FIRST_STEP <= (n) && (n) <= LAST_STEP)
#define SYNC(n) do { if ((n) < LAST_STEP) { XcdBarrier bar_; bar_.bar = (unsigned*)ws; bar_.x = xb_xcc_id(); bar_.st = (volatile LAS unsigned*)(L + RING_BYTES + 352); xcd_barrier(bar_); } } while (0)
#define WSB(off) ((const bf16_t*)(ws + (off)))
__global__ void __launch_bounds__(512, 2) fox_s5_mega(Args a) {
    extern __shared__ __attribute__((aligned(16))) unsigned char lds[];
    LAS unsigned char* L = (LAS unsigned char*)lds;
    const int G = gridDim.x, bx = blockIdx.x, NGW = G * 8, NGT = G * 512;
#define KA const __attribute__((address_space(4))) unsigned char* ka_ = (const __attribute__((address_space(4))) unsigned char*)__builtin_amdgcn_kernarg_segment_ptr(); asm volatile("" : "+s"(ka_)); \
    InTab in = (InTab)ka_; float* out = *(float* const __attribute__((address_space(4)))*)(ka_ + 256); unsigned char* ws = *(unsigned char* const __attribute__((address_space(4)))*)(ka_ + 264); (void)in; (void)out;
#define IDS int tid = threadIdx.x; asm volatile("" : "+v"(tid)); const int lane = tid & 63, wave = __builtin_amdgcn_readfirstlane(tid >> 6); const int gw = bx * 8 + wave, gt = bx * 512 + tid; (void)lane; (void)gw; (void)gt;
    {
        KA
        if (threadIdx.x < 8) ((volatile LAS unsigned*)(L + RING_BYTES + 320))[threadIdx.x + 8 - 8] = 0u;
        if (threadIdx.x < 2) ((volatile LAS unsigned*)(L + RING_BYTES + 352))[threadIdx.x] = 0u;
        __syncthreads();
        (void)xcd_barrier_post((unsigned*)ws, (volatile LAS unsigned*)(L + RING_BYTES + 352));
    }

    if (ON(0)) {
        KA
        IDS
        LAS float* scr = (LAS float*)(L + wave * 16384);
        { int base = 0;
          for (int j = 0; j < NTJ; ++j) { TJob J; get_tjob(in, ws, j, J);
              int first = gw - (base % NGW); if (first < 0) first += NGW;
              for (int it = first; it < J.items; it += NGW) transpose_item(J, scr, it, lane);
              base += J.items; } }
        __syncthreads();
        LAS float* wf = (LAS float*)L;
        for (int idx = tid; idx < 8192; idx += 512) wf[idx] = in[I_W_IN][(size_t)(idx >> 3) * INCOLS + 1536 + (idx & 7)];
        __syncthreads();
        {
            f32x4 nx[4];
            if (gw < T) { const f32x4* xr = (const f32x4*)(in[I_X] + (size_t)gw * DM) + lane;
#pragma unroll
                for (int j = 0; j < 4; ++j) nx[j] = xr[64 * j]; }
            const f32x4* gp = (const f32x4*)in[I_NORM_MIX]; f32x4 gn[4];
#pragma unroll
            for (int j = 0; j < 4; ++j) gn[j] = gp[64 * j + lane];
            const float fbias = in[I_FBIAS][lane & 7];
            for (int m = gw; m < T; m += NGW) {
                f32x4 v[4]; float s = 0.f;
#pragma unroll
                for (int j = 0; j < 4; ++j) { v[j] = nx[j]; s += (v[j][0] * v[j][0] + v[j][1] * v[j][1]) + (v[j][2] * v[j][2] + v[j][3] * v[j][3]); }
                if (m + NGW < T) { const f32x4* xr = (const f32x4*)(in[I_X] + (size_t)(m + NGW) * DM) + lane;
#pragma unroll
                    for (int j = 0; j < 4; ++j) nx[j] = xr[64 * j]; }
                const float rs = rsqrtf(wave_sum(s) * (1.f / DM) + EPS);
                u32x2* o8 = (u32x2*)((bf16_t*)(ws + WS_HN) + (size_t)m * DM) + lane;
#pragma unroll
                for (int j = 0; j < 4; ++j) { v[j] = v[j] * rs * gn[j]; u32x2 w; w.x = pk2(v[j][0], v[j][1]); w.y = pk2(v[j][2], v[j][3]); o8[64 * j] = w; }
                float d[8];
#pragma unroll
                for (int h = 0; h < 8; ++h) d[h] = 0.f;
#pragma unroll
                for (int j = 0; j < 4; ++j)
#pragma unroll
                    for (int i = 0; i < 4; ++i) { const int k = 256 * j + 4 * lane + i; const f32x4 w0 = *(const LAS f32x4*)(wf + k * 8), w1 = *(const LAS f32x4*)(wf + k * 8 + 4);
                        d[0] += v[j][i] * w0[0]; d[1] += v[j][i] * w0[1]; d[2] += v[j][i] * w0[2]; d[3] += v[j][i] * w0[3];
                        d[4] += v[j][i] * w1[0]; d[5] += v[j][i] * w1[1]; d[6] += v[j][i] * w1[2]; d[7] += v[j][i] * w1[3]; }
                float e4[4];
#pragma unroll
                for (int h = 0; h < 4; ++h) { const float keep = (lane & 4) ? d[h + 4] : d[h], give = (lane & 4) ? d[h] : d[h + 4]; e4[h] = keep + __shfl_xor(give, 4); }
                float e2[2];
#pragma unroll
                for (int h = 0; h < 2; ++h) { const float keep = (lane & 2) ? e4[h + 2] : e4[h], give = (lane & 2) ? e4[h] : e4[h + 2]; e2[h] = keep + __shfl_xor(give, 2); }
                float z; { const float keep = (lane & 1) ? e2[1] : e2[0], give = (lane & 1) ? e2[0] : e2[1]; z = keep + __shfl_xor(give, 1); }
                z += __shfl_xor(z, 8); z += __shfl_xor(z, 16); z += __shfl_xor(z, 32);
                if (lane < 8) {
                    z += fbias;
                    const float ls = fminf(z, 0.f) - __logf(1.f + __expf(-fabsf(z)));
                    const int b = m >> 11, t = m & 2047;
                    ((float*)(ws + WS_LOGF))[(size_t)(b * 8 + lane) * SEQ + t] = ls; }
            }
        }
        for (int m = gw; m < TM; m += NGW) { f32x4 v[4]; rms_row(in[I_MEM] + (size_t)m * DM, in[I_NMEM], (bf16_t*)(ws + WS_MN) + (size_t)m * DM, lane, v); }
        __syncthreads();
        {
            const int NTASK = S5G * TC, sub = tid >> 7, ltid = tid & 127, per = NTASK / G;
            for (int i0 = 0; bx + i0 * G < NTASK; i0 += 4) { const int task = bx + (i0 + sub) * G; const bool valid = task < NTASK;
                const int t2 = !valid ? 0 : ((NTASK % G == 0) ? (task % G) * per + task / G : task);
                s5_prep_task<128>(in, ws, t2 / TC, t2 % TC, (LAS float*)L + sub * 5120, ltid, valid); }
        }
        SYNC(0);
    }
    if (ON(2)) {
        KA
        pg8::Gemm g{WSB(WS_HN), WSB(WS_WIN), DM, DM, DM}; GOrder<OK_PLAIN> S; S.init(T / 256, 8, G, bx, DM, DM);
        Epi<EK_PROJ> E{ws + WS_Q, ws + WS_K, ws + WS_V, ws + WS_UG, in[I_FQN], in[I_FKN], nullptr};
        pg8::gemm_phase(L, g, S, E);
    }
    if (ON(1)) {
        KA
        IDS
        int seq = (bx < BATCH * NFH) ? bx : -1;
        if (G == 256) seq = (bx >= 64 && bx < 128) ? bx - 64 : ((bx >= 192) ? bx - 128 : -1);
        if (wave == 0 && seq >= 0) {
            const float* lf = (const float*)(ws + WS_LOGF) + (size_t)seq * SEQ + lane * 32; float* cb = (float*)(ws + WS_CB) + (size_t)seq * SEQ + lane * 32;
            f32x4 x[8]; float run = 0.f;
#pragma unroll
            for (int j = 0; j < 8; ++j) { x[j] = ((const f32x4*)lf)[j]; x[j][0] += run; x[j][1] += x[j][0]; x[j][2] += x[j][1]; x[j][3] += x[j][2]; run = x[j][3]; }
            float incl = run;
#pragma unroll
            for (int o = 1; o < 64; o <<= 1) { const float y = __shfl_up(incl, o); if (lane >= o) incl += y; }
            const float excl = incl - run;
#pragma unroll
            for (int j = 0; j < 8; ++j) ((f32x4*)cb)[j] = (x[j] + excl) * LOG2E;
        }
    }
    if (ON(3)) {
        KA
        pg8::Gemm g{WSB(WS_MN), WSB(WS_WXK), DM, DM, DM}; GOrder<OK_PLAIN> S; S.init(TM / 256, 4, G, bx, DM, DM);
        Epi<EK_MEMK> E{ws + WS_KST, ws + WS_SSQK, nullptr, nullptr, nullptr, nullptr, nullptr};
        pg8::gemm_phase(L, g, S, E);
    }
    if (ON(4)) {
        KA
        pg8::Gemm g{WSB(WS_WXV), WSB(WS_MN), DM, DM, DM}; GOrder<OK_PLAIN> S; S.init(4, TM / 256, G, (bx + 128) % G, DM, DM);
        Epi<EK_MEMVT> E{ws + WS_VT, nullptr, nullptr, nullptr, nullptr, nullptr, nullptr};
        pg8::gemm_phase(L, g, S, E);
        SYNC(4);
    }
    if (ON(5)) {
        KA
        const int vcu = (G % 8 == 0) ? (bx % 8) * (G / 8) + bx / 8 : bx;
        float skip_th; { const int ln = threadIdx.x & 63; float gq = fabsf(in[I_FQN][ln]), gk = fabsf(in[I_FKN][ln]);
#pragma unroll
            for (int o = 1; o < 64; o <<= 1) { gq = fmaxf(gq, __shfl_xor(gq, o)); gk = fmaxf(gk, __shfl_xor(gk, o)); }
            skip_th = 2.f * (64.f * C2Q * gq * gk) + 40.f; }
        for (int L2 = vcu; L2 < BATCH * NFH * 2; L2 += G) { const int bh = L2 >> 1, s = L2 & 1;
            for (int i = 0; i < 4; ++i) { const int qb = (i == 0) ? s : (i == 1) ? 3 - s : (i == 2) ? 4 + s : 7 - s;
                attn_body::attn_unit<8>(bh >> 3, bh & 7, qb, (const attn_body::bf16*)(ws + WS_Q), (const attn_body::bf16*)(ws + WS_K), (const attn_body::bf16*)(ws + WS_V),
                                        (attn_body::bf16*)(ws + WS_FOX), (const float*)(ws + WS_CB), (float*)(ws + WS_SSQF), (char*)lds, skip_th); } }
    }
    if (ON(6)) {
        KA
        pg8::Gemm g{WSB(WS_UG), WSB(WS_BTE), UGP, 512, 256}; GOrder<OK_S5E> S; S.init(256, 1, G, bx, UGP, 512);
        Epi<EK_S5E> E{ws + WS_EPART, nullptr, nullptr, nullptr, nullptr, nullptr, nullptr};
        pg8::gemm_phase(L, g, S, E);
        SYNC(6);
    }
    if (ON(7)) {
        KA
        IDS
        const float* kt = (const float*)(ws + WS_KTAB); bf16_t* bty = (bf16_t*)(ws + WS_BTY);
        for (int idx = gt; idx < S5G * 512 * 64; idx += NGT) {
            const int half = idx & 1, ss = (idx >> 1) & 31, nn = (idx >> 6) & 511, gI = idx >> 15; const int tt = nn >> 4, c = nn & 15;
            u32x4 w = (u32x4){0u, 0u, 0u, 0u};
            if (ss <= tt) { const float* src = kt + ((size_t)((gI * TC + (tt - ss)) * 16 + c)) * 16 + half * 8; const f32x4 k0 = *(const f32x4*)src, k1 = *(const f32x4*)(src + 4);
                w.x = pk2(k0[0], k0[1]); w.y = pk2(k0[2], k0[3]); w.z = pk2(k1[0], k1[1]); w.w = pk2(k1[2], k1[3]); }
            *(u32x4*)(bty + ((size_t)gI * 512 + nn) * UGP + ss * 16 + half * 8) = w; }
        const float* ep = (const float*)(ws + WS_EPART); const float* lb = (const float*)(ws + WS_LB32); bf16_t* ug = (bf16_t*)(ws + WS_UG);
        for (int idx = gt; idx < S5G * BATCH * S5P; idx += NGT) { const int p = idx & 63, gb = idx >> 6, gI = gb >> 4;
            const float lr = lb[(gI * 64 + p) * 2], li = lb[(gI * 64 + p) * 2 + 1]; float sr = 0.f, si = 0.f;
            for (int k0 = 0; k0 < NCH; k0 += 16) {
                f32x2 e0[16], e1[16];
#pragma unroll
                for (int j = 0; j < 16; ++j) { const size_t row = (size_t)gb * NCH + k0 + j; e0[j] = *(const f32x2*)(ep + row * 128 + 2 * p); e1[j] = *(const f32x2*)(ep + (size_t)32768 * 128 + row * 128 + 2 * p); }
#pragma unroll
                for (int j = 0; j < 16; ++j) { const size_t row = (size_t)gb * NCH + k0 + j;
                    *(unsigned*)(ug + row * UGP + 512 + 2 * p) = pk2(sr, si);
                    const float nr = lr * sr - li * si + (e0[j][0] + e1[j][0]), ni = lr * si + li * sr + (e0[j][1] + e1[j][1]); sr = nr; si = ni; } } }
        SYNC(7);
    }
    if (ON(8)) {
        KA
        pg8::Gemm g{WSB(WS_UG), WSB(WS_BTY), UGP, UGP, UGP}; GOrder<OK_S5Y> S; S.init(256, 1, G, bx, UGP, UGP);
        Epi<EK_S5Y> E{ws + WS_Y1, nullptr, nullptr, nullptr, nullptr, nullptr, nullptr};
        pg8::gemm_phase(L, g, S, E);
        SYNC(8);
    }
    if (ON(9)) {
        KA
        pg8::Gemm g{WSB(WS_Y1), WSB(WS_WGLU), 512, 512, 512}; GOrder<OK_PLAIN> S; S.init(T / 256, 2, G, bx, 512, 512);
        Epi<EK_GLU> E{ws + WS_Y2, ws + WS_SSQY, nullptr, nullptr, ws + WS_Y1, in[I_BGLU], nullptr};
        pg8::gemm_phase(L, g, S, E);
        SYNC(9);
    }
    if (ON(10)) {
        KA
        IDS
        const float* sf = (const float*)(ws + WS_SSQF); const float* sy = (const float*)(ws + WS_SSQY);
        const bf16_t* fox = WSB(WS_FOX); const bf16_t* y2 = WSB(WS_Y2); bf16_t* mx = (bf16_t*)(ws + WS_MIXN);
        {
            f32x4 a0, a1, b0, b1; u32x4 f, y;
#define NRM_LOAD(mm) do { a0 = *(const f32x4*)(sf + (size_t)(mm) * 8); a1 = *(const f32x4*)(sf + (size_t)(mm) * 8 + 4); b0 = *(const f32x4*)(sy + (size_t)(mm) * 8); b1 = *(const f32x4*)(sy + (size_t)(mm) * 8 + 4); \
                f = *(const u32x4*)(fox + (size_t)(mm) * 512 + lane * 8); y = *(const u32x4*)(y2 + (size_t)(mm) * 512 + lane * 8); } while (0)
            if (gw < T) NRM_LOAD(gw);
            for (int m = gw; m < T; m += NGW) {
                const float rf = rsqrtf((((a0[0] + a0[1]) + (a0[2] + a0[3])) + ((a1[0] + a1[1]) + (a1[2] + a1[3]))) * (1.f / 512.f) + EPS);
                const float ry = rsqrtf((((b0[0] + b0[1]) + (b0[2] + b0[3])) + ((b1[0] + b1[1]) + (b1[2] + b1[3]))) * (1.f / 512.f) + EPS);
                u32x4 of, oy;
                of.x = pk2(bflo(f.x) * rf, bfhi(f.x) * rf); of.y = pk2(bflo(f.y) * rf, bfhi(f.y) * rf); of.z = pk2(bflo(f.z) * rf, bfhi(f.z) * rf); of.w = pk2(bflo(f.w) * rf, bfhi(f.w) * rf);
                oy.x = pk2(bflo(y.x) * ry, bfhi(y.x) * ry); oy.y = pk2(bflo(y.y) * ry, bfhi(y.y) * ry); oy.z = pk2(bflo(y.z) * ry, bfhi(y.z) * ry); oy.w = pk2(bflo(y.w) * ry, bfhi(y.w) * ry);
                if (m + NGW < T) NRM_LOAD(m + NGW);
                *(u32x4*)(mx + (size_t)m * DM + lane * 8) = of; *(u32x4*)(mx + (size_t)m * DM + 512 + lane * 8) = oy; }
#undef NRM_LOAD
        }
        SYNC(10);
    }
    if (ON(11)) {
        KA
        pg8::Gemm g{WSB(WS_MIXN), WSB(WS_WOUT), DM, DM, DM}; GOrder<OK_PLAIN> S; S.init(T / 256, 4, G, bx, DM, DM);
        Epi<EK_WOUT> E{out, ws + WS_H1B, ws + WS_SSQ1, nullptr, in[I_X], nullptr, nullptr};
        pg8::gemm_phase(L, g, S, E);
        SYNC(11);
    }
    if (ON(12)) {
        KA
        IDS
        const float* sk = (const float*)(ws + WS_SSQK); float* sck = (float*)(ws + WS_SCK);
        for (int idx = gt; idx < TM * 4; idx += NGT) { const int key = idx >> 2, h = idx & 3; const f32x4 q = *(const f32x4*)(sk + (size_t)key * 16 + h * 4);
            sck[(size_t)h * TM + key] = rsqrtf(((q[0] + q[1]) + (q[2] + q[3])) * (1.f / 256.f) + EPS); }
        pg8::Gemm g{WSB(WS_H1B), WSB(WS_WXQ), DM, DM, DM}; GOrder<OK_PLAIN> S; S.init(T / 256, 4, G, bx, DM, DM);
        Epi<EK_XQ> E{ws + WS_QST, ws + WS_SSQQ, nullptr, nullptr, in[I_XQN], in[I_XKN], nullptr};
        pg8::gemm_phase(L, g, S, E);
        SYNC(12);
    }
    if (ON(13)) {
        KA
        pg8::Gemm g{WSB(WS_QST), WSB(WS_KST), DM, DM, 256}; GOrder<OK_XS> S; S.init(512, 1, G, bx, DM, DM);
        Epi<EK_XS> E{ws + WS_P, ws + WS_PSUM, nullptr, nullptr, ws + WS_SSQ1, ws + WS_SSQQ, ws + WS_SCK};
        pg8::gemm_phase(L, g, S, E);
        SYNC(13);
    }
    if (ON(14)) {
        KA
        pg8::Gemm g{WSB(WS_P), WSB(WS_VT), DM, TM, 256}; GOrder<OK_XO> S; S.init(512, 1, G, bx, DM, TM);
        Epi<EK_XO> E{ws + WS_XO, nullptr, nullptr, nullptr, ws + WS_PSUM, nullptr, nullptr};
        pg8::gemm_phase(L, g, S, E);
        SYNC(14);
    }
    if (ON(15)) {
        KA
        pg8::Gemm g{WSB(WS_XO), WSB(WS_WXO), DM, DM, DM}; GOrder<OK_PLAIN> S; S.init(T / 256, 4, G, bx, DM, DM);
        Epi<EK_WXO> E{out, ws + WS_H2B, ws + WS_SSQ2, nullptr, out, nullptr, nullptr};
        pg8::gemm_phase(L, g, S, E);
        SYNC(15);
    }
    if (ON(16)) {
        KA
        { IDS
          const float* s2 = (const float*)(ws + WS_SSQ2); float* r2 = (float*)(ws + WS_RS2);
          for (int row = gt; row < T; row += NGT) { const f32x4 t0 = *(const f32x4*)(s2 + (size_t)row * 16), t1 = *(const f32x4*)(s2 + (size_t)row * 16 + 4), t2 = *(const f32x4*)(s2 + (size_t)row * 16 + 8), t3 = *(const f32x4*)(s2 + (size_t)row * 16 + 12);
              r2[row] = rsqrtf((((t0[0] + t0[1]) + (t0[2] + t0[3])) + ((t1[0] + t1[1]) + (t1[2] + t1[3])) + ((t2[0] + t2[1]) + (t2[2] + t2[3])) + ((t3[0] + t3[1]) + (t3[2] + t3[3]))) * (1.f / DM) + EPS); }
          SYNC(15); }
        pg8::Gemm g{WSB(WS_H2B), WSB(WS_WUP), DM, DM, DM}; GOrder<OK_PLAIN> S; S.init(T / 256, 22, G, bx, DM, DM);
        Epi<EK_UPC> E{ws + WS_U, ws + WS_G, ws + WS_G + 4 * MiB, ws + WS_G + 8 * MiB, ws + WS_RS2, in[I_CONVW], in[I_CONVB], (LAS float*)(L + RING_BYTES + 1024)};
        pg8::gemm_phase(L, g, S, E);
        SYNC(16);
    }
    if (ON(17)) {
        KA
        IDS
        const float* GHF = (const float*)(ws + WS_G); const float* GHL = (const float*)(ws + WS_G + 4 * MiB); const float* UH = (const float*)(ws + WS_G + 8 * MiB);
        const float* cw = in[I_CONVW]; const float* cbv = in[I_CONVB]; bf16_t* A = (bf16_t*)(ws + WS_U);
        for (int idx = gt; idx < (T / 256) * 2 * DFF; idx += NGT) { const int j = idx % DFF, pi = idx / DFF, i = pi & 1, pm = pi >> 1; const bool first = (pm & 7) == 0;
            const float g0 = GHF[(size_t)pi * DFF + j];
            const float gl1 = first ? 0.f : GHL[((size_t)(pm - 1) * 2 + 1) * DFF + j], gl0 = first ? 0.f : GHL[((size_t)(pm - 1) * 2) * DFF + j];
            const float g1 = i ? GHF[(size_t)(pm * 2) * DFF + j] : gl1, g2 = i ? gl1 : gl0;
            const float z = cbv[j] + cw[j] * g2 + cw[DFF + j] * g1 + cw[2 * DFF + j] * g0;
            A[(size_t)(pm * 256 + i) * DFF + j] = (bf16_t)f2bf(z * sigm(z) * UH[(size_t)pi * DFF + j]); }
        SYNC(17);
    }
    if (ON(18)) {
        KA
        pg8::Gemm g{WSB(WS_U), WSB(WS_WDN), DFF, DFF, DFF}; GOrder<OK_PLAIN> S; S.init(T / 256, 4, G, bx, DFF, DFF);
        Epi<EK_DOWN> E{out, nullptr, nullptr, nullptr, nullptr, nullptr, nullptr};
        pg8::gemm_phase(L, g, S, E);
    }
}

extern "C" void kernel_launch(void* const* d_in, const int* in_sizes, int n_in, void* d_out, int out_size, void* d_ws, size_t ws_size, hipStream_t stream) {
    static int grid = 0;
    if (grid == 0) {
        if (n_in != 32 || out_size != T * DM || ws_size < WS_END) { fprintf(stderr, "kernel_launch: unexpected shapes (n_in %d out %d ws %zu)\n", n_in, out_size, ws_size); grid = -1; return; }
        int dev = 0, cus = 0, per_cu = 0;
        (void)hipGetDevice(&dev); (void)hipDeviceGetAttribute(&cus, hipDeviceAttributeMultiprocessorCount, dev);
        if (hipFuncSetAttribute((const void*)fox_s5_mega, hipFuncAttributeMaxDynamicSharedMemorySize, LDS_TOTAL) != hipSuccess) { fprintf(stderr, "kernel_launch: hipFuncSetAttribute failed\n"); grid = -1; return; }
        if (hipOccupancyMaxActiveBlocksPerMultiprocessor(&per_cu, (const void*)fox_s5_mega, 512, LDS_TOTAL) != hipSuccess || per_cu < 1) { fprintf(stderr, "kernel_launch: occupancy query says %d\n", per_cu); per_cu = 1; }
        (void)hipGetLastError();
        grid = cus;
        if (grid > cus * per_cu) grid = cus * per_cu;
    }
    if (grid < 0) return;
    if (hipMemsetAsync(d_ws, 0, 65536, stream) != hipSuccess) { fprintf(stderr, "kernel_launch: memset of the barrier words failed\n"); return; }
    Args a{};
    for (int i = 0; i < 32; ++i) a.in[i] = (const float*)d_in[i];
    a.out = (float*)d_out; a.ws = (unsigned char*)d_ws;
    void* args[] = {&a};
    hipError_t e = hipLaunchCooperativeKernel((const void*)fox_s5_mega, dim3(grid), dim3(512), args, LDS_TOTAL, stream);
    if (e != hipSuccess) fprintf(stderr, "cooperative launch failed: %s (grid %d)\n", hipGetErrorString(e), grid);
}
```

```cpp
#include <hip/hip_runtime.h>
#include <hip/hip_bf16.h>
#include <cstdio>
#include <cstdint>
#include <cmath>

constexpr int BATCH = 16, SEQ = 2048, DM = 1024, T = BATCH * SEQ;
constexpr int NMEM = 256, TM = BATCH * NMEM;
constexpr int FOXW = 512, HD = 64, NFH = 8;
constexpr int S5W = 512, S5G = 32, S5C = 16, S5P = 64;
constexpr int NXH = 4, XHD = 256;
constexpr int DFF = 2816;
constexpr int INCOLS = 2056;
constexpr float EPS = 1e-6f;
constexpr int TC = 32, NCH = SEQ / TC;
constexpr int UGP = TC * 16 + 128;
constexpr float LOG2E = 1.4426950408889634f;
constexpr float C2Q = 0.125f * LOG2E;

#define LAS __attribute__((address_space(3)))
typedef unsigned short bf16_t;
typedef short bf16x8 __attribute__((ext_vector_type(8)));
typedef float f32x4 __attribute__((ext_vector_type(4)));
typedef float f32x2 __attribute__((ext_vector_type(2)));
typedef unsigned u32x4 __attribute__((ext_vector_type(4)));
typedef unsigned u32x2 __attribute__((ext_vector_type(2)));

__device__ __forceinline__ unsigned f2bf(float f) { unsigned u = __builtin_bit_cast(unsigned, f); return (u + 0x7fffu + ((u >> 16) & 1u)) >> 16; }
typedef __bf16 bf16x2_hw __attribute__((ext_vector_type(2)));
__device__ __forceinline__ unsigned pk2(float lo, float hi) { f32x2 v = {lo, hi}; bf16x2_hw b = __builtin_convertvector(v, bf16x2_hw); return __builtin_bit_cast(unsigned, b); }
__device__ __forceinline__ float bflo(unsigned w) { return __builtin_bit_cast(float, w << 16); }
__device__ __forceinline__ float bfhi(unsigned w) { return __builtin_bit_cast(float, w & 0xffff0000u); }
__device__ __forceinline__ float wave_sum(float v) {
#pragma unroll
    for (int o = 1; o < 64; o <<= 1) v += __shfl_xor(v, o);
    return v;
}

__device__ __forceinline__ float red_fq(float v) {
    v += __builtin_bit_cast(float, __builtin_amdgcn_ds_swizzle(__builtin_bit_cast(int, v), 0x401F));
    float a = v, b = v;
    asm volatile("s_nop 1\n\tv_permlane32_swap_b32 %0, %1\n\ts_nop 1" : "+v"(a), "+v"(b));
    return a + b;
}

constexpr size_t MiB = 1u << 20;
constexpr size_t WS_WIN = 1 * MiB, WS_WGLU = 5 * MiB, WS_WOUT = 6 * MiB, WS_WXQ = 8 * MiB, WS_WXK = 10 * MiB, WS_WXV = 12 * MiB, WS_WXO = 14 * MiB,
                 WS_WUP = 16 * MiB, WS_WDN = 27 * MiB, WS_BTY = 33 * MiB, WS_BTE = 53 * MiB, WS_KTAB = 61 * MiB, WS_LB32 = 62 * MiB, WS_LOGF = 63 * MiB,
                 WS_CB = 64 * MiB, WS_SSQF = 65 * MiB, WS_SSQY = 66 * MiB, WS_SSQ1 = 67 * MiB, WS_SSQ2 = 69 * MiB, WS_SSQQ = 71 * MiB, WS_PSUM = 73 * MiB,
                 WS_SSQK = 75 * MiB, WS_SCK = 76 * MiB, WS_RS2 = 77 * MiB;
constexpr size_t WS_HN = 80 * MiB, WS_FOX = 80 * MiB, WS_Y1 = 112 * MiB, WS_QST = 80 * MiB, WS_H2B = 80 * MiB;
constexpr size_t WS_MN = 144 * MiB, WS_KST = 152 * MiB, WS_VT = 160 * MiB;
constexpr size_t WS_Q = 168 * MiB, WS_K = 200 * MiB, WS_V = 232 * MiB, WS_Y2 = 168 * MiB, WS_MIXN = 200 * MiB, WS_P = 168 * MiB;
constexpr size_t WS_UG = 264 * MiB, WS_EPART = 304 * MiB, WS_H1B = 264 * MiB, WS_XO = 264 * MiB;
constexpr size_t WS_G = 144 * MiB, WS_U = 320 * MiB, WS_END = 496 * MiB;

namespace pg8 {
constexpr int BM = 256, BK = 64, HALF = 128, HTB = HALF * BK * 2, STAGE_BYTES = 8 * HTB;
__device__ __forceinline__ int lds_byte(int r, int c) { const int st = (r >> 4) * 2 + (c >> 5), rr = r & 15, cc = c & 31, ob = rr * 64 + cc * 2; return st * 1024 + (ob ^ (((ob >> 9) & 1) << 5)); }
__device__ __forceinline__ void stage_rc(int b, int& R, int& C) { const int st = b / 1024, sb = b % 1024, swz = sb ^ (((sb >> 9) & 1) << 5); R = (st >> 1) * 16 + swz / 64; C = (st & 1) * 32 + (swz % 64) / 2; }
__device__ __forceinline__ int perm32(int rho) { const int n = rho >> 4, i = rho & 15; return 8 * (i >> 2) + 4 * n + (i & 3); }

struct Unit { int pm, pn; long offA, offB; };
struct Gemm { const bf16_t* A; const bf16_t* Bt; int lda, ldb, K; };

template <class Epi, class Sched>
__device__ __forceinline__ void gemm_phase(LAS unsigned char* lds, const Gemm g, const Sched& S, const Epi& E) {
    int tid = threadIdx.x; asm volatile("" : "+v"(tid));
    const int wid = __builtin_amdgcn_readfirstlane(tid >> 6), lane = tid & 63, wr = wid >> 2, wc = wid & 3, fr = lane & 15, fq = lane >> 4;
    const int K = g.K, nt = K / BK;
    unsigned voffA[2], voffB[2];
#pragma unroll
    for (int i = 0; i < 2; ++i) { int R, C; stage_rc(tid * 16 + i * 8192, R, C); const int Rb = (R & ~31) + perm32(R & 31);
        voffA[i] = (unsigned)(R * g.lda + C) * 2u; voffB[i] = (unsigned)(Rb * g.ldb + C) * 2u; }
    const size_t kstep = (size_t)(BK * 2);
    const size_t hstepA = (size_t)HALF * g.lda * 2, hstepB = (size_t)HALF * g.ldb * 2;
    const unsigned ldsw = (unsigned)wid * 1024u;
    const int aoff = lds_byte(wr * 64 + fr, fq * 8), boff = lds_byte(wc * 32 + fr, fq * 8);
#define PG8_SA(b, h) (((b) * 2 + (h)) * HTB)
#define PG8_SB(b, h) ((4 + (b) * 2 + (h)) * HTB)
#define PG8_STAGE(bufoff, gbase, voff) do { _Pragma("unroll") for (int _i = 0; _i < 2; ++_i) \
        __builtin_amdgcn_global_load_lds((const unsigned*)((const char*)(gbase) + (voff)[_i]), (LAS unsigned*)(lds + (bufoff) + ldsw + _i * 8192), 16, 0, 0); } while (0)
#define PG8_LDA(dst, b, h) do { _Pragma("unroll") for (int m = 0; m < 4; ++m) _Pragma("unroll") for (int k = 0; k < 2; ++k) dst[m][k] = *(const LAS bf16x8*)(lds + PG8_SA(b, h) + aoff + m * 2048 + k * 1024); } while (0)
#define PG8_LDB(dst, b, h) do { _Pragma("unroll") for (int n = 0; n < 2; ++n) _Pragma("unroll") for (int k = 0; k < 2; ++k) dst[n][k] = *(const LAS bf16x8*)(lds + PG8_SB(b, h) + boff + n * 2048 + k * 1024); } while (0)
#define PG8_MMA(ai, bj, At, Bt) do { __builtin_amdgcn_s_setprio(1); _Pragma("unroll") for (int m = 0; m < 4; ++m) _Pragma("unroll") for (int n = 0; n < 2; ++n) _Pragma("unroll") for (int k = 0; k < 2; ++k) \
        acc[ai][bj][m][n] = __builtin_amdgcn_mfma_f32_16x16x32_bf16(Bt[n][k], At[m][k], acc[ai][bj][m][n], 0, 0, 0); __builtin_amdgcn_s_setprio(0); } while (0)
#define PG8_WAIT_V(n) asm volatile("s_waitcnt vmcnt(" #n ")" ::: "memory")
#define PG8_WAIT_L(n) asm volatile("s_waitcnt lgkmcnt(" #n ")" ::: "memory")
#define PG8_BAR __builtin_amdgcn_s_barrier()
#define PG8_SCHED __builtin_amdgcn_sched_barrier(0)
    Unit cur, nxt; int ui = 0;
    if (!S.next(0, cur)) return;
    f32x4 acc[2][2][4][2];
#pragma unroll
    for (int a = 0; a < 2; ++a)
#pragma unroll
        for (int b = 0; b < 2; ++b)
#pragma unroll
            for (int m = 0; m < 4; ++m)
#pragma unroll
                for (int n = 0; n < 2; ++n) acc[a][b][m][n] = (f32x4){0.f, 0.f, 0.f, 0.f};
    bf16x8 At[4][2], B0[2][2], B1[2][2];
    const char* cA = (const char*)g.A + cur.offA; const char* cB = (const char*)g.Bt + cur.offB;
    PG8_STAGE(PG8_SB(0, 0), cB, voffB); PG8_STAGE(PG8_SB(0, 1), cB + hstepB, voffB); PG8_STAGE(PG8_SA(0, 0), cA, voffA); PG8_STAGE(PG8_SA(0, 1), cA + hstepA, voffA);
    if (wr == 1) PG8_BAR;
    PG8_WAIT_V(2); PG8_BAR;
    PG8_STAGE(PG8_SB(1, 0), cB + kstep, voffB); PG8_STAGE(PG8_SA(1, 0), cA + kstep, voffA); PG8_STAGE(PG8_SB(1, 1), cB + hstepB + kstep, voffB);
    PG8_WAIT_V(6); PG8_BAR;
    for (;;) {
        const bool has_next = S.next(ui + 1, nxt);
        const char* nA = has_next ? (const char*)g.A + nxt.offA : cA; const char* nB = has_next ? (const char*)g.Bt + nxt.offB : cB;
        for (int t = 0; t < nt; t += 2) {
            const bool last = (t == nt - 2);
            const char* a1 = cA + (size_t)(t + 1) * kstep;
            const char* a2 = last ? nA : cA + (size_t)(t + 2) * kstep; const char* b2 = last ? nB : cB + (size_t)(t + 2) * kstep;
            const char* a3 = a2 + kstep; const char* b3 = b2 + kstep;
            PG8_LDB(B0, 0, 0); PG8_LDB(B1, 0, 1); PG8_SCHED; PG8_LDA(At, 0, 0); PG8_STAGE(PG8_SA(1, 1), a1 + hstepA, voffA);
            PG8_WAIT_V(8); PG8_WAIT_L(0); PG8_BAR; PG8_MMA(0, 0, At, B0); PG8_MMA(0, 1, At, B1); PG8_BAR; PG8_SCHED;
            PG8_LDA(At, 0, 1); PG8_STAGE(PG8_SB(0, 0), b2, voffB); PG8_STAGE(PG8_SB(0, 1), b2 + hstepB, voffB); PG8_STAGE(PG8_SA(0, 0), a2, voffA);
            PG8_WAIT_V(8); PG8_WAIT_L(0); PG8_BAR; PG8_MMA(1, 0, At, B0); PG8_MMA(1, 1, At, B1); PG8_BAR; PG8_SCHED;
            PG8_LDB(B0, 1, 0); PG8_LDB(B1, 1, 1); PG8_SCHED; PG8_LDA(At, 1, 0); PG8_STAGE(PG8_SA(0, 1), a2 + hstepA, voffA);
            PG8_WAIT_V(8); PG8_WAIT_L(0); PG8_BAR; PG8_MMA(0, 0, At, B0); PG8_MMA(0, 1, At, B1); PG8_BAR; PG8_SCHED;
            PG8_LDA(At, 1, 1); PG8_STAGE(PG8_SB(1, 0), b3, voffB); PG8_STAGE(PG8_SB(1, 1), b3 + hstepB, voffB); PG8_STAGE(PG8_SA(1, 0), a3, voffA);
            PG8_WAIT_V(8); PG8_WAIT_L(0); PG8_BAR; PG8_MMA(1, 0, At, B0); PG8_MMA(1, 1, At, B1); PG8_BAR; PG8_SCHED;
        }
        if (wr == 0) PG8_BAR;
        { int fr2 = fr, fq2 = fq; asm volatile("" : "+v"(fr2), "+v"(fq2));
          E(acc, cur, wr, wc, fr2, fq2); }
        if (!has_next) break;
#pragma unroll
        for (int a = 0; a < 2; ++a)
#pragma unroll
            for (int b = 0; b < 2; ++b)
#pragma unroll
                for (int m = 0; m < 4; ++m)
#pragma unroll
                    for (int n = 0; n < 2; ++n) acc[a][b][m][n] = (f32x4){0.f, 0.f, 0.f, 0.f};
        cur = nxt; cA = nA; cB = nB; ++ui;
        if (wr == 1) PG8_BAR;
    }
    PG8_WAIT_V(0);
    PG8_BAR;
#undef PG8_SA
#undef PG8_SB
#undef PG8_STAGE
#undef PG8_LDA
#undef PG8_LDB
#undef PG8_MMA
#undef PG8_WAIT_V
#undef PG8_WAIT_L
#undef PG8_BAR
#undef PG8_SCHED
}
}
using pg8::Unit;

enum OrderKind { OK_PLAIN = 0, OK_S5E, OK_S5Y, OK_XS, OK_XO };
template <int kind> struct GOrder {
    int nM, nN, nwg, G, c, lda, ldb;
    __device__ __forceinline__ void init(int nM_, int nN_, int G_, int c_, int lda_, int ldb_) { nM = nM_; nN = nN_; nwg = nM_ * nN_; G = G_; c = c_; lda = lda_; ldb = ldb_; }
    __device__ __forceinline__ bool next(int i, Unit& u) const {
        const long L = (long)i * G + c; if (L >= nwg) return false;
        const int l = (int)L;
        if constexpr (kind == OK_PLAIN) {
            int wgid = l; { const int q = nwg / 8, r = nwg % 8, xcd = wgid % 8, off = wgid / 8; wgid = (xcd < r ? xcd * (q + 1) : r * (q + 1) + (xcd - r) * q) + off; }
            const int nig = 8 * nN, gid = wgid / nig, fm = gid * 8, gsz = (nM - fm) < 8 ? (nM - fm) : 8;
            u.pm = fm + ((wgid % nig) % gsz); u.pn = (wgid % nig) / gsz;
            u.offA = (long)u.pm * 256 * lda * 2; u.offB = (long)u.pn * 256 * ldb * 2;
        } else if constexpr (kind == OK_S5E) {
            const int kq = l & 1, pmm = (l >> 1) & 3, gg = l >> 3;
            u.pm = gg * 4 + pmm; u.pn = kq;
            u.offA = ((long)u.pm * 256 * UGP + kq * 256) * 2; u.offB = ((long)gg * 256 * 512 + kq * 256) * 2;
        } else if constexpr (kind == OK_S5Y) {
            const int pn = l & 1, pmm = (l >> 1) & 3, gg = l >> 3;
            u.pm = gg * 4 + pmm; u.pn = pn;
            u.offA = (long)u.pm * 256 * UGP * 2; u.offB = ((long)gg * 512 + pn * 256) * UGP * 2;
        } else if constexpr (kind == OK_XS) {
            const int h = l & 3, pm = l >> 2, b = pm >> 3;
            u.pm = pm; u.pn = h;
            u.offA = ((long)pm * 256 * DM + h * 256) * 2; u.offB = ((long)b * 256 * DM + h * 256) * 2;
        } else {
            const int h = l & 3, pm = l >> 2, b = pm >> 3;
            u.pm = pm; u.pn = h;
            u.offA = ((long)pm * 256 * DM + h * 256) * 2; u.offB = ((long)h * 256 * TM + b * 256) * 2;
        }
        return true;
    }
};

enum EpiKind { EK_PROJ = 0, EK_MEMK, EK_MEMVT, EK_S5E, EK_S5Y, EK_GLU, EK_WOUT, EK_XQ, EK_XS, EK_XO, EK_WXO, EK_UP, EK_DOWN, EK_GATE, EK_UPACT, EK_UPC };
    __device__ __forceinline__ u32x4 pack8(const f32x4 a, const f32x4 b) { u32x4 w; w.x = pk2(a[0], a[1]); w.y = pk2(a[2], a[3]); w.z = pk2(b[0], b[1]); w.w = pk2(b[2], b[3]); return w; }
    __device__ __forceinline__ float gelu_t(float y) { const float z = 0.7978845608028654f * (y + 0.044715f * y * y * y); const float e = __expf(2.f * z); const float th = 1.f - 2.f / (e + 1.f); return 0.5f * y * (1.f + th); }
    __device__ __forceinline__ float sigm(float z) { return 1.f / (1.f + __expf(-z)); }
    __device__ __forceinline__ float ssq8(const f32x4 a, const f32x4 b) { return (a[0] * a[0] + a[1] * a[1]) + (a[2] * a[2] + a[3] * a[3]) + (b[0] * b[0] + b[1] * b[1]) + (b[2] * b[2] + b[3] * b[3]); }

template <int kind> struct Epi {
    void* p0; void* p1; void* p2; void* p3; const void* c0; const void* c1; const void* c2; LAS float* hx;
    __device__ __forceinline__ void operator()(const f32x4 (&acc)[2][2][4][2], const Unit& u, int wr, int wc, int fr, int fq) const {
        const int rbase = u.pm * 256 + wr * 64 + fr;
        const int cl0 = wc * 32 + 8 * fq;
        switch (kind) {
        case EK_PROJ: {
            const int pn = u.pn;
            if (pn < 4) {
                const bool isq = pn < 2; bf16_t* dst = (bf16_t*)(isq ? p0 : p1); const float* gptr = (const float*)(isq ? c0 : c1); const float post = isq ? C2Q : 1.f;
                const int head = 4 * (pn & 1) + wc;
#pragma unroll
                for (int ai = 0; ai < 2; ++ai)
#pragma unroll
                    for (int m = 0; m < 4; ++m) {
                        float ss = ssq8(acc[ai][0][m][0], acc[ai][0][m][1]) + ssq8(acc[ai][1][m][0], acc[ai][1][m][1]);
                        ss = red_fq(ss);
                        const float sc = rsqrtf(ss * (1.f / 64.f) + EPS) * post;
                        const size_t row = (size_t)(rbase + ai * 128 + m * 16);
#pragma unroll
                        for (int bj = 0; bj < 2; ++bj)
                            *(u32x4*)(dst + row * 512 + head * 64 + 32 * bj + 8 * fq) = pack8(acc[ai][bj][m][0] * sc * *(const f32x4*)(gptr + 32 * bj + 8 * fq), acc[ai][bj][m][1] * sc * *(const f32x4*)(gptr + 32 * bj + 8 * fq + 4));
                    }
            } else if (pn < 6) {
                bf16_t* dst = (bf16_t*)p2;
#pragma unroll
                for (int ai = 0; ai < 2; ++ai)
#pragma unroll
                    for (int m = 0; m < 4; ++m) { const size_t row = (size_t)(rbase + ai * 128 + m * 16);
#pragma unroll
                        for (int bj = 0; bj < 2; ++bj) *(u32x4*)(dst + row * 512 + (pn - 4) * 256 + bj * 128 + cl0) = pack8(acc[ai][bj][m][0], acc[ai][bj][m][1]); }
            } else {
                bf16_t* dst = (bf16_t*)p3;
#pragma unroll
                for (int ai = 0; ai < 2; ++ai)
#pragma unroll
                    for (int m = 0; m < 4; ++m) { const int row = rbase + ai * 128 + m * 16; const int b = row >> 11, t = row & 2047, ch = t >> 5, s = t & 31;
#pragma unroll
                        for (int bj = 0; bj < 2; ++bj) { const int f = (pn - 6) * 256 + bj * 128 + cl0; const int gI = f >> 4, cc = f & 15;
                            *(u32x4*)(dst + ((size_t)(gI * 1024 + b * 64 + ch)) * UGP + s * 16 + cc) = pack8(acc[ai][bj][m][0], acc[ai][bj][m][1]); } }
            }
        } break;
        case EK_MEMK: {
            bf16_t* dst = (bf16_t*)p0; float* sq = (float*)p1;
#pragma unroll
            for (int ai = 0; ai < 2; ++ai)
#pragma unroll
                for (int m = 0; m < 4; ++m) { const size_t row = (size_t)(rbase + ai * 128 + m * 16);
                    float ss = ssq8(acc[ai][0][m][0], acc[ai][0][m][1]) + ssq8(acc[ai][1][m][0], acc[ai][1][m][1]);
                    ss = red_fq(ss);
                    if (fq == 0) sq[row * 16 + u.pn * 4 + wc] = ss;
#pragma unroll
                    for (int bj = 0; bj < 2; ++bj) *(u32x4*)(dst + row * DM + u.pn * 256 + bj * 128 + cl0) = pack8(acc[ai][bj][m][0], acc[ai][bj][m][1]); }
        } break;
        case EK_MEMVT: {
            bf16_t* dst = (bf16_t*)p0;
#pragma unroll
            for (int ai = 0; ai < 2; ++ai)
#pragma unroll
                for (int m = 0; m < 4; ++m) { const size_t row = (size_t)(rbase + ai * 128 + m * 16);
#pragma unroll
                    for (int bj = 0; bj < 2; ++bj) *(u32x4*)(dst + row * TM + u.pn * 256 + bj * 128 + cl0) = pack8(acc[ai][bj][m][0], acc[ai][bj][m][1]); }
        } break;
        case EK_S5E: {
            float* dst = (float*)p0 + (size_t)u.pn * 32768 * 128;
#pragma unroll
            for (int ai = 0; ai < 2; ++ai)
#pragma unroll
                for (int m = 0; m < 4; ++m) { const size_t row = (size_t)(rbase + ai * 128 + m * 16);
                    *(f32x4*)(dst + row * 128 + cl0) = acc[ai][0][m][0]; *(f32x4*)(dst + row * 128 + cl0 + 4) = acc[ai][0][m][1]; }
        } break;
        case EK_S5Y: {
            bf16_t* dst = (bf16_t*)p0;
#pragma unroll
            for (int ai = 0; ai < 2; ++ai)
#pragma unroll
                for (int m = 0; m < 4; ++m) { const int r = rbase + ai * 128 + m * 16; const int gI = r >> 10, b = (r >> 6) & 15, k = r & 63;
#pragma unroll
                    for (int bj = 0; bj < 2; ++bj) { const int nn = u.pn * 256 + bj * 128 + cl0; const int tt = nn >> 4, cc = nn & 15;
                        f32x4 a = acc[ai][bj][m][0], c = acc[ai][bj][m][1];
#pragma unroll
                        for (int j = 0; j < 4; ++j) { a[j] = gelu_t(a[j]); c[j] = gelu_t(c[j]); }
                        *(u32x4*)(dst + ((size_t)(b * SEQ + k * TC + tt)) * 512 + gI * 16 + cc) = pack8(a, c); } }
        } break;
        case EK_GLU: {
            bf16_t* dst = (bf16_t*)p0; float* sq = (float*)p1; const bf16_t* y1 = (const bf16_t*)c0; const float* bg = (const float*)c1;
            f32x4 bv[2][2];
#pragma unroll
            for (int bj = 0; bj < 2; ++bj)
#pragma unroll
                for (int n = 0; n < 2; ++n) bv[bj][n] = *(const f32x4*)(bg + u.pn * 256 + bj * 128 + cl0 + 4 * n);
#pragma unroll
            for (int ai = 0; ai < 2; ++ai)
#pragma unroll
                for (int m = 0; m < 4; ++m) { const size_t row = (size_t)(rbase + ai * 128 + m * 16); float ss = 0.f;
#pragma unroll
                    for (int bj = 0; bj < 2; ++bj) { const size_t off = row * 512 + u.pn * 256 + bj * 128 + cl0;
                        const u32x4 yv = *(const u32x4*)(y1 + off);
                        f32x4 a = acc[ai][bj][m][0] + bv[bj][0], c = acc[ai][bj][m][1] + bv[bj][1];
                        a[0] = bflo(yv.x) * sigm(a[0]); a[1] = bfhi(yv.x) * sigm(a[1]); a[2] = bflo(yv.y) * sigm(a[2]); a[3] = bfhi(yv.y) * sigm(a[3]);
                        c[0] = bflo(yv.z) * sigm(c[0]); c[1] = bfhi(yv.z) * sigm(c[1]); c[2] = bflo(yv.w) * sigm(c[2]); c[3] = bfhi(yv.w) * sigm(c[3]);
                        ss += ssq8(a, c);
                        *(u32x4*)(dst + off) = pack8(a, c); }
                    ss = red_fq(ss);
                    if (fq == 0) sq[row * 8 + u.pn * 4 + wc] = ss; }
        } break;
        case EK_WOUT: case EK_WXO: {
            float* out = (float*)p0; bf16_t* hb = (bf16_t*)p1; float* sq = (float*)p2; const float* base = (const float*)c0;
#pragma unroll
            for (int ai = 0; ai < 2; ++ai)
#pragma unroll
                for (int m = 0; m < 4; ++m) { const size_t row = (size_t)(rbase + ai * 128 + m * 16); float ss = 0.f;
#pragma unroll
                    for (int bj = 0; bj < 2; ++bj) { const size_t off = row * DM + u.pn * 256 + bj * 128 + cl0;
                        const f32x4 a = acc[ai][bj][m][0] + *(const f32x4*)(base + off), c = acc[ai][bj][m][1] + *(const f32x4*)(base + off + 4);
                        *(f32x4*)(out + off) = a; *(f32x4*)(out + off + 4) = c;
                        ss += ssq8(a, c);
                        *(u32x4*)(hb + off) = pack8(a, c); }
                    ss = red_fq(ss);
                    if (fq == 0) sq[row * 16 + u.pn * 4 + wc] = ss; }
        } break;
        case EK_XQ: {
            bf16_t* dst = (bf16_t*)p0; float* sq = (float*)p1; const float* gq = (const float*)c0; const float* gk = (const float*)c1;
            f32x4 gg[2][2];
#pragma unroll
            for (int bj = 0; bj < 2; ++bj)
#pragma unroll
                for (int n = 0; n < 2; ++n) gg[bj][n] = *(const f32x4*)(gq + bj * 128 + cl0 + 4 * n) * *(const f32x4*)(gk + bj * 128 + cl0 + 4 * n);
#pragma unroll
            for (int ai = 0; ai < 2; ++ai)
#pragma unroll
                for (int m = 0; m < 4; ++m) { const size_t row = (size_t)(rbase + ai * 128 + m * 16);
                    float ss = ssq8(acc[ai][0][m][0], acc[ai][0][m][1]) + ssq8(acc[ai][1][m][0], acc[ai][1][m][1]);
                    ss = red_fq(ss);
                    if (fq == 0) sq[row * 16 + u.pn * 4 + wc] = ss;
#pragma unroll
                    for (int bj = 0; bj < 2; ++bj) *(u32x4*)(dst + row * DM + u.pn * 256 + bj * 128 + cl0) = pack8(acc[ai][bj][m][0] * gg[bj][0], acc[ai][bj][m][1] * gg[bj][1]); }
        } break;
        case EK_XS: {
            bf16_t* dst = (bf16_t*)p0; float* ps = (float*)p1; const float* s1 = (const float*)c0; const float* sqq = (const float*)c1; const float* sck = (const float*)c2;
            const int h = u.pn, b = u.pm >> 3;
            f32x4 kv[2][2];
#pragma unroll
            for (int bj = 0; bj < 2; ++bj)
#pragma unroll
                for (int n = 0; n < 2; ++n) kv[bj][n] = *(const f32x4*)(sck + (size_t)h * TM + b * 256 + bj * 128 + cl0 + 4 * n) * (LOG2E / 16.f);
#pragma unroll
            for (int ai = 0; ai < 2; ++ai)
#pragma unroll
                for (int m = 0; m < 4; ++m) { const size_t row = (size_t)(rbase + ai * 128 + m * 16);
                    const f32x4 t0 = *(const f32x4*)(s1 + row * 16), t1 = *(const f32x4*)(s1 + row * 16 + 4), t2 = *(const f32x4*)(s1 + row * 16 + 8), t3 = *(const f32x4*)(s1 + row * 16 + 12);
                    const float tot = ((t0[0] + t0[1]) + (t0[2] + t0[3])) + ((t1[0] + t1[1]) + (t1[2] + t1[3])) + ((t2[0] + t2[1]) + (t2[2] + t2[3])) + ((t3[0] + t3[1]) + (t3[2] + t3[3]));
                    const float rs1 = rsqrtf(tot * (1.f / DM) + EPS);
                    const f32x4 qq = *(const f32x4*)(sqq + row * 16 + h * 4);
                    const float sq = rs1 * rsqrtf(rs1 * rs1 * ((qq[0] + qq[1]) + (qq[2] + qq[3])) * (1.f / 256.f) + EPS);
                    float ss = 0.f;
#pragma unroll
                    for (int bj = 0; bj < 2; ++bj) { f32x4 a = acc[ai][bj][m][0] * kv[bj][0] * sq, c = acc[ai][bj][m][1] * kv[bj][1] * sq;
#pragma unroll
                        for (int j = 0; j < 4; ++j) { a[j] = __builtin_amdgcn_exp2f(a[j]); c[j] = __builtin_amdgcn_exp2f(c[j]); }
                        const u32x4 w = pack8(a, c);
                        ss += (bflo(w.x) + bfhi(w.x)) + (bflo(w.y) + bfhi(w.y)) + (bflo(w.z) + bfhi(w.z)) + (bflo(w.w) + bfhi(w.w));
                        *(u32x4*)(dst + row * DM + h * 256 + bj * 128 + cl0) = w; }
                    ss = red_fq(ss);
                    if (fq == 0) ps[row * 16 + h * 4 + wc] = ss; }
        } break;
        case EK_XO: {
            bf16_t* dst = (bf16_t*)p0; const float* ps = (const float*)c0; const int h = u.pn;
#pragma unroll
            for (int ai = 0; ai < 2; ++ai)
#pragma unroll
                for (int m = 0; m < 4; ++m) { const size_t row = (size_t)(rbase + ai * 128 + m * 16);
                    const f32x4 pp = *(const f32x4*)(ps + row * 16 + h * 4); const float inv = 1.f / ((pp[0] + pp[1]) + (pp[2] + pp[3]));
#pragma unroll
                    for (int bj = 0; bj < 2; ++bj) *(u32x4*)(dst + row * DM + h * 256 + bj * 128 + cl0) = pack8(acc[ai][bj][m][0] * inv, acc[ai][bj][m][1] * inv); }
        } break;
        case EK_DOWN: {
            float* out = (float*)p0;
#pragma unroll
            for (int ai = 0; ai < 2; ++ai)
#pragma unroll
                for (int m = 0; m < 4; ++m) { const size_t row = (size_t)(rbase + ai * 128 + m * 16);
#pragma unroll
                    for (int bj = 0; bj < 2; ++bj) { const size_t off = row * DM + u.pn * 256 + bj * 128 + cl0;
                        const f32x4 a = acc[ai][bj][m][0] + *(const f32x4*)(out + off), c = acc[ai][bj][m][1] + *(const f32x4*)(out + off + 4);
                        *(f32x4*)(out + off) = a; *(f32x4*)(out + off + 4) = c; } }
        } break;
        case EK_UPC: {
            bf16_t* A = (bf16_t*)p0; float* GHF = (float*)p1; float* GHL = (float*)p2; float* UH = (float*)p3; const float* s2 = (const float*)c0; const float* cw = (const float*)c1; const float* cbv = (const float*)c2;
            const int j0 = u.pn * 128 + cl0;
            float w0[8], w1[8], w2[8], bb[8];
#pragma unroll
            for (int i = 0; i < 2; ++i) { const f32x4 a0 = *(const f32x4*)(cw + j0 + 4 * i), a1 = *(const f32x4*)(cw + DFF + j0 + 4 * i), a2 = *(const f32x4*)(cw + 2 * DFF + j0 + 4 * i), a3 = *(const f32x4*)(cbv + j0 + 4 * i);
#pragma unroll
                for (int q = 0; q < 4; ++q) { w0[4 * i + q] = a0[q]; w1[4 * i + q] = a1[q]; w2[4 * i + q] = a2[q]; bb[4 * i + q] = a3[q]; } }
            float rsv[2][4];
#pragma unroll
            for (int ai = 0; ai < 2; ++ai)
#pragma unroll
                for (int m = 0; m < 4; ++m) rsv[ai][m] = s2[rbase + ai * 128 + m * 16];
            if (fr >= 14) {
#pragma unroll
                for (int ai = 0; ai < 2; ++ai) { const f32x4 g0 = acc[ai][0][3][0] * rsv[ai][3], g1 = acc[ai][0][3][1] * rsv[ai][3];
                    LAS float* hp = hx + ((ai * 2 + wr) * 2 + (fr - 14)) * 128 + cl0; *(LAS f32x4*)hp = g0; *(LAS f32x4*)(hp + 4) = g1;
                    if (ai == 1 && wr == 1) { float* gp = GHL + ((size_t)u.pm * 2 + (fr - 14)) * DFF + j0; *(f32x4*)gp = g0; *(f32x4*)(gp + 4) = g1; } } }
            if (wr == 0 && fr < 2) {
                const float rs = rsv[0][0]; float* gp = GHF + ((size_t)u.pm * 2 + fr) * DFF + j0; float* up = UH + ((size_t)u.pm * 2 + fr) * DFF + j0;
                *(f32x4*)gp = acc[0][0][0][0] * rs; *(f32x4*)(gp + 4) = acc[0][0][0][1] * rs; *(f32x4*)up = acc[0][1][0][0] * rs; *(f32x4*)(up + 4) = acc[0][1][0][1] * rs; }
            asm volatile("s_waitcnt lgkmcnt(0)" ::: "memory"); __builtin_amdgcn_s_barrier(); asm volatile("" ::: "memory");
#define ROR1(x) __builtin_bit_cast(float, __builtin_amdgcn_update_dpp(0, __builtin_bit_cast(int, (x)), 0x121, 0xF, 0xF, false))
#define ROR2(x) __builtin_bit_cast(float, __builtin_amdgcn_update_dpp(0, __builtin_bit_cast(int, (x)), 0x122, 0xF, 0xF, false))
#pragma unroll
            for (int ai = 0; ai < 2; ++ai) {
                const int grp = ai * 2 + wr;
                float p1v[8], p2v[8];
                { f32x4 h1a = (f32x4){0.f, 0.f, 0.f, 0.f}, h1b = h1a, h2a = h1a, h2b = h1a;
                  if (grp > 0) { const LAS float* hp = hx + ((grp - 1) * 2) * 128 + cl0; h2a = *(const LAS f32x4*)hp; h2b = *(const LAS f32x4*)(hp + 4); h1a = *(const LAS f32x4*)(hp + 128); h1b = *(const LAS f32x4*)(hp + 132); }
#pragma unroll
                  for (int i = 0; i < 4; ++i) { p1v[i] = h1a[i]; p1v[4 + i] = h1b[i]; p2v[i] = (fr == 0) ? h2a[i] : h1a[i]; p2v[4 + i] = (fr == 0) ? h2b[i] : h1b[i]; } }
#pragma unroll
                for (int m = 0; m < 4; ++m) { const float rs = rsv[ai][m]; const size_t row = (size_t)(rbase + ai * 128 + m * 16);
                    float gs[8], r[8];
#pragma unroll
                    for (int i = 0; i < 4; ++i) { gs[i] = acc[ai][0][m][0][i] * rs; gs[4 + i] = acc[ai][0][m][1][i] * rs; }
#pragma unroll
                    for (int i = 0; i < 8; ++i) { const float c1v = ROR1(gs[i]), c2v = ROR2(gs[i]);
                        const float g1 = (fr == 0) ? p1v[i] : c1v, g2 = (fr < 2) ? p2v[i] : c2v;
                        p1v[i] = c1v; p2v[i] = c2v;
                        const float z = bb[i] + w0[i] * g2 + w1[i] * g1 + w2[i] * gs[i];
                        const float uv = (i < 4 ? acc[ai][1][m][0][i & 3] : acc[ai][1][m][1][i & 3]) * rs;
                        r[i] = z * sigm(z) * uv; }
                    u32x4 o; o.x = pk2(r[0], r[1]); o.y = pk2(r[2], r[3]); o.z = pk2(r[4], r[5]); o.w = pk2(r[6], r[7]);
                    if (!(grp == 0 && m == 0 && fr < 2)) *(u32x4*)(A + row * DFF + j0) = o; } }
#undef ROR1
#undef ROR2
        } break;
        default: break;
        }
    }
};

namespace attn_body {
using bf16=__hip_bfloat16;
using s16x4=__attribute__((ext_vector_type(4)))short;
using f32x16=__attribute__((ext_vector_type(16)))float;
constexpr int NHEAD=NFH,D=64,ADM=NHEAD*D;
constexpr int NW=8,QBLK=32,QB=QBLK*NW,KVBLK=64,NQB=SEQ/QB;
__device__ __forceinline__ int crow(int r,int hi){return (r&3)+8*(r>>2)+4*hi;}
#define SBAR() __builtin_amdgcn_sched_barrier(0)
__device__ __forceinline__ void cmask(f32x16&p0,f32x16&p1,int jb,int qrel,int hi){
  const float NEG=-INFINITY; int kb=64*jb+4*hi;
  #pragma unroll
  for(int r=0;r<16;++r){int kv=kb+(r&3)+8*(r>>2); if(kv>qrel)p0[r]=NEG; if(kv+32>qrel)p1[r]=NEG;}
}
constexpr int NSLOT=3, SLOTB=8192;
constexpr int LDS_K=0, LDS_V=NSLOT*SLOTB, LDS_WS=2*NSLOT*SLOTB, LDS_OST=LDS_WS+NW*64*4, LDS_BYTES=LDS_OST+NW*4096;
constexpr int LDS_BIAS=86016;
__device__ __forceinline__ void glds16(const void*gsrc,unsigned lds_dst){unsigned keep;
  asm volatile("s_mov_b32 %0, m0\n\ts_mov_b32 m0, %2\n\ts_nop 0\n\tglobal_load_lds_dwordx4 %1, off\n\ts_mov_b32 m0, %0":"=&s"(keep):"v"(gsrc),"s"(lds_dst):"memory");}
__device__ __forceinline__ float max3f(float a,float b,float c){float r;asm("v_max3_f32 %0, %1, %2, %3":"=v"(r):"v"(a),"v"(b),"v"(c));return r;}
__device__ __forceinline__ float max2f(float a,float b){float r;asm("v_max_f32_e32 %0, %1, %2":"=v"(r):"v"(a),"v"(b));return r;}
__device__ __forceinline__ float fadd_s(float a,float b){float r;asm("v_add_f32_e32 %0, %1, %2":"=v"(r):"v"(a),"v"(b));return r;}
__device__ __forceinline__ float fsub_s(float a,float b){float r;asm("v_sub_f32_e32 %0, %1, %2":"=v"(r):"v"(a),"v"(b));return r;}
typedef float f32x2_t __attribute__((ext_vector_type(2))); typedef __bf16 bf16x2_t __attribute__((ext_vector_type(2)));
__device__ __forceinline__ unsigned cvtpk_s(float lo,float hi){f32x2_t v={lo,hi};bf16x2_t b=__builtin_convertvector(v,bf16x2_t);return __builtin_bit_cast(unsigned,b);}
#define WAIT_BAR(N) asm volatile("s_waitcnt vmcnt(" #N ") lgkmcnt(0)\n\ts_barrier":::"memory")

__device__ __forceinline__ void qkt(f32x16&p0,f32x16&p1,const char*Kslot,const bf16x8*qr,const f32x16&negm,int r32,int hi){
  const char*kb=Kslot+hi*1024+r32*16;
  #pragma unroll
  for(int d0=0;d0<4;++d0){
    const bf16x8 b0=*reinterpret_cast<const bf16x8*>(kb+d0*2048);
    const bf16x8 b1=*reinterpret_cast<const bf16x8*>(kb+d0*2048+512);
    if(d0==0){p0=__builtin_amdgcn_mfma_f32_32x32x16_bf16(b0,qr[0],negm,0,0,0);p1=__builtin_amdgcn_mfma_f32_32x32x16_bf16(b1,qr[0],negm,0,0,0);}
    else{p0=__builtin_amdgcn_mfma_f32_32x32x16_bf16(b0,qr[d0],p0,0,0,0);p1=__builtin_amdgcn_mfma_f32_32x32x16_bf16(b1,qr[d0],p1,0,0,0);}}
}
typedef __attribute__((address_space(3))) const char* lds_cptr;
typedef short v4i16_t __attribute__((ext_vector_type(4)));
__device__ __forceinline__ void kload8(bf16x8*kf,lds_cptr kp){
  kf[0]=*(const __attribute__((address_space(3))) bf16x8*)(kp);      kf[1]=*(const __attribute__((address_space(3))) bf16x8*)(kp+512);
  kf[2]=*(const __attribute__((address_space(3))) bf16x8*)(kp+2048); kf[3]=*(const __attribute__((address_space(3))) bf16x8*)(kp+2560);
  kf[4]=*(const __attribute__((address_space(3))) bf16x8*)(kp+4096); kf[5]=*(const __attribute__((address_space(3))) bf16x8*)(kp+4608);
  kf[6]=*(const __attribute__((address_space(3))) bf16x8*)(kp+6144); kf[7]=*(const __attribute__((address_space(3))) bf16x8*)(kp+6656);
}
__device__ __forceinline__ void kload2(bf16x8*kf,lds_cptr kp,int j){ kf[2*j]=*(const __attribute__((address_space(3))) bf16x8*)(kp+j*2048); kf[2*j+1]=*(const __attribute__((address_space(3))) bf16x8*)(kp+j*2048+512); }
__device__ __forceinline__ s16x4 vtr(lds_cptr p){ return __builtin_bit_cast(s16x4,__builtin_amdgcn_ds_read_tr16_b64_v4i16((__attribute__((address_space(3))) v4i16_t*)p)); }
__device__ __forceinline__ float rowmax(const f32x16&p0,const f32x16&p1){
  float a=max3f(p0[0],p0[1],p1[0]),b=max3f(p0[2],p0[3],p1[1]);a=max3f(a,p1[2],p1[3]);
  #pragma unroll
  for(int r=4;r<16;r+=4){a=max3f(a,p0[r],p0[r+1]);b=max3f(b,p0[r+2],p0[r+3]);a=max3f(a,p1[r],p1[r+1]);b=max3f(b,p1[r+2],p1[r+3]);}
  const float m=max2f(a,b);
  auto rr=__builtin_amdgcn_permlane32_swap(__float_as_uint(m),__float_as_uint(m),false,false);
  return max2f(__uint_as_float(rr[0]),__uint_as_float(rr[1]));
}
__device__ __forceinline__ void pv(f32x16*o,int vb,bf16x8 pa0,bf16x8 pa1,bf16x8 pa2,bf16x8 pa3){
  #pragma unroll
  for(int d0=0;d0<2;++d0){s16x4 lo[4],hi[4];
    #pragma unroll
    for(int ks=0;ks<4;++ks){
      asm volatile("ds_read_b64_tr_b16 %0,%1 offset:%c2":"=&v"(lo[ks]):"v"(vb),"i"(d0*4096+ks*1024):"memory");
      asm volatile("ds_read_b64_tr_b16 %0,%1 offset:%c2":"=&v"(hi[ks]):"v"(vb),"i"(d0*4096+ks*1024+512):"memory");}
    asm volatile("s_waitcnt lgkmcnt(0)":::"memory");SBAR();
    #define PK(k) (bf16x8){lo[k][0],lo[k][1],lo[k][2],lo[k][3],hi[k][0],hi[k][1],hi[k][2],hi[k][3]}
    o[d0]=__builtin_amdgcn_mfma_f32_32x32x16_bf16(pa0,PK(0),o[d0],0,0,0);
    o[d0]=__builtin_amdgcn_mfma_f32_32x32x16_bf16(pa1,PK(1),o[d0],0,0,0);
    o[d0]=__builtin_amdgcn_mfma_f32_32x32x16_bf16(pa2,PK(2),o[d0],0,0,0);
    o[d0]=__builtin_amdgcn_mfma_f32_32x32x16_bf16(pa3,PK(3),o[d0],0,0,0);
    #undef PK
  }
}
typedef const __attribute__((address_space(3))) f32x4* lds_f4ptr;
#define BIASADD(P0,P1,t) do{ const lds_f4ptr bp_=(lds_f4ptr)(shm3+bias_off+((t)*64+4*hi)*4); \
    _Pragma("unroll") for(int j_=0;j_<4;++j_){ const f32x4 b0_=bp_[2*j_]-mhat, b1_=bp_[8+2*j_]-mhat; \
      P0[4*j_]+=b0_[0]; P0[4*j_+1]+=b0_[1]; P0[4*j_+2]+=b0_[2]; P0[4*j_+3]+=b0_[3]; \
      P1[4*j_]+=b1_[0]; P1[4*j_+1]+=b1_[1]; P1[4*j_+2]+=b1_[2]; P1[4*j_+3]+=b1_[3]; } }while(0)

#define CINIT(P0,P1,t) do{ const lds_f4ptr bp_=(lds_f4ptr)(shm3+bias_off+((t)*64+4*hi)*4); \
    _Pragma("unroll") for(int j_=0;j_<4;++j_){ const f32x4 b0_=bp_[2*j_]-mhat, b1_=bp_[8+2*j_]-mhat; \
      P0[4*j_]=b0_[0]; P0[4*j_+1]=b0_[1]; P0[4*j_+2]=b0_[2]; P0[4*j_+3]=b0_[3]; \
      P1[4*j_]=b1_[0]; P1[4*j_+1]=b1_[1]; P1[4*j_+2]=b1_[2]; P1[4*j_+3]=b1_[3]; } }while(0)
template<int THRL> __device__ __forceinline__ void attn_unit(int b,int h,int qb,const bf16*Q,const bf16*__restrict__ K,const bf16*__restrict__ V,bf16*O,const float*__restrict__ CB,float*__restrict__ SSQ,char*shm,const float skip_th){
  int tid=threadIdx.x; asm volatile("":"+v"(tid));
  const int lane=tid&63,r32=lane&31,hi=lane>>5; const int wid=__builtin_amdgcn_readfirstlane(tid>>6);
  const long rowbase=(long)b*SEQ; const int q0=qb*QB;
  const bf16*Qw=Q+(rowbase+q0+wid*QBLK)*ADM+h*D;
  int t0=0; { const float*cbh0=CB+(long)(b*NHEAD+h)*SEQ; const int npair=(q0+QB)/KVBLK/2-2; const float c0v=cbh0[q0];
    const bool far=(lane<npair)&&(cbh0[128*(lane<npair?lane:0)+127]-c0v>skip_th); const unsigned long long mk=__ballot(far);
    int lead=__builtin_ctzll(~mk); if(lead>npair)lead=npair; if(lead<0)lead=0; t0=2*__builtin_amdgcn_readfirstlane(lead); }
  const bf16*Kh=K+(rowbase+(long)t0*KVBLK)*ADM+h*D,*Vh=V+(rowbase+(long)t0*KVBLK)*ADM+h*D;
  const unsigned lds0=(unsigned)(uintptr_t)shm;
  float*wsf=(float*)(shm+LDS_WS)+wid*64;
  const lds_cptr shm3=(lds_cptr)shm;
  { const float*cbh=CB+(long)(b*NHEAD+h)*SEQ; const float cref=cbh[q0+128];
    if(tid*4<q0+QB){ const f32x4 c4=*(const f32x4*)(cbh+tid*4); *(__attribute__((address_space(3))) f32x4*)(shm3+LDS_BIAS+tid*16)=(f32x4){cref-c4[0],cref-c4[1],cref-c4[2],cref-c4[3]}; } }
  const bf16*ksrc=Kh+(long)lane*ADM+wid*8;
  const bf16*vsrc=Vh+(long)(16*(wid&3)+(lane>>2))*ADM+(wid>>2)*32+(lane&3)*8;
  const unsigned kdst=lds0+LDS_K+wid*1024, vdst=lds0+LDS_V+wid*1024;
  #define DMA_K(t,slot) glds16(ksrc+(long)(t)*KVBLK*ADM,(unsigned)__builtin_amdgcn_readfirstlane(kdst+(slot)))
  #define DMA_V(t,slot) glds16(vsrc+(long)(t)*KVBLK*ADM,(unsigned)__builtin_amdgcn_readfirstlane(vdst+(slot)))
  const int vb0=(int)(lds0+LDS_V)+((lane>>4)&1)*32+(lane&3)*8+(4*hi+((lane&15)>>2))*64;
  const char*Kbase=shm+LDS_K; bf16x8 kf[8];
  const lds_cptr kp0=shm3+LDS_K+hi*1024+r32*16; const lds_cptr vp0=shm3+LDS_V+((lane>>4)&1)*32+(lane&3)*8+(4*hi+((lane&15)>>2))*64;
  const int NT=(q0+QB)/KVBLK-t0; const int bias_off=LDS_BIAS+t0*KVBLK*4;
  DMA_K(0,0);DMA_V(0,0);DMA_K(1,SLOTB);
  bf16x8 qr[4];
  #pragma unroll
  for(int d0=0;d0<4;++d0)qr[d0]=*reinterpret_cast<const bf16x8*>(&Qw[(long)r32*ADM+d0*16+hi*8]);
  float mhat=0.f,l_reg=0.f;f32x16 o[2];o[0]=f32x16{};o[1]=f32x16{};const f32x16 negm=f32x16{};
  const int qrel=wid*QBLK+r32;
  #define CMASK(P0,P1,t) do{int jb_=(t)-(NT-4); if(jb_>=0)cmask(P0,P1,jb_,qrel,hi);}while(0)
  bool resc=false;
  #define START(P0,P1) do{ const float rm=rowmax(P0,P1); resc=false; \
    { const float dl=max2f(rm,-24.f); mhat=fadd_s(mhat,dl); \
      _Pragma("unroll") for(int r=0;r<16;++r){P0[r]=fsub_s(P0[r],dl);P1[r]=fsub_s(P1[r],dl);} } \
    _Pragma("unroll") for(int r=0;r<16;++r)P0[r]=__builtin_amdgcn_exp2f(P0[r]); }while(0)
  #define RESC() do{ if(resc){ asm volatile("s_waitcnt lgkmcnt(0)":::"memory"); \
      _Pragma("unroll") for(int d_=0;d_<2;++d_) _Pragma("unroll") for(int r=0;r<16;++r)o[d_][r]*=wsf[crow(r,hi)]; } }while(0)
  f32x16 pA0,pA1,pB0,pB1;
  int sl_prev=0,sl_cur=0,sl_next=SLOTB;
  #define ROT() do{sl_prev=sl_cur;sl_cur=sl_next;sl_next=(sl_next==(NSLOT-1)*SLOTB)?0:sl_next+SLOTB;}while(0)
  DMA_K(2,2*SLOTB);
  WAIT_BAR(3);
  qkt(pA0,pA1,Kbase,qr,negm,r32,hi);asm volatile("s_nop 15\n\ts_nop 7":"+v"(pA0),"+v"(pA1));BIASADD(pA0,pA1,0);CMASK(pA0,pA1,0);
  START(pA0,pA1);
  _Pragma("unroll") for(int r=0;r<16;++r)pA1[r]=__builtin_amdgcn_exp2f(pA1[r]);
  WAIT_BAR(0);
  DMA_K(3,0);DMA_V(1,SLOTB);
  ROT();
  kload8(kf,kp0+sl_cur);
  WAIT_BAR(2);
  s16x4 vlo[8],vhi[8]; u32x4 pw0,pw1,pw2,pw3;
  #define PKW(P,B) cvtpk_s(P[B],P[B+1])
  #define PAF(k) __builtin_bit_cast(bf16x8,pw##k)
  #define VFR(i) (bf16x8){vlo[i][0],vlo[i][1],vlo[i][2],vlo[i][3],vhi[i][0],vhi[i][1],vhi[i][2],vhi[i][3]}
  #define PIN(x) asm volatile("":"+v"(x))
  #define MX3(a,b,c) __builtin_fmaxf(__builtin_fmaxf((a),(b)),(c))
  #define GAPA(MF,A0,A1,A2,A3,W0,W1,PW) do{ MF; sacc+=A0; sacc+=A1; sacc+=A2; sacc+=A3; PIN(sacc); W0; W1; PIN(PW); SBAR(); }while(0)
  #define EX(v) __builtin_amdgcn_exp2f(v)
  #define GAPB(MF,X,B) do{ MF; X[B]=EX(X[B]); X[B+1]=EX(X[B+1]); X[B+2]=EX(X[B+2]); X[B+3]=EX(X[B+3]); PIN(X); SBAR(); }while(0)
  #define VRD(i) do{ vlo[i]=vtr(vp_+(((i)>>2)*4096+((i)&3)*1024)); vhi[i]=vtr(vp_+(((i)>>2)*4096+((i)&3)*1024+512)); }while(0)
  #define KRD(G,j) do{ if(G){ kload2(kf,kp0+sl_next,j); SBAR(); } }while(0)
  #define STEP(C0,C1,P0,P1,t,GK,GV,GL) do{ SBAR(); CINIT(C0,C1,t); SBAR(); \
    const lds_cptr vp_=vp0+sl_prev; \
    VRD(0); SBAR(); float sacc=(P0[0]+P0[1]); \
    GAPA(C0=__builtin_amdgcn_mfma_f32_32x32x16_bf16(kf[0],qr[0],C0,0,0,0), P0[2],P0[3],P0[4],P0[5],     pw0[0]=PKW(P0,0), pw0[1]=PKW(P0,2), pw0); \
    VRD(4); SBAR(); GAPA(C1=__builtin_amdgcn_mfma_f32_32x32x16_bf16(kf[1],qr[0],C1,0,0,0), P0[6],P0[7],P0[8],P0[9],     pw0[2]=PKW(P0,4), pw0[3]=PKW(P0,6), pw0); \
    VRD(1); SBAR(); GAPA(C0=__builtin_amdgcn_mfma_f32_32x32x16_bf16(kf[2],qr[1],C0,0,0,0),   P0[10],P0[11],P0[12],P0[13], pw1[0]=PKW(P0,8), pw1[1]=PKW(P0,10), pw1); \
    VRD(5); SBAR(); GAPA(C1=__builtin_amdgcn_mfma_f32_32x32x16_bf16(kf[3],qr[1],C1,0,0,0),   P0[14],P0[15],P1[0],P1[1],   pw1[2]=PKW(P0,12),pw1[3]=PKW(P0,14), pw1); \
    VRD(2); SBAR(); GAPA(C0=__builtin_amdgcn_mfma_f32_32x32x16_bf16(kf[4],qr[2],C0,0,0,0),   P1[2],P1[3],P1[4],P1[5],     pw2[0]=PKW(P1,0), pw2[1]=PKW(P1,2), pw2); \
    VRD(6); SBAR(); GAPA(C1=__builtin_amdgcn_mfma_f32_32x32x16_bf16(kf[5],qr[2],C1,0,0,0),   P1[6],P1[7],P1[8],P1[9],     pw2[2]=PKW(P1,4), pw2[3]=PKW(P1,6), pw2); \
    VRD(3); SBAR(); GAPA(C0=__builtin_amdgcn_mfma_f32_32x32x16_bf16(kf[6],qr[3],C0,0,0,0),   P1[10],P1[11],P1[12],P1[13], pw3[0]=PKW(P1,8), pw3[1]=PKW(P1,10), pw3); \
    VRD(7); SBAR(); GAPA(C1=__builtin_amdgcn_mfma_f32_32x32x16_bf16(kf[7],qr[3],C1,0,0,0),   P1[14],P1[15],0.f,0.f,       pw3[2]=PKW(P1,12),pw3[3]=PKW(P1,14), pw3); \
    l_reg+=sacc; \
    if(GK){DMA_K((t)+3,sl_cur);} if(GV){DMA_V((t)+1,sl_next);} \
    CMASK(C0,C1,t); \
    { float a=MX3(C0[0],C0[1],C1[0]),b=MX3(C0[2],C0[3],C1[1]); a=MX3(a,C1[2],C1[3]); \
      _Pragma("unroll") for(int r=4;r<16;r+=4){a=MX3(a,C0[r],C0[r+1]);b=MX3(b,C0[r+2],C0[r+3]);a=MX3(a,C1[r],C1[r+1]);b=MX3(b,C1[r+2],C1[r+3]);} \
      float rm=__builtin_fmaxf(a,b); { auto rr=__builtin_amdgcn_permlane32_swap(__float_as_uint(rm),__float_as_uint(rm),false,false); rm=__builtin_fmaxf(__uint_as_float(rr[0]),__uint_as_float(rr[1])); } \
      resc=false; \
      if(__builtin_expect(__any(rm>(float)THRL),0)){ const float dl=__builtin_fmaxf(rm,0.f); mhat+=dl; \
        _Pragma("unroll") for(int r=0;r<16;++r){C0[r]-=dl;C1[r]-=dl;} \
        const float f=__builtin_amdgcn_exp2f(-dl); l_reg*=f; if(hi==0)wsf[r32]=f; resc=true; } } \
    SBAR(); \
    GAPB(o[0]=__builtin_amdgcn_mfma_f32_32x32x16_bf16(PAF(0),VFR(0),o[0],0,0,0), C0,0); \
    GAPB(o[1]=__builtin_amdgcn_mfma_f32_32x32x16_bf16(PAF(0),VFR(4),o[1],0,0,0), C0,4); \
    KRD(GL,0); GAPB(o[0]=__builtin_amdgcn_mfma_f32_32x32x16_bf16(PAF(1),VFR(1),o[0],0,0,0), C0,8); \
    KRD(GL,1); GAPB(o[1]=__builtin_amdgcn_mfma_f32_32x32x16_bf16(PAF(1),VFR(5),o[1],0,0,0), C0,12); \
    KRD(GL,2); GAPB(o[0]=__builtin_amdgcn_mfma_f32_32x32x16_bf16(PAF(2),VFR(2),o[0],0,0,0), C1,0); \
    KRD(GL,3); GAPB(o[1]=__builtin_amdgcn_mfma_f32_32x32x16_bf16(PAF(2),VFR(6),o[1],0,0,0), C1,4); \
    GAPB(o[0]=__builtin_amdgcn_mfma_f32_32x32x16_bf16(PAF(3),VFR(3),o[0],0,0,0), C1,8); \
    GAPB(o[1]=__builtin_amdgcn_mfma_f32_32x32x16_bf16(PAF(3),VFR(7),o[1],0,0,0), C1,12); \
    }while(0)
  int t=1;
  #undef CMASK
  #define CMASK(P0,P1,t) do{}while(0)
  for(;t+5<NT;t+=2){
    STEP(pB0,pB1,pA0,pA1,t,true,true,true);     WAIT_BAR(2); RESC(); ROT();
    STEP(pA0,pA1,pB0,pB1,t+1,true,true,true);   WAIT_BAR(2); RESC(); ROT();
  }
  #undef CMASK
  #define CMASK(P0,P1,t) do{int jb_=(t)-(NT-4); if(jb_>=0)cmask(P0,P1,jb_,qrel,hi);}while(0)
  #define ENDW(tt) do{ if((tt)+3<NT){WAIT_BAR(2);} else if((tt)+2<NT){WAIT_BAR(1);} else {WAIT_BAR(0);} }while(0)
  for(;t+1<NT;t+=2){
    STEP(pB0,pB1,pA0,pA1,t,(t+3<NT),(t+1<NT),(t+1<NT));       ENDW(t);   RESC(); ROT();
    STEP(pA0,pA1,pB0,pB1,t+1,(t+4<NT),(t+2<NT),(t+2<NT));     ENDW(t+1); RESC(); ROT();
  }
  STEP(pB0,pB1,pA0,pA1,NT-1,false,false,false); RESC();
  { float sacc=pB0[0]+pB0[1]; _Pragma("unroll") for(int r=2;r<16;++r)sacc+=pB0[r]; _Pragma("unroll") for(int r=0;r<16;++r)sacc+=pB1[r]; l_reg+=sacc;
    pw0=(u32x4){PKW(pB0,0),PKW(pB0,2),PKW(pB0,4),PKW(pB0,6)};pw1=(u32x4){PKW(pB0,8),PKW(pB0,10),PKW(pB0,12),PKW(pB0,14)};pw2=(u32x4){PKW(pB1,0),PKW(pB1,2),PKW(pB1,4),PKW(pB1,6)};pw3=(u32x4){PKW(pB1,8),PKW(pB1,10),PKW(pB1,12),PKW(pB1,14)};
    SBAR(); pv(o,vb0+sl_cur,PAF(0),PAF(1),PAF(2),PAF(3)); }
  #undef PKW
  #undef PAF
  #undef VFR
  #undef PIN
  #undef MX3
  #undef GAPA
  #undef GAPB
  #undef EX
  #undef VRD
  #undef KRD
  #undef STEP
  #undef ENDW
  {auto rr=__builtin_amdgcn_permlane32_swap(__float_as_uint(l_reg),__float_as_uint(l_reg),false,false);l_reg=__uint_as_float(rr[0])+__uint_as_float(rr[1]);}
  if(hi==0)wsf[32+r32]=l_reg;asm volatile("s_waitcnt lgkmcnt(0)":::"memory");
  float rli[16];
  #pragma unroll
  for(int r=0;r<16;++r)rli[r]=__builtin_amdgcn_rcpf(wsf[32+crow(r,hi)]);
  int lane2=lane; asm volatile("":"+v"(lane2));
  bf16*Ow=O+(rowbase+q0+wid*QBLK)*ADM+h*D;
  { bf16*stg=(bf16*)(shm+LDS_OST)+wid*2048;
    #pragma unroll
    for(int r=0;r<16;++r){const int orow=crow(r,hi);
      #pragma unroll
      for(int d0=0;d0<2;++d0)stg[orow*64+d0*32+r32]=__float2bfloat16(o[d0][r]*rli[r]);}
    asm volatile("s_waitcnt lgkmcnt(0)":::"memory");
    #pragma unroll
    for(int i=0;i<4;++i){const int row=i*8+(lane2>>3),ch=lane2&7; const u32x4 v=*(const u32x4*)(stg+row*64+ch*8); *(u32x4*)(Ow+(long)row*ADM+ch*8)=v;
      float s=(bflo(v.x)*bflo(v.x)+bfhi(v.x)*bfhi(v.x))+(bflo(v.y)*bflo(v.y)+bfhi(v.y)*bfhi(v.y))+(bflo(v.z)*bflo(v.z)+bfhi(v.z)*bfhi(v.z))+(bflo(v.w)*bflo(v.w)+bfhi(v.w)*bfhi(v.w));
      s+=__shfl_xor(s,1); s+=__shfl_xor(s,2); s+=__shfl_xor(s,4);
      if(ch==0)SSQ[(rowbase+q0+wid*QBLK+row)*NHEAD+h]=s; } }
  asm volatile("s_waitcnt lgkmcnt(0)\n\ts_barrier":::"memory");
  #undef DMA_K
  #undef DMA_V
  #undef CMASK
  #undef START
  #undef RESC
  #undef ROT
}
#undef SBAR
#undef WAIT_BAR
}

constexpr int RING_BYTES = 131072;
constexpr int LDS_TOTAL = 147456;
struct Args { const float* in[32]; float* out; unsigned char* ws; };
typedef const float* const __attribute__((address_space(4)))* InTab;
enum In { I_X = 0, I_MEM, I_NORM_MIX, I_W_IN, I_FQN, I_FKN, I_FBIAS, I_ARE, I_AIM, I_LOGDT, I_BRE, I_BIM, I_CRE, I_CIM, I_D, I_WGLU, I_BGLU, I_ONF, I_ONS, I_WOUT,
          I_NCROSS, I_NMEM, I_WXQ, I_WXKV, I_XQN, I_XKN, I_WXO, I_NFFN, I_WUP, I_CONVW, I_CONVB, I_WDN };

struct TJob { const float* W; int ldw, col0, ncols, K; const float* kg; const float* kg2; bf16_t* WT; int mapid, rowoff, items; };
__device__ __forceinline__ int tmap(int mapid, int n, int rowoff) {
    if (mapid == 1) { const int part = n >> 9, f = n & 511, head = f >> 6, d = f & 63; return 512 * part + 256 * (head >> 2) + 128 * (d >> 5) + 32 * (head & 3) + (d & 31); }
    if (mapid == 2) { const int isup = n >= DFF ? 1 : 0; const int j = n - isup * DFF; return 256 * (j >> 7) + 128 * isup + (j & 127); }
    return rowoff + n;
}
__device__ __forceinline__ void transpose_item(const TJob& J, LAS float* scr, int item, int lane) {
    LAS unsigned* s32 = (LAS unsigned*)scr; const LAS unsigned short* s16 = (const LAS unsigned short*)scr;
    const int nblk = J.ncols / 128, kb = item / nblk, nb = item % nblk, k0 = 64 * kb, n0 = 128 * nb;
    const float* src = J.W + (size_t)k0 * J.ldw + J.col0 + n0 + 2 * lane;
    float gv = 1.f; if (J.kg) { const int k = k0 + lane; gv = (J.kg2 && k >= 512) ? J.kg2[k - 512] : J.kg[k]; }
#pragma unroll 16
    for (int kk = 0; kk < 64; ++kk) { f32x2 w = *(const f32x2*)(src + (size_t)kk * J.ldw);
        w = w * __builtin_bit_cast(float, __builtin_amdgcn_readlane(__builtin_bit_cast(int, gv), kk));
        s32[kk * 64 + lane] = pk2(w[0], w[1]); }
    asm volatile("s_waitcnt lgkmcnt(0)" ::: "memory");
    const int c = lane & 7;
#pragma unroll 4
    for (int j = 0; j < 16; ++j) { const int n = (lane >> 3) + 8 * j; const LAS unsigned short* s = s16 + (8 * c) * 128 + n;
        u32x4 o; o.x = (unsigned)s[0] | ((unsigned)s[128] << 16); o.y = (unsigned)s[256] | ((unsigned)s[384] << 16); o.z = (unsigned)s[512] | ((unsigned)s[640] << 16); o.w = (unsigned)s[768] | ((unsigned)s[896] << 16);
        *(u32x4*)(J.WT + (size_t)tmap(J.mapid, n0 + n, J.rowoff) * J.K + k0 + 8 * c) = o; }
    asm volatile("s_waitcnt lgkmcnt(0)" ::: "memory");
}
constexpr int NTJ = 11;
__device__ __forceinline__ void get_tjob(InTab in, unsigned char* ws, int j, TJob& J) {
    J.kg = nullptr; J.kg2 = nullptr; J.mapid = 0; J.rowoff = 0; J.col0 = 0;
    switch (j) {
    case 0: J.W = in[I_W_IN]; J.ldw = INCOLS; J.col0 = 0; J.ncols = 1024; J.K = 1024; J.WT = (bf16_t*)(ws + WS_WIN); J.mapid = 1; break;
    case 1: J.W = in[I_W_IN]; J.ldw = INCOLS; J.col0 = 1024; J.ncols = 512; J.K = 1024; J.WT = (bf16_t*)(ws + WS_WIN); J.rowoff = 1024; break;
    case 2: J.W = in[I_W_IN]; J.ldw = INCOLS; J.col0 = 1544; J.ncols = 512; J.K = 1024; J.WT = (bf16_t*)(ws + WS_WIN); J.rowoff = 1536; break;
    case 3: J.W = in[I_WGLU]; J.ldw = 512; J.ncols = 512; J.K = 512; J.WT = (bf16_t*)(ws + WS_WGLU); break;
    case 4: J.W = in[I_WOUT]; J.ldw = 1024; J.ncols = 1024; J.K = 1024; J.WT = (bf16_t*)(ws + WS_WOUT); J.kg = in[I_ONF]; J.kg2 = in[I_ONS]; break;
    case 5: J.W = in[I_WXQ]; J.ldw = 1024; J.ncols = 1024; J.K = 1024; J.WT = (bf16_t*)(ws + WS_WXQ); J.kg = in[I_NCROSS]; break;
    case 6: J.W = in[I_WXKV]; J.ldw = 2048; J.col0 = 0; J.ncols = 1024; J.K = 1024; J.WT = (bf16_t*)(ws + WS_WXK); break;
    case 7: J.W = in[I_WXKV]; J.ldw = 2048; J.col0 = 1024; J.ncols = 1024; J.K = 1024; J.WT = (bf16_t*)(ws + WS_WXV); break;
    case 8: J.W = in[I_WXO]; J.ldw = 1024; J.ncols = 1024; J.K = 1024; J.WT = (bf16_t*)(ws + WS_WXO); break;
    case 9: J.W = in[I_WUP]; J.ldw = 2 * DFF; J.ncols = 2 * DFF; J.K = 1024; J.WT = (bf16_t*)(ws + WS_WUP); J.kg = in[I_NFFN]; J.mapid = 2; break;
    default: J.W = in[I_WDN]; J.ldw = 1024; J.ncols = 1024; J.K = DFF; J.WT = (bf16_t*)(ws + WS_WDN); break;
    }
    J.items = (J.K / 64) * (J.ncols / 128);
}

__device__ __forceinline__ void rms_row(const float* xrow, const float* gain, bf16_t* orow, int lane, f32x4 (&v)[4]) {
    const f32x4* xr = (const f32x4*)xrow + lane; float s = 0.f;
#pragma unroll
    for (int j = 0; j < 4; ++j) { v[j] = xr[64 * j]; s += (v[j][0] * v[j][0] + v[j][1] * v[j][1]) + (v[j][2] * v[j][2] + v[j][3] * v[j][3]); }
    const float rs = rsqrtf(wave_sum(s) * (1.f / DM) + EPS);
    u32x2* o8 = (u32x2*)orow + lane;
#pragma unroll
    for (int j = 0; j < 4; ++j) { v[j] = v[j] * rs * ((const f32x4*)gain)[64 * j + lane]; u32x2 w; w.x = pk2(v[j][0], v[j][1]); w.y = pk2(v[j][2], v[j][3]); o8[64 * j] = w; }
}

__device__ __forceinline__ void cpow(float ar, float ai, float dt, float e, float& r, float& i) {
    const float mag = __expf(ar * dt * e);
    float rev = ai * dt * e * 0.15915494309189535f; rev -= rintf(rev);
    const float ang = rev * 6.283185307179586f;
    r = mag * cosf(ang); i = mag * sinf(ang);
}

template <int NT>
__device__ __forceinline__ void s5_prep_task(InTab in, unsigned char* ws, int g, int tt, LAS float* L, int tid, bool valid) {
    LAS float* pwA = L; LAS float* pwB = L + 128; LAS float* pwC = L + 256; LAS float* cf = L + 384; LAS float* bb = L + 512; LAS float* cc = L + 512 + 2048;
    if (valid) {
        const float dt = __expf(in[I_LOGDT][g]);
        if (tid < 64) { const int p = tid; const float ar = in[I_ARE][g * 64 + p], ai = in[I_AIM][g * 64 + p];
            float r, i; cpow(ar, ai, dt, (float)tt, r, i); pwA[2 * p] = r; pwA[2 * p + 1] = i;
            cpow(ar, ai, dt, (float)(tt + 1), r, i); pwB[2 * p] = r; pwB[2 * p + 1] = i;
            cpow(ar, ai, dt, (float)(TC - 1 - tt), r, i); pwC[2 * p] = r; pwC[2 * p + 1] = i;
            float lr, li; cpow(ar, ai, dt, 1.f, lr, li);
            const float den = ar * ar + ai * ai, nr = lr - 1.f;
            cf[2 * p] = (nr * ar + li * ai) / den; cf[2 * p + 1] = (li * ar - nr * ai) / den;
            if (tt == 0) { cpow(ar, ai, dt, (float)TC, r, i); float* lb = (float*)(ws + WS_LB32); lb[(g * 64 + p) * 2] = r; lb[(g * 64 + p) * 2 + 1] = i; } }
        for (int idx = tid; idx < 1024; idx += NT) { cc[2 * idx] = in[I_CRE][g * 1024 + idx]; cc[2 * idx + 1] = in[I_CIM][g * 1024 + idx]; }
    }
    __syncthreads();
    if (valid)
        for (int idx = tid; idx < 1024; idx += NT) { const int p = idx >> 4; const float br = in[I_BRE][g * 1024 + idx], bi = in[I_BIM][g * 1024 + idx], cr = cf[2 * p], ci = cf[2 * p + 1];
            bb[2 * idx] = cr * br - ci * bi; bb[2 * idx + 1] = cr * bi + ci * br; }
    __syncthreads();
    if (valid) {
        for (int e = tid; e < 256; e += NT) {
            const int c = e >> 4, cp = e & 15; float s = 0.f;
            for (int p = 0; p < 64; ++p) { const float pr = pwA[2 * p], pi = pwA[2 * p + 1], br = bb[2 * (p * 16 + cp)], bi = bb[2 * (p * 16 + cp) + 1];
                const float mr = pr * br - pi * bi, mi = pr * bi + pi * br; s += cc[2 * (c * 64 + p)] * mr - cc[2 * (c * 64 + p) + 1] * mi; }
            if (tt == 0 && c == cp) s += in[I_D][g * 16 + c];
            ((float*)(ws + WS_KTAB))[((g * TC + tt) * 16 + c) * 16 + cp] = s; }
        bf16_t* bty = (bf16_t*)(ws + WS_BTY) + (size_t)g * 512 * UGP; bf16_t* bte = (bf16_t*)(ws + WS_BTE) + (size_t)g * 256 * 512;
        for (int idx = tid; idx < 1024; idx += NT) { const int c = idx >> 6, p = idx & 63;
            const float cr = cc[2 * idx], ci = cc[2 * idx + 1], pr = pwB[2 * p], pi = pwB[2 * p + 1];
            const float zr = cr * pr - ci * pi, zi = cr * pi + ci * pr;
            *(unsigned*)(bty + (size_t)(tt * 16 + c) * UGP + 512 + 2 * p) = pk2(zr, -zi); }
        for (int idx = tid; idx < 1024; idx += NT) { const int p = idx >> 4, cp = idx & 15;
            const float pr = pwC[2 * p], pi = pwC[2 * p + 1], br = bb[2 * idx], bi = bb[2 * idx + 1];
            bte[(size_t)(2 * p) * 512 + tt * 16 + cp] = (bf16_t)f2bf(pr * br - pi * bi); bte[(size_t)(2 * p + 1) * 512 + tt * 16 + cp] = (bf16_t)f2bf(pr * bi + pi * br); }
        for (int u = tid; u < 256; u += NT) *(u32x4*)(bte + (size_t)(128 + (u >> 1)) * 512 + tt * 16 + (u & 1) * 8) = (u32x4){0u, 0u, 0u, 0u};
    }
    __syncthreads();
}

#define RLX_AGENT __ATOMIC_RELAXED, __HIP_MEMORY_SCOPE_AGENT
#define XB_TMO      128
#define XB_XCNT(j)  (256  + 64 * (j))
#define XB_XSUB(j)  (1280 + 64 * (j))
#define XB_XGEN(j)  (2304 + 64 * (j))
#define XB_TOP      3328
#define XB_TOPGEN   3392
#define XCD_BAR_WORDS 3456
#define XB_SPIN_CAP (1u << 18)

__device__ __forceinline__ unsigned xb_ld(unsigned* p)              { return __hip_atomic_load(p, __ATOMIC_RELAXED, __HIP_MEMORY_SCOPE_AGENT); }
__device__ __forceinline__ unsigned xb_add(unsigned* p, unsigned v) { return __hip_atomic_fetch_add(p, v, __ATOMIC_RELAXED, __HIP_MEMORY_SCOPE_AGENT); }
__device__ __forceinline__ unsigned xb_xcc_id() { return (unsigned)__builtin_amdgcn_s_getreg((3 << 11) | 20) & 0xFu; }
#define XB_SPIN(cond, bar) do { unsigned _sp = 0; while (cond) { __builtin_amdgcn_s_sleep(1); \
    if ((++_sp & 255u) == 0u) { if (xb_ld(&(bar)[XB_TMO])) break; if (_sp > XB_SPIN_CAP) { atomicAdd(&(bar)[XB_TMO], 1u); break; } } } } while (0)

struct XcdBarrier {
    unsigned* bar; unsigned x;
    volatile LAS unsigned* st;
};

__device__ __forceinline__ XcdBarrier xcd_barrier_post(unsigned* bar, volatile LAS unsigned* st) {
    XcdBarrier b; b.bar = bar; b.x = xb_xcc_id(); b.st = st;
    if (threadIdx.x == 0) (void)xb_add(&bar[XB_XCNT(b.x)], 1u);
    return b;
}
__device__ __forceinline__ void xcd_barrier_complete(unsigned* bar, unsigned x, unsigned& nloc, unsigned& nx) {
    const unsigned G = gridDim.x * gridDim.y * gridDim.z;
    unsigned sum, cnt, mine, sp = 0u;
    for (;;) {
        sum = 0u; cnt = 0u; mine = 0u;
#pragma unroll
        for (unsigned j = 0; j < 16; ++j) { const unsigned c = xb_ld(&bar[XB_XCNT(j)]); sum += c; cnt += (c > 0u) ? 1u : 0u; mine = (j == x) ? c : mine; }
        if (sum == G) break;
        __builtin_amdgcn_s_sleep(1);
        if ((++sp & 255u) == 0u) { if (xb_ld(&bar[XB_TMO])) break; if (sp > XB_SPIN_CAP) { atomicAdd(&bar[XB_TMO], 1u); break; } }
    }
    nloc = mine > 0u ? mine : 1u; nx = cnt > 0u ? cnt : 1u;
}

__device__ __forceinline__ void xcd_barrier(const XcdBarrier& b) {
    asm volatile("s_waitcnt vmcnt(0)" ::: "memory");
    __syncthreads();
    if (threadIdx.x == 0) {
        unsigned* bar = b.bar;
        __builtin_amdgcn_s_waitcnt(0);
        unsigned nloc = b.st[0], nx = b.st[1];
        if (nloc == 0u) { xcd_barrier_complete(bar, b.x, nloc, nx); b.st[0] = nloc; b.st[1] = nx; }
        const unsigned old = xb_add(&bar[XB_XSUB(b.x)], 1u);
        const unsigned gen = old / nloc;
        if (old + 1u == (gen + 1u) * nloc) {
            __builtin_amdgcn_fence(__ATOMIC_RELEASE, "agent");
            asm volatile("s_waitcnt vmcnt(0)" ::: "memory");
            const unsigned og = xb_add(&bar[XB_TOP], 1u);
            const unsigned tg = og / nx;
            if (og + 1u == (tg + 1u) * nx) xb_add(&bar[XB_TOPGEN], 1u);
            else XB_SPIN(xb_ld(&bar[XB_TOPGEN]) == tg, bar);
            __builtin_amdgcn_fence(__ATOMIC_ACQUIRE, "agent");
            xb_add(&bar[XB_XGEN(b.x)], 1u);
            asm volatile("s_waitcnt vmcnt(0)" ::: "memory");
        } else {
            XB_SPIN(xb_ld(&bar[XB_XGEN(b.x)]) == gen, bar);
            __builtin_amdgcn_fence(__ATOMIC_ACQUIRE, "agent");
            asm volatile("s_waitcnt vmcnt(0)" ::: "memory");
        }
    }
    __syncthreads();
}


#ifndef FIRST_STEP
#define FIRST_STEP 0
#endif
#ifndef LAST_STEP
#define LAST_STEP 18
#endif
#define ON(n) (FIRST_STEP <= (n) && (n) <= LAST_STEP)
#define SYNC(n) do { if ((n) < LAST_STEP) { XcdBarrier bar_; bar_.bar = (unsigned*)ws; bar_.x = xb_xcc_id(); bar_.st = (volatile LAS unsigned*)(L + RING_BYTES + 352); xcd_barrier(bar_); } } while (0)
#define WSB(off) ((const bf16_t*)(ws + (off)))
__global__ void __launch_bounds__(512, 2) fox_s5_mega(Args a) {
    extern __shared__ __attribute__((aligned(16))) unsigned char lds[];
    LAS unsigned char* L = (LAS unsigned char*)lds;
    const int G = gridDim.x, bx = blockIdx.x, NGW = G * 8, NGT = G * 512;
#define KA const __attribute__((address_space(4))) unsigned char* ka_ = (const __attribute__((address_space(4))) unsigned char*)__builtin_amdgcn_kernarg_segment_ptr(); asm volatile("" : "+s"(ka_)); \
    InTab in = (InTab)ka_; float* out = *(float* const __attribute__((address_space(4)))*)(ka_ + 256); unsigned char* ws = *(unsigned char* const __attribute__((address_space(4)))*)(ka_ + 264); (void)in; (void)out;
#define IDS int tid = threadIdx.x; asm volatile("" : "+v"(tid)); const int lane = tid & 63, wave = __builtin_amdgcn_readfirstlane(tid >> 6); const int gw = bx * 8 + wave, gt = bx * 512 + tid; (void)lane; (void)gw; (void)gt;
    {
        KA
        if (threadIdx.x < 8) ((volatile LAS unsigned*)(L + RING_BYTES + 320))[threadIdx.x + 8 - 8] = 0u;
        if (threadIdx.x < 2) ((volatile LAS unsigned*)(L + RING_BYTES + 352))[threadIdx.x] = 0u;
        __syncthreads();
        (void)xcd_barrier_post((unsigned*)ws, (volatile LAS unsigned*)(L + RING_BYTES + 352));
    }

    if (ON(0)) {
        KA
        IDS
        LAS float* scr = (LAS float*)(L + wave * 16384);
        { int base = 0;
          for (int j = 0; j < NTJ; ++j) { TJob J; get_tjob(in, ws, j, J);
              int first = gw - (base % NGW); if (first < 0) first += NGW;
              for (int it = first; it < J.items; it += NGW) transpose_item(J, scr, it, lane);
              base += J.items; } }
        __syncthreads();
        LAS float* wf = (LAS float*)L;
        for (int idx = tid; idx < 8192; idx += 512) wf[idx] = in[I_W_IN][(size_t)(idx >> 3) * INCOLS + 1536 + (idx & 7)];
        __syncthreads();
        {
            f32x4 nx[4];
            if (gw < T) { const f32x4* xr = (const f32x4*)(in[I_X] + (size_t)gw * DM) + lane;
#pragma unroll
                for (int j = 0; j < 4; ++j) nx[j] = xr[64 * j]; }
            const f32x4* gp = (const f32x4*)in[I_NORM_MIX]; f32x4 gn[4];
#pragma unroll
            for (int j = 0; j < 4; ++j) gn[j] = gp[64 * j + lane];
            const float fbias = in[I_FBIAS][lane & 7];
            for (int m = gw; m < T; m += NGW) {
                f32x4 v[4]; float s = 0.f;
#pragma unroll
                for (int j = 0; j < 4; ++j) { v[j] = nx[j]; s += (v[j][0] * v[j][0] + v[j][1] * v[j][1]) + (v[j][2] * v[j][2] + v[j][3] * v[j][3]); }
                if (m + NGW < T) { const f32x4* xr = (const f32x4*)(in[I_X] + (size_t)(m + NGW) * DM) + lane;
#pragma unroll
                    for (int j = 0; j < 4; ++j) nx[j] = xr[64 * j]; }
                const float rs = rsqrtf(wave_sum(s) * (1.f / DM) + EPS);
                u32x2* o8 = (u32x2*)((bf16_t*)(ws + WS_HN) + (size_t)m * DM) + lane;
#pragma unroll
                for (int j = 0; j < 4; ++j) { v[j] = v[j] * rs * gn[j]; u32x2 w; w.x = pk2(v[j][0], v[j][1]); w.y = pk2(v[j][2], v[j][3]); o8[64 * j] = w; }
                float d[8];
#pragma unroll
                for (int h = 0; h < 8; ++h) d[h] = 0.f;
#pragma unroll
                for (int j = 0; j < 4; ++j)
#pragma unroll
                    for (int i = 0; i < 4; ++i) { const int k = 256 * j + 4 * lane + i; const f32x4 w0 = *(const LAS f32x4*)(wf + k * 8), w1 = *(const LAS f32x4*)(wf + k * 8 + 4);
                        d[0] += v[j][i] * w0[0]; d[1] += v[j][i] * w0[1]; d[2] += v[j][i] * w0[2]; d[3] += v[j][i] * w0[3];
                        d[4] += v[j][i] * w1[0]; d[5] += v[j][i] * w1[1]; d[6] += v[j][i] * w1[2]; d[7] += v[j][i] * w1[3]; }
                float e4[4];
#pragma unroll
                for (int h = 0; h < 4; ++h) { const float keep = (lane & 4) ? d[h + 4] : d[h], give = (lane & 4) ? d[h] : d[h + 4]; e4[h] = keep + __shfl_xor(give, 4); }
                float e2[2];
#pragma unroll
                for (int h = 0; h < 2; ++h) { const float keep = (lane & 2) ? e4[h + 2] : e4[h], give = (lane & 2) ? e4[h] : e4[h + 2]; e2[h] = keep + __shfl_xor(give, 2); }
                float z; { const float keep = (lane & 1) ? e2[1] : e2[0], give = (lane & 1) ? e2[0] : e2[1]; z = keep + __shfl_xor(give, 1); }
                z += __shfl_xor(z, 8); z += __shfl_xor(z, 16); z += __shfl_xor(z, 32);
                if (lane < 8) {
                    z += fbias;
                    const float ls = fminf(z, 0.f) - __logf(1.f + __expf(-fabsf(z)));
                    const int b = m >> 11, t = m & 2047;
                    ((float*)(ws + WS_LOGF))[(size_t)(b * 8 + lane) * SEQ + t] = ls; }
            }
        }
        for (int m = gw; m < TM; m += NGW) { f32x4 v[4]; rms_row(in[I_MEM] + (size_t)m * DM, in[I_NMEM], (bf16_t*)(ws + WS_MN) + (size_t)m * DM, lane, v); }
        __syncthreads();
        {
            const int NTASK = S5G * TC, sub = tid >> 7, ltid = tid & 127, per = NTASK / G;
            for (int i0 = 0; bx + i0 * G < NTASK; i0 += 4) { const int task = bx + (i0 + sub) * G; const bool valid = task < NTASK;
                const int t2 = !valid ? 0 : ((NTASK % G == 0) ? (task % G) * per + task / G : task);
                s5_prep_task<128>(in, ws, t2 / TC, t2 % TC, (LAS float*)L + sub * 5120, ltid, valid); }
        }
        SYNC(0);
    }
    if (ON(2)) {
        KA
        pg8::Gemm g{WSB(WS_HN), WSB(WS_WIN), DM, DM, DM}; GOrder<OK_PLAIN> S; S.init(T / 256, 8, G, bx, DM, DM);
        Epi<EK_PROJ> E{ws + WS_Q, ws + WS_K, ws + WS_V, ws + WS_UG, in[I_FQN], in[I_FKN], nullptr};
        pg8::gemm_phase(L, g, S, E);
    }
    if (ON(1)) {
        KA
        IDS
        int seq = (bx < BATCH * NFH) ? bx : -1;
        if (G == 256) seq = (bx >= 64 && bx < 128) ? bx - 64 : ((bx >= 192) ? bx - 128 : -1);
        if (wave == 0 && seq >= 0) {
            const float* lf = (const float*)(ws + WS_LOGF) + (size_t)seq * SEQ + lane * 32; float* cb = (float*)(ws + WS_CB) + (size_t)seq * SEQ + lane * 32;
            f32x4 x[8]; float run = 0.f;
#pragma unroll
            for (int j = 0; j < 8; ++j) { x[j] = ((const f32x4*)lf)[j]; x[j][0] += run; x[j][1] += x[j][0]; x[j][2] += x[j][1]; x[j][3] += x[j][2]; run = x[j][3]; }
            float incl = run;
#pragma unroll
            for (int o = 1; o < 64; o <<= 1) { const float y = __shfl_up(incl, o); if (lane >= o) incl += y; }
            const float excl = incl - run;
#pragma unroll
            for (int j = 0; j < 8; ++j) ((f32x4*)cb)[j] = (x[j] + excl) * LOG2E;
        }
    }
    if (ON(3)) {
        KA
        pg8::Gemm g{WSB(WS_MN), WSB(WS_WXK), DM, DM, DM}; GOrder<OK_PLAIN> S; S.init(TM / 256, 4, G, bx, DM, DM);
        Epi<EK_MEMK> E{ws + WS_KST, ws + WS_SSQK, nullptr, nullptr, nullptr, nullptr, nullptr};
        pg8::gemm_phase(L, g, S, E);
    }
    if (ON(4)) {
        KA
        pg8::Gemm g{WSB(WS_WXV), WSB(WS_MN), DM, DM, DM}; GOrder<OK_PLAIN> S; S.init(4, TM / 256, G, (bx + 128) % G, DM, DM);
        Epi<EK_MEMVT> E{ws + WS_VT, nullptr, nullptr, nullptr, nullptr, nullptr, nullptr};
        pg8::gemm_phase(L, g, S, E);
        SYNC(4);
    }
    if (ON(5)) {
        KA
        const int vcu = (G % 8 == 0) ? (bx % 8) * (G / 8) + bx / 8 : bx;
        float skip_th; { const int ln = threadIdx.x & 63; float gq = fabsf(in[I_FQN][ln]), gk = fabsf(in[I_FKN][ln]);
#pragma unroll
            for (int o = 1; o < 64; o <<= 1) { gq = fmaxf(gq, __shfl_xor(gq, o)); gk = fmaxf(gk, __shfl_xor(gk, o)); }
            skip_th = 2.f * (64.f * C2Q * gq * gk) + 40.f; }
        for (int L2 = vcu; L2 < BATCH * NFH * 2; L2 += G) { const int bh = L2 >> 1, s = L2 & 1;
            for (int i = 0; i < 4; ++i) { const int qb = (i == 0) ? s : (i == 1) ? 3 - s : (i == 2) ? 4 + s : 7 - s;
                attn_body::attn_unit<8>(bh >> 3, bh & 7, qb, (const attn_body::bf16*)(ws + WS_Q), (const attn_body::bf16*)(ws + WS_K), (const attn_body::bf16*)(ws + WS_V),
                                        (attn_body::bf16*)(ws + WS_FOX), (const float*)(ws + WS_CB), (float*)(ws + WS_SSQF), (char*)lds, skip_th); } }
    }
    if (ON(6)) {
        KA
        pg8::Gemm g{WSB(WS_UG), WSB(WS_BTE), UGP, 512, 256}; GOrder<OK_S5E> S; S.init(256, 1, G, bx, UGP, 512);
        Epi<EK_S5E> E{ws + WS_EPART, nullptr, nullptr, nullptr, nullptr, nullptr, nullptr};
        pg8::gemm_phase(L, g, S, E);
        SYNC(6);
    }
    if (ON(7)) {
        KA
        IDS
        const float* kt = (const float*)(ws + WS_KTAB); bf16_t* bty = (bf16_t*)(ws + WS_BTY);
        for (int idx = gt; idx < S5G * 512 * 64; idx += NGT) {
            const int half = idx & 1, ss = (idx >> 1) & 31, nn = (idx >> 6) & 511, gI = idx >> 15; const int tt = nn >> 4, c = nn & 15;
            u32x4 w = (u32x4){0u, 0u, 0u, 0u};
            if (ss <= tt) { const float* src = kt + ((size_t)((gI * TC + (tt - ss)) * 16 + c)) * 16 + half * 8; const f32x4 k0 = *(const f32x4*)src, k1 = *(const f32x4*)(src + 4);
                w.x = pk2(k0[0], k0[1]); w.y = pk2(k0[2], k0[3]); w.z = pk2(k1[0], k1[1]); w.w = pk2(k1[2], k1[3]); }
            *(u32x4*)(bty + ((size_t)gI * 512 + nn) * UGP + ss * 16 + half * 8) = w; }
        const float* ep = (const float*)(ws + WS_EPART); const float* lb = (const float*)(ws + WS_LB32); bf16_t* ug = (bf16_t*)(ws + WS_UG);
        for (int idx = gt; idx < S5G * BATCH * S5P; idx += NGT) { const int p = idx & 63, gb = idx >> 6, gI = gb >> 4;
            const float lr = lb[(gI * 64 + p) * 2], li = lb[(gI * 64 + p) * 2 + 1]; float sr = 0.f, si = 0.f;
            for (int k0 = 0; k0 < NCH; k0 += 16) {
                f32x2 e0[16], e1[16];
#pragma unroll
                for (int j = 0; j < 16; ++j) { const size_t row = (size_t)gb * NCH + k0 + j; e0[j] = *(const f32x2*)(ep + row * 128 + 2 * p); e1[j] = *(const f32x2*)(ep + (size_t)32768 * 128 + row * 128 + 2 * p); }
#pragma unroll
                for (int j = 0; j < 16; ++j) { const size_t row = (size_t)gb * NCH + k0 + j;
                    *(unsigned*)(ug + row * UGP + 512 + 2 * p) = pk2(sr, si);
                    const float nr = lr * sr - li * si + (e0[j][0] + e1[j][0]), ni = lr * si + li * sr + (e0[j][1] + e1[j][1]); sr = nr; si = ni; } } }
        SYNC(7);
    }
    if (ON(8)) {
        KA
        pg8::Gemm g{WSB(WS_UG), WSB(WS_BTY), UGP, UGP, UGP}; GOrder<OK_S5Y> S; S.init(256, 1, G, bx, UGP, UGP);
        Epi<EK_S5Y> E{ws + WS_Y1, nullptr, nullptr, nullptr, nullptr, nullptr, nullptr};
        pg8::gemm_phase(L, g, S, E);
        SYNC(8);
    }
    if (ON(9)) {
        KA
        pg8::Gemm g{WSB(WS_Y1), WSB(WS_WGLU), 512, 512, 512}; GOrder<OK_PLAIN> S; S.init(T / 256, 2, G, bx, 512, 512);
        Epi<EK_GLU> E{ws + WS_Y2, ws + WS_SSQY, nullptr, nullptr, ws + WS_Y1, in[I_BGLU], nullptr};
        pg8::gemm_phase(L, g, S, E);
        SYNC(9);
    }
    if (ON(10)) {
        KA
        IDS
        const float* sf = (const float*)(ws + WS_SSQF); const float* sy = (const float*)(ws + WS_SSQY);
        const bf16_t* fox = WSB(WS_FOX); const bf16_t* y2 = WSB(WS_Y2); bf16_t* mx = (bf16_t*)(ws + WS_MIXN);
        {
            f32x4 a0, a1, b0, b1; u32x4 f, y;
#define NRM_LOAD(mm) do { a0 = *(const f32x4*)(sf + (size_t)(mm) * 8); a1 = *(const f32x4*)(sf + (size_t)(mm) * 8 + 4); b0 = *(const f32x4*)(sy + (size_t)(mm) * 8); b1 = *(const f32x4*)(sy + (size_t)(mm) * 8 + 4); \
                f = *(const u32x4*)(fox + (size_t)(mm) * 512 + lane * 8); y = *(const u32x4*)(y2 + (size_t)(mm) * 512 + lane * 8); } while (0)
            if (gw < T) NRM_LOAD(gw);
            for (int m = gw; m < T; m += NGW) {
                const float rf = rsqrtf((((a0[0] + a0[1]) + (a0[2] + a0[3])) + ((a1[0] + a1[1]) + (a1[2] + a1[3]))) * (1.f / 512.f) + EPS);
                const float ry = rsqrtf((((b0[0] + b0[1]) + (b0[2] + b0[3])) + ((b1[0] + b1[1]) + (b1[2] + b1[3]))) * (1.f / 512.f) + EPS);
                u32x4 of, oy;
                of.x = pk2(bflo(f.x) * rf, bfhi(f.x) * rf); of.y = pk2(bflo(f.y) * rf, bfhi(f.y) * rf); of.z = pk2(bflo(f.z) * rf, bfhi(f.z) * rf); of.w = pk2(bflo(f.w) * rf, bfhi(f.w) * rf);
                oy.x = pk2(bflo(y.x) * ry, bfhi(y.x) * ry); oy.y = pk2(bflo(y.y) * ry, bfhi(y.y) * ry); oy.z = pk2(bflo(y.z) * ry, bfhi(y.z) * ry); oy.w = pk2(bflo(y.w) * ry, bfhi(y.w) * ry);
                if (m + NGW < T) NRM_LOAD(m + NGW);
                *(u32x4*)(mx + (size_t)m * DM + lane * 8) = of; *(u32x4*)(mx + (size_t)m * DM + 512 + lane * 8) = oy; }
#undef NRM_LOAD
        }
        SYNC(10);
    }
    if (ON(11)) {
        KA
        pg8::Gemm g{WSB(WS_MIXN), WSB(WS_WOUT), DM, DM, DM}; GOrder<OK_PLAIN> S; S.init(T / 256, 4, G, bx, DM, DM);
        Epi<EK_WOUT> E{out, ws + WS_H1B, ws + WS_SSQ1, nullptr, in[I_X], nullptr, nullptr};
        pg8::gemm_phase(L, g, S, E);
        SYNC(11);
    }
    if (ON(12)) {
        KA
        IDS
        const float* sk = (const float*)(ws + WS_SSQK); float* sck = (float*)(ws + WS_SCK);
        for (int idx = gt; idx < TM * 4; idx += NGT) { const int key = idx >> 2, h = idx & 3; const f32x4 q = *(const f32x4*)(sk + (size_t)key * 16 + h * 4);
            sck[(size_t)h * TM + key] = rsqrtf(((q[0] + q[1]) + (q[2] + q[3])) * (1.f / 256.f) + EPS); }
        pg8::Gemm g{WSB(WS_H1B), WSB(WS_WXQ), DM, DM, DM}; GOrder<OK_PLAIN> S; S.init(T / 256, 4, G, bx, DM, DM);
        Epi<EK_XQ> E{ws + WS_QST, ws + WS_SSQQ, nullptr, nullptr, in[I_XQN], in[I_XKN], nullptr};
        pg8::gemm_phase(L, g, S, E);
        SYNC(12);
    }
    if (ON(13)) {
        KA
        pg8::Gemm g{WSB(WS_QST), WSB(WS_KST), DM, DM, 256}; GOrder<OK_XS> S; S.init(512, 1, G, bx, DM, DM);
        Epi<EK_XS> E{ws + WS_P, ws + WS_PSUM, nullptr, nullptr, ws + WS_SSQ1, ws + WS_SSQQ, ws + WS_SCK};
        pg8::gemm_phase(L, g, S, E);
        SYNC(13);
    }
    if (ON(14)) {
        KA
        pg8::Gemm g{WSB(WS_P), WSB(WS_VT), DM, TM, 256}; GOrder<OK_XO> S; S.init(512, 1, G, bx, DM, TM);
        Epi<EK_XO> E{ws + WS_XO, nullptr, nullptr, nullptr, ws + WS_PSUM, nullptr, nullptr};
        pg8::gemm_phase(L, g, S, E);
        SYNC(14);
    }
    if (ON(15)) {
        KA
        pg8::Gemm g{WSB(WS_XO), WSB(WS_WXO), DM, DM, DM}; GOrder<OK_PLAIN> S; S.init(T / 256, 4, G, bx, DM, DM);
        Epi<EK_WXO> E{out, ws + WS_H2B, ws + WS_SSQ2, nullptr, out, nullptr, nullptr};
        pg8::gemm_phase(L, g, S, E);
        SYNC(15);
    }
    if (ON(16)) {
        KA
        { IDS
          const float* s2 = (const float*)(ws + WS_SSQ2); float* r2 = (float*)(ws + WS_RS2);
          for (int row = gt; row < T; row += NGT) { const f32x4 t0 = *(const f32x4*)(s2 + (size_t)row * 16), t1 = *(const f32x4*)(s2 + (size_t)row * 16 + 4), t2 = *(const f32x4*)(s2 + (size_t)row * 16 + 8), t3 = *(const f32x4*)(s2 + (size_t)row * 16 + 12);
              r2[row] = rsqrtf((((t0[0] + t0[1]) + (t0[2] + t0[3])) + ((t1[0] + t1[1]) + (t1[2] + t1[3])) + ((t2[0] + t2[1]) + (t2[2] + t2[3])) + ((t3[0] + t3[1]) + (t3[2] + t3[3]))) * (1.f / DM) + EPS); }
          SYNC(15); }
        pg8::Gemm g{WSB(WS_H2B), WSB(WS_WUP), DM, DM, DM}; GOrder<OK_PLAIN> S; S.init(T / 256, 22, G, bx, DM, DM);
        Epi<EK_UPC> E{ws + WS_U, ws + WS_G, ws + WS_G + 4 * MiB, ws + WS_G + 8 * MiB, ws + WS_RS2, in[I_CONVW], in[I_CONVB], (LAS float*)(L + RING_BYTES + 1024)};
        pg8::gemm_phase(L, g, S, E);
        SYNC(16);
    }
    if (ON(17)) {
        KA
        IDS
        const float* GHF = (const float*)(ws + WS_G); const float* GHL = (const float*)(ws + WS_G + 4 * MiB); const float* UH = (const float*)(ws + WS_G + 8 * MiB);
        const float* cw = in[I_CONVW]; const float* cbv = in[I_CONVB]; bf16_t* A = (bf16_t*)(ws + WS_U);
        for (int idx = gt; idx < (T / 256) * 2 * DFF; idx += NGT) { const int j = idx % DFF, pi = idx / DFF, i = pi & 1, pm = pi >> 1; const bool first = (pm & 7) == 0;
            const float g0 = GHF[(size_t)pi * DFF + j];
            const float gl1 = first ? 0.f : GHL[((size_t)(pm - 1) * 2 + 1) * DFF + j], gl0 = first ? 0.f : GHL[((size_t)(pm - 1) * 2) * DFF + j];
            const float g1 = i ? GHF[(size_t)(pm * 2) * DFF + j] : gl1, g2 = i ? gl1 : gl0;
            const float z = cbv[j] + cw[j] * g2 + cw[DFF + j] * g1 + cw[2 * DFF + j] * g0;
            A[(size_t)(pm * 256 + i) * DFF + j] = (bf16_t)f2bf(z * sigm(z) * UH[(size_t)pi * DFF + j]); }
        SYNC(17);
    }
    if (ON(18)) {
        KA
        pg8::Gemm g{WSB(WS_U), WSB(WS_WDN), DFF, DFF, DFF}; GOrder<OK_PLAIN> S; S.init(T / 256, 4, G, bx, DFF, DFF);
        Epi<EK_DOWN> E{out, nullptr, nullptr, nullptr, nullptr, nullptr, nullptr};
        pg8::gemm_phase(L, g, S, E);
    }
}

extern "C" void kernel_launch(void* const* d_in, const int* in_sizes, int n_in, void* d_out, int out_size, void* d_ws, size_t ws_size, hipStream_t stream) {
    static int grid = 0;
    if (grid == 0) {
        if (n_in != 32 || out_size != T * DM || ws_size < WS_END) { fprintf(stderr, "kernel_launch: unexpected shapes (n_in %d out %d ws %zu)\n", n_in, out_size, ws_size); grid = -1; return; }
        int dev = 0, cus = 0, per_cu = 0;
        (void)hipGetDevice(&dev); (void)hipDeviceGetAttribute(&cus, hipDeviceAttributeMultiprocessorCount, dev);
        if (hipFuncSetAttribute((const void*)fox_s5_mega, hipFuncAttributeMaxDynamicSharedMemorySize, LDS_TOTAL) != hipSuccess) { fprintf(stderr, "kernel_launch: hipFuncSetAttribute failed\n"); grid = -1; return; }
        if (hipOccupancyMaxActiveBlocksPerMultiprocessor(&per_cu, (const void*)fox_s5_mega, 512, LDS_TOTAL) != hipSuccess || per_cu < 1) { fprintf(stderr, "kernel_launch: occupancy query says %d\n", per_cu); per_cu = 1; }
        (void)hipGetLastError();
        grid = cus;
        if (grid > cus * per_cu) grid = cus * per_cu;
    }
    if (grid < 0) return;
    if (hipMemsetAsync(d_ws, 0, 65536, stream) != hipSuccess) { fprintf(stderr, "kernel_launch: memset of the barrier words failed\n"); return; }
    Args a{};
    for (int i = 0; i < 32; ++i) a.in[i] = (const float*)d_in[i];
    a.out = (float*)d_out; a.ws = (unsigned char*)d_ws;
    void* args[] = {&a};
    hipError_t e = hipLaunchCooperativeKernel((const void*)fox_s5_mega, dim3(grid), dim3(512), args, LDS_TOTAL, stream);
    if (e != hipSuccess) fprintf(stderr, "cooperative launch failed: %s (grid %d)\n", hipGetErrorString(e), grid);
}
```

```cpp
#include <hip/hip_runtime.h>
#include <hip/hip_bf16.h>
#include <cstdio>
#include <cstdint>
#include <cmath>

constexpr int BATCH = 16, SEQ = 2048, DM = 1024, T = BATCH * SEQ;
constexpr int NMEM = 256, TM = BATCH * NMEM;
constexpr int FOXW = 512, HD = 64, NFH = 8;
constexpr int S5W = 512, S5G = 32, S5C = 16, S5P = 64;
constexpr int NXH = 4, XHD = 256;
constexpr int DFF = 2816;
constexpr int INCOLS = 2056;
constexpr float EPS = 1e-6f;
constexpr int TC = 32, NCH = SEQ / TC;
constexpr int UGP = TC * 16 + 128;
constexpr float LOG2E = 1.4426950408889634f;
constexpr float C2Q = 0.125f * LOG2E;

#define LAS __attribute__((address_space(3)))
typedef unsigned short bf16_t;
typedef short bf16x8 __attribute__((ext_vector_type(8)));
typedef float f32x4 __attribute__((ext_vector_type(4)));
typedef float f32x2 __attribute__((ext_vector_type(2)));
typedef unsigned u32x4 __attribute__((ext_vector_type(4)));
typedef unsigned u32x2 __attribute__((ext_vector_type(2)));

__device__ __forceinline__ unsigned f2bf(float f) { unsigned u = __builtin_bit_cast(unsigned, f); return (u + 0x7fffu + ((u >> 16) & 1u)) >> 16; }
typedef __bf16 bf16x2_hw __attribute__((ext_vector_type(2)));
__device__ __forceinline__ unsigned pk2(float lo, float hi) { f32x2 v = {lo, hi}; bf16x2_hw b = __builtin_convertvector(v, bf16x2_hw); return __builtin_bit_cast(unsigned, b); }
__device__ __forceinline__ float bflo(unsigned w) { return __builtin_bit_cast(float, w << 16); }
__device__ __forceinline__ float bfhi(unsigned w) { return __builtin_bit_cast(float, w & 0xffff0000u); }
__device__ __forceinline__ float wave_sum(float v) {
#pragma unroll
    for (int o = 1; o < 64; o <<= 1) v += __shfl_xor(v, o);
    return v;
}

__device__ __forceinline__ float red_fq(float v) {
    v += __builtin_bit_cast(float, __builtin_amdgcn_ds_swizzle(__builtin_bit_cast(int, v), 0x401F));
    float a = v, b = v;
    asm volatile("s_nop 1\n\tv_permlane32_swap_b32 %0, %1\n\ts_nop 1" : "+v"(a), "+v"(b));
    return a + b;
}

constexpr size_t MiB = 1u << 20;
constexpr size_t WS_WIN = 1 * MiB, WS_WGLU = 5 * MiB, WS_WOUT = 6 * MiB, WS_WXQ = 8 * MiB, WS_WXK = 10 * MiB, WS_WXV = 12 * MiB, WS_WXO = 14 * MiB,
                 WS_WUP = 16 * MiB, WS_WDN = 27 * MiB, WS_BTY = 33 * MiB, WS_BTE = 53 * MiB, WS_KTAB = 61 * MiB, WS_LB32 = 62 * MiB, WS_LOGF = 63 * MiB,
                 WS_CB = 64 * MiB, WS_SSQF = 65 * MiB, WS_SSQY = 66 * MiB, WS_SSQ1 = 67 * MiB, WS_SSQ2 = 69 * MiB, WS_SSQQ = 71 * MiB, WS_PSUM = 73 * MiB,
                 WS_SSQK = 75 * MiB, WS_SCK = 76 * MiB, WS_RS2 = 77 * MiB;
constexpr size_t WS_HN = 80 * MiB, WS_FOX = 80 * MiB, WS_Y1 = 112 * MiB, WS_QST = 80 * MiB, WS_H2B = 80 * MiB;
constexpr size_t WS_MN = 144 * MiB, WS_KST = 152 * MiB, WS_VT = 160 * MiB;
constexpr size_t WS_Q = 168 * MiB, WS_K = 200 * MiB, WS_V = 232 * MiB, WS_Y2 = 168 * MiB, WS_MIXN = 200 * MiB, WS_P = 168 * MiB;
constexpr size_t WS_UG = 264 * MiB, WS_EPART = 304 * MiB, WS_H1B = 264 * MiB, WS_XO = 336 * MiB;
constexpr size_t WS_G = 144 * MiB, WS_U = 320 * MiB, WS_END = 496 * MiB;

namespace pg8 {
constexpr int BM = 256, BK = 64, HALF = 128, HTB = HALF * BK * 2, STAGE_BYTES = 8 * HTB;
__device__ __forceinline__ int lds_byte(int r, int c) { const int st = (r >> 4) * 2 + (c >> 5), rr = r & 15, cc = c & 31, ob = rr * 64 + cc * 2; return st * 1024 + (ob ^ (((ob >> 9) & 1) << 5)); }
__device__ __forceinline__ void stage_rc(int b, int& R, int& C) { const int st = b / 1024, sb = b % 1024, swz = sb ^ (((sb >> 9) & 1) << 5); R = (st >> 1) * 16 + swz / 64; C = (st & 1) * 32 + (swz % 64) / 2; }
__device__ __forceinline__ int perm32(int rho) { const int n = rho >> 4, i = rho & 15; return 8 * (i >> 2) + 4 * n + (i & 3); }

struct Unit { int pm, pn; long offA, offB; };
struct Gemm { const bf16_t* A; const bf16_t* Bt; int lda, ldb, K; };

template <class Epi, class Sched>
__device__ __forceinline__ void gemm_phase(LAS unsigned char* lds, const Gemm g, const Sched& S, const Epi& E) {
    int tid = threadIdx.x; asm volatile("" : "+v"(tid));
    const int wid = __builtin_amdgcn_readfirstlane(tid >> 6), lane = tid & 63, wr = wid >> 2, wc = wid & 3, fr = lane & 15, fq = lane >> 4;
    const int K = g.K, nt = K / BK;
    unsigned voffA[2], voffB[2];
#pragma unroll
    for (int i = 0; i < 2; ++i) { int R, C; stage_rc(tid * 16 + i * 8192, R, C); const int Rb = (R & ~31) + perm32(R & 31);
        voffA[i] = (unsigned)(R * g.lda + C) * 2u; voffB[i] = (unsigned)(Rb * g.ldb + C) * 2u; }
    const size_t kstep = (size_t)(BK * 2);
    const size_t hstepA = (size_t)HALF * g.lda * 2, hstepB = (size_t)HALF * g.ldb * 2;
    const unsigned ldsw = (unsigned)wid * 1024u;
    const int aoff = lds_byte(wr * 64 + fr, fq * 8), boff = lds_byte(wc * 32 + fr, fq * 8);
#define PG8_SA(b, h) (((b) * 2 + (h)) * HTB)
#define PG8_SB(b, h) ((4 + (b) * 2 + (h)) * HTB)
#define PG8_STAGE(bufoff, gbase, voff) do { _Pragma("unroll") for (int _i = 0; _i < 2; ++_i) \
        __builtin_amdgcn_global_load_lds((const unsigned*)((const char*)(gbase) + (voff)[_i]), (LAS unsigned*)(lds + (bufoff) + ldsw + _i * 8192), 16, 0, 0); } while (0)
#define PG8_LDA(dst, b, h) do { _Pragma("unroll") for (int m = 0; m < 4; ++m) _Pragma("unroll") for (int k = 0; k < 2; ++k) dst[m][k] = *(const LAS bf16x8*)(lds + PG8_SA(b, h) + aoff + m * 2048 + k * 1024); } while (0)
#define PG8_LDB(dst, b, h) do { _Pragma("unroll") for (int n = 0; n < 2; ++n) _Pragma("unroll") for (int k = 0; k < 2; ++k) dst[n][k] = *(const LAS bf16x8*)(lds + PG8_SB(b, h) + boff + n * 2048 + k * 1024); } while (0)
#define PG8_MMA(ai, bj, At, Bt) do { __builtin_amdgcn_s_setprio(1); _Pragma("unroll") for (int m = 0; m < 4; ++m) _Pragma("unroll") for (int n = 0; n < 2; ++n) _Pragma("unroll") for (int k = 0; k < 2; ++k) \
        acc[ai][bj][m][n] = __builtin_amdgcn_mfma_f32_16x16x32_bf16(Bt[n][k], At[m][k], acc[ai][bj][m][n], 0, 0, 0); __builtin_amdgcn_s_setprio(0); } while (0)
#define PG8_WAIT_V(n) asm volatile("s_waitcnt vmcnt(" #n ")" ::: "memory")
#define PG8_WAIT_L(n) asm volatile("s_waitcnt lgkmcnt(" #n ")" ::: "memory")
#define PG8_BAR __builtin_amdgcn_s_barrier()
#define PG8_SCHED __builtin_amdgcn_sched_barrier(0)
    Unit cur, nxt; int ui = 0;
    if (!S.next(0, cur)) return;
    f32x4 acc[2][2][4][2];
#pragma unroll
    for (int a = 0; a < 2; ++a)
#pragma unroll
        for (int b = 0; b < 2; ++b)
#pragma unroll
            for (int m = 0; m < 4; ++m)
#pragma unroll
                for (int n = 0; n < 2; ++n) acc[a][b][m][n] = (f32x4){0.f, 0.f, 0.f, 0.f};
    bf16x8 At[4][2], B0[2][2], B1[2][2];
    const char* cA = (const char*)g.A + cur.offA; const char* cB = (const char*)g.Bt + cur.offB;
    PG8_STAGE(PG8_SB(0, 0), cB, voffB); PG8_STAGE(PG8_SB(0, 1), cB + hstepB, voffB); PG8_STAGE(PG8_SA(0, 0), cA, voffA); PG8_STAGE(PG8_SA(0, 1), cA + hstepA, voffA);
    if (wr == 1) PG8_BAR;
    PG8_WAIT_V(2); PG8_BAR;
    PG8_STAGE(PG8_SB(1, 0), cB + kstep, voffB); PG8_STAGE(PG8_SA(1, 0), cA + kstep, voffA); PG8_STAGE(PG8_SB(1, 1), cB + hstepB + kstep, voffB);
    PG8_WAIT_V(6); PG8_BAR;
    for (;;) {
        const bool has_next = S.next(ui + 1, nxt);
        const char* nA = has_next ? (const char*)g.A + nxt.offA : cA; const char* nB = has_next ? (const char*)g.Bt + nxt.offB : cB;
        for (int t = 0; t < nt; t += 2) {
            const bool last = (t == nt - 2);
            const char* a1 = cA + (size_t)(t + 1) * kstep;
            const char* a2 = last ? nA : cA + (size_t)(t + 2) * kstep; const char* b2 = last ? nB : cB + (size_t)(t + 2) * kstep;
            const char* a3 = a2 + kstep; const char* b3 = b2 + kstep;
            PG8_LDB(B0, 0, 0); PG8_LDB(B1, 0, 1); PG8_SCHED; PG8_LDA(At, 0, 0); PG8_STAGE(PG8_SA(1, 1), a1 + hstepA, voffA);
            PG8_WAIT_V(8); PG8_WAIT_L(0); PG8_BAR; PG8_MMA(0, 0, At, B0); PG8_MMA(0, 1, At, B1); PG8_BAR; PG8_SCHED;
            PG8_LDA(At, 0, 1); PG8_STAGE(PG8_SB(0, 0), b2, voffB); PG8_STAGE(PG8_SB(0, 1), b2 + hstepB, voffB); PG8_STAGE(PG8_SA(0, 0), a2, voffA);
            PG8_WAIT_V(8); PG8_WAIT_L(0); PG8_BAR; PG8_MMA(1, 0, At, B0); PG8_MMA(1, 1, At, B1); PG8_BAR; PG8_SCHED;
            PG8_LDB(B0, 1, 0); PG8_LDB(B1, 1, 1); PG8_SCHED; PG8_LDA(At, 1, 0); PG8_STAGE(PG8_SA(0, 1), a2 + hstepA, voffA);
            PG8_WAIT_V(8); PG8_WAIT_L(0); PG8_BAR; PG8_MMA(0, 0, At, B0); PG8_MMA(0, 1, At, B1); PG8_BAR; PG8_SCHED;
            PG8_LDA(At, 1, 1); PG8_STAGE(PG8_SB(1, 0), b3, voffB); PG8_STAGE(PG8_SB(1, 1), b3 + hstepB, voffB); PG8_STAGE(PG8_SA(1, 0), a3, voffA);
            PG8_WAIT_V(8); PG8_WAIT_L(0); PG8_BAR; PG8_MMA(1, 0, At, B0); PG8_MMA(1, 1, At, B1); PG8_BAR; PG8_SCHED;
        }
        if (wr == 0) PG8_BAR;
        { int fr2 = fr, fq2 = fq; asm volatile("" : "+v"(fr2), "+v"(fq2));
          E(acc, cur, wr, wc, fr2, fq2); }
        if (!has_next) break;
#pragma unroll
        for (int a = 0; a < 2; ++a)
#pragma unroll
            for (int b = 0; b < 2; ++b)
#pragma unroll
                for (int m = 0; m < 4; ++m)
#pragma unroll
                    for (int n = 0; n < 2; ++n) acc[a][b][m][n] = (f32x4){0.f, 0.f, 0.f, 0.f};
        cur = nxt; cA = nA; cB = nB; ++ui;
        if (wr == 1) PG8_BAR;
    }
    PG8_WAIT_V(0);
    PG8_BAR;
#undef PG8_SA
#undef PG8_SB
#undef PG8_STAGE
#undef PG8_LDA
#undef PG8_LDB
#undef PG8_MMA
#undef PG8_WAIT_V
#undef PG8_WAIT_L
#undef PG8_BAR
#undef PG8_SCHED
}
}
using pg8::Unit;

enum OrderKind { OK_PLAIN = 0, OK_S5E, OK_S5Y, OK_XS, OK_XO };
template <int kind> struct GOrder {
    int nM, nN, nwg, G, c, lda, ldb;
    __device__ __forceinline__ void init(int nM_, int nN_, int G_, int c_, int lda_, int ldb_) { nM = nM_; nN = nN_; nwg = nM_ * nN_; G = G_; c = c_; lda = lda_; ldb = ldb_; }
    __device__ __forceinline__ bool next(int i, Unit& u) const {
        const long L = (long)i * G + c; if (L >= nwg) return false;
        const int l = (int)L;
        if constexpr (kind == OK_PLAIN) {
            int wgid = l; { const int q = nwg / 8, r = nwg % 8, xcd = wgid % 8, off = wgid / 8; wgid = (xcd < r ? xcd * (q + 1) : r * (q + 1) + (xcd - r) * q) + off; }
            const int nig = 8 * nN, gid = wgid / nig, fm = gid * 8, gsz = (nM - fm) < 8 ? (nM - fm) : 8;
            u.pm = fm + ((wgid % nig) % gsz); u.pn = (wgid % nig) / gsz;
            u.offA = (long)u.pm * 256 * lda * 2; u.offB = (long)u.pn * 256 * ldb * 2;
        } else if constexpr (kind == OK_S5E) {
            const int kq = l & 1, pmm = (l >> 1) & 3, gg = l >> 3;
            u.pm = gg * 4 + pmm; u.pn = kq;
            u.offA = ((long)u.pm * 256 * UGP + kq * 256) * 2; u.offB = ((long)gg * 256 * 512 + kq * 256) * 2;
        } else if constexpr (kind == OK_S5Y) {
            const int pn = l & 1, pmm = (l >> 1) & 3, gg = l >> 3;
            u.pm = gg * 4 + pmm; u.pn = pn;
            u.offA = (long)u.pm * 256 * UGP * 2; u.offB = ((long)gg * 512 + pn * 256) * UGP * 2;
        } else if constexpr (kind == OK_XS) {
            const int h = l & 3, pm = l >> 2, b = pm >> 3;
            u.pm = pm; u.pn = h;
            u.offA = ((long)pm * 256 * DM + h * 256) * 2; u.offB = ((long)b * 256 * DM + h * 256) * 2;
        } else {
            const int h = l & 3, pm = l >> 2, b = pm >> 3;
            u.pm = pm; u.pn = h;
            u.offA = ((long)pm * 256 * DM + h * 256) * 2; u.offB = ((long)h * 256 * TM + b * 256) * 2;
        }
        return true;
    }
};

enum EpiKind { EK_PROJ = 0, EK_MEMK, EK_MEMVT, EK_S5E, EK_S5Y, EK_GLU, EK_WOUT, EK_XQ, EK_XS, EK_XO, EK_WXO, EK_UP, EK_DOWN, EK_GATE, EK_UPACT, EK_UPC };
    __device__ __forceinline__ u32x4 pack8(const f32x4 a, const f32x4 b) { u32x4 w; w.x = pk2(a[0], a[1]); w.y = pk2(a[2], a[3]); w.z = pk2(b[0], b[1]); w.w = pk2(b[2], b[3]); return w; }
    __device__ __forceinline__ float gelu_t(float y) { const float z = 0.7978845608028654f * (y + 0.044715f * y * y * y); const float e = __expf(2.f * z); const float th = 1.f - 2.f / (e + 1.f); return 0.5f * y * (1.f + th); }
    __device__ __forceinline__ float sigm(float z) { return 1.f / (1.f + __expf(-z)); }
    __device__ __forceinline__ float ssq8(const f32x4 a, const f32x4 b) { return (a[0] * a[0] + a[1] * a[1]) + (a[2] * a[2] + a[3] * a[3]) + (b[0] * b[0] + b[1] * b[1]) + (b[2] * b[2] + b[3] * b[3]); }

template <int kind> struct Epi {
    void* p0; void* p1; void* p2; void* p3; const void* c0; const void* c1; const void* c2; LAS float* hx;
    __device__ __forceinline__ void operator()(const f32x4 (&acc)[2][2][4][2], const Unit& u, int wr, int wc, int fr, int fq) const {
        const int rbase = u.pm * 256 + wr * 64 + fr;
        const int cl0 = wc * 32 + 8 * fq;
        switch (kind) {
        case EK_PROJ: {
            const int pn = u.pn;
            if (pn < 4) {
                const bool isq = pn < 2; bf16_t* dst = (bf16_t*)(isq ? p0 : p1); const float* gptr = (const float*)(isq ? c0 : c1); const float post = isq ? C2Q : 1.f;
                const int head = 4 * (pn & 1) + wc;
#pragma unroll
                for (int ai = 0; ai < 2; ++ai)
#pragma unroll
                    for (int m = 0; m < 4; ++m) {
                        float ss = ssq8(acc[ai][0][m][0], acc[ai][0][m][1]) + ssq8(acc[ai][1][m][0], acc[ai][1][m][1]);
                        ss = red_fq(ss);
                        const float sc = rsqrtf(ss * (1.f / 64.f) + EPS) * post;
                        const size_t row = (size_t)(rbase + ai * 128 + m * 16);
#pragma unroll
                        for (int bj = 0; bj < 2; ++bj)
                            *(u32x4*)(dst + row * 512 + head * 64 + 32 * bj + 8 * fq) = pack8(acc[ai][bj][m][0] * sc * *(const f32x4*)(gptr + 32 * bj + 8 * fq), acc[ai][bj][m][1] * sc * *(const f32x4*)(gptr + 32 * bj + 8 * fq + 4));
                    }
            } else if (pn < 6) {
                bf16_t* dst = (bf16_t*)p2;
#pragma unroll
                for (int ai = 0; ai < 2; ++ai)
#pragma unroll
                    for (int m = 0; m < 4; ++m) { const size_t row = (size_t)(rbase + ai * 128 + m * 16);
#pragma unroll
                        for (int bj = 0; bj < 2; ++bj) *(u32x4*)(dst + row * 512 + (pn - 4) * 256 + bj * 128 + cl0) = pack8(acc[ai][bj][m][0], acc[ai][bj][m][1]); }
            } else {
                bf16_t* dst = (bf16_t*)p3;
#pragma unroll
                for (int ai = 0; ai < 2; ++ai)
#pragma unroll
                    for (int m = 0; m < 4; ++m) { const int row = rbase + ai * 128 + m * 16; const int b = row >> 11, t = row & 2047, ch = t >> 5, s = t & 31;
#pragma unroll
                        for (int bj = 0; bj < 2; ++bj) { const int f = (pn - 6) * 256 + bj * 128 + cl0; const int gI = f >> 4, cc = f & 15;
                            *(u32x4*)(dst + ((size_t)(gI * 1024 + b * 64 + ch)) * UGP + s * 16 + cc) = pack8(acc[ai][bj][m][0], acc[ai][bj][m][1]); } }
            }
        } break;
        case EK_MEMK: {
            bf16_t* dst = (bf16_t*)p0; float* sq = (float*)p1;
#pragma unroll
            for (int ai = 0; ai < 2; ++ai)
#pragma unroll
                for (int m = 0; m < 4; ++m) { const size_t row = (size_t)(rbase + ai * 128 + m * 16);
                    float ss = ssq8(acc[ai][0][m][0], acc[ai][0][m][1]) + ssq8(acc[ai][1][m][0], acc[ai][1][m][1]);
                    ss = red_fq(ss);
                    if (fq == 0) sq[row * 16 + u.pn * 4 + wc] = ss;
#pragma unroll
                    for (int bj = 0; bj < 2; ++bj) *(u32x4*)(dst + row * DM + u.pn * 256 + bj * 128 + cl0) = pack8(acc[ai][bj][m][0], acc[ai][bj][m][1]); }
        } break;
        case EK_MEMVT: {
            bf16_t* dst = (bf16_t*)p0;
#pragma unroll
            for (int ai = 0; ai < 2; ++ai)
#pragma unroll
                for (int m = 0; m < 4; ++m) { const size_t row = (size_t)(rbase + ai * 128 + m * 16);
#pragma unroll
                    for (int bj = 0; bj < 2; ++bj) *(u32x4*)(dst + row * TM + u.pn * 256 + bj * 128 + cl0) = pack8(acc[ai][bj][m][0], acc[ai][bj][m][1]); }
        } break;
        case EK_S5E: {
            float* dst = (float*)p0 + (size_t)u.pn * 32768 * 128;
#pragma unroll
            for (int ai = 0; ai < 2; ++ai)
#pragma unroll
                for (int m = 0; m < 4; ++m) { const size_t row = (size_t)(rbase + ai * 128 + m * 16);
                    *(f32x4*)(dst + row * 128 + cl0) = acc[ai][0][m][0]; *(f32x4*)(dst + row * 128 + cl0 + 4) = acc[ai][0][m][1]; }
        } break;
        case EK_S5Y: {
            bf16_t* dst = (bf16_t*)p0;
#pragma unroll
            for (int ai = 0; ai < 2; ++ai)
#pragma unroll
                for (int m = 0; m < 4; ++m) { const int r = rbase + ai * 128 + m * 16; const int gI = r >> 10, b = (r >> 6) & 15, k = r & 63;
#pragma unroll
                    for (int bj = 0; bj < 2; ++bj) { const int nn = u.pn * 256 + bj * 128 + cl0; const int tt = nn >> 4, cc = nn & 15;
                        f32x4 a = acc[ai][bj][m][0], c = acc[ai][bj][m][1];
#pragma unroll
                        for (int j = 0; j < 4; ++j) { a[j] = gelu_t(a[j]); c[j] = gelu_t(c[j]); }
                        *(u32x4*)(dst + ((size_t)(b * SEQ + k * TC + tt)) * 512 + gI * 16 + cc) = pack8(a, c); } }
        } break;
        case EK_GLU: {
            bf16_t* dst = (bf16_t*)p0; float* sq = (float*)p1; const bf16_t* y1 = (const bf16_t*)c0; const float* bg = (const float*)c1;
            f32x4 bv[2][2];
#pragma unroll
            for (int bj = 0; bj < 2; ++bj)
#pragma unroll
                for (int n = 0; n < 2; ++n) bv[bj][n] = *(const f32x4*)(bg + u.pn * 256 + bj * 128 + cl0 + 4 * n);
#pragma unroll
            for (int ai = 0; ai < 2; ++ai)
#pragma unroll
                for (int m = 0; m < 4; ++m) { const size_t row = (size_t)(rbase + ai * 128 + m * 16); float ss = 0.f;
#pragma unroll
                    for (int bj = 0; bj < 2; ++bj) { const size_t off = row * 512 + u.pn * 256 + bj * 128 + cl0;
                        const u32x4 yv = *(const u32x4*)(y1 + off);
                        f32x4 a = acc[ai][bj][m][0] + bv[bj][0], c = acc[ai][bj][m][1] + bv[bj][1];
                        a[0] = bflo(yv.x) * sigm(a[0]); a[1] = bfhi(yv.x) * sigm(a[1]); a[2] = bflo(yv.y) * sigm(a[2]); a[3] = bfhi(yv.y) * sigm(a[3]);
                        c[0] = bflo(yv.z) * sigm(c[0]); c[1] = bfhi(yv.z) * sigm(c[1]); c[2] = bflo(yv.w) * sigm(c[2]); c[3] = bfhi(yv.w) * sigm(c[3]);
                        ss += ssq8(a, c);
                        *(u32x4*)(dst + off) = pack8(a, c); }
                    ss = red_fq(ss);
                    if (fq == 0) sq[row * 8 + u.pn * 4 + wc] = ss; }
        } break;
        case EK_WOUT: case EK_WXO: {
            bf16_t* hb = (bf16_t*)p1; float* sq = (float*)p2;
#pragma unroll
            for (int ai = 0; ai < 2; ++ai)
#pragma unroll
                for (int m = 0; m < 4; ++m) { const size_t row = (size_t)(rbase + ai * 128 + m * 16); float ss = 0.f;
#pragma unroll
                    for (int bj = 0; bj < 2; ++bj) { const size_t off = row * DM + u.pn * 256 + bj * 128 + cl0;
                        f32x4 a, c;
                        if (kind == EK_WOUT) { const float* base = (const float*)c0; a = acc[ai][bj][m][0] + *(const f32x4*)(base + off); c = acc[ai][bj][m][1] + *(const f32x4*)(base + off + 4); }
                        else { const u32x4 bv = *(const u32x4*)((const bf16_t*)c0 + off);
                            a = acc[ai][bj][m][0] + (f32x4){bflo(bv.x), bfhi(bv.x), bflo(bv.y), bfhi(bv.y)}; c = acc[ai][bj][m][1] + (f32x4){bflo(bv.z), bfhi(bv.z), bflo(bv.w), bfhi(bv.w)}; }
                        ss += ssq8(a, c);
                        *(u32x4*)(hb + off) = pack8(a, c); }
                    ss = red_fq(ss);
                    if (fq == 0) sq[row * 16 + u.pn * 4 + wc] = ss; }
        } break;
        case EK_XQ: {
            bf16_t* dst = (bf16_t*)p0; float* sq = (float*)p1; const float* gq = (const float*)c0; const float* gk = (const float*)c1;
            f32x4 gg[2][2];
#pragma unroll
            for (int bj = 0; bj < 2; ++bj)
#pragma unroll
                for (int n = 0; n < 2; ++n) gg[bj][n] = *(const f32x4*)(gq + bj * 128 + cl0 + 4 * n) * *(const f32x4*)(gk + bj * 128 + cl0 + 4 * n);
#pragma unroll
            for (int ai = 0; ai < 2; ++ai)
#pragma unroll
                for (int m = 0; m < 4; ++m) { const size_t row = (size_t)(rbase + ai * 128 + m * 16);
                    float ss = ssq8(acc[ai][0][m][0], acc[ai][0][m][1]) + ssq8(acc[ai][1][m][0], acc[ai][1][m][1]);
                    ss = red_fq(ss);
                    if (fq == 0) sq[row * 16 + u.pn * 4 + wc] = ss;
#pragma unroll
                    for (int bj = 0; bj < 2; ++bj) *(u32x4*)(dst + row * DM + u.pn * 256 + bj * 128 + cl0) = pack8(acc[ai][bj][m][0] * gg[bj][0], acc[ai][bj][m][1] * gg[bj][1]); }
        } break;
        case EK_XS: {
            bf16_t* dst = (bf16_t*)p0; float* ps = (float*)p1; const float* s1 = (const float*)c0; const float* sqq = (const float*)c1; const float* sck = (const float*)c2;
            const int h = u.pn, b = u.pm >> 3;
            f32x4 kv[2][2];
#pragma unroll
            for (int bj = 0; bj < 2; ++bj)
#pragma unroll
                for (int n = 0; n < 2; ++n) kv[bj][n] = *(const f32x4*)(sck + (size_t)h * TM + b * 256 + bj * 128 + cl0 + 4 * n) * (LOG2E / 16.f);
#pragma unroll
            for (int ai = 0; ai < 2; ++ai)
#pragma unroll
                for (int m = 0; m < 4; ++m) { const size_t row = (size_t)(rbase + ai * 128 + m * 16);
                    const f32x4 t0 = *(const f32x4*)(s1 + row * 16), t1 = *(const f32x4*)(s1 + row * 16 + 4), t2 = *(const f32x4*)(s1 + row * 16 + 8), t3 = *(const f32x4*)(s1 + row * 16 + 12);
                    const float tot = ((t0[0] + t0[1]) + (t0[2] + t0[3])) + ((t1[0] + t1[1]) + (t1[2] + t1[3])) + ((t2[0] + t2[1]) + (t2[2] + t2[3])) + ((t3[0] + t3[1]) + (t3[2] + t3[3]));
                    const float rs1 = rsqrtf(tot * (1.f / DM) + EPS);
                    const f32x4 qq = *(const f32x4*)(sqq + row * 16 + h * 4);
                    const float sq = rs1 * rsqrtf(rs1 * rs1 * ((qq[0] + qq[1]) + (qq[2] + qq[3])) * (1.f / 256.f) + EPS);
                    float ss = 0.f;
#pragma unroll
                    for (int bj = 0; bj < 2; ++bj) { f32x4 a = acc[ai][bj][m][0] * kv[bj][0] * sq, c = acc[ai][bj][m][1] * kv[bj][1] * sq;
#pragma unroll
                        for (int j = 0; j < 4; ++j) { a[j] = __builtin_amdgcn_exp2f(a[j]); c[j] = __builtin_amdgcn_exp2f(c[j]); }
                        const u32x4 w = pack8(a, c);
                        ss += (bflo(w.x) + bfhi(w.x)) + (bflo(w.y) + bfhi(w.y)) + (bflo(w.z) + bfhi(w.z)) + (bflo(w.w) + bfhi(w.w));
                        *(u32x4*)(dst + row * DM + h * 256 + bj * 128 + cl0) = w; }
                    ss = red_fq(ss);
                    if (fq == 0) ps[row * 16 + h * 4 + wc] = ss; }
        } break;
        case EK_XO: {
            bf16_t* dst = (bf16_t*)p0; const float* ps = (const float*)c0; const int h = u.pn;
#pragma unroll
            for (int ai = 0; ai < 2; ++ai)
#pragma unroll
                for (int m = 0; m < 4; ++m) { const size_t row = (size_t)(rbase + ai * 128 + m * 16);
                    const f32x4 pp = *(const f32x4*)(ps + row * 16 + h * 4); const float inv = 1.f / ((pp[0] + pp[1]) + (pp[2] + pp[3]));
#pragma unroll
                    for (int bj = 0; bj < 2; ++bj) *(u32x4*)(dst + row * DM + h * 256 + bj * 128 + cl0) = pack8(acc[ai][bj][m][0] * inv, acc[ai][bj][m][1] * inv); }
        } break;
        case EK_DOWN: {
            float* out = (float*)p0; const bf16_t* h2 = (const bf16_t*)c0;
#pragma unroll
            for (int ai = 0; ai < 2; ++ai)
#pragma unroll
                for (int m = 0; m < 4; ++m) { const size_t row = (size_t)(rbase + ai * 128 + m * 16);
#pragma unroll
                    for (int bj = 0; bj < 2; ++bj) { const size_t off = row * DM + u.pn * 256 + bj * 128 + cl0;
                        const u32x4 bv = *(const u32x4*)(h2 + off);
                        const f32x4 a = acc[ai][bj][m][0] + (f32x4){bflo(bv.x), bfhi(bv.x), bflo(bv.y), bfhi(bv.y)}, c = acc[ai][bj][m][1] + (f32x4){bflo(bv.z), bfhi(bv.z), bflo(bv.w), bfhi(bv.w)};
                        *(f32x4*)(out + off) = a; *(f32x4*)(out + off + 4) = c; } }
        } break;
        case EK_UPC: {
            bf16_t* A = (bf16_t*)p0; float* GHF = (float*)p1; float* GHL = (float*)p2; float* UH = (float*)p3; const float* s2 = (const float*)c0; const float* cw = (const float*)c1; const float* cbv = (const float*)c2;
            const int j0 = u.pn * 128 + cl0;
            float w0[8], w1[8], w2[8], bb[8];
#pragma unroll
            for (int i = 0; i < 2; ++i) { const f32x4 a0 = *(const f32x4*)(cw + j0 + 4 * i), a1 = *(const f32x4*)(cw + DFF + j0 + 4 * i), a2 = *(const f32x4*)(cw + 2 * DFF + j0 + 4 * i), a3 = *(const f32x4*)(cbv + j0 + 4 * i);
#pragma unroll
                for (int q = 0; q < 4; ++q) { w0[4 * i + q] = a0[q]; w1[4 * i + q] = a1[q]; w2[4 * i + q] = a2[q]; bb[4 * i + q] = a3[q]; } }
            float rsv[2][4];
#pragma unroll
            for (int ai = 0; ai < 2; ++ai)
#pragma unroll
                for (int m = 0; m < 4; ++m) rsv[ai][m] = s2[rbase + ai * 128 + m * 16];
            if (fr >= 14) {
#pragma unroll
                for (int ai = 0; ai < 2; ++ai) { const f32x4 g0 = acc[ai][0][3][0] * rsv[ai][3], g1 = acc[ai][0][3][1] * rsv[ai][3];
                    LAS float* hp = hx + ((ai * 2 + wr) * 2 + (fr - 14)) * 128 + cl0; *(LAS f32x4*)hp = g0; *(LAS f32x4*)(hp + 4) = g1;
                    if (ai == 1 && wr == 1) { float* gp = GHL + ((size_t)u.pm * 2 + (fr - 14)) * DFF + j0; *(f32x4*)gp = g0; *(f32x4*)(gp + 4) = g1; } } }
            if (wr == 0 && fr < 2) {
                const float rs = rsv[0][0]; float* gp = GHF + ((size_t)u.pm * 2 + fr) * DFF + j0; float* up = UH + ((size_t)u.pm * 2 + fr) * DFF + j0;
                *(f32x4*)gp = acc[0][0][0][0] * rs; *(f32x4*)(gp + 4) = acc[0][0][0][1] * rs; *(f32x4*)up = acc[0][1][0][0] * rs; *(f32x4*)(up + 4) = acc[0][1][0][1] * rs; }
            asm volatile("s_waitcnt lgkmcnt(0)" ::: "memory"); __builtin_amdgcn_s_barrier(); asm volatile("" ::: "memory");
#define ROR1(x) __builtin_bit_cast(float, __builtin_amdgcn_update_dpp(0, __builtin_bit_cast(int, (x)), 0x121, 0xF, 0xF, false))
#define ROR2(x) __builtin_bit_cast(float, __builtin_amdgcn_update_dpp(0, __builtin_bit_cast(int, (x)), 0x122, 0xF, 0xF, false))
#pragma unroll
            for (int ai = 0; ai < 2; ++ai) {
                const int grp = ai * 2 + wr;
                float p1v[8], p2v[8];
                { f32x4 h1a = (f32x4){0.f, 0.f, 0.f, 0.f}, h1b = h1a, h2a = h1a, h2b = h1a;
                  if (grp > 0) { const LAS float* hp = hx + ((grp - 1) * 2) * 128 + cl0; h2a = *(const LAS f32x4*)hp; h2b = *(const LAS f32x4*)(hp + 4); h1a = *(const LAS f32x4*)(hp + 128); h1b = *(const LAS f32x4*)(hp + 132); }
#pragma unroll
                  for (int i = 0; i < 4; ++i) { p1v[i] = h1a[i]; p1v[4 + i] = h1b[i]; p2v[i] = (fr == 0) ? h2a[i] : h1a[i]; p2v[4 + i] = (fr == 0) ? h2b[i] : h1b[i]; } }
#pragma unroll
                for (int m = 0; m < 4; ++m) { const float rs = rsv[ai][m]; const size_t row = (size_t)(rbase + ai * 128 + m * 16);
                    float gs[8], r[8];
#pragma unroll
                    for (int i = 0; i < 4; ++i) { gs[i] = acc[ai][0][m][0][i] * rs; gs[4 + i] = acc[ai][0][m][1][i] * rs; }
#pragma unroll
                    for (int i = 0; i < 8; ++i) { const float c1v = ROR1(gs[i]), c2v = ROR2(gs[i]);
                        const float g1 = (fr == 0) ? p1v[i] : c1v, g2 = (fr < 2) ? p2v[i] : c2v;
                        p1v[i] = c1v; p2v[i] = c2v;
                        const float z = bb[i] + w0[i] * g2 + w1[i] * g1 + w2[i] * gs[i];
                        const float uv = (i < 4 ? acc[ai][1][m][0][i & 3] : acc[ai][1][m][1][i & 3]) * rs;
                        r[i] = z * sigm(z) * uv; }
                    u32x4 o; o.x = pk2(r[0], r[1]); o.y = pk2(r[2], r[3]); o.z = pk2(r[4], r[5]); o.w = pk2(r[6], r[7]);
                    if (!(grp == 0 && m == 0 && fr < 2)) *(u32x4*)(A + row * DFF + j0) = o; } }
#undef ROR1
#undef ROR2
        } break;
        default: break;
        }
    }
};

namespace attn_body {
using bf16=__hip_bfloat16;
using s16x4=__attribute__((ext_vector_type(4)))short;
using f32x16=__attribute__((ext_vector_type(16)))float;
constexpr int NHEAD=NFH,D=64,ADM=NHEAD*D;
constexpr int NW=8,QBLK=32,QB=QBLK*NW,KVBLK=64,NQB=SEQ/QB;
__device__ __forceinline__ int crow(int r,int hi){return (r&3)+8*(r>>2)+4*hi;}
#define SBAR() __builtin_amdgcn_sched_barrier(0)
__device__ __forceinline__ void cmask(f32x16&p0,f32x16&p1,int jb,int qrel,int hi){
  const float NEG=-INFINITY; int kb=64*jb+4*hi;
  #pragma unroll
  for(int r=0;r<16;++r){int kv=kb+(r&3)+8*(r>>2); if(kv>qrel)p0[r]=NEG; if(kv+32>qrel)p1[r]=NEG;}
}
constexpr int NSLOT=3, SLOTB=8192;
constexpr int LDS_K=0, LDS_V=NSLOT*SLOTB, LDS_WS=2*NSLOT*SLOTB, LDS_OST=LDS_WS+NW*64*4, LDS_BYTES=LDS_OST+NW*4096;
constexpr int LDS_BIAS=86016;
__device__ __forceinline__ void glds16(const void*gsrc,unsigned lds_dst){unsigned keep;
  asm volatile("s_mov_b32 %0, m0\n\ts_mov_b32 m0, %2\n\ts_nop 0\n\tglobal_load_lds_dwordx4 %1, off\n\ts_mov_b32 m0, %0":"=&s"(keep):"v"(gsrc),"s"(lds_dst):"memory");}
__device__ __forceinline__ float max3f(float a,float b,float c){float r;asm("v_max3_f32 %0, %1, %2, %3":"=v"(r):"v"(a),"v"(b),"v"(c));return r;}
__device__ __forceinline__ float max2f(float a,float b){float r;asm("v_max_f32_e32 %0, %1, %2":"=v"(r):"v"(a),"v"(b));return r;}
__device__ __forceinline__ float fadd_s(float a,float b){float r;asm("v_add_f32_e32 %0, %1, %2":"=v"(r):"v"(a),"v"(b));return r;}
__device__ __forceinline__ float fsub_s(float a,float b){float r;asm("v_sub_f32_e32 %0, %1, %2":"=v"(r):"v"(a),"v"(b));return r;}
typedef float f32x2_t __attribute__((ext_vector_type(2))); typedef __bf16 bf16x2_t __attribute__((ext_vector_type(2)));
__device__ __forceinline__ unsigned cvtpk_s(float lo,float hi){f32x2_t v={lo,hi};bf16x2_t b=__builtin_convertvector(v,bf16x2_t);return __builtin_bit_cast(unsigned,b);}
#define WAIT_BAR(N) asm volatile("s_waitcnt vmcnt(" #N ") lgkmcnt(0)\n\ts_barrier":::"memory")

__device__ __forceinline__ void qkt(f32x16&p0,f32x16&p1,const char*Kslot,const bf16x8*qr,const f32x16&negm,int r32,int hi){
  const char*kb=Kslot+hi*1024+r32*16;
  #pragma unroll
  for(int d0=0;d0<4;++d0){
    const bf16x8 b0=*reinterpret_cast<const bf16x8*>(kb+d0*2048);
    const bf16x8 b1=*reinterpret_cast<const bf16x8*>(kb+d0*2048+512);
    if(d0==0){p0=__builtin_amdgcn_mfma_f32_32x32x16_bf16(b0,qr[0],negm,0,0,0);p1=__builtin_amdgcn_mfma_f32_32x32x16_bf16(b1,qr[0],negm,0,0,0);}
    else{p0=__builtin_amdgcn_mfma_f32_32x32x16_bf16(b0,qr[d0],p0,0,0,0);p1=__builtin_amdgcn_mfma_f32_32x32x16_bf16(b1,qr[d0],p1,0,0,0);}}
}
typedef __attribute__((address_space(3))) const char* lds_cptr;
typedef short v4i16_t __attribute__((ext_vector_type(4)));
__device__ __forceinline__ void kload8(bf16x8*kf,lds_cptr kp){
  kf[0]=*(const __attribute__((address_space(3))) bf16x8*)(kp);      kf[1]=*(const __attribute__((address_space(3))) bf16x8*)(kp+512);
  kf[2]=*(const __attribute__((address_space(3))) bf16x8*)(kp+2048); kf[3]=*(const __attribute__((address_space(3))) bf16x8*)(kp+2560);
  kf[4]=*(const __attribute__((address_space(3))) bf16x8*)(kp+4096); kf[5]=*(const __attribute__((address_space(3))) bf16x8*)(kp+4608);
  kf[6]=*(const __attribute__((address_space(3))) bf16x8*)(kp+6144); kf[7]=*(const __attribute__((address_space(3))) bf16x8*)(kp+6656);
}
__device__ __forceinline__ void kload2(bf16x8*kf,lds_cptr kp,int j){ kf[2*j]=*(const __attribute__((address_space(3))) bf16x8*)(kp+j*2048); kf[2*j+1]=*(const __attribute__((address_space(3))) bf16x8*)(kp+j*2048+512); }
__device__ __forceinline__ s16x4 vtr(lds_cptr p){ return __builtin_bit_cast(s16x4,__builtin_amdgcn_ds_read_tr16_b64_v4i16((__attribute__((address_space(3))) v4i16_t*)p)); }
__device__ __forceinline__ float rowmax(const f32x16&p0,const f32x16&p1){
  float a=max3f(p0[0],p0[1],p1[0]),b=max3f(p0[2],p0[3],p1[1]);a=max3f(a,p1[2],p1[3]);
  #pragma unroll
  for(int r=4;r<16;r+=4){a=max3f(a,p0[r],p0[r+1]);b=max3f(b,p0[r+2],p0[r+3]);a=max3f(a,p1[r],p1[r+1]);b=max3f(b,p1[r+2],p1[r+3]);}
  const float m=max2f(a,b);
  auto rr=__builtin_amdgcn_permlane32_swap(__float_as_uint(m),__float_as_uint(m),false,false);
  return max2f(__uint_as_float(rr[0]),__uint_as_float(rr[1]));
}
__device__ __forceinline__ void pv(f32x16*o,int vb,bf16x8 pa0,bf16x8 pa1,bf16x8 pa2,bf16x8 pa3){
  #pragma unroll
  for(int d0=0;d0<2;++d0){s16x4 lo[4],hi[4];
    #pragma unroll
    for(int ks=0;ks<4;++ks){
      asm volatile("ds_read_b64_tr_b16 %0,%1 offset:%c2":"=&v"(lo[ks]):"v"(vb),"i"(d0*4096+ks*1024):"memory");
      asm volatile("ds_read_b64_tr_b16 %0,%1 offset:%c2":"=&v"(hi[ks]):"v"(vb),"i"(d0*4096+ks*1024+512):"memory");}
    asm volatile("s_waitcnt lgkmcnt(0)":::"memory");SBAR();
    #define PK(k) (bf16x8){lo[k][0],lo[k][1],lo[k][2],lo[k][3],hi[k][0],hi[k][1],hi[k][2],hi[k][3]}
    o[d0]=__builtin_amdgcn_mfma_f32_32x32x16_bf16(pa0,PK(0),o[d0],0,0,0);
    o[d0]=__builtin_amdgcn_mfma_f32_32x32x16_bf16(pa1,PK(1),o[d0],0,0,0);
    o[d0]=__builtin_amdgcn_mfma_f32_32x32x16_bf16(pa2,PK(2),o[d0],0,0,0);
    o[d0]=__builtin_amdgcn_mfma_f32_32x32x16_bf16(pa3,PK(3),o[d0],0,0,0);
    #undef PK
  }
}
typedef const __attribute__((address_space(3))) f32x4* lds_f4ptr;
#define BIASADD(P0,P1,t) do{ const lds_f4ptr bp_=(lds_f4ptr)(shm3+bias_off+((t)*64+4*hi)*4); \
    _Pragma("unroll") for(int j_=0;j_<4;++j_){ const f32x4 b0_=bp_[2*j_]-mhat, b1_=bp_[8+2*j_]-mhat; \
      P0[4*j_]+=b0_[0]; P0[4*j_+1]+=b0_[1]; P0[4*j_+2]+=b0_[2]; P0[4*j_+3]+=b0_[3]; \
      P1[4*j_]+=b1_[0]; P1[4*j_+1]+=b1_[1]; P1[4*j_+2]+=b1_[2]; P1[4*j_+3]+=b1_[3]; } }while(0)

#define CINIT(P0,P1,t) do{ const lds_f4ptr bp_=(lds_f4ptr)(shm3+bias_off+((t)*64+4*hi)*4); \
    _Pragma("unroll") for(int j_=0;j_<4;++j_){ const f32x4 b0_=bp_[2*j_]-mhat, b1_=bp_[8+2*j_]-mhat; \
      P0[4*j_]=b0_[0]; P0[4*j_+1]=b0_[1]; P0[4*j_+2]=b0_[2]; P0[4*j_+3]=b0_[3]; \
      P1[4*j_]=b1_[0]; P1[4*j_+1]=b1_[1]; P1[4*j_+2]=b1_[2]; P1[4*j_+3]=b1_[3]; } }while(0)
template<int THRL> __device__ __forceinline__ void attn_unit(int b,int h,int qb,const bf16*Q,const bf16*__restrict__ K,const bf16*__restrict__ V,bf16*O,const float*__restrict__ CB,float*__restrict__ SSQ,char*shm,const float skip_th){
  int tid=threadIdx.x; asm volatile("":"+v"(tid));
  const int lane=tid&63,r32=lane&31,hi=lane>>5; const int wid=__builtin_amdgcn_readfirstlane(tid>>6);
  const long rowbase=(long)b*SEQ; const int q0=qb*QB;
  const bf16*Qw=Q+(rowbase+q0+wid*QBLK)*ADM+h*D;
  int t0=0; { const float*cbh0=CB+(long)(b*NHEAD+h)*SEQ; const int npair=(q0+QB)/KVBLK/2-2; const float c0v=cbh0[q0];
    const bool far=(lane<npair)&&(cbh0[128*(lane<npair?lane:0)+127]-c0v>skip_th); const unsigned long long mk=__ballot(far);
    int lead=__builtin_ctzll(~mk); if(lead>npair)lead=npair; if(lead<0)lead=0; t0=2*__builtin_amdgcn_readfirstlane(lead); }
  const bf16*Kh=K+(rowbase+(long)t0*KVBLK)*ADM+h*D,*Vh=V+(rowbase+(long)t0*KVBLK)*ADM+h*D;
  const unsigned lds0=(unsigned)(uintptr_t)shm;
  float*wsf=(float*)(shm+LDS_WS)+wid*64;
  const lds_cptr shm3=(lds_cptr)shm;
  { const float*cbh=CB+(long)(b*NHEAD+h)*SEQ; const float cref=cbh[q0+128];
    if(tid*4<q0+QB){ const f32x4 c4=*(const f32x4*)(cbh+tid*4); *(__attribute__((address_space(3))) f32x4*)(shm3+LDS_BIAS+tid*16)=(f32x4){cref-c4[0],cref-c4[1],cref-c4[2],cref-c4[3]}; } }
  const bf16*ksrc=Kh+(long)lane*ADM+wid*8;
  const bf16*vsrc=Vh+(long)(16*(wid&3)+(lane>>2))*ADM+(wid>>2)*32+(lane&3)*8;
  const unsigned kdst=lds0+LDS_K+wid*1024, vdst=lds0+LDS_V+wid*1024;
  #define DMA_K(t,slot) glds16(ksrc+(long)(t)*KVBLK*ADM,(unsigned)__builtin_amdgcn_readfirstlane(kdst+(slot)))
  #define DMA_V(t,slot) glds16(vsrc+(long)(t)*KVBLK*ADM,(unsigned)__builtin_amdgcn_readfirstlane(vdst+(slot)))
  const int vb0=(int)(lds0+LDS_V)+((lane>>4)&1)*32+(lane&3)*8+(4*hi+((lane&15)>>2))*64;
  const char*Kbase=shm+LDS_K; bf16x8 kf[8];
  const lds_cptr kp0=shm3+LDS_K+hi*1024+r32*16; const lds_cptr vp0=shm3+LDS_V+((lane>>4)&1)*32+(lane&3)*8+(4*hi+((lane&15)>>2))*64;
  const int NT=(q0+QB)/KVBLK-t0; const int bias_off=LDS_BIAS+t0*KVBLK*4;
  DMA_K(0,0);DMA_V(0,0);DMA_K(1,SLOTB);
  bf16x8 qr[4];
  #pragma unroll
  for(int d0=0;d0<4;++d0)qr[d0]=*reinterpret_cast<const bf16x8*>(&Qw[(long)r32*ADM+d0*16+hi*8]);
  float mhat=0.f,l_reg=0.f;f32x16 o[2];o[0]=f32x16{};o[1]=f32x16{};const f32x16 negm=f32x16{};
  const int qrel=wid*QBLK+r32;
  #define CMASK(P0,P1,t) do{int jb_=(t)-(NT-4); if(jb_>=0)cmask(P0,P1,jb_,qrel,hi);}while(0)
  bool resc=false;
  #define START(P0,P1) do{ const float rm=rowmax(P0,P1); resc=false; \
    { const float dl=max2f(rm,-24.f); mhat=fadd_s(mhat,dl); \
      _Pragma("unroll") for(int r=0;r<16;++r){P0[r]=fsub_s(P0[r],dl);P1[r]=fsub_s(P1[r],dl);} } \
    _Pragma("unroll") for(int r=0;r<16;++r)P0[r]=__builtin_amdgcn_exp2f(P0[r]); }while(0)
  #define RESC() do{ if(resc){ asm volatile("s_waitcnt lgkmcnt(0)":::"memory"); \
      _Pragma("unroll") for(int d_=0;d_<2;++d_) _Pragma("unroll") for(int r=0;r<16;++r)o[d_][r]*=wsf[crow(r,hi)]; } }while(0)
  f32x16 pA0,pA1,pB0,pB1;
  int sl_prev=0,sl_cur=0,sl_next=SLOTB;
  #define ROT() do{sl_prev=sl_cur;sl_cur=sl_next;sl_next=(sl_next==(NSLOT-1)*SLOTB)?0:sl_next+SLOTB;}while(0)
  DMA_K(2,2*SLOTB);
  WAIT_BAR(3);
  qkt(pA0,pA1,Kbase,qr,negm,r32,hi);asm volatile("s_nop 15\n\ts_nop 7":"+v"(pA0),"+v"(pA1));BIASADD(pA0,pA1,0);CMASK(pA0,pA1,0);
  START(pA0,pA1);
  _Pragma("unroll") for(int r=0;r<16;++r)pA1[r]=__builtin_amdgcn_exp2f(pA1[r]);
  WAIT_BAR(0);
  DMA_K(3,0);DMA_V(1,SLOTB);
  ROT();
  kload8(kf,kp0+sl_cur);
  WAIT_BAR(2);
  s16x4 vlo[8],vhi[8]; u32x4 pw0,pw1,pw2,pw3;
  #define PKW(P,B) cvtpk_s(P[B],P[B+1])
  #define PAF(k) __builtin_bit_cast(bf16x8,pw##k)
  #define VFR(i) (bf16x8){vlo[i][0],vlo[i][1],vlo[i][2],vlo[i][3],vhi[i][0],vhi[i][1],vhi[i][2],vhi[i][3]}
  #define PIN(x) asm volatile("":"+v"(x))
  #define MX3(a,b,c) __builtin_fmaxf(__builtin_fmaxf((a),(b)),(c))
  #define GAPA(MF,A0,A1,A2,A3,W0,W1,PW) do{ MF; sacc+=A0; sacc+=A1; sacc+=A2; sacc+=A3; PIN(sacc); W0; W1; PIN(PW); SBAR(); }while(0)
  #define EX(v) __builtin_amdgcn_exp2f(v)
  #define GAPB(MF,X,B) do{ MF; X[B]=EX(X[B]); X[B+1]=EX(X[B+1]); X[B+2]=EX(X[B+2]); X[B+3]=EX(X[B+3]); PIN(X); SBAR(); }while(0)
  #define VRD(i) do{ vlo[i]=vtr(vp_+(((i)>>2)*4096+((i)&3)*1024)); vhi[i]=vtr(vp_+(((i)>>2)*4096+((i)&3)*1024+512)); }while(0)
  #define KRD(G,j) do{ if(G){ kload2(kf,kp0+sl_next,j); SBAR(); } }while(0)
  #define STEP(C0,C1,P0,P1,t,GK,GV,GL) do{ SBAR(); CINIT(C0,C1,t); SBAR(); \
    const lds_cptr vp_=vp0+sl_prev; \
    VRD(0); SBAR(); float sacc=(P0[0]+P0[1]); \
    GAPA(C0=__builtin_amdgcn_mfma_f32_32x32x16_bf16(kf[0],qr[0],C0,0,0,0), P0[2],P0[3],P0[4],P0[5],     pw0[0]=PKW(P0,0), pw0[1]=PKW(P0,2), pw0); \
    VRD(4); SBAR(); GAPA(C1=__builtin_amdgcn_mfma_f32_32x32x16_bf16(kf[1],qr[0],C1,0,0,0), P0[6],P0[7],P0[8],P0[9],     pw0[2]=PKW(P0,4), pw0[3]=PKW(P0,6), pw0); \
    VRD(1); SBAR(); GAPA(C0=__builtin_amdgcn_mfma_f32_32x32x16_bf16(kf[2],qr[1],C0,0,0,0),   P0[10],P0[11],P0[12],P0[13], pw1[0]=PKW(P0,8), pw1[1]=PKW(P0,10), pw1); \
    VRD(5); SBAR(); GAPA(C1=__builtin_amdgcn_mfma_f32_32x32x16_bf16(kf[3],qr[1],C1,0,0,0),   P0[14],P0[15],P1[0],P1[1],   pw1[2]=PKW(P0,12),pw1[3]=PKW(P0,14), pw1); \
    VRD(2); SBAR(); GAPA(C0=__builtin_amdgcn_mfma_f32_32x32x16_bf16(kf[4],qr[2],C0,0,0,0),   P1[2],P1[3],P1[4],P1[5],     pw2[0]=PKW(P1,0), pw2[1]=PKW(P1,2), pw2); \
    VRD(6); SBAR(); GAPA(C1=__builtin_amdgcn_mfma_f32_32x32x16_bf16(kf[5],qr[2],C1,0,0,0),   P1[6],P1[7],P1[8],P1[9],     pw2[2]=PKW(P1,4), pw2[3]=PKW(P1,6), pw2); \
    VRD(3); SBAR(); GAPA(C0=__builtin_amdgcn_mfma_f32_32x32x16_bf16(kf[6],qr[3],C0,0,0,0),   P1[10],P1[11],P1[12],P1[13], pw3[0]=PKW(P1,8), pw3[1]=PKW(P1,10), pw3); \
    VRD(7); SBAR(); GAPA(C1=__builtin_amdgcn_mfma_f32_32x32x16_bf16(kf[7],qr[3],C1,0,0,0),   P1[14],P1[15],0.f,0.f,       pw3[2]=PKW(P1,12),pw3[3]=PKW(P1,14), pw3); \
    l_reg+=sacc; \
    if(GK){DMA_K((t)+3,sl_cur);} if(GV){DMA_V((t)+1,sl_next);} \
    CMASK(C0,C1,t); \
    { float a=MX3(C0[0],C0[1],C1[0]),b=MX3(C0[2],C0[3],C1[1]); a=MX3(a,C1[2],C1[3]); \
      _Pragma("unroll") for(int r=4;r<16;r+=4){a=MX3(a,C0[r],C0[r+1]);b=MX3(b,C0[r+2],C0[r+3]);a=MX3(a,C1[r],C1[r+1]);b=MX3(b,C1[r+2],C1[r+3]);} \
      float rm=__builtin_fmaxf(a,b); { auto rr=__builtin_amdgcn_permlane32_swap(__float_as_uint(rm),__float_as_uint(rm),false,false); rm=__builtin_fmaxf(__uint_as_float(rr[0]),__uint_as_float(rr[1])); } \
      resc=false; \
      if(__builtin_expect(__any(rm>(float)THRL),0)){ const float dl=__builtin_fmaxf(rm,0.f); mhat+=dl; \
        _Pragma("unroll") for(int r=0;r<16;++r){C0[r]-=dl;C1[r]-=dl;} \
        const float f=__builtin_amdgcn_exp2f(-dl); l_reg*=f; if(hi==0)wsf[r32]=f; resc=true; } } \
    SBAR(); \
    GAPB(o[0]=__builtin_amdgcn_mfma_f32_32x32x16_bf16(PAF(0),VFR(0),o[0],0,0,0), C0,0); \
    GAPB(o[1]=__builtin_amdgcn_mfma_f32_32x32x16_bf16(PAF(0),VFR(4),o[1],0,0,0), C0,4); \
    KRD(GL,0); GAPB(o[0]=__builtin_amdgcn_mfma_f32_32x32x16_bf16(PAF(1),VFR(1),o[0],0,0,0), C0,8); \
    KRD(GL,1); GAPB(o[1]=__builtin_amdgcn_mfma_f32_32x32x16_bf16(PAF(1),VFR(5),o[1],0,0,0), C0,12); \
    KRD(GL,2); GAPB(o[0]=__builtin_amdgcn_mfma_f32_32x32x16_bf16(PAF(2),VFR(2),o[0],0,0,0), C1,0); \
    KRD(GL,3); GAPB(o[1]=__builtin_amdgcn_mfma_f32_32x32x16_bf16(PAF(2),VFR(6),o[1],0,0,0), C1,4); \
    GAPB(o[0]=__builtin_amdgcn_mfma_f32_32x32x16_bf16(PAF(3),VFR(3),o[0],0,0,0), C1,8); \
    GAPB(o[1]=__builtin_amdgcn_mfma_f32_32x32x16_bf16(PAF(3),VFR(7),o[1],0,0,0), C1,12); \
    }while(0)
  int t=1;
  #undef CMASK
  #define CMASK(P0,P1,t) do{}while(0)
  for(;t+5<NT;t+=2){
    STEP(pB0,pB1,pA0,pA1,t,true,true,true);     WAIT_BAR(2); RESC(); ROT();
    STEP(pA0,pA1,pB0,pB1,t+1,true,true,true);   WAIT_BAR(2); RESC(); ROT();
  }
  #undef CMASK
  #define CMASK(P0,P1,t) do{int jb_=(t)-(NT-4); if(jb_>=0)cmask(P0,P1,jb_,qrel,hi);}while(0)
  #define ENDW(tt) do{ if((tt)+3<NT){WAIT_BAR(2);} else if((tt)+2<NT){WAIT_BAR(1);} else {WAIT_BAR(0);} }while(0)
  for(;t+1<NT;t+=2){
    STEP(pB0,pB1,pA0,pA1,t,(t+3<NT),(t+1<NT),(t+1<NT));       ENDW(t);   RESC(); ROT();
    STEP(pA0,pA1,pB0,pB1,t+1,(t+4<NT),(t+2<NT),(t+2<NT));     ENDW(t+1); RESC(); ROT();
  }
  STEP(pB0,pB1,pA0,pA1,NT-1,false,false,false); RESC();
  { float sacc=pB0[0]+pB0[1]; _Pragma("unroll") for(int r=2;r<16;++r)sacc+=pB0[r]; _Pragma("unroll") for(int r=0;r<16;++r)sacc+=pB1[r]; l_reg+=sacc;
    pw0=(u32x4){PKW(pB0,0),PKW(pB0,2),PKW(pB0,4),PKW(pB0,6)};pw1=(u32x4){PKW(pB0,8),PKW(pB0,10),PKW(pB0,12),PKW(pB0,14)};pw2=(u32x4){PKW(pB1,0),PKW(pB1,2),PKW(pB1,4),PKW(pB1,6)};pw3=(u32x4){PKW(pB1,8),PKW(pB1,10),PKW(pB1,12),PKW(pB1,14)};
    SBAR(); pv(o,vb0+sl_cur,PAF(0),PAF(1),PAF(2),PAF(3)); }
  #undef PKW
  #undef PAF
  #undef VFR
  #undef PIN
  #undef MX3
  #undef GAPA
  #undef GAPB
  #undef EX
  #undef VRD
  #undef KRD
  #undef STEP
  #undef ENDW
  {auto rr=__builtin_amdgcn_permlane32_swap(__float_as_uint(l_reg),__float_as_uint(l_reg),false,false);l_reg=__uint_as_float(rr[0])+__uint_as_float(rr[1]);}
  if(hi==0)wsf[32+r32]=l_reg;asm volatile("s_waitcnt lgkmcnt(0)":::"memory");
  float rli[16];
  #pragma unroll
  for(int r=0;r<16;++r)rli[r]=__builtin_amdgcn_rcpf(wsf[32+crow(r,hi)]);
  int lane2=lane; asm volatile("":"+v"(lane2));
  bf16*Ow=O+(rowbase+q0+wid*QBLK)*ADM+h*D;
  { bf16*stg=(bf16*)(shm+LDS_OST)+wid*2048;
    #pragma unroll
    for(int r=0;r<16;++r){const int orow=crow(r,hi);
      #pragma unroll
      for(int d0=0;d0<2;++d0)stg[orow*64+d0*32+r32]=__float2bfloat16(o[d0][r]*rli[r]);}
    asm volatile("s_waitcnt lgkmcnt(0)":::"memory");
    #pragma unroll
    for(int i=0;i<4;++i){const int row=i*8+(lane2>>3),ch=lane2&7; const u32x4 v=*(const u32x4*)(stg+row*64+ch*8); *(u32x4*)(Ow+(long)row*ADM+ch*8)=v;
      float s=(bflo(v.x)*bflo(v.x)+bfhi(v.x)*bfhi(v.x))+(bflo(v.y)*bflo(v.y)+bfhi(v.y)*bfhi(v.y))+(bflo(v.z)*bflo(v.z)+bfhi(v.z)*bfhi(v.z))+(bflo(v.w)*bflo(v.w)+bfhi(v.w)*bfhi(v.w));
      s+=__shfl_xor(s,1); s+=__shfl_xor(s,2); s+=__shfl_xor(s,4);
      if(ch==0)SSQ[(rowbase+q0+wid*QBLK+row)*NHEAD+h]=s; } }
  asm volatile("s_waitcnt lgkmcnt(0)\n\ts_barrier":::"memory");
  #undef DMA_K
  #undef DMA_V
  #undef CMASK
  #undef START
  #undef RESC
  #undef ROT
}
#undef SBAR
#undef WAIT_BAR
}

constexpr int RING_BYTES = 131072;
constexpr int LDS_TOTAL = 147456;
struct Args { const float* in[32]; float* out; unsigned char* ws; };
typedef const float* const __attribute__((address_space(4)))* InTab;
enum In { I_X = 0, I_MEM, I_NORM_MIX, I_W_IN, I_FQN, I_FKN, I_FBIAS, I_ARE, I_AIM, I_LOGDT, I_BRE, I_BIM, I_CRE, I_CIM, I_D, I_WGLU, I_BGLU, I_ONF, I_ONS, I_WOUT,
          I_NCROSS, I_NMEM, I_WXQ, I_WXKV, I_XQN, I_XKN, I_WXO, I_NFFN, I_WUP, I_CONVW, I_CONVB, I_WDN };

struct TJob { const float* W; int ldw, col0, ncols, K; const float* kg; const float* kg2; bf16_t* WT; int mapid, rowoff, items; };
__device__ __forceinline__ int tmap(int mapid, int n, int rowoff) {
    if (mapid == 1) { const int part = n >> 9, f = n & 511, head = f >> 6, d = f & 63; return 512 * part + 256 * (head >> 2) + 128 * (d >> 5) + 32 * (head & 3) + (d & 31); }
    if (mapid == 2) { const int isup = n >= DFF ? 1 : 0; const int j = n - isup * DFF; return 256 * (j >> 7) + 128 * isup + (j & 127); }
    return rowoff + n;
}
__device__ __forceinline__ void transpose_item(const TJob& J, LAS float* scr, int item, int lane) {
    LAS unsigned* s32 = (LAS unsigned*)scr; const LAS unsigned short* s16 = (const LAS unsigned short*)scr;
    const int nblk = J.ncols / 128, kb = item / nblk, nb = item % nblk, k0 = 64 * kb, n0 = 128 * nb;
    const float* src = J.W + (size_t)k0 * J.ldw + J.col0 + n0 + 2 * lane;
    float gv = 1.f; if (J.kg) { const int k = k0 + lane; gv = (J.kg2 && k >= 512) ? J.kg2[k - 512] : J.kg[k]; }
#pragma unroll 16
    for (int kk = 0; kk < 64; ++kk) { f32x2 w = *(const f32x2*)(src + (size_t)kk * J.ldw);
        w = w * __builtin_bit_cast(float, __builtin_amdgcn_readlane(__builtin_bit_cast(int, gv), kk));
        s32[kk * 64 + lane] = pk2(w[0], w[1]); }
    asm volatile("s_waitcnt lgkmcnt(0)" ::: "memory");
    const int c = lane & 7;
#pragma unroll 4
    for (int j = 0; j < 16; ++j) { const int n = (lane >> 3) + 8 * j; const LAS unsigned short* s = s16 + (8 * c) * 128 + n;
        u32x4 o; o.x = (unsigned)s[0] | ((unsigned)s[128] << 16); o.y = (unsigned)s[256] | ((unsigned)s[384] << 16); o.z = (unsigned)s[512] | ((unsigned)s[640] << 16); o.w = (unsigned)s[768] | ((unsigned)s[896] << 16);
        *(u32x4*)(J.WT + (size_t)tmap(J.mapid, n0 + n, J.rowoff) * J.K + k0 + 8 * c) = o; }
    asm volatile("s_waitcnt lgkmcnt(0)" ::: "memory");
}
constexpr int NTJ = 11;
__device__ __forceinline__ void get_tjob(InTab in, unsigned char* ws, int j, TJob& J) {
    J.kg = nullptr; J.kg2 = nullptr; J.mapid = 0; J.rowoff = 0; J.col0 = 0;
    switch (j) {
    case 0: J.W = in[I_W_IN]; J.ldw = INCOLS; J.col0 = 0; J.ncols = 1024; J.K = 1024; J.WT = (bf16_t*)(ws + WS_WIN); J.mapid = 1; break;
    case 1: J.W = in[I_W_IN]; J.ldw = INCOLS; J.col0 = 1024; J.ncols = 512; J.K = 1024; J.WT = (bf16_t*)(ws + WS_WIN); J.rowoff = 1024; break;
    case 2: J.W = in[I_W_IN]; J.ldw = INCOLS; J.col0 = 1544; J.ncols = 512; J.K = 1024; J.WT = (bf16_t*)(ws + WS_WIN); J.rowoff = 1536; break;
    case 3: J.W = in[I_WGLU]; J.ldw = 512; J.ncols = 512; J.K = 512; J.WT = (bf16_t*)(ws + WS_WGLU); break;
    case 4: J.W = in[I_WOUT]; J.ldw = 1024; J.ncols = 1024; J.K = 1024; J.WT = (bf16_t*)(ws + WS_WOUT); J.kg = in[I_ONF]; J.kg2 = in[I_ONS]; break;
    case 5: J.W = in[I_WXQ]; J.ldw = 1024; J.ncols = 1024; J.K = 1024; J.WT = (bf16_t*)(ws + WS_WXQ); J.kg = in[I_NCROSS]; break;
    case 6: J.W = in[I_WXKV]; J.ldw = 2048; J.col0 = 0; J.ncols = 1024; J.K = 1024; J.WT = (bf16_t*)(ws + WS_WXK); break;
    case 7: J.W = in[I_WXKV]; J.ldw = 2048; J.col0 = 1024; J.ncols = 1024; J.K = 1024; J.WT = (bf16_t*)(ws + WS_WXV); break;
    case 8: J.W = in[I_WXO]; J.ldw = 1024; J.ncols = 1024; J.K = 1024; J.WT = (bf16_t*)(ws + WS_WXO); break;
    case 9: J.W = in[I_WUP]; J.ldw = 2 * DFF; J.ncols = 2 * DFF; J.K = 1024; J.WT = (bf16_t*)(ws + WS_WUP); J.kg = in[I_NFFN]; J.mapid = 2; break;
    default: J.W = in[I_WDN]; J.ldw = 1024; J.ncols = 1024; J.K = DFF; J.WT = (bf16_t*)(ws + WS_WDN); break;
    }
    J.items = (J.K / 64) * (J.ncols / 128);
}

__device__ __forceinline__ void rms_row(const float* xrow, const float* gain, bf16_t* orow, int lane, f32x4 (&v)[4]) {
    const f32x4* xr = (const f32x4*)xrow + lane; float s = 0.f;
#pragma unroll
    for (int j = 0; j < 4; ++j) { v[j] = xr[64 * j]; s += (v[j][0] * v[j][0] + v[j][1] * v[j][1]) + (v[j][2] * v[j][2] + v[j][3] * v[j][3]); }
    const float rs = rsqrtf(wave_sum(s) * (1.f / DM) + EPS);
    u32x2* o8 = (u32x2*)orow + lane;
#pragma unroll
    for (int j = 0; j < 4; ++j) { v[j] = v[j] * rs * ((const f32x4*)gain)[64 * j + lane]; u32x2 w; w.x = pk2(v[j][0], v[j][1]); w.y = pk2(v[j][2], v[j][3]); o8[64 * j] = w; }
}

__device__ __forceinline__ void cpow(float ar, float ai, float dt, float e, float& r, float& i) {
    const float mag = __expf(ar * dt * e);
    float rev = ai * dt * e * 0.15915494309189535f; rev -= rintf(rev);
    const float ang = rev * 6.283185307179586f;
    r = mag * cosf(ang); i = mag * sinf(ang);
}

template <int NT>
__device__ __forceinline__ void s5_prep_task(InTab in, unsigned char* ws, int g, int tt, LAS float* L, int tid, bool valid) {
    LAS float* pwA = L; LAS float* pwB = L + 128; LAS float* pwC = L + 256; LAS float* cf = L + 384; LAS float* bb = L + 512; LAS float* cc = L + 512 + 2048;
    if (valid) {
        const float dt = __expf(in[I_LOGDT][g]);
        if (tid < 64) { const int p = tid; const float ar = in[I_ARE][g * 64 + p], ai = in[I_AIM][g * 64 + p];
            float r, i; cpow(ar, ai, dt, (float)tt, r, i); pwA[2 * p] = r; pwA[2 * p + 1] = i;
            cpow(ar, ai, dt, (float)(tt + 1), r, i); pwB[2 * p] = r; pwB[2 * p + 1] = i;
            cpow(ar, ai, dt, (float)(TC - 1 - tt), r, i); pwC[2 * p] = r; pwC[2 * p + 1] = i;
            float lr, li; cpow(ar, ai, dt, 1.f, lr, li);
            const float den = ar * ar + ai * ai, nr = lr - 1.f;
            cf[2 * p] = (nr * ar + li * ai) / den; cf[2 * p + 1] = (li * ar - nr * ai) / den;
            if (tt == 0) { cpow(ar, ai, dt, (float)TC, r, i); float* lb = (float*)(ws + WS_LB32); lb[(g * 64 + p) * 2] = r; lb[(g * 64 + p) * 2 + 1] = i; } }
        for (int idx = tid; idx < 1024; idx += NT) { cc[2 * idx] = in[I_CRE][g * 1024 + idx]; cc[2 * idx + 1] = in[I_CIM][g * 1024 + idx]; }
    }
    __syncthreads();
    if (valid)
        for (int idx = tid; idx < 1024; idx += NT) { const int p = idx >> 4; const float br = in[I_BRE][g * 1024 + idx], bi = in[I_BIM][g * 1024 + idx], cr = cf[2 * p], ci = cf[2 * p + 1];
            bb[2 * idx] = cr * br - ci * bi; bb[2 * idx + 1] = cr * bi + ci * br; }
    __syncthreads();
    if (valid) {
        for (int e = tid; e < 256; e += NT) {
            const int c = e >> 4, cp = e & 15; float s = 0.f;
            for (int p = 0; p < 64; ++p) { const float pr = pwA[2 * p], pi = pwA[2 * p + 1], br = bb[2 * (p * 16 + cp)], bi = bb[2 * (p * 16 + cp) + 1];
                const float mr = pr * br - pi * bi, mi = pr * bi + pi * br; s += cc[2 * (c * 64 + p)] * mr - cc[2 * (c * 64 + p) + 1] * mi; }
            if (tt == 0 && c == cp) s += in[I_D][g * 16 + c];
            ((float*)(ws + WS_KTAB))[((g * TC + tt) * 16 + c) * 16 + cp] = s; }
        bf16_t* bty = (bf16_t*)(ws + WS_BTY) + (size_t)g * 512 * UGP; bf16_t* bte = (bf16_t*)(ws + WS_BTE) + (size_t)g * 256 * 512;
        for (int idx = tid; idx < 1024; idx += NT) { const int c = idx >> 6, p = idx & 63;
            const float cr = cc[2 * idx], ci = cc[2 * idx + 1], pr = pwB[2 * p], pi = pwB[2 * p + 1];
            const float zr = cr * pr - ci * pi, zi = cr * pi + ci * pr;
            *(unsigned*)(bty + (size_t)(tt * 16 + c) * UGP + 512 + 2 * p) = pk2(zr, -zi); }
        for (int idx = tid; idx < 1024; idx += NT) { const int p = idx >> 4, cp = idx & 15;
            const float pr = pwC[2 * p], pi = pwC[2 * p + 1], br = bb[2 * idx], bi = bb[2 * idx + 1];
            bte[(size_t)(2 * p) * 512 + tt * 16 + cp] = (bf16_t)f2bf(pr * br - pi * bi); bte[(size_t)(2 * p + 1) * 512 + tt * 16 + cp] = (bf16_t)f2bf(pr * bi + pi * br); }
        for (int u = tid; u < 256; u += NT) *(u32x4*)(bte + (size_t)(128 + (u >> 1)) * 512 + tt * 16 + (u & 1) * 8) = (u32x4){0u, 0u, 0u, 0u};
    }
    __syncthreads();
}

#define RLX_AGENT __ATOMIC_RELAXED, __HIP_MEMORY_SCOPE_AGENT
#define XB_TMO      128
#define XB_XCNT(j)  (256  + 64 * (j))
#define XB_XSUB(j)  (1280 + 64 * (j))
#define XB_XGEN(j)  (2304 + 64 * (j))
#define XB_TOP      3328
#define XB_TOPGEN   3392
#define XCD_BAR_WORDS 3456
#define XB_SPIN_CAP (1u << 18)

__device__ __forceinline__ unsigned xb_ld(unsigned* p)              { return __hip_atomic_load(p, __ATOMIC_RELAXED, __HIP_MEMORY_SCOPE_AGENT); }
__device__ __forceinline__ unsigned xb_add(unsigned* p, unsigned v) { return __hip_atomic_fetch_add(p, v, __ATOMIC_RELAXED, __HIP_MEMORY_SCOPE_AGENT); }
__device__ __forceinline__ unsigned xb_xcc_id() { return (unsigned)__builtin_amdgcn_s_getreg((3 << 11) | 20) & 0xFu; }
#define XB_SPIN(cond, bar) do { unsigned _sp = 0; while (cond) { __builtin_amdgcn_s_sleep(1); \
    if ((++_sp & 255u) == 0u) { if (xb_ld(&(bar)[XB_TMO])) break; if (_sp > XB_SPIN_CAP) { atomicAdd(&(bar)[XB_TMO], 1u); break; } } } } while (0)

struct XcdBarrier {
    unsigned* bar; unsigned x;
    volatile LAS unsigned* st;
};

__device__ __forceinline__ XcdBarrier xcd_barrier_post(unsigned* bar, volatile LAS unsigned* st) {
    XcdBarrier b; b.bar = bar; b.x = xb_xcc_id(); b.st = st;
    if (threadIdx.x == 0) (void)xb_add(&bar[XB_XCNT(b.x)], 1u);
    return b;
}
__device__ __forceinline__ void xcd_barrier_complete(unsigned* bar, unsigned x, unsigned& nloc, unsigned& nx) {
    const unsigned G = gridDim.x * gridDim.y * gridDim.z;
    unsigned sum, cnt, mine, sp = 0u;
    for (;;) {
        sum = 0u; cnt = 0u; mine = 0u;
#pragma unroll
        for (unsigned j = 0; j < 16; ++j) { const unsigned c = xb_ld(&bar[XB_XCNT(j)]); sum += c; cnt += (c > 0u) ? 1u : 0u; mine = (j == x) ? c : mine; }
        if (sum == G) break;
        __builtin_amdgcn_s_sleep(1);
        if ((++sp & 255u) == 0u) { if (xb_ld(&bar[XB_TMO])) break; if (sp > XB_SPIN_CAP) { atomicAdd(&bar[XB_TMO], 1u); break; } }
    }
    nloc = mine > 0u ? mine : 1u; nx = cnt > 0u ? cnt : 1u;
}

__device__ __forceinline__ void xcd_barrier(const XcdBarrier& b) {
    asm volatile("s_waitcnt vmcnt(0)" ::: "memory");
    __syncthreads();
    if (threadIdx.x == 0) {
        unsigned* bar = b.bar;
        __builtin_amdgcn_s_waitcnt(0);
        unsigned nloc = b.st[0], nx = b.st[1];
        if (nloc == 0u) { xcd_barrier_complete(bar, b.x, nloc, nx); b.st[0] = nloc; b.st[1] = nx; }
        const unsigned old = xb_add(&bar[XB_XSUB(b.x)], 1u);
        const unsigned gen = old / nloc;
        if (old + 1u == (gen + 1u) * nloc) {
            __builtin_amdgcn_fence(__ATOMIC_RELEASE, "agent");
            asm volatile("s_waitcnt vmcnt(0)" ::: "memory");
            const unsigned og = xb_add(&bar[XB_TOP], 1u);
            const unsigned tg = og / nx;
            if (og + 1u == (tg + 1u) * nx) xb_add(&bar[XB_TOPGEN], 1u);
            else XB_SPIN(xb_ld(&bar[XB_TOPGEN]) == tg, bar);
            __builtin_amdgcn_fence(__ATOMIC_ACQUIRE, "agent");
            xb_add(&bar[XB_XGEN(b.x)], 1u);
            asm volatile("s_waitcnt vmcnt(0)" ::: "memory");
        } else {
            XB_SPIN(xb_ld(&bar[XB_XGEN(b.x)]) == gen, bar);
            __builtin_amdgcn_fence(__ATOMIC_ACQUIRE, "agent");
            asm volatile("s_waitcnt vmcnt(0)" ::: "memory");
        }
    }
    __syncthreads();
}


#ifndef FIRST_STEP
#define FIRST_STEP 0
#endif
#ifndef LAST_STEP
#define LAST_STEP 18
#endif
#define ON(n) (FIRST_STEP <= (n) && (n) <= LAST_STEP)
#define SYNC(n) do { if ((n) < LAST_STEP) { XcdBarrier bar_; bar_.bar = (unsigned*)ws; bar_.x = xb_xcc_id(); bar_.st = (volatile LAS unsigned*)(L + RING_BYTES + 352); xcd_barrier(bar_); } } while (0)
#define WSB(off) ((const bf16_t*)(ws + (off)))
__global__ void __launch_bounds__(512, 2) fox_s5_mega(Args a) {
    extern __shared__ __attribute__((aligned(16))) unsigned char lds[];
    LAS unsigned char* L = (LAS unsigned char*)lds;
    const int G = gridDim.x, bx = blockIdx.x, NGW = G * 8, NGT = G * 512;
#define KA const __attribute__((address_space(4))) unsigned char* ka_ = (const __attribute__((address_space(4))) unsigned char*)__builtin_amdgcn_kernarg_segment_ptr(); asm volatile("" : "+s"(ka_)); \
    InTab in = (InTab)ka_; float* out = *(float* const __attribute__((address_space(4)))*)(ka_ + 256); unsigned char* ws = *(unsigned char* const __attribute__((address_space(4)))*)(ka_ + 264); (void)in; (void)out;
#define IDS int tid = threadIdx.x; asm volatile("" : "+v"(tid)); const int lane = tid & 63, wave = __builtin_amdgcn_readfirstlane(tid >> 6); const int gw = bx * 8 + wave, gt = bx * 512 + tid; (void)lane; (void)gw; (void)gt;
    {
        KA
        if (threadIdx.x < 8) ((volatile LAS unsigned*)(L + RING_BYTES + 320))[threadIdx.x + 8 - 8] = 0u;
        if (threadIdx.x < 2) ((volatile LAS unsigned*)(L + RING_BYTES + 352))[threadIdx.x] = 0u;
        __syncthreads();
        (void)xcd_barrier_post((unsigned*)ws, (volatile LAS unsigned*)(L + RING_BYTES + 352));
    }

    if (ON(0)) {
        KA
        IDS
        LAS float* scr = (LAS float*)(L + wave * 16384);
        { int base = 0;
          for (int j = 0; j < NTJ; ++j) { TJob J; get_tjob(in, ws, j, J);
              int first = gw - (base % NGW); if (first < 0) first += NGW;
              for (int it = first; it < J.items; it += NGW) transpose_item(J, scr, it, lane);
              base += J.items; } }
        __syncthreads();
        LAS float* wf = (LAS float*)L;
        for (int idx = tid; idx < 8192; idx += 512) wf[idx] = in[I_W_IN][(size_t)(idx >> 3) * INCOLS + 1536 + (idx & 7)];
        __syncthreads();
        {
            f32x4 nx[4];
            if (gw < T) { const f32x4* xr = (const f32x4*)(in[I_X] + (size_t)gw * DM) + lane;
#pragma unroll
                for (int j = 0; j < 4; ++j) nx[j] = xr[64 * j]; }
            const f32x4* gp = (const f32x4*)in[I_NORM_MIX]; f32x4 gn[4];
#pragma unroll
            for (int j = 0; j < 4; ++j) gn[j] = gp[64 * j + lane];
            const float fbias = in[I_FBIAS][lane & 7];
            for (int m = gw; m < T; m += NGW) {
                f32x4 v[4]; float s = 0.f;
#pragma unroll
                for (int j = 0; j < 4; ++j) { v[j] = nx[j]; s += (v[j][0] * v[j][0] + v[j][1] * v[j][1]) + (v[j][2] * v[j][2] + v[j][3] * v[j][3]); }
                if (m + NGW < T) { const f32x4* xr = (const f32x4*)(in[I_X] + (size_t)(m + NGW) * DM) + lane;
#pragma unroll
                    for (int j = 0; j < 4; ++j) nx[j] = xr[64 * j]; }
                const float rs = rsqrtf(wave_sum(s) * (1.f / DM) + EPS);
                u32x2* o8 = (u32x2*)((bf16_t*)(ws + WS_HN) + (size_t)m * DM) + lane;
#pragma unroll
                for (int j = 0; j < 4; ++j) { v[j] = v[j] * rs * gn[j]; u32x2 w; w.x = pk2(v[j][0], v[j][1]); w.y = pk2(v[j][2], v[j][3]); o8[64 * j] = w; }
                float d[8];
#pragma unroll
                for (int h = 0; h < 8; ++h) d[h] = 0.f;
#pragma unroll
                for (int j = 0; j < 4; ++j)
#pragma unroll
                    for (int i = 0; i < 4; ++i) { const int k = 256 * j + 4 * lane + i; const f32x4 w0 = *(const LAS f32x4*)(wf + k * 8), w1 = *(const LAS f32x4*)(wf + k * 8 + 4);
                        d[0] += v[j][i] * w0[0]; d[1] += v[j][i] * w0[1]; d[2] += v[j][i] * w0[2]; d[3] += v[j][i] * w0[3];
                        d[4] += v[j][i] * w1[0]; d[5] += v[j][i] * w1[1]; d[6] += v[j][i] * w1[2]; d[7] += v[j][i] * w1[3]; }
                float e4[4];
#pragma unroll
                for (int h = 0; h < 4; ++h) { const float keep = (lane & 4) ? d[h + 4] : d[h], give = (lane & 4) ? d[h] : d[h + 4]; e4[h] = keep + __shfl_xor(give, 4); }
                float e2[2];
#pragma unroll
                for (int h = 0; h < 2; ++h) { const float keep = (lane & 2) ? e4[h + 2] : e4[h], give = (lane & 2) ? e4[h] : e4[h + 2]; e2[h] = keep + __shfl_xor(give, 2); }
                float z; { const float keep = (lane & 1) ? e2[1] : e2[0], give = (lane & 1) ? e2[0] : e2[1]; z = keep + __shfl_xor(give, 1); }
                z += __shfl_xor(z, 8); z += __shfl_xor(z, 16); z += __shfl_xor(z, 32);
                if (lane < 8) {
                    z += fbias;
                    const float ls = fminf(z, 0.f) - __logf(1.f + __expf(-fabsf(z)));
                    const int b = m >> 11, t = m & 2047;
                    ((float*)(ws + WS_LOGF))[(size_t)(b * 8 + lane) * SEQ + t] = ls; }
            }
        }
        for (int m = gw; m < TM; m += NGW) { f32x4 v[4]; rms_row(in[I_MEM] + (size_t)m * DM, in[I_NMEM], (bf16_t*)(ws + WS_MN) + (size_t)m * DM, lane, v); }
        __syncthreads();
        {
            const int NTASK = S5G * TC, sub = tid >> 7, ltid = tid & 127, per = NTASK / G;
            for (int i0 = 0; bx + i0 * G < NTASK; i0 += 4) { const int task = bx + (i0 + sub) * G; const bool valid = task < NTASK;
                const int t2 = !valid ? 0 : ((NTASK % G == 0) ? (task % G) * per + task / G : task);
                s5_prep_task<128>(in, ws, t2 / TC, t2 % TC, (LAS float*)L + sub * 5120, ltid, valid); }
        }
        SYNC(0);
    }
    if (ON(2)) {
        KA
        pg8::Gemm g{WSB(WS_HN), WSB(WS_WIN), DM, DM, DM}; GOrder<OK_PLAIN> S; S.init(T / 256, 8, G, bx, DM, DM);
        Epi<EK_PROJ> E{ws + WS_Q, ws + WS_K, ws + WS_V, ws + WS_UG, in[I_FQN], in[I_FKN], nullptr};
        pg8::gemm_phase(L, g, S, E);
    }
    if (ON(1)) {
        KA
        IDS
        int seq = (bx < BATCH * NFH) ? bx : -1;
        if (G == 256) seq = (bx >= 64 && bx < 128) ? bx - 64 : ((bx >= 192) ? bx - 128 : -1);
        if (wave == 0 && seq >= 0) {
            const float* lf = (const float*)(ws + WS_LOGF) + (size_t)seq * SEQ + lane * 32; float* cb = (float*)(ws + WS_CB) + (size_t)seq * SEQ + lane * 32;
            f32x4 x[8]; float run = 0.f;
#pragma unroll
            for (int j = 0; j < 8; ++j) { x[j] = ((const f32x4*)lf)[j]; x[j][0] += run; x[j][1] += x[j][0]; x[j][2] += x[j][1]; x[j][3] += x[j][2]; run = x[j][3]; }
            float incl = run;
#pragma unroll
            for (int o = 1; o < 64; o <<= 1) { const float y = __shfl_up(incl, o); if (lane >= o) incl += y; }
            const float excl = incl - run;
#pragma unroll
            for (int j = 0; j < 8; ++j) ((f32x4*)cb)[j] = (x[j] + excl) * LOG2E;
        }
    }
    if (ON(3)) {
        KA
        pg8::Gemm g{WSB(WS_MN), WSB(WS_WXK), DM, DM, DM}; GOrder<OK_PLAIN> S; S.init(TM / 256, 4, G, bx, DM, DM);
        Epi<EK_MEMK> E{ws + WS_KST, ws + WS_SSQK, nullptr, nullptr, nullptr, nullptr, nullptr};
        pg8::gemm_phase(L, g, S, E);
    }
    if (ON(4)) {
        KA
        pg8::Gemm g{WSB(WS_WXV), WSB(WS_MN), DM, DM, DM}; GOrder<OK_PLAIN> S; S.init(4, TM / 256, G, (bx + 128) % G, DM, DM);
        Epi<EK_MEMVT> E{ws + WS_VT, nullptr, nullptr, nullptr, nullptr, nullptr, nullptr};
        pg8::gemm_phase(L, g, S, E);
        SYNC(4);
    }
    if (ON(5)) {
        KA
        const int vcu = (G % 8 == 0) ? (bx % 8) * (G / 8) + bx / 8 : bx;
        float skip_th; { const int ln = threadIdx.x & 63; float gq = fabsf(in[I_FQN][ln]), gk = fabsf(in[I_FKN][ln]);
#pragma unroll
            for (int o = 1; o < 64; o <<= 1) { gq = fmaxf(gq, __shfl_xor(gq, o)); gk = fmaxf(gk, __shfl_xor(gk, o)); }
            skip_th = 2.f * (64.f * C2Q * gq * gk) + 40.f; }
        for (int L2 = vcu; L2 < BATCH * NFH * 2; L2 += G) { const int bh = L2 >> 1, s = L2 & 1;
            for (int i = 0; i < 4; ++i) { const int qb = (i == 0) ? s : (i == 1) ? 3 - s : (i == 2) ? 4 + s : 7 - s;
                attn_body::attn_unit<8>(bh >> 3, bh & 7, qb, (const attn_body::bf16*)(ws + WS_Q), (const attn_body::bf16*)(ws + WS_K), (const attn_body::bf16*)(ws + WS_V),
                                        (attn_body::bf16*)(ws + WS_FOX), (const float*)(ws + WS_CB), (float*)(ws + WS_SSQF), (char*)lds, skip_th); } }
    }
    if (ON(6)) {
        KA
        pg8::Gemm g{WSB(WS_UG), WSB(WS_BTE), UGP, 512, 256}; GOrder<OK_S5E> S; S.init(256, 1, G, bx, UGP, 512);
        Epi<EK_S5E> E{ws + WS_EPART, nullptr, nullptr, nullptr, nullptr, nullptr, nullptr};
        pg8::gemm_phase(L, g, S, E);
        SYNC(6);
    }
    if (ON(7)) {
        KA
        IDS
        const float* kt = (const float*)(ws + WS_KTAB); bf16_t* bty = (bf16_t*)(ws + WS_BTY);
        for (int idx = gt; idx < S5G * 512 * 64; idx += NGT) {
            const int half = idx & 1, ss = (idx >> 1) & 31, nn = (idx >> 6) & 511, gI = idx >> 15; const int tt = nn >> 4, c = nn & 15;
            u32x4 w = (u32x4){0u, 0u, 0u, 0u};
            if (ss <= tt) { const float* src = kt + ((size_t)((gI * TC + (tt - ss)) * 16 + c)) * 16 + half * 8; const f32x4 k0 = *(const f32x4*)src, k1 = *(const f32x4*)(src + 4);
                w.x = pk2(k0[0], k0[1]); w.y = pk2(k0[2], k0[3]); w.z = pk2(k1[0], k1[1]); w.w = pk2(k1[2], k1[3]); }
            *(u32x4*)(bty + ((size_t)gI * 512 + nn) * UGP + ss * 16 + half * 8) = w; }
        const float* ep = (const float*)(ws + WS_EPART); const float* lb = (const float*)(ws + WS_LB32); bf16_t* ug = (bf16_t*)(ws + WS_UG);
        for (int idx = gt; idx < S5G * BATCH * S5P; idx += NGT) { const int p = idx & 63, gb = idx >> 6, gI = gb >> 4;
            const float lr = lb[(gI * 64 + p) * 2], li = lb[(gI * 64 + p) * 2 + 1]; float sr = 0.f, si = 0.f;
            for (int k0 = 0; k0 < NCH; k0 += 16) {
                f32x2 e0[16], e1[16];
#pragma unroll
                for (int j = 0; j < 16; ++j) { const size_t row = (size_t)gb * NCH + k0 + j; e0[j] = *(const f32x2*)(ep + row * 128 + 2 * p); e1[j] = *(const f32x2*)(ep + (size_t)32768 * 128 + row * 128 + 2 * p); }
#pragma unroll
                for (int j = 0; j < 16; ++j) { const size_t row = (size_t)gb * NCH + k0 + j;
                    *(unsigned*)(ug + row * UGP + 512 + 2 * p) = pk2(sr, si);
                    const float nr = lr * sr - li * si + (e0[j][0] + e1[j][0]), ni = lr * si + li * sr + (e0[j][1] + e1[j][1]); sr = nr; si = ni; } } }
        SYNC(7);
    }
    if (ON(8)) {
        KA
        pg8::Gemm g{WSB(WS_UG), WSB(WS_BTY), UGP, UGP, UGP}; GOrder<OK_S5Y> S; S.init(256, 1, G, bx, UGP, UGP);
        Epi<EK_S5Y> E{ws + WS_Y1, nullptr, nullptr, nullptr, nullptr, nullptr, nullptr};
        pg8::gemm_phase(L, g, S, E);
        SYNC(8);
    }
    if (ON(9)) {
        KA
        pg8::Gemm g{WSB(WS_Y1), WSB(WS_WGLU), 512, 512, 512}; GOrder<OK_PLAIN> S; S.init(T / 256, 2, G, bx, 512, 512);
        Epi<EK_GLU> E{ws + WS_Y2, ws + WS_SSQY, nullptr, nullptr, ws + WS_Y1, in[I_BGLU], nullptr};
        pg8::gemm_phase(L, g, S, E);
        SYNC(9);
    }
    if (ON(10)) {
        KA
        IDS
        const float* sf = (const float*)(ws + WS_SSQF); const float* sy = (const float*)(ws + WS_SSQY);
        const bf16_t* fox = WSB(WS_FOX); const bf16_t* y2 = WSB(WS_Y2); bf16_t* mx = (bf16_t*)(ws + WS_MIXN);
        {
            f32x4 a0, a1, b0, b1; u32x4 f, y;
#define NRM_LOAD(mm) do { a0 = *(const f32x4*)(sf + (size_t)(mm) * 8); a1 = *(const f32x4*)(sf + (size_t)(mm) * 8 + 4); b0 = *(const f32x4*)(sy + (size_t)(mm) * 8); b1 = *(const f32x4*)(sy + (size_t)(mm) * 8 + 4); \
                f = *(const u32x4*)(fox + (size_t)(mm) * 512 + lane * 8); y = *(const u32x4*)(y2 + (size_t)(mm) * 512 + lane * 8); } while (0)
            if (gw < T) NRM_LOAD(gw);
            for (int m = gw; m < T; m += NGW) {
                const float rf = rsqrtf((((a0[0] + a0[1]) + (a0[2] + a0[3])) + ((a1[0] + a1[1]) + (a1[2] + a1[3]))) * (1.f / 512.f) + EPS);
                const float ry = rsqrtf((((b0[0] + b0[1]) + (b0[2] + b0[3])) + ((b1[0] + b1[1]) + (b1[2] + b1[3]))) * (1.f / 512.f) + EPS);
                u32x4 of, oy;
                of.x = pk2(bflo(f.x) * rf, bfhi(f.x) * rf); of.y = pk2(bflo(f.y) * rf, bfhi(f.y) * rf); of.z = pk2(bflo(f.z) * rf, bfhi(f.z) * rf); of.w = pk2(bflo(f.w) * rf, bfhi(f.w) * rf);
                oy.x = pk2(bflo(y.x) * ry, bfhi(y.x) * ry); oy.y = pk2(bflo(y.y) * ry, bfhi(y.y) * ry); oy.z = pk2(bflo(y.z) * ry, bfhi(y.z) * ry); oy.w = pk2(bflo(y.w) * ry, bfhi(y.w) * ry);
                if (m + NGW < T) NRM_LOAD(m + NGW);
                *(u32x4*)(mx + (size_t)m * DM + lane * 8) = of; *(u32x4*)(mx + (size_t)m * DM + 512 + lane * 8) = oy; }
#undef NRM_LOAD
        }
        SYNC(10);
    }
    if (ON(11)) {
        KA
        pg8::Gemm g{WSB(WS_MIXN), WSB(WS_WOUT), DM, DM, DM}; GOrder<OK_PLAIN> S; S.init(T / 256, 4, G, bx, DM, DM);
        Epi<EK_WOUT> E{nullptr, ws + WS_H1B, ws + WS_SSQ1, nullptr, in[I_X], nullptr, nullptr};
        pg8::gemm_phase(L, g, S, E);
        SYNC(11);
    }
    if (ON(12)) {
        KA
        IDS
        const float* sk = (const float*)(ws + WS_SSQK); float* sck = (float*)(ws + WS_SCK);
        for (int idx = gt; idx < TM * 4; idx += NGT) { const int key = idx >> 2, h = idx & 3; const f32x4 q = *(const f32x4*)(sk + (size_t)key * 16 + h * 4);
            sck[(size_t)h * TM + key] = rsqrtf(((q[0] + q[1]) + (q[2] + q[3])) * (1.f / 256.f) + EPS); }
        pg8::Gemm g{WSB(WS_H1B), WSB(WS_WXQ), DM, DM, DM}; GOrder<OK_PLAIN> S; S.init(T / 256, 4, G, bx, DM, DM);
        Epi<EK_XQ> E{ws + WS_QST, ws + WS_SSQQ, nullptr, nullptr, in[I_XQN], in[I_XKN], nullptr};
        pg8::gemm_phase(L, g, S, E);
        SYNC(12);
    }
    if (ON(13)) {
        KA
        pg8::Gemm g{WSB(WS_QST), WSB(WS_KST), DM, DM, 256}; GOrder<OK_XS> S; S.init(512, 1, G, bx, DM, DM);
        Epi<EK_XS> E{ws + WS_P, ws + WS_PSUM, nullptr, nullptr, ws + WS_SSQ1, ws + WS_SSQQ, ws + WS_SCK};
        pg8::gemm_phase(L, g, S, E);
        SYNC(13);
    }
    if (ON(14)) {
        KA
        pg8::Gemm g{WSB(WS_P), WSB(WS_VT), DM, TM, 256}; GOrder<OK_XO> S; S.init(512, 1, G, bx, DM, TM);
        Epi<EK_XO> E{ws + WS_XO, nullptr, nullptr, nullptr, ws + WS_PSUM, nullptr, nullptr};
        pg8::gemm_phase(L, g, S, E);
        SYNC(14);
    }
    if (ON(15)) {
        KA
        pg8::Gemm g{WSB(WS_XO), WSB(WS_WXO), DM, DM, DM}; GOrder<OK_PLAIN> S; S.init(T / 256, 4, G, bx, DM, DM);
        Epi<EK_WXO> E{nullptr, ws + WS_H2B, ws + WS_SSQ2, nullptr, ws + WS_H1B, nullptr, nullptr};
        pg8::gemm_phase(L, g, S, E);
        SYNC(15);
    }
    if (ON(16)) {
        KA
        { IDS
          const float* s2 = (const float*)(ws + WS_SSQ2); float* r2 = (float*)(ws + WS_RS2);
          for (int row = gt; row < T; row += NGT) { const f32x4 t0 = *(const f32x4*)(s2 + (size_t)row * 16), t1 = *(const f32x4*)(s2 + (size_t)row * 16 + 4), t2 = *(const f32x4*)(s2 + (size_t)row * 16 + 8), t3 = *(const f32x4*)(s2 + (size_t)row * 16 + 12);
              r2[row] = rsqrtf((((t0[0] + t0[1]) + (t0[2] + t0[3])) + ((t1[0] + t1[1]) + (t1[2] + t1[3])) + ((t2[0] + t2[1]) + (t2[2] + t2[3])) + ((t3[0] + t3[1]) + (t3[2] + t3[3]))) * (1.f / DM) + EPS); }
          SYNC(15); }
        pg8::Gemm g{WSB(WS_H2B), WSB(WS_WUP), DM, DM, DM}; GOrder<OK_PLAIN> S; S.init(T / 256, 22, G, bx, DM, DM);
        Epi<EK_UPC> E{ws + WS_U, ws + WS_G, ws + WS_G + 4 * MiB, ws + WS_G + 8 * MiB, ws + WS_RS2, in[I_CONVW], in[I_CONVB], (LAS float*)(L + RING_BYTES + 1024)};
        pg8::gemm_phase(L, g, S, E);
        SYNC(16);
    }
    if (ON(17)) {
        KA
        IDS
        const float* GHF = (const float*)(ws + WS_G); const float* GHL = (const float*)(ws + WS_G + 4 * MiB); const float* UH = (const float*)(ws + WS_G + 8 * MiB);
        const float* cw = in[I_CONVW]; const float* cbv = in[I_CONVB]; bf16_t* A = (bf16_t*)(ws + WS_U);
        for (int idx = gt; idx < (T / 256) * 2 * DFF; idx += NGT) { const int j = idx % DFF, pi = idx / DFF, i = pi & 1, pm = pi >> 1; const bool first = (pm & 7) == 0;
            const float g0 = GHF[(size_t)pi * DFF + j];
            const float gl1 = first ? 0.f : GHL[((size_t)(pm - 1) * 2 + 1) * DFF + j], gl0 = first ? 0.f : GHL[((size_t)(pm - 1) * 2) * DFF + j];
            const float g1 = i ? GHF[(size_t)(pm * 2) * DFF + j] : gl1, g2 = i ? gl1 : gl0;
            const float z = cbv[j] + cw[j] * g2 + cw[DFF + j] * g1 + cw[2 * DFF + j] * g0;
            A[(size_t)(pm * 256 + i) * DFF + j] = (bf16_t)f2bf(z * sigm(z) * UH[(size_t)pi * DFF + j]); }
        SYNC(17);
    }
    if (ON(18)) {
        KA
        pg8::Gemm g{WSB(WS_U), WSB(WS_WDN), DFF, DFF, DFF}; GOrder<OK_PLAIN> S; S.init(T / 256, 4, G, bx, DFF, DFF);
        Epi<EK_DOWN> E{out, nullptr, nullptr, nullptr, ws + WS_H2B, nullptr, nullptr};
        pg8::gemm_phase(L, g, S, E);
    }
}

extern "C" void kernel_launch(void* const* d_in, const int* in_sizes, int n_in, void* d_out, int out_size, void* d_ws, size_t ws_size, hipStream_t stream) {
    static int grid = 0;
    if (grid == 0) {
        if (n_in != 32 || out_size != T * DM || ws_size < WS_END) { fprintf(stderr, "kernel_launch: unexpected shapes (n_in %d out %d ws %zu)\n", n_in, out_size, ws_size); grid = -1; return; }
        int dev = 0, cus = 0, per_cu = 0;
        (void)hipGetDevice(&dev); (void)hipDeviceGetAttribute(&cus, hipDeviceAttributeMultiprocessorCount, dev);
        if (hipFuncSetAttribute((const void*)fox_s5_mega, hipFuncAttributeMaxDynamicSharedMemorySize, LDS_TOTAL) != hipSuccess) { fprintf(stderr, "kernel_launch: hipFuncSetAttribute failed\n"); grid = -1; return; }
        if (hipOccupancyMaxActiveBlocksPerMultiprocessor(&per_cu, (const void*)fox_s5_mega, 512, LDS_TOTAL) != hipSuccess || per_cu < 1) { fprintf(stderr, "kernel_launch: occupancy query says %d\n", per_cu); per_cu = 1; }
        (void)hipGetLastError();
        grid = cus;
        if (grid > cus * per_cu) grid = cus * per_cu;
    }
    if (grid < 0) return;
    if (hipMemsetAsync(d_ws, 0, 65536, stream) != hipSuccess) { fprintf(stderr, "kernel_launch: memset of the barrier words failed\n"); return; }
    Args a{};
    for (int i = 0; i < 32; ++i) a.in[i] = (const float*)d_in[i];
    a.out = (float*)d_out; a.ws = (unsigned char*)d_ws;
    void* args[] = {&a};
    hipError_t e = hipLaunchCooperativeKernel((const void*)fox_s5_mega, dim3(grid), dim3(512), args, LDS_TOTAL, stream);
    if (e != hipSuccess) fprintf(stderr, "cooperative launch failed: %s (grid %d)\n", hipGetErrorString(e), grid);
}
```

```cpp
#include <hip/hip_runtime.h>
#include <hip/hip_bf16.h>
#include <cstdio>
#include <cstdint>
#include <cmath>

constexpr int BATCH = 16, SEQ = 2048, DM = 1024, T = BATCH * SEQ;
constexpr int NMEM = 256, TM = BATCH * NMEM;
constexpr int FOXW = 512, HD = 64, NFH = 8;
constexpr int S5W = 512, S5G = 32, S5C = 16, S5P = 64;
constexpr int NXH = 4, XHD = 256;
constexpr int DFF = 2816;
constexpr int INCOLS = 2056;
constexpr float EPS = 1e-6f;
constexpr int TC = 32, NCH = SEQ / TC;
constexpr int UGP = TC * 16 + 128;
constexpr float LOG2E = 1.4426950408889634f;
constexpr float C2Q = 0.125f * LOG2E;

#define LAS __attribute__((address_space(3)))
typedef unsigned short bf16_t;
typedef short bf16x8 __attribute__((ext_vector_type(8)));
typedef float f32x4 __attribute__((ext_vector_type(4)));
typedef float f32x2 __attribute__((ext_vector_type(2)));
typedef unsigned u32x4 __attribute__((ext_vector_type(4)));
typedef unsigned u32x2 __attribute__((ext_vector_type(2)));

__device__ __forceinline__ unsigned f2bf(float f) { unsigned u = __builtin_bit_cast(unsigned, f); return (u + 0x7fffu + ((u >> 16) & 1u)) >> 16; }
typedef __bf16 bf16x2_hw __attribute__((ext_vector_type(2)));
__device__ __forceinline__ unsigned pk2(float lo, float hi) { f32x2 v = {lo, hi}; bf16x2_hw b = __builtin_convertvector(v, bf16x2_hw); return __builtin_bit_cast(unsigned, b); }
__device__ __forceinline__ float bflo(unsigned w) { return __builtin_bit_cast(float, w << 16); }
__device__ __forceinline__ float bfhi(unsigned w) { return __builtin_bit_cast(float, w & 0xffff0000u); }
__device__ __forceinline__ float wave_sum(float v) {
#pragma unroll
    for (int o = 1; o < 64; o <<= 1) v += __shfl_xor(v, o);
    return v;
}

__device__ __forceinline__ float red_fq(float v) {
    v += __builtin_bit_cast(float, __builtin_amdgcn_ds_swizzle(__builtin_bit_cast(int, v), 0x401F));
    float a = v, b = v;
    asm volatile("s_nop 1\n\tv_permlane32_swap_b32 %0, %1\n\ts_nop 1" : "+v"(a), "+v"(b));
    return a + b;
}

constexpr size_t MiB = 1u << 20;
constexpr size_t WS_WIN = 1 * MiB, WS_WGLU = 5 * MiB, WS_WOUT = 6 * MiB, WS_WXQ = 8 * MiB, WS_WXK = 10 * MiB, WS_WXV = 12 * MiB, WS_WXO = 14 * MiB,
                 WS_WUP = 16 * MiB, WS_WDN = 27 * MiB, WS_BTY = 33 * MiB, WS_BTE = 53 * MiB, WS_KTAB = 61 * MiB, WS_LB32 = 62 * MiB, WS_LOGF = 63 * MiB,
                 WS_CB = 64 * MiB, WS_SSQF = 65 * MiB, WS_SSQY = 66 * MiB, WS_SSQ1 = 67 * MiB, WS_SSQ2 = 69 * MiB, WS_SSQQ = 71 * MiB, WS_PSUM = 73 * MiB,
                 WS_SSQK = 75 * MiB, WS_SCK = 76 * MiB, WS_RS2 = 77 * MiB;
constexpr size_t WS_HN = 80 * MiB, WS_MIXN = 80 * MiB, WS_Y1 = 304 * MiB, WS_QST = 80 * MiB, WS_H2B = 80 * MiB;
constexpr size_t WS_MN = 144 * MiB, WS_KST = 152 * MiB, WS_VT = 160 * MiB;
constexpr size_t WS_Q = 168 * MiB, WS_K = 200 * MiB, WS_V = 232 * MiB, WS_P = 168 * MiB;
constexpr size_t WS_UG = 264 * MiB, WS_EPART = 304 * MiB, WS_H1B = 264 * MiB, WS_XO = 336 * MiB;
constexpr size_t WS_G = 144 * MiB, WS_U = 320 * MiB, WS_END = 496 * MiB;

namespace pg8 {
constexpr int BM = 256, BK = 64, HALF = 128, HTB = HALF * BK * 2, STAGE_BYTES = 8 * HTB;
__device__ __forceinline__ int lds_byte(int r, int c) { const int st = (r >> 4) * 2 + (c >> 5), rr = r & 15, cc = c & 31, ob = rr * 64 + cc * 2; return st * 1024 + (ob ^ (((ob >> 9) & 1) << 5)); }
__device__ __forceinline__ void stage_rc(int b, int& R, int& C) { const int st = b / 1024, sb = b % 1024, swz = sb ^ (((sb >> 9) & 1) << 5); R = (st >> 1) * 16 + swz / 64; C = (st & 1) * 32 + (swz % 64) / 2; }
__device__ __forceinline__ int perm32(int rho) { const int n = rho >> 4, i = rho & 15; return 8 * (i >> 2) + 4 * n + (i & 3); }

struct Unit { int pm, pn; long offA, offB; };
struct Gemm { const bf16_t* A; const bf16_t* Bt; int lda, ldb, K; };

template <class Epi, class Sched>
__device__ __forceinline__ void gemm_phase(LAS unsigned char* lds, const Gemm g, const Sched& S, const Epi& E) {
    int tid = threadIdx.x; asm volatile("" : "+v"(tid));
    const int wid = __builtin_amdgcn_readfirstlane(tid >> 6), lane = tid & 63, wr = wid >> 2, wc = wid & 3, fr = lane & 15, fq = lane >> 4;
    const int K = g.K, nt = K / BK;
    unsigned voffA[2], voffB[2];
#pragma unroll
    for (int i = 0; i < 2; ++i) { int R, C; stage_rc(tid * 16 + i * 8192, R, C); const int Rb = (R & ~31) + perm32(R & 31);
        voffA[i] = (unsigned)(R * g.lda + C) * 2u; voffB[i] = (unsigned)(Rb * g.ldb + C) * 2u; }
    const size_t kstep = (size_t)(BK * 2);
    const size_t hstepA = (size_t)HALF * g.lda * 2, hstepB = (size_t)HALF * g.ldb * 2;
    const unsigned ldsw = (unsigned)wid * 1024u;
    const int aoff = lds_byte(wr * 64 + fr, fq * 8), boff = lds_byte(wc * 32 + fr, fq * 8);
#define PG8_SA(b, h) (((b) * 2 + (h)) * HTB)
#define PG8_SB(b, h) ((4 + (b) * 2 + (h)) * HTB)
#define PG8_STAGE(bufoff, gbase, voff) do { _Pragma("unroll") for (int _i = 0; _i < 2; ++_i) \
        __builtin_amdgcn_global_load_lds((const unsigned*)((const char*)(gbase) + (voff)[_i]), (LAS unsigned*)(lds + (bufoff) + ldsw + _i * 8192), 16, 0, 0); } while (0)
#define PG8_LDA(dst, b, h) do { _Pragma("unroll") for (int m = 0; m < 4; ++m) _Pragma("unroll") for (int k = 0; k < 2; ++k) dst[m][k] = *(const LAS bf16x8*)(lds + PG8_SA(b, h) + aoff + m * 2048 + k * 1024); } while (0)
#define PG8_LDB(dst, b, h) do { _Pragma("unroll") for (int n = 0; n < 2; ++n) _Pragma("unroll") for (int k = 0; k < 2; ++k) dst[n][k] = *(const LAS bf16x8*)(lds + PG8_SB(b, h) + boff + n * 2048 + k * 1024); } while (0)
#define PG8_MMA(ai, bj, At, Bt) do { __builtin_amdgcn_s_setprio(1); _Pragma("unroll") for (int m = 0; m < 4; ++m) _Pragma("unroll") for (int n = 0; n < 2; ++n) _Pragma("unroll") for (int k = 0; k < 2; ++k) \
        acc[ai][bj][m][n] = __builtin_amdgcn_mfma_f32_16x16x32_bf16(Bt[n][k], At[m][k], acc[ai][bj][m][n], 0, 0, 0); __builtin_amdgcn_s_setprio(0); } while (0)
#define PG8_WAIT_V(n) asm volatile("s_waitcnt vmcnt(" #n ")" ::: "memory")
#define PG8_WAIT_L(n) asm volatile("s_waitcnt lgkmcnt(" #n ")" ::: "memory")
#define PG8_BAR __builtin_amdgcn_s_barrier()
#define PG8_SCHED __builtin_amdgcn_sched_barrier(0)
    Unit cur, nxt; int ui = 0;
    if (!S.next(0, cur)) return;
    f32x4 acc[2][2][4][2];
#pragma unroll
    for (int a = 0; a < 2; ++a)
#pragma unroll
        for (int b = 0; b < 2; ++b)
#pragma unroll
            for (int m = 0; m < 4; ++m)
#pragma unroll
                for (int n = 0; n < 2; ++n) acc[a][b][m][n] = (f32x4){0.f, 0.f, 0.f, 0.f};
    bf16x8 At[4][2], B0[2][2], B1[2][2];
    const char* cA = (const char*)g.A + cur.offA; const char* cB = (const char*)g.Bt + cur.offB;
    PG8_STAGE(PG8_SB(0, 0), cB, voffB); PG8_STAGE(PG8_SB(0, 1), cB + hstepB, voffB); PG8_STAGE(PG8_SA(0, 0), cA, voffA); PG8_STAGE(PG8_SA(0, 1), cA + hstepA, voffA);
    if (wr == 1) PG8_BAR;
    PG8_WAIT_V(2); PG8_BAR;
    PG8_STAGE(PG8_SB(1, 0), cB + kstep, voffB); PG8_STAGE(PG8_SA(1, 0), cA + kstep, voffA); PG8_STAGE(PG8_SB(1, 1), cB + hstepB + kstep, voffB);
    PG8_WAIT_V(6); PG8_BAR;
    for (;;) {
        const bool has_next = S.next(ui + 1, nxt);
        const char* nA = has_next ? (const char*)g.A + nxt.offA : cA; const char* nB = has_next ? (const char*)g.Bt + nxt.offB : cB;
        for (int t = 0; t < nt; t += 2) {
            if constexpr (Epi::MID) { if (t == nt / 2) { int fr2 = fr; asm volatile("" : "+v"(fr2)); E.mid(acc, cur, wr, fr2); } }
            const bool last = (t == nt - 2);
            const char* a1 = cA + (size_t)(t + 1) * kstep;
            const char* a2 = last ? nA : cA + (size_t)(t + 2) * kstep; const char* b2 = last ? nB : cB + (size_t)(t + 2) * kstep;
            const char* a3 = a2 + kstep; const char* b3 = b2 + kstep;
            PG8_LDB(B0, 0, 0); PG8_LDB(B1, 0, 1); PG8_SCHED; PG8_LDA(At, 0, 0); PG8_STAGE(PG8_SA(1, 1), a1 + hstepA, voffA);
            PG8_WAIT_V(8); PG8_WAIT_L(0); PG8_BAR; PG8_MMA(0, 0, At, B0); PG8_MMA(0, 1, At, B1); PG8_BAR; PG8_SCHED;
            PG8_LDA(At, 0, 1); PG8_STAGE(PG8_SB(0, 0), b2, voffB); PG8_STAGE(PG8_SB(0, 1), b2 + hstepB, voffB); PG8_STAGE(PG8_SA(0, 0), a2, voffA);
            PG8_WAIT_V(8); PG8_WAIT_L(0); PG8_BAR; PG8_MMA(1, 0, At, B0); PG8_MMA(1, 1, At, B1); PG8_BAR; PG8_SCHED;
            PG8_LDB(B0, 1, 0); PG8_LDB(B1, 1, 1); PG8_SCHED; PG8_LDA(At, 1, 0); PG8_STAGE(PG8_SA(0, 1), a2 + hstepA, voffA);
            PG8_WAIT_V(8); PG8_WAIT_L(0); PG8_BAR; PG8_MMA(0, 0, At, B0); PG8_MMA(0, 1, At, B1); PG8_BAR; PG8_SCHED;
            PG8_LDA(At, 1, 1); PG8_STAGE(PG8_SB(1, 0), b3, voffB); PG8_STAGE(PG8_SB(1, 1), b3 + hstepB, voffB); PG8_STAGE(PG8_SA(1, 0), a3, voffA);
            PG8_WAIT_V(8); PG8_WAIT_L(0); PG8_BAR; PG8_MMA(1, 0, At, B0); PG8_MMA(1, 1, At, B1); PG8_BAR; PG8_SCHED;
        }
        if (wr == 0) PG8_BAR;
        { int fr2 = fr, fq2 = fq; asm volatile("" : "+v"(fr2), "+v"(fq2));
          E(acc, cur, wr, wc, fr2, fq2); }
        if (!has_next) break;
#pragma unroll
        for (int a = 0; a < 2; ++a)
#pragma unroll
            for (int b = 0; b < 2; ++b)
#pragma unroll
                for (int m = 0; m < 4; ++m)
#pragma unroll
                    for (int n = 0; n < 2; ++n) acc[a][b][m][n] = (f32x4){0.f, 0.f, 0.f, 0.f};
        cur = nxt; cA = nA; cB = nB; ++ui;
        if (wr == 1) PG8_BAR;
    }
    PG8_WAIT_V(0);
    PG8_BAR;
#undef PG8_SA
#undef PG8_SB
#undef PG8_STAGE
#undef PG8_LDA
#undef PG8_LDB
#undef PG8_MMA
#undef PG8_WAIT_V
#undef PG8_WAIT_L
#undef PG8_BAR
#undef PG8_SCHED
}
}
using pg8::Unit;

enum OrderKind { OK_PLAIN = 0, OK_S5E, OK_S5Y, OK_XS, OK_XO };
template <int kind> struct GOrder {
    int nM, nN, nwg, G, c, lda, ldb;
    __device__ __forceinline__ void init(int nM_, int nN_, int G_, int c_, int lda_, int ldb_) { nM = nM_; nN = nN_; nwg = nM_ * nN_; G = G_; c = c_; lda = lda_; ldb = ldb_; }
    __device__ __forceinline__ bool next(int i, Unit& u) const {
        const long L = (long)i * G + c; if (L >= nwg) return false;
        const int l = (int)L;
        if constexpr (kind == OK_PLAIN) {
            int wgid = l; { const int q = nwg / 8, r = nwg % 8, xcd = wgid % 8, off = wgid / 8; wgid = (xcd < r ? xcd * (q + 1) : r * (q + 1) + (xcd - r) * q) + off; }
            const int nig = 8 * nN, gid = wgid / nig, fm = gid * 8, gsz = (nM - fm) < 8 ? (nM - fm) : 8;
            u.pm = fm + ((wgid % nig) % gsz); u.pn = (wgid % nig) / gsz;
            u.offA = (long)u.pm * 256 * lda * 2; u.offB = (long)u.pn * 256 * ldb * 2;
        } else if constexpr (kind == OK_S5E) {
            const int kq = l & 1, pmm = (l >> 1) & 3, gg = l >> 3;
            u.pm = gg * 4 + pmm; u.pn = kq;
            u.offA = ((long)u.pm * 256 * UGP + kq * 256) * 2; u.offB = ((long)gg * 256 * 512 + kq * 256) * 2;
        } else if constexpr (kind == OK_S5Y) {
            const int pn = l & 1, pmm = (l >> 1) & 3, gg = l >> 3;
            u.pm = gg * 4 + pmm; u.pn = pn;
            u.offA = (long)u.pm * 256 * UGP * 2; u.offB = ((long)gg * 512 + pn * 256) * UGP * 2;
        } else if constexpr (kind == OK_XS) {
            const int h = l & 3, pm = l >> 2, b = pm >> 3;
            u.pm = pm; u.pn = h;
            u.offA = ((long)pm * 256 * DM + h * 256) * 2; u.offB = ((long)b * 256 * DM + h * 256) * 2;
        } else {
            const int h = l & 3, pm = l >> 2, b = pm >> 3;
            u.pm = pm; u.pn = h;
            u.offA = ((long)pm * 256 * DM + h * 256) * 2; u.offB = ((long)h * 256 * TM + b * 256) * 2;
        }
        return true;
    }
};

enum EpiKind { EK_PROJ = 0, EK_MEMK, EK_MEMVT, EK_S5E, EK_S5Y, EK_GLU, EK_WOUT, EK_XQ, EK_XS, EK_XO, EK_WXO, EK_UP, EK_DOWN, EK_GATE, EK_UPACT, EK_UPC };
    __device__ __forceinline__ u32x4 pack8(const f32x4 a, const f32x4 b) { u32x4 w; w.x = pk2(a[0], a[1]); w.y = pk2(a[2], a[3]); w.z = pk2(b[0], b[1]); w.w = pk2(b[2], b[3]); return w; }
    __device__ __forceinline__ float gelu_t(float y) { const float z = 0.7978845608028654f * (y + 0.044715f * y * y * y); const float e = __expf(2.f * z); const float th = 1.f - 2.f / (e + 1.f); return 0.5f * y * (1.f + th); }
    __device__ __forceinline__ float sigm(float z) { return 1.f / (1.f + __expf(-z)); }
    __device__ __forceinline__ float ssq8(const f32x4 a, const f32x4 b) { return (a[0] * a[0] + a[1] * a[1]) + (a[2] * a[2] + a[3] * a[3]) + (b[0] * b[0] + b[1] * b[1]) + (b[2] * b[2] + b[3] * b[3]); }

template <int kind> struct Epi {
    void* p0; void* p1; void* p2; void* p3; const void* c0; const void* c1; const void* c2; LAS float* hx;
    static constexpr bool MID = (kind == EK_WOUT);
    __device__ __forceinline__ static float rs8(const float* s, size_t row) { const f32x4 a0 = *(const f32x4*)(s + row * 8), a1 = *(const f32x4*)(s + row * 8 + 4); return rsqrtf((((a0[0] + a0[1]) + (a0[2] + a0[3])) + ((a1[0] + a1[1]) + (a1[2] + a1[3]))) * (1.f / 512.f) + EPS); }
    __device__ __forceinline__ void mid(f32x4 (&acc)[2][2][4][2], const Unit& u, int wr, int fr) const {
        const float* sf = (const float*)c1; const float* sy = (const float*)c2;
#pragma unroll
        for (int ai = 0; ai < 2; ++ai)
#pragma unroll
            for (int m = 0; m < 4; ++m) { const size_t row = (size_t)(u.pm * 256 + wr * 64 + fr + ai * 128 + m * 16);
                const float ratio = rs8(sf, row) / rs8(sy, row);
#pragma unroll
                for (int bj = 0; bj < 2; ++bj) { acc[ai][bj][m][0] = acc[ai][bj][m][0] * ratio; acc[ai][bj][m][1] = acc[ai][bj][m][1] * ratio; } }
    }
    __device__ __forceinline__ void operator()(const f32x4 (&acc)[2][2][4][2], const Unit& u, int wr, int wc, int fr, int fq) const {
        const int rbase = u.pm * 256 + wr * 64 + fr;
        const int cl0 = wc * 32 + 8 * fq;
        switch (kind) {
        case EK_PROJ: {
            const int pn = u.pn;
            if (pn < 4) {
                const bool isq = pn < 2; bf16_t* dst = (bf16_t*)(isq ? p0 : p1); const float* gptr = (const float*)(isq ? c0 : c1); const float post = isq ? C2Q : 1.f;
                const int head = 4 * (pn & 1) + wc;
#pragma unroll
                for (int ai = 0; ai < 2; ++ai)
#pragma unroll
                    for (int m = 0; m < 4; ++m) {
                        float ss = ssq8(acc[ai][0][m][0], acc[ai][0][m][1]) + ssq8(acc[ai][1][m][0], acc[ai][1][m][1]);
                        ss = red_fq(ss);
                        const float sc = rsqrtf(ss * (1.f / 64.f) + EPS) * post;
                        const size_t row = (size_t)(rbase + ai * 128 + m * 16);
#pragma unroll
                        for (int bj = 0; bj < 2; ++bj)
                            *(u32x4*)(dst + row * 512 + head * 64 + 32 * bj + 8 * fq) = pack8(acc[ai][bj][m][0] * sc * *(const f32x4*)(gptr + 32 * bj + 8 * fq), acc[ai][bj][m][1] * sc * *(const f32x4*)(gptr + 32 * bj + 8 * fq + 4));
                    }
            } else if (pn < 6) {
                bf16_t* dst = (bf16_t*)p2;
#pragma unroll
                for (int ai = 0; ai < 2; ++ai)
#pragma unroll
                    for (int m = 0; m < 4; ++m) { const size_t row = (size_t)(rbase + ai * 128 + m * 16);
#pragma unroll
                        for (int bj = 0; bj < 2; ++bj) *(u32x4*)(dst + row * 512 + (pn - 4) * 256 + bj * 128 + cl0) = pack8(acc[ai][bj][m][0], acc[ai][bj][m][1]); }
            } else {
                bf16_t* dst = (bf16_t*)p3;
#pragma unroll
                for (int ai = 0; ai < 2; ++ai)
#pragma unroll
                    for (int m = 0; m < 4; ++m) { const int row = rbase + ai * 128 + m * 16; const int b = row >> 11, t = row & 2047, ch = t >> 5, s = t & 31;
#pragma unroll
                        for (int bj = 0; bj < 2; ++bj) { const int f = (pn - 6) * 256 + bj * 128 + cl0; const int gI = f >> 4, cc = f & 15;
                            *(u32x4*)(dst + ((size_t)(gI * 1024 + b * 64 + ch)) * UGP + s * 16 + cc) = pack8(acc[ai][bj][m][0], acc[ai][bj][m][1]); } }
            }
        } break;
        case EK_MEMK: {
            bf16_t* dst = (bf16_t*)p0; float* sq = (float*)p1;
#pragma unroll
            for (int ai = 0; ai < 2; ++ai)
#pragma unroll
                for (int m = 0; m < 4; ++m) { const size_t row = (size_t)(rbase + ai * 128 + m * 16);
                    float ss = ssq8(acc[ai][0][m][0], acc[ai][0][m][1]) + ssq8(acc[ai][1][m][0], acc[ai][1][m][1]);
                    ss = red_fq(ss);
                    if (fq == 0) sq[row * 16 + u.pn * 4 + wc] = ss;
#pragma unroll
                    for (int bj = 0; bj < 2; ++bj) *(u32x4*)(dst + row * DM + u.pn * 256 + bj * 128 + cl0) = pack8(acc[ai][bj][m][0], acc[ai][bj][m][1]); }
        } break;
        case EK_MEMVT: {
            bf16_t* dst = (bf16_t*)p0;
#pragma unroll
            for (int ai = 0; ai < 2; ++ai)
#pragma unroll
                for (int m = 0; m < 4; ++m) { const size_t row = (size_t)(rbase + ai * 128 + m * 16);
#pragma unroll
                    for (int bj = 0; bj < 2; ++bj) *(u32x4*)(dst + row * TM + u.pn * 256 + bj * 128 + cl0) = pack8(acc[ai][bj][m][0], acc[ai][bj][m][1]); }
        } break;
        case EK_S5E: {
            float* dst = (float*)p0 + (size_t)u.pn * 32768 * 128;
#pragma unroll
            for (int ai = 0; ai < 2; ++ai)
#pragma unroll
                for (int m = 0; m < 4; ++m) { const size_t row = (size_t)(rbase + ai * 128 + m * 16);
                    *(f32x4*)(dst + row * 128 + cl0) = acc[ai][0][m][0]; *(f32x4*)(dst + row * 128 + cl0 + 4) = acc[ai][0][m][1]; }
        } break;
        case EK_S5Y: {
            bf16_t* dst = (bf16_t*)p0;
#pragma unroll
            for (int ai = 0; ai < 2; ++ai)
#pragma unroll
                for (int m = 0; m < 4; ++m) { const int r = rbase + ai * 128 + m * 16; const int gI = r >> 10, b = (r >> 6) & 15, k = r & 63;
#pragma unroll
                    for (int bj = 0; bj < 2; ++bj) { const int nn = u.pn * 256 + bj * 128 + cl0; const int tt = nn >> 4, cc = nn & 15;
                        f32x4 a = acc[ai][bj][m][0], c = acc[ai][bj][m][1];
#pragma unroll
                        for (int j = 0; j < 4; ++j) { a[j] = gelu_t(a[j]); c[j] = gelu_t(c[j]); }
                        *(u32x4*)(dst + ((size_t)(b * SEQ + k * TC + tt)) * 512 + gI * 16 + cc) = pack8(a, c); } }
        } break;
        case EK_GLU: {
            bf16_t* dst = (bf16_t*)p0; float* sq = (float*)p1; const bf16_t* y1 = (const bf16_t*)c0; const float* bg = (const float*)c1;
            f32x4 bv[2][2];
#pragma unroll
            for (int bj = 0; bj < 2; ++bj)
#pragma unroll
                for (int n = 0; n < 2; ++n) bv[bj][n] = *(const f32x4*)(bg + u.pn * 256 + bj * 128 + cl0 + 4 * n);
#pragma unroll
            for (int ai = 0; ai < 2; ++ai)
#pragma unroll
                for (int m = 0; m < 4; ++m) { const size_t row = (size_t)(rbase + ai * 128 + m * 16); float ss = 0.f;
#pragma unroll
                    for (int bj = 0; bj < 2; ++bj) { const size_t off = row * 512 + u.pn * 256 + bj * 128 + cl0;
                        const u32x4 yv = *(const u32x4*)(y1 + off);
                        f32x4 a = acc[ai][bj][m][0] + bv[bj][0], c = acc[ai][bj][m][1] + bv[bj][1];
                        a[0] = bflo(yv.x) * sigm(a[0]); a[1] = bfhi(yv.x) * sigm(a[1]); a[2] = bflo(yv.y) * sigm(a[2]); a[3] = bfhi(yv.y) * sigm(a[3]);
                        c[0] = bflo(yv.z) * sigm(c[0]); c[1] = bfhi(yv.z) * sigm(c[1]); c[2] = bflo(yv.w) * sigm(c[2]); c[3] = bfhi(yv.w) * sigm(c[3]);
                        ss += ssq8(a, c);
                        *(u32x4*)(dst + row * DM + 512 + u.pn * 256 + bj * 128 + cl0) = pack8(a, c); }
                    ss = red_fq(ss);
                    if (fq == 0) sq[row * 8 + u.pn * 4 + wc] = ss; }
        } break;
        case EK_WOUT: case EK_WXO: {
            bf16_t* hb = (bf16_t*)p1; float* sq = (float*)p2;
#pragma unroll
            for (int ai = 0; ai < 2; ++ai)
#pragma unroll
                for (int m = 0; m < 4; ++m) { const size_t row = (size_t)(rbase + ai * 128 + m * 16); float ss = 0.f;
#pragma unroll
                    for (int bj = 0; bj < 2; ++bj) { const size_t off = row * DM + u.pn * 256 + bj * 128 + cl0;
                        f32x4 a, c;
                        if (kind == EK_WOUT) { const float* base = (const float*)c0; const float rsy = rs8((const float*)c2, row); a = acc[ai][bj][m][0] * rsy + *(const f32x4*)(base + off); c = acc[ai][bj][m][1] * rsy + *(const f32x4*)(base + off + 4); }
                        else { const u32x4 bv = *(const u32x4*)((const bf16_t*)c0 + off);
                            a = acc[ai][bj][m][0] + (f32x4){bflo(bv.x), bfhi(bv.x), bflo(bv.y), bfhi(bv.y)}; c = acc[ai][bj][m][1] + (f32x4){bflo(bv.z), bfhi(bv.z), bflo(bv.w), bfhi(bv.w)}; }
                        ss += ssq8(a, c);
                        *(u32x4*)(hb + off) = pack8(a, c); }
                    ss = red_fq(ss);
                    if (fq == 0) sq[row * 16 + u.pn * 4 + wc] = ss; }
        } break;
        case EK_XQ: {
            bf16_t* dst = (bf16_t*)p0; float* sq = (float*)p1; const float* gq = (const float*)c0; const float* gk = (const float*)c1;
            f32x4 gg[2][2];
#pragma unroll
            for (int bj = 0; bj < 2; ++bj)
#pragma unroll
                for (int n = 0; n < 2; ++n) gg[bj][n] = *(const f32x4*)(gq + bj * 128 + cl0 + 4 * n) * *(const f32x4*)(gk + bj * 128 + cl0 + 4 * n);
#pragma unroll
            for (int ai = 0; ai < 2; ++ai)
#pragma unroll
                for (int m = 0; m < 4; ++m) { const size_t row = (size_t)(rbase + ai * 128 + m * 16);
                    float ss = ssq8(acc[ai][0][m][0], acc[ai][0][m][1]) + ssq8(acc[ai][1][m][0], acc[ai][1][m][1]);
                    ss = red_fq(ss);
                    if (fq == 0) sq[row * 16 + u.pn * 4 + wc] = ss;
#pragma unroll
                    for (int bj = 0; bj < 2; ++bj) *(u32x4*)(dst + row * DM + u.pn * 256 + bj * 128 + cl0) = pack8(acc[ai][bj][m][0] * gg[bj][0], acc[ai][bj][m][1] * gg[bj][1]); }
        } break;
        case EK_XS: {
            bf16_t* dst = (bf16_t*)p0; float* ps = (float*)p1; const float* s1 = (const float*)c0; const float* sqq = (const float*)c1; const float* sck = (const float*)c2;
            const int h = u.pn, b = u.pm >> 3;
            f32x4 kv[2][2];
#pragma unroll
            for (int bj = 0; bj < 2; ++bj)
#pragma unroll
                for (int n = 0; n < 2; ++n) kv[bj][n] = *(const f32x4*)(sck + (size_t)h * TM + b * 256 + bj * 128 + cl0 + 4 * n) * (LOG2E / 16.f);
#pragma unroll
            for (int ai = 0; ai < 2; ++ai)
#pragma unroll
                for (int m = 0; m < 4; ++m) { const size_t row = (size_t)(rbase + ai * 128 + m * 16);
                    const f32x4 t0 = *(const f32x4*)(s1 + row * 16), t1 = *(const f32x4*)(s1 + row * 16 + 4), t2 = *(const f32x4*)(s1 + row * 16 + 8), t3 = *(const f32x4*)(s1 + row * 16 + 12);
                    const float tot = ((t0[0] + t0[1]) + (t0[2] + t0[3])) + ((t1[0] + t1[1]) + (t1[2] + t1[3])) + ((t2[0] + t2[1]) + (t2[2] + t2[3])) + ((t3[0] + t3[1]) + (t3[2] + t3[3]));
                    const float rs1 = rsqrtf(tot * (1.f / DM) + EPS);
                    const f32x4 qq = *(const f32x4*)(sqq + row * 16 + h * 4);
                    const float sq = rs1 * rsqrtf(rs1 * rs1 * ((qq[0] + qq[1]) + (qq[2] + qq[3])) * (1.f / 256.f) + EPS);
                    float ss = 0.f;
#pragma unroll
                    for (int bj = 0; bj < 2; ++bj) { f32x4 a = acc[ai][bj][m][0] * kv[bj][0] * sq, c = acc[ai][bj][m][1] * kv[bj][1] * sq;
#pragma unroll
                        for (int j = 0; j < 4; ++j) { a[j] = __builtin_amdgcn_exp2f(a[j]); c[j] = __builtin_amdgcn_exp2f(c[j]); }
                        const u32x4 w = pack8(a, c);
                        ss += (bflo(w.x) + bfhi(w.x)) + (bflo(w.y) + bfhi(w.y)) + (bflo(w.z) + bfhi(w.z)) + (bflo(w.w) + bfhi(w.w));
                        *(u32x4*)(dst + row * DM + h * 256 + bj * 128 + cl0) = w; }
                    ss = red_fq(ss);
                    if (fq == 0) ps[row * 16 + h * 4 + wc] = ss; }
        } break;
        case EK_XO: {
            bf16_t* dst = (bf16_t*)p0; const float* ps = (const float*)c0; const int h = u.pn;
#pragma unroll
            for (int ai = 0; ai < 2; ++ai)
#pragma unroll
                for (int m = 0; m < 4; ++m) { const size_t row = (size_t)(rbase + ai * 128 + m * 16);
                    const f32x4 pp = *(const f32x4*)(ps + row * 16 + h * 4); const float inv = 1.f / ((pp[0] + pp[1]) + (pp[2] + pp[3]));
#pragma unroll
                    for (int bj = 0; bj < 2; ++bj) *(u32x4*)(dst + row * DM + h * 256 + bj * 128 + cl0) = pack8(acc[ai][bj][m][0] * inv, acc[ai][bj][m][1] * inv); }
        } break;
        case EK_DOWN: {
            float* out = (float*)p0; const bf16_t* h2 = (const bf16_t*)c0;
#pragma unroll
            for (int ai = 0; ai < 2; ++ai)
#pragma unroll
                for (int m = 0; m < 4; ++m) { const size_t row = (size_t)(rbase + ai * 128 + m * 16);
#pragma unroll
                    for (int bj = 0; bj < 2; ++bj) { const size_t off = row * DM + u.pn * 256 + bj * 128 + cl0;
                        const u32x4 bv = *(const u32x4*)(h2 + off);
                        const f32x4 a = acc[ai][bj][m][0] + (f32x4){bflo(bv.x), bfhi(bv.x), bflo(bv.y), bfhi(bv.y)}, c = acc[ai][bj][m][1] + (f32x4){bflo(bv.z), bfhi(bv.z), bflo(bv.w), bfhi(bv.w)};
                        *(f32x4*)(out + off) = a; *(f32x4*)(out + off + 4) = c; } }
        } break;
        case EK_UPC: {
            bf16_t* A = (bf16_t*)p0; float* GHF = (float*)p1; float* GHL = (float*)p2; float* UH = (float*)p3; const float* s2 = (const float*)c0; const float* cw = (const float*)c1; const float* cbv = (const float*)c2;
            const int j0 = u.pn * 128 + cl0;
            float w0[8], w1[8], w2[8], bb[8];
#pragma unroll
            for (int i = 0; i < 2; ++i) { const f32x4 a0 = *(const f32x4*)(cw + j0 + 4 * i), a1 = *(const f32x4*)(cw + DFF + j0 + 4 * i), a2 = *(const f32x4*)(cw + 2 * DFF + j0 + 4 * i), a3 = *(const f32x4*)(cbv + j0 + 4 * i);
#pragma unroll
                for (int q = 0; q < 4; ++q) { w0[4 * i + q] = a0[q]; w1[4 * i + q] = a1[q]; w2[4 * i + q] = a2[q]; bb[4 * i + q] = a3[q]; } }
            float rsv[2][4];
#pragma unroll
            for (int ai = 0; ai < 2; ++ai)
#pragma unroll
                for (int m = 0; m < 4; ++m) rsv[ai][m] = s2[rbase + ai * 128 + m * 16];
            if (fr >= 14) {
#pragma unroll
                for (int ai = 0; ai < 2; ++ai) { const f32x4 g0 = acc[ai][0][3][0] * rsv[ai][3], g1 = acc[ai][0][3][1] * rsv[ai][3];
                    LAS float* hp = hx + ((ai * 2 + wr) * 2 + (fr - 14)) * 128 + cl0; *(LAS f32x4*)hp = g0; *(LAS f32x4*)(hp + 4) = g1;
                    if (ai == 1 && wr == 1) { float* gp = GHL + ((size_t)u.pm * 2 + (fr - 14)) * DFF + j0; *(f32x4*)gp = g0; *(f32x4*)(gp + 4) = g1; } } }
            if (wr == 0 && fr < 2) {
                const float rs = rsv[0][0]; float* gp = GHF + ((size_t)u.pm * 2 + fr) * DFF + j0; float* up = UH + ((size_t)u.pm * 2 + fr) * DFF + j0;
                *(f32x4*)gp = acc[0][0][0][0] * rs; *(f32x4*)(gp + 4) = acc[0][0][0][1] * rs; *(f32x4*)up = acc[0][1][0][0] * rs; *(f32x4*)(up + 4) = acc[0][1][0][1] * rs; }
            asm volatile("s_waitcnt lgkmcnt(0)" ::: "memory"); __builtin_amdgcn_s_barrier(); asm volatile("" ::: "memory");
#define ROR1(x) __builtin_bit_cast(float, __builtin_amdgcn_update_dpp(0, __builtin_bit_cast(int, (x)), 0x121, 0xF, 0xF, false))
#define ROR2(x) __builtin_bit_cast(float, __builtin_amdgcn_update_dpp(0, __builtin_bit_cast(int, (x)), 0x122, 0xF, 0xF, false))
#pragma unroll
            for (int ai = 0; ai < 2; ++ai) {
                const int grp = ai * 2 + wr;
                float p1v[8], p2v[8];
                { f32x4 h1a = (f32x4){0.f, 0.f, 0.f, 0.f}, h1b = h1a, h2a = h1a, h2b = h1a;
                  if (grp > 0) { const LAS float* hp = hx + ((grp - 1) * 2) * 128 + cl0; h2a = *(const LAS f32x4*)hp; h2b = *(const LAS f32x4*)(hp + 4); h1a = *(const LAS f32x4*)(hp + 128); h1b = *(const LAS f32x4*)(hp + 132); }
#pragma unroll
                  for (int i = 0; i < 4; ++i) { p1v[i] = h1a[i]; p1v[4 + i] = h1b[i]; p2v[i] = (fr == 0) ? h2a[i] : h1a[i]; p2v[4 + i] = (fr == 0) ? h2b[i] : h1b[i]; } }
#pragma unroll
                for (int m = 0; m < 4; ++m) { const float rs = rsv[ai][m]; const size_t row = (size_t)(rbase + ai * 128 + m * 16);
                    float gs[8], r[8];
#pragma unroll
                    for (int i = 0; i < 4; ++i) { gs[i] = acc[ai][0][m][0][i] * rs; gs[4 + i] = acc[ai][0][m][1][i] * rs; }
#pragma unroll
                    for (int i = 0; i < 8; ++i) { const float c1v = ROR1(gs[i]), c2v = ROR2(gs[i]);
                        const float g1 = (fr == 0) ? p1v[i] : c1v, g2 = (fr < 2) ? p2v[i] : c2v;
                        p1v[i] = c1v; p2v[i] = c2v;
                        const float z = bb[i] + w0[i] * g2 + w1[i] * g1 + w2[i] * gs[i];
                        const float uv = (i < 4 ? acc[ai][1][m][0][i & 3] : acc[ai][1][m][1][i & 3]) * rs;
                        r[i] = z * sigm(z) * uv; }
                    u32x4 o; o.x = pk2(r[0], r[1]); o.y = pk2(r[2], r[3]); o.z = pk2(r[4], r[5]); o.w = pk2(r[6], r[7]);
                    if (!(grp == 0 && m == 0 && fr < 2)) *(u32x4*)(A + row * DFF + j0) = o; } }
#undef ROR1
#undef ROR2
        } break;
        default: break;
        }
    }
};

namespace attn_body {
using bf16=__hip_bfloat16;
using s16x4=__attribute__((ext_vector_type(4)))short;
using f32x16=__attribute__((ext_vector_type(16)))float;
constexpr int NHEAD=NFH,D=64,ADM=NHEAD*D,OPITCH=1024;
constexpr int NW=8,QBLK=32,QB=QBLK*NW,KVBLK=64,NQB=SEQ/QB;
__device__ __forceinline__ int crow(int r,int hi){return (r&3)+8*(r>>2)+4*hi;}
#define SBAR() __builtin_amdgcn_sched_barrier(0)
__device__ __forceinline__ void cmask(f32x16&p0,f32x16&p1,int jb,int qrel,int hi){
  const float NEG=-INFINITY; int kb=64*jb+4*hi;
  #pragma unroll
  for(int r=0;r<16;++r){int kv=kb+(r&3)+8*(r>>2); if(kv>qrel)p0[r]=NEG; if(kv+32>qrel)p1[r]=NEG;}
}
constexpr int NSLOT=3, SLOTB=8192;
constexpr int LDS_K=0, LDS_V=NSLOT*SLOTB, LDS_WS=2*NSLOT*SLOTB, LDS_OST=LDS_WS+NW*64*4, LDS_BYTES=LDS_OST+NW*4096;
constexpr int LDS_BIAS=86016;
__device__ __forceinline__ void glds16(const void*gsrc,unsigned lds_dst){unsigned keep;
  asm volatile("s_mov_b32 %0, m0\n\ts_mov_b32 m0, %2\n\ts_nop 0\n\tglobal_load_lds_dwordx4 %1, off\n\ts_mov_b32 m0, %0":"=&s"(keep):"v"(gsrc),"s"(lds_dst):"memory");}
__device__ __forceinline__ float max3f(float a,float b,float c){float r;asm("v_max3_f32 %0, %1, %2, %3":"=v"(r):"v"(a),"v"(b),"v"(c));return r;}
__device__ __forceinline__ float max2f(float a,float b){float r;asm("v_max_f32_e32 %0, %1, %2":"=v"(r):"v"(a),"v"(b));return r;}
__device__ __forceinline__ float fadd_s(float a,float b){float r;asm("v_add_f32_e32 %0, %1, %2":"=v"(r):"v"(a),"v"(b));return r;}
__device__ __forceinline__ float fsub_s(float a,float b){float r;asm("v_sub_f32_e32 %0, %1, %2":"=v"(r):"v"(a),"v"(b));return r;}
typedef float f32x2_t __attribute__((ext_vector_type(2))); typedef __bf16 bf16x2_t __attribute__((ext_vector_type(2)));
__device__ __forceinline__ unsigned cvtpk_s(float lo,float hi){f32x2_t v={lo,hi};bf16x2_t b=__builtin_convertvector(v,bf16x2_t);return __builtin_bit_cast(unsigned,b);}
#define WAIT_BAR(N) asm volatile("s_waitcnt vmcnt(" #N ") lgkmcnt(0)\n\ts_barrier":::"memory")

__device__ __forceinline__ void qkt(f32x16&p0,f32x16&p1,const char*Kslot,const bf16x8*qr,const f32x16&negm,int r32,int hi){
  const char*kb=Kslot+hi*1024+r32*16;
  #pragma unroll
  for(int d0=0;d0<4;++d0){
    const bf16x8 b0=*reinterpret_cast<const bf16x8*>(kb+d0*2048);
    const bf16x8 b1=*reinterpret_cast<const bf16x8*>(kb+d0*2048+512);
    if(d0==0){p0=__builtin_amdgcn_mfma_f32_32x32x16_bf16(b0,qr[0],negm,0,0,0);p1=__builtin_amdgcn_mfma_f32_32x32x16_bf16(b1,qr[0],negm,0,0,0);}
    else{p0=__builtin_amdgcn_mfma_f32_32x32x16_bf16(b0,qr[d0],p0,0,0,0);p1=__builtin_amdgcn_mfma_f32_32x32x16_bf16(b1,qr[d0],p1,0,0,0);}}
}
typedef __attribute__((address_space(3))) const char* lds_cptr;
typedef short v4i16_t __attribute__((ext_vector_type(4)));
__device__ __forceinline__ void kload8(bf16x8*kf,lds_cptr kp){
  kf[0]=*(const __attribute__((address_space(3))) bf16x8*)(kp);      kf[1]=*(const __attribute__((address_space(3))) bf16x8*)(kp+512);
  kf[2]=*(const __attribute__((address_space(3))) bf16x8*)(kp+2048); kf[3]=*(const __attribute__((address_space(3))) bf16x8*)(kp+2560);
  kf[4]=*(const __attribute__((address_space(3))) bf16x8*)(kp+4096); kf[5]=*(const __attribute__((address_space(3))) bf16x8*)(kp+4608);
  kf[6]=*(const __attribute__((address_space(3))) bf16x8*)(kp+6144); kf[7]=*(const __attribute__((address_space(3))) bf16x8*)(kp+6656);
}
__device__ __forceinline__ void kload2(bf16x8*kf,lds_cptr kp,int j){ kf[2*j]=*(const __attribute__((address_space(3))) bf16x8*)(kp+j*2048); kf[2*j+1]=*(const __attribute__((address_space(3))) bf16x8*)(kp+j*2048+512); }
__device__ __forceinline__ s16x4 vtr(lds_cptr p){ return __builtin_bit_cast(s16x4,__builtin_amdgcn_ds_read_tr16_b64_v4i16((__attribute__((address_space(3))) v4i16_t*)p)); }
__device__ __forceinline__ float rowmax(const f32x16&p0,const f32x16&p1){
  float a=max3f(p0[0],p0[1],p1[0]),b=max3f(p0[2],p0[3],p1[1]);a=max3f(a,p1[2],p1[3]);
  #pragma unroll
  for(int r=4;r<16;r+=4){a=max3f(a,p0[r],p0[r+1]);b=max3f(b,p0[r+2],p0[r+3]);a=max3f(a,p1[r],p1[r+1]);b=max3f(b,p1[r+2],p1[r+3]);}
  const float m=max2f(a,b);
  auto rr=__builtin_amdgcn_permlane32_swap(__float_as_uint(m),__float_as_uint(m),false,false);
  return max2f(__uint_as_float(rr[0]),__uint_as_float(rr[1]));
}
__device__ __forceinline__ void pv(f32x16*o,int vb,bf16x8 pa0,bf16x8 pa1,bf16x8 pa2,bf16x8 pa3){
  #pragma unroll
  for(int d0=0;d0<2;++d0){s16x4 lo[4],hi[4];
    #pragma unroll
    for(int ks=0;ks<4;++ks){
      asm volatile("ds_read_b64_tr_b16 %0,%1 offset:%c2":"=&v"(lo[ks]):"v"(vb),"i"(d0*4096+ks*1024):"memory");
      asm volatile("ds_read_b64_tr_b16 %0,%1 offset:%c2":"=&v"(hi[ks]):"v"(vb),"i"(d0*4096+ks*1024+512):"memory");}
    asm volatile("s_waitcnt lgkmcnt(0)":::"memory");SBAR();
    #define PK(k) (bf16x8){lo[k][0],lo[k][1],lo[k][2],lo[k][3],hi[k][0],hi[k][1],hi[k][2],hi[k][3]}
    o[d0]=__builtin_amdgcn_mfma_f32_32x32x16_bf16(pa0,PK(0),o[d0],0,0,0);
    o[d0]=__builtin_amdgcn_mfma_f32_32x32x16_bf16(pa1,PK(1),o[d0],0,0,0);
    o[d0]=__builtin_amdgcn_mfma_f32_32x32x16_bf16(pa2,PK(2),o[d0],0,0,0);
    o[d0]=__builtin_amdgcn_mfma_f32_32x32x16_bf16(pa3,PK(3),o[d0],0,0,0);
    #undef PK
  }
}
typedef const __attribute__((address_space(3))) f32x4* lds_f4ptr;
#define BIASADD(P0,P1,t) do{ const lds_f4ptr bp_=(lds_f4ptr)(shm3+bias_off+((t)*64+4*hi)*4); \
    _Pragma("unroll") for(int j_=0;j_<4;++j_){ const f32x4 b0_=bp_[2*j_]-mhat, b1_=bp_[8+2*j_]-mhat; \
      P0[4*j_]+=b0_[0]; P0[4*j_+1]+=b0_[1]; P0[4*j_+2]+=b0_[2]; P0[4*j_+3]+=b0_[3]; \
      P1[4*j_]+=b1_[0]; P1[4*j_+1]+=b1_[1]; P1[4*j_+2]+=b1_[2]; P1[4*j_+3]+=b1_[3]; } }while(0)

#define CINIT(P0,P1,t) do{ const lds_f4ptr bp_=(lds_f4ptr)(shm3+bias_off+((t)*64+4*hi)*4); \
    _Pragma("unroll") for(int j_=0;j_<4;++j_){ const f32x4 b0_=bp_[2*j_]-mhat, b1_=bp_[8+2*j_]-mhat; \
      P0[4*j_]=b0_[0]; P0[4*j_+1]=b0_[1]; P0[4*j_+2]=b0_[2]; P0[4*j_+3]=b0_[3]; \
      P1[4*j_]=b1_[0]; P1[4*j_+1]=b1_[1]; P1[4*j_+2]=b1_[2]; P1[4*j_+3]=b1_[3]; } }while(0)
template<int THRL> __device__ __forceinline__ void attn_unit(int b,int h,int qb,const bf16*Q,const bf16*__restrict__ K,const bf16*__restrict__ V,bf16*O,const float*__restrict__ CB,float*__restrict__ SSQ,char*shm,const float skip_th){
  int tid=threadIdx.x; asm volatile("":"+v"(tid));
  const int lane=tid&63,r32=lane&31,hi=lane>>5; const int wid=__builtin_amdgcn_readfirstlane(tid>>6);
  const long rowbase=(long)b*SEQ; const int q0=qb*QB;
  const bf16*Qw=Q+(rowbase+q0+wid*QBLK)*ADM+h*D;
  int t0=0; { const float*cbh0=CB+(long)(b*NHEAD+h)*SEQ; const int npair=(q0+QB)/KVBLK/2-2; const float c0v=cbh0[q0];
    const bool far=(lane<npair)&&(cbh0[128*(lane<npair?lane:0)+127]-c0v>skip_th); const unsigned long long mk=__ballot(far);
    int lead=__builtin_ctzll(~mk); if(lead>npair)lead=npair; if(lead<0)lead=0; t0=2*__builtin_amdgcn_readfirstlane(lead); }
  const bf16*Kh=K+(rowbase+(long)t0*KVBLK)*ADM+h*D,*Vh=V+(rowbase+(long)t0*KVBLK)*ADM+h*D;
  const unsigned lds0=(unsigned)(uintptr_t)shm;
  float*wsf=(float*)(shm+LDS_WS)+wid*64;
  const lds_cptr shm3=(lds_cptr)shm;
  { const float*cbh=CB+(long)(b*NHEAD+h)*SEQ; const float cref=cbh[q0+128];
    if(tid*4<q0+QB){ const f32x4 c4=*(const f32x4*)(cbh+tid*4); *(__attribute__((address_space(3))) f32x4*)(shm3+LDS_BIAS+tid*16)=(f32x4){cref-c4[0],cref-c4[1],cref-c4[2],cref-c4[3]}; } }
  const bf16*ksrc=Kh+(long)lane*ADM+wid*8;
  const bf16*vsrc=Vh+(long)(16*(wid&3)+(lane>>2))*ADM+(wid>>2)*32+(lane&3)*8;
  const unsigned kdst=lds0+LDS_K+wid*1024, vdst=lds0+LDS_V+wid*1024;
  #define DMA_K(t,slot) glds16(ksrc+(long)(t)*KVBLK*ADM,(unsigned)__builtin_amdgcn_readfirstlane(kdst+(slot)))
  #define DMA_V(t,slot) glds16(vsrc+(long)(t)*KVBLK*ADM,(unsigned)__builtin_amdgcn_readfirstlane(vdst+(slot)))
  const int vb0=(int)(lds0+LDS_V)+((lane>>4)&1)*32+(lane&3)*8+(4*hi+((lane&15)>>2))*64;
  const char*Kbase=shm+LDS_K; bf16x8 kf[8];
  const lds_cptr kp0=shm3+LDS_K+hi*1024+r32*16; const lds_cptr vp0=shm3+LDS_V+((lane>>4)&1)*32+(lane&3)*8+(4*hi+((lane&15)>>2))*64;
  const int NT=(q0+QB)/KVBLK-t0; const int bias_off=LDS_BIAS+t0*KVBLK*4;
  DMA_K(0,0);DMA_V(0,0);DMA_K(1,SLOTB);
  bf16x8 qr[4];
  #pragma unroll
  for(int d0=0;d0<4;++d0)qr[d0]=*reinterpret_cast<const bf16x8*>(&Qw[(long)r32*ADM+d0*16+hi*8]);
  float mhat=0.f,l_reg=0.f;f32x16 o[2];o[0]=f32x16{};o[1]=f32x16{};const f32x16 negm=f32x16{};
  const int qrel=wid*QBLK+r32;
  #define CMASK(P0,P1,t) do{int jb_=(t)-(NT-4); if(jb_>=0)cmask(P0,P1,jb_,qrel,hi);}while(0)
  bool resc=false;
  #define START(P0,P1) do{ const float rm=rowmax(P0,P1); resc=false; \
    { const float dl=max2f(rm,-24.f); mhat=fadd_s(mhat,dl); \
      _Pragma("unroll") for(int r=0;r<16;++r){P0[r]=fsub_s(P0[r],dl);P1[r]=fsub_s(P1[r],dl);} } \
    _Pragma("unroll") for(int r=0;r<16;++r)P0[r]=__builtin_amdgcn_exp2f(P0[r]); }while(0)
  #define RESC() do{ if(resc){ asm volatile("s_waitcnt lgkmcnt(0)":::"memory"); \
      _Pragma("unroll") for(int d_=0;d_<2;++d_) _Pragma("unroll") for(int r=0;r<16;++r)o[d_][r]*=wsf[crow(r,hi)]; } }while(0)
  f32x16 pA0,pA1,pB0,pB1;
  int sl_prev=0,sl_cur=0,sl_next=SLOTB;
  #define ROT() do{sl_prev=sl_cur;sl_cur=sl_next;sl_next=(sl_next==(NSLOT-1)*SLOTB)?0:sl_next+SLOTB;}while(0)
  DMA_K(2,2*SLOTB);
  WAIT_BAR(3);
  qkt(pA0,pA1,Kbase,qr,negm,r32,hi);asm volatile("s_nop 15\n\ts_nop 7":"+v"(pA0),"+v"(pA1));BIASADD(pA0,pA1,0);CMASK(pA0,pA1,0);
  START(pA0,pA1);
  _Pragma("unroll") for(int r=0;r<16;++r)pA1[r]=__builtin_amdgcn_exp2f(pA1[r]);
  WAIT_BAR(0);
  DMA_K(3,0);DMA_V(1,SLOTB);
  ROT();
  kload8(kf,kp0+sl_cur);
  WAIT_BAR(2);
  s16x4 vlo[8],vhi[8]; u32x4 pw0,pw1,pw2,pw3;
  #define PKW(P,B) cvtpk_s(P[B],P[B+1])
  #define PAF(k) __builtin_bit_cast(bf16x8,pw##k)
  #define VFR(i) (bf16x8){vlo[i][0],vlo[i][1],vlo[i][2],vlo[i][3],vhi[i][0],vhi[i][1],vhi[i][2],vhi[i][3]}
  #define PIN(x) asm volatile("":"+v"(x))
  #define MX3(a,b,c) __builtin_fmaxf(__builtin_fmaxf((a),(b)),(c))
  #define GAPA(MF,A0,A1,A2,A3,W0,W1,PW) do{ MF; sacc+=A0; sacc+=A1; sacc+=A2; sacc+=A3; PIN(sacc); W0; W1; PIN(PW); SBAR(); }while(0)
  #define EX(v) __builtin_amdgcn_exp2f(v)
  #define GAPB(MF,X,B) do{ MF; X[B]=EX(X[B]); X[B+1]=EX(X[B+1]); X[B+2]=EX(X[B+2]); X[B+3]=EX(X[B+3]); PIN(X); SBAR(); }while(0)
  #define VRD(i) do{ vlo[i]=vtr(vp_+(((i)>>2)*4096+((i)&3)*1024)); vhi[i]=vtr(vp_+(((i)>>2)*4096+((i)&3)*1024+512)); }while(0)
  #define KRD(G,j) do{ if(G){ kload2(kf,kp0+sl_next,j); SBAR(); } }while(0)
  #define STEP(C0,C1,P0,P1,t,GK,GV,GL) do{ SBAR(); CINIT(C0,C1,t); SBAR(); \
    const lds_cptr vp_=vp0+sl_prev; \
    VRD(0); SBAR(); float sacc=(P0[0]+P0[1]); \
    GAPA(C0=__builtin_amdgcn_mfma_f32_32x32x16_bf16(kf[0],qr[0],C0,0,0,0), P0[2],P0[3],P0[4],P0[5],     pw0[0]=PKW(P0,0), pw0[1]=PKW(P0,2), pw0); \
    VRD(4); SBAR(); GAPA(C1=__builtin_amdgcn_mfma_f32_32x32x16_bf16(kf[1],qr[0],C1,0,0,0), P0[6],P0[7],P0[8],P0[9],     pw0[2]=PKW(P0,4), pw0[3]=PKW(P0,6), pw0); \
    VRD(1); SBAR(); GAPA(C0=__builtin_amdgcn_mfma_f32_32x32x16_bf16(kf[2],qr[1],C0,0,0,0),   P0[10],P0[11],P0[12],P0[13], pw1[0]=PKW(P0,8), pw1[1]=PKW(P0,10), pw1); \
    VRD(5); SBAR(); GAPA(C1=__builtin_amdgcn_mfma_f32_32x32x16_bf16(kf[3],qr[1],C1,0,0,0),   P0[14],P0[15],P1[0],P1[1],   pw1[2]=PKW(P0,12),pw1[3]=PKW(P0,14), pw1); \
    VRD(2); SBAR(); GAPA(C0=__builtin_amdgcn_mfma_f32_32x32x16_bf16(kf[4],qr[2],C0,0,0,0),   P1[2],P1[3],P1[4],P1[5],     pw2[0]=PKW(P1,0), pw2[1]=PKW(P1,2), pw2); \
    VRD(6); SBAR(); GAPA(C1=__builtin_amdgcn_mfma_f32_32x32x16_bf16(kf[5],qr[2],C1,0,0,0),   P1[6],P1[7],P1[8],P1[9],     pw2[2]=PKW(P1,4), pw2[3]=PKW(P1,6), pw2); \
    VRD(3); SBAR(); GAPA(C0=__builtin_amdgcn_mfma_f32_32x32x16_bf16(kf[6],qr[3],C0,0,0,0),   P1[10],P1[11],P1[12],P1[13], pw3[0]=PKW(P1,8), pw3[1]=PKW(P1,10), pw3); \
    VRD(7); SBAR(); GAPA(C1=__builtin_amdgcn_mfma_f32_32x32x16_bf16(kf[7],qr[3],C1,0,0,0),   P1[14],P1[15],0.f,0.f,       pw3[2]=PKW(P1,12),pw3[3]=PKW(P1,14), pw3); \
    l_reg+=sacc; \
    if(GK){DMA_K((t)+3,sl_cur);} if(GV){DMA_V((t)+1,sl_next);} \
    CMASK(C0,C1,t); \
    { float a=MX3(C0[0],C0[1],C1[0]),b=MX3(C0[2],C0[3],C1[1]); a=MX3(a,C1[2],C1[3]); \
      _Pragma("unroll") for(int r=4;r<16;r+=4){a=MX3(a,C0[r],C0[r+1]);b=MX3(b,C0[r+2],C0[r+3]);a=MX3(a,C1[r],C1[r+1]);b=MX3(b,C1[r+2],C1[r+3]);} \
      float rm=__builtin_fmaxf(a,b); { auto rr=__builtin_amdgcn_permlane32_swap(__float_as_uint(rm),__float_as_uint(rm),false,false); rm=__builtin_fmaxf(__uint_as_float(rr[0]),__uint_as_float(rr[1])); } \
      resc=false; \
      if(__builtin_expect(__any(rm>(float)THRL),0)){ const float dl=__builtin_fmaxf(rm,0.f); mhat+=dl; \
        _Pragma("unroll") for(int r=0;r<16;++r){C0[r]-=dl;C1[r]-=dl;} \
        const float f=__builtin_amdgcn_exp2f(-dl); l_reg*=f; if(hi==0)wsf[r32]=f; resc=true; } } \
    SBAR(); \
    GAPB(o[0]=__builtin_amdgcn_mfma_f32_32x32x16_bf16(PAF(0),VFR(0),o[0],0,0,0), C0,0); \
    GAPB(o[1]=__builtin_amdgcn_mfma_f32_32x32x16_bf16(PAF(0),VFR(4),o[1],0,0,0), C0,4); \
    KRD(GL,0); GAPB(o[0]=__builtin_amdgcn_mfma_f32_32x32x16_bf16(PAF(1),VFR(1),o[0],0,0,0), C0,8); \
    KRD(GL,1); GAPB(o[1]=__builtin_amdgcn_mfma_f32_32x32x16_bf16(PAF(1),VFR(5),o[1],0,0,0), C0,12); \
    KRD(GL,2); GAPB(o[0]=__builtin_amdgcn_mfma_f32_32x32x16_bf16(PAF(2),VFR(2),o[0],0,0,0), C1,0); \
    KRD(GL,3); GAPB(o[1]=__builtin_amdgcn_mfma_f32_32x32x16_bf16(PAF(2),VFR(6),o[1],0,0,0), C1,4); \
    GAPB(o[0]=__builtin_amdgcn_mfma_f32_32x32x16_bf16(PAF(3),VFR(3),o[0],0,0,0), C1,8); \
    GAPB(o[1]=__builtin_amdgcn_mfma_f32_32x32x16_bf16(PAF(3),VFR(7),o[1],0,0,0), C1,12); \
    }while(0)
  int t=1;
  #undef CMASK
  #define CMASK(P0,P1,t) do{}while(0)
  for(;t+5<NT;t+=2){
    STEP(pB0,pB1,pA0,pA1,t,true,true,true);     WAIT_BAR(2); RESC(); ROT();
    STEP(pA0,pA1,pB0,pB1,t+1,true,true,true);   WAIT_BAR(2); RESC(); ROT();
  }
  #undef CMASK
  #define CMASK(P0,P1,t) do{int jb_=(t)-(NT-4); if(jb_>=0)cmask(P0,P1,jb_,qrel,hi);}while(0)
  #define ENDW(tt) do{ if((tt)+3<NT){WAIT_BAR(2);} else if((tt)+2<NT){WAIT_BAR(1);} else {WAIT_BAR(0);} }while(0)
  for(;t+1<NT;t+=2){
    STEP(pB0,pB1,pA0,pA1,t,(t+3<NT),(t+1<NT),(t+1<NT));       ENDW(t);   RESC(); ROT();
    STEP(pA0,pA1,pB0,pB1,t+1,(t+4<NT),(t+2<NT),(t+2<NT));     ENDW(t+1); RESC(); ROT();
  }
  STEP(pB0,pB1,pA0,pA1,NT-1,false,false,false); RESC();
  { float sacc=pB0[0]+pB0[1]; _Pragma("unroll") for(int r=2;r<16;++r)sacc+=pB0[r]; _Pragma("unroll") for(int r=0;r<16;++r)sacc+=pB1[r]; l_reg+=sacc;
    pw0=(u32x4){PKW(pB0,0),PKW(pB0,2),PKW(pB0,4),PKW(pB0,6)};pw1=(u32x4){PKW(pB0,8),PKW(pB0,10),PKW(pB0,12),PKW(pB0,14)};pw2=(u32x4){PKW(pB1,0),PKW(pB1,2),PKW(pB1,4),PKW(pB1,6)};pw3=(u32x4){PKW(pB1,8),PKW(pB1,10),PKW(pB1,12),PKW(pB1,14)};
    SBAR(); pv(o,vb0+sl_cur,PAF(0),PAF(1),PAF(2),PAF(3)); }
  #undef PKW
  #undef PAF
  #undef VFR
  #undef PIN
  #undef MX3
  #undef GAPA
  #undef GAPB
  #undef EX
  #undef VRD
  #undef KRD
  #undef STEP
  #undef ENDW
  {auto rr=__builtin_amdgcn_permlane32_swap(__float_as_uint(l_reg),__float_as_uint(l_reg),false,false);l_reg=__uint_as_float(rr[0])+__uint_as_float(rr[1]);}
  if(hi==0)wsf[32+r32]=l_reg;asm volatile("s_waitcnt lgkmcnt(0)":::"memory");
  float rli[16];
  #pragma unroll
  for(int r=0;r<16;++r)rli[r]=__builtin_amdgcn_rcpf(wsf[32+crow(r,hi)]);
  int lane2=lane; asm volatile("":"+v"(lane2));
  bf16*Ow=O+(rowbase+q0+wid*QBLK)*OPITCH+h*D;
  { bf16*stg=(bf16*)(shm+LDS_OST)+wid*2048;
    #pragma unroll
    for(int r=0;r<16;++r){const int orow=crow(r,hi);
      #pragma unroll
      for(int d0=0;d0<2;++d0)stg[orow*64+d0*32+r32]=__float2bfloat16(o[d0][r]*rli[r]);}
    asm volatile("s_waitcnt lgkmcnt(0)":::"memory");
    #pragma unroll
    for(int i=0;i<4;++i){const int row=i*8+(lane2>>3),ch=lane2&7; const u32x4 v=*(const u32x4*)(stg+row*64+ch*8); *(u32x4*)(Ow+(long)row*OPITCH+ch*8)=v;
      float s=(bflo(v.x)*bflo(v.x)+bfhi(v.x)*bfhi(v.x))+(bflo(v.y)*bflo(v.y)+bfhi(v.y)*bfhi(v.y))+(bflo(v.z)*bflo(v.z)+bfhi(v.z)*bfhi(v.z))+(bflo(v.w)*bflo(v.w)+bfhi(v.w)*bfhi(v.w));
      s+=__shfl_xor(s,1); s+=__shfl_xor(s,2); s+=__shfl_xor(s,4);
      if(ch==0)SSQ[(rowbase+q0+wid*QBLK+row)*NHEAD+h]=s; } }
  asm volatile("s_waitcnt lgkmcnt(0)\n\ts_barrier":::"memory");
  #undef DMA_K
  #undef DMA_V
  #undef CMASK
  #undef START
  #undef RESC
  #undef ROT
}
#undef SBAR
#undef WAIT_BAR
}

constexpr int RING_BYTES = 131072;
constexpr int LDS_TOTAL = 147456;
struct Args { const float* in[32]; float* out; unsigned char* ws; };
typedef const float* const __attribute__((address_space(4)))* InTab;
enum In { I_X = 0, I_MEM, I_NORM_MIX, I_W_IN, I_FQN, I_FKN, I_FBIAS, I_ARE, I_AIM, I_LOGDT, I_BRE, I_BIM, I_CRE, I_CIM, I_D, I_WGLU, I_BGLU, I_ONF, I_ONS, I_WOUT,
          I_NCROSS, I_NMEM, I_WXQ, I_WXKV, I_XQN, I_XKN, I_WXO, I_NFFN, I_WUP, I_CONVW, I_CONVB, I_WDN };

struct TJob { const float* W; int ldw, col0, ncols, K; const float* kg; const float* kg2; bf16_t* WT; int mapid, rowoff, items; };
__device__ __forceinline__ int tmap(int mapid, int n, int rowoff) {
    if (mapid == 1) { const int part = n >> 9, f = n & 511, head = f >> 6, d = f & 63; return 512 * part + 256 * (head >> 2) + 128 * (d >> 5) + 32 * (head & 3) + (d & 31); }
    if (mapid == 2) { const int isup = n >= DFF ? 1 : 0; const int j = n - isup * DFF; return 256 * (j >> 7) + 128 * isup + (j & 127); }
    return rowoff + n;
}
__device__ __forceinline__ void transpose_item(const TJob& J, LAS float* scr, int item, int lane) {
    LAS unsigned* s32 = (LAS unsigned*)scr; const LAS unsigned short* s16 = (const LAS unsigned short*)scr;
    const int nblk = J.ncols / 128, kb = item / nblk, nb = item % nblk, k0 = 64 * kb, n0 = 128 * nb;
    const float* src = J.W + (size_t)k0 * J.ldw + J.col0 + n0 + 2 * lane;
    float gv = 1.f; if (J.kg) { const int k = k0 + lane; gv = (J.kg2 && k >= 512) ? J.kg2[k - 512] : J.kg[k]; }
#pragma unroll 16
    for (int kk = 0; kk < 64; ++kk) { f32x2 w = *(const f32x2*)(src + (size_t)kk * J.ldw);
        w = w * __builtin_bit_cast(float, __builtin_amdgcn_readlane(__builtin_bit_cast(int, gv), kk));
        s32[kk * 64 + lane] = pk2(w[0], w[1]); }
    asm volatile("s_waitcnt lgkmcnt(0)" ::: "memory");
    const int c = lane & 7;
#pragma unroll 4
    for (int j = 0; j < 16; ++j) { const int n = (lane >> 3) + 8 * j; const LAS unsigned short* s = s16 + (8 * c) * 128 + n;
        u32x4 o; o.x = (unsigned)s[0] | ((unsigned)s[128] << 16); o.y = (unsigned)s[256] | ((unsigned)s[384] << 16); o.z = (unsigned)s[512] | ((unsigned)s[640] << 16); o.w = (unsigned)s[768] | ((unsigned)s[896] << 16);
        *(u32x4*)(J.WT + (size_t)tmap(J.mapid, n0 + n, J.rowoff) * J.K + k0 + 8 * c) = o; }
    asm volatile("s_waitcnt lgkmcnt(0)" ::: "memory");
}
constexpr int NTJ = 11;
__device__ __forceinline__ void get_tjob(InTab in, unsigned char* ws, int j, TJob& J) {
    J.kg = nullptr; J.kg2 = nullptr; J.mapid = 0; J.rowoff = 0; J.col0 = 0;
    switch (j) {
    case 0: J.W = in[I_W_IN]; J.ldw = INCOLS; J.col0 = 0; J.ncols = 1024; J.K = 1024; J.WT = (bf16_t*)(ws + WS_WIN); J.mapid = 1; break;
    case 1: J.W = in[I_W_IN]; J.ldw = INCOLS; J.col0 = 1024; J.ncols = 512; J.K = 1024; J.WT = (bf16_t*)(ws + WS_WIN); J.rowoff = 1024; break;
    case 2: J.W = in[I_W_IN]; J.ldw = INCOLS; J.col0 = 1544; J.ncols = 512; J.K = 1024; J.WT = (bf16_t*)(ws + WS_WIN); J.rowoff = 1536; break;
    case 3: J.W = in[I_WGLU]; J.ldw = 512; J.ncols = 512; J.K = 512; J.WT = (bf16_t*)(ws + WS_WGLU); break;
    case 4: J.W = in[I_WOUT]; J.ldw = 1024; J.ncols = 1024; J.K = 1024; J.WT = (bf16_t*)(ws + WS_WOUT); J.kg = in[I_ONF]; J.kg2 = in[I_ONS]; break;
    case 5: J.W = in[I_WXQ]; J.ldw = 1024; J.ncols = 1024; J.K = 1024; J.WT = (bf16_t*)(ws + WS_WXQ); J.kg = in[I_NCROSS]; break;
    case 6: J.W = in[I_WXKV]; J.ldw = 2048; J.col0 = 0; J.ncols = 1024; J.K = 1024; J.WT = (bf16_t*)(ws + WS_WXK); break;
    case 7: J.W = in[I_WXKV]; J.ldw = 2048; J.col0 = 1024; J.ncols = 1024; J.K = 1024; J.WT = (bf16_t*)(ws + WS_WXV); break;
    case 8: J.W = in[I_WXO]; J.ldw = 1024; J.ncols = 1024; J.K = 1024; J.WT = (bf16_t*)(ws + WS_WXO); break;
    case 9: J.W = in[I_WUP]; J.ldw = 2 * DFF; J.ncols = 2 * DFF; J.K = 1024; J.WT = (bf16_t*)(ws + WS_WUP); J.kg = in[I_NFFN]; J.mapid = 2; break;
    default: J.W = in[I_WDN]; J.ldw = 1024; J.ncols = 1024; J.K = DFF; J.WT = (bf16_t*)(ws + WS_WDN); break;
    }
    J.items = (J.K / 64) * (J.ncols / 128);
}

__device__ __forceinline__ void rms_row(const float* xrow, const float* gain, bf16_t* orow, int lane, f32x4 (&v)[4]) {
    const f32x4* xr = (const f32x4*)xrow + lane; float s = 0.f;
#pragma unroll
    for (int j = 0; j < 4; ++j) { v[j] = xr[64 * j]; s += (v[j][0] * v[j][0] + v[j][1] * v[j][1]) + (v[j][2] * v[j][2] + v[j][3] * v[j][3]); }
    const float rs = rsqrtf(wave_sum(s) * (1.f / DM) + EPS);
    u32x2* o8 = (u32x2*)orow + lane;
#pragma unroll
    for (int j = 0; j < 4; ++j) { v[j] = v[j] * rs * ((const f32x4*)gain)[64 * j + lane]; u32x2 w; w.x = pk2(v[j][0], v[j][1]); w.y = pk2(v[j][2], v[j][3]); o8[64 * j] = w; }
}

__device__ __forceinline__ void cpow(float ar, float ai, float dt, float e, float& r, float& i) {
    const float mag = __expf(ar * dt * e);
    float rev = ai * dt * e * 0.15915494309189535f; rev -= rintf(rev);
    const float ang = rev * 6.283185307179586f;
    r = mag * cosf(ang); i = mag * sinf(ang);
}

template <int NT>
__device__ __forceinline__ void s5_prep_task(InTab in, unsigned char* ws, int g, int tt, LAS float* L, int tid, bool valid) {
    LAS float* pwA = L; LAS float* pwB = L + 128; LAS float* pwC = L + 256; LAS float* cf = L + 384; LAS float* bb = L + 512; LAS float* cc = L + 512 + 2048;
    if (valid) {
        const float dt = __expf(in[I_LOGDT][g]);
        if (tid < 64) { const int p = tid; const float ar = in[I_ARE][g * 64 + p], ai = in[I_AIM][g * 64 + p];
            float r, i; cpow(ar, ai, dt, (float)tt, r, i); pwA[2 * p] = r; pwA[2 * p + 1] = i;
            cpow(ar, ai, dt, (float)(tt + 1), r, i); pwB[2 * p] = r; pwB[2 * p + 1] = i;
            cpow(ar, ai, dt, (float)(TC - 1 - tt), r, i); pwC[2 * p] = r; pwC[2 * p + 1] = i;
            float lr, li; cpow(ar, ai, dt, 1.f, lr, li);
            const float den = ar * ar + ai * ai, nr = lr - 1.f;
            cf[2 * p] = (nr * ar + li * ai) / den; cf[2 * p + 1] = (li * ar - nr * ai) / den;
            if (tt == 0) { cpow(ar, ai, dt, (float)TC, r, i); float* lb = (float*)(ws + WS_LB32); lb[(g * 64 + p) * 2] = r; lb[(g * 64 + p) * 2 + 1] = i; } }
        for (int idx = tid; idx < 1024; idx += NT) { cc[2 * idx] = in[I_CRE][g * 1024 + idx]; cc[2 * idx + 1] = in[I_CIM][g * 1024 + idx]; }
    }
    __syncthreads();
    if (valid)
        for (int idx = tid; idx < 1024; idx += NT) { const int p = idx >> 4; const float br = in[I_BRE][g * 1024 + idx], bi = in[I_BIM][g * 1024 + idx], cr = cf[2 * p], ci = cf[2 * p + 1];
            bb[2 * idx] = cr * br - ci * bi; bb[2 * idx + 1] = cr * bi + ci * br; }
    __syncthreads();
    if (valid) {
        for (int e = tid; e < 256; e += NT) {
            const int c = e >> 4, cp = e & 15; float s = 0.f;
            for (int p = 0; p < 64; ++p) { const float pr = pwA[2 * p], pi = pwA[2 * p + 1], br = bb[2 * (p * 16 + cp)], bi = bb[2 * (p * 16 + cp) + 1];
                const float mr = pr * br - pi * bi, mi = pr * bi + pi * br; s += cc[2 * (c * 64 + p)] * mr - cc[2 * (c * 64 + p) + 1] * mi; }
            if (tt == 0 && c == cp) s += in[I_D][g * 16 + c];
            ((float*)(ws + WS_KTAB))[((g * TC + tt) * 16 + c) * 16 + cp] = s; }
        bf16_t* bty = (bf16_t*)(ws + WS_BTY) + (size_t)g * 512 * UGP; bf16_t* bte = (bf16_t*)(ws + WS_BTE) + (size_t)g * 256 * 512;
        for (int idx = tid; idx < 1024; idx += NT) { const int c = idx >> 6, p = idx & 63;
            const float cr = cc[2 * idx], ci = cc[2 * idx + 1], pr = pwB[2 * p], pi = pwB[2 * p + 1];
            const float zr = cr * pr - ci * pi, zi = cr * pi + ci * pr;
            *(unsigned*)(bty + (size_t)(tt * 16 + c) * UGP + 512 + 2 * p) = pk2(zr, -zi); }
        for (int idx = tid; idx < 1024; idx += NT) { const int p = idx >> 4, cp = idx & 15;
            const float pr = pwC[2 * p], pi = pwC[2 * p + 1], br = bb[2 * idx], bi = bb[2 * idx + 1];
            bte[(size_t)(2 * p) * 512 + tt * 16 + cp] = (bf16_t)f2bf(pr * br - pi * bi); bte[(size_t)(2 * p + 1) * 512 + tt * 16 + cp] = (bf16_t)f2bf(pr * bi + pi * br); }
        for (int u = tid; u < 256; u += NT) *(u32x4*)(bte + (size_t)(128 + (u >> 1)) * 512 + tt * 16 + (u & 1) * 8) = (u32x4){0u, 0u, 0u, 0u};
    }
    __syncthreads();
}

#define RLX_AGENT __ATOMIC_RELAXED, __HIP_MEMORY_SCOPE_AGENT
#define XB_TMO      128
#define XB_XCNT(j)  (256  + 64 * (j))
#define XB_XSUB(j)  (1280 + 64 * (j))
#define XB_XGEN(j)  (2304 + 64 * (j))
#define XB_TOP      3328
#define XB_TOPGEN   3392
#define XCD_BAR_WORDS 3456
#define XB_SPIN_CAP (1u << 18)

__device__ __forceinline__ unsigned xb_ld(unsigned* p)              { return __hip_atomic_load(p, __ATOMIC_RELAXED, __HIP_MEMORY_SCOPE_AGENT); }
__device__ __forceinline__ unsigned xb_add(unsigned* p, unsigned v) { return __hip_atomic_fetch_add(p, v, __ATOMIC_RELAXED, __HIP_MEMORY_SCOPE_AGENT); }
__device__ __forceinline__ unsigned xb_xcc_id() { return (unsigned)__builtin_amdgcn_s_getreg((3 << 11) | 20) & 0xFu; }
#define XB_SPIN(cond, bar) do { unsigned _sp = 0; while (cond) { __builtin_amdgcn_s_sleep(1); \
    if ((++_sp & 255u) == 0u) { if (xb_ld(&(bar)[XB_TMO])) break; if (_sp > XB_SPIN_CAP) { atomicAdd(&(bar)[XB_TMO], 1u); break; } } } } while (0)

struct XcdBarrier {
    unsigned* bar; unsigned x;
    volatile LAS unsigned* st;
};

__device__ __forceinline__ XcdBarrier xcd_barrier_post(unsigned* bar, volatile LAS unsigned* st) {
    XcdBarrier b; b.bar = bar; b.x = xb_xcc_id(); b.st = st;
    if (threadIdx.x == 0) (void)xb_add(&bar[XB_XCNT(b.x)], 1u);
    return b;
}
__device__ __forceinline__ void xcd_barrier_complete(unsigned* bar, unsigned x, unsigned& nloc, unsigned& nx) {
    const unsigned G = gridDim.x * gridDim.y * gridDim.z;
    unsigned sum, cnt, mine, sp = 0u;
    for (;;) {
        sum = 0u; cnt = 0u; mine = 0u;
#pragma unroll
        for (unsigned j = 0; j < 16; ++j) { const unsigned c = xb_ld(&bar[XB_XCNT(j)]); sum += c; cnt += (c > 0u) ? 1u : 0u; mine = (j == x) ? c : mine; }
        if (sum == G) break;
        __builtin_amdgcn_s_sleep(1);
        if ((++sp & 255u) == 0u) { if (xb_ld(&bar[XB_TMO])) break; if (sp > XB_SPIN_CAP) { atomicAdd(&bar[XB_TMO], 1u); break; } }
    }
    nloc = mine > 0u ? mine : 1u; nx = cnt > 0u ? cnt : 1u;
}

__device__ __forceinline__ void xcd_barrier(const XcdBarrier& b) {
    asm volatile("s_waitcnt vmcnt(0)" ::: "memory");
    __syncthreads();
    if (threadIdx.x == 0) {
        unsigned* bar = b.bar;
        __builtin_amdgcn_s_waitcnt(0);
        unsigned nloc = b.st[0], nx = b.st[1];
        if (nloc == 0u) { xcd_barrier_complete(bar, b.x, nloc, nx); b.st[0] = nloc; b.st[1] = nx; }
        const unsigned old = xb_add(&bar[XB_XSUB(b.x)], 1u);
        const unsigned gen = old / nloc;
        if (old + 1u == (gen + 1u) * nloc) {
            __builtin_amdgcn_fence(__ATOMIC_RELEASE, "agent");
            asm volatile("s_waitcnt vmcnt(0)" ::: "memory");
            const unsigned og = xb_add(&bar[XB_TOP], 1u);
            const unsigned tg = og / nx;
            if (og + 1u == (tg + 1u) * nx) xb_add(&bar[XB_TOPGEN], 1u);
            else XB_SPIN(xb_ld(&bar[XB_TOPGEN]) == tg, bar);
            __builtin_amdgcn_fence(__ATOMIC_ACQUIRE, "agent");
            xb_add(&bar[XB_XGEN(b.x)], 1u);
            asm volatile("s_waitcnt vmcnt(0)" ::: "memory");
        } else {
            XB_SPIN(xb_ld(&bar[XB_XGEN(b.x)]) == gen, bar);
            __builtin_amdgcn_fence(__ATOMIC_ACQUIRE, "agent");
            asm volatile("s_waitcnt vmcnt(0)" ::: "memory");
        }
    }
    __syncthreads();
}


#ifndef FIRST_STEP
#define FIRST_STEP 0
#endif
#ifndef LAST_STEP
#define LAST_STEP 18
#endif
#define ON(n) (FIRST_STEP <= (n) && (n) <= LAST_STEP)
#define SYNC(n) do { if ((n) < LAST_STEP) { XcdBarrier bar_; bar_.bar = (unsigned*)ws; bar_.x = xb_xcc_id(); bar_.st = (volatile LAS unsigned*)(L + RING_BYTES + 352); xcd_barrier(bar_); } } while (0)
#define WSB(off) ((const bf16_t*)(ws + (off)))
__global__ void __launch_bounds__(512, 2) fox_s5_mega(Args a) {
    extern __shared__ __attribute__((aligned(16))) unsigned char lds[];
    LAS unsigned char* L = (LAS unsigned char*)lds;
    const int G = gridDim.x, bx = blockIdx.x, NGW = G * 8, NGT = G * 512;
#define KA const __attribute__((address_space(4))) unsigned char* ka_ = (const __attribute__((address_space(4))) unsigned char*)__builtin_amdgcn_kernarg_segment_ptr(); asm volatile("" : "+s"(ka_)); \
    InTab in = (InTab)ka_; float* out = *(float* const __attribute__((address_space(4)))*)(ka_ + 256); unsigned char* ws = *(unsigned char* const __attribute__((address_space(4)))*)(ka_ + 264); (void)in; (void)out;
#define IDS int tid = threadIdx.x; asm volatile("" : "+v"(tid)); const int lane = tid & 63, wave = __builtin_amdgcn_readfirstlane(tid >> 6); const int gw = bx * 8 + wave, gt = bx * 512 + tid; (void)lane; (void)gw; (void)gt;
    {
        KA
        if (threadIdx.x < 8) ((volatile LAS unsigned*)(L + RING_BYTES + 320))[threadIdx.x + 8 - 8] = 0u;
        if (threadIdx.x < 2) ((volatile LAS unsigned*)(L + RING_BYTES + 352))[threadIdx.x] = 0u;
        __syncthreads();
        (void)xcd_barrier_post((unsigned*)ws, (volatile LAS unsigned*)(L + RING_BYTES + 352));
    }

    if (ON(0)) {
        KA
        IDS
        LAS float* scr = (LAS float*)(L + wave * 16384);
        { int base = 0;
          for (int j = 0; j < NTJ; ++j) { TJob J; get_tjob(in, ws, j, J);
              int first = gw - (base % NGW); if (first < 0) first += NGW;
              for (int it = first; it < J.items; it += NGW) transpose_item(J, scr, it, lane);
              base += J.items; } }
        __syncthreads();
        LAS float* wf = (LAS float*)L;
        for (int idx = tid; idx < 8192; idx += 512) wf[idx] = in[I_W_IN][(size_t)(idx >> 3) * INCOLS + 1536 + (idx & 7)];
        __syncthreads();
        {
            f32x4 nx[4];
            if (gw < T) { const f32x4* xr = (const f32x4*)(in[I_X] + (size_t)gw * DM) + lane;
#pragma unroll
                for (int j = 0; j < 4; ++j) nx[j] = xr[64 * j]; }
            const f32x4* gp = (const f32x4*)in[I_NORM_MIX]; f32x4 gn[4];
#pragma unroll
            for (int j = 0; j < 4; ++j) gn[j] = gp[64 * j + lane];
            const float fbias = in[I_FBIAS][lane & 7];
            for (int m = gw; m < T; m += NGW) {
                f32x4 v[4]; float s = 0.f;
#pragma unroll
                for (int j = 0; j < 4; ++j) { v[j] = nx[j]; s += (v[j][0] * v[j][0] + v[j][1] * v[j][1]) + (v[j][2] * v[j][2] + v[j][3] * v[j][3]); }
                if (m + NGW < T) { const f32x4* xr = (const f32x4*)(in[I_X] + (size_t)(m + NGW) * DM) + lane;
#pragma unroll
                    for (int j = 0; j < 4; ++j) nx[j] = xr[64 * j]; }
                const float rs = rsqrtf(wave_sum(s) * (1.f / DM) + EPS);
                u32x2* o8 = (u32x2*)((bf16_t*)(ws + WS_HN) + (size_t)m * DM) + lane;
#pragma unroll
                for (int j = 0; j < 4; ++j) { v[j] = v[j] * rs * gn[j]; u32x2 w; w.x = pk2(v[j][0], v[j][1]); w.y = pk2(v[j][2], v[j][3]); o8[64 * j] = w; }
                float d[8];
#pragma unroll
                for (int h = 0; h < 8; ++h) d[h] = 0.f;
#pragma unroll
                for (int j = 0; j < 4; ++j)
#pragma unroll
                    for (int i = 0; i < 4; ++i) { const int k = 256 * j + 4 * lane + i; const f32x4 w0 = *(const LAS f32x4*)(wf + k * 8), w1 = *(const LAS f32x4*)(wf + k * 8 + 4);
                        d[0] += v[j][i] * w0[0]; d[1] += v[j][i] * w0[1]; d[2] += v[j][i] * w0[2]; d[3] += v[j][i] * w0[3];
                        d[4] += v[j][i] * w1[0]; d[5] += v[j][i] * w1[1]; d[6] += v[j][i] * w1[2]; d[7] += v[j][i] * w1[3]; }
                float e4[4];
#pragma unroll
                for (int h = 0; h < 4; ++h) { const float keep = (lane & 4) ? d[h + 4] : d[h], give = (lane & 4) ? d[h] : d[h + 4]; e4[h] = keep + __shfl_xor(give, 4); }
                float e2[2];
#pragma unroll
                for (int h = 0; h < 2; ++h) { const float keep = (lane & 2) ? e4[h + 2] : e4[h], give = (lane & 2) ? e4[h] : e4[h + 2]; e2[h] = keep + __shfl_xor(give, 2); }
                float z; { const float keep = (lane & 1) ? e2[1] : e2[0], give = (lane & 1) ? e2[0] : e2[1]; z = keep + __shfl_xor(give, 1); }
                z += __shfl_xor(z, 8); z += __shfl_xor(z, 16); z += __shfl_xor(z, 32);
                if (lane < 8) {
                    z += fbias;
                    const float ls = fminf(z, 0.f) - __logf(1.f + __expf(-fabsf(z)));
                    const int b = m >> 11, t = m & 2047;
                    ((float*)(ws + WS_LOGF))[(size_t)(b * 8 + lane) * SEQ + t] = ls; }
            }
        }
        for (int m = gw; m < TM; m += NGW) { f32x4 v[4]; rms_row(in[I_MEM] + (size_t)m * DM, in[I_NMEM], (bf16_t*)(ws + WS_MN) + (size_t)m * DM, lane, v); }
        __syncthreads();
        {
            const int NTASK = S5G * TC, sub = tid >> 7, ltid = tid & 127, per = NTASK / G;
            for (int i0 = 0; bx + i0 * G < NTASK; i0 += 4) { const int task = bx + (i0 + sub) * G; const bool valid = task < NTASK;
                const int t2 = !valid ? 0 : ((NTASK % G == 0) ? (task % G) * per + task / G : task);
                s5_prep_task<128>(in, ws, t2 / TC, t2 % TC, (LAS float*)L + sub * 5120, ltid, valid); }
        }
        SYNC(0);
    }
    if (ON(2)) {
        KA
        pg8::Gemm g{WSB(WS_HN), WSB(WS_WIN), DM, DM, DM}; GOrder<OK_PLAIN> S; S.init(T / 256, 8, G, bx, DM, DM);
        Epi<EK_PROJ> E{ws + WS_Q, ws + WS_K, ws + WS_V, ws + WS_UG, in[I_FQN], in[I_FKN], nullptr};
        pg8::gemm_phase(L, g, S, E);
    }
    if (ON(1)) {
        KA
        IDS
        int seq = (bx < BATCH * NFH) ? bx : -1;
        if (G == 256) seq = (bx >= 64 && bx < 128) ? bx - 64 : ((bx >= 192) ? bx - 128 : -1);
        if (wave == 0 && seq >= 0) {
            const float* lf = (const float*)(ws + WS_LOGF) + (size_t)seq * SEQ + lane * 32; float* cb = (float*)(ws + WS_CB) + (size_t)seq * SEQ + lane * 32;
            f32x4 x[8]; float run = 0.f;
#pragma unroll
            for (int j = 0; j < 8; ++j) { x[j] = ((const f32x4*)lf)[j]; x[j][0] += run; x[j][1] += x[j][0]; x[j][2] += x[j][1]; x[j][3] += x[j][2]; run = x[j][3]; }
            float incl = run;
#pragma unroll
            for (int o = 1; o < 64; o <<= 1) { const float y = __shfl_up(incl, o); if (lane >= o) incl += y; }
            const float excl = incl - run;
#pragma unroll
            for (int j = 0; j < 8; ++j) ((f32x4*)cb)[j] = (x[j] + excl) * LOG2E;
        }
    }
    if (ON(3)) {
        KA
        pg8::Gemm g{WSB(WS_MN), WSB(WS_WXK), DM, DM, DM}; GOrder<OK_PLAIN> S; S.init(TM / 256, 4, G, bx, DM, DM);
        Epi<EK_MEMK> E{ws + WS_KST, ws + WS_SSQK, nullptr, nullptr, nullptr, nullptr, nullptr};
        pg8::gemm_phase(L, g, S, E);
    }
    if (ON(4)) {
        KA
        pg8::Gemm g{WSB(WS_WXV), WSB(WS_MN), DM, DM, DM}; GOrder<OK_PLAIN> S; S.init(4, TM / 256, G, (bx + 128) % G, DM, DM);
        Epi<EK_MEMVT> E{ws + WS_VT, nullptr, nullptr, nullptr, nullptr, nullptr, nullptr};
        pg8::gemm_phase(L, g, S, E);
        SYNC(4);
    }
    if (ON(5)) {
        KA
        const int vcu = (G % 8 == 0) ? (bx % 8) * (G / 8) + bx / 8 : bx;
        float skip_th; { const int ln = threadIdx.x & 63; float gq = fabsf(in[I_FQN][ln]), gk = fabsf(in[I_FKN][ln]);
#pragma unroll
            for (int o = 1; o < 64; o <<= 1) { gq = fmaxf(gq, __shfl_xor(gq, o)); gk = fmaxf(gk, __shfl_xor(gk, o)); }
            skip_th = 2.f * (64.f * C2Q * gq * gk) + 40.f; }
        for (int L2 = vcu; L2 < BATCH * NFH * 2; L2 += G) { const int bh = L2 >> 1, s = L2 & 1;
            for (int i = 0; i < 4; ++i) { const int qb = (i == 0) ? s : (i == 1) ? 3 - s : (i == 2) ? 4 + s : 7 - s;
                attn_body::attn_unit<8>(bh >> 3, bh & 7, qb, (const attn_body::bf16*)(ws + WS_Q), (const attn_body::bf16*)(ws + WS_K), (const attn_body::bf16*)(ws + WS_V),
                                        (attn_body::bf16*)(ws + WS_MIXN), (const float*)(ws + WS_CB), (float*)(ws + WS_SSQF), (char*)lds, skip_th); } }
    }
    if (ON(6)) {
        KA
        pg8::Gemm g{WSB(WS_UG), WSB(WS_BTE), UGP, 512, 256}; GOrder<OK_S5E> S; S.init(256, 1, G, bx, UGP, 512);
        Epi<EK_S5E> E{ws + WS_EPART, nullptr, nullptr, nullptr, nullptr, nullptr, nullptr};
        pg8::gemm_phase(L, g, S, E);
        SYNC(6);
    }
    if (ON(7)) {
        KA
        IDS
        const float* kt = (const float*)(ws + WS_KTAB); bf16_t* bty = (bf16_t*)(ws + WS_BTY);
        for (int idx = gt; idx < S5G * 512 * 64; idx += NGT) {
            const int half = idx & 1, ss = (idx >> 1) & 31, nn = (idx >> 6) & 511, gI = idx >> 15; const int tt = nn >> 4, c = nn & 15;
            u32x4 w = (u32x4){0u, 0u, 0u, 0u};
            if (ss <= tt) { const float* src = kt + ((size_t)((gI * TC + (tt - ss)) * 16 + c)) * 16 + half * 8; const f32x4 k0 = *(const f32x4*)src, k1 = *(const f32x4*)(src + 4);
                w.x = pk2(k0[0], k0[1]); w.y = pk2(k0[2], k0[3]); w.z = pk2(k1[0], k1[1]); w.w = pk2(k1[2], k1[3]); }
            *(u32x4*)(bty + ((size_t)gI * 512 + nn) * UGP + ss * 16 + half * 8) = w; }
        const float* ep = (const float*)(ws + WS_EPART); const float* lb = (const float*)(ws + WS_LB32); bf16_t* ug = (bf16_t*)(ws + WS_UG);
        for (int idx = gt; idx < S5G * BATCH * S5P; idx += NGT) { const int p = idx & 63, gb = idx >> 6, gI = gb >> 4;
            const float lr = lb[(gI * 64 + p) * 2], li = lb[(gI * 64 + p) * 2 + 1]; float sr = 0.f, si = 0.f;
            for (int k0 = 0; k0 < NCH; k0 += 16) {
                f32x2 e0[16], e1[16];
#pragma unroll
                for (int j = 0; j < 16; ++j) { const size_t row = (size_t)gb * NCH + k0 + j; e0[j] = *(const f32x2*)(ep + row * 128 + 2 * p); e1[j] = *(const f32x2*)(ep + (size_t)32768 * 128 + row * 128 + 2 * p); }
#pragma unroll
                for (int j = 0; j < 16; ++j) { const size_t row = (size_t)gb * NCH + k0 + j;
                    *(unsigned*)(ug + row * UGP + 512 + 2 * p) = pk2(sr, si);
                    const float nr = lr * sr - li * si + (e0[j][0] + e1[j][0]), ni = lr * si + li * sr + (e0[j][1] + e1[j][1]); sr = nr; si = ni; } } }
        SYNC(7);
    }
    if (ON(8)) {
        KA
        pg8::Gemm g{WSB(WS_UG), WSB(WS_BTY), UGP, UGP, UGP}; GOrder<OK_S5Y> S; S.init(256, 1, G, bx, UGP, UGP);
        Epi<EK_S5Y> E{ws + WS_Y1, nullptr, nullptr, nullptr, nullptr, nullptr, nullptr};
        pg8::gemm_phase(L, g, S, E);
        SYNC(8);
    }
    if (ON(9)) {
        KA
        pg8::Gemm g{WSB(WS_Y1), WSB(WS_WGLU), 512, 512, 512}; GOrder<OK_PLAIN> S; S.init(T / 256, 2, G, bx, 512, 512);
        Epi<EK_GLU> E{ws + WS_MIXN, ws + WS_SSQY, nullptr, nullptr, ws + WS_Y1, in[I_BGLU], nullptr};
        pg8::gemm_phase(L, g, S, E);
        SYNC(9);
    }
    if (ON(11)) {
        KA
        pg8::Gemm g{WSB(WS_MIXN), WSB(WS_WOUT), DM, DM, DM}; GOrder<OK_PLAIN> S; S.init(T / 256, 4, G, bx, DM, DM);
        Epi<EK_WOUT> E{nullptr, ws + WS_H1B, ws + WS_SSQ1, nullptr, in[I_X], ws + WS_SSQF, ws + WS_SSQY};
        pg8::gemm_phase(L, g, S, E);
        SYNC(11);
    }
    if (ON(12)) {
        KA
        IDS
        const float* sk = (const float*)(ws + WS_SSQK); float* sck = (float*)(ws + WS_SCK);
        for (int idx = gt; idx < TM * 4; idx += NGT) { const int key = idx >> 2, h = idx & 3; const f32x4 q = *(const f32x4*)(sk + (size_t)key * 16 + h * 4);
            sck[(size_t)h * TM + key] = rsqrtf(((q[0] + q[1]) + (q[2] + q[3])) * (1.f / 256.f) + EPS); }
        pg8::Gemm g{WSB(WS_H1B), WSB(WS_WXQ), DM, DM, DM}; GOrder<OK_PLAIN> S; S.init(T / 256, 4, G, bx, DM, DM);
        Epi<EK_XQ> E{ws + WS_QST, ws + WS_SSQQ, nullptr, nullptr, in[I_XQN], in[I_XKN], nullptr};
        pg8::gemm_phase(L, g, S, E);
        SYNC(12);
    }
    if (ON(13)) {
        KA
        pg8::Gemm g{WSB(WS_QST), WSB(WS_KST), DM, DM, 256}; GOrder<OK_XS> S; S.init(512, 1, G, bx, DM, DM);
        Epi<EK_XS> E{ws + WS_P, ws + WS_PSUM, nullptr, nullptr, ws + WS_SSQ1, ws + WS_SSQQ, ws + WS_SCK};
        pg8::gemm_phase(L, g, S, E);
        SYNC(13);
    }
    if (ON(14)) {
        KA
        pg8::Gemm g{WSB(WS_P), WSB(WS_VT), DM, TM, 256}; GOrder<OK_XO> S; S.init(512, 1, G, bx, DM, TM);
        Epi<EK_XO> E{ws + WS_XO, nullptr, nullptr, nullptr, ws + WS_PSUM, nullptr, nullptr};
        pg8::gemm_phase(L, g, S, E);
        SYNC(14);
    }
    if (ON(15)) {
        KA
        pg8::Gemm g{WSB(WS_XO), WSB(WS_WXO), DM, DM, DM}; GOrder<OK_PLAIN> S; S.init(T / 256, 4, G, bx, DM, DM);
        Epi<EK_WXO> E{nullptr, ws + WS_H2B, ws + WS_SSQ2, nullptr, ws + WS_H1B, nullptr, nullptr};
        pg8::gemm_phase(L, g, S, E);
        SYNC(15);
    }
    if (ON(16)) {
        KA
        { IDS
          const float* s2 = (const float*)(ws + WS_SSQ2); float* r2 = (float*)(ws + WS_RS2);
          for (int row = gt; row < T; row += NGT) { const f32x4 t0 = *(const f32x4*)(s2 + (size_t)row * 16), t1 = *(const f32x4*)(s2 + (size_t)row * 16 + 4), t2 = *(const f32x4*)(s2 + (size_t)row * 16 + 8), t3 = *(const f32x4*)(s2 + (size_t)row * 16 + 12);
              r2[row] = rsqrtf((((t0[0] + t0[1]) + (t0[2] + t0[3])) + ((t1[0] + t1[1]) + (t1[2] + t1[3])) + ((t2[0] + t2[1]) + (t2[2] + t2[3])) + ((t3[0] + t3[1]) + (t3[2] + t3[3]))) * (1.f / DM) + EPS); }
          SYNC(15); }
        pg8::Gemm g{WSB(WS_H2B), WSB(WS_WUP), DM, DM, DM}; GOrder<OK_PLAIN> S; S.init(T / 256, 22, G, bx, DM, DM);
        Epi<EK_UPC> E{ws + WS_U, ws + WS_G, ws + WS_G + 4 * MiB, ws + WS_G + 8 * MiB, ws + WS_RS2, in[I_CONVW], in[I_CONVB], (LAS float*)(L + RING_BYTES + 1024)};
        pg8::gemm_phase(L, g, S, E);
        SYNC(16);
    }
    if (ON(17)) {
        KA
        IDS
        const float* GHF = (const float*)(ws + WS_G); const float* GHL = (const float*)(ws + WS_G + 4 * MiB); const float* UH = (const float*)(ws + WS_G + 8 * MiB);
        const float* cw = in[I_CONVW]; const float* cbv = in[I_CONVB]; bf16_t* A = (bf16_t*)(ws + WS_U);
        for (int idx = gt; idx < (T / 256) * 2 * DFF; idx += NGT) { const int j = idx % DFF, pi = idx / DFF, i = pi & 1, pm = pi >> 1; const bool first = (pm & 7) == 0;
            const float g0 = GHF[(size_t)pi * DFF + j];
            const float gl1 = first ? 0.f : GHL[((size_t)(pm - 1) * 2 + 1) * DFF + j], gl0 = first ? 0.f : GHL[((size_t)(pm - 1) * 2) * DFF + j];
            const float g1 = i ? GHF[(size_t)(pm * 2) * DFF + j] : gl1, g2 = i ? gl1 : gl0;
            const float z = cbv[j] + cw[j] * g2 + cw[DFF + j] * g1 + cw[2 * DFF + j] * g0;
            A[(size_t)(pm * 256 + i) * DFF + j] = (bf16_t)f2bf(z * sigm(z) * UH[(size_t)pi * DFF + j]); }
        SYNC(17);
    }
    if (ON(18)) {
        KA
        pg8::Gemm g{WSB(WS_U), WSB(WS_WDN), DFF, DFF, DFF}; GOrder<OK_PLAIN> S; S.init(T / 256, 4, G, bx, DFF, DFF);
        Epi<EK_DOWN> E{out, nullptr, nullptr, nullptr, ws + WS_H2B, nullptr, nullptr};
        pg8::gemm_phase(L, g, S, E);
    }
}

extern "C" void kernel_launch(void* const* d_in, const int* in_sizes, int n_in, void* d_out, int out_size, void* d_ws, size_t ws_size, hipStream_t stream) {
    static int grid = 0;
    if (grid == 0) {
        if (n_in != 32 || out_size != T * DM || ws_size < WS_END) { fprintf(stderr, "kernel_launch: unexpected shapes (n_in %d out %d ws %zu)\n", n_in, out_size, ws_size); grid = -1; return; }
        int dev = 0, cus = 0, per_cu = 0;
        (void)hipGetDevice(&dev); (void)hipDeviceGetAttribute(&cus, hipDeviceAttributeMultiprocessorCount, dev);
        if (hipFuncSetAttribute((const void*)fox_s5_mega, hipFuncAttributeMaxDynamicSharedMemorySize, LDS_TOTAL) != hipSuccess) { fprintf(stderr, "kernel_launch: hipFuncSetAttribute failed\n"); grid = -1; return; }
        if (hipOccupancyMaxActiveBlocksPerMultiprocessor(&per_cu, (const void*)fox_s5_mega, 512, LDS_TOTAL) != hipSuccess || per_cu < 1) { fprintf(stderr, "kernel_launch: occupancy query says %d\n", per_cu); per_cu = 1; }
        (void)hipGetLastError();
        grid = cus;
        if (grid > cus * per_cu) grid = cus * per_cu;
    }
    if (grid < 0) return;
    if (hipMemsetAsync(d_ws, 0, 65536, stream) != hipSuccess) { fprintf(stderr, "kernel_launch: memset of the barrier words failed\n"); return; }
    Args a{};
    for (int i = 0; i < 32; ++i) a.in[i] = (const float*)d_in[i];
    a.out = (float*)d_out; a.ws = (unsigned char*)d_ws;
    void* args[] = {&a};
    hipError_t e = hipLaunchCooperativeKernel((const void*)fox_s5_mega, dim3(grid), dim3(512), args, LDS_TOTAL, stream);
    if (e != hipSuccess) fprintf(stderr, "cooperative launch failed: %s (grid %d)\n", hipGetErrorString(e), grid);
}
```

```cpp
#include <hip/hip_runtime.h>
#include <hip/hip_bf16.h>
#include <cstdio>
#include <cstdint>
#include <cmath>

constexpr int BATCH = 16, SEQ = 2048, DM = 1024, T = BATCH * SEQ;
constexpr int NMEM = 256, TM = BATCH * NMEM;
constexpr int FOXW = 512, HD = 64, NFH = 8;
constexpr int S5W = 512, S5G = 32, S5C = 16, S5P = 64;
constexpr int NXH = 4, XHD = 256;
constexpr int DFF = 2816;
constexpr int INCOLS = 2056;
constexpr float EPS = 1e-6f;
constexpr int TC = 32, NCH = SEQ / TC;
constexpr int UGP = TC * 16 + 128;
constexpr float LOG2E = 1.4426950408889634f;
constexpr float C2Q = 0.125f * LOG2E;

#define LAS __attribute__((address_space(3)))
typedef unsigned short bf16_t;
typedef short bf16x8 __attribute__((ext_vector_type(8)));
typedef float f32x4 __attribute__((ext_vector_type(4)));
typedef float f32x2 __attribute__((ext_vector_type(2)));
typedef unsigned u32x4 __attribute__((ext_vector_type(4)));
typedef unsigned u32x2 __attribute__((ext_vector_type(2)));

__device__ __forceinline__ unsigned f2bf(float f) { unsigned u = __builtin_bit_cast(unsigned, f); return (u + 0x7fffu + ((u >> 16) & 1u)) >> 16; }
typedef __bf16 bf16x2_hw __attribute__((ext_vector_type(2)));
__device__ __forceinline__ unsigned pk2(float lo, float hi) { f32x2 v = {lo, hi}; bf16x2_hw b = __builtin_convertvector(v, bf16x2_hw); return __builtin_bit_cast(unsigned, b); }
__device__ __forceinline__ float bflo(unsigned w) { return __builtin_bit_cast(float, w << 16); }
__device__ __forceinline__ float bfhi(unsigned w) { return __builtin_bit_cast(float, w & 0xffff0000u); }
__device__ __forceinline__ float wave_sum(float v) {
#pragma unroll
    for (int o = 1; o < 64; o <<= 1) v += __shfl_xor(v, o);
    return v;
}

__device__ __forceinline__ float red_fq(float v) {
    v += __builtin_bit_cast(float, __builtin_amdgcn_ds_swizzle(__builtin_bit_cast(int, v), 0x401F));
    float a = v, b = v;
    asm volatile("s_nop 1\n\tv_permlane32_swap_b32 %0, %1\n\ts_nop 1" : "+v"(a), "+v"(b));
    return a + b;
}

constexpr size_t MiB = 1u << 20;
constexpr size_t WS_WIN = 1 * MiB, WS_WGLU = 5 * MiB, WS_WOUT = 6 * MiB, WS_WXQ = 8 * MiB, WS_WXK = 10 * MiB, WS_WXV = 12 * MiB, WS_WXO = 14 * MiB,
                 WS_WUP = 16 * MiB, WS_WDN = 27 * MiB, WS_BTY = 33 * MiB, WS_BTE = 53 * MiB, WS_KTAB = 61 * MiB, WS_LB32 = 62 * MiB, WS_LOGF = 63 * MiB,
                 WS_CB = 64 * MiB, WS_SSQF = 65 * MiB, WS_SSQY = 66 * MiB, WS_SSQ1 = 67 * MiB, WS_SSQ2 = 69 * MiB, WS_SSQQ = 71 * MiB, WS_PSUM = 73 * MiB,
                 WS_SSQK = 75 * MiB, WS_SCK = 76 * MiB, WS_RS2 = 77 * MiB;
constexpr size_t WS_HN = 80 * MiB, WS_MIXN = 80 * MiB, WS_Y1 = 304 * MiB, WS_QST = 80 * MiB, WS_H2B = 80 * MiB;
constexpr size_t WS_MN = 144 * MiB, WS_KST = 152 * MiB, WS_VT = 160 * MiB;
constexpr size_t WS_Q = 168 * MiB, WS_K = 200 * MiB, WS_V = 232 * MiB, WS_P = 168 * MiB;
constexpr size_t WS_UG = 264 * MiB, WS_EPART = 304 * MiB, WS_H1B = 264 * MiB, WS_XO = 336 * MiB;
constexpr size_t WS_G = 144 * MiB, WS_U = 320 * MiB, WS_END = 496 * MiB;

namespace pg8 {
constexpr int BM = 256, BK = 64, HALF = 128, HTB = HALF * BK * 2, STAGE_BYTES = 8 * HTB;
__device__ __forceinline__ int lds_byte(int r, int c) { const int st = (r >> 4) * 2 + (c >> 5), rr = r & 15, cc = c & 31, ob = rr * 64 + cc * 2; return st * 1024 + (ob ^ (((ob >> 9) & 1) << 5)); }
__device__ __forceinline__ void stage_rc(int b, int& R, int& C) { const int st = b / 1024, sb = b % 1024, swz = sb ^ (((sb >> 9) & 1) << 5); R = (st >> 1) * 16 + swz / 64; C = (st & 1) * 32 + (swz % 64) / 2; }
__device__ __forceinline__ int perm32(int rho) { const int n = rho >> 4, i = rho & 15; return 8 * (i >> 2) + 4 * n + (i & 3); }

struct Unit { int pm, pn; long offA, offB; };
struct Gemm { const bf16_t* A; const bf16_t* Bt; int lda, ldb, K; };

template <class Epi, class Sched>
__device__ __forceinline__ void gemm_phase(LAS unsigned char* lds, const Gemm g, const Sched& S, const Epi& E) {
    int tid = threadIdx.x; asm volatile("" : "+v"(tid));
    const int wid = __builtin_amdgcn_readfirstlane(tid >> 6), lane = tid & 63, wr = wid >> 2, wc = wid & 3, fr = lane & 15, fq = lane >> 4;
    const int K = g.K, nt = K / BK;
    unsigned voffA[2], voffB[2];
#pragma unroll
    for (int i = 0; i < 2; ++i) { int R, C; stage_rc(tid * 16 + i * 8192, R, C); const int Rb = (R & ~31) + perm32(R & 31);
        voffA[i] = (unsigned)(R * g.lda + C) * 2u; voffB[i] = (unsigned)(Rb * g.ldb + C) * 2u; }
    const size_t kstep = (size_t)(BK * 2);
    const size_t hstepA = (size_t)HALF * g.lda * 2, hstepB = (size_t)HALF * g.ldb * 2;
    const unsigned ldsw = (unsigned)wid * 1024u;
    const int aoff = lds_byte(wr * 64 + fr, fq * 8), boff = lds_byte(wc * 32 + fr, fq * 8);
#define PG8_SA(b, h) (((b) * 2 + (h)) * HTB)
#define PG8_SB(b, h) ((4 + (b) * 2 + (h)) * HTB)
#define PG8_STAGE(bufoff, gbase, voff) do { _Pragma("unroll") for (int _i = 0; _i < 2; ++_i) \
        __builtin_amdgcn_global_load_lds((const unsigned*)((const char*)(gbase) + (voff)[_i]), (LAS unsigned*)(lds + (bufoff) + ldsw + _i * 8192), 16, 0, 0); } while (0)
#define PG8_LDA(dst, b, h) do { _Pragma("unroll") for (int m = 0; m < 4; ++m) _Pragma("unroll") for (int k = 0; k < 2; ++k) dst[m][k] = *(const LAS bf16x8*)(lds + PG8_SA(b, h) + aoff + m * 2048 + k * 1024); } while (0)
#define PG8_LDB(dst, b, h) do { _Pragma("unroll") for (int n = 0; n < 2; ++n) _Pragma("unroll") for (int k = 0; k < 2; ++k) dst[n][k] = *(const LAS bf16x8*)(lds + PG8_SB(b, h) + boff + n * 2048 + k * 1024); } while (0)
#define PG8_MMA(ai, bj, At, Bt) do { __builtin_amdgcn_s_setprio(1); _Pragma("unroll") for (int m = 0; m < 4; ++m) _Pragma("unroll") for (int n = 0; n < 2; ++n) _Pragma("unroll") for (int k = 0; k < 2; ++k) \
        acc[ai][bj][m][n] = __builtin_amdgcn_mfma_f32_16x16x32_bf16(Bt[n][k], At[m][k], acc[ai][bj][m][n], 0, 0, 0); __builtin_amdgcn_s_setprio(0); } while (0)
#define PG8_WAIT_V(n) asm volatile("s_waitcnt vmcnt(" #n ")" ::: "memory")
#define PG8_WAIT_L(n) asm volatile("s_waitcnt lgkmcnt(" #n ")" ::: "memory")
#define PG8_BAR __builtin_amdgcn_s_barrier()
#define PG8_SCHED __builtin_amdgcn_sched_barrier(0)
    Unit cur, nxt; int ui = 0;
    if (!S.next(0, cur)) return;
    f32x4 acc[2][2][4][2];
#pragma unroll
    for (int a = 0; a < 2; ++a)
#pragma unroll
        for (int b = 0; b < 2; ++b)
#pragma unroll
            for (int m = 0; m < 4; ++m)
#pragma unroll
                for (int n = 0; n < 2; ++n) acc[a][b][m][n] = (f32x4){0.f, 0.f, 0.f, 0.f};
    bf16x8 At[4][2], B0[2][2], B1[2][2];
    const char* cA = (const char*)g.A + cur.offA; const char* cB = (const char*)g.Bt + cur.offB;
    PG8_STAGE(PG8_SB(0, 0), cB, voffB); PG8_STAGE(PG8_SB(0, 1), cB + hstepB, voffB); PG8_STAGE(PG8_SA(0, 0), cA, voffA); PG8_STAGE(PG8_SA(0, 1), cA + hstepA, voffA);
    if (wr == 1) PG8_BAR;
    PG8_WAIT_V(2); PG8_BAR;
    PG8_STAGE(PG8_SB(1, 0), cB + kstep, voffB); PG8_STAGE(PG8_SA(1, 0), cA + kstep, voffA); PG8_STAGE(PG8_SB(1, 1), cB + hstepB + kstep, voffB);
    PG8_WAIT_V(6); PG8_BAR;
    for (;;) {
        const bool has_next = S.next(ui + 1, nxt);
        const char* nA = has_next ? (const char*)g.A + nxt.offA : cA; const char* nB = has_next ? (const char*)g.Bt + nxt.offB : cB;
        for (int t = 0; t < nt; t += 2) {
            if constexpr (Epi::MID) { if (t == nt / 2) { int fr2 = fr; asm volatile("" : "+v"(fr2)); E.mid(acc, cur, wr, fr2); } }
            const bool last = (t == nt - 2);
            const char* a1 = cA + (size_t)(t + 1) * kstep;
            const char* a2 = last ? nA : cA + (size_t)(t + 2) * kstep; const char* b2 = last ? nB : cB + (size_t)(t + 2) * kstep;
            const char* a3 = a2 + kstep; const char* b3 = b2 + kstep;
            PG8_LDB(B0, 0, 0); PG8_LDB(B1, 0, 1); PG8_SCHED; PG8_LDA(At, 0, 0); PG8_STAGE(PG8_SA(1, 1), a1 + hstepA, voffA);
            PG8_WAIT_V(8); PG8_WAIT_L(0); PG8_BAR; PG8_MMA(0, 0, At, B0); PG8_MMA(0, 1, At, B1); PG8_BAR; PG8_SCHED;
            PG8_LDA(At, 0, 1); PG8_STAGE(PG8_SB(0, 0), b2, voffB); PG8_STAGE(PG8_SB(0, 1), b2 + hstepB, voffB); PG8_STAGE(PG8_SA(0, 0), a2, voffA);
            PG8_WAIT_V(8); PG8_WAIT_L(0); PG8_BAR; PG8_MMA(1, 0, At, B0); PG8_MMA(1, 1, At, B1); PG8_BAR; PG8_SCHED;
            PG8_LDB(B0, 1, 0); PG8_LDB(B1, 1, 1); PG8_SCHED; PG8_LDA(At, 1, 0); PG8_STAGE(PG8_SA(0, 1), a2 + hstepA, voffA);
            PG8_WAIT_V(8); PG8_WAIT_L(0); PG8_BAR; PG8_MMA(0, 0, At, B0); PG8_MMA(0, 1, At, B1); PG8_BAR; PG8_SCHED;
            PG8_LDA(At, 1, 1); PG8_STAGE(PG8_SB(1, 0), b3, voffB); PG8_STAGE(PG8_SB(1, 1), b3 + hstepB, voffB); PG8_STAGE(PG8_SA(1, 0), a3, voffA);
            PG8_WAIT_V(8); PG8_WAIT_L(0); PG8_BAR; PG8_MMA(1, 0, At, B0); PG8_MMA(1, 1, At, B1); PG8_BAR; PG8_SCHED;
        }
        if (wr == 0) PG8_BAR;
        { int fr2 = fr, fq2 = fq; asm volatile("" : "+v"(fr2), "+v"(fq2));
          E(acc, cur, wr, wc, fr2, fq2); }
        if (!has_next) break;
#pragma unroll
        for (int a = 0; a < 2; ++a)
#pragma unroll
            for (int b = 0; b < 2; ++b)
#pragma unroll
                for (int m = 0; m < 4; ++m)
#pragma unroll
                    for (int n = 0; n < 2; ++n) acc[a][b][m][n] = (f32x4){0.f, 0.f, 0.f, 0.f};
        cur = nxt; cA = nA; cB = nB; ++ui;
        if (wr == 1) PG8_BAR;
    }
    PG8_WAIT_V(0);
    PG8_BAR;
#undef PG8_SA
#undef PG8_SB
#undef PG8_STAGE
#undef PG8_LDA
#undef PG8_LDB
#undef PG8_MMA
#undef PG8_WAIT_V
#undef PG8_WAIT_L
#undef PG8_BAR
#undef PG8_SCHED
}
}
using pg8::Unit;

enum OrderKind { OK_PLAIN = 0, OK_S5E, OK_S5Y, OK_XS, OK_XO };
template <int kind> struct GOrder {
    int nM, nN, nwg, G, c, lda, ldb;
    __device__ __forceinline__ void init(int nM_, int nN_, int G_, int c_, int lda_, int ldb_) { nM = nM_; nN = nN_; nwg = nM_ * nN_; G = G_; c = c_; lda = lda_; ldb = ldb_; }
    __device__ __forceinline__ bool next(int i, Unit& u) const {
        const long L = (long)i * G + c; if (L >= nwg) return false;
        const int l = (int)L;
        if constexpr (kind == OK_PLAIN) {
            int wgid = l; { const int q = nwg / 8, r = nwg % 8, xcd = wgid % 8, off = wgid / 8; wgid = (xcd < r ? xcd * (q + 1) : r * (q + 1) + (xcd - r) * q) + off; }
            const int nig = 8 * nN, gid = wgid / nig, fm = gid * 8, gsz = (nM - fm) < 8 ? (nM - fm) : 8;
            u.pm = fm + ((wgid % nig) % gsz); u.pn = (wgid % nig) / gsz;
            u.offA = (long)u.pm * 256 * lda * 2; u.offB = (long)u.pn * 256 * ldb * 2;
        } else if constexpr (kind == OK_S5E) {
            const int kq = l & 1, pmm = (l >> 1) & 3, gg = l >> 3;
            u.pm = gg * 4 + pmm; u.pn = kq;
            u.offA = ((long)u.pm * 256 * UGP + kq * 256) * 2; u.offB = ((long)gg * 256 * 512 + kq * 256) * 2;
        } else if constexpr (kind == OK_S5Y) {
            const int pn = l & 1, pmm = (l >> 1) & 3, gg = l >> 3;
            u.pm = gg * 4 + pmm; u.pn = pn;
            u.offA = (long)u.pm * 256 * UGP * 2; u.offB = ((long)gg * 512 + pn * 256) * UGP * 2;
        } else if constexpr (kind == OK_XS) {
            const int h = l & 3, pm = l >> 2, b = pm >> 3;
            u.pm = pm; u.pn = h;
            u.offA = ((long)pm * 256 * DM + h * 256) * 2; u.offB = ((long)b * 256 * DM + h * 256) * 2;
        } else {
            const int h = l & 3, pm = l >> 2, b = pm >> 3;
            u.pm = pm; u.pn = h;
            u.offA = ((long)pm * 256 * DM + h * 256) * 2; u.offB = ((long)h * 256 * TM + b * 256) * 2;
        }
        return true;
    }
};

enum EpiKind { EK_PROJ = 0, EK_MEMK, EK_MEMVT, EK_S5E, EK_S5Y, EK_GLU, EK_WOUT, EK_XQ, EK_XS, EK_XO, EK_WXO, EK_UP, EK_DOWN, EK_GATE, EK_UPACT, EK_UPC };
    __device__ __forceinline__ u32x4 pack8(const f32x4 a, const f32x4 b) { u32x4 w; w.x = pk2(a[0], a[1]); w.y = pk2(a[2], a[3]); w.z = pk2(b[0], b[1]); w.w = pk2(b[2], b[3]); return w; }
    __device__ __forceinline__ float gelu_t(float y) { const float z = 0.7978845608028654f * (y + 0.044715f * y * y * y); const float e = __builtin_amdgcn_exp2f((2.f * LOG2E) * z); const float th = 1.f - 2.f * __builtin_amdgcn_rcpf(e + 1.f); return 0.5f * y * (1.f + th); }
    __device__ __forceinline__ float sigm(float z) { return __builtin_amdgcn_rcpf(1.f + __builtin_amdgcn_exp2f(-LOG2E * z)); }
    __device__ __forceinline__ float ssq8(const f32x4 a, const f32x4 b) { return (a[0] * a[0] + a[1] * a[1]) + (a[2] * a[2] + a[3] * a[3]) + (b[0] * b[0] + b[1] * b[1]) + (b[2] * b[2] + b[3] * b[3]); }

template <int kind> struct Epi {
    void* p0; void* p1; void* p2; void* p3; const void* c0; const void* c1; const void* c2; LAS float* hx;
    static constexpr bool MID = (kind == EK_WOUT);
    __device__ __forceinline__ static float rs8(const float* s, size_t row) { const f32x4 a0 = *(const f32x4*)(s + row * 8), a1 = *(const f32x4*)(s + row * 8 + 4); return rsqrtf((((a0[0] + a0[1]) + (a0[2] + a0[3])) + ((a1[0] + a1[1]) + (a1[2] + a1[3]))) * (1.f / 512.f) + EPS); }
    __device__ __forceinline__ void mid(f32x4 (&acc)[2][2][4][2], const Unit& u, int wr, int fr) const {
        const float* sf = (const float*)c1; const float* sy = (const float*)c2;
#pragma unroll
        for (int ai = 0; ai < 2; ++ai)
#pragma unroll
            for (int m = 0; m < 4; ++m) { const size_t row = (size_t)(u.pm * 256 + wr * 64 + fr + ai * 128 + m * 16);
                const float ratio = rs8(sf, row) * __builtin_amdgcn_rcpf(rs8(sy, row));
#pragma unroll
                for (int bj = 0; bj < 2; ++bj) { acc[ai][bj][m][0] = acc[ai][bj][m][0] * ratio; acc[ai][bj][m][1] = acc[ai][bj][m][1] * ratio; } }
    }
    __device__ __forceinline__ void operator()(const f32x4 (&acc)[2][2][4][2], const Unit& u, int wr, int wc, int fr, int fq) const {
        const int rbase = u.pm * 256 + wr * 64 + fr;
        const int cl0 = wc * 32 + 8 * fq;
        switch (kind) {
        case EK_PROJ: {
            const int pn = u.pn;
            if (pn < 4) {
                const bool isq = pn < 2; bf16_t* dst = (bf16_t*)(isq ? p0 : p1); const float* gptr = (const float*)(isq ? c0 : c1); const float post = isq ? C2Q : 1.f;
                const int head = 4 * (pn & 1) + wc;
#pragma unroll
                for (int ai = 0; ai < 2; ++ai)
#pragma unroll
                    for (int m = 0; m < 4; ++m) {
                        float ss = ssq8(acc[ai][0][m][0], acc[ai][0][m][1]) + ssq8(acc[ai][1][m][0], acc[ai][1][m][1]);
                        ss = red_fq(ss);
                        const float sc = rsqrtf(ss * (1.f / 64.f) + EPS) * post;
                        const size_t row = (size_t)(rbase + ai * 128 + m * 16);
#pragma unroll
                        for (int bj = 0; bj < 2; ++bj)
                            *(u32x4*)(dst + row * 512 + head * 64 + 32 * bj + 8 * fq) = pack8(acc[ai][bj][m][0] * sc * *(const f32x4*)(gptr + 32 * bj + 8 * fq), acc[ai][bj][m][1] * sc * *(const f32x4*)(gptr + 32 * bj + 8 * fq + 4));
                    }
            } else if (pn < 6) {
                bf16_t* dst = (bf16_t*)p2;
#pragma unroll
                for (int ai = 0; ai < 2; ++ai)
#pragma unroll
                    for (int m = 0; m < 4; ++m) { const size_t row = (size_t)(rbase + ai * 128 + m * 16);
#pragma unroll
                        for (int bj = 0; bj < 2; ++bj) *(u32x4*)(dst + row * 512 + (pn - 4) * 256 + bj * 128 + cl0) = pack8(acc[ai][bj][m][0], acc[ai][bj][m][1]); }
            } else {
                bf16_t* dst = (bf16_t*)p3;
#pragma unroll
                for (int ai = 0; ai < 2; ++ai)
#pragma unroll
                    for (int m = 0; m < 4; ++m) { const int row = rbase + ai * 128 + m * 16; const int b = row >> 11, t = row & 2047, ch = t >> 5, s = t & 31;
#pragma unroll
                        for (int bj = 0; bj < 2; ++bj) { const int f = (pn - 6) * 256 + bj * 128 + cl0; const int gI = f >> 4, cc = f & 15;
                            *(u32x4*)(dst + ((size_t)(gI * 1024 + b * 64 + ch)) * UGP + s * 16 + cc) = pack8(acc[ai][bj][m][0], acc[ai][bj][m][1]); } }
            }
        } break;
        case EK_MEMK: {
            bf16_t* dst = (bf16_t*)p0; float* sq = (float*)p1;
#pragma unroll
            for (int ai = 0; ai < 2; ++ai)
#pragma unroll
                for (int m = 0; m < 4; ++m) { const size_t row = (size_t)(rbase + ai * 128 + m * 16);
                    float ss = ssq8(acc[ai][0][m][0], acc[ai][0][m][1]) + ssq8(acc[ai][1][m][0], acc[ai][1][m][1]);
                    ss = red_fq(ss);
                    if (fq == 0) sq[row * 16 + u.pn * 4 + wc] = ss;
#pragma unroll
                    for (int bj = 0; bj < 2; ++bj) *(u32x4*)(dst + row * DM + u.pn * 256 + bj * 128 + cl0) = pack8(acc[ai][bj][m][0], acc[ai][bj][m][1]); }
        } break;
        case EK_MEMVT: {
            bf16_t* dst = (bf16_t*)p0;
#pragma unroll
            for (int ai = 0; ai < 2; ++ai)
#pragma unroll
                for (int m = 0; m < 4; ++m) { const size_t row = (size_t)(rbase + ai * 128 + m * 16);
#pragma unroll
                    for (int bj = 0; bj < 2; ++bj) *(u32x4*)(dst + row * TM + u.pn * 256 + bj * 128 + cl0) = pack8(acc[ai][bj][m][0], acc[ai][bj][m][1]); }
        } break;
        case EK_S5E: {
            float* dst = (float*)p0 + (size_t)u.pn * 32768 * 128;
#pragma unroll
            for (int ai = 0; ai < 2; ++ai)
#pragma unroll
                for (int m = 0; m < 4; ++m) { const size_t row = (size_t)(rbase + ai * 128 + m * 16);
                    *(f32x4*)(dst + row * 128 + cl0) = acc[ai][0][m][0]; *(f32x4*)(dst + row * 128 + cl0 + 4) = acc[ai][0][m][1]; }
        } break;
        case EK_S5Y: {
            bf16_t* dst = (bf16_t*)p0;
#pragma unroll
            for (int ai = 0; ai < 2; ++ai)
#pragma unroll
                for (int m = 0; m < 4; ++m) { const int r = rbase + ai * 128 + m * 16; const int gI = r >> 10, b = (r >> 6) & 15, k = r & 63;
#pragma unroll
                    for (int bj = 0; bj < 2; ++bj) { const int nn = u.pn * 256 + bj * 128 + cl0; const int tt = nn >> 4, cc = nn & 15;
                        f32x4 a = acc[ai][bj][m][0], c = acc[ai][bj][m][1];
#pragma unroll
                        for (int j = 0; j < 4; ++j) { a[j] = gelu_t(a[j]); c[j] = gelu_t(c[j]); }
                        *(u32x4*)(dst + ((size_t)(b * SEQ + k * TC + tt)) * 512 + gI * 16 + cc) = pack8(a, c); } }
        } break;
        case EK_GLU: {
            bf16_t* dst = (bf16_t*)p0; float* sq = (float*)p1; const bf16_t* y1 = (const bf16_t*)c0; const float* bg = (const float*)c1;
            f32x4 bv[2][2];
#pragma unroll
            for (int bj = 0; bj < 2; ++bj)
#pragma unroll
                for (int n = 0; n < 2; ++n) bv[bj][n] = *(const f32x4*)(bg + u.pn * 256 + bj * 128 + cl0 + 4 * n);
#pragma unroll
            for (int ai = 0; ai < 2; ++ai)
#pragma unroll
                for (int m = 0; m < 4; ++m) { const size_t row = (size_t)(rbase + ai * 128 + m * 16); float ss = 0.f;
#pragma unroll
                    for (int bj = 0; bj < 2; ++bj) { const size_t off = row * 512 + u.pn * 256 + bj * 128 + cl0;
                        const u32x4 yv = *(const u32x4*)(y1 + off);
                        f32x4 a = acc[ai][bj][m][0] + bv[bj][0], c = acc[ai][bj][m][1] + bv[bj][1];
                        a[0] = bflo(yv.x) * sigm(a[0]); a[1] = bfhi(yv.x) * sigm(a[1]); a[2] = bflo(yv.y) * sigm(a[2]); a[3] = bfhi(yv.y) * sigm(a[3]);
                        c[0] = bflo(yv.z) * sigm(c[0]); c[1] = bfhi(yv.z) * sigm(c[1]); c[2] = bflo(yv.w) * sigm(c[2]); c[3] = bfhi(yv.w) * sigm(c[3]);
                        ss += ssq8(a, c);
                        *(u32x4*)(dst + row * DM + 512 + u.pn * 256 + bj * 128 + cl0) = pack8(a, c); }
                    ss = red_fq(ss);
                    if (fq == 0) sq[row * 8 + u.pn * 4 + wc] = ss; }
        } break;
        case EK_WOUT: case EK_WXO: {
            bf16_t* hb = (bf16_t*)p1; float* sq = (float*)p2;
#pragma unroll
            for (int ai = 0; ai < 2; ++ai)
#pragma unroll
                for (int m = 0; m < 4; ++m) { const size_t row = (size_t)(rbase + ai * 128 + m * 16); float ss = 0.f;
#pragma unroll
                    for (int bj = 0; bj < 2; ++bj) { const size_t off = row * DM + u.pn * 256 + bj * 128 + cl0;
                        f32x4 a, c;
                        if (kind == EK_WOUT) { const float* base = (const float*)c0; const float rsy = rs8((const float*)c2, row); a = acc[ai][bj][m][0] * rsy + *(const f32x4*)(base + off); c = acc[ai][bj][m][1] * rsy + *(const f32x4*)(base + off + 4); }
                        else { const u32x4 bv = *(const u32x4*)((const bf16_t*)c0 + off);
                            a = acc[ai][bj][m][0] + (f32x4){bflo(bv.x), bfhi(bv.x), bflo(bv.y), bfhi(bv.y)}; c = acc[ai][bj][m][1] + (f32x4){bflo(bv.z), bfhi(bv.z), bflo(bv.w), bfhi(bv.w)}; }
                        ss += ssq8(a, c);
                        *(u32x4*)(hb + off) = pack8(a, c); }
                    ss = red_fq(ss);
                    if (fq == 0) sq[row * 16 + u.pn * 4 + wc] = ss; }
        } break;
        case EK_XQ: {
            bf16_t* dst = (bf16_t*)p0; float* sq = (float*)p1; const float* gq = (const float*)c0; const float* gk = (const float*)c1;
            f32x4 gg[2][2];
#pragma unroll
            for (int bj = 0; bj < 2; ++bj)
#pragma unroll
                for (int n = 0; n < 2; ++n) gg[bj][n] = *(const f32x4*)(gq + bj * 128 + cl0 + 4 * n) * *(const f32x4*)(gk + bj * 128 + cl0 + 4 * n);
#pragma unroll
            for (int ai = 0; ai < 2; ++ai)
#pragma unroll
                for (int m = 0; m < 4; ++m) { const size_t row = (size_t)(rbase + ai * 128 + m * 16);
                    float ss = ssq8(acc[ai][0][m][0], acc[ai][0][m][1]) + ssq8(acc[ai][1][m][0], acc[ai][1][m][1]);
                    ss = red_fq(ss);
                    if (fq == 0) sq[row * 16 + u.pn * 4 + wc] = ss;
#pragma unroll
                    for (int bj = 0; bj < 2; ++bj) *(u32x4*)(dst + row * DM + u.pn * 256 + bj * 128 + cl0) = pack8(acc[ai][bj][m][0] * gg[bj][0], acc[ai][bj][m][1] * gg[bj][1]); }
        } break;
        case EK_XS: {
            bf16_t* dst = (bf16_t*)p0; float* ps = (float*)p1; const float* s1 = (const float*)c0; const float* sqq = (const float*)c1; const float* sck = (const float*)c2;
            const int h = u.pn, b = u.pm >> 3;
            f32x4 kv[2][2];
#pragma unroll
            for (int bj = 0; bj < 2; ++bj)
#pragma unroll
                for (int n = 0; n < 2; ++n) kv[bj][n] = *(const f32x4*)(sck + (size_t)h * TM + b * 256 + bj * 128 + cl0 + 4 * n) * (LOG2E / 16.f);
#pragma unroll
            for (int ai = 0; ai < 2; ++ai)
#pragma unroll
                for (int m = 0; m < 4; ++m) { const size_t row = (size_t)(rbase + ai * 128 + m * 16);
                    const f32x4 t0 = *(const f32x4*)(s1 + row * 16), t1 = *(const f32x4*)(s1 + row * 16 + 4), t2 = *(const f32x4*)(s1 + row * 16 + 8), t3 = *(const f32x4*)(s1 + row * 16 + 12);
                    const float tot = ((t0[0] + t0[1]) + (t0[2] + t0[3])) + ((t1[0] + t1[1]) + (t1[2] + t1[3])) + ((t2[0] + t2[1]) + (t2[2] + t2[3])) + ((t3[0] + t3[1]) + (t3[2] + t3[3]));
                    const float rs1 = rsqrtf(tot * (1.f / DM) + EPS);
                    const f32x4 qq = *(const f32x4*)(sqq + row * 16 + h * 4);
                    const float sq = rs1 * rsqrtf(rs1 * rs1 * ((qq[0] + qq[1]) + (qq[2] + qq[3])) * (1.f / 256.f) + EPS);
                    float ss = 0.f;
#pragma unroll
                    for (int bj = 0; bj < 2; ++bj) { f32x4 a = acc[ai][bj][m][0] * kv[bj][0] * sq, c = acc[ai][bj][m][1] * kv[bj][1] * sq;
#pragma unroll
                        for (int j = 0; j < 4; ++j) { a[j] = __builtin_amdgcn_exp2f(a[j]); c[j] = __builtin_amdgcn_exp2f(c[j]); }
                        const u32x4 w = pack8(a, c);
                        ss += (bflo(w.x) + bfhi(w.x)) + (bflo(w.y) + bfhi(w.y)) + (bflo(w.z) + bfhi(w.z)) + (bflo(w.w) + bfhi(w.w));
                        *(u32x4*)(dst + row * DM + h * 256 + bj * 128 + cl0) = w; }
                    ss = red_fq(ss);
                    if (fq == 0) ps[row * 16 + h * 4 + wc] = ss; }
        } break;
        case EK_XO: {
            bf16_t* dst = (bf16_t*)p0; const float* ps = (const float*)c0; const int h = u.pn;
#pragma unroll
            for (int ai = 0; ai < 2; ++ai)
#pragma unroll
                for (int m = 0; m < 4; ++m) { const size_t row = (size_t)(rbase + ai * 128 + m * 16);
                    const f32x4 pp = *(const f32x4*)(ps + row * 16 + h * 4); const float inv = __builtin_amdgcn_rcpf((pp[0] + pp[1]) + (pp[2] + pp[3]));
#pragma unroll
                    for (int bj = 0; bj < 2; ++bj) *(u32x4*)(dst + row * DM + h * 256 + bj * 128 + cl0) = pack8(acc[ai][bj][m][0] * inv, acc[ai][bj][m][1] * inv); }
        } break;
        case EK_DOWN: {
            float* out = (float*)p0; const bf16_t* h2 = (const bf16_t*)c0;
#pragma unroll
            for (int ai = 0; ai < 2; ++ai)
#pragma unroll
                for (int m = 0; m < 4; ++m) { const size_t row = (size_t)(rbase + ai * 128 + m * 16);
#pragma unroll
                    for (int bj = 0; bj < 2; ++bj) { const size_t off = row * DM + u.pn * 256 + bj * 128 + cl0;
                        const u32x4 bv = *(const u32x4*)(h2 + off);
                        const f32x4 a = acc[ai][bj][m][0] + (f32x4){bflo(bv.x), bfhi(bv.x), bflo(bv.y), bfhi(bv.y)}, c = acc[ai][bj][m][1] + (f32x4){bflo(bv.z), bfhi(bv.z), bflo(bv.w), bfhi(bv.w)};
                        *(f32x4*)(out + off) = a; *(f32x4*)(out + off + 4) = c; } }
        } break;
        case EK_UPC: {
            bf16_t* A = (bf16_t*)p0; float* GHF = (float*)p1; float* GHL = (float*)p2; float* UH = (float*)p3; const float* s2 = (const float*)c0; const float* cw = (const float*)c1; const float* cbv = (const float*)c2;
            const int j0 = u.pn * 128 + cl0;
            float w0[8], w1[8], w2[8], bb[8];
#pragma unroll
            for (int i = 0; i < 2; ++i) { const f32x4 a0 = *(const f32x4*)(cw + j0 + 4 * i), a1 = *(const f32x4*)(cw + DFF + j0 + 4 * i), a2 = *(const f32x4*)(cw + 2 * DFF + j0 + 4 * i), a3 = *(const f32x4*)(cbv + j0 + 4 * i);
#pragma unroll
                for (int q = 0; q < 4; ++q) { w0[4 * i + q] = a0[q]; w1[4 * i + q] = a1[q]; w2[4 * i + q] = a2[q]; bb[4 * i + q] = a3[q]; } }
            float rsv[2][4];
#pragma unroll
            for (int ai = 0; ai < 2; ++ai)
#pragma unroll
                for (int m = 0; m < 4; ++m) rsv[ai][m] = s2[rbase + ai * 128 + m * 16];
            if (fr >= 14) {
#pragma unroll
                for (int ai = 0; ai < 2; ++ai) { const f32x4 g0 = acc[ai][0][3][0] * rsv[ai][3], g1 = acc[ai][0][3][1] * rsv[ai][3];
                    LAS float* hp = hx + ((ai * 2 + wr) * 2 + (fr - 14)) * 128 + cl0; *(LAS f32x4*)hp = g0; *(LAS f32x4*)(hp + 4) = g1;
                    if (ai == 1 && wr == 1) { float* gp = GHL + ((size_t)u.pm * 2 + (fr - 14)) * DFF + j0; *(f32x4*)gp = g0; *(f32x4*)(gp + 4) = g1; } } }
            if (wr == 0 && fr < 2) {
                const float rs = rsv[0][0]; float* gp = GHF + ((size_t)u.pm * 2 + fr) * DFF + j0; float* up = UH + ((size_t)u.pm * 2 + fr) * DFF + j0;
                *(f32x4*)gp = acc[0][0][0][0] * rs; *(f32x4*)(gp + 4) = acc[0][0][0][1] * rs; *(f32x4*)up = acc[0][1][0][0] * rs; *(f32x4*)(up + 4) = acc[0][1][0][1] * rs; }
            asm volatile("s_waitcnt lgkmcnt(0)" ::: "memory"); __builtin_amdgcn_s_barrier(); asm volatile("" ::: "memory");
#define ROR1(x) __builtin_bit_cast(float, __builtin_amdgcn_update_dpp(0, __builtin_bit_cast(int, (x)), 0x121, 0xF, 0xF, false))
#define ROR2(x) __builtin_bit_cast(float, __builtin_amdgcn_update_dpp(0, __builtin_bit_cast(int, (x)), 0x122, 0xF, 0xF, false))
#pragma unroll
            for (int ai = 0; ai < 2; ++ai) {
                const int grp = ai * 2 + wr;
                float p1v[8], p2v[8];
                { f32x4 h1a = (f32x4){0.f, 0.f, 0.f, 0.f}, h1b = h1a, h2a = h1a, h2b = h1a;
                  if (grp > 0) { const LAS float* hp = hx + ((grp - 1) * 2) * 128 + cl0; h2a = *(const LAS f32x4*)hp; h2b = *(const LAS f32x4*)(hp + 4); h1a = *(const LAS f32x4*)(hp + 128); h1b = *(const LAS f32x4*)(hp + 132); }
#pragma unroll
                  for (int i = 0; i < 4; ++i) { p1v[i] = h1a[i]; p1v[4 + i] = h1b[i]; p2v[i] = (fr == 0) ? h2a[i] : h1a[i]; p2v[4 + i] = (fr == 0) ? h2b[i] : h1b[i]; } }
#pragma unroll
                for (int m = 0; m < 4; ++m) { const float rs = rsv[ai][m]; const size_t row = (size_t)(rbase + ai * 128 + m * 16);
                    float gs[8], r[8];
#pragma unroll
                    for (int i = 0; i < 4; ++i) { gs[i] = acc[ai][0][m][0][i] * rs; gs[4 + i] = acc[ai][0][m][1][i] * rs; }
#pragma unroll
                    for (int i = 0; i < 8; ++i) { const float c1v = ROR1(gs[i]), c2v = ROR2(gs[i]);
                        const float g1 = (fr == 0) ? p1v[i] : c1v, g2 = (fr < 2) ? p2v[i] : c2v;
                        p1v[i] = c1v; p2v[i] = c2v;
                        const float z = bb[i] + w0[i] * g2 + w1[i] * g1 + w2[i] * gs[i];
                        const float uv = (i < 4 ? acc[ai][1][m][0][i & 3] : acc[ai][1][m][1][i & 3]) * rs;
                        r[i] = z * sigm(z) * uv; }
                    u32x4 o; o.x = pk2(r[0], r[1]); o.y = pk2(r[2], r[3]); o.z = pk2(r[4], r[5]); o.w = pk2(r[6], r[7]);
                    if (!(grp == 0 && m == 0 && fr < 2)) *(u32x4*)(A + row * DFF + j0) = o; } }
#undef ROR1
#undef ROR2
        } break;
        default: break;
        }
    }
};

namespace attn_body {
using bf16=__hip_bfloat16;
using s16x4=__attribute__((ext_vector_type(4)))short;
using f32x16=__attribute__((ext_vector_type(16)))float;
constexpr int NHEAD=NFH,D=64,ADM=NHEAD*D,OPITCH=1024;
constexpr int NW=8,QBLK=32,QB=QBLK*NW,KVBLK=64,NQB=SEQ/QB;
__device__ __forceinline__ int crow(int r,int hi){return (r&3)+8*(r>>2)+4*hi;}
#define SBAR() __builtin_amdgcn_sched_barrier(0)
__device__ __forceinline__ void cmask(f32x16&p0,f32x16&p1,int jb,int qrel,int hi){
  const float NEG=-INFINITY; int kb=64*jb+4*hi;
  #pragma unroll
  for(int r=0;r<16;++r){int kv=kb+(r&3)+8*(r>>2); if(kv>qrel)p0[r]=NEG; if(kv+32>qrel)p1[r]=NEG;}
}
constexpr int NSLOT=3, SLOTB=8192;
constexpr int LDS_K=0, LDS_V=NSLOT*SLOTB, LDS_WS=2*NSLOT*SLOTB, LDS_OST=LDS_WS+NW*64*4, LDS_BYTES=LDS_OST+NW*4096;
constexpr int LDS_BIAS=86016;
__device__ __forceinline__ void glds16(const void*gsrc,unsigned lds_dst){unsigned keep;
  asm volatile("s_mov_b32 %0, m0\n\ts_mov_b32 m0, %2\n\ts_nop 0\n\tglobal_load_lds_dwordx4 %1, off\n\ts_mov_b32 m0, %0":"=&s"(keep):"v"(gsrc),"s"(lds_dst):"memory");}
__device__ __forceinline__ float max3f(float a,float b,float c){float r;asm("v_max3_f32 %0, %1, %2, %3":"=v"(r):"v"(a),"v"(b),"v"(c));return r;}
__device__ __forceinline__ float max2f(float a,float b){float r;asm("v_max_f32_e32 %0, %1, %2":"=v"(r):"v"(a),"v"(b));return r;}
__device__ __forceinline__ float fadd_s(float a,float b){float r;asm("v_add_f32_e32 %0, %1, %2":"=v"(r):"v"(a),"v"(b));return r;}
__device__ __forceinline__ float fsub_s(float a,float b){float r;asm("v_sub_f32_e32 %0, %1, %2":"=v"(r):"v"(a),"v"(b));return r;}
typedef float f32x2_t __attribute__((ext_vector_type(2))); typedef __bf16 bf16x2_t __attribute__((ext_vector_type(2)));
__device__ __forceinline__ unsigned cvtpk_s(float lo,float hi){f32x2_t v={lo,hi};bf16x2_t b=__builtin_convertvector(v,bf16x2_t);return __builtin_bit_cast(unsigned,b);}
#define WAIT_BAR(N) asm volatile("s_waitcnt vmcnt(" #N ") lgkmcnt(0)\n\ts_barrier":::"memory")

__device__ __forceinline__ void qkt(f32x16&p0,f32x16&p1,const char*Kslot,const bf16x8*qr,const f32x16&negm,int r32,int hi){
  const char*kb=Kslot+hi*1024+r32*16;
  #pragma unroll
  for(int d0=0;d0<4;++d0){
    const bf16x8 b0=*reinterpret_cast<const bf16x8*>(kb+d0*2048);
    const bf16x8 b1=*reinterpret_cast<const bf16x8*>(kb+d0*2048+512);
    if(d0==0){p0=__builtin_amdgcn_mfma_f32_32x32x16_bf16(b0,qr[0],negm,0,0,0);p1=__builtin_amdgcn_mfma_f32_32x32x16_bf16(b1,qr[0],negm,0,0,0);}
    else{p0=__builtin_amdgcn_mfma_f32_32x32x16_bf16(b0,qr[d0],p0,0,0,0);p1=__builtin_amdgcn_mfma_f32_32x32x16_bf16(b1,qr[d0],p1,0,0,0);}}
}
typedef __attribute__((address_space(3))) const char* lds_cptr;
typedef short v4i16_t __attribute__((ext_vector_type(4)));
__device__ __forceinline__ void kload8(bf16x8*kf,lds_cptr kp){
  kf[0]=*(const __attribute__((address_space(3))) bf16x8*)(kp);      kf[1]=*(const __attribute__((address_space(3))) bf16x8*)(kp+512);
  kf[2]=*(const __attribute__((address_space(3))) bf16x8*)(kp+2048); kf[3]=*(const __attribute__((address_space(3))) bf16x8*)(kp+2560);
  kf[4]=*(const __attribute__((address_space(3))) bf16x8*)(kp+4096); kf[5]=*(const __attribute__((address_space(3))) bf16x8*)(kp+4608);
  kf[6]=*(const __attribute__((address_space(3))) bf16x8*)(kp+6144); kf[7]=*(const __attribute__((address_space(3))) bf16x8*)(kp+6656);
}
__device__ __forceinline__ void kload2(bf16x8*kf,lds_cptr kp,int j){ kf[2*j]=*(const __attribute__((address_space(3))) bf16x8*)(kp+j*2048); kf[2*j+1]=*(const __attribute__((address_space(3))) bf16x8*)(kp+j*2048+512); }
__device__ __forceinline__ s16x4 vtr(lds_cptr p){ return __builtin_bit_cast(s16x4,__builtin_amdgcn_ds_read_tr16_b64_v4i16((__attribute__((address_space(3))) v4i16_t*)p)); }
__device__ __forceinline__ float rowmax(const f32x16&p0,const f32x16&p1){
  float a=max3f(p0[0],p0[1],p1[0]),b=max3f(p0[2],p0[3],p1[1]);a=max3f(a,p1[2],p1[3]);
  #pragma unroll
  for(int r=4;r<16;r+=4){a=max3f(a,p0[r],p0[r+1]);b=max3f(b,p0[r+2],p0[r+3]);a=max3f(a,p1[r],p1[r+1]);b=max3f(b,p1[r+2],p1[r+3]);}
  const float m=max2f(a,b);
  auto rr=__builtin_amdgcn_permlane32_swap(__float_as_uint(m),__float_as_uint(m),false,false);
  return max2f(__uint_as_float(rr[0]),__uint_as_float(rr[1]));
}
__device__ __forceinline__ void pv(f32x16*o,int vb,bf16x8 pa0,bf16x8 pa1,bf16x8 pa2,bf16x8 pa3){
  #pragma unroll
  for(int d0=0;d0<2;++d0){s16x4 lo[4],hi[4];
    #pragma unroll
    for(int ks=0;ks<4;++ks){
      asm volatile("ds_read_b64_tr_b16 %0,%1 offset:%c2":"=&v"(lo[ks]):"v"(vb),"i"(d0*4096+ks*1024):"memory");
      asm volatile("ds_read_b64_tr_b16 %0,%1 offset:%c2":"=&v"(hi[ks]):"v"(vb),"i"(d0*4096+ks*1024+512):"memory");}
    asm volatile("s_waitcnt lgkmcnt(0)":::"memory");SBAR();
    #define PK(k) (bf16x8){lo[k][0],lo[k][1],lo[k][2],lo[k][3],hi[k][0],hi[k][1],hi[k][2],hi[k][3]}
    o[d0]=__builtin_amdgcn_mfma_f32_32x32x16_bf16(pa0,PK(0),o[d0],0,0,0);
    o[d0]=__builtin_amdgcn_mfma_f32_32x32x16_bf16(pa1,PK(1),o[d0],0,0,0);
    o[d0]=__builtin_amdgcn_mfma_f32_32x32x16_bf16(pa2,PK(2),o[d0],0,0,0);
    o[d0]=__builtin_amdgcn_mfma_f32_32x32x16_bf16(pa3,PK(3),o[d0],0,0,0);
    #undef PK
  }
}
typedef const __attribute__((address_space(3))) f32x4* lds_f4ptr;
#define BIASADD(P0,P1,t) do{ const lds_f4ptr bp_=(lds_f4ptr)(shm3+bias_off+((t)*64+4*hi)*4); \
    _Pragma("unroll") for(int j_=0;j_<4;++j_){ const f32x4 b0_=bp_[2*j_]-mhat, b1_=bp_[8+2*j_]-mhat; \
      P0[4*j_]+=b0_[0]; P0[4*j_+1]+=b0_[1]; P0[4*j_+2]+=b0_[2]; P0[4*j_+3]+=b0_[3]; \
      P1[4*j_]+=b1_[0]; P1[4*j_+1]+=b1_[1]; P1[4*j_+2]+=b1_[2]; P1[4*j_+3]+=b1_[3]; } }while(0)

#define CINIT(P0,P1,t) do{ const lds_f4ptr bp_=(lds_f4ptr)(shm3+bias_off+((t)*64+4*hi)*4); \
    _Pragma("unroll") for(int j_=0;j_<4;++j_){ const f32x4 b0_=bp_[2*j_]-mhat, b1_=bp_[8+2*j_]-mhat; \
      P0[4*j_]=b0_[0]; P0[4*j_+1]=b0_[1]; P0[4*j_+2]=b0_[2]; P0[4*j_+3]=b0_[3]; \
      P1[4*j_]=b1_[0]; P1[4*j_+1]=b1_[1]; P1[4*j_+2]=b1_[2]; P1[4*j_+3]=b1_[3]; } }while(0)
template<int THRL> __device__ __forceinline__ void attn_unit(int b,int h,int qb,const bf16*Q,const bf16*__restrict__ K,const bf16*__restrict__ V,bf16*O,const float*__restrict__ CB,float*__restrict__ SSQ,char*shm,const float skip_th){
  int tid=threadIdx.x; asm volatile("":"+v"(tid));
  const int lane=tid&63,r32=lane&31,hi=lane>>5; const int wid=__builtin_amdgcn_readfirstlane(tid>>6);
  const long rowbase=(long)b*SEQ; const int q0=qb*QB;
  const bf16*Qw=Q+(rowbase+q0+wid*QBLK)*ADM+h*D;
  int t0=0; { const float*cbh0=CB+(long)(b*NHEAD+h)*SEQ; const int npair=(q0+QB)/KVBLK/2-2; const float c0v=cbh0[q0];
    const bool far=(lane<npair)&&(cbh0[128*(lane<npair?lane:0)+127]-c0v>skip_th); const unsigned long long mk=__ballot(far);
    int lead=__builtin_ctzll(~mk); if(lead>npair)lead=npair; if(lead<0)lead=0; t0=2*__builtin_amdgcn_readfirstlane(lead); }
  const bf16*Kh=K+(rowbase+(long)t0*KVBLK)*ADM+h*D,*Vh=V+(rowbase+(long)t0*KVBLK)*ADM+h*D;
  const unsigned lds0=(unsigned)(uintptr_t)shm;
  float*wsf=(float*)(shm+LDS_WS)+wid*64;
  const lds_cptr shm3=(lds_cptr)shm;
  { const float*cbh=CB+(long)(b*NHEAD+h)*SEQ; const float cref=cbh[q0+128];
    if(tid*4<q0+QB){ const f32x4 c4=*(const f32x4*)(cbh+tid*4); *(__attribute__((address_space(3))) f32x4*)(shm3+LDS_BIAS+tid*16)=(f32x4){cref-c4[0],cref-c4[1],cref-c4[2],cref-c4[3]}; } }
  const bf16*ksrc=Kh+(long)lane*ADM+wid*8;
  const bf16*vsrc=Vh+(long)(16*(wid&3)+(lane>>2))*ADM+(wid>>2)*32+(lane&3)*8;
  const unsigned kdst=lds0+LDS_K+wid*1024, vdst=lds0+LDS_V+wid*1024;
  #define DMA_K(t,slot) glds16(ksrc+(long)(t)*KVBLK*ADM,(unsigned)__builtin_amdgcn_readfirstlane(kdst+(slot)))
  #define DMA_V(t,slot) glds16(vsrc+(long)(t)*KVBLK*ADM,(unsigned)__builtin_amdgcn_readfirstlane(vdst+(slot)))
  const int vb0=(int)(lds0+LDS_V)+((lane>>4)&1)*32+(lane&3)*8+(4*hi+((lane&15)>>2))*64;
  const char*Kbase=shm+LDS_K; bf16x8 kf[8];
  const lds_cptr kp0=shm3+LDS_K+hi*1024+r32*16; const lds_cptr vp0=shm3+LDS_V+((lane>>4)&1)*32+(lane&3)*8+(4*hi+((lane&15)>>2))*64;
  const int NT=(q0+QB)/KVBLK-t0; const int bias_off=LDS_BIAS+t0*KVBLK*4;
  DMA_K(0,0);DMA_V(0,0);DMA_K(1,SLOTB);
  bf16x8 qr[4];
  #pragma unroll
  for(int d0=0;d0<4;++d0)qr[d0]=*reinterpret_cast<const bf16x8*>(&Qw[(long)r32*ADM+d0*16+hi*8]);
  float mhat=0.f,l_reg=0.f;f32x16 o[2];o[0]=f32x16{};o[1]=f32x16{};const f32x16 negm=f32x16{};
  const int qrel=wid*QBLK+r32;
  #define CMASK(P0,P1,t) do{int jb_=(t)-(NT-4); if(jb_>=0)cmask(P0,P1,jb_,qrel,hi);}while(0)
  bool resc=false;
  #define START(P0,P1) do{ const float rm=rowmax(P0,P1); resc=false; \
    { const float dl=max2f(rm,-24.f); mhat=fadd_s(mhat,dl); \
      _Pragma("unroll") for(int r=0;r<16;++r){P0[r]=fsub_s(P0[r],dl);P1[r]=fsub_s(P1[r],dl);} } \
    _Pragma("unroll") for(int r=0;r<16;++r)P0[r]=__builtin_amdgcn_exp2f(P0[r]); }while(0)
  #define RESC() do{ if(resc){ asm volatile("s_waitcnt lgkmcnt(0)":::"memory"); \
      _Pragma("unroll") for(int d_=0;d_<2;++d_) _Pragma("unroll") for(int r=0;r<16;++r)o[d_][r]*=wsf[crow(r,hi)]; } }while(0)
  f32x16 pA0,pA1,pB0,pB1;
  int sl_prev=0,sl_cur=0,sl_next=SLOTB;
  #define ROT() do{sl_prev=sl_cur;sl_cur=sl_next;sl_next=(sl_next==(NSLOT-1)*SLOTB)?0:sl_next+SLOTB;}while(0)
  DMA_K(2,2*SLOTB);
  WAIT_BAR(3);
  qkt(pA0,pA1,Kbase,qr,negm,r32,hi);asm volatile("s_nop 15\n\ts_nop 7":"+v"(pA0),"+v"(pA1));BIASADD(pA0,pA1,0);CMASK(pA0,pA1,0);
  START(pA0,pA1);
  _Pragma("unroll") for(int r=0;r<16;++r)pA1[r]=__builtin_amdgcn_exp2f(pA1[r]);
  WAIT_BAR(0);
  DMA_K(3,0);DMA_V(1,SLOTB);
  ROT();
  kload8(kf,kp0+sl_cur);
  WAIT_BAR(2);
  s16x4 vlo[8],vhi[8]; u32x4 pw0,pw1,pw2,pw3;
  #define PKW(P,B) cvtpk_s(P[B],P[B+1])
  #define PAF(k) __builtin_bit_cast(bf16x8,pw##k)
  #define VFR(i) (bf16x8){vlo[i][0],vlo[i][1],vlo[i][2],vlo[i][3],vhi[i][0],vhi[i][1],vhi[i][2],vhi[i][3]}
  #define PIN(x) asm volatile("":"+v"(x))
  #define MX3(a,b,c) __builtin_fmaxf(__builtin_fmaxf((a),(b)),(c))
  #define GAPA(MF,A0,A1,A2,A3,W0,W1,PW) do{ MF; sacc+=A0; sacc+=A1; sacc+=A2; sacc+=A3; PIN(sacc); W0; W1; PIN(PW); SBAR(); }while(0)
  #define EX(v) __builtin_amdgcn_exp2f(v)
  #define GAPB(MF,X,B) do{ MF; X[B]=EX(X[B]); X[B+1]=EX(X[B+1]); X[B+2]=EX(X[B+2]); X[B+3]=EX(X[B+3]); PIN(X); SBAR(); }while(0)
  #define VRD(i) do{ vlo[i]=vtr(vp_+(((i)>>2)*4096+((i)&3)*1024)); vhi[i]=vtr(vp_+(((i)>>2)*4096+((i)&3)*1024+512)); }while(0)
  #define KRD(G,j) do{ if(G){ kload2(kf,kp0+sl_next,j); SBAR(); } }while(0)
  #define STEP(C0,C1,P0,P1,t,GK,GV,GL) do{ SBAR(); CINIT(C0,C1,t); SBAR(); \
    const lds_cptr vp_=vp0+sl_prev; \
    VRD(0); SBAR(); float sacc=(P0[0]+P0[1]); \
    GAPA(C0=__builtin_amdgcn_mfma_f32_32x32x16_bf16(kf[0],qr[0],C0,0,0,0), P0[2],P0[3],P0[4],P0[5],     pw0[0]=PKW(P0,0), pw0[1]=PKW(P0,2), pw0); \
    VRD(4); SBAR(); GAPA(C1=__builtin_amdgcn_mfma_f32_32x32x16_bf16(kf[1],qr[0],C1,0,0,0), P0[6],P0[7],P0[8],P0[9],     pw0[2]=PKW(P0,4), pw0[3]=PKW(P0,6), pw0); \
    VRD(1); SBAR(); GAPA(C0=__builtin_amdgcn_mfma_f32_32x32x16_bf16(kf[2],qr[1],C0,0,0,0),   P0[10],P0[11],P0[12],P0[13], pw1[0]=PKW(P0,8), pw1[1]=PKW(P0,10), pw1); \
    VRD(5); SBAR(); GAPA(C1=__builtin_amdgcn_mfma_f32_32x32x16_bf16(kf[3],qr[1],C1,0,0,0),   P0[14],P0[15],P1[0],P1[1],   pw1[2]=PKW(P0,12),pw1[3]=PKW(P0,14), pw1); \
    VRD(2); SBAR(); GAPA(C0=__builtin_amdgcn_mfma_f32_32x32x16_bf16(kf[4],qr[2],C0,0,0,0),   P1[2],P1[3],P1[4],P1[5],     pw2[0]=PKW(P1,0), pw2[1]=PKW(P1,2), pw2); \
    VRD(6); SBAR(); GAPA(C1=__builtin_amdgcn_mfma_f32_32x32x16_bf16(kf[5],qr[2],C1,0,0,0),   P1[6],P1[7],P1[8],P1[9],     pw2[2]=PKW(P1,4), pw2[3]=PKW(P1,6), pw2); \
    VRD(3); SBAR(); GAPA(C0=__builtin_amdgcn_mfma_f32_32x32x16_bf16(kf[6],qr[3],C0,0,0,0),   P1[10],P1[11],P1[12],P1[13], pw3[0]=PKW(P1,8), pw3[1]=PKW(P1,10), pw3); \
    VRD(7); SBAR(); GAPA(C1=__builtin_amdgcn_mfma_f32_32x32x16_bf16(kf[7],qr[3],C1,0,0,0),   P1[14],P1[15],0.f,0.f,       pw3[2]=PKW(P1,12),pw3[3]=PKW(P1,14), pw3); \
    l_reg+=sacc; \
    if(GK){DMA_K((t)+3,sl_cur);} if(GV){DMA_V((t)+1,sl_next);} \
    CMASK(C0,C1,t); \
    { float a=MX3(C0[0],C0[1],C1[0]),b=MX3(C0[2],C0[3],C1[1]); a=MX3(a,C1[2],C1[3]); \
      _Pragma("unroll") for(int r=4;r<16;r+=4){a=MX3(a,C0[r],C0[r+1]);b=MX3(b,C0[r+2],C0[r+3]);a=MX3(a,C1[r],C1[r+1]);b=MX3(b,C1[r+2],C1[r+3]);} \
      float rm=__builtin_fmaxf(a,b); { auto rr=__builtin_amdgcn_permlane32_swap(__float_as_uint(rm),__float_as_uint(rm),false,false); rm=__builtin_fmaxf(__uint_as_float(rr[0]),__uint_as_float(rr[1])); } \
      resc=false; \
      if(__builtin_expect(__any(rm>(float)THRL),0)){ const float dl=__builtin_fmaxf(rm,0.f); mhat+=dl; \
        _Pragma("unroll") for(int r=0;r<16;++r){C0[r]-=dl;C1[r]-=dl;} \
        const float f=__builtin_amdgcn_exp2f(-dl); l_reg*=f; if(hi==0)wsf[r32]=f; resc=true; } } \
    SBAR(); \
    GAPB(o[0]=__builtin_amdgcn_mfma_f32_32x32x16_bf16(PAF(0),VFR(0),o[0],0,0,0), C0,0); \
    GAPB(o[1]=__builtin_amdgcn_mfma_f32_32x32x16_bf16(PAF(0),VFR(4),o[1],0,0,0), C0,4); \
    KRD(GL,0); GAPB(o[0]=__builtin_amdgcn_mfma_f32_32x32x16_bf16(PAF(1),VFR(1),o[0],0,0,0), C0,8); \
    KRD(GL,1); GAPB(o[1]=__builtin_amdgcn_mfma_f32_32x32x16_bf16(PAF(1),VFR(5),o[1],0,0,0), C0,12); \
    KRD(GL,2); GAPB(o[0]=__builtin_amdgcn_mfma_f32_32x32x16_bf16(PAF(2),VFR(2),o[0],0,0,0), C1,0); \
    KRD(GL,3); GAPB(o[1]=__builtin_amdgcn_mfma_f32_32x32x16_bf16(PAF(2),VFR(6),o[1],0,0,0), C1,4); \
    GAPB(o[0]=__builtin_amdgcn_mfma_f32_32x32x16_bf16(PAF(3),VFR(3),o[0],0,0,0), C1,8); \
    GAPB(o[1]=__builtin_amdgcn_mfma_f32_32x32x16_bf16(PAF(3),VFR(7),o[1],0,0,0), C1,12); \
    }while(0)
  int t=1;
  #undef CMASK
  #define CMASK(P0,P1,t) do{}while(0)
  for(;t+5<NT;t+=2){
    STEP(pB0,pB1,pA0,pA1,t,true,true,true);     WAIT_BAR(2); RESC(); ROT();
    STEP(pA0,pA1,pB0,pB1,t+1,true,true,true);   WAIT_BAR(2); RESC(); ROT();
  }
  #undef CMASK
  #define CMASK(P0,P1,t) do{int jb_=(t)-(NT-4); if(jb_>=0)cmask(P0,P1,jb_,qrel,hi);}while(0)
  #define ENDW(tt) do{ if((tt)+3<NT){WAIT_BAR(2);} else if((tt)+2<NT){WAIT_BAR(1);} else {WAIT_BAR(0);} }while(0)
  for(;t+1<NT;t+=2){
    STEP(pB0,pB1,pA0,pA1,t,(t+3<NT),(t+1<NT),(t+1<NT));       ENDW(t);   RESC(); ROT();
    STEP(pA0,pA1,pB0,pB1,t+1,(t+4<NT),(t+2<NT),(t+2<NT));     ENDW(t+1); RESC(); ROT();
  }
  STEP(pB0,pB1,pA0,pA1,NT-1,false,false,false); RESC();
  { float sacc=pB0[0]+pB0[1]; _Pragma("unroll") for(int r=2;r<16;++r)sacc+=pB0[r]; _Pragma("unroll") for(int r=0;r<16;++r)sacc+=pB1[r]; l_reg+=sacc;
    pw0=(u32x4){PKW(pB0,0),PKW(pB0,2),PKW(pB0,4),PKW(pB0,6)};pw1=(u32x4){PKW(pB0,8),PKW(pB0,10),PKW(pB0,12),PKW(pB0,14)};pw2=(u32x4){PKW(pB1,0),PKW(pB1,2),PKW(pB1,4),PKW(pB1,6)};pw3=(u32x4){PKW(pB1,8),PKW(pB1,10),PKW(pB1,12),PKW(pB1,14)};
    SBAR(); pv(o,vb0+sl_cur,PAF(0),PAF(1),PAF(2),PAF(3)); }
  #undef PKW
  #undef PAF
  #undef VFR
  #undef PIN
  #undef MX3
  #undef GAPA
  #undef GAPB
  #undef EX
  #undef VRD
  #undef KRD
  #undef STEP
  #undef ENDW
  {auto rr=__builtin_amdgcn_permlane32_swap(__float_as_uint(l_reg),__float_as_uint(l_reg),false,false);l_reg=__uint_as_float(rr[0])+__uint_as_float(rr[1]);}
  if(hi==0)wsf[32+r32]=l_reg;asm volatile("s_waitcnt lgkmcnt(0)":::"memory");
  float rli[16];
  #pragma unroll
  for(int r=0;r<16;++r)rli[r]=__builtin_amdgcn_rcpf(wsf[32+crow(r,hi)]);
  int lane2=lane; asm volatile("":"+v"(lane2));
  bf16*Ow=O+(rowbase+q0+wid*QBLK)*OPITCH+h*D;
  { bf16*stg=(bf16*)(shm+LDS_OST)+wid*2048;
    #pragma unroll
    for(int r=0;r<16;++r){const int orow=crow(r,hi);
      #pragma unroll
      for(int d0=0;d0<2;++d0)stg[orow*64+d0*32+r32]=__float2bfloat16(o[d0][r]*rli[r]);}
    asm volatile("s_waitcnt lgkmcnt(0)":::"memory");
    #pragma unroll
    for(int i=0;i<4;++i){const int row=i*8+(lane2>>3),ch=lane2&7; const u32x4 v=*(const u32x4*)(stg+row*64+ch*8); *(u32x4*)(Ow+(long)row*OPITCH+ch*8)=v;
      float s=(bflo(v.x)*bflo(v.x)+bfhi(v.x)*bfhi(v.x))+(bflo(v.y)*bflo(v.y)+bfhi(v.y)*bfhi(v.y))+(bflo(v.z)*bflo(v.z)+bfhi(v.z)*bfhi(v.z))+(bflo(v.w)*bflo(v.w)+bfhi(v.w)*bfhi(v.w));
      s+=__shfl_xor(s,1); s+=__shfl_xor(s,2); s+=__shfl_xor(s,4);
      if(ch==0)SSQ[(rowbase+q0+wid*QBLK+row)*NHEAD+h]=s; } }
  asm volatile("s_waitcnt lgkmcnt(0)\n\ts_barrier":::"memory");
  #undef DMA_K
  #undef DMA_V
  #undef CMASK
  #undef START
  #undef RESC
  #undef ROT
}
#undef SBAR
#undef WAIT_BAR
}

constexpr int RING_BYTES = 131072;
constexpr int LDS_TOTAL = 147456;
struct Args { const float* in[32]; float* out; unsigned char* ws; };
typedef const float* const __attribute__((address_space(4)))* InTab;
enum In { I_X = 0, I_MEM, I_NORM_MIX, I_W_IN, I_FQN, I_FKN, I_FBIAS, I_ARE, I_AIM, I_LOGDT, I_BRE, I_BIM, I_CRE, I_CIM, I_D, I_WGLU, I_BGLU, I_ONF, I_ONS, I_WOUT,
          I_NCROSS, I_NMEM, I_WXQ, I_WXKV, I_XQN, I_XKN, I_WXO, I_NFFN, I_WUP, I_CONVW, I_CONVB, I_WDN };

struct TJob { const float* W; int ldw, col0, ncols, K; const float* kg; const float* kg2; bf16_t* WT; int mapid, rowoff, items; };
__device__ __forceinline__ int tmap(int mapid, int n, int rowoff) {
    if (mapid == 1) { const int part = n >> 9, f = n & 511, head = f >> 6, d = f & 63; return 512 * part + 256 * (head >> 2) + 128 * (d >> 5) + 32 * (head & 3) + (d & 31); }
    if (mapid == 2) { const int isup = n >= DFF ? 1 : 0; const int j = n - isup * DFF; return 256 * (j >> 7) + 128 * isup + (j & 127); }
    return rowoff + n;
}
__device__ __forceinline__ void transpose_item(const TJob& J, LAS float* scr, int item, int lane) {
    LAS unsigned* s32 = (LAS unsigned*)scr; const LAS unsigned short* s16 = (const LAS unsigned short*)scr;
    const int nblk = J.ncols / 128, kb = item / nblk, nb = item % nblk, k0 = 64 * kb, n0 = 128 * nb;
    const float* src = J.W + (size_t)k0 * J.ldw + J.col0 + n0 + 2 * lane;
    float gv = 1.f; if (J.kg) { const int k = k0 + lane; gv = (J.kg2 && k >= 512) ? J.kg2[k - 512] : J.kg[k]; }
#pragma unroll 16
    for (int kk = 0; kk < 64; ++kk) { f32x2 w = *(const f32x2*)(src + (size_t)kk * J.ldw);
        w = w * __builtin_bit_cast(float, __builtin_amdgcn_readlane(__builtin_bit_cast(int, gv), kk));
        s32[kk * 64 + lane] = pk2(w[0], w[1]); }
    asm volatile("s_waitcnt lgkmcnt(0)" ::: "memory");
    const int c = lane & 7;
#pragma unroll 4
    for (int j = 0; j < 16; ++j) { const int n = (lane >> 3) + 8 * j; const LAS unsigned short* s = s16 + (8 * c) * 128 + n;
        u32x4 o; o.x = (unsigned)s[0] | ((unsigned)s[128] << 16); o.y = (unsigned)s[256] | ((unsigned)s[384] << 16); o.z = (unsigned)s[512] | ((unsigned)s[640] << 16); o.w = (unsigned)s[768] | ((unsigned)s[896] << 16);
        *(u32x4*)(J.WT + (size_t)tmap(J.mapid, n0 + n, J.rowoff) * J.K + k0 + 8 * c) = o; }
    asm volatile("s_waitcnt lgkmcnt(0)" ::: "memory");
}
constexpr int NTJ = 11;
__device__ __forceinline__ void get_tjob(InTab in, unsigned char* ws, int j, TJob& J) {
    J.kg = nullptr; J.kg2 = nullptr; J.mapid = 0; J.rowoff = 0; J.col0 = 0;
    switch (j) {
    case 0: J.W = in[I_W_IN]; J.ldw = INCOLS; J.col0 = 0; J.ncols = 1024; J.K = 1024; J.WT = (bf16_t*)(ws + WS_WIN); J.mapid = 1; break;
    case 1: J.W = in[I_W_IN]; J.ldw = INCOLS; J.col0 = 1024; J.ncols = 512; J.K = 1024; J.WT = (bf16_t*)(ws + WS_WIN); J.rowoff = 1024; break;
    case 2: J.W = in[I_W_IN]; J.ldw = INCOLS; J.col0 = 1544; J.ncols = 512; J.K = 1024; J.WT = (bf16_t*)(ws + WS_WIN); J.rowoff = 1536; break;
    case 3: J.W = in[I_WGLU]; J.ldw = 512; J.ncols = 512; J.K = 512; J.WT = (bf16_t*)(ws + WS_WGLU); break;
    case 4: J.W = in[I_WOUT]; J.ldw = 1024; J.ncols = 1024; J.K = 1024; J.WT = (bf16_t*)(ws + WS_WOUT); J.kg = in[I_ONF]; J.kg2 = in[I_ONS]; break;
    case 5: J.W = in[I_WXQ]; J.ldw = 1024; J.ncols = 1024; J.K = 1024; J.WT = (bf16_t*)(ws + WS_WXQ); J.kg = in[I_NCROSS]; break;
    case 6: J.W = in[I_WXKV]; J.ldw = 2048; J.col0 = 0; J.ncols = 1024; J.K = 1024; J.WT = (bf16_t*)(ws + WS_WXK); break;
    case 7: J.W = in[I_WXKV]; J.ldw = 2048; J.col0 = 1024; J.ncols = 1024; J.K = 1024; J.WT = (bf16_t*)(ws + WS_WXV); break;
    case 8: J.W = in[I_WXO]; J.ldw = 1024; J.ncols = 1024; J.K = 1024; J.WT = (bf16_t*)(ws + WS_WXO); break;
    case 9: J.W = in[I_WUP]; J.ldw = 2 * DFF; J.ncols = 2 * DFF; J.K = 1024; J.WT = (bf16_t*)(ws + WS_WUP); J.kg = in[I_NFFN]; J.mapid = 2; break;
    default: J.W = in[I_WDN]; J.ldw = 1024; J.ncols = 1024; J.K = DFF; J.WT = (bf16_t*)(ws + WS_WDN); break;
    }
    J.items = (J.K / 64) * (J.ncols / 128);
}

__device__ __forceinline__ void rms_row(const float* xrow, const float* gain, bf16_t* orow, int lane, f32x4 (&v)[4]) {
    const f32x4* xr = (const f32x4*)xrow + lane; float s = 0.f;
#pragma unroll
    for (int j = 0; j < 4; ++j) { v[j] = xr[64 * j]; s += (v[j][0] * v[j][0] + v[j][1] * v[j][1]) + (v[j][2] * v[j][2] + v[j][3] * v[j][3]); }
    const float rs = rsqrtf(wave_sum(s) * (1.f / DM) + EPS);
    u32x2* o8 = (u32x2*)orow + lane;
#pragma unroll
    for (int j = 0; j < 4; ++j) { v[j] = v[j] * rs * ((const f32x4*)gain)[64 * j + lane]; u32x2 w; w.x = pk2(v[j][0], v[j][1]); w.y = pk2(v[j][2], v[j][3]); o8[64 * j] = w; }
}

__device__ __forceinline__ void cpow(float ar, float ai, float dt, float e, float& r, float& i) {
    const float mag = __expf(ar * dt * e);
    float rev = ai * dt * e * 0.15915494309189535f; rev -= rintf(rev);
    const float ang = rev * 6.283185307179586f;
    r = mag * cosf(ang); i = mag * sinf(ang);
}

template <int NT>
__device__ __forceinline__ void s5_prep_task(InTab in, unsigned char* ws, int g, int tt, LAS float* L, int tid, bool valid) {
    LAS float* pwA = L; LAS float* pwB = L + 128; LAS float* pwC = L + 256; LAS float* cf = L + 384; LAS float* bb = L + 512; LAS float* cc = L + 512 + 2048;
    if (valid) {
        const float dt = __expf(in[I_LOGDT][g]);
        if (tid < 64) { const int p = tid; const float ar = in[I_ARE][g * 64 + p], ai = in[I_AIM][g * 64 + p];
            float r, i; cpow(ar, ai, dt, (float)tt, r, i); pwA[2 * p] = r; pwA[2 * p + 1] = i;
            cpow(ar, ai, dt, (float)(tt + 1), r, i); pwB[2 * p] = r; pwB[2 * p + 1] = i;
            cpow(ar, ai, dt, (float)(TC - 1 - tt), r, i); pwC[2 * p] = r; pwC[2 * p + 1] = i;
            float lr, li; cpow(ar, ai, dt, 1.f, lr, li);
            const float den = ar * ar + ai * ai, nr = lr - 1.f;
            cf[2 * p] = (nr * ar + li * ai) / den; cf[2 * p + 1] = (li * ar - nr * ai) / den;
            if (tt == 0) { cpow(ar, ai, dt, (float)TC, r, i); float* lb = (float*)(ws + WS_LB32); lb[(g * 64 + p) * 2] = r; lb[(g * 64 + p) * 2 + 1] = i; } }
        for (int idx = tid; idx < 1024; idx += NT) { cc[2 * idx] = in[I_CRE][g * 1024 + idx]; cc[2 * idx + 1] = in[I_CIM][g * 1024 + idx]; }
    }
    __syncthreads();
    if (valid)
        for (int idx = tid; idx < 1024; idx += NT) { const int p = idx >> 4; const float br = in[I_BRE][g * 1024 + idx], bi = in[I_BIM][g * 1024 + idx], cr = cf[2 * p], ci = cf[2 * p + 1];
            bb[2 * idx] = cr * br - ci * bi; bb[2 * idx + 1] = cr * bi + ci * br; }
    __syncthreads();
    if (valid) {
        for (int e = tid; e < 256; e += NT) {
            const int c = e >> 4, cp = e & 15; float s = 0.f;
            for (int p = 0; p < 64; ++p) { const float pr = pwA[2 * p], pi = pwA[2 * p + 1], br = bb[2 * (p * 16 + cp)], bi = bb[2 * (p * 16 + cp) + 1];
                const float mr = pr * br - pi * bi, mi = pr * bi + pi * br; s += cc[2 * (c * 64 + p)] * mr - cc[2 * (c * 64 + p) + 1] * mi; }
            if (tt == 0 && c == cp) s += in[I_D][g * 16 + c];
            ((float*)(ws + WS_KTAB))[((g * TC + tt) * 16 + c) * 16 + cp] = s; }
        bf16_t* bty = (bf16_t*)(ws + WS_BTY) + (size_t)g * 512 * UGP; bf16_t* bte = (bf16_t*)(ws + WS_BTE) + (size_t)g * 256 * 512;
        for (int idx = tid; idx < 1024; idx += NT) { const int c = idx >> 6, p = idx & 63;
            const float cr = cc[2 * idx], ci = cc[2 * idx + 1], pr = pwB[2 * p], pi = pwB[2 * p + 1];
            const float zr = cr * pr - ci * pi, zi = cr * pi + ci * pr;
            *(unsigned*)(bty + (size_t)(tt * 16 + c) * UGP + 512 + 2 * p) = pk2(zr, -zi); }
        for (int idx = tid; idx < 1024; idx += NT) { const int p = idx >> 4, cp = idx & 15;
            const float pr = pwC[2 * p], pi = pwC[2 * p + 1], br = bb[2 * idx], bi = bb[2 * idx + 1];
            bte[(size_t)(2 * p) * 512 + tt * 16 + cp] = (bf16_t)f2bf(pr * br - pi * bi); bte[(size_t)(2 * p + 1) * 512 + tt * 16 + cp] = (bf16_t)f2bf(pr * bi + pi * br); }
        for (int u = tid; u < 256; u += NT) *(u32x4*)(bte + (size_t)(128 + (u >> 1)) * 512 + tt * 16 + (u & 1) * 8) = (u32x4){0u, 0u, 0u, 0u};
    }
    __syncthreads();
}

#define RLX_AGENT __ATOMIC_RELAXED, __HIP_MEMORY_SCOPE_AGENT
#define XB_TMO      128
#define XB_XCNT(j)  (256  + 64 * (j))
#define XB_XSUB(j)  (1280 + 64 * (j))
#define XB_XGEN(j)  (2304 + 64 * (j))
#define XB_TOP      3328
#define XB_TOPGEN   3392
#define XCD_BAR_WORDS 3456
#define XB_SPIN_CAP (1u << 18)

__device__ __forceinline__ unsigned xb_ld(unsigned* p)              { return __hip_atomic_load(p, __ATOMIC_RELAXED, __HIP_MEMORY_SCOPE_AGENT); }
__device__ __forceinline__ unsigned xb_add(unsigned* p, unsigned v) { return __hip_atomic_fetch_add(p, v, __ATOMIC_RELAXED, __HIP_MEMORY_SCOPE_AGENT); }
__device__ __forceinline__ unsigned xb_xcc_id() { return (unsigned)__builtin_amdgcn_s_getreg((3 << 11) | 20) & 0xFu; }
#define XB_SPIN(cond, bar) do { unsigned _sp = 0; while (cond) { __builtin_amdgcn_s_sleep(1); \
    if ((++_sp & 255u) == 0u) { if (xb_ld(&(bar)[XB_TMO])) break; if (_sp > XB_SPIN_CAP) { atomicAdd(&(bar)[XB_TMO], 1u); break; } } } } while (0)

struct XcdBarrier {
    unsigned* bar; unsigned x;
    volatile LAS unsigned* st;
};

__device__ __forceinline__ XcdBarrier xcd_barrier_post(unsigned* bar, volatile LAS unsigned* st) {
    XcdBarrier b; b.bar = bar; b.x = xb_xcc_id(); b.st = st;
    if (threadIdx.x == 0) (void)xb_add(&bar[XB_XCNT(b.x)], 1u);
    return b;
}
__device__ __forceinline__ void xcd_barrier_complete(unsigned* bar, unsigned x, unsigned& nloc, unsigned& nx) {
    const unsigned G = gridDim.x * gridDim.y * gridDim.z;
    unsigned sum, cnt, mine, sp = 0u;
    for (;;) {
        sum = 0u; cnt = 0u; mine = 0u;
#pragma unroll
        for (unsigned j = 0; j < 16; ++j) { const unsigned c = xb_ld(&bar[XB_XCNT(j)]); sum += c; cnt += (c > 0u) ? 1u : 0u; mine = (j == x) ? c : mine; }
        if (sum == G) break;
        __builtin_amdgcn_s_sleep(1);
        if ((++sp & 255u) == 0u) { if (xb_ld(&bar[XB_TMO])) break; if (sp > XB_SPIN_CAP) { atomicAdd(&bar[XB_TMO], 1u); break; } }
    }
    nloc = mine > 0u ? mine : 1u; nx = cnt > 0u ? cnt : 1u;
}

__device__ __forceinline__ void xcd_barrier(const XcdBarrier& b) {
    asm volatile("s_waitcnt vmcnt(0)" ::: "memory");
    __syncthreads();
    if (threadIdx.x == 0) {
        unsigned* bar = b.bar;
        __builtin_amdgcn_s_waitcnt(0);
        unsigned nloc = b.st[0], nx = b.st[1];
        if (nloc == 0u) { xcd_barrier_complete(bar, b.x, nloc, nx); b.st[0] = nloc; b.st[1] = nx; }
        const unsigned old = xb_add(&bar[XB_XSUB(b.x)], 1u);
        const unsigned gen = old / nloc;
        if (old + 1u == (gen + 1u) * nloc) {
            __builtin_amdgcn_fence(__ATOMIC_RELEASE, "agent");
            asm volatile("s_waitcnt vmcnt(0)" ::: "memory");
            const unsigned og = xb_add(&bar[XB_TOP], 1u);
            const unsigned tg = og / nx;
            if (og + 1u == (tg + 1u) * nx) xb_add(&bar[XB_TOPGEN], 1u);
            else XB_SPIN(xb_ld(&bar[XB_TOPGEN]) == tg, bar);
            __builtin_amdgcn_fence(__ATOMIC_ACQUIRE, "agent");
            xb_add(&bar[XB_XGEN(b.x)], 1u);
            asm volatile("s_waitcnt vmcnt(0)" ::: "memory");
        } else {
            XB_SPIN(xb_ld(&bar[XB_XGEN(b.x)]) == gen, bar);
            __builtin_amdgcn_fence(__ATOMIC_ACQUIRE, "agent");
            asm volatile("s_waitcnt vmcnt(0)" ::: "memory");
        }
    }
    __syncthreads();
}


#ifndef FIRST_STEP
#define FIRST_STEP 0
#endif
#ifndef LAST_STEP
#define LAST_STEP 18
#endif
#define ON(n) (FIRST_STEP <= (n) && (n) <= LAST_STEP)
#define SYNC(n) do { if ((n) < LAST_STEP) { XcdBarrier bar_; bar_.bar = (unsigned*)ws; bar_.x = xb_xcc_id(); bar_.st = (volatile LAS unsigned*)(L + RING_BYTES + 352); xcd_barrier(bar_); } } while (0)
#define WSB(off) ((const bf16_t*)(ws + (off)))
__global__ void __launch_bounds__(512, 2) fox_s5_mega(Args a) {
    extern __shared__ __attribute__((aligned(16))) unsigned char lds[];
    LAS unsigned char* L = (LAS unsigned char*)lds;
    const int G = gridDim.x, bx = blockIdx.x, NGW = G * 8, NGT = G * 512;
#define KA const __attribute__((address_space(4))) unsigned char* ka_ = (const __attribute__((address_space(4))) unsigned char*)__builtin_amdgcn_kernarg_segment_ptr(); asm volatile("" : "+s"(ka_)); \
    InTab in = (InTab)ka_; float* out = *(float* const __attribute__((address_space(4)))*)(ka_ + 256); unsigned char* ws = *(unsigned char* const __attribute__((address_space(4)))*)(ka_ + 264); (void)in; (void)out;
#define IDS int tid = threadIdx.x; asm volatile("" : "+v"(tid)); const int lane = tid & 63, wave = __builtin_amdgcn_readfirstlane(tid >> 6); const int gw = bx * 8 + wave, gt = bx * 512 + tid; (void)lane; (void)gw; (void)gt;
    {
        KA
        if (threadIdx.x < 8) ((volatile LAS unsigned*)(L + RING_BYTES + 320))[threadIdx.x + 8 - 8] = 0u;
        if (threadIdx.x < 2) ((volatile LAS unsigned*)(L + RING_BYTES + 352))[threadIdx.x] = 0u;
        __syncthreads();
        (void)xcd_barrier_post((unsigned*)ws, (volatile LAS unsigned*)(L + RING_BYTES + 352));
    }

    if (ON(0)) {
        KA
        IDS
        LAS float* scr = (LAS float*)(L + wave * 16384);
        { int base = 0;
          for (int j = 0; j < NTJ; ++j) { TJob J; get_tjob(in, ws, j, J);
              int first = gw - (base % NGW); if (first < 0) first += NGW;
              for (int it = first; it < J.items; it += NGW) transpose_item(J, scr, it, lane);
              base += J.items; } }
        __syncthreads();
        LAS float* wf = (LAS float*)L;
        for (int idx = tid; idx < 8192; idx += 512) wf[idx] = in[I_W_IN][(size_t)(idx >> 3) * INCOLS + 1536 + (idx & 7)];
        __syncthreads();
        {
            f32x4 nx[4];
            if (gw < T) { const f32x4* xr = (const f32x4*)(in[I_X] + (size_t)gw * DM) + lane;
#pragma unroll
                for (int j = 0; j < 4; ++j) nx[j] = xr[64 * j]; }
            const f32x4* gp = (const f32x4*)in[I_NORM_MIX]; f32x4 gn[4];
#pragma unroll
            for (int j = 0; j < 4; ++j) gn[j] = gp[64 * j + lane];
            const float fbias = in[I_FBIAS][lane & 7];
            for (int m = gw; m < T; m += NGW) {
                f32x4 v[4]; float s = 0.f;
#pragma unroll
                for (int j = 0; j < 4; ++j) { v[j] = nx[j]; s += (v[j][0] * v[j][0] + v[j][1] * v[j][1]) + (v[j][2] * v[j][2] + v[j][3] * v[j][3]); }
                if (m + NGW < T) { const f32x4* xr = (const f32x4*)(in[I_X] + (size_t)(m + NGW) * DM) + lane;
#pragma unroll
                    for (int j = 0; j < 4; ++j) nx[j] = xr[64 * j]; }
                const float rs = rsqrtf(wave_sum(s) * (1.f / DM) + EPS);
                u32x2* o8 = (u32x2*)((bf16_t*)(ws + WS_HN) + (size_t)m * DM) + lane;
#pragma unroll
                for (int j = 0; j < 4; ++j) { v[j] = v[j] * rs * gn[j]; u32x2 w; w.x = pk2(v[j][0], v[j][1]); w.y = pk2(v[j][2], v[j][3]); o8[64 * j] = w; }
                float d[8];
#pragma unroll
                for (int h = 0; h < 8; ++h) d[h] = 0.f;
#pragma unroll
                for (int j = 0; j < 4; ++j)
#pragma unroll
                    for (int i = 0; i < 4; ++i) { const int k = 256 * j + 4 * lane + i; const f32x4 w0 = *(const LAS f32x4*)(wf + k * 8), w1 = *(const LAS f32x4*)(wf + k * 8 + 4);
                        d[0] += v[j][i] * w0[0]; d[1] += v[j][i] * w0[1]; d[2] += v[j][i] * w0[2]; d[3] += v[j][i] * w0[3];
                        d[4] += v[j][i] * w1[0]; d[5] += v[j][i] * w1[1]; d[6] += v[j][i] * w1[2]; d[7] += v[j][i] * w1[3]; }
                float e4[4];
#pragma unroll
                for (int h = 0; h < 4; ++h) { const float keep = (lane & 4) ? d[h + 4] : d[h], give = (lane & 4) ? d[h] : d[h + 4]; e4[h] = keep + __shfl_xor(give, 4); }
                float e2[2];
#pragma unroll
                for (int h = 0; h < 2; ++h) { const float keep = (lane & 2) ? e4[h + 2] : e4[h], give = (lane & 2) ? e4[h] : e4[h + 2]; e2[h] = keep + __shfl_xor(give, 2); }
                float z; { const float keep = (lane & 1) ? e2[1] : e2[0], give = (lane & 1) ? e2[0] : e2[1]; z = keep + __shfl_xor(give, 1); }
                z += __shfl_xor(z, 8); z += __shfl_xor(z, 16); z += __shfl_xor(z, 32);
                if (lane < 8) {
                    z += fbias;
                    const float ls = fminf(z, 0.f) - __logf(1.f + __expf(-fabsf(z)));
                    const int b = m >> 11, t = m & 2047;
                    ((float*)(ws + WS_LOGF))[(size_t)(b * 8 + lane) * SEQ + t] = ls; }
            }
        }
        for (int m = gw; m < TM; m += NGW) { f32x4 v[4]; rms_row(in[I_MEM] + (size_t)m * DM, in[I_NMEM], (bf16_t*)(ws + WS_MN) + (size_t)m * DM, lane, v); }
        __syncthreads();
        {
            const int NTASK = S5G * TC, sub = tid >> 7, ltid = tid & 127, per = NTASK / G;
            for (int i0 = 0; bx + i0 * G < NTASK; i0 += 4) { const int task = bx + (i0 + sub) * G; const bool valid = task < NTASK;
                const int t2 = !valid ? 0 : ((NTASK % G == 0) ? (task % G) * per + task / G : task);
                s5_prep_task<128>(in, ws, t2 / TC, t2 % TC, (LAS float*)L + sub * 5120, ltid, valid); }
        }
        SYNC(0);
    }
    if (ON(2)) {
        KA
        pg8::Gemm g{WSB(WS_HN), WSB(WS_WIN), DM, DM, DM}; GOrder<OK_PLAIN> S; S.init(T / 256, 8, G, bx, DM, DM);
        Epi<EK_PROJ> E{ws + WS_Q, ws + WS_K, ws + WS_V, ws + WS_UG, in[I_FQN], in[I_FKN], nullptr};
        pg8::gemm_phase(L, g, S, E);
    }
    if (ON(1)) {
        KA
        IDS
        int seq = (bx < BATCH * NFH) ? bx : -1;
        if (G == 256) seq = (bx >= 64 && bx < 128) ? bx - 64 : ((bx >= 192) ? bx - 128 : -1);
        if (wave == 0 && seq >= 0) {
            const float* lf = (const float*)(ws + WS_LOGF) + (size_t)seq * SEQ + lane * 32; float* cb = (float*)(ws + WS_CB) + (size_t)seq * SEQ + lane * 32;
            f32x4 x[8]; float run = 0.f;
#pragma unroll
            for (int j = 0; j < 8; ++j) { x[j] = ((const f32x4*)lf)[j]; x[j][0] += run; x[j][1] += x[j][0]; x[j][2] += x[j][1]; x[j][3] += x[j][2]; run = x[j][3]; }
            float incl = run;
#pragma unroll
            for (int o = 1; o < 64; o <<= 1) { const float y = __shfl_up(incl, o); if (lane >= o) incl += y; }
            const float excl = incl - run;
#pragma unroll
            for (int j = 0; j < 8; ++j) ((f32x4*)cb)[j] = (x[j] + excl) * LOG2E;
        }
    }
    if (ON(3)) {
        KA
        pg8::Gemm g{WSB(WS_MN), WSB(WS_WXK), DM, DM, DM}; GOrder<OK_PLAIN> S; S.init(TM / 256, 4, G, bx, DM, DM);
        Epi<EK_MEMK> E{ws + WS_KST, ws + WS_SSQK, nullptr, nullptr, nullptr, nullptr, nullptr};
        pg8::gemm_phase(L, g, S, E);
    }
    if (ON(4)) {
        KA
        pg8::Gemm g{WSB(WS_WXV), WSB(WS_MN), DM, DM, DM}; GOrder<OK_PLAIN> S; S.init(4, TM / 256, G, (bx + 128) % G, DM, DM);
        Epi<EK_MEMVT> E{ws + WS_VT, nullptr, nullptr, nullptr, nullptr, nullptr, nullptr};
        pg8::gemm_phase(L, g, S, E);
        SYNC(4);
    }
    if (ON(5)) {
        KA
        const int vcu = (G % 8 == 0) ? (bx % 8) * (G / 8) + bx / 8 : bx;
        float skip_th; { const int ln = threadIdx.x & 63; float gq = fabsf(in[I_FQN][ln]), gk = fabsf(in[I_FKN][ln]);
#pragma unroll
            for (int o = 1; o < 64; o <<= 1) { gq = fmaxf(gq, __shfl_xor(gq, o)); gk = fmaxf(gk, __shfl_xor(gk, o)); }
            skip_th = 2.f * (64.f * C2Q * gq * gk) + 40.f; }
        for (int L2 = vcu; L2 < BATCH * NFH * 2; L2 += G) { const int bh = L2 >> 1, s = L2 & 1;
            for (int i = 0; i < 4; ++i) { const int qb = (i == 0) ? s : (i == 1) ? 3 - s : (i == 2) ? 4 + s : 7 - s;
                attn_body::attn_unit<8>(bh >> 3, bh & 7, qb, (const attn_body::bf16*)(ws + WS_Q), (const attn_body::bf16*)(ws + WS_K), (const attn_body::bf16*)(ws + WS_V),
                                        (attn_body::bf16*)(ws + WS_MIXN), (const float*)(ws + WS_CB), (float*)(ws + WS_SSQF), (char*)lds, skip_th); } }
    }
    if (ON(6)) {
        KA
        pg8::Gemm g{WSB(WS_UG), WSB(WS_BTE), UGP, 512, 256}; GOrder<OK_S5E> S; S.init(256, 1, G, bx, UGP, 512);
        Epi<EK_S5E> E{ws + WS_EPART, nullptr, nullptr, nullptr, nullptr, nullptr, nullptr};
        pg8::gemm_phase(L, g, S, E);
        SYNC(6);
    }
    if (ON(7)) {
        KA
        IDS
        const float* kt = (const float*)(ws + WS_KTAB); bf16_t* bty = (bf16_t*)(ws + WS_BTY);
        for (int idx = gt; idx < S5G * 512 * 64; idx += NGT) {
            const int half = idx & 1, ss = (idx >> 1) & 31, nn = (idx >> 6) & 511, gI = idx >> 15; const int tt = nn >> 4, c = nn & 15;
            u32x4 w = (u32x4){0u, 0u, 0u, 0u};
            if (ss <= tt) { const float* src = kt + ((size_t)((gI * TC + (tt - ss)) * 16 + c)) * 16 + half * 8; const f32x4 k0 = *(const f32x4*)src, k1 = *(const f32x4*)(src + 4);
                w.x = pk2(k0[0], k0[1]); w.y = pk2(k0[2], k0[3]); w.z = pk2(k1[0], k1[1]); w.w = pk2(k1[2], k1[3]); }
            *(u32x4*)(bty + ((size_t)gI * 512 + nn) * UGP + ss * 16 + half * 8) = w; }
        const float* ep = (const float*)(ws + WS_EPART); const float* lb = (const float*)(ws + WS_LB32); bf16_t* ug = (bf16_t*)(ws + WS_UG);
        for (int idx = gt; idx < S5G * BATCH * S5P; idx += NGT) { const int p = idx & 63, gb = idx >> 6, gI = gb >> 4;
            const float lr = lb[(gI * 64 + p) * 2], li = lb[(gI * 64 + p) * 2 + 1]; float sr = 0.f, si = 0.f;
            for (int k0 = 0; k0 < NCH; k0 += 16) {
                f32x2 e0[16], e1[16];
#pragma unroll
                for (int j = 0; j < 16; ++j) { const size_t row = (size_t)gb * NCH + k0 + j; e0[j] = *(const f32x2*)(ep + row * 128 + 2 * p); e1[j] = *(const f32x2*)(ep + (size_t)32768 * 128 + row * 128 + 2 * p); }
#pragma unroll
                for (int j = 0; j < 16; ++j) { const size_t row = (size_t)gb * NCH + k0 + j;
                    *(unsigned*)(ug + row * UGP + 512 + 2 * p) = pk2(sr, si);
                    const float nr = lr * sr - li * si + (e0[j][0] + e1[j][0]), ni = lr * si + li * sr + (e0[j][1] + e1[j][1]); sr = nr; si = ni; } } }
        SYNC(7);
    }
    if (ON(8)) {
        KA
        pg8::Gemm g{WSB(WS_UG), WSB(WS_BTY), UGP, UGP, UGP}; GOrder<OK_S5Y> S; S.init(256, 1, G, bx, UGP, UGP);
        Epi<EK_S5Y> E{ws + WS_Y1, nullptr, nullptr, nullptr, nullptr, nullptr, nullptr};
        pg8::gemm_phase(L, g, S, E);
        SYNC(8);
    }
    if (ON(9)) {
        KA
        pg8::Gemm g{WSB(WS_Y1), WSB(WS_WGLU), 512, 512, 512}; GOrder<OK_PLAIN> S; S.init(T / 256, 2, G, bx, 512, 512);
        Epi<EK_GLU> E{ws + WS_MIXN, ws + WS_SSQY, nullptr, nullptr, ws + WS_Y1, in[I_BGLU], nullptr};
        pg8::gemm_phase(L, g, S, E);
        SYNC(9);
    }
    if (ON(11)) {
        KA
        pg8::Gemm g{WSB(WS_MIXN), WSB(WS_WOUT), DM, DM, DM}; GOrder<OK_PLAIN> S; S.init(T / 256, 4, G, bx, DM, DM);
        Epi<EK_WOUT> E{nullptr, ws + WS_H1B, ws + WS_SSQ1, nullptr, in[I_X], ws + WS_SSQF, ws + WS_SSQY};
        pg8::gemm_phase(L, g, S, E);
        SYNC(11);
    }
    if (ON(12)) {
        KA
        IDS
        const float* sk = (const float*)(ws + WS_SSQK); float* sck = (float*)(ws + WS_SCK);
        for (int idx = gt; idx < TM * 4; idx += NGT) { const int key = idx >> 2, h = idx & 3; const f32x4 q = *(const f32x4*)(sk + (size_t)key * 16 + h * 4);
            sck[(size_t)h * TM + key] = rsqrtf(((q[0] + q[1]) + (q[2] + q[3])) * (1.f / 256.f) + EPS); }
        pg8::Gemm g{WSB(WS_H1B), WSB(WS_WXQ), DM, DM, DM}; GOrder<OK_PLAIN> S; S.init(T / 256, 4, G, bx, DM, DM);
        Epi<EK_XQ> E{ws + WS_QST, ws + WS_SSQQ, nullptr, nullptr, in[I_XQN], in[I_XKN], nullptr};
        pg8::gemm_phase(L, g, S, E);
        SYNC(12);
    }
    if (ON(13)) {
        KA
        pg8::Gemm g{WSB(WS_QST), WSB(WS_KST), DM, DM, 256}; GOrder<OK_XS> S; S.init(512, 1, G, bx, DM, DM);
        Epi<EK_XS> E{ws + WS_P, ws + WS_PSUM, nullptr, nullptr, ws + WS_SSQ1, ws + WS_SSQQ, ws + WS_SCK};
        pg8::gemm_phase(L, g, S, E);
        SYNC(13);
    }
    if (ON(14)) {
        KA
        pg8::Gemm g{WSB(WS_P), WSB(WS_VT), DM, TM, 256}; GOrder<OK_XO> S; S.init(512, 1, G, bx, DM, TM);
        Epi<EK_XO> E{ws + WS_XO, nullptr, nullptr, nullptr, ws + WS_PSUM, nullptr, nullptr};
        pg8::gemm_phase(L, g, S, E);
        SYNC(14);
    }
    if (ON(15)) {
        KA
        pg8::Gemm g{WSB(WS_XO), WSB(WS_WXO), DM, DM, DM}; GOrder<OK_PLAIN> S; S.init(T / 256, 4, G, bx, DM, DM);
        Epi<EK_WXO> E{nullptr, ws + WS_H2B, ws + WS_SSQ2, nullptr, ws + WS_H1B, nullptr, nullptr};
        pg8::gemm_phase(L, g, S, E);
        SYNC(15);
    }
    if (ON(16)) {
        KA
        { IDS
          const float* s2 = (const float*)(ws + WS_SSQ2); float* r2 = (float*)(ws + WS_RS2);
          for (int row = gt; row < T; row += NGT) { const f32x4 t0 = *(const f32x4*)(s2 + (size_t)row * 16), t1 = *(const f32x4*)(s2 + (size_t)row * 16 + 4), t2 = *(const f32x4*)(s2 + (size_t)row * 16 + 8), t3 = *(const f32x4*)(s2 + (size_t)row * 16 + 12);
              r2[row] = rsqrtf((((t0[0] + t0[1]) + (t0[2] + t0[3])) + ((t1[0] + t1[1]) + (t1[2] + t1[3])) + ((t2[0] + t2[1]) + (t2[2] + t2[3])) + ((t3[0] + t3[1]) + (t3[2] + t3[3]))) * (1.f / DM) + EPS); }
          SYNC(15); }
        pg8::Gemm g{WSB(WS_H2B), WSB(WS_WUP), DM, DM, DM}; GOrder<OK_PLAIN> S; S.init(T / 256, 22, G, bx, DM, DM);
        Epi<EK_UPC> E{ws + WS_U, ws + WS_G, ws + WS_G + 4 * MiB, ws + WS_G + 8 * MiB, ws + WS_RS2, in[I_CONVW], in[I_CONVB], (LAS float*)(L + RING_BYTES + 1024)};
        pg8::gemm_phase(L, g, S, E);
        SYNC(16);
    }
    if (ON(17)) {
        KA
        IDS
        const float* GHF = (const float*)(ws + WS_G); const float* GHL = (const float*)(ws + WS_G + 4 * MiB); const float* UH = (const float*)(ws + WS_G + 8 * MiB);
        const float* cw = in[I_CONVW]; const float* cbv = in[I_CONVB]; bf16_t* A = (bf16_t*)(ws + WS_U);
        for (int idx = gt; idx < (T / 256) * 2 * DFF; idx += NGT) { const int j = idx % DFF, pi = idx / DFF, i = pi & 1, pm = pi >> 1; const bool first = (pm & 7) == 0;
            const float g0 = GHF[(size_t)pi * DFF + j];
            const float gl1 = first ? 0.f : GHL[((size_t)(pm - 1) * 2 + 1) * DFF + j], gl0 = first ? 0.f : GHL[((size_t)(pm - 1) * 2) * DFF + j];
            const float g1 = i ? GHF[(size_t)(pm * 2) * DFF + j] : gl1, g2 = i ? gl1 : gl0;
            const float z = cbv[j] + cw[j] * g2 + cw[DFF + j] * g1 + cw[2 * DFF + j] * g0;
            A[(size_t)(pm * 256 + i) * DFF + j] = (bf16_t)f2bf(z * sigm(z) * UH[(size_t)pi * DFF + j]); }
        SYNC(17);
    }
    if (ON(18)) {
        KA
        pg8::Gemm g{WSB(WS_U), WSB(WS_WDN), DFF, DFF, DFF}; GOrder<OK_PLAIN> S; S.init(T / 256, 4, G, bx, DFF, DFF);
        Epi<EK_DOWN> E{out, nullptr, nullptr, nullptr, ws + WS_H2B, nullptr, nullptr};
        pg8::gemm_phase(L, g, S, E);
    }
}

extern "C" void kernel_launch(void* const* d_in, const int* in_sizes, int n_in, void* d_out, int out_size, void* d_ws, size_t ws_size, hipStream_t stream) {
    static int grid = 0;
    if (grid == 0) {
        if (n_in != 32 || out_size != T * DM || ws_size < WS_END) { fprintf(stderr, "kernel_launch: unexpected shapes (n_in %d out %d ws %zu)\n", n_in, out_size, ws_size); grid = -1; return; }
        int dev = 0, cus = 0, per_cu = 0;
        (void)hipGetDevice(&dev); (void)hipDeviceGetAttribute(&cus, hipDeviceAttributeMultiprocessorCount, dev);
        if (hipFuncSetAttribute((const void*)fox_s5_mega, hipFuncAttributeMaxDynamicSharedMemorySize, LDS_TOTAL) != hipSuccess) { fprintf(stderr, "kernel_launch: hipFuncSetAttribute failed\n"); grid = -1; return; }
        if (hipOccupancyMaxActiveBlocksPerMultiprocessor(&per_cu, (const void*)fox_s5_mega, 512, LDS_TOTAL) != hipSuccess || per_cu < 1) { fprintf(stderr, "kernel_launch: occupancy query says %d\n", per_cu); per_cu = 1; }
        (void)hipGetLastError();
        grid = cus;
        if (grid > cus * per_cu) grid = cus * per_cu;
    }
    if (grid < 0) return;
    if (hipMemsetAsync(d_ws, 0, 65536, stream) != hipSuccess) { fprintf(stderr, "kernel_launch: memset of the barrier words failed\n"); return; }
    Args a{};
    for (int i = 0; i < 32; ++i) a.in[i] = (const float*)d_in[i];
    a.out = (float*)d_out; a.ws = (unsigned char*)d_ws;
    void* args[] = {&a};
    hipError_t e = hipLaunchCooperativeKernel((const void*)fox_s5_mega, dim3(grid), dim3(512), args, LDS_TOTAL, stream);
    if (e != hipSuccess) fprintf(stderr, "cooperative launch failed: %s (grid %d)\n", hipGetErrorString(e), grid);
}
```

```cpp
#include <hip/hip_runtime.h>
#include <hip/hip_bf16.h>
#include <cstdio>
#include <cstdint>
#include <cmath>

constexpr int BATCH = 16, SEQ = 2048, DM = 1024, T = BATCH * SEQ;
constexpr int NMEM = 256, TM = BATCH * NMEM;
constexpr int FOXW = 512, HD = 64, NFH = 8;
constexpr int S5W = 512, S5G = 32, S5C = 16, S5P = 64;
constexpr int NXH = 4, XHD = 256;
constexpr int DFF = 2816;
constexpr int INCOLS = 2056;
constexpr float EPS = 1e-6f;
constexpr int TC = 32, NCH = SEQ / TC;
constexpr int UGP = TC * 16 + 128;
constexpr float LOG2E = 1.4426950408889634f;
constexpr float C2Q = 0.125f * LOG2E;

#define LAS __attribute__((address_space(3)))
typedef unsigned short bf16_t;
typedef short bf16x8 __attribute__((ext_vector_type(8)));
typedef float f32x4 __attribute__((ext_vector_type(4)));
typedef float f32x2 __attribute__((ext_vector_type(2)));
typedef unsigned u32x4 __attribute__((ext_vector_type(4)));
typedef unsigned u32x2 __attribute__((ext_vector_type(2)));

__device__ __forceinline__ unsigned f2bf(float f) { unsigned u = __builtin_bit_cast(unsigned, f); return (u + 0x7fffu + ((u >> 16) & 1u)) >> 16; }
typedef __bf16 bf16x2_hw __attribute__((ext_vector_type(2)));
__device__ __forceinline__ unsigned pk2(float lo, float hi) { f32x2 v = {lo, hi}; bf16x2_hw b = __builtin_convertvector(v, bf16x2_hw); return __builtin_bit_cast(unsigned, b); }
__device__ __forceinline__ float bflo(unsigned w) { return __builtin_bit_cast(float, w << 16); }
__device__ __forceinline__ float bfhi(unsigned w) { return __builtin_bit_cast(float, w & 0xffff0000u); }
__device__ __forceinline__ float wave_sum(float v) {
#pragma unroll
    for (int o = 1; o < 64; o <<= 1) v += __shfl_xor(v, o);
    return v;
}

__device__ __forceinline__ float red_fq(float v) {
    v += __builtin_bit_cast(float, __builtin_amdgcn_ds_swizzle(__builtin_bit_cast(int, v), 0x401F));
    float a = v, b = v;
    asm volatile("s_nop 1\n\tv_permlane32_swap_b32 %0, %1\n\ts_nop 1" : "+v"(a), "+v"(b));
    return a + b;
}

constexpr size_t MiB = 1u << 20;
constexpr size_t WS_WIN = 1 * MiB, WS_WGLU = 5 * MiB, WS_WOUT = 6 * MiB, WS_WXQ = 8 * MiB, WS_WXK = 10 * MiB, WS_WXV = 12 * MiB, WS_WXO = 14 * MiB,
                 WS_WUP = 16 * MiB, WS_WDN = 27 * MiB, WS_BTY = 33 * MiB, WS_BTE = 53 * MiB, WS_KTAB = 61 * MiB, WS_LB32 = 62 * MiB, WS_LOGF = 63 * MiB,
                 WS_CB = 64 * MiB, WS_SSQF = 65 * MiB, WS_SSQY = 66 * MiB, WS_SSQ1 = 67 * MiB, WS_SSQ2 = 69 * MiB, WS_SSQQ = 71 * MiB, WS_PSUM = 73 * MiB,
                 WS_SSQK = 75 * MiB, WS_SCK = 76 * MiB, WS_RS2 = 77 * MiB;
constexpr size_t WS_HN = 80 * MiB, WS_MIXN = 80 * MiB, WS_Y1 = 304 * MiB, WS_QST = 80 * MiB, WS_H2B = 80 * MiB;
constexpr size_t WS_MN = 144 * MiB, WS_KST = 152 * MiB, WS_VT = 160 * MiB;
constexpr size_t WS_Q = 168 * MiB, WS_K = 200 * MiB, WS_V = 232 * MiB, WS_P = 168 * MiB;
constexpr size_t WS_UG = 264 * MiB, WS_EPART = 304 * MiB, WS_H1B = 264 * MiB, WS_XO = 336 * MiB;
constexpr size_t WS_G = 144 * MiB, WS_U = 320 * MiB, WS_END = 496 * MiB;

namespace pg8 {
constexpr int BM = 256, BK = 64, HALF = 128, HTB = HALF * BK * 2, STAGE_BYTES = 8 * HTB;
__device__ __forceinline__ int lds_byte(int r, int c) { const int st = (r >> 4) * 2 + (c >> 5), rr = r & 15, cc = c & 31, ob = rr * 64 + cc * 2; return st * 1024 + (ob ^ (((ob >> 9) & 1) << 5)); }
__device__ __forceinline__ void stage_rc(int b, int& R, int& C) { const int st = b / 1024, sb = b % 1024, swz = sb ^ (((sb >> 9) & 1) << 5); R = (st >> 1) * 16 + swz / 64; C = (st & 1) * 32 + (swz % 64) / 2; }
__device__ __forceinline__ int perm32(int rho) { const int n = rho >> 4, i = rho & 15; return 8 * (i >> 2) + 4 * n + (i & 3); }

struct Unit { int pm, pn; long offA, offB; };
struct Gemm { const bf16_t* A; const bf16_t* Bt; int lda, ldb, K; };

template <class Epi, class Sched>
__device__ __forceinline__ void gemm_phase(LAS unsigned char* lds, const Gemm g, const Sched& S, const Epi& E) {
    int tid = threadIdx.x; asm volatile("" : "+v"(tid));
    const int wid = __builtin_amdgcn_readfirstlane(tid >> 6), lane = tid & 63, wr = wid >> 2, wc = wid & 3, fr = lane & 15, fq = lane >> 4;
    const int K = g.K, nt = K / BK;
    unsigned voffA[2], voffB[2];
#pragma unroll
    for (int i = 0; i < 2; ++i) { int R, C; stage_rc(tid * 16 + i * 8192, R, C); const int Rb = (R & ~31) + perm32(R & 31);
        voffA[i] = (unsigned)(R * g.lda + C) * 2u; voffB[i] = (unsigned)(Rb * g.ldb + C) * 2u; }
    const size_t kstep = (size_t)(BK * 2);
    const size_t hstepA = (size_t)HALF * g.lda * 2, hstepB = (size_t)HALF * g.ldb * 2;
    const unsigned ldsw = (unsigned)wid * 1024u;
    const int aoff = lds_byte(wr * 64 + fr, fq * 8), boff = lds_byte(wc * 32 + fr, fq * 8);
#define PG8_SA(b, h) (((b) * 2 + (h)) * HTB)
#define PG8_SB(b, h) ((4 + (b) * 2 + (h)) * HTB)
#define PG8_STAGE(bufoff, gbase, voff) do { _Pragma("unroll") for (int _i = 0; _i < 2; ++_i) \
        __builtin_amdgcn_global_load_lds((const unsigned*)((const char*)(gbase) + (voff)[_i]), (LAS unsigned*)(lds + (bufoff) + ldsw + _i * 8192), 16, 0, 0); } while (0)
#define PG8_LDA(dst, b, h) do { _Pragma("unroll") for (int m = 0; m < 4; ++m) _Pragma("unroll") for (int k = 0; k < 2; ++k) dst[m][k] = *(const LAS bf16x8*)(lds + PG8_SA(b, h) + aoff + m * 2048 + k * 1024); } while (0)
#define PG8_LDB(dst, b, h) do { _Pragma("unroll") for (int n = 0; n < 2; ++n) _Pragma("unroll") for (int k = 0; k < 2; ++k) dst[n][k] = *(const LAS bf16x8*)(lds + PG8_SB(b, h) + boff + n * 2048 + k * 1024); } while (0)
#define PG8_MMA(ai, bj, At, Bt) do { __builtin_amdgcn_s_setprio(1); _Pragma("unroll") for (int m = 0; m < 4; ++m) _Pragma("unroll") for (int n = 0; n < 2; ++n) _Pragma("unroll") for (int k = 0; k < 2; ++k) \
        acc[ai][bj][m][n] = __builtin_amdgcn_mfma_f32_16x16x32_bf16(Bt[n][k], At[m][k], acc[ai][bj][m][n], 0, 0, 0); __builtin_amdgcn_s_setprio(0); } while (0)
#define PG8_WAIT_V(n) asm volatile("s_waitcnt vmcnt(" #n ")" ::: "memory")
#define PG8_WAIT_L(n) asm volatile("s_waitcnt lgkmcnt(" #n ")" ::: "memory")
#define PG8_BAR __builtin_amdgcn_s_barrier()
#define PG8_SCHED __builtin_amdgcn_sched_barrier(0)
    Unit cur, nxt; int ui = 0;
    if (!S.next(0, cur)) return;
    f32x4 acc[2][2][4][2];
#pragma unroll
    for (int a = 0; a < 2; ++a)
#pragma unroll
        for (int b = 0; b < 2; ++b)
#pragma unroll
            for (int m = 0; m < 4; ++m)
#pragma unroll
                for (int n = 0; n < 2; ++n) acc[a][b][m][n] = (f32x4){0.f, 0.f, 0.f, 0.f};
    bf16x8 At[4][2], B0[2][2], B1[2][2];
    const char* cA = (const char*)g.A + cur.offA; const char* cB = (const char*)g.Bt + cur.offB;
    PG8_STAGE(PG8_SB(0, 0), cB, voffB); PG8_STAGE(PG8_SB(0, 1), cB + hstepB, voffB); PG8_STAGE(PG8_SA(0, 0), cA, voffA); PG8_STAGE(PG8_SA(0, 1), cA + hstepA, voffA);
    if (wr == 1) PG8_BAR;
    PG8_WAIT_V(2); PG8_BAR;
    PG8_STAGE(PG8_SB(1, 0), cB + kstep, voffB); PG8_STAGE(PG8_SA(1, 0), cA + kstep, voffA); PG8_STAGE(PG8_SB(1, 1), cB + hstepB + kstep, voffB);
    PG8_WAIT_V(6); PG8_BAR;
    for (;;) {
        const bool has_next = S.next(ui + 1, nxt);
        const char* nA = has_next ? (const char*)g.A + nxt.offA : cA; const char* nB = has_next ? (const char*)g.Bt + nxt.offB : cB;
        for (int t = 0; t < nt; t += 2) {
            if constexpr (Epi::MID) { if (t == nt / 2) { int fr2 = fr; asm volatile("" : "+v"(fr2)); E.mid(acc, cur, wr, fr2); } }
            const bool last = (t == nt - 2);
            const char* a1 = cA + (size_t)(t + 1) * kstep;
            const char* a2 = last ? nA : cA + (size_t)(t + 2) * kstep; const char* b2 = last ? nB : cB + (size_t)(t + 2) * kstep;
            const char* a3 = a2 + kstep; const char* b3 = b2 + kstep;
            PG8_LDB(B0, 0, 0); PG8_LDB(B1, 0, 1); PG8_SCHED; PG8_LDA(At, 0, 0); PG8_STAGE(PG8_SA(1, 1), a1 + hstepA, voffA);
            PG8_WAIT_V(8); PG8_WAIT_L(0); PG8_BAR; PG8_MMA(0, 0, At, B0); PG8_MMA(0, 1, At, B1); PG8_BAR; PG8_SCHED;
            PG8_LDA(At, 0, 1); PG8_STAGE(PG8_SB(0, 0), b2, voffB); PG8_STAGE(PG8_SB(0, 1), b2 + hstepB, voffB); PG8_STAGE(PG8_SA(0, 0), a2, voffA);
            PG8_WAIT_V(8); PG8_WAIT_L(0); PG8_BAR; PG8_MMA(1, 0, At, B0); PG8_MMA(1, 1, At, B1); PG8_BAR; PG8_SCHED;
            PG8_LDB(B0, 1, 0); PG8_LDB(B1, 1, 1); PG8_SCHED; PG8_LDA(At, 1, 0); PG8_STAGE(PG8_SA(0, 1), a2 + hstepA, voffA);
            PG8_WAIT_V(8); PG8_WAIT_L(0); PG8_BAR; PG8_MMA(0, 0, At, B0); PG8_MMA(0, 1, At, B1); PG8_BAR; PG8_SCHED;
            PG8_LDA(At, 1, 1); PG8_STAGE(PG8_SB(1, 0), b3, voffB); PG8_STAGE(PG8_SB(1, 1), b3 + hstepB, voffB); PG8_STAGE(PG8_SA(1, 0), a3, voffA);
            PG8_WAIT_V(8); PG8_WAIT_L(0); PG8_BAR; PG8_MMA(1, 0, At, B0); PG8_MMA(1, 1, At, B1); PG8_BAR; PG8_SCHED;
        }
        if (wr == 0) PG8_BAR;
        { int fr2 = fr, fq2 = fq; asm volatile("" : "+v"(fr2), "+v"(fq2));
          E(acc, cur, wr, wc, fr2, fq2); }
        if (!has_next) break;
#pragma unroll
        for (int a = 0; a < 2; ++a)
#pragma unroll
            for (int b = 0; b < 2; ++b)
#pragma unroll
                for (int m = 0; m < 4; ++m)
#pragma unroll
                    for (int n = 0; n < 2; ++n) acc[a][b][m][n] = (f32x4){0.f, 0.f, 0.f, 0.f};
        cur = nxt; cA = nA; cB = nB; ++ui;
        if (wr == 1) PG8_BAR;
    }
    PG8_WAIT_V(0);
    PG8_BAR;
#undef PG8_SA
#undef PG8_SB
#undef PG8_STAGE
#undef PG8_LDA
#undef PG8_LDB
#undef PG8_MMA
#undef PG8_WAIT_V
#undef PG8_WAIT_L
#undef PG8_BAR
#undef PG8_SCHED
}
}
using pg8::Unit;

enum OrderKind { OK_PLAIN = 0, OK_S5E, OK_S5Y, OK_XS, OK_XO };
template <int kind> struct GOrder {
    int nM, nN, nwg, G, c, lda, ldb;
    __device__ __forceinline__ void init(int nM_, int nN_, int G_, int c_, int lda_, int ldb_) { nM = nM_; nN = nN_; nwg = nM_ * nN_; G = G_; c = c_; lda = lda_; ldb = ldb_; }
    __device__ __forceinline__ bool next(int i, Unit& u) const {
        const long L = (long)i * G + c; if (L >= nwg) return false;
        const int l = (int)L;
        if constexpr (kind == OK_PLAIN) {
            int wgid = l; { const int q = nwg / 8, r = nwg % 8, xcd = wgid % 8, off = wgid / 8; wgid = (xcd < r ? xcd * (q + 1) : r * (q + 1) + (xcd - r) * q) + off; }
            const int nig = 8 * nN, gid = wgid / nig, fm = gid * 8, gsz = (nM - fm) < 8 ? (nM - fm) : 8;
            u.pm = fm + ((wgid % nig) % gsz); u.pn = (wgid % nig) / gsz;
            u.offA = (long)u.pm * 256 * lda * 2; u.offB = (long)u.pn * 256 * ldb * 2;
        } else if constexpr (kind == OK_S5E) {
            const int kq = l & 1, pmm = (l >> 1) & 3, gg = l >> 3;
            u.pm = gg * 4 + pmm; u.pn = kq;
            u.offA = ((long)u.pm * 256 * UGP + kq * 256) * 2; u.offB = ((long)gg * 256 * 512 + kq * 256) * 2;
        } else if constexpr (kind == OK_S5Y) {
            const int pn = l & 1, pmm = (l >> 1) & 3, gg = l >> 3;
            u.pm = gg * 4 + pmm; u.pn = pn;
            u.offA = (long)u.pm * 256 * UGP * 2; u.offB = ((long)gg * 512 + pn * 256) * UGP * 2;
        } else if constexpr (kind == OK_XS) {
            const int h = l & 3, pm = l >> 2, b = pm >> 3;
            u.pm = pm; u.pn = h;
            u.offA = ((long)pm * 256 * DM + h * 256) * 2; u.offB = ((long)b * 256 * DM + h * 256) * 2;
        } else {
            const int h = l & 3, pm = l >> 2, b = pm >> 3;
            u.pm = pm; u.pn = h;
            u.offA = ((long)pm * 256 * DM + h * 256) * 2; u.offB = ((long)h * 256 * TM + b * 256) * 2;
        }
        return true;
    }
};

enum EpiKind { EK_PROJ = 0, EK_MEMK, EK_MEMVT, EK_S5E, EK_S5Y, EK_GLU, EK_WOUT, EK_XQ, EK_XS, EK_XO, EK_WXO, EK_UP, EK_DOWN, EK_GATE, EK_UPACT, EK_UPC };
    __device__ __forceinline__ u32x4 pack8(const f32x4 a, const f32x4 b) { u32x4 w; w.x = pk2(a[0], a[1]); w.y = pk2(a[2], a[3]); w.z = pk2(b[0], b[1]); w.w = pk2(b[2], b[3]); return w; }
    __device__ __forceinline__ float gelu_t(float y) { const float z = 0.7978845608028654f * (y + 0.044715f * y * y * y); const float e = __builtin_amdgcn_exp2f((2.f * LOG2E) * z); const float th = 1.f - 2.f * __builtin_amdgcn_rcpf(e + 1.f); return 0.5f * y * (1.f + th); }
    __device__ __forceinline__ float sigm(float z) { return __builtin_amdgcn_rcpf(1.f + __builtin_amdgcn_exp2f(-LOG2E * z)); }
    __device__ __forceinline__ float ssq8(const f32x4 a, const f32x4 b) { return (a[0] * a[0] + a[1] * a[1]) + (a[2] * a[2] + a[3] * a[3]) + (b[0] * b[0] + b[1] * b[1]) + (b[2] * b[2] + b[3] * b[3]); }

template <int kind> struct Epi {
    void* p0; void* p1; void* p2; void* p3; const void* c0; const void* c1; const void* c2; LAS float* hx;
    static constexpr bool MID = (kind == EK_WOUT);
    __device__ __forceinline__ static float rs8(const float* s, size_t row) { const f32x4 a0 = *(const f32x4*)(s + row * 8), a1 = *(const f32x4*)(s + row * 8 + 4); return rsqrtf((((a0[0] + a0[1]) + (a0[2] + a0[3])) + ((a1[0] + a1[1]) + (a1[2] + a1[3]))) * (1.f / 512.f) + EPS); }
    __device__ __forceinline__ void mid(f32x4 (&acc)[2][2][4][2], const Unit& u, int wr, int fr) const {
        const float* sf = (const float*)c1; const float* sy = (const float*)c2;
#pragma unroll
        for (int ai = 0; ai < 2; ++ai)
#pragma unroll
            for (int m = 0; m < 4; ++m) { const size_t row = (size_t)(u.pm * 256 + wr * 64 + fr + ai * 128 + m * 16);
                const float ratio = rs8(sf, row) * __builtin_amdgcn_rcpf(rs8(sy, row));
#pragma unroll
                for (int bj = 0; bj < 2; ++bj) { acc[ai][bj][m][0] = acc[ai][bj][m][0] * ratio; acc[ai][bj][m][1] = acc[ai][bj][m][1] * ratio; } }
    }
    __device__ __forceinline__ void operator()(const f32x4 (&acc)[2][2][4][2], const Unit& u, int wr, int wc, int fr, int fq) const {
        const int rbase = u.pm * 256 + wr * 64 + fr;
        const int cl0 = wc * 32 + 8 * fq;
        switch (kind) {
        case EK_PROJ: {
            const int pn = u.pn;
            if (pn < 4) {
                const bool isq = pn < 2; bf16_t* dst = (bf16_t*)(isq ? p0 : p1); const float* gptr = (const float*)(isq ? c0 : c1); const float post = isq ? C2Q : 1.f;
                const int head = 4 * (pn & 1) + wc;
#pragma unroll
                for (int ai = 0; ai < 2; ++ai)
#pragma unroll
                    for (int m = 0; m < 4; ++m) {
                        float ss = ssq8(acc[ai][0][m][0], acc[ai][0][m][1]) + ssq8(acc[ai][1][m][0], acc[ai][1][m][1]);
                        ss = red_fq(ss);
                        const float sc = rsqrtf(ss * (1.f / 64.f) + EPS) * post;
                        const size_t row = (size_t)(rbase + ai * 128 + m * 16);
#pragma unroll
                        for (int bj = 0; bj < 2; ++bj)
                            *(u32x4*)(dst + row * 512 + head * 64 + 32 * bj + 8 * fq) = pack8(acc[ai][bj][m][0] * sc * *(const f32x4*)(gptr + 32 * bj + 8 * fq), acc[ai][bj][m][1] * sc * *(const f32x4*)(gptr + 32 * bj + 8 * fq + 4));
                    }
            } else if (pn < 6) {
                bf16_t* dst = (bf16_t*)p2;
#pragma unroll
                for (int ai = 0; ai < 2; ++ai)
#pragma unroll
                    for (int m = 0; m < 4; ++m) { const size_t row = (size_t)(rbase + ai * 128 + m * 16);
#pragma unroll
                        for (int bj = 0; bj < 2; ++bj) *(u32x4*)(dst + row * 512 + (pn - 4) * 256 + bj * 128 + cl0) = pack8(acc[ai][bj][m][0], acc[ai][bj][m][1]); }
            } else {
                bf16_t* dst = (bf16_t*)p3;
#pragma unroll
                for (int ai = 0; ai < 2; ++ai)
#pragma unroll
                    for (int m = 0; m < 4; ++m) { const int row = rbase + ai * 128 + m * 16; const int b = row >> 11, t = row & 2047, ch = t >> 5, s = t & 31;
#pragma unroll
                        for (int bj = 0; bj < 2; ++bj) { const int f = (pn - 6) * 256 + bj * 128 + cl0; const int gI = f >> 4, cc = f & 15;
                            *(u32x4*)(dst + ((size_t)(gI * 1024 + b * 64 + ch)) * UGP + s * 16 + cc) = pack8(acc[ai][bj][m][0], acc[ai][bj][m][1]); } }
            }
        } break;
        case EK_MEMK: {
            bf16_t* dst = (bf16_t*)p0; float* sq = (float*)p1;
#pragma unroll
            for (int ai = 0; ai < 2; ++ai)
#pragma unroll
                for (int m = 0; m < 4; ++m) { const size_t row = (size_t)(rbase + ai * 128 + m * 16);
                    float ss = ssq8(acc[ai][0][m][0], acc[ai][0][m][1]) + ssq8(acc[ai][1][m][0], acc[ai][1][m][1]);
                    ss = red_fq(ss);
                    if (fq == 0) sq[row * 16 + u.pn * 4 + wc] = ss;
#pragma unroll
                    for (int bj = 0; bj < 2; ++bj) *(u32x4*)(dst + row * DM + u.pn * 256 + bj * 128 + cl0) = pack8(acc[ai][bj][m][0], acc[ai][bj][m][1]); }
        } break;
        case EK_MEMVT: {
            bf16_t* dst = (bf16_t*)p0;
#pragma unroll
            for (int ai = 0; ai < 2; ++ai)
#pragma unroll
                for (int m = 0; m < 4; ++m) { const size_t row = (size_t)(rbase + ai * 128 + m * 16);
#pragma unroll
                    for (int bj = 0; bj < 2; ++bj) *(u32x4*)(dst + row * TM + u.pn * 256 + bj * 128 + cl0) = pack8(acc[ai][bj][m][0], acc[ai][bj][m][1]); }
        } break;
        case EK_S5E: {
            float* dst = (float*)p0 + (size_t)u.pn * 32768 * 128;
#pragma unroll
            for (int ai = 0; ai < 2; ++ai)
#pragma unroll
                for (int m = 0; m < 4; ++m) { const size_t row = (size_t)(rbase + ai * 128 + m * 16);
                    *(f32x4*)(dst + row * 128 + cl0) = acc[ai][0][m][0]; *(f32x4*)(dst + row * 128 + cl0 + 4) = acc[ai][0][m][1]; }
        } break;
        case EK_S5Y: {
            bf16_t* dst = (bf16_t*)p0;
#pragma unroll
            for (int ai = 0; ai < 2; ++ai)
#pragma unroll
                for (int m = 0; m < 4; ++m) { const int r = rbase + ai * 128 + m * 16; const int gI = r >> 10, b = (r >> 6) & 15, k = r & 63;
#pragma unroll
                    for (int bj = 0; bj < 2; ++bj) { const int nn = u.pn * 256 + bj * 128 + cl0; const int tt = nn >> 4, cc = nn & 15;
                        f32x4 a = acc[ai][bj][m][0], c = acc[ai][bj][m][1];
#pragma unroll
                        for (int j = 0; j < 4; ++j) { a[j] = gelu_t(a[j]); c[j] = gelu_t(c[j]); }
                        *(u32x4*)(dst + ((size_t)(b * SEQ + k * TC + tt)) * 512 + gI * 16 + cc) = pack8(a, c); } }
        } break;
        case EK_GLU: {
            bf16_t* dst = (bf16_t*)p0; float* sq = (float*)p1; const bf16_t* y1 = (const bf16_t*)c0; const float* bg = (const float*)c1;
            f32x4 bv[2][2];
#pragma unroll
            for (int bj = 0; bj < 2; ++bj)
#pragma unroll
                for (int n = 0; n < 2; ++n) bv[bj][n] = *(const f32x4*)(bg + u.pn * 256 + bj * 128 + cl0 + 4 * n);
#pragma unroll
            for (int ai = 0; ai < 2; ++ai)
#pragma unroll
                for (int m = 0; m < 4; ++m) { const size_t row = (size_t)(rbase + ai * 128 + m * 16); float ss = 0.f;
#pragma unroll
                    for (int bj = 0; bj < 2; ++bj) { const size_t off = row * 512 + u.pn * 256 + bj * 128 + cl0;
                        const u32x4 yv = *(const u32x4*)(y1 + off);
                        f32x4 a = acc[ai][bj][m][0] + bv[bj][0], c = acc[ai][bj][m][1] + bv[bj][1];
                        a[0] = bflo(yv.x) * sigm(a[0]); a[1] = bfhi(yv.x) * sigm(a[1]); a[2] = bflo(yv.y) * sigm(a[2]); a[3] = bfhi(yv.y) * sigm(a[3]);
                        c[0] = bflo(yv.z) * sigm(c[0]); c[1] = bfhi(yv.z) * sigm(c[1]); c[2] = bflo(yv.w) * sigm(c[2]); c[3] = bfhi(yv.w) * sigm(c[3]);
                        ss += ssq8(a, c);
                        *(u32x4*)(dst + row * DM + 512 + u.pn * 256 + bj * 128 + cl0) = pack8(a, c); }
                    ss = red_fq(ss);
                    if (fq == 0) sq[row * 8 + u.pn * 4 + wc] = ss; }
        } break;
        case EK_WOUT: case EK_WXO: {
            bf16_t* hb = (bf16_t*)p1; float* sq = (float*)p2;
#pragma unroll
            for (int ai = 0; ai < 2; ++ai)
#pragma unroll
                for (int m = 0; m < 4; ++m) { const size_t row = (size_t)(rbase + ai * 128 + m * 16); float ss = 0.f;
#pragma unroll
                    for (int bj = 0; bj < 2; ++bj) { const size_t off = row * DM + u.pn * 256 + bj * 128 + cl0;
                        f32x4 a, c;
                        if (kind == EK_WOUT) { const float* base = (const float*)c0; const float rsy = rs8((const float*)c2, row); a = acc[ai][bj][m][0] * rsy + *(const f32x4*)(base + off); c = acc[ai][bj][m][1] * rsy + *(const f32x4*)(base + off + 4); }
                        else { const u32x4 bv = *(const u32x4*)((const bf16_t*)c0 + off);
                            a = acc[ai][bj][m][0] + (f32x4){bflo(bv.x), bfhi(bv.x), bflo(bv.y), bfhi(bv.y)}; c = acc[ai][bj][m][1] + (f32x4){bflo(bv.z), bfhi(bv.z), bflo(bv.w), bfhi(bv.w)}; }
                        ss += ssq8(a, c);
                        *(u32x4*)(hb + off) = pack8(a, c); }
                    ss = red_fq(ss);
                    if (fq == 0) sq[row * 16 + u.pn * 4 + wc] = ss; }
        } break;
        case EK_XQ: {
            bf16_t* dst = (bf16_t*)p0; float* sq = (float*)p1; const float* gq = (const float*)c0; const float* gk = (const float*)c1;
            f32x4 gg[2][2];
#pragma unroll
            for (int bj = 0; bj < 2; ++bj)
#pragma unroll
                for (int n = 0; n < 2; ++n) gg[bj][n] = *(const f32x4*)(gq + bj * 128 + cl0 + 4 * n) * *(const f32x4*)(gk + bj * 128 + cl0 + 4 * n);
#pragma unroll
            for (int ai = 0; ai < 2; ++ai)
#pragma unroll
                for (int m = 0; m < 4; ++m) { const size_t row = (size_t)(rbase + ai * 128 + m * 16);
                    float ss = ssq8(acc[ai][0][m][0], acc[ai][0][m][1]) + ssq8(acc[ai][1][m][0], acc[ai][1][m][1]);
                    ss = red_fq(ss);
                    if (fq == 0) sq[row * 16 + u.pn * 4 + wc] = ss;
#pragma unroll
                    for (int bj = 0; bj < 2; ++bj) *(u32x4*)(dst + row * DM + u.pn * 256 + bj * 128 + cl0) = pack8(acc[ai][bj][m][0] * gg[bj][0], acc[ai][bj][m][1] * gg[bj][1]); }
        } break;
        case EK_XS: {
            bf16_t* dst = (bf16_t*)p0; float* ps = (float*)p1; const float* s1 = (const float*)c0; const float* sqq = (const float*)c1; const float* sck = (const float*)c2;
            const int h = u.pn, b = u.pm >> 3;
            f32x4 kv[2][2];
#pragma unroll
            for (int bj = 0; bj < 2; ++bj)
#pragma unroll
                for (int n = 0; n < 2; ++n) kv[bj][n] = *(const f32x4*)(sck + (size_t)h * TM + b * 256 + bj * 128 + cl0 + 4 * n) * (LOG2E / 16.f);
#pragma unroll
            for (int ai = 0; ai < 2; ++ai)
#pragma unroll
                for (int m = 0; m < 4; ++m) { const size_t row = (size_t)(rbase + ai * 128 + m * 16);
                    const f32x4 t0 = *(const f32x4*)(s1 + row * 16), t1 = *(const f32x4*)(s1 + row * 16 + 4), t2 = *(const f32x4*)(s1 + row * 16 + 8), t3 = *(const f32x4*)(s1 + row * 16 + 12);
                    const float tot = ((t0[0] + t0[1]) + (t0[2] + t0[3])) + ((t1[0] + t1[1]) + (t1[2] + t1[3])) + ((t2[0] + t2[1]) + (t2[2] + t2[3])) + ((t3[0] + t3[1]) + (t3[2] + t3[3]));
                    const float rs1 = rsqrtf(tot * (1.f / DM) + EPS);
                    const f32x4 qq = *(const f32x4*)(sqq + row * 16 + h * 4);
                    const float sq = rs1 * rsqrtf(rs1 * rs1 * ((qq[0] + qq[1]) + (qq[2] + qq[3])) * (1.f / 256.f) + EPS);
                    float ss = 0.f;
#pragma unroll
                    for (int bj = 0; bj < 2; ++bj) { f32x4 a = acc[ai][bj][m][0] * kv[bj][0] * sq, c = acc[ai][bj][m][1] * kv[bj][1] * sq;
#pragma unroll
                        for (int j = 0; j < 4; ++j) { a[j] = __builtin_amdgcn_exp2f(a[j]); c[j] = __builtin_amdgcn_exp2f(c[j]); }
                        const u32x4 w = pack8(a, c);
                        ss += (bflo(w.x) + bfhi(w.x)) + (bflo(w.y) + bfhi(w.y)) + (bflo(w.z) + bfhi(w.z)) + (bflo(w.w) + bfhi(w.w));
                        *(u32x4*)(dst + row * DM + h * 256 + bj * 128 + cl0) = w; }
                    ss = red_fq(ss);
                    if (fq == 0) ps[row * 16 + h * 4 + wc] = ss; }
        } break;
        case EK_XO: {
            bf16_t* dst = (bf16_t*)p0; const float* ps = (const float*)c0; const int h = u.pn;
#pragma unroll
            for (int ai = 0; ai < 2; ++ai)
#pragma unroll
                for (int m = 0; m < 4; ++m) { const size_t row = (size_t)(rbase + ai * 128 + m * 16);
                    const f32x4 pp = *(const f32x4*)(ps + row * 16 + h * 4); const float inv = __builtin_amdgcn_rcpf((pp[0] + pp[1]) + (pp[2] + pp[3]));
#pragma unroll
                    for (int bj = 0; bj < 2; ++bj) *(u32x4*)(dst + row * DM + h * 256 + bj * 128 + cl0) = pack8(acc[ai][bj][m][0] * inv, acc[ai][bj][m][1] * inv); }
        } break;
        case EK_DOWN: {
            float* out = (float*)p0; const bf16_t* h2 = (const bf16_t*)c0;
#pragma unroll
            for (int ai = 0; ai < 2; ++ai)
#pragma unroll
                for (int m = 0; m < 4; ++m) { const size_t row = (size_t)(rbase + ai * 128 + m * 16);
#pragma unroll
                    for (int bj = 0; bj < 2; ++bj) { const size_t off = row * DM + u.pn * 256 + bj * 128 + cl0;
                        const u32x4 bv = *(const u32x4*)(h2 + off);
                        const f32x4 a = acc[ai][bj][m][0] + (f32x4){bflo(bv.x), bfhi(bv.x), bflo(bv.y), bfhi(bv.y)}, c = acc[ai][bj][m][1] + (f32x4){bflo(bv.z), bfhi(bv.z), bflo(bv.w), bfhi(bv.w)};
                        *(f32x4*)(out + off) = a; *(f32x4*)(out + off + 4) = c; } }
        } break;
        case EK_UPC: {
            bf16_t* A = (bf16_t*)p0; float* GHF = (float*)p1; float* GHL = (float*)p2; float* UH = (float*)p3; const float* s2 = (const float*)c0; const float* cw = (const float*)c1; const float* cbv = (const float*)c2;
            const int j0 = u.pn * 128 + cl0;
            float w0[8], w1[8], w2[8], bb[8];
#pragma unroll
            for (int i = 0; i < 2; ++i) { const f32x4 a0 = *(const f32x4*)(cw + j0 + 4 * i), a1 = *(const f32x4*)(cw + DFF + j0 + 4 * i), a2 = *(const f32x4*)(cw + 2 * DFF + j0 + 4 * i), a3 = *(const f32x4*)(cbv + j0 + 4 * i);
#pragma unroll
                for (int q = 0; q < 4; ++q) { w0[4 * i + q] = a0[q]; w1[4 * i + q] = a1[q]; w2[4 * i + q] = a2[q]; bb[4 * i + q] = a3[q]; } }
            float rsv[2][4];
#pragma unroll
            for (int ai = 0; ai < 2; ++ai)
#pragma unroll
                for (int m = 0; m < 4; ++m) rsv[ai][m] = s2[rbase + ai * 128 + m * 16];
            if (fr >= 14) {
#pragma unroll
                for (int ai = 0; ai < 2; ++ai) { const f32x4 g0 = acc[ai][0][3][0] * rsv[ai][3], g1 = acc[ai][0][3][1] * rsv[ai][3];
                    LAS float* hp = hx + ((ai * 2 + wr) * 2 + (fr - 14)) * 128 + cl0; *(LAS f32x4*)hp = g0; *(LAS f32x4*)(hp + 4) = g1;
                    if (ai == 1 && wr == 1) { float* gp = GHL + ((size_t)u.pm * 2 + (fr - 14)) * DFF + j0; *(f32x4*)gp = g0; *(f32x4*)(gp + 4) = g1; } } }
            if (wr == 0 && fr < 2) {
                const float rs = rsv[0][0]; float* gp = GHF + ((size_t)u.pm * 2 + fr) * DFF + j0; float* up = UH + ((size_t)u.pm * 2 + fr) * DFF + j0;
                *(f32x4*)gp = acc[0][0][0][0] * rs; *(f32x4*)(gp + 4) = acc[0][0][0][1] * rs; *(f32x4*)up = acc[0][1][0][0] * rs; *(f32x4*)(up + 4) = acc[0][1][0][1] * rs; }
            asm volatile("s_waitcnt lgkmcnt(0)" ::: "memory"); __builtin_amdgcn_s_barrier(); asm volatile("" ::: "memory");
#define ROR1(x) __builtin_bit_cast(float, __builtin_amdgcn_update_dpp(0, __builtin_bit_cast(int, (x)), 0x121, 0xF, 0xF, false))
#define ROR2(x) __builtin_bit_cast(float, __builtin_amdgcn_update_dpp(0, __builtin_bit_cast(int, (x)), 0x122, 0xF, 0xF, false))
#pragma unroll
            for (int ai = 0; ai < 2; ++ai) {
                const int grp = ai * 2 + wr;
                float p1v[8], p2v[8];
                { f32x4 h1a = (f32x4){0.f, 0.f, 0.f, 0.f}, h1b = h1a, h2a = h1a, h2b = h1a;
                  if (grp > 0) { const LAS float* hp = hx + ((grp - 1) * 2) * 128 + cl0; h2a = *(const LAS f32x4*)hp; h2b = *(const LAS f32x4*)(hp + 4); h1a = *(const LAS f32x4*)(hp + 128); h1b = *(const LAS f32x4*)(hp + 132); }
#pragma unroll
                  for (int i = 0; i < 4; ++i) { p1v[i] = h1a[i]; p1v[4 + i] = h1b[i]; p2v[i] = (fr == 0) ? h2a[i] : h1a[i]; p2v[4 + i] = (fr == 0) ? h2b[i] : h1b[i]; } }
#pragma unroll
                for (int m = 0; m < 4; ++m) { const float rs = rsv[ai][m]; const size_t row = (size_t)(rbase + ai * 128 + m * 16);
                    float gs[8], r[8];
#pragma unroll
                    for (int i = 0; i < 4; ++i) { gs[i] = acc[ai][0][m][0][i] * rs; gs[4 + i] = acc[ai][0][m][1][i] * rs; }
#pragma unroll
                    for (int i = 0; i < 8; ++i) { const float c1v = ROR1(gs[i]), c2v = ROR2(gs[i]);
                        const float g1 = (fr == 0) ? p1v[i] : c1v, g2 = (fr < 2) ? p2v[i] : c2v;
                        p1v[i] = c1v; p2v[i] = c2v;
                        const float z = bb[i] + w0[i] * g2 + w1[i] * g1 + w2[i] * gs[i];
                        const float uv = (i < 4 ? acc[ai][1][m][0][i & 3] : acc[ai][1][m][1][i & 3]) * rs;
                        r[i] = z * sigm(z) * uv; }
                    u32x4 o; o.x = pk2(r[0], r[1]); o.y = pk2(r[2], r[3]); o.z = pk2(r[4], r[5]); o.w = pk2(r[6], r[7]);
                    if (!(grp == 0 && m == 0 && fr < 2)) *(u32x4*)(A + row * DFF + j0) = o; } }
#undef ROR1
#undef ROR2
        } break;
        default: break;
        }
    }
};

namespace attn_body {
using bf16=__hip_bfloat16;
using s16x4=__attribute__((ext_vector_type(4)))short;
using f32x16=__attribute__((ext_vector_type(16)))float;
constexpr int NHEAD=NFH,D=64,ADM=NHEAD*D,OPITCH=1024;
constexpr int NW=8,QBLK=32,QB=QBLK*NW,KVBLK=64,NQB=SEQ/QB;
__device__ __forceinline__ int crow(int r,int hi){return (r&3)+8*(r>>2)+4*hi;}
#define SBAR() __builtin_amdgcn_sched_barrier(0)
__device__ __forceinline__ void cmask(f32x16&p0,f32x16&p1,int jb,int qrel,int hi){
  const float NEG=-INFINITY; int kb=64*jb+4*hi;
  #pragma unroll
  for(int r=0;r<16;++r){int kv=kb+(r&3)+8*(r>>2); if(kv>qrel)p0[r]=NEG; if(kv+32>qrel)p1[r]=NEG;}
}
constexpr int NSLOT=3, SLOTB=8192;
constexpr int LDS_K=0, LDS_V=NSLOT*SLOTB, LDS_WS=2*NSLOT*SLOTB, LDS_OST=LDS_WS+NW*64*4, LDS_BYTES=LDS_OST+NW*4096;
constexpr int LDS_BIAS=86016;
__device__ __forceinline__ void glds16(const void*gsrc,unsigned lds_dst){unsigned keep;
  asm volatile("s_mov_b32 %0, m0\n\ts_mov_b32 m0, %2\n\ts_nop 0\n\tglobal_load_lds_dwordx4 %1, off\n\ts_mov_b32 m0, %0":"=&s"(keep):"v"(gsrc),"s"(lds_dst):"memory");}
__device__ __forceinline__ float max3f(float a,float b,float c){float r;asm("v_max3_f32 %0, %1, %2, %3":"=v"(r):"v"(a),"v"(b),"v"(c));return r;}
__device__ __forceinline__ float max2f(float a,float b){float r;asm("v_max_f32_e32 %0, %1, %2":"=v"(r):"v"(a),"v"(b));return r;}
__device__ __forceinline__ float fadd_s(float a,float b){float r;asm("v_add_f32_e32 %0, %1, %2":"=v"(r):"v"(a),"v"(b));return r;}
__device__ __forceinline__ float fsub_s(float a,float b){float r;asm("v_sub_f32_e32 %0, %1, %2":"=v"(r):"v"(a),"v"(b));return r;}
typedef float f32x2_t __attribute__((ext_vector_type(2))); typedef __bf16 bf16x2_t __attribute__((ext_vector_type(2)));
__device__ __forceinline__ unsigned cvtpk_s(float lo,float hi){f32x2_t v={lo,hi};bf16x2_t b=__builtin_convertvector(v,bf16x2_t);return __builtin_bit_cast(unsigned,b);}
#define WAIT_BAR(N) asm volatile("s_waitcnt vmcnt(" #N ") lgkmcnt(0)\n\ts_barrier":::"memory")

__device__ __forceinline__ void qkt(f32x16&p0,f32x16&p1,const char*Kslot,const bf16x8*qr,const f32x16&negm,int r32,int hi){
  const char*kb=Kslot+hi*1024+r32*16;
  #pragma unroll
  for(int d0=0;d0<4;++d0){
    const bf16x8 b0=*reinterpret_cast<const bf16x8*>(kb+d0*2048);
    const bf16x8 b1=*reinterpret_cast<const bf16x8*>(kb+d0*2048+512);
    if(d0==0){p0=__builtin_amdgcn_mfma_f32_32x32x16_bf16(b0,qr[0],negm,0,0,0);p1=__builtin_amdgcn_mfma_f32_32x32x16_bf16(b1,qr[0],negm,0,0,0);}
    else{p0=__builtin_amdgcn_mfma_f32_32x32x16_bf16(b0,qr[d0],p0,0,0,0);p1=__builtin_amdgcn_mfma_f32_32x32x16_bf16(b1,qr[d0],p1,0,0,0);}}
}
typedef __attribute__((address_space(3))) const char* lds_cptr;
typedef short v4i16_t __attribute__((ext_vector_type(4)));
__device__ __forceinline__ void kload8(bf16x8*kf,lds_cptr kp){
  kf[0]=*(const __attribute__((address_space(3))) bf16x8*)(kp);      kf[1]=*(const __attribute__((address_space(3))) bf16x8*)(kp+512);
  kf[2]=*(const __attribute__((address_space(3))) bf16x8*)(kp+2048); kf[3]=*(const __attribute__((address_space(3))) bf16x8*)(kp+2560);
  kf[4]=*(const __attribute__((address_space(3))) bf16x8*)(kp+4096); kf[5]=*(const __attribute__((address_space(3))) bf16x8*)(kp+4608);
  kf[6]=*(const __attribute__((address_space(3))) bf16x8*)(kp+6144); kf[7]=*(const __attribute__((address_space(3))) bf16x8*)(kp+6656);
}
__device__ __forceinline__ void kload2(bf16x8*kf,lds_cptr kp,int j){ kf[2*j]=*(const __attribute__((address_space(3))) bf16x8*)(kp+j*2048); kf[2*j+1]=*(const __attribute__((address_space(3))) bf16x8*)(kp+j*2048+512); }
__device__ __forceinline__ s16x4 vtr(lds_cptr p){ return __builtin_bit_cast(s16x4,__builtin_amdgcn_ds_read_tr16_b64_v4i16((__attribute__((address_space(3))) v4i16_t*)p)); }
__device__ __forceinline__ float rowmax(const f32x16&p0,const f32x16&p1){
  float a=max3f(p0[0],p0[1],p1[0]),b=max3f(p0[2],p0[3],p1[1]);a=max3f(a,p1[2],p1[3]);
  #pragma unroll
  for(int r=4;r<16;r+=4){a=max3f(a,p0[r],p0[r+1]);b=max3f(b,p0[r+2],p0[r+3]);a=max3f(a,p1[r],p1[r+1]);b=max3f(b,p1[r+2],p1[r+3]);}
  const float m=max2f(a,b);
  auto rr=__builtin_amdgcn_permlane32_swap(__float_as_uint(m),__float_as_uint(m),false,false);
  return max2f(__uint_as_float(rr[0]),__uint_as_float(rr[1]));
}
__device__ __forceinline__ void pv(f32x16*o,int vb,bf16x8 pa0,bf16x8 pa1,bf16x8 pa2,bf16x8 pa3){
  #pragma unroll
  for(int d0=0;d0<2;++d0){s16x4 lo[4],hi[4];
    #pragma unroll
    for(int ks=0;ks<4;++ks){
      asm volatile("ds_read_b64_tr_b16 %0,%1 offset:%c2":"=&v"(lo[ks]):"v"(vb),"i"(d0*4096+ks*1024):"memory");
      asm volatile("ds_read_b64_tr_b16 %0,%1 offset:%c2":"=&v"(hi[ks]):"v"(vb),"i"(d0*4096+ks*1024+512):"memory");}
    asm volatile("s_waitcnt lgkmcnt(0)":::"memory");SBAR();
    #define PK(k) (bf16x8){lo[k][0],lo[k][1],lo[k][2],lo[k][3],hi[k][0],hi[k][1],hi[k][2],hi[k][3]}
    o[d0]=__builtin_amdgcn_mfma_f32_32x32x16_bf16(pa0,PK(0),o[d0],0,0,0);
    o[d0]=__builtin_amdgcn_mfma_f32_32x32x16_bf16(pa1,PK(1),o[d0],0,0,0);
    o[d0]=__builtin_amdgcn_mfma_f32_32x32x16_bf16(pa2,PK(2),o[d0],0,0,0);
    o[d0]=__builtin_amdgcn_mfma_f32_32x32x16_bf16(pa3,PK(3),o[d0],0,0,0);
    #undef PK
  }
}
typedef const __attribute__((address_space(3))) f32x4* lds_f4ptr;
#define BIASADD(P0,P1,t) do{ const lds_f4ptr bp_=(lds_f4ptr)(shm3+bias_off+((t)*64+4*hi)*4); \
    _Pragma("unroll") for(int j_=0;j_<4;++j_){ const f32x4 b0_=bp_[2*j_]-mhat, b1_=bp_[8+2*j_]-mhat; \
      P0[4*j_]+=b0_[0]; P0[4*j_+1]+=b0_[1]; P0[4*j_+2]+=b0_[2]; P0[4*j_+3]+=b0_[3]; \
      P1[4*j_]+=b1_[0]; P1[4*j_+1]+=b1_[1]; P1[4*j_+2]+=b1_[2]; P1[4*j_+3]+=b1_[3]; } }while(0)

#define CINIT(P0,P1,t) do{ const lds_f4ptr bp_=(lds_f4ptr)(shm3+bias_off+((t)*64+4*hi)*4); \
    _Pragma("unroll") for(int j_=0;j_<4;++j_){ const f32x4 b0_=bp_[2*j_]-mhat, b1_=bp_[8+2*j_]-mhat; \
      P0[4*j_]=b0_[0]; P0[4*j_+1]=b0_[1]; P0[4*j_+2]=b0_[2]; P0[4*j_+3]=b0_[3]; \
      P1[4*j_]=b1_[0]; P1[4*j_+1]=b1_[1]; P1[4*j_+2]=b1_[2]; P1[4*j_+3]=b1_[3]; } }while(0)
template<int THRL> __device__ __forceinline__ void attn_unit(int b,int h,int qb,const bf16*Q,const bf16*__restrict__ K,const bf16*__restrict__ V,bf16*O,const float*__restrict__ CB,float*__restrict__ SSQ,char*shm,const float skip_th){
  int tid=threadIdx.x; asm volatile("":"+v"(tid));
  const int lane=tid&63,r32=lane&31,hi=lane>>5; const int wid=__builtin_amdgcn_readfirstlane(tid>>6);
  const long rowbase=(long)b*SEQ; const int q0=qb*QB;
  const bf16*Qw=Q+(rowbase+q0+wid*QBLK)*ADM+h*D;
  int t0=0; { const float*cbh0=CB+(long)(b*NHEAD+h)*SEQ; const int npair=(q0+QB)/KVBLK/2-2; const float c0v=cbh0[q0];
    const bool far=(lane<npair)&&(cbh0[128*(lane<npair?lane:0)+127]-c0v>skip_th); const unsigned long long mk=__ballot(far);
    int lead=__builtin_ctzll(~mk); if(lead>npair)lead=npair; if(lead<0)lead=0; t0=2*__builtin_amdgcn_readfirstlane(lead); }
  const bf16*Kh=K+(rowbase+(long)t0*KVBLK)*ADM+h*D,*Vh=V+(rowbase+(long)t0*KVBLK)*ADM+h*D;
  const unsigned lds0=(unsigned)(uintptr_t)shm;
  float*wsf=(float*)(shm+LDS_WS)+wid*64;
  const lds_cptr shm3=(lds_cptr)shm;
  { const float*cbh=CB+(long)(b*NHEAD+h)*SEQ; const float cref=cbh[q0+128];
    if(tid*4<q0+QB){ const f32x4 c4=*(const f32x4*)(cbh+tid*4); *(__attribute__((address_space(3))) f32x4*)(shm3+LDS_BIAS+tid*16)=(f32x4){cref-c4[0],cref-c4[1],cref-c4[2],cref-c4[3]}; } }
  const bf16*ksrc=Kh+(long)lane*ADM+wid*8;
  const bf16*vsrc=Vh+(long)(16*(wid&3)+(lane>>2))*ADM+(wid>>2)*32+(lane&3)*8;
  const unsigned kdst=lds0+LDS_K+wid*1024, vdst=lds0+LDS_V+wid*1024;
  #define DMA_K(t,slot) glds16(ksrc+(long)(t)*KVBLK*ADM,(unsigned)__builtin_amdgcn_readfirstlane(kdst+(slot)))
  #define DMA_V(t,slot) glds16(vsrc+(long)(t)*KVBLK*ADM,(unsigned)__builtin_amdgcn_readfirstlane(vdst+(slot)))
  const int vb0=(int)(lds0+LDS_V)+((lane>>4)&1)*32+(lane&3)*8+(4*hi+((lane&15)>>2))*64;
  const char*Kbase=shm+LDS_K; bf16x8 kf[8];
  const lds_cptr kp0=shm3+LDS_K+hi*1024+r32*16; const lds_cptr vp0=shm3+LDS_V+((lane>>4)&1)*32+(lane&3)*8+(4*hi+((lane&15)>>2))*64;
  const int NT=(q0+QB)/KVBLK-t0; const int bias_off=LDS_BIAS+t0*KVBLK*4;
  DMA_K(0,0);DMA_V(0,0);DMA_K(1,SLOTB);
  bf16x8 qr[4];
  #pragma unroll
  for(int d0=0;d0<4;++d0)qr[d0]=*reinterpret_cast<const bf16x8*>(&Qw[(long)r32*ADM+d0*16+hi*8]);
  float mhat=0.f,l_reg=0.f;f32x16 o[2];o[0]=f32x16{};o[1]=f32x16{};const f32x16 negm=f32x16{};
  const int qrel=wid*QBLK+r32;
  #define CMASK(P0,P1,t) do{int jb_=(t)-(NT-4); if(jb_>=0)cmask(P0,P1,jb_,qrel,hi);}while(0)
  bool resc=false;
  #define START(P0,P1) do{ const float rm=rowmax(P0,P1); resc=false; \
    { const float dl=max2f(rm,-24.f); mhat=fadd_s(mhat,dl); \
      _Pragma("unroll") for(int r=0;r<16;++r){P0[r]=fsub_s(P0[r],dl);P1[r]=fsub_s(P1[r],dl);} } \
    _Pragma("unroll") for(int r=0;r<16;++r)P0[r]=__builtin_amdgcn_exp2f(P0[r]); }while(0)
  #define RESC() do{ if(resc){ asm volatile("s_waitcnt lgkmcnt(0)":::"memory"); \
      _Pragma("unroll") for(int d_=0;d_<2;++d_) _Pragma("unroll") for(int r=0;r<16;++r)o[d_][r]*=wsf[crow(r,hi)]; } }while(0)
  f32x16 pA0,pA1,pB0,pB1;
  int sl_prev=0,sl_cur=0,sl_next=SLOTB;
  #define ROT() do{sl_prev=sl_cur;sl_cur=sl_next;sl_next=(sl_next==(NSLOT-1)*SLOTB)?0:sl_next+SLOTB;}while(0)
  DMA_K(2,2*SLOTB);
  WAIT_BAR(3);
  qkt(pA0,pA1,Kbase,qr,negm,r32,hi);asm volatile("s_nop 15\n\ts_nop 7":"+v"(pA0),"+v"(pA1));BIASADD(pA0,pA1,0);CMASK(pA0,pA1,0);
  START(pA0,pA1);
  _Pragma("unroll") for(int r=0;r<16;++r)pA1[r]=__builtin_amdgcn_exp2f(pA1[r]);
  WAIT_BAR(0);
  DMA_K(3,0);DMA_V(1,SLOTB);
  ROT();
  kload8(kf,kp0+sl_cur);
  WAIT_BAR(2);
  s16x4 vlo[8],vhi[8]; u32x4 pw0,pw1,pw2,pw3;
  #define PKW(P,B) cvtpk_s(P[B],P[B+1])
  #define PAF(k) __builtin_bit_cast(bf16x8,pw##k)
  #define VFR(i) (bf16x8){vlo[i][0],vlo[i][1],vlo[i][2],vlo[i][3],vhi[i][0],vhi[i][1],vhi[i][2],vhi[i][3]}
  #define PIN(x) asm volatile("":"+v"(x))
  #define MX3(a,b,c) __builtin_fmaxf(__builtin_fmaxf((a),(b)),(c))
  #define GAPA(MF,A0,A1,A2,A3,W0,W1,PW) do{ MF; sacc+=A0; sacc+=A1; sacc+=A2; sacc+=A3; PIN(sacc); W0; W1; PIN(PW); SBAR(); }while(0)
  #define EX(v) __builtin_amdgcn_exp2f(v)
  #define GAPB(MF,X,B) do{ MF; X[B]=EX(X[B]); X[B+1]=EX(X[B+1]); X[B+2]=EX(X[B+2]); X[B+3]=EX(X[B+3]); PIN(X); SBAR(); }while(0)
  #define VRD(i) do{ vlo[i]=vtr(vp_+(((i)>>2)*4096+((i)&3)*1024)); vhi[i]=vtr(vp_+(((i)>>2)*4096+((i)&3)*1024+512)); }while(0)
  #define KRD(G,j) do{ if(G){ kload2(kf,kp0+sl_next,j); SBAR(); } }while(0)
  #define STEP(C0,C1,P0,P1,t,GK,GV,GL) do{ SBAR(); CINIT(C0,C1,t); SBAR(); \
    const lds_cptr vp_=vp0+sl_prev; \
    VRD(0); SBAR(); float sacc=(P0[0]+P0[1]); \
    GAPA(C0=__builtin_amdgcn_mfma_f32_32x32x16_bf16(kf[0],qr[0],C0,0,0,0), P0[2],P0[3],P0[4],P0[5],     pw0[0]=PKW(P0,0), pw0[1]=PKW(P0,2), pw0); \
    VRD(4); SBAR(); GAPA(C1=__builtin_amdgcn_mfma_f32_32x32x16_bf16(kf[1],qr[0],C1,0,0,0), P0[6],P0[7],P0[8],P0[9],     pw0[2]=PKW(P0,4), pw0[3]=PKW(P0,6), pw0); \
    VRD(1); SBAR(); GAPA(C0=__builtin_amdgcn_mfma_f32_32x32x16_bf16(kf[2],qr[1],C0,0,0,0),   P0[10],P0[11],P0[12],P0[13], pw1[0]=PKW(P0,8), pw1[1]=PKW(P0,10), pw1); \
    VRD(5); SBAR(); GAPA(C1=__builtin_amdgcn_mfma_f32_32x32x16_bf16(kf[3],qr[1],C1,0,0,0),   P0[14],P0[15],P1[0],P1[1],   pw1[2]=PKW(P0,12),pw1[3]=PKW(P0,14), pw1); \
    VRD(2); SBAR(); GAPA(C0=__builtin_amdgcn_mfma_f32_32x32x16_bf16(kf[4],qr[2],C0,0,0,0),   P1[2],P1[3],P1[4],P1[5],     pw2[0]=PKW(P1,0), pw2[1]=PKW(P1,2), pw2); \
    VRD(6); SBAR(); GAPA(C1=__builtin_amdgcn_mfma_f32_32x32x16_bf16(kf[5],qr[2],C1,0,0,0),   P1[6],P1[7],P1[8],P1[9],     pw2[2]=PKW(P1,4), pw2[3]=PKW(P1,6), pw2); \
    VRD(3); SBAR(); GAPA(C0=__builtin_amdgcn_mfma_f32_32x32x16_bf16(kf[6],qr[3],C0,0,0,0),   P1[10],P1[11],P1[12],P1[13], pw3[0]=PKW(P1,8), pw3[1]=PKW(P1,10), pw3); \
    VRD(7); SBAR(); GAPA(C1=__builtin_amdgcn_mfma_f32_32x32x16_bf16(kf[7],qr[3],C1,0,0,0),   P1[14],P1[15],0.f,0.f,       pw3[2]=PKW(P1,12),pw3[3]=PKW(P1,14), pw3); \
    l_reg+=sacc; \
    if(GK){DMA_K((t)+3,sl_cur);} if(GV){DMA_V((t)+1,sl_next);} \
    CMASK(C0,C1,t); \
    { float a=MX3(C0[0],C0[1],C1[0]),b=MX3(C0[2],C0[3],C1[1]); a=MX3(a,C1[2],C1[3]); \
      _Pragma("unroll") for(int r=4;r<16;r+=4){a=MX3(a,C0[r],C0[r+1]);b=MX3(b,C0[r+2],C0[r+3]);a=MX3(a,C1[r],C1[r+1]);b=MX3(b,C1[r+2],C1[r+3]);} \
      float rm=__builtin_fmaxf(a,b); { auto rr=__builtin_amdgcn_permlane32_swap(__float_as_uint(rm),__float_as_uint(rm),false,false); rm=__builtin_fmaxf(__uint_as_float(rr[0]),__uint_as_float(rr[1])); } \
      resc=false; \
      if(__builtin_expect(__any(rm>(float)THRL),0)){ const float dl=__builtin_fmaxf(rm,0.f); mhat+=dl; \
        _Pragma("unroll") for(int r=0;r<16;++r){C0[r]-=dl;C1[r]-=dl;} \
        const float f=__builtin_amdgcn_exp2f(-dl); l_reg*=f; if(hi==0)wsf[r32]=f; resc=true; } } \
    SBAR(); \
    GAPB(o[0]=__builtin_amdgcn_mfma_f32_32x32x16_bf16(PAF(0),VFR(0),o[0],0,0,0), C0,0); \
    GAPB(o[1]=__builtin_amdgcn_mfma_f32_32x32x16_bf16(PAF(0),VFR(4),o[1],0,0,0), C0,4); \
    KRD(GL,0); GAPB(o[0]=__builtin_amdgcn_mfma_f32_32x32x16_bf16(PAF(1),VFR(1),o[0],0,0,0), C0,8); \
    KRD(GL,1); GAPB(o[1]=__builtin_amdgcn_mfma_f32_32x32x16_bf16(PAF(1),VFR(5),o[1],0,0,0), C0,12); \
    KRD(GL,2); GAPB(o[0]=__builtin_amdgcn_mfma_f32_32x32x16_bf16(PAF(2),VFR(2),o[0],0,0,0), C1,0); \
    KRD(GL,3); GAPB(o[1]=__builtin_amdgcn_mfma_f32_32x32x16_bf16(PAF(2),VFR(6),o[1],0,0,0), C1,4); \
    GAPB(o[0]=__builtin_amdgcn_mfma_f32_32x32x16_bf16(PAF(3),VFR(3),o[0],0,0,0), C1,8); \
    GAPB(o[1]=__builtin_amdgcn_mfma_f32_32x32x16_bf16(PAF(3),VFR(7),o[1],0,0,0), C1,12); \
    }while(0)
  int t=1;
  #undef CMASK
  #define CMASK(P0,P1,t) do{}while(0)
  for(;t+5<NT;t+=2){
    STEP(pB0,pB1,pA0,pA1,t,true,true,true);     WAIT_BAR(2); RESC(); ROT();
    STEP(pA0,pA1,pB0,pB1,t+1,true,true,true);   WAIT_BAR(2); RESC(); ROT();
  }
  #undef CMASK
  #define CMASK(P0,P1,t) do{int jb_=(t)-(NT-4); if(jb_>=0)cmask(P0,P1,jb_,qrel,hi);}while(0)
  #define ENDW(tt) do{ if((tt)+3<NT){WAIT_BAR(2);} else if((tt)+2<NT){WAIT_BAR(1);} else {WAIT_BAR(0);} }while(0)
  for(;t+1<NT;t+=2){
    STEP(pB0,pB1,pA0,pA1,t,(t+3<NT),(t+1<NT),(t+1<NT));       ENDW(t);   RESC(); ROT();
    STEP(pA0,pA1,pB0,pB1,t+1,(t+4<NT),(t+2<NT),(t+2<NT));     ENDW(t+1); RESC(); ROT();
  }
  STEP(pB0,pB1,pA0,pA1,NT-1,false,false,false); RESC();
  { float sacc=pB0[0]+pB0[1]; _Pragma("unroll") for(int r=2;r<16;++r)sacc+=pB0[r]; _Pragma("unroll") for(int r=0;r<16;++r)sacc+=pB1[r]; l_reg+=sacc;
    pw0=(u32x4){PKW(pB0,0),PKW(pB0,2),PKW(pB0,4),PKW(pB0,6)};pw1=(u32x4){PKW(pB0,8),PKW(pB0,10),PKW(pB0,12),PKW(pB0,14)};pw2=(u32x4){PKW(pB1,0),PKW(pB1,2),PKW(pB1,4),PKW(pB1,6)};pw3=(u32x4){PKW(pB1,8),PKW(pB1,10),PKW(pB1,12),PKW(pB1,14)};
    SBAR(); pv(o,vb0+sl_cur,PAF(0),PAF(1),PAF(2),PAF(3)); }
  #undef PKW
  #undef PAF
  #undef VFR
  #undef PIN
  #undef MX3
  #undef GAPA
  #undef GAPB
  #undef EX
  #undef VRD
  #undef KRD
  #undef STEP
  #undef ENDW
  {auto rr=__builtin_amdgcn_permlane32_swap(__float_as_uint(l_reg),__float_as_uint(l_reg),false,false);l_reg=__uint_as_float(rr[0])+__uint_as_float(rr[1]);}
  if(hi==0)wsf[32+r32]=l_reg;asm volatile("s_waitcnt lgkmcnt(0)":::"memory");
  float rli[16];
  #pragma unroll
  for(int r=0;r<16;++r)rli[r]=__builtin_amdgcn_rcpf(wsf[32+crow(r,hi)]);
  int lane2=lane; asm volatile("":"+v"(lane2));
  bf16*Ow=O+(rowbase+q0+wid*QBLK)*OPITCH+h*D;
  { bf16*stg=(bf16*)(shm+LDS_OST)+wid*2048;
    #pragma unroll
    for(int r=0;r<16;++r){const int orow=crow(r,hi);
      #pragma unroll
      for(int d0=0;d0<2;++d0)stg[orow*64+d0*32+r32]=__float2bfloat16(o[d0][r]*rli[r]);}
    asm volatile("s_waitcnt lgkmcnt(0)":::"memory");
    #pragma unroll
    for(int i=0;i<4;++i){const int row=i*8+(lane2>>3),ch=lane2&7; const u32x4 v=*(const u32x4*)(stg+row*64+ch*8); *(u32x4*)(Ow+(long)row*OPITCH+ch*8)=v;
      float s=(bflo(v.x)*bflo(v.x)+bfhi(v.x)*bfhi(v.x))+(bflo(v.y)*bflo(v.y)+bfhi(v.y)*bfhi(v.y))+(bflo(v.z)*bflo(v.z)+bfhi(v.z)*bfhi(v.z))+(bflo(v.w)*bflo(v.w)+bfhi(v.w)*bfhi(v.w));
      s+=__shfl_xor(s,1); s+=__shfl_xor(s,2); s+=__shfl_xor(s,4);
      if(ch==0)SSQ[(rowbase+q0+wid*QBLK+row)*NHEAD+h]=s; } }
  asm volatile("s_waitcnt lgkmcnt(0)\n\ts_barrier":::"memory");
  #undef DMA_K
  #undef DMA_V
  #undef CMASK
  #undef START
  #undef RESC
  #undef ROT
}
#undef SBAR
#undef WAIT_BAR
}

constexpr int RING_BYTES = 131072;
constexpr int LDS_TOTAL = 147456;
struct Args { const float* in[32]; float* out; unsigned char* ws; };
typedef const float* const __attribute__((address_space(4)))* InTab;
enum In { I_X = 0, I_MEM, I_NORM_MIX, I_W_IN, I_FQN, I_FKN, I_FBIAS, I_ARE, I_AIM, I_LOGDT, I_BRE, I_BIM, I_CRE, I_CIM, I_D, I_WGLU, I_BGLU, I_ONF, I_ONS, I_WOUT,
          I_NCROSS, I_NMEM, I_WXQ, I_WXKV, I_XQN, I_XKN, I_WXO, I_NFFN, I_WUP, I_CONVW, I_CONVB, I_WDN };

struct TJob { const float* W; int ldw, col0, ncols, K; const float* kg; const float* kg2; bf16_t* WT; int mapid, rowoff, items; };
__device__ __forceinline__ int tmap(int mapid, int n, int rowoff) {
    if (mapid == 1) { const int part = n >> 9, f = n & 511, head = f >> 6, d = f & 63; return 512 * part + 256 * (head >> 2) + 128 * (d >> 5) + 32 * (head & 3) + (d & 31); }
    if (mapid == 2) { const int isup = n >= DFF ? 1 : 0; const int j = n - isup * DFF; return 256 * (j >> 7) + 128 * isup + (j & 127); }
    return rowoff + n;
}
__device__ __forceinline__ void transpose_item(const TJob& J, LAS float* scr, int item, int lane) {
    LAS unsigned* s32 = (LAS unsigned*)scr; const LAS unsigned short* s16 = (const LAS unsigned short*)scr;
    const int nblk = J.ncols / 128, kb = item / nblk, nb = item % nblk, k0 = 64 * kb, n0 = 128 * nb;
    const float* src = J.W + (size_t)k0 * J.ldw + J.col0 + n0 + 2 * lane;
    float gv = 1.f; if (J.kg) { const int k = k0 + lane; gv = (J.kg2 && k >= 512) ? J.kg2[k - 512] : J.kg[k]; }
#pragma unroll 16
    for (int kk = 0; kk < 64; ++kk) { f32x2 w = *(const f32x2*)(src + (size_t)kk * J.ldw);
        w = w * __builtin_bit_cast(float, __builtin_amdgcn_readlane(__builtin_bit_cast(int, gv), kk));
        s32[kk * 64 + lane] = pk2(w[0], w[1]); }
    asm volatile("s_waitcnt lgkmcnt(0)" ::: "memory");
    const int c = lane & 7;
#pragma unroll 4
    for (int j = 0; j < 16; ++j) { const int n = (lane >> 3) + 8 * j; const LAS unsigned short* s = s16 + (8 * c) * 128 + n;
        u32x4 o; o.x = (unsigned)s[0] | ((unsigned)s[128] << 16); o.y = (unsigned)s[256] | ((unsigned)s[384] << 16); o.z = (unsigned)s[512] | ((unsigned)s[640] << 16); o.w = (unsigned)s[768] | ((unsigned)s[896] << 16);
        *(u32x4*)(J.WT + (size_t)tmap(J.mapid, n0 + n, J.rowoff) * J.K + k0 + 8 * c) = o; }
    asm volatile("s_waitcnt lgkmcnt(0)" ::: "memory");
}
constexpr int NTJ = 11;
__device__ __forceinline__ void get_tjob(InTab in, unsigned char* ws, int j, TJob& J) {
    J.kg = nullptr; J.kg2 = nullptr; J.mapid = 0; J.rowoff = 0; J.col0 = 0;
    switch (j) {
    case 0: J.W = in[I_W_IN]; J.ldw = INCOLS; J.col0 = 0; J.ncols = 1024; J.K = 1024; J.WT = (bf16_t*)(ws + WS_WIN); J.mapid = 1; break;
    case 1: J.W = in[I_W_IN]; J.ldw = INCOLS; J.col0 = 1024; J.ncols = 512; J.K = 1024; J.WT = (bf16_t*)(ws + WS_WIN); J.rowoff = 1024; break;
    case 2: J.W = in[I_W_IN]; J.ldw = INCOLS; J.col0 = 1544; J.ncols = 512; J.K = 1024; J.WT = (bf16_t*)(ws + WS_WIN); J.rowoff = 1536; break;
    case 3: J.W = in[I_WGLU]; J.ldw = 512; J.ncols = 512; J.K = 512; J.WT = (bf16_t*)(ws + WS_WGLU); break;
    case 4: J.W = in[I_WOUT]; J.ldw = 1024; J.ncols = 1024; J.K = 1024; J.WT = (bf16_t*)(ws + WS_WOUT); J.kg = in[I_ONF]; J.kg2 = in[I_ONS]; break;
    case 5: J.W = in[I_WXQ]; J.ldw = 1024; J.ncols = 1024; J.K = 1024; J.WT = (bf16_t*)(ws + WS_WXQ); J.kg = in[I_NCROSS]; break;
    case 6: J.W = in[I_WXKV]; J.ldw = 2048; J.col0 = 0; J.ncols = 1024; J.K = 1024; J.WT = (bf16_t*)(ws + WS_WXK); break;
    case 7: J.W = in[I_WXKV]; J.ldw = 2048; J.col0 = 1024; J.ncols = 1024; J.K = 1024; J.WT = (bf16_t*)(ws + WS_WXV); break;
    case 8: J.W = in[I_WXO]; J.ldw = 1024; J.ncols = 1024; J.K = 1024; J.WT = (bf16_t*)(ws + WS_WXO); break;
    case 9: J.W = in[I_WUP]; J.ldw = 2 * DFF; J.ncols = 2 * DFF; J.K = 1024; J.WT = (bf16_t*)(ws + WS_WUP); J.kg = in[I_NFFN]; J.mapid = 2; break;
    default: J.W = in[I_WDN]; J.ldw = 1024; J.ncols = 1024; J.K = DFF; J.WT = (bf16_t*)(ws + WS_WDN); break;
    }
    J.items = (J.K / 64) * (J.ncols / 128);
}

__device__ __forceinline__ void rms_row(const float* xrow, const float* gain, bf16_t* orow, int lane, f32x4 (&v)[4]) {
    const f32x4* xr = (const f32x4*)xrow + lane; float s = 0.f;
#pragma unroll
    for (int j = 0; j < 4; ++j) { v[j] = xr[64 * j]; s += (v[j][0] * v[j][0] + v[j][1] * v[j][1]) + (v[j][2] * v[j][2] + v[j][3] * v[j][3]); }
    const float rs = rsqrtf(wave_sum(s) * (1.f / DM) + EPS);
    u32x2* o8 = (u32x2*)orow + lane;
#pragma unroll
    for (int j = 0; j < 4; ++j) { v[j] = v[j] * rs * ((const f32x4*)gain)[64 * j + lane]; u32x2 w; w.x = pk2(v[j][0], v[j][1]); w.y = pk2(v[j][2], v[j][3]); o8[64 * j] = w; }
}

__device__ __forceinline__ void cpow(float ar, float ai, float dt, float e, float& r, float& i) {
    const float mag = __expf(ar * dt * e);
    float rev = ai * dt * e * 0.15915494309189535f; rev -= rintf(rev);
    const float ang = rev * 6.283185307179586f;
    r = mag * cosf(ang); i = mag * sinf(ang);
}

template <int NT>
__device__ __forceinline__ void s5_prep_task(InTab in, unsigned char* ws, int g, int tt, LAS float* L, int tid, bool valid) {
    LAS float* pwA = L; LAS float* pwB = L + 128; LAS float* pwC = L + 256; LAS float* cf = L + 384; LAS float* bb = L + 512; LAS float* cc = L + 512 + 2048;
    if (valid) {
        const float dt = __expf(in[I_LOGDT][g]);
        if (tid < 64) { const int p = tid; const float ar = in[I_ARE][g * 64 + p], ai = in[I_AIM][g * 64 + p];
            float r, i; cpow(ar, ai, dt, (float)tt, r, i); pwA[2 * p] = r; pwA[2 * p + 1] = i;
            cpow(ar, ai, dt, (float)(tt + 1), r, i); pwB[2 * p] = r; pwB[2 * p + 1] = i;
            cpow(ar, ai, dt, (float)(TC - 1 - tt), r, i); pwC[2 * p] = r; pwC[2 * p + 1] = i;
            float lr, li; cpow(ar, ai, dt, 1.f, lr, li);
            const float den = ar * ar + ai * ai, nr = lr - 1.f;
            cf[2 * p] = (nr * ar + li * ai) / den; cf[2 * p + 1] = (li * ar - nr * ai) / den;
            if (tt == 0) { cpow(ar, ai, dt, (float)TC, r, i); float* lb = (float*)(ws + WS_LB32); lb[(g * 64 + p) * 2] = r; lb[(g * 64 + p) * 2 + 1] = i; } }
        for (int idx = tid; idx < 1024; idx += NT) { cc[2 * idx] = in[I_CRE][g * 1024 + idx]; cc[2 * idx + 1] = in[I_CIM][g * 1024 + idx]; }
    }
    __syncthreads();
    if (valid)
        for (int idx = tid; idx < 1024; idx += NT) { const int p = idx >> 4; const float br = in[I_BRE][g * 1024 + idx], bi = in[I_BIM][g * 1024 + idx], cr = cf[2 * p], ci = cf[2 * p + 1];
            bb[2 * idx] = cr * br - ci * bi; bb[2 * idx + 1] = cr * bi + ci * br; }
    __syncthreads();
    if (valid) {
        for (int e = tid; e < 256; e += NT) {
            const int c = e >> 4, cp = e & 15; float s = 0.f;
            for (int p = 0; p < 64; ++p) { const float pr = pwA[2 * p], pi = pwA[2 * p + 1], br = bb[2 * (p * 16 + cp)], bi = bb[2 * (p * 16 + cp) + 1];
                const float mr = pr * br - pi * bi, mi = pr * bi + pi * br; s += cc[2 * (c * 64 + p)] * mr - cc[2 * (c * 64 + p) + 1] * mi; }
            if (tt == 0 && c == cp) s += in[I_D][g * 16 + c];
            ((float*)(ws + WS_KTAB))[((g * TC + tt) * 16 + c) * 16 + cp] = s; }
        bf16_t* bty = (bf16_t*)(ws + WS_BTY) + (size_t)g * 512 * UGP; bf16_t* bte = (bf16_t*)(ws + WS_BTE) + (size_t)g * 256 * 512;
        for (int idx = tid; idx < 1024; idx += NT) { const int c = idx >> 6, p = idx & 63;
            const float cr = cc[2 * idx], ci = cc[2 * idx + 1], pr = pwB[2 * p], pi = pwB[2 * p + 1];
            const float zr = cr * pr - ci * pi, zi = cr * pi + ci * pr;
            *(unsigned*)(bty + (size_t)(tt * 16 + c) * UGP + 512 + 2 * p) = pk2(zr, -zi); }
        for (int idx = tid; idx < 1024; idx += NT) { const int p = idx >> 4, cp = idx & 15;
            const float pr = pwC[2 * p], pi = pwC[2 * p + 1], br = bb[2 * idx], bi = bb[2 * idx + 1];
            bte[(size_t)(2 * p) * 512 + tt * 16 + cp] = (bf16_t)f2bf(pr * br - pi * bi); bte[(size_t)(2 * p + 1) * 512 + tt * 16 + cp] = (bf16_t)f2bf(pr * bi + pi * br); }
        for (int u = tid; u < 256; u += NT) *(u32x4*)(bte + (size_t)(128 + (u >> 1)) * 512 + tt * 16 + (u & 1) * 8) = (u32x4){0u, 0u, 0u, 0u};
    }
    __syncthreads();
}

#define RLX_AGENT __ATOMIC_RELAXED, __HIP_MEMORY_SCOPE_AGENT
#define XB_TMO      128
#define XB_XCNT(j)  (256  + 64 * (j))
#define XB_XSUB(j)  (1280 + 64 * (j))
#define XB_XGEN(j)  (2304 + 64 * (j))
#define XB_TOP      3328
#define XB_TOPGEN   3392
#define XCD_BAR_WORDS 3456
#define XB_SPIN_CAP (1u << 18)

__device__ __forceinline__ unsigned xb_ld(unsigned* p)              { return __hip_atomic_load(p, __ATOMIC_RELAXED, __HIP_MEMORY_SCOPE_AGENT); }
__device__ __forceinline__ unsigned xb_add(unsigned* p, unsigned v) { return __hip_atomic_fetch_add(p, v, __ATOMIC_RELAXED, __HIP_MEMORY_SCOPE_AGENT); }
__device__ __forceinline__ unsigned xb_xcc_id() { return (unsigned)__builtin_amdgcn_s_getreg((3 << 11) | 20) & 0xFu; }
#define XB_SPIN(cond, bar) do { unsigned _sp = 0; while (cond) { __builtin_amdgcn_s_sleep(1); \
    if ((++_sp & 255u) == 0u) { if (xb_ld(&(bar)[XB_TMO])) break; if (_sp > XB_SPIN_CAP) { atomicAdd(&(bar)[XB_TMO], 1u); break; } } } } while (0)

struct XcdBarrier {
    unsigned* bar; unsigned x;
    volatile LAS unsigned* st;
};

__device__ __forceinline__ XcdBarrier xcd_barrier_post(unsigned* bar, volatile LAS unsigned* st) {
    XcdBarrier b; b.bar = bar; b.x = xb_xcc_id(); b.st = st;
    if (threadIdx.x == 0) (void)xb_add(&bar[XB_XCNT(b.x)], 1u);
    return b;
}
__device__ __forceinline__ void xcd_barrier_complete(unsigned* bar, unsigned x, unsigned& nloc, unsigned& nx) {
    const unsigned G = gridDim.x * gridDim.y * gridDim.z;
    unsigned sum, cnt, mine, sp = 0u;
    for (;;) {
        sum = 0u; cnt = 0u; mine = 0u;
#pragma unroll
        for (unsigned j = 0; j < 16; ++j) { const unsigned c = xb_ld(&bar[XB_XCNT(j)]); sum += c; cnt += (c > 0u) ? 1u : 0u; mine = (j == x) ? c : mine; }
        if (sum == G) break;
        __builtin_amdgcn_s_sleep(1);
        if ((++sp & 255u) == 0u) { if (xb_ld(&bar[XB_TMO])) break; if (sp > XB_SPIN_CAP) { atomicAdd(&bar[XB_TMO], 1u); break; } }
    }
    nloc = mine > 0u ? mine : 1u; nx = cnt > 0u ? cnt : 1u;
}

__device__ __forceinline__ void xcd_barrier(const XcdBarrier& b) {
    asm volatile("s_waitcnt vmcnt(0)" ::: "memory");
    __syncthreads();
    if (threadIdx.x == 0) {
        unsigned* bar = b.bar;
        __builtin_amdgcn_s_waitcnt(0);
        unsigned nloc = b.st[0], nx = b.st[1];
        if (nloc == 0u) { xcd_barrier_complete(bar, b.x, nloc, nx); b.st[0] = nloc; b.st[1] = nx; }
        const unsigned old = xb_add(&bar[XB_XSUB(b.x)], 1u);
        const unsigned gen = old / nloc;
        if (old + 1u == (gen + 1u) * nloc) {
            __builtin_amdgcn_fence(__ATOMIC_RELEASE, "agent");
            asm volatile("s_waitcnt vmcnt(0)" ::: "memory");
            const unsigned og = xb_add(&bar[XB_TOP], 1u);
            const unsigned tg = og / nx;
            if (og + 1u == (tg + 1u) * nx) xb_add(&bar[XB_TOPGEN], 1u);
            else XB_SPIN(xb_ld(&bar[XB_TOPGEN]) == tg, bar);
            __builtin_amdgcn_fence(__ATOMIC_ACQUIRE, "agent");
            xb_add(&bar[XB_XGEN(b.x)], 1u);
            asm volatile("s_waitcnt vmcnt(0)" ::: "memory");
        } else {
            XB_SPIN(xb_ld(&bar[XB_XGEN(b.x)]) == gen, bar);
            __builtin_amdgcn_fence(__ATOMIC_ACQUIRE, "agent");
            asm volatile("s_waitcnt vmcnt(0)" ::: "memory");
        }
    }
    __syncthreads();
}


#ifndef FIRST_STEP
#define FIRST_STEP 0
#endif
#ifndef LAST_STEP
#define LAST_STEP 18
#endif
#define ON(n) (FIRST_STEP <= (n) && (n) <= LAST_STEP)
#define SYNC(n) do { if ((n) < LAST_STEP) { XcdBarrier bar_; bar_.bar = (unsigned*)ws; bar_.x = xb_xcc_id(); bar_.st = (volatile LAS unsigned*)(L + RING_BYTES + 352); xcd_barrier(bar_); } } while (0)
#define WSB(off) ((const bf16_t*)(ws + (off)))
__global__ void __launch_bounds__(512, 2) fox_s5_mega(Args a) {
    extern __shared__ __attribute__((aligned(16))) unsigned char lds[];
    LAS unsigned char* L = (LAS unsigned char*)lds;
    const int G = gridDim.x, bx = blockIdx.x, NGW = G * 8, NGT = G * 512;
#define KA const __attribute__((address_space(4))) unsigned char* ka_ = (const __attribute__((address_space(4))) unsigned char*)__builtin_amdgcn_kernarg_segment_ptr(); asm volatile("" : "+s"(ka_)); \
    InTab in = (InTab)ka_; float* out = *(float* const __attribute__((address_space(4)))*)(ka_ + 256); unsigned char* ws = *(unsigned char* const __attribute__((address_space(4)))*)(ka_ + 264); (void)in; (void)out;
#define IDS int tid = threadIdx.x; asm volatile("" : "+v"(tid)); const int lane = tid & 63, wave = __builtin_amdgcn_readfirstlane(tid >> 6); const int gw = bx * 8 + wave, gt = bx * 512 + tid; (void)lane; (void)gw; (void)gt;
    {
        KA
        if (threadIdx.x < 8) ((volatile LAS unsigned*)(L + RING_BYTES + 320))[threadIdx.x + 8 - 8] = 0u;
        if (threadIdx.x < 2) ((volatile LAS unsigned*)(L + RING_BYTES + 352))[threadIdx.x] = 0u;
        __syncthreads();
        (void)xcd_barrier_post((unsigned*)ws, (volatile LAS unsigned*)(L + RING_BYTES + 352));
    }

    if (ON(0)) {
        KA
        IDS
        LAS float* scr = (LAS float*)(L + wave * 16384);
        { int base = 0;
          for (int j = 0; j < NTJ; ++j) { TJob J; get_tjob(in, ws, j, J);
              int first = gw - (base % NGW); if (first < 0) first += NGW;
              for (int it = first; it < J.items; it += NGW) transpose_item(J, scr, it, lane);
              base += J.items; } }
        __syncthreads();
        LAS float* wf = (LAS float*)L;
        for (int idx = tid; idx < 8192; idx += 512) wf[idx] = in[I_W_IN][(size_t)(idx >> 3) * INCOLS + 1536 + (idx & 7)];
        __syncthreads();
        {
            f32x4 nx[4];
            if (gw < T) { const f32x4* xr = (const f32x4*)(in[I_X] + (size_t)gw * DM) + lane;
#pragma unroll
                for (int j = 0; j < 4; ++j) nx[j] = xr[64 * j]; }
            const f32x4* gp = (const f32x4*)in[I_NORM_MIX]; f32x4 gn[4];
#pragma unroll
            for (int j = 0; j < 4; ++j) gn[j] = gp[64 * j + lane];
            const float fbias = in[I_FBIAS][lane & 7];
            for (int m = gw; m < T; m += NGW) {
                f32x4 v[4]; float s = 0.f;
#pragma unroll
                for (int j = 0; j < 4; ++j) { v[j] = nx[j]; s += (v[j][0] * v[j][0] + v[j][1] * v[j][1]) + (v[j][2] * v[j][2] + v[j][3] * v[j][3]); }
                if (m + NGW < T) { const f32x4* xr = (const f32x4*)(in[I_X] + (size_t)(m + NGW) * DM) + lane;
#pragma unroll
                    for (int j = 0; j < 4; ++j) nx[j] = xr[64 * j]; }
                const float rs = rsqrtf(wave_sum(s) * (1.f / DM) + EPS);
                u32x2* o8 = (u32x2*)((bf16_t*)(ws + WS_HN) + (size_t)m * DM) + lane;
#pragma unroll
                for (int j = 0; j < 4; ++j) { v[j] = v[j] * rs * gn[j]; u32x2 w; w.x = pk2(v[j][0], v[j][1]); w.y = pk2(v[j][2], v[j][3]); o8[64 * j] = w; }
                float d[8];
#pragma unroll
                for (int h = 0; h < 8; ++h) d[h] = 0.f;
#pragma unroll
                for (int j = 0; j < 4; ++j)
#pragma unroll
                    for (int i = 0; i < 4; ++i) { const int k = 256 * j + 4 * lane + i; const f32x4 w0 = *(const LAS f32x4*)(wf + k * 8), w1 = *(const LAS f32x4*)(wf + k * 8 + 4);
                        d[0] += v[j][i] * w0[0]; d[1] += v[j][i] * w0[1]; d[2] += v[j][i] * w0[2]; d[3] += v[j][i] * w0[3];
                        d[4] += v[j][i] * w1[0]; d[5] += v[j][i] * w1[1]; d[6] += v[j][i] * w1[2]; d[7] += v[j][i] * w1[3]; }
                float e4[4];
#pragma unroll
                for (int h = 0; h < 4; ++h) { const float keep = (lane & 4) ? d[h + 4] : d[h], give = (lane & 4) ? d[h] : d[h + 4]; e4[h] = keep + __shfl_xor(give, 4); }
                float e2[2];
#pragma unroll
                for (int h = 0; h < 2; ++h) { const float keep = (lane & 2) ? e4[h + 2] : e4[h], give = (lane & 2) ? e4[h] : e4[h + 2]; e2[h] = keep + __shfl_xor(give, 2); }
                float z; { const float keep = (lane & 1) ? e2[1] : e2[0], give = (lane & 1) ? e2[0] : e2[1]; z = keep + __shfl_xor(give, 1); }
                z += __shfl_xor(z, 8); z += __shfl_xor(z, 16); z += __shfl_xor(z, 32);
                if (lane < 8) {
                    z += fbias;
                    const float ls = fminf(z, 0.f) - __logf(1.f + __expf(-fabsf(z)));
                    const int b = m >> 11, t = m & 2047;
                    ((float*)(ws + WS_LOGF))[(size_t)(b * 8 + lane) * SEQ + t] = ls; }
            }
        }
        for (int m = gw; m < TM; m += NGW) { f32x4 v[4]; rms_row(in[I_MEM] + (size_t)m * DM, in[I_NMEM], (bf16_t*)(ws + WS_MN) + (size_t)m * DM, lane, v); }
        __syncthreads();
        SYNC(0);
    }
    if (ON(2)) {
        KA
        pg8::Gemm g{WSB(WS_HN), WSB(WS_WIN), DM, DM, DM}; GOrder<OK_PLAIN> S; S.init(T / 256, 8, G, bx, DM, DM);
        Epi<EK_PROJ> E{ws + WS_Q, ws + WS_K, ws + WS_V, ws + WS_UG, in[I_FQN], in[I_FKN], nullptr};
        pg8::gemm_phase(L, g, S, E);
    }
    if (ON(1)) {
        KA
        IDS
        int seq = (bx < BATCH * NFH) ? bx : -1;
        if (G == 256) seq = (bx >= 64 && bx < 128) ? bx - 64 : ((bx >= 192) ? bx - 128 : -1);
        if (wave == 0 && seq >= 0) {
            const float* lf = (const float*)(ws + WS_LOGF) + (size_t)seq * SEQ + lane * 32; float* cb = (float*)(ws + WS_CB) + (size_t)seq * SEQ + lane * 32;
            f32x4 x[8]; float run = 0.f;
#pragma unroll
            for (int j = 0; j < 8; ++j) { x[j] = ((const f32x4*)lf)[j]; x[j][0] += run; x[j][1] += x[j][0]; x[j][2] += x[j][1]; x[j][3] += x[j][2]; run = x[j][3]; }
            float incl = run;
#pragma unroll
            for (int o = 1; o < 64; o <<= 1) { const float y = __shfl_up(incl, o); if (lane >= o) incl += y; }
            const float excl = incl - run;
#pragma unroll
            for (int j = 0; j < 8; ++j) ((f32x4*)cb)[j] = (x[j] + excl) * LOG2E;
        }
        {
            const int cnt = (G == 256) ? 128 : G, idx = (G == 256) ? seq : bx;
            if (idx >= 0) {
                const int NTASK = S5G * TC, sub = tid >> 7, ltid = tid & 127, per = NTASK / cnt;
                for (int i0 = 0; idx + i0 * cnt < NTASK; i0 += 4) { const int task = idx + (i0 + sub) * cnt; const bool valid = task < NTASK;
                    const int t2 = !valid ? 0 : ((NTASK % cnt == 0) ? (task % cnt) * per + task / cnt : task);
                    s5_prep_task<128>(in, ws, t2 / TC, t2 % TC, (LAS float*)L + sub * 5120, ltid, valid); }
            }
        }
    }
    if (ON(3)) {
        KA
        pg8::Gemm g{WSB(WS_MN), WSB(WS_WXK), DM, DM, DM}; GOrder<OK_PLAIN> S; S.init(TM / 256, 4, G, bx, DM, DM);
        Epi<EK_MEMK> E{ws + WS_KST, ws + WS_SSQK, nullptr, nullptr, nullptr, nullptr, nullptr};
        pg8::gemm_phase(L, g, S, E);
    }
    if (ON(4)) {
        KA
        pg8::Gemm g{WSB(WS_WXV), WSB(WS_MN), DM, DM, DM}; GOrder<OK_PLAIN> S; S.init(4, TM / 256, G, (bx + 128) % G, DM, DM);
        Epi<EK_MEMVT> E{ws + WS_VT, nullptr, nullptr, nullptr, nullptr, nullptr, nullptr};
        pg8::gemm_phase(L, g, S, E);
        SYNC(4);
    }
    if (ON(5)) {
        KA
        const int vcu = (G % 8 == 0) ? (bx % 8) * (G / 8) + bx / 8 : bx;
        float skip_th; { const int ln = threadIdx.x & 63; float gq = fabsf(in[I_FQN][ln]), gk = fabsf(in[I_FKN][ln]);
#pragma unroll
            for (int o = 1; o < 64; o <<= 1) { gq = fmaxf(gq, __shfl_xor(gq, o)); gk = fmaxf(gk, __shfl_xor(gk, o)); }
            skip_th = 2.f * (64.f * C2Q * gq * gk) + 40.f; }
        for (int L2 = vcu; L2 < BATCH * NFH * 2; L2 += G) { const int bh = L2 >> 1, s = L2 & 1;
            for (int i = 0; i < 4; ++i) { const int qb = (i == 0) ? s : (i == 1) ? 3 - s : (i == 2) ? 4 + s : 7 - s;
                attn_body::attn_unit<8>(bh >> 3, bh & 7, qb, (const attn_body::bf16*)(ws + WS_Q), (const attn_body::bf16*)(ws + WS_K), (const attn_body::bf16*)(ws + WS_V),
                                        (attn_body::bf16*)(ws + WS_MIXN), (const float*)(ws + WS_CB), (float*)(ws + WS_SSQF), (char*)lds, skip_th); } }
    }
    if (ON(6)) {
        KA
        pg8::Gemm g{WSB(WS_UG), WSB(WS_BTE), UGP, 512, 256}; GOrder<OK_S5E> S; S.init(256, 1, G, bx, UGP, 512);
        Epi<EK_S5E> E{ws + WS_EPART, nullptr, nullptr, nullptr, nullptr, nullptr, nullptr};
        pg8::gemm_phase(L, g, S, E);
        SYNC(6);
    }
    if (ON(7)) {
        KA
        IDS
        const float* kt = (const float*)(ws + WS_KTAB); bf16_t* bty = (bf16_t*)(ws + WS_BTY);
        for (int idx = gt; idx < S5G * 512 * 64; idx += NGT) {
            const int half = idx & 1, ss = (idx >> 1) & 31, nn = (idx >> 6) & 511, gI = idx >> 15; const int tt = nn >> 4, c = nn & 15;
            u32x4 w = (u32x4){0u, 0u, 0u, 0u};
            if (ss <= tt) { const float* src = kt + ((size_t)((gI * TC + (tt - ss)) * 16 + c)) * 16 + half * 8; const f32x4 k0 = *(const f32x4*)src, k1 = *(const f32x4*)(src + 4);
                w.x = pk2(k0[0], k0[1]); w.y = pk2(k0[2], k0[3]); w.z = pk2(k1[0], k1[1]); w.w = pk2(k1[2], k1[3]); }
            *(u32x4*)(bty + ((size_t)gI * 512 + nn) * UGP + ss * 16 + half * 8) = w; }
        const float* ep = (const float*)(ws + WS_EPART); const float* lb = (const float*)(ws + WS_LB32); bf16_t* ug = (bf16_t*)(ws + WS_UG);
        for (int idx = gt; idx < S5G * BATCH * S5P; idx += NGT) { const int p = idx & 63, gb = idx >> 6, gI = gb >> 4;
            const float lr = lb[(gI * 64 + p) * 2], li = lb[(gI * 64 + p) * 2 + 1]; float sr = 0.f, si = 0.f;
            for (int k0 = 0; k0 < NCH; k0 += 16) {
                f32x2 e0[16], e1[16];
#pragma unroll
                for (int j = 0; j < 16; ++j) { const size_t row = (size_t)gb * NCH + k0 + j; e0[j] = *(const f32x2*)(ep + row * 128 + 2 * p); e1[j] = *(const f32x2*)(ep + (size_t)32768 * 128 + row * 128 + 2 * p); }
#pragma unroll
                for (int j = 0; j < 16; ++j) { const size_t row = (size_t)gb * NCH + k0 + j;
                    *(unsigned*)(ug + row * UGP + 512 + 2 * p) = pk2(sr, si);
                    const float nr = lr * sr - li * si + (e0[j][0] + e1[j][0]), ni = lr * si + li * sr + (e0[j][1] + e1[j][1]); sr = nr; si = ni; } } }
        SYNC(7);
    }
    if (ON(8)) {
        KA
        pg8::Gemm g{WSB(WS_UG), WSB(WS_BTY), UGP, UGP, UGP}; GOrder<OK_S5Y> S; S.init(256, 1, G, bx, UGP, UGP);
        Epi<EK_S5Y> E{ws + WS_Y1, nullptr, nullptr, nullptr, nullptr, nullptr, nullptr};
        pg8::gemm_phase(L, g, S, E);
        SYNC(8);
    }
    if (ON(9)) {
        KA
        pg8::Gemm g{WSB(WS_Y1), WSB(WS_WGLU), 512, 512, 512}; GOrder<OK_PLAIN> S; S.init(T / 256, 2, G, bx, 512, 512);
        Epi<EK_GLU> E{ws + WS_MIXN, ws + WS_SSQY, nullptr, nullptr, ws + WS_Y1, in[I_BGLU], nullptr};
        pg8::gemm_phase(L, g, S, E);
        SYNC(9);
    }
    if (ON(11)) {
        KA
        pg8::Gemm g{WSB(WS_MIXN), WSB(WS_WOUT), DM, DM, DM}; GOrder<OK_PLAIN> S; S.init(T / 256, 4, G, bx, DM, DM);
        Epi<EK_WOUT> E{nullptr, ws + WS_H1B, ws + WS_SSQ1, nullptr, in[I_X], ws + WS_SSQF, ws + WS_SSQY};
        pg8::gemm_phase(L, g, S, E);
        SYNC(11);
    }
    if (ON(12)) {
        KA
        IDS
        const float* sk = (const float*)(ws + WS_SSQK); float* sck = (float*)(ws + WS_SCK);
        for (int idx = gt; idx < TM * 4; idx += NGT) { const int key = idx >> 2, h = idx & 3; const f32x4 q = *(const f32x4*)(sk + (size_t)key * 16 + h * 4);
            sck[(size_t)h * TM + key] = rsqrtf(((q[0] + q[1]) + (q[2] + q[3])) * (1.f / 256.f) + EPS); }
        pg8::Gemm g{WSB(WS_H1B), WSB(WS_WXQ), DM, DM, DM}; GOrder<OK_PLAIN> S; S.init(T / 256, 4, G, bx, DM, DM);
        Epi<EK_XQ> E{ws + WS_QST, ws + WS_SSQQ, nullptr, nullptr, in[I_XQN], in[I_XKN], nullptr};
        pg8::gemm_phase(L, g, S, E);
        SYNC(12);
    }
    if (ON(13)) {
        KA
        pg8::Gemm g{WSB(WS_QST), WSB(WS_KST), DM, DM, 256}; GOrder<OK_XS> S; S.init(512, 1, G, bx, DM, DM);
        Epi<EK_XS> E{ws + WS_P, ws + WS_PSUM, nullptr, nullptr, ws + WS_SSQ1, ws + WS_SSQQ, ws + WS_SCK};
        pg8::gemm_phase(L, g, S, E);
        SYNC(13);
    }
    if (ON(14)) {
        KA
        pg8::Gemm g{WSB(WS_P), WSB(WS_VT), DM, TM, 256}; GOrder<OK_XO> S; S.init(512, 1, G, bx, DM, TM);
        Epi<EK_XO> E{ws + WS_XO, nullptr, nullptr, nullptr, ws + WS_PSUM, nullptr, nullptr};
        pg8::gemm_phase(L, g, S, E);
        SYNC(14);
    }
    if (ON(15)) {
        KA
        pg8::Gemm g{WSB(WS_XO), WSB(WS_WXO), DM, DM, DM}; GOrder<OK_PLAIN> S; S.init(T / 256, 4, G, bx, DM, DM);
        Epi<EK_WXO> E{nullptr, ws + WS_H2B, ws + WS_SSQ2, nullptr, ws + WS_H1B, nullptr, nullptr};
        pg8::gemm_phase(L, g, S, E);
        SYNC(15);
    }
    if (ON(16)) {
        KA
        { IDS
          const float* s2 = (const float*)(ws + WS_SSQ2); float* r2 = (float*)(ws + WS_RS2);
          for (int row = gt; row < T; row += NGT) { const f32x4 t0 = *(const f32x4*)(s2 + (size_t)row * 16), t1 = *(const f32x4*)(s2 + (size_t)row * 16 + 4), t2 = *(const f32x4*)(s2 + (size_t)row * 16 + 8), t3 = *(const f32x4*)(s2 + (size_t)row * 16 + 12);
              r2[row] = rsqrtf((((t0[0] + t0[1]) + (t0[2] + t0[3])) + ((t1[0] + t1[1]) + (t1[2] + t1[3])) + ((t2[0] + t2[1]) + (t2[2] + t2[3])) + ((t3[0] + t3[1]) + (t3[2] + t3[3]))) * (1.f / DM) + EPS); }
          SYNC(15); }
        pg8::Gemm g{WSB(WS_H2B), WSB(WS_WUP), DM, DM, DM}; GOrder<OK_PLAIN> S; S.init(T / 256, 22, G, bx, DM, DM);
        Epi<EK_UPC> E{ws + WS_U, ws + WS_G, ws + WS_G + 4 * MiB, ws + WS_G + 8 * MiB, ws + WS_RS2, in[I_CONVW], in[I_CONVB], (LAS float*)(L + RING_BYTES + 1024)};
        pg8::gemm_phase(L, g, S, E);
        SYNC(16);
    }
    if (ON(17)) {
        KA
        IDS
        const float* GHF = (const float*)(ws + WS_G); const float* GHL = (const float*)(ws + WS_G + 4 * MiB); const float* UH = (const float*)(ws + WS_G + 8 * MiB);
        const float* cw = in[I_CONVW]; const float* cbv = in[I_CONVB]; bf16_t* A = (bf16_t*)(ws + WS_U);
        for (int idx = gt; idx < (T / 256) * 2 * DFF; idx += NGT) { const int j = idx % DFF, pi = idx / DFF, i = pi & 1, pm = pi >> 1; const bool first = (pm & 7) == 0;
            const float g0 = GHF[(size_t)pi * DFF + j];
            const float gl1 = first ? 0.f : GHL[((size_t)(pm - 1) * 2 + 1) * DFF + j], gl0 = first ? 0.f : GHL[((size_t)(pm - 1) * 2) * DFF + j];
            const float g1 = i ? GHF[(size_t)(pm * 2) * DFF + j] : gl1, g2 = i ? gl1 : gl0;
            const float z = cbv[j] + cw[j] * g2 + cw[DFF + j] * g1 + cw[2 * DFF + j] * g0;
            A[(size_t)(pm * 256 + i) * DFF + j] = (bf16_t)f2bf(z * sigm(z) * UH[(size_t)pi * DFF + j]); }
        SYNC(17);
    }
    if (ON(18)) {
        KA
        pg8::Gemm g{WSB(WS_U), WSB(WS_WDN), DFF, DFF, DFF}; GOrder<OK_PLAIN> S; S.init(T / 256, 4, G, bx, DFF, DFF);
        Epi<EK_DOWN> E{out, nullptr, nullptr, nullptr, ws + WS_H2B, nullptr, nullptr};
        pg8::gemm_phase(L, g, S, E);
    }
}

extern "C" void kernel_launch(void* const* d_in, const int* in_sizes, int n_in, void* d_out, int out_size, void* d_ws, size_t ws_size, hipStream_t stream) {
    static int grid = 0;
    if (grid == 0) {
        if (n_in != 32 || out_size != T * DM || ws_size < WS_END) { fprintf(stderr, "kernel_launch: unexpected shapes (n_in %d out %d ws %zu)\n", n_in, out_size, ws_size); grid = -1; return; }
        int dev = 0, cus = 0, per_cu = 0;
        (void)hipGetDevice(&dev); (void)hipDeviceGetAttribute(&cus, hipDeviceAttributeMultiprocessorCount, dev);
        if (hipFuncSetAttribute((const void*)fox_s5_mega, hipFuncAttributeMaxDynamicSharedMemorySize, LDS_TOTAL) != hipSuccess) { fprintf(stderr, "kernel_launch: hipFuncSetAttribute failed\n"); grid = -1; return; }
        if (hipOccupancyMaxActiveBlocksPerMultiprocessor(&per_cu, (const void*)fox_s5_mega, 512, LDS_TOTAL) != hipSuccess || per_cu < 1) { fprintf(stderr, "kernel_launch: occupancy query says %d\n", per_cu); per_cu = 1; }
        (void)hipGetLastError();
        grid = cus;
        if (grid > cus * per_cu) grid = cus * per_cu;
    }
    if (grid < 0) return;
    if (hipMemsetAsync(d_ws, 0, 65536, stream) != hipSuccess) { fprintf(stderr, "kernel_launch: memset of the barrier words failed\n"); return; }
    Args a{};
    for (int i = 0; i < 32; ++i) a.in[i] = (const float*)d_in[i];
    a.out = (float*)d_out; a.ws = (unsigned char*)d_ws;
    void* args[] = {&a};
    hipError_t e = hipLaunchCooperativeKernel((const void*)fox_s5_mega, dim3(grid), dim3(512), args, LDS_TOTAL, stream);
    if (e != hipSuccess) fprintf(stderr, "cooperative launch failed: %s (grid %d)\n", hipGetErrorString(e), grid);
}
```

```cpp
#include <hip/hip_runtime.h>
#include <hip/hip_bf16.h>
#include <cstdio>
#include <cstdint>
#include <cmath>

constexpr int BATCH = 16, SEQ = 2048, DM = 1024, T = BATCH * SEQ;
constexpr int NMEM = 256, TM = BATCH * NMEM;
constexpr int FOXW = 512, HD = 64, NFH = 8;
constexpr int S5W = 512, S5G = 32, S5C = 16, S5P = 64;
constexpr int NXH = 4, XHD = 256;
constexpr int DFF = 2816;
constexpr int INCOLS = 2056;
constexpr float EPS = 1e-6f;
constexpr int TC = 32, NCH = SEQ / TC;
constexpr int UGP = TC * 16 + 128;
constexpr float LOG2E = 1.4426950408889634f;
constexpr float C2Q = 0.125f * LOG2E;

#define LAS __attribute__((address_space(3)))
typedef unsigned short bf16_t;
typedef short bf16x8 __attribute__((ext_vector_type(8)));
typedef float f32x4 __attribute__((ext_vector_type(4)));
typedef float f32x2 __attribute__((ext_vector_type(2)));
typedef unsigned u32x4 __attribute__((ext_vector_type(4)));
typedef unsigned u32x2 __attribute__((ext_vector_type(2)));

__device__ __forceinline__ unsigned f2bf(float f) { unsigned u = __builtin_bit_cast(unsigned, f); return (u + 0x7fffu + ((u >> 16) & 1u)) >> 16; }
typedef __bf16 bf16x2_hw __attribute__((ext_vector_type(2)));
__device__ __forceinline__ unsigned pk2(float lo, float hi) { f32x2 v = {lo, hi}; bf16x2_hw b = __builtin_convertvector(v, bf16x2_hw); return __builtin_bit_cast(unsigned, b); }
__device__ __forceinline__ float bflo(unsigned w) { return __builtin_bit_cast(float, w << 16); }
__device__ __forceinline__ float bfhi(unsigned w) { return __builtin_bit_cast(float, w & 0xffff0000u); }
__device__ __forceinline__ float wave_sum(float v) {
#pragma unroll
    for (int o = 1; o < 64; o <<= 1) v += __shfl_xor(v, o);
    return v;
}

__device__ __forceinline__ float red_fq(float v) {
    v += __builtin_bit_cast(float, __builtin_amdgcn_ds_swizzle(__builtin_bit_cast(int, v), 0x401F));
    float a = v, b = v;
    asm volatile("s_nop 1\n\tv_permlane32_swap_b32 %0, %1\n\ts_nop 1" : "+v"(a), "+v"(b));
    return a + b;
}

constexpr size_t MiB = 1u << 20;
constexpr size_t WS_WIN = 1 * MiB, WS_WGLU = 5 * MiB, WS_WOUT = 6 * MiB, WS_WXQ = 8 * MiB, WS_WXK = 10 * MiB, WS_WXV = 12 * MiB, WS_WXO = 14 * MiB,
                 WS_WUP = 16 * MiB, WS_WDN = 27 * MiB, WS_BTY = 33 * MiB, WS_BTE = 53 * MiB, WS_KTAB = 61 * MiB, WS_LB32 = 62 * MiB, WS_LOGF = 63 * MiB,
                 WS_CB = 64 * MiB, WS_SSQF = 65 * MiB, WS_SSQY = 66 * MiB, WS_SSQ1 = 67 * MiB, WS_SSQ2 = 69 * MiB, WS_SSQQ = 71 * MiB, WS_PSUM = 73 * MiB,
                 WS_SSQK = 75 * MiB, WS_SCK = 76 * MiB, WS_RS2 = 77 * MiB, WS_RS1 = 77 * MiB + 512 * 1024;
constexpr size_t WS_HN = 80 * MiB, WS_MIXN = 80 * MiB, WS_Y1 = 304 * MiB, WS_QST = 80 * MiB, WS_H2B = 80 * MiB;
constexpr size_t WS_MN = 144 * MiB, WS_KST = 152 * MiB, WS_VT = 160 * MiB;
constexpr size_t WS_Q = 168 * MiB, WS_K = 200 * MiB, WS_V = 232 * MiB, WS_P = 168 * MiB;
constexpr size_t WS_UG = 264 * MiB, WS_EPART = 304 * MiB, WS_H1B = 264 * MiB, WS_XO = 336 * MiB;
constexpr size_t WS_G = 144 * MiB, WS_U = 320 * MiB, WS_END = 496 * MiB;

namespace pg8 {
constexpr int BM = 256, BK = 64, HALF = 128, HTB = HALF * BK * 2, STAGE_BYTES = 8 * HTB;
__device__ __forceinline__ int lds_byte(int r, int c) { const int st = (r >> 4) * 2 + (c >> 5), rr = r & 15, cc = c & 31, ob = rr * 64 + cc * 2; return st * 1024 + (ob ^ (((ob >> 9) & 1) << 5)); }
__device__ __forceinline__ void stage_rc(int b, int& R, int& C) { const int st = b / 1024, sb = b % 1024, swz = sb ^ (((sb >> 9) & 1) << 5); R = (st >> 1) * 16 + swz / 64; C = (st & 1) * 32 + (swz % 64) / 2; }
__device__ __forceinline__ int perm32(int rho) { const int n = rho >> 4, i = rho & 15; return 8 * (i >> 2) + 4 * n + (i & 3); }

struct Unit { int pm, pn; long offA, offB; };
struct Gemm { const bf16_t* A; const bf16_t* Bt; int lda, ldb, K; };

template <class Epi, class Sched>
__device__ __forceinline__ void gemm_phase(LAS unsigned char* lds, const Gemm g, const Sched& S, const Epi& E) {
    int tid = threadIdx.x; asm volatile("" : "+v"(tid));
    const int wid = __builtin_amdgcn_readfirstlane(tid >> 6), lane = tid & 63, wr = wid >> 2, wc = wid & 3, fr = lane & 15, fq = lane >> 4;
    const int K = g.K, nt = K / BK;
    unsigned voffA[2], voffB[2];
#pragma unroll
    for (int i = 0; i < 2; ++i) { int R, C; stage_rc(tid * 16 + i * 8192, R, C); const int Rb = (R & ~31) + perm32(R & 31);
        voffA[i] = (unsigned)(R * g.lda + C) * 2u; voffB[i] = (unsigned)(Rb * g.ldb + C) * 2u; }
    const size_t kstep = (size_t)(BK * 2);
    const size_t hstepA = (size_t)HALF * g.lda * 2, hstepB = (size_t)HALF * g.ldb * 2;
    const unsigned ldsw = (unsigned)wid * 1024u;
    const int aoff = lds_byte(wr * 64 + fr, fq * 8), boff = lds_byte(wc * 32 + fr, fq * 8);
#define PG8_SA(b, h) (((b) * 2 + (h)) * HTB)
#define PG8_SB(b, h) ((4 + (b) * 2 + (h)) * HTB)
#define PG8_STAGE(bufoff, gbase, voff) do { _Pragma("unroll") for (int _i = 0; _i < 2; ++_i) \
        __builtin_amdgcn_global_load_lds((const unsigned*)((const char*)(gbase) + (voff)[_i]), (LAS unsigned*)(lds + (bufoff) + ldsw + _i * 8192), 16, 0, 0); } while (0)
#define PG8_LDA(dst, b, h) do { _Pragma("unroll") for (int m = 0; m < 4; ++m) _Pragma("unroll") for (int k = 0; k < 2; ++k) dst[m][k] = *(const LAS bf16x8*)(lds + PG8_SA(b, h) + aoff + m * 2048 + k * 1024); } while (0)
#define PG8_LDB(dst, b, h) do { _Pragma("unroll") for (int n = 0; n < 2; ++n) _Pragma("unroll") for (int k = 0; k < 2; ++k) dst[n][k] = *(const LAS bf16x8*)(lds + PG8_SB(b, h) + boff + n * 2048 + k * 1024); } while (0)
#define PG8_MMA(ai, bj, At, Bt) do { __builtin_amdgcn_s_setprio(1); _Pragma("unroll") for (int m = 0; m < 4; ++m) _Pragma("unroll") for (int n = 0; n < 2; ++n) _Pragma("unroll") for (int k = 0; k < 2; ++k) \
        acc[ai][bj][m][n] = __builtin_amdgcn_mfma_f32_16x16x32_bf16(Bt[n][k], At[m][k], acc[ai][bj][m][n], 0, 0, 0); __builtin_amdgcn_s_setprio(0); } while (0)
#define PG8_WAIT_V(n) asm volatile("s_waitcnt vmcnt(" #n ")" ::: "memory")
#define PG8_WAIT_L(n) asm volatile("s_waitcnt lgkmcnt(" #n ")" ::: "memory")
#define PG8_BAR __builtin_amdgcn_s_barrier()
#define PG8_SCHED __builtin_amdgcn_sched_barrier(0)
    Unit cur, nxt; int ui = 0;
    if (!S.next(0, cur)) return;
    f32x4 acc[2][2][4][2];
#pragma unroll
    for (int a = 0; a < 2; ++a)
#pragma unroll
        for (int b = 0; b < 2; ++b)
#pragma unroll
            for (int m = 0; m < 4; ++m)
#pragma unroll
                for (int n = 0; n < 2; ++n) acc[a][b][m][n] = (f32x4){0.f, 0.f, 0.f, 0.f};
    bf16x8 At[4][2], B0[2][2], B1[2][2];
    const char* cA = (const char*)g.A + cur.offA; const char* cB = (const char*)g.Bt + cur.offB;
    PG8_STAGE(PG8_SB(0, 0), cB, voffB); PG8_STAGE(PG8_SB(0, 1), cB + hstepB, voffB); PG8_STAGE(PG8_SA(0, 0), cA, voffA); PG8_STAGE(PG8_SA(0, 1), cA + hstepA, voffA);
    if (wr == 1) PG8_BAR;
    PG8_WAIT_V(2); PG8_BAR;
    PG8_STAGE(PG8_SB(1, 0), cB + kstep, voffB); PG8_STAGE(PG8_SA(1, 0), cA + kstep, voffA); PG8_STAGE(PG8_SB(1, 1), cB + hstepB + kstep, voffB);
    PG8_WAIT_V(6); PG8_BAR;
    for (;;) {
        const bool has_next = S.next(ui + 1, nxt);
        const char* nA = has_next ? (const char*)g.A + nxt.offA : cA; const char* nB = has_next ? (const char*)g.Bt + nxt.offB : cB;
        for (int t = 0; t < nt; t += 2) {
            if constexpr (Epi::MID) { if (t == nt / 2) { int fr2 = fr; asm volatile("" : "+v"(fr2)); E.mid(acc, cur, wr, fr2); } }
            const bool last = (t == nt - 2);
            const char* a1 = cA + (size_t)(t + 1) * kstep;
            const char* a2 = last ? nA : cA + (size_t)(t + 2) * kstep; const char* b2 = last ? nB : cB + (size_t)(t + 2) * kstep;
            const char* a3 = a2 + kstep; const char* b3 = b2 + kstep;
            PG8_LDB(B0, 0, 0); PG8_LDB(B1, 0, 1); PG8_SCHED; PG8_LDA(At, 0, 0); PG8_STAGE(PG8_SA(1, 1), a1 + hstepA, voffA);
            PG8_WAIT_V(8); PG8_WAIT_L(0); PG8_BAR; PG8_MMA(0, 0, At, B0); PG8_MMA(0, 1, At, B1); PG8_BAR; PG8_SCHED;
            PG8_LDA(At, 0, 1); PG8_STAGE(PG8_SB(0, 0), b2, voffB); PG8_STAGE(PG8_SB(0, 1), b2 + hstepB, voffB); PG8_STAGE(PG8_SA(0, 0), a2, voffA);
            PG8_WAIT_V(8); PG8_WAIT_L(0); PG8_BAR; PG8_MMA(1, 0, At, B0); PG8_MMA(1, 1, At, B1); PG8_BAR; PG8_SCHED;
            PG8_LDB(B0, 1, 0); PG8_LDB(B1, 1, 1); PG8_SCHED; PG8_LDA(At, 1, 0); PG8_STAGE(PG8_SA(0, 1), a2 + hstepA, voffA);
            PG8_WAIT_V(8); PG8_WAIT_L(0); PG8_BAR; PG8_MMA(0, 0, At, B0); PG8_MMA(0, 1, At, B1); PG8_BAR; PG8_SCHED;
            PG8_LDA(At, 1, 1); PG8_STAGE(PG8_SB(1, 0), b3, voffB); PG8_STAGE(PG8_SB(1, 1), b3 + hstepB, voffB); PG8_STAGE(PG8_SA(1, 0), a3, voffA);
            PG8_WAIT_V(8); PG8_WAIT_L(0); PG8_BAR; PG8_MMA(1, 0, At, B0); PG8_MMA(1, 1, At, B1); PG8_BAR; PG8_SCHED;
        }
        if (wr == 0) PG8_BAR;
        { int fr2 = fr, fq2 = fq; asm volatile("" : "+v"(fr2), "+v"(fq2));
          E(acc, cur, wr, wc, fr2, fq2); }
        if (!has_next) break;
#pragma unroll
        for (int a = 0; a < 2; ++a)
#pragma unroll
            for (int b = 0; b < 2; ++b)
#pragma unroll
                for (int m = 0; m < 4; ++m)
#pragma unroll
                    for (int n = 0; n < 2; ++n) acc[a][b][m][n] = (f32x4){0.f, 0.f, 0.f, 0.f};
        cur = nxt; cA = nA; cB = nB; ++ui;
        if (wr == 1) PG8_BAR;
    }
    PG8_WAIT_V(0);
    PG8_BAR;
#undef PG8_SA
#undef PG8_SB
#undef PG8_STAGE
#undef PG8_LDA
#undef PG8_LDB
#undef PG8_MMA
#undef PG8_WAIT_V
#undef PG8_WAIT_L
#undef PG8_BAR
#undef PG8_SCHED
}
}
using pg8::Unit;

enum OrderKind { OK_PLAIN = 0, OK_S5E, OK_S5Y, OK_XS, OK_XO };
template <int kind> struct GOrder {
    int nM, nN, nwg, G, c, lda, ldb;
    __device__ __forceinline__ void init(int nM_, int nN_, int G_, int c_, int lda_, int ldb_) { nM = nM_; nN = nN_; nwg = nM_ * nN_; G = G_; c = c_; lda = lda_; ldb = ldb_; }
    __device__ __forceinline__ bool next(int i, Unit& u) const {
        const long L = (long)i * G + c; if (L >= nwg) return false;
        const int l = (int)L;
        if constexpr (kind == OK_PLAIN) {
            int wgid = l; { const int q = nwg / 8, r = nwg % 8, xcd = wgid % 8, off = wgid / 8; wgid = (xcd < r ? xcd * (q + 1) : r * (q + 1) + (xcd - r) * q) + off; }
            const int nig = 8 * nN, gid = wgid / nig, fm = gid * 8, gsz = (nM - fm) < 8 ? (nM - fm) : 8;
            u.pm = fm + ((wgid % nig) % gsz); u.pn = (wgid % nig) / gsz;
            u.offA = (long)u.pm * 256 * lda * 2; u.offB = (long)u.pn * 256 * ldb * 2;
        } else if constexpr (kind == OK_S5E) {
            const int kq = l & 1, pmm = (l >> 1) & 3, gg = l >> 3;
            u.pm = gg * 4 + pmm; u.pn = kq;
            u.offA = ((long)u.pm * 256 * UGP + kq * 256) * 2; u.offB = ((long)gg * 256 * 512 + kq * 256) * 2;
        } else if constexpr (kind == OK_S5Y) {
            const int pn = l & 1, pmm = (l >> 1) & 3, gg = l >> 3;
            u.pm = gg * 4 + pmm; u.pn = pn;
            u.offA = (long)u.pm * 256 * UGP * 2; u.offB = ((long)gg * 512 + pn * 256) * UGP * 2;
        } else if constexpr (kind == OK_XS) {
            const int h = l & 3, pm = l >> 2, b = pm >> 3;
            u.pm = pm; u.pn = h;
            u.offA = ((long)pm * 256 * DM + h * 256) * 2; u.offB = ((long)b * 256 * DM + h * 256) * 2;
        } else {
            const int h = l & 3, pm = l >> 2, b = pm >> 3;
            u.pm = pm; u.pn = h;
            u.offA = ((long)pm * 256 * DM + h * 256) * 2; u.offB = ((long)h * 256 * TM + b * 256) * 2;
        }
        return true;
    }
};

enum EpiKind { EK_PROJ = 0, EK_MEMK, EK_MEMVT, EK_S5E, EK_S5Y, EK_GLU, EK_WOUT, EK_XQ, EK_XS, EK_XO, EK_WXO, EK_UP, EK_DOWN, EK_GATE, EK_UPACT, EK_UPC };
    __device__ __forceinline__ u32x4 pack8(const f32x4 a, const f32x4 b) { u32x4 w; w.x = pk2(a[0], a[1]); w.y = pk2(a[2], a[3]); w.z = pk2(b[0], b[1]); w.w = pk2(b[2], b[3]); return w; }
    __device__ __forceinline__ float gelu_t(float y) { const float z = 0.7978845608028654f * (y + 0.044715f * y * y * y); const float e = __builtin_amdgcn_exp2f((2.f * LOG2E) * z); const float th = 1.f - 2.f * __builtin_amdgcn_rcpf(e + 1.f); return 0.5f * y * (1.f + th); }
    __device__ __forceinline__ float sigm(float z) { return __builtin_amdgcn_rcpf(1.f + __builtin_amdgcn_exp2f(-LOG2E * z)); }
    __device__ __forceinline__ float ssq8(const f32x4 a, const f32x4 b) { return (a[0] * a[0] + a[1] * a[1]) + (a[2] * a[2] + a[3] * a[3]) + (b[0] * b[0] + b[1] * b[1]) + (b[2] * b[2] + b[3] * b[3]); }

template <int kind> struct Epi {
    void* p0; void* p1; void* p2; void* p3; const void* c0; const void* c1; const void* c2; LAS float* hx;
    static constexpr bool MID = (kind == EK_WOUT);
    __device__ __forceinline__ static float rs8(const float* s, size_t row) { const f32x4 a0 = *(const f32x4*)(s + row * 8), a1 = *(const f32x4*)(s + row * 8 + 4); return rsqrtf((((a0[0] + a0[1]) + (a0[2] + a0[3])) + ((a1[0] + a1[1]) + (a1[2] + a1[3]))) * (1.f / 512.f) + EPS); }
    __device__ __forceinline__ void mid(f32x4 (&acc)[2][2][4][2], const Unit& u, int wr, int fr) const {
        const float* sf = (const float*)c1; const float* sy = (const float*)c2;
#pragma unroll
        for (int ai = 0; ai < 2; ++ai)
#pragma unroll
            for (int m = 0; m < 4; ++m) { const size_t row = (size_t)(u.pm * 256 + wr * 64 + fr + ai * 128 + m * 16);
                const float ratio = rs8(sf, row) * __builtin_amdgcn_rcpf(rs8(sy, row));
#pragma unroll
                for (int bj = 0; bj < 2; ++bj) { acc[ai][bj][m][0] = acc[ai][bj][m][0] * ratio; acc[ai][bj][m][1] = acc[ai][bj][m][1] * ratio; } }
    }
    __device__ __forceinline__ void operator()(const f32x4 (&acc)[2][2][4][2], const Unit& u, int wr, int wc, int fr, int fq) const {
        const int rbase = u.pm * 256 + wr * 64 + fr;
        const int cl0 = wc * 32 + 8 * fq;
        switch (kind) {
        case EK_PROJ: {
            const int pn = u.pn;
            if (pn < 4) {
                const bool isq = pn < 2; bf16_t* dst = (bf16_t*)(isq ? p0 : p1); const float* gptr = (const float*)(isq ? c0 : c1); const float post = isq ? C2Q : 1.f;
                const int head = 4 * (pn & 1) + wc;
#pragma unroll
                for (int ai = 0; ai < 2; ++ai)
#pragma unroll
                    for (int m = 0; m < 4; ++m) {
                        float ss = ssq8(acc[ai][0][m][0], acc[ai][0][m][1]) + ssq8(acc[ai][1][m][0], acc[ai][1][m][1]);
                        ss = red_fq(ss);
                        const float sc = rsqrtf(ss * (1.f / 64.f) + EPS) * post;
                        const size_t row = (size_t)(rbase + ai * 128 + m * 16);
#pragma unroll
                        for (int bj = 0; bj < 2; ++bj)
                            *(u32x4*)(dst + row * 512 + head * 64 + 32 * bj + 8 * fq) = pack8(acc[ai][bj][m][0] * sc * *(const f32x4*)(gptr + 32 * bj + 8 * fq), acc[ai][bj][m][1] * sc * *(const f32x4*)(gptr + 32 * bj + 8 * fq + 4));
                    }
            } else if (pn < 6) {
                bf16_t* dst = (bf16_t*)p2;
#pragma unroll
                for (int ai = 0; ai < 2; ++ai)
#pragma unroll
                    for (int m = 0; m < 4; ++m) { const size_t row = (size_t)(rbase + ai * 128 + m * 16);
#pragma unroll
                        for (int bj = 0; bj < 2; ++bj) *(u32x4*)(dst + row * 512 + (pn - 4) * 256 + bj * 128 + cl0) = pack8(acc[ai][bj][m][0], acc[ai][bj][m][1]); }
            } else {
                bf16_t* dst = (bf16_t*)p3;
#pragma unroll
                for (int ai = 0; ai < 2; ++ai)
#pragma unroll
                    for (int m = 0; m < 4; ++m) { const int row = rbase + ai * 128 + m * 16; const int b = row >> 11, t = row & 2047, ch = t >> 5, s = t & 31;
#pragma unroll
                        for (int bj = 0; bj < 2; ++bj) { const int f = (pn - 6) * 256 + bj * 128 + cl0; const int gI = f >> 4, cc = f & 15;
                            *(u32x4*)(dst + ((size_t)(gI * 1024 + b * 64 + ch)) * UGP + s * 16 + cc) = pack8(acc[ai][bj][m][0], acc[ai][bj][m][1]); } }
            }
        } break;
        case EK_MEMK: {
            bf16_t* dst = (bf16_t*)p0; float* sq = (float*)p1;
#pragma unroll
            for (int ai = 0; ai < 2; ++ai)
#pragma unroll
                for (int m = 0; m < 4; ++m) { const size_t row = (size_t)(rbase + ai * 128 + m * 16);
                    float ss = ssq8(acc[ai][0][m][0], acc[ai][0][m][1]) + ssq8(acc[ai][1][m][0], acc[ai][1][m][1]);
                    ss = red_fq(ss);
                    if (fq == 0) sq[row * 16 + u.pn * 4 + wc] = ss;
#pragma unroll
                    for (int bj = 0; bj < 2; ++bj) *(u32x4*)(dst + row * DM + u.pn * 256 + bj * 128 + cl0) = pack8(acc[ai][bj][m][0], acc[ai][bj][m][1]); }
        } break;
        case EK_MEMVT: {
            bf16_t* dst = (bf16_t*)p0;
#pragma unroll
            for (int ai = 0; ai < 2; ++ai)
#pragma unroll
                for (int m = 0; m < 4; ++m) { const size_t row = (size_t)(rbase + ai * 128 + m * 16);
#pragma unroll
                    for (int bj = 0; bj < 2; ++bj) *(u32x4*)(dst + row * TM + u.pn * 256 + bj * 128 + cl0) = pack8(acc[ai][bj][m][0], acc[ai][bj][m][1]); }
        } break;
        case EK_S5E: {
            float* dst = (float*)p0 + (size_t)u.pn * 32768 * 128;
#pragma unroll
            for (int ai = 0; ai < 2; ++ai)
#pragma unroll
                for (int m = 0; m < 4; ++m) { const size_t row = (size_t)(rbase + ai * 128 + m * 16);
                    *(f32x4*)(dst + row * 128 + cl0) = acc[ai][0][m][0]; *(f32x4*)(dst + row * 128 + cl0 + 4) = acc[ai][0][m][1]; }
        } break;
        case EK_S5Y: {
            bf16_t* dst = (bf16_t*)p0;
#pragma unroll
            for (int ai = 0; ai < 2; ++ai)
#pragma unroll
                for (int m = 0; m < 4; ++m) { const int r = rbase + ai * 128 + m * 16; const int gI = r >> 10, b = (r >> 6) & 15, k = r & 63;
#pragma unroll
                    for (int bj = 0; bj < 2; ++bj) { const int nn = u.pn * 256 + bj * 128 + cl0; const int tt = nn >> 4, cc = nn & 15;
                        f32x4 a = acc[ai][bj][m][0], c = acc[ai][bj][m][1];
#pragma unroll
                        for (int j = 0; j < 4; ++j) { a[j] = gelu_t(a[j]); c[j] = gelu_t(c[j]); }
                        *(u32x4*)(dst + ((size_t)(b * SEQ + k * TC + tt)) * 512 + gI * 16 + cc) = pack8(a, c); } }
        } break;
        case EK_GLU: {
            bf16_t* dst = (bf16_t*)p0; float* sq = (float*)p1; const bf16_t* y1 = (const bf16_t*)c0; const float* bg = (const float*)c1;
            f32x4 bv[2][2];
#pragma unroll
            for (int bj = 0; bj < 2; ++bj)
#pragma unroll
                for (int n = 0; n < 2; ++n) bv[bj][n] = *(const f32x4*)(bg + u.pn * 256 + bj * 128 + cl0 + 4 * n);
#pragma unroll
            for (int ai = 0; ai < 2; ++ai)
#pragma unroll
                for (int m = 0; m < 4; ++m) { const size_t row = (size_t)(rbase + ai * 128 + m * 16); float ss = 0.f;
#pragma unroll
                    for (int bj = 0; bj < 2; ++bj) { const size_t off = row * 512 + u.pn * 256 + bj * 128 + cl0;
                        const u32x4 yv = *(const u32x4*)(y1 + off);
                        f32x4 a = acc[ai][bj][m][0] + bv[bj][0], c = acc[ai][bj][m][1] + bv[bj][1];
                        a[0] = bflo(yv.x) * sigm(a[0]); a[1] = bfhi(yv.x) * sigm(a[1]); a[2] = bflo(yv.y) * sigm(a[2]); a[3] = bfhi(yv.y) * sigm(a[3]);
                        c[0] = bflo(yv.z) * sigm(c[0]); c[1] = bfhi(yv.z) * sigm(c[1]); c[2] = bflo(yv.w) * sigm(c[2]); c[3] = bfhi(yv.w) * sigm(c[3]);
                        ss += ssq8(a, c);
                        *(u32x4*)(dst + row * DM + 512 + u.pn * 256 + bj * 128 + cl0) = pack8(a, c); }
                    ss = red_fq(ss);
                    if (fq == 0) sq[row * 8 + u.pn * 4 + wc] = ss; }
        } break;
        case EK_WOUT: case EK_WXO: {
            bf16_t* hb = (bf16_t*)p1; float* sq = (float*)p2;
#pragma unroll
            for (int ai = 0; ai < 2; ++ai)
#pragma unroll
                for (int m = 0; m < 4; ++m) { const size_t row = (size_t)(rbase + ai * 128 + m * 16); float ss = 0.f;
#pragma unroll
                    for (int bj = 0; bj < 2; ++bj) { const size_t off = row * DM + u.pn * 256 + bj * 128 + cl0;
                        f32x4 a, c;
                        if (kind == EK_WOUT) { const float* base = (const float*)c0; const float rsy = rs8((const float*)c2, row); a = acc[ai][bj][m][0] * rsy + *(const f32x4*)(base + off); c = acc[ai][bj][m][1] * rsy + *(const f32x4*)(base + off + 4); }
                        else { const u32x4 bv = *(const u32x4*)((const bf16_t*)c0 + off);
                            a = acc[ai][bj][m][0] + (f32x4){bflo(bv.x), bfhi(bv.x), bflo(bv.y), bfhi(bv.y)}; c = acc[ai][bj][m][1] + (f32x4){bflo(bv.z), bfhi(bv.z), bflo(bv.w), bfhi(bv.w)}; }
                        ss += ssq8(a, c);
                        *(u32x4*)(hb + off) = pack8(a, c); }
                    ss = red_fq(ss);
                    if (fq == 0) sq[row * 16 + u.pn * 4 + wc] = ss; }
        } break;
        case EK_XQ: {
            bf16_t* dst = (bf16_t*)p0; float* sq = (float*)p1; const float* gq = (const float*)c0; const float* gk = (const float*)c1;
            f32x4 gg[2][2];
#pragma unroll
            for (int bj = 0; bj < 2; ++bj)
#pragma unroll
                for (int n = 0; n < 2; ++n) gg[bj][n] = *(const f32x4*)(gq + bj * 128 + cl0 + 4 * n) * *(const f32x4*)(gk + bj * 128 + cl0 + 4 * n);
#pragma unroll
            for (int ai = 0; ai < 2; ++ai)
#pragma unroll
                for (int m = 0; m < 4; ++m) { const size_t row = (size_t)(rbase + ai * 128 + m * 16);
                    float ss = ssq8(acc[ai][0][m][0], acc[ai][0][m][1]) + ssq8(acc[ai][1][m][0], acc[ai][1][m][1]);
                    ss = red_fq(ss);
                    if (fq == 0) sq[row * 16 + u.pn * 4 + wc] = ss;
#pragma unroll
                    for (int bj = 0; bj < 2; ++bj) *(u32x4*)(dst + row * DM + u.pn * 256 + bj * 128 + cl0) = pack8(acc[ai][bj][m][0] * gg[bj][0], acc[ai][bj][m][1] * gg[bj][1]); }
        } break;
        case EK_XS: {
            bf16_t* dst = (bf16_t*)p0; float* ps = (float*)p1; const float* s1 = (const float*)c0; const float* sqq = (const float*)c1; const float* sck = (const float*)c2;
            const int h = u.pn, b = u.pm >> 3;
            f32x4 kv[2][2];
#pragma unroll
            for (int bj = 0; bj < 2; ++bj)
#pragma unroll
                for (int n = 0; n < 2; ++n) kv[bj][n] = *(const f32x4*)(sck + (size_t)h * TM + b * 256 + bj * 128 + cl0 + 4 * n) * (LOG2E / 16.f);
#pragma unroll
            for (int ai = 0; ai < 2; ++ai)
#pragma unroll
                for (int m = 0; m < 4; ++m) { const size_t row = (size_t)(rbase + ai * 128 + m * 16);
                    const float rs1 = s1[row];
                    const f32x4 qq = *(const f32x4*)(sqq + row * 16 + h * 4);
                    const float sq = rs1 * rsqrtf(rs1 * rs1 * ((qq[0] + qq[1]) + (qq[2] + qq[3])) * (1.f / 256.f) + EPS);
                    float ss = 0.f;
#pragma unroll
                    for (int bj = 0; bj < 2; ++bj) { f32x4 a = acc[ai][bj][m][0] * kv[bj][0] * sq, c = acc[ai][bj][m][1] * kv[bj][1] * sq;
#pragma unroll
                        for (int j = 0; j < 4; ++j) { a[j] = __builtin_amdgcn_exp2f(a[j]); c[j] = __builtin_amdgcn_exp2f(c[j]); }
                        const u32x4 w = pack8(a, c);
                        ss += (bflo(w.x) + bfhi(w.x)) + (bflo(w.y) + bfhi(w.y)) + (bflo(w.z) + bfhi(w.z)) + (bflo(w.w) + bfhi(w.w));
                        *(u32x4*)(dst + row * DM + h * 256 + bj * 128 + cl0) = w; }
                    ss = red_fq(ss);
                    if (fq == 0) ps[row * 16 + h * 4 + wc] = ss; }
        } break;
        case EK_XO: {
            bf16_t* dst = (bf16_t*)p0; const float* ps = (const float*)c0; const int h = u.pn;
#pragma unroll
            for (int ai = 0; ai < 2; ++ai)
#pragma unroll
                for (int m = 0; m < 4; ++m) { const size_t row = (size_t)(rbase + ai * 128 + m * 16);
                    const f32x4 pp = *(const f32x4*)(ps + row * 16 + h * 4); const float inv = __builtin_amdgcn_rcpf((pp[0] + pp[1]) + (pp[2] + pp[3]));
#pragma unroll
                    for (int bj = 0; bj < 2; ++bj) *(u32x4*)(dst + row * DM + h * 256 + bj * 128 + cl0) = pack8(acc[ai][bj][m][0] * inv, acc[ai][bj][m][1] * inv); }
        } break;
        case EK_DOWN: {
            float* out = (float*)p0; const bf16_t* h2 = (const bf16_t*)c0;
#pragma unroll
            for (int ai = 0; ai < 2; ++ai)
#pragma unroll
                for (int m = 0; m < 4; ++m) { const size_t row = (size_t)(rbase + ai * 128 + m * 16);
#pragma unroll
                    for (int bj = 0; bj < 2; ++bj) { const size_t off = row * DM + u.pn * 256 + bj * 128 + cl0;
                        const u32x4 bv = *(const u32x4*)(h2 + off);
                        const f32x4 a = acc[ai][bj][m][0] + (f32x4){bflo(bv.x), bfhi(bv.x), bflo(bv.y), bfhi(bv.y)}, c = acc[ai][bj][m][1] + (f32x4){bflo(bv.z), bfhi(bv.z), bflo(bv.w), bfhi(bv.w)};
                        *(f32x4*)(out + off) = a; *(f32x4*)(out + off + 4) = c; } }
        } break;
        case EK_UPC: {
            bf16_t* A = (bf16_t*)p0; float* GHF = (float*)p1; float* GHL = (float*)p2; float* UH = (float*)p3; const float* s2 = (const float*)c0; const float* cw = (const float*)c1; const float* cbv = (const float*)c2;
            const int j0 = u.pn * 128 + cl0;
            float w0[8], w1[8], w2[8], bb[8];
#pragma unroll
            for (int i = 0; i < 2; ++i) { const f32x4 a0 = *(const f32x4*)(cw + j0 + 4 * i), a1 = *(const f32x4*)(cw + DFF + j0 + 4 * i), a2 = *(const f32x4*)(cw + 2 * DFF + j0 + 4 * i), a3 = *(const f32x4*)(cbv + j0 + 4 * i);
#pragma unroll
                for (int q = 0; q < 4; ++q) { w0[4 * i + q] = a0[q]; w1[4 * i + q] = a1[q]; w2[4 * i + q] = a2[q]; bb[4 * i + q] = a3[q]; } }
            float rsv[2][4];
#pragma unroll
            for (int ai = 0; ai < 2; ++ai)
#pragma unroll
                for (int m = 0; m < 4; ++m) rsv[ai][m] = s2[rbase + ai * 128 + m * 16];
            if (fr >= 14) {
#pragma unroll
                for (int ai = 0; ai < 2; ++ai) { const f32x4 g0 = acc[ai][0][3][0] * rsv[ai][3], g1 = acc[ai][0][3][1] * rsv[ai][3];
                    LAS float* hp = hx + ((ai * 2 + wr) * 2 + (fr - 14)) * 128 + cl0; *(LAS f32x4*)hp = g0; *(LAS f32x4*)(hp + 4) = g1;
                    if (ai == 1 && wr == 1) { float* gp = GHL + ((size_t)u.pm * 2 + (fr - 14)) * DFF + j0; *(f32x4*)gp = g0; *(f32x4*)(gp + 4) = g1; } } }
            if (wr == 0 && fr < 2) {
                const float rs = rsv[0][0]; float* gp = GHF + ((size_t)u.pm * 2 + fr) * DFF + j0; float* up = UH + ((size_t)u.pm * 2 + fr) * DFF + j0;
                *(f32x4*)gp = acc[0][0][0][0] * rs; *(f32x4*)(gp + 4) = acc[0][0][0][1] * rs; *(f32x4*)up = acc[0][1][0][0] * rs; *(f32x4*)(up + 4) = acc[0][1][0][1] * rs; }
            asm volatile("s_waitcnt lgkmcnt(0)" ::: "memory"); __builtin_amdgcn_s_barrier(); asm volatile("" ::: "memory");
#define ROR1(x) __builtin_bit_cast(float, __builtin_amdgcn_update_dpp(0, __builtin_bit_cast(int, (x)), 0x121, 0xF, 0xF, false))
#define ROR2(x) __builtin_bit_cast(float, __builtin_amdgcn_update_dpp(0, __builtin_bit_cast(int, (x)), 0x122, 0xF, 0xF, false))
#pragma unroll
            for (int ai = 0; ai < 2; ++ai) {
                const int grp = ai * 2 + wr;
                float p1v[8], p2v[8];
                { f32x4 h1a = (f32x4){0.f, 0.f, 0.f, 0.f}, h1b = h1a, h2a = h1a, h2b = h1a;
                  if (grp > 0) { const LAS float* hp = hx + ((grp - 1) * 2) * 128 + cl0; h2a = *(const LAS f32x4*)hp; h2b = *(const LAS f32x4*)(hp + 4); h1a = *(const LAS f32x4*)(hp + 128); h1b = *(const LAS f32x4*)(hp + 132); }
#pragma unroll
                  for (int i = 0; i < 4; ++i) { p1v[i] = h1a[i]; p1v[4 + i] = h1b[i]; p2v[i] = (fr == 0) ? h2a[i] : h1a[i]; p2v[4 + i] = (fr == 0) ? h2b[i] : h1b[i]; } }
#pragma unroll
                for (int m = 0; m < 4; ++m) { const float rs = rsv[ai][m]; const size_t row = (size_t)(rbase + ai * 128 + m * 16);
                    float gs[8], r[8];
#pragma unroll
                    for (int i = 0; i < 4; ++i) { gs[i] = acc[ai][0][m][0][i] * rs; gs[4 + i] = acc[ai][0][m][1][i] * rs; }
#pragma unroll
                    for (int i = 0; i < 8; ++i) { const float c1v = ROR1(gs[i]), c2v = ROR2(gs[i]);
                        const float g1 = (fr == 0) ? p1v[i] : c1v, g2 = (fr < 2) ? p2v[i] : c2v;
                        p1v[i] = c1v; p2v[i] = c2v;
                        const float z = bb[i] + w0[i] * g2 + w1[i] * g1 + w2[i] * gs[i];
                        const float uv = (i < 4 ? acc[ai][1][m][0][i & 3] : acc[ai][1][m][1][i & 3]) * rs;
                        r[i] = z * sigm(z) * uv; }
                    u32x4 o; o.x = pk2(r[0], r[1]); o.y = pk2(r[2], r[3]); o.z = pk2(r[4], r[5]); o.w = pk2(r[6], r[7]);
                    if (!(grp == 0 && m == 0 && fr < 2)) *(u32x4*)(A + row * DFF + j0) = o; } }
#undef ROR1
#undef ROR2
        } break;
        default: break;
        }
    }
};

namespace attn_body {
using bf16=__hip_bfloat16;
using s16x4=__attribute__((ext_vector_type(4)))short;
using f32x16=__attribute__((ext_vector_type(16)))float;
constexpr int NHEAD=NFH,D=64,ADM=NHEAD*D,OPITCH=1024;
constexpr int NW=8,QBLK=32,QB=QBLK*NW,KVBLK=64,NQB=SEQ/QB;
__device__ __forceinline__ int crow(int r,int hi){return (r&3)+8*(r>>2)+4*hi;}
#define SBAR() __builtin_amdgcn_sched_barrier(0)
__device__ __forceinline__ void cmask(f32x16&p0,f32x16&p1,int jb,int qrel,int hi){
  const float NEG=-INFINITY; int kb=64*jb+4*hi;
  #pragma unroll
  for(int r=0;r<16;++r){int kv=kb+(r&3)+8*(r>>2); if(kv>qrel)p0[r]=NEG; if(kv+32>qrel)p1[r]=NEG;}
}
constexpr int NSLOT=3, SLOTB=8192;
constexpr int LDS_K=0, LDS_V=NSLOT*SLOTB, LDS_WS=2*NSLOT*SLOTB, LDS_OST=LDS_WS+NW*64*4, LDS_BYTES=LDS_OST+NW*4096;
constexpr int LDS_BIAS=86016;
__device__ __forceinline__ void glds16(const void*gsrc,unsigned lds_dst){unsigned keep;
  asm volatile("s_mov_b32 %0, m0\n\ts_mov_b32 m0, %2\n\ts_nop 0\n\tglobal_load_lds_dwordx4 %1, off\n\ts_mov_b32 m0, %0":"=&s"(keep):"v"(gsrc),"s"(lds_dst):"memory");}
__device__ __forceinline__ float max3f(float a,float b,float c){float r;asm("v_max3_f32 %0, %1, %2, %3":"=v"(r):"v"(a),"v"(b),"v"(c));return r;}
__device__ __forceinline__ float max2f(float a,float b){float r;asm("v_max_f32_e32 %0, %1, %2":"=v"(r):"v"(a),"v"(b));return r;}
__device__ __forceinline__ float fadd_s(float a,float b){float r;asm("v_add_f32_e32 %0, %1, %2":"=v"(r):"v"(a),"v"(b));return r;}
__device__ __forceinline__ float fsub_s(float a,float b){float r;asm("v_sub_f32_e32 %0, %1, %2":"=v"(r):"v"(a),"v"(b));return r;}
typedef float f32x2_t __attribute__((ext_vector_type(2))); typedef __bf16 bf16x2_t __attribute__((ext_vector_type(2)));
__device__ __forceinline__ unsigned cvtpk_s(float lo,float hi){f32x2_t v={lo,hi};bf16x2_t b=__builtin_convertvector(v,bf16x2_t);return __builtin_bit_cast(unsigned,b);}
#define WAIT_BAR(N) asm volatile("s_waitcnt vmcnt(" #N ") lgkmcnt(0)\n\ts_barrier":::"memory")

__device__ __forceinline__ void qkt(f32x16&p0,f32x16&p1,const char*Kslot,const bf16x8*qr,const f32x16&negm,int r32,int hi){
  const char*kb=Kslot+hi*1024+r32*16;
  #pragma unroll
  for(int d0=0;d0<4;++d0){
    const bf16x8 b0=*reinterpret_cast<const bf16x8*>(kb+d0*2048);
    const bf16x8 b1=*reinterpret_cast<const bf16x8*>(kb+d0*2048+512);
    if(d0==0){p0=__builtin_amdgcn_mfma_f32_32x32x16_bf16(b0,qr[0],negm,0,0,0);p1=__builtin_amdgcn_mfma_f32_32x32x16_bf16(b1,qr[0],negm,0,0,0);}
    else{p0=__builtin_amdgcn_mfma_f32_32x32x16_bf16(b0,qr[d0],p0,0,0,0);p1=__builtin_amdgcn_mfma_f32_32x32x16_bf16(b1,qr[d0],p1,0,0,0);}}
}
typedef __attribute__((address_space(3))) const char* lds_cptr;
typedef short v4i16_t __attribute__((ext_vector_type(4)));
__device__ __forceinline__ void kload8(bf16x8*kf,lds_cptr kp){
  kf[0]=*(const __attribute__((address_space(3))) bf16x8*)(kp);      kf[1]=*(const __attribute__((address_space(3))) bf16x8*)(kp+512);
  kf[2]=*(const __attribute__((address_space(3))) bf16x8*)(kp+2048); kf[3]=*(const __attribute__((address_space(3))) bf16x8*)(kp+2560);
  kf[4]=*(const __attribute__((address_space(3))) bf16x8*)(kp+4096); kf[5]=*(const __attribute__((address_space(3))) bf16x8*)(kp+4608);
  kf[6]=*(const __attribute__((address_space(3))) bf16x8*)(kp+6144); kf[7]=*(const __attribute__((address_space(3))) bf16x8*)(kp+6656);
}
__device__ __forceinline__ void kload2(bf16x8*kf,lds_cptr kp,int j){ kf[2*j]=*(const __attribute__((address_space(3))) bf16x8*)(kp+j*2048); kf[2*j+1]=*(const __attribute__((address_space(3))) bf16x8*)(kp+j*2048+512); }
__device__ __forceinline__ s16x4 vtr(lds_cptr p){ return __builtin_bit_cast(s16x4,__builtin_amdgcn_ds_read_tr16_b64_v4i16((__attribute__((address_space(3))) v4i16_t*)p)); }
__device__ __forceinline__ float rowmax(const f32x16&p0,const f32x16&p1){
  float a=max3f(p0[0],p0[1],p1[0]),b=max3f(p0[2],p0[3],p1[1]);a=max3f(a,p1[2],p1[3]);
  #pragma unroll
  for(int r=4;r<16;r+=4){a=max3f(a,p0[r],p0[r+1]);b=max3f(b,p0[r+2],p0[r+3]);a=max3f(a,p1[r],p1[r+1]);b=max3f(b,p1[r+2],p1[r+3]);}
  const float m=max2f(a,b);
  auto rr=__builtin_amdgcn_permlane32_swap(__float_as_uint(m),__float_as_uint(m),false,false);
  return max2f(__uint_as_float(rr[0]),__uint_as_float(rr[1]));
}
__device__ __forceinline__ void pv(f32x16*o,int vb,bf16x8 pa0,bf16x8 pa1,bf16x8 pa2,bf16x8 pa3){
  #pragma unroll
  for(int d0=0;d0<2;++d0){s16x4 lo[4],hi[4];
    #pragma unroll
    for(int ks=0;ks<4;++ks){
      asm volatile("ds_read_b64_tr_b16 %0,%1 offset:%c2":"=&v"(lo[ks]):"v"(vb),"i"(d0*4096+ks*1024):"memory");
      asm volatile("ds_read_b64_tr_b16 %0,%1 offset:%c2":"=&v"(hi[ks]):"v"(vb),"i"(d0*4096+ks*1024+512):"memory");}
    asm volatile("s_waitcnt lgkmcnt(0)":::"memory");SBAR();
    #define PK(k) (bf16x8){lo[k][0],lo[k][1],lo[k][2],lo[k][3],hi[k][0],hi[k][1],hi[k][2],hi[k][3]}
    o[d0]=__builtin_amdgcn_mfma_f32_32x32x16_bf16(pa0,PK(0),o[d0],0,0,0);
    o[d0]=__builtin_amdgcn_mfma_f32_32x32x16_bf16(pa1,PK(1),o[d0],0,0,0);
    o[d0]=__builtin_amdgcn_mfma_f32_32x32x16_bf16(pa2,PK(2),o[d0],0,0,0);
    o[d0]=__builtin_amdgcn_mfma_f32_32x32x16_bf16(pa3,PK(3),o[d0],0,0,0);
    #undef PK
  }
}
typedef const __attribute__((address_space(3))) f32x4* lds_f4ptr;
#define BIASADD(P0,P1,t) do{ const lds_f4ptr bp_=(lds_f4ptr)(shm3+bias_off+((t)*64+4*hi)*4); \
    _Pragma("unroll") for(int j_=0;j_<4;++j_){ const f32x4 b0_=bp_[2*j_]-mhat, b1_=bp_[8+2*j_]-mhat; \
      P0[4*j_]+=b0_[0]; P0[4*j_+1]+=b0_[1]; P0[4*j_+2]+=b0_[2]; P0[4*j_+3]+=b0_[3]; \
      P1[4*j_]+=b1_[0]; P1[4*j_+1]+=b1_[1]; P1[4*j_+2]+=b1_[2]; P1[4*j_+3]+=b1_[3]; } }while(0)

#define CINIT(P0,P1,t) do{ const lds_f4ptr bp_=(lds_f4ptr)(shm3+bias_off+((t)*64+4*hi)*4); \
    _Pragma("unroll") for(int j_=0;j_<4;++j_){ const f32x4 b0_=bp_[2*j_]-mhat, b1_=bp_[8+2*j_]-mhat; \
      P0[4*j_]=b0_[0]; P0[4*j_+1]=b0_[1]; P0[4*j_+2]=b0_[2]; P0[4*j_+3]=b0_[3]; \
      P1[4*j_]=b1_[0]; P1[4*j_+1]=b1_[1]; P1[4*j_+2]=b1_[2]; P1[4*j_+3]=b1_[3]; } }while(0)
template<int THRL> __device__ __forceinline__ void attn_unit(int b,int h,int qb,const bf16*Q,const bf16*__restrict__ K,const bf16*__restrict__ V,bf16*O,const float*__restrict__ CB,float*__restrict__ SSQ,char*shm,const float skip_th){
  int tid=threadIdx.x; asm volatile("":"+v"(tid));
  const int lane=tid&63,r32=lane&31,hi=lane>>5; const int wid=__builtin_amdgcn_readfirstlane(tid>>6);
  const long rowbase=(long)b*SEQ; const int q0=qb*QB;
  const bf16*Qw=Q+(rowbase+q0+wid*QBLK)*ADM+h*D;
  int t0=0; { const float*cbh0=CB+(long)(b*NHEAD+h)*SEQ; const int npair=(q0+QB)/KVBLK/2-2; const float c0v=cbh0[q0];
    const bool far=(lane<npair)&&(cbh0[128*(lane<npair?lane:0)+127]-c0v>skip_th); const unsigned long long mk=__ballot(far);
    int lead=__builtin_ctzll(~mk); if(lead>npair)lead=npair; if(lead<0)lead=0; t0=2*__builtin_amdgcn_readfirstlane(lead); }
  const bf16*Kh=K+(rowbase+(long)t0*KVBLK)*ADM+h*D,*Vh=V+(rowbase+(long)t0*KVBLK)*ADM+h*D;
  const unsigned lds0=(unsigned)(uintptr_t)shm;
  float*wsf=(float*)(shm+LDS_WS)+wid*64;
  const lds_cptr shm3=(lds_cptr)shm;
  { const float*cbh=CB+(long)(b*NHEAD+h)*SEQ; const float cref=cbh[q0+128];
    if(tid*4<q0+QB){ const f32x4 c4=*(const f32x4*)(cbh+tid*4); *(__attribute__((address_space(3))) f32x4*)(shm3+LDS_BIAS+tid*16)=(f32x4){cref-c4[0],cref-c4[1],cref-c4[2],cref-c4[3]}; } }
  const bf16*ksrc=Kh+(long)lane*ADM+wid*8;
  const bf16*vsrc=Vh+(long)(16*(wid&3)+(lane>>2))*ADM+(wid>>2)*32+(lane&3)*8;
  const unsigned kdst=lds0+LDS_K+wid*1024, vdst=lds0+LDS_V+wid*1024;
  #define DMA_K(t,slot) glds16(ksrc+(long)(t)*KVBLK*ADM,(unsigned)__builtin_amdgcn_readfirstlane(kdst+(slot)))
  #define DMA_V(t,slot) glds16(vsrc+(long)(t)*KVBLK*ADM,(unsigned)__builtin_amdgcn_readfirstlane(vdst+(slot)))
  const int vb0=(int)(lds0+LDS_V)+((lane>>4)&1)*32+(lane&3)*8+(4*hi+((lane&15)>>2))*64;
  const char*Kbase=shm+LDS_K; bf16x8 kf[8];
  const lds_cptr kp0=shm3+LDS_K+hi*1024+r32*16; const lds_cptr vp0=shm3+LDS_V+((lane>>4)&1)*32+(lane&3)*8+(4*hi+((lane&15)>>2))*64;
  const int NT=(q0+QB)/KVBLK-t0; const int bias_off=LDS_BIAS+t0*KVBLK*4;
  DMA_K(0,0);DMA_V(0,0);DMA_K(1,SLOTB);
  bf16x8 qr[4];
  #pragma unroll
  for(int d0=0;d0<4;++d0)qr[d0]=*reinterpret_cast<const bf16x8*>(&Qw[(long)r32*ADM+d0*16+hi*8]);
  float mhat=0.f,l_reg=0.f;f32x16 o[2];o[0]=f32x16{};o[1]=f32x16{};const f32x16 negm=f32x16{};
  const int qrel=wid*QBLK+r32;
  #define CMASK(P0,P1,t) do{int jb_=(t)-(NT-4); if(jb_>=0)cmask(P0,P1,jb_,qrel,hi);}while(0)
  bool resc=false;
  #define START(P0,P1) do{ const float rm=rowmax(P0,P1); resc=false; \
    { const float dl=max2f(rm,-24.f); mhat=fadd_s(mhat,dl); \
      _Pragma("unroll") for(int r=0;r<16;++r){P0[r]=fsub_s(P0[r],dl);P1[r]=fsub_s(P1[r],dl);} } \
    _Pragma("unroll") for(int r=0;r<16;++r)P0[r]=__builtin_amdgcn_exp2f(P0[r]); }while(0)
  #define RESC() do{ if(resc){ asm volatile("s_waitcnt lgkmcnt(0)":::"memory"); \
      _Pragma("unroll") for(int d_=0;d_<2;++d_) _Pragma("unroll") for(int r=0;r<16;++r)o[d_][r]*=wsf[crow(r,hi)]; } }while(0)
  f32x16 pA0,pA1,pB0,pB1;
  int sl_prev=0,sl_cur=0,sl_next=SLOTB;
  #define ROT() do{sl_prev=sl_cur;sl_cur=sl_next;sl_next=(sl_next==(NSLOT-1)*SLOTB)?0:sl_next+SLOTB;}while(0)
  DMA_K(2,2*SLOTB);
  WAIT_BAR(3);
  qkt(pA0,pA1,Kbase,qr,negm,r32,hi);asm volatile("s_nop 15\n\ts_nop 7":"+v"(pA0),"+v"(pA1));BIASADD(pA0,pA1,0);CMASK(pA0,pA1,0);
  START(pA0,pA1);
  _Pragma("unroll") for(int r=0;r<16;++r)pA1[r]=__builtin_amdgcn_exp2f(pA1[r]);
  WAIT_BAR(0);
  DMA_K(3,0);DMA_V(1,SLOTB);
  ROT();
  kload8(kf,kp0+sl_cur);
  WAIT_BAR(2);
  s16x4 vlo[8],vhi[8]; u32x4 pw0,pw1,pw2,pw3;
  #define PKW(P,B) cvtpk_s(P[B],P[B+1])
  #define PAF(k) __builtin_bit_cast(bf16x8,pw##k)
  #define VFR(i) (bf16x8){vlo[i][0],vlo[i][1],vlo[i][2],vlo[i][3],vhi[i][0],vhi[i][1],vhi[i][2],vhi[i][3]}
  #define PIN(x) asm volatile("":"+v"(x))
  #define MX3(a,b,c) __builtin_fmaxf(__builtin_fmaxf((a),(b)),(c))
  #define GAPA(MF,A0,A1,A2,A3,W0,W1,PW) do{ MF; sacc+=A0; sacc+=A1; sacc+=A2; sacc+=A3; PIN(sacc); W0; W1; PIN(PW); SBAR(); }while(0)
  #define EX(v) __builtin_amdgcn_exp2f(v)
  #define GAPB(MF,X,B) do{ MF; X[B]=EX(X[B]); X[B+1]=EX(X[B+1]); X[B+2]=EX(X[B+2]); X[B+3]=EX(X[B+3]); PIN(X); SBAR(); }while(0)
  #define VRD(i) do{ vlo[i]=vtr(vp_+(((i)>>2)*4096+((i)&3)*1024)); vhi[i]=vtr(vp_+(((i)>>2)*4096+((i)&3)*1024+512)); }while(0)
  #define KRD(G,j) do{ if(G){ kload2(kf,kp0+sl_next,j); SBAR(); } }while(0)
  #define STEP(C0,C1,P0,P1,t,GK,GV,GL) do{ SBAR(); CINIT(C0,C1,t); SBAR(); \
    const lds_cptr vp_=vp0+sl_prev; \
    VRD(0); SBAR(); float sacc=(P0[0]+P0[1]); \
    GAPA(C0=__builtin_amdgcn_mfma_f32_32x32x16_bf16(kf[0],qr[0],C0,0,0,0), P0[2],P0[3],P0[4],P0[5],     pw0[0]=PKW(P0,0), pw0[1]=PKW(P0,2), pw0); \
    VRD(4); SBAR(); GAPA(C1=__builtin_amdgcn_mfma_f32_32x32x16_bf16(kf[1],qr[0],C1,0,0,0), P0[6],P0[7],P0[8],P0[9],     pw0[2]=PKW(P0,4), pw0[3]=PKW(P0,6), pw0); \
    VRD(1); SBAR(); GAPA(C0=__builtin_amdgcn_mfma_f32_32x32x16_bf16(kf[2],qr[1],C0,0,0,0),   P0[10],P0[11],P0[12],P0[13], pw1[0]=PKW(P0,8), pw1[1]=PKW(P0,10), pw1); \
    VRD(5); SBAR(); GAPA(C1=__builtin_amdgcn_mfma_f32_32x32x16_bf16(kf[3],qr[1],C1,0,0,0),   P0[14],P0[15],P1[0],P1[1],   pw1[2]=PKW(P0,12),pw1[3]=PKW(P0,14), pw1); \
    VRD(2); SBAR(); GAPA(C0=__builtin_amdgcn_mfma_f32_32x32x16_bf16(kf[4],qr[2],C0,0,0,0),   P1[2],P1[3],P1[4],P1[5],     pw2[0]=PKW(P1,0), pw2[1]=PKW(P1,2), pw2); \
    VRD(6); SBAR(); GAPA(C1=__builtin_amdgcn_mfma_f32_32x32x16_bf16(kf[5],qr[2],C1,0,0,0),   P1[6],P1[7],P1[8],P1[9],     pw2[2]=PKW(P1,4), pw2[3]=PKW(P1,6), pw2); \
    VRD(3); SBAR(); GAPA(C0=__builtin_amdgcn_mfma_f32_32x32x16_bf16(kf[6],qr[3],C0,0,0,0),   P1[10],P1[11],P1[12],P1[13], pw3[0]=PKW(P1,8), pw3[1]=PKW(P1,10), pw3); \
    VRD(7); SBAR(); GAPA(C1=__builtin_amdgcn_mfma_f32_32x32x16_bf16(kf[7],qr[3],C1,0,0,0),   P1[14],P1[15],0.f,0.f,       pw3[2]=PKW(P1,12),pw3[3]=PKW(P1,14), pw3); \
    l_reg+=sacc; \
    if(GK){DMA_K((t)+3,sl_cur);} if(GV){DMA_V((t)+1,sl_next);} \
    CMASK(C0,C1,t); \
    { float a=MX3(C0[0],C0[1],C1[0]),b=MX3(C0[2],C0[3],C1[1]); a=MX3(a,C1[2],C1[3]); \
      _Pragma("unroll") for(int r=4;r<16;r+=4){a=MX3(a,C0[r],C0[r+1]);b=MX3(b,C0[r+2],C0[r+3]);a=MX3(a,C1[r],C1[r+1]);b=MX3(b,C1[r+2],C1[r+3]);} \
      float rm=__builtin_fmaxf(a,b); { auto rr=__builtin_amdgcn_permlane32_swap(__float_as_uint(rm),__float_as_uint(rm),false,false); rm=__builtin_fmaxf(__uint_as_float(rr[0]),__uint_as_float(rr[1])); } \
      resc=false; \
      if(__builtin_expect(__any(rm>(float)THRL),0)){ const float dl=__builtin_fmaxf(rm,0.f); mhat+=dl; \
        _Pragma("unroll") for(int r=0;r<16;++r){C0[r]-=dl;C1[r]-=dl;} \
        const float f=__builtin_amdgcn_exp2f(-dl); l_reg*=f; if(hi==0)wsf[r32]=f; resc=true; } } \
    SBAR(); \
    GAPB(o[0]=__builtin_amdgcn_mfma_f32_32x32x16_bf16(PAF(0),VFR(0),o[0],0,0,0), C0,0); \
    GAPB(o[1]=__builtin_amdgcn_mfma_f32_32x32x16_bf16(PAF(0),VFR(4),o[1],0,0,0), C0,4); \
    KRD(GL,0); GAPB(o[0]=__builtin_amdgcn_mfma_f32_32x32x16_bf16(PAF(1),VFR(1),o[0],0,0,0), C0,8); \
    KRD(GL,1); GAPB(o[1]=__builtin_amdgcn_mfma_f32_32x32x16_bf16(PAF(1),VFR(5),o[1],0,0,0), C0,12); \
    KRD(GL,2); GAPB(o[0]=__builtin_amdgcn_mfma_f32_32x32x16_bf16(PAF(2),VFR(2),o[0],0,0,0), C1,0); \
    KRD(GL,3); GAPB(o[1]=__builtin_amdgcn_mfma_f32_32x32x16_bf16(PAF(2),VFR(6),o[1],0,0,0), C1,4); \
    GAPB(o[0]=__builtin_amdgcn_mfma_f32_32x32x16_bf16(PAF(3),VFR(3),o[0],0,0,0), C1,8); \
    GAPB(o[1]=__builtin_amdgcn_mfma_f32_32x32x16_bf16(PAF(3),VFR(7),o[1],0,0,0), C1,12); \
    }while(0)
  int t=1;
  #undef CMASK
  #define CMASK(P0,P1,t) do{}while(0)
  for(;t+5<NT;t+=2){
    STEP(pB0,pB1,pA0,pA1,t,true,true,true);     WAIT_BAR(2); RESC(); ROT();
    STEP(pA0,pA1,pB0,pB1,t+1,true,true,true);   WAIT_BAR(2); RESC(); ROT();
  }
  #undef CMASK
  #define CMASK(P0,P1,t) do{int jb_=(t)-(NT-4); if(jb_>=0)cmask(P0,P1,jb_,qrel,hi);}while(0)
  #define ENDW(tt) do{ if((tt)+3<NT){WAIT_BAR(2);} else if((tt)+2<NT){WAIT_BAR(1);} else {WAIT_BAR(0);} }while(0)
  for(;t+1<NT;t+=2){
    STEP(pB0,pB1,pA0,pA1,t,(t+3<NT),(t+1<NT),(t+1<NT));       ENDW(t);   RESC(); ROT();
    STEP(pA0,pA1,pB0,pB1,t+1,(t+4<NT),(t+2<NT),(t+2<NT));     ENDW(t+1); RESC(); ROT();
  }
  STEP(pB0,pB1,pA0,pA1,NT-1,false,false,false); RESC();
  { float sacc=pB0[0]+pB0[1]; _Pragma("unroll") for(int r=2;r<16;++r)sacc+=pB0[r]; _Pragma("unroll") for(int r=0;r<16;++r)sacc+=pB1[r]; l_reg+=sacc;
    pw0=(u32x4){PKW(pB0,0),PKW(pB0,2),PKW(pB0,4),PKW(pB0,6)};pw1=(u32x4){PKW(pB0,8),PKW(pB0,10),PKW(pB0,12),PKW(pB0,14)};pw2=(u32x4){PKW(pB1,0),PKW(pB1,2),PKW(pB1,4),PKW(pB1,6)};pw3=(u32x4){PKW(pB1,8),PKW(pB1,10),PKW(pB1,12),PKW(pB1,14)};
    SBAR(); pv(o,vb0+sl_cur,PAF(0),PAF(1),PAF(2),PAF(3)); }
  #undef PKW
  #undef PAF
  #undef VFR
  #undef PIN
  #undef MX3
  #undef GAPA
  #undef GAPB
  #undef EX
  #undef VRD
  #undef KRD
  #undef STEP
  #undef ENDW
  {auto rr=__builtin_amdgcn_permlane32_swap(__float_as_uint(l_reg),__float_as_uint(l_reg),false,false);l_reg=__uint_as_float(rr[0])+__uint_as_float(rr[1]);}
  if(hi==0)wsf[32+r32]=l_reg;asm volatile("s_waitcnt lgkmcnt(0)":::"memory");
  float rli[16];
  #pragma unroll
  for(int r=0;r<16;++r)rli[r]=__builtin_amdgcn_rcpf(wsf[32+crow(r,hi)]);
  int lane2=lane; asm volatile("":"+v"(lane2));
  bf16*Ow=O+(rowbase+q0+wid*QBLK)*OPITCH+h*D;
  { bf16*stg=(bf16*)(shm+LDS_OST)+wid*2048;
    #pragma unroll
    for(int r=0;r<16;++r){const int orow=crow(r,hi);
      #pragma unroll
      for(int d0=0;d0<2;++d0)stg[orow*64+d0*32+r32]=__float2bfloat16(o[d0][r]*rli[r]);}
    asm volatile("s_waitcnt lgkmcnt(0)":::"memory");
    #pragma unroll
    for(int i=0;i<4;++i){const int row=i*8+(lane2>>3),ch=lane2&7; const u32x4 v=*(const u32x4*)(stg+row*64+ch*8); *(u32x4*)(Ow+(long)row*OPITCH+ch*8)=v;
      float s=(bflo(v.x)*bflo(v.x)+bfhi(v.x)*bfhi(v.x))+(bflo(v.y)*bflo(v.y)+bfhi(v.y)*bfhi(v.y))+(bflo(v.z)*bflo(v.z)+bfhi(v.z)*bfhi(v.z))+(bflo(v.w)*bflo(v.w)+bfhi(v.w)*bfhi(v.w));
      s+=__shfl_xor(s,1); s+=__shfl_xor(s,2); s+=__shfl_xor(s,4);
      if(ch==0)SSQ[(rowbase+q0+wid*QBLK+row)*NHEAD+h]=s; } }
  asm volatile("s_waitcnt lgkmcnt(0)\n\ts_barrier":::"memory");
  #undef DMA_K
  #undef DMA_V
  #undef CMASK
  #undef START
  #undef RESC
  #undef ROT
}
#undef SBAR
#undef WAIT_BAR
}

constexpr int RING_BYTES = 131072;
constexpr int LDS_TOTAL = 147456;
struct Args { const float* in[32]; float* out; unsigned char* ws; };
typedef const float* const __attribute__((address_space(4)))* InTab;
enum In { I_X = 0, I_MEM, I_NORM_MIX, I_W_IN, I_FQN, I_FKN, I_FBIAS, I_ARE, I_AIM, I_LOGDT, I_BRE, I_BIM, I_CRE, I_CIM, I_D, I_WGLU, I_BGLU, I_ONF, I_ONS, I_WOUT,
          I_NCROSS, I_NMEM, I_WXQ, I_WXKV, I_XQN, I_XKN, I_WXO, I_NFFN, I_WUP, I_CONVW, I_CONVB, I_WDN };

struct TJob { const float* W; int ldw, col0, ncols, K; const float* kg; const float* kg2; bf16_t* WT; int mapid, rowoff, items; };
__device__ __forceinline__ int tmap(int mapid, int n, int rowoff) {
    if (mapid == 1) { const int part = n >> 9, f = n & 511, head = f >> 6, d = f & 63; return 512 * part + 256 * (head >> 2) + 128 * (d >> 5) + 32 * (head & 3) + (d & 31); }
    if (mapid == 2) { const int isup = n >= DFF ? 1 : 0; const int j = n - isup * DFF; return 256 * (j >> 7) + 128 * isup + (j & 127); }
    return rowoff + n;
}
__device__ __forceinline__ void transpose_item(const TJob& J, LAS float* scr, int item, int lane) {
    LAS unsigned* s32 = (LAS unsigned*)scr; const LAS unsigned short* s16 = (const LAS unsigned short*)scr;
    const int nblk = J.ncols / 128, kb = item / nblk, nb = item % nblk, k0 = 64 * kb, n0 = 128 * nb;
    const float* src = J.W + (size_t)k0 * J.ldw + J.col0 + n0 + 2 * lane;
    float gv = 1.f; if (J.kg) { const int k = k0 + lane; gv = (J.kg2 && k >= 512) ? J.kg2[k - 512] : J.kg[k]; }
#pragma unroll 16
    for (int kk = 0; kk < 64; ++kk) { f32x2 w = *(const f32x2*)(src + (size_t)kk * J.ldw);
        w = w * __builtin_bit_cast(float, __builtin_amdgcn_readlane(__builtin_bit_cast(int, gv), kk));
        s32[kk * 64 + lane] = pk2(w[0], w[1]); }
    asm volatile("s_waitcnt lgkmcnt(0)" ::: "memory");
    const int c = lane & 7;
#pragma unroll 4
    for (int j = 0; j < 16; ++j) { const int n = (lane >> 3) + 8 * j; const LAS unsigned short* s = s16 + (8 * c) * 128 + n;
        u32x4 o; o.x = (unsigned)s[0] | ((unsigned)s[128] << 16); o.y = (unsigned)s[256] | ((unsigned)s[384] << 16); o.z = (unsigned)s[512] | ((unsigned)s[640] << 16); o.w = (unsigned)s[768] | ((unsigned)s[896] << 16);
        *(u32x4*)(J.WT + (size_t)tmap(J.mapid, n0 + n, J.rowoff) * J.K + k0 + 8 * c) = o; }
    asm volatile("s_waitcnt lgkmcnt(0)" ::: "memory");
}
constexpr int NTJ = 11;
__device__ __forceinline__ void get_tjob(InTab in, unsigned char* ws, int j, TJob& J) {
    J.kg = nullptr; J.kg2 = nullptr; J.mapid = 0; J.rowoff = 0; J.col0 = 0;
    switch (j) {
    case 0: J.W = in[I_W_IN]; J.ldw = INCOLS; J.col0 = 0; J.ncols = 1024; J.K = 1024; J.WT = (bf16_t*)(ws + WS_WIN); J.mapid = 1; break;
    case 1: J.W = in[I_W_IN]; J.ldw = INCOLS; J.col0 = 1024; J.ncols = 512; J.K = 1024; J.WT = (bf16_t*)(ws + WS_WIN); J.rowoff = 1024; break;
    case 2: J.W = in[I_W_IN]; J.ldw = INCOLS; J.col0 = 1544; J.ncols = 512; J.K = 1024; J.WT = (bf16_t*)(ws + WS_WIN); J.rowoff = 1536; break;
    case 3: J.W = in[I_WGLU]; J.ldw = 512; J.ncols = 512; J.K = 512; J.WT = (bf16_t*)(ws + WS_WGLU); break;
    case 4: J.W = in[I_WOUT]; J.ldw = 1024; J.ncols = 1024; J.K = 1024; J.WT = (bf16_t*)(ws + WS_WOUT); J.kg = in[I_ONF]; J.kg2 = in[I_ONS]; break;
    case 5: J.W = in[I_WXQ]; J.ldw = 1024; J.ncols = 1024; J.K = 1024; J.WT = (bf16_t*)(ws + WS_WXQ); J.kg = in[I_NCROSS]; break;
    case 6: J.W = in[I_WXKV]; J.ldw = 2048; J.col0 = 0; J.ncols = 1024; J.K = 1024; J.WT = (bf16_t*)(ws + WS_WXK); break;
    case 7: J.W = in[I_WXKV]; J.ldw = 2048; J.col0 = 1024; J.ncols = 1024; J.K = 1024; J.WT = (bf16_t*)(ws + WS_WXV); break;
    case 8: J.W = in[I_WXO]; J.ldw = 1024; J.ncols = 1024; J.K = 1024; J.WT = (bf16_t*)(ws + WS_WXO); break;
    case 9: J.W = in[I_WUP]; J.ldw = 2 * DFF; J.ncols = 2 * DFF; J.K = 1024; J.WT = (bf16_t*)(ws + WS_WUP); J.kg = in[I_NFFN]; J.mapid = 2; break;
    default: J.W = in[I_WDN]; J.ldw = 1024; J.ncols = 1024; J.K = DFF; J.WT = (bf16_t*)(ws + WS_WDN); break;
    }
    J.items = (J.K / 64) * (J.ncols / 128);
}

__device__ __forceinline__ void rms_row(const float* xrow, const float* gain, bf16_t* orow, int lane, f32x4 (&v)[4]) {
    const f32x4* xr = (const f32x4*)xrow + lane; float s = 0.f;
#pragma unroll
    for (int j = 0; j < 4; ++j) { v[j] = xr[64 * j]; s += (v[j][0] * v[j][0] + v[j][1] * v[j][1]) + (v[j][2] * v[j][2] + v[j][3] * v[j][3]); }
    const float rs = rsqrtf(wave_sum(s) * (1.f / DM) + EPS);
    u32x2* o8 = (u32x2*)orow + lane;
#pragma unroll
    for (int j = 0; j < 4; ++j) { v[j] = v[j] * rs * ((const f32x4*)gain)[64 * j + lane]; u32x2 w; w.x = pk2(v[j][0], v[j][1]); w.y = pk2(v[j][2], v[j][3]); o8[64 * j] = w; }
}

__device__ __forceinline__ void cpow(float ar, float ai, float dt, float e, float& r, float& i) {
    const float mag = __expf(ar * dt * e);
    float rev = ai * dt * e * 0.15915494309189535f; rev -= rintf(rev);
    const float ang = rev * 6.283185307179586f;
    r = mag * cosf(ang); i = mag * sinf(ang);
}

template <int NT>
__device__ __forceinline__ void s5_prep_task(InTab in, unsigned char* ws, int g, int tt, LAS float* L, int tid, bool valid) {
    LAS float* pwA = L; LAS float* pwB = L + 128; LAS float* pwC = L + 256; LAS float* cf = L + 384; LAS float* bb = L + 512; LAS float* cc = L + 512 + 2048;
    if (valid) {
        const float dt = __expf(in[I_LOGDT][g]);
        if (tid < 64) { const int p = tid; const float ar = in[I_ARE][g * 64 + p], ai = in[I_AIM][g * 64 + p];
            float r, i; cpow(ar, ai, dt, (float)tt, r, i); pwA[2 * p] = r; pwA[2 * p + 1] = i;
            cpow(ar, ai, dt, (float)(tt + 1), r, i); pwB[2 * p] = r; pwB[2 * p + 1] = i;
            cpow(ar, ai, dt, (float)(TC - 1 - tt), r, i); pwC[2 * p] = r; pwC[2 * p + 1] = i;
            float lr, li; cpow(ar, ai, dt, 1.f, lr, li);
            const float den = ar * ar + ai * ai, nr = lr - 1.f;
            cf[2 * p] = (nr * ar + li * ai) / den; cf[2 * p + 1] = (li * ar - nr * ai) / den;
            if (tt == 0) { cpow(ar, ai, dt, (float)TC, r, i); float* lb = (float*)(ws + WS_LB32); lb[(g * 64 + p) * 2] = r; lb[(g * 64 + p) * 2 + 1] = i; } }
        for (int idx = tid; idx < 1024; idx += NT) { cc[2 * idx] = in[I_CRE][g * 1024 + idx]; cc[2 * idx + 1] = in[I_CIM][g * 1024 + idx]; }
    }
    __syncthreads();
    if (valid)
        for (int idx = tid; idx < 1024; idx += NT) { const int p = idx >> 4; const float br = in[I_BRE][g * 1024 + idx], bi = in[I_BIM][g * 1024 + idx], cr = cf[2 * p], ci = cf[2 * p + 1];
            bb[2 * idx] = cr * br - ci * bi; bb[2 * idx + 1] = cr * bi + ci * br; }
    __syncthreads();
    if (valid) {
        for (int e = tid; e < 256; e += NT) {
            const int c = e >> 4, cp = e & 15; float s = 0.f;
            for (int p = 0; p < 64; ++p) { const float pr = pwA[2 * p], pi = pwA[2 * p + 1], br = bb[2 * (p * 16 + cp)], bi = bb[2 * (p * 16 + cp) + 1];
                const float mr = pr * br - pi * bi, mi = pr * bi + pi * br; s += cc[2 * (c * 64 + p)] * mr - cc[2 * (c * 64 + p) + 1] * mi; }
            if (tt == 0 && c == cp) s += in[I_D][g * 16 + c];
            ((float*)(ws + WS_KTAB))[((g * TC + tt) * 16 + c) * 16 + cp] = s; }
        bf16_t* bty = (bf16_t*)(ws + WS_BTY) + (size_t)g * 512 * UGP; bf16_t* bte = (bf16_t*)(ws + WS_BTE) + (size_t)g * 256 * 512;
        for (int idx = tid; idx < 1024; idx += NT) { const int c = idx >> 6, p = idx & 63;
            const float cr = cc[2 * idx], ci = cc[2 * idx + 1], pr = pwB[2 * p], pi = pwB[2 * p + 1];
            const float zr = cr * pr - ci * pi, zi = cr * pi + ci * pr;
            *(unsigned*)(bty + (size_t)(tt * 16 + c) * UGP + 512 + 2 * p) = pk2(zr, -zi); }
        for (int idx = tid; idx < 1024; idx += NT) { const int p = idx >> 4, cp = idx & 15;
            const float pr = pwC[2 * p], pi = pwC[2 * p + 1], br = bb[2 * idx], bi = bb[2 * idx + 1];
            bte[(size_t)(2 * p) * 512 + tt * 16 + cp] = (bf16_t)f2bf(pr * br - pi * bi); bte[(size_t)(2 * p + 1) * 512 + tt * 16 + cp] = (bf16_t)f2bf(pr * bi + pi * br); }
        for (int u = tid; u < 256; u += NT) *(u32x4*)(bte + (size_t)(128 + (u >> 1)) * 512 + tt * 16 + (u & 1) * 8) = (u32x4){0u, 0u, 0u, 0u};
    }
    __syncthreads();
}

#define RLX_AGENT __ATOMIC_RELAXED, __HIP_MEMORY_SCOPE_AGENT
#define XB_TMO      128
#define XB_XCNT(j)  (256  + 64 * (j))
#define XB_XSUB(j)  (1280 + 64 * (j))
#define XB_XGEN(j)  (2304 + 64 * (j))
#define XB_TOP      3328
#define XB_TOPGEN   3392
#define XCD_BAR_WORDS 3456
#define XB_SPIN_CAP (1u << 18)

__device__ __forceinline__ unsigned xb_ld(unsigned* p)              { return __hip_atomic_load(p, __ATOMIC_RELAXED, __HIP_MEMORY_SCOPE_AGENT); }
__device__ __forceinline__ unsigned xb_add(unsigned* p, unsigned v) { return __hip_atomic_fetch_add(p, v, __ATOMIC_RELAXED, __HIP_MEMORY_SCOPE_AGENT); }
__device__ __forceinline__ unsigned xb_xcc_id() { return (unsigned)__builtin_amdgcn_s_getreg((3 << 11) | 20) & 0xFu; }
#define XB_SPIN(cond, bar) do { unsigned _sp = 0; while (cond) { __builtin_amdgcn_s_sleep(1); \
    if ((++_sp & 255u) == 0u) { if (xb_ld(&(bar)[XB_TMO])) break; if (_sp > XB_SPIN_CAP) { atomicAdd(&(bar)[XB_TMO], 1u); break; } } } } while (0)

struct XcdBarrier {
    unsigned* bar; unsigned x;
    volatile LAS unsigned* st;
};

__device__ __forceinline__ XcdBarrier xcd_barrier_post(unsigned* bar, volatile LAS unsigned* st) {
    XcdBarrier b; b.bar = bar; b.x = xb_xcc_id(); b.st = st;
    if (threadIdx.x == 0) (void)xb_add(&bar[XB_XCNT(b.x)], 1u);
    return b;
}
__device__ __forceinline__ void xcd_barrier_complete(unsigned* bar, unsigned x, unsigned& nloc, unsigned& nx) {
    const unsigned G = gridDim.x * gridDim.y * gridDim.z;
    unsigned sum, cnt, mine, sp = 0u;
    for (;;) {
        sum = 0u; cnt = 0u; mine = 0u;
#pragma unroll
        for (unsigned j = 0; j < 16; ++j) { const unsigned c = xb_ld(&bar[XB_XCNT(j)]); sum += c; cnt += (c > 0u) ? 1u : 0u; mine = (j == x) ? c : mine; }
        if (sum == G) break;
        __builtin_amdgcn_s_sleep(1);
        if ((++sp & 255u) == 0u) { if (xb_ld(&bar[XB_TMO])) break; if (sp > XB_SPIN_CAP) { atomicAdd(&bar[XB_TMO], 1u); break; } }
    }
    nloc = mine > 0u ? mine : 1u; nx = cnt > 0u ? cnt : 1u;
}

__device__ __forceinline__ void xcd_barrier(const XcdBarrier& b) {
    asm volatile("s_waitcnt vmcnt(0)" ::: "memory");
    __syncthreads();
    if (threadIdx.x == 0) {
        unsigned* bar = b.bar;
        __builtin_amdgcn_s_waitcnt(0);
        unsigned nloc = b.st[0], nx = b.st[1];
        if (nloc == 0u) { xcd_barrier_complete(bar, b.x, nloc, nx); b.st[0] = nloc; b.st[1] = nx; }
        const unsigned old = xb_add(&bar[XB_XSUB(b.x)], 1u);
        const unsigned gen = old / nloc;
        if (old + 1u == (gen + 1u) * nloc) {
            __builtin_amdgcn_fence(__ATOMIC_RELEASE, "agent");
            asm volatile("s_waitcnt vmcnt(0)" ::: "memory");
            const unsigned og = xb_add(&bar[XB_TOP], 1u);
            const unsigned tg = og / nx;
            if (og + 1u == (tg + 1u) * nx) xb_add(&bar[XB_TOPGEN], 1u);
            else XB_SPIN(xb_ld(&bar[XB_TOPGEN]) == tg, bar);
            __builtin_amdgcn_fence(__ATOMIC_ACQUIRE, "agent");
            xb_add(&bar[XB_XGEN(b.x)], 1u);
            asm volatile("s_waitcnt vmcnt(0)" ::: "memory");
        } else {
            XB_SPIN(xb_ld(&bar[XB_XGEN(b.x)]) == gen, bar);
            __builtin_amdgcn_fence(__ATOMIC_ACQUIRE, "agent");
            asm volatile("s_waitcnt vmcnt(0)" ::: "memory");
        }
    }
    __syncthreads();
}


#ifndef FIRST_STEP
#define FIRST_STEP 0
#endif
#ifndef LAST_STEP
#define LAST_STEP 18
#endif
#define ON(n) (FIRST_STEP <= (n) && (n) <= LAST_STEP)
#define SYNC(n) do { if ((n) < LAST_STEP) { XcdBarrier bar_; bar_.bar = (unsigned*)ws; bar_.x = xb_xcc_id(); bar_.st = (volatile LAS unsigned*)(L + RING_BYTES + 352); xcd_barrier(bar_); } } while (0)
#define WSB(off) ((const bf16_t*)(ws + (off)))
__global__ void __launch_bounds__(512, 2) fox_s5_mega(Args a) {
    extern __shared__ __attribute__((aligned(16))) unsigned char lds[];
    LAS unsigned char* L = (LAS unsigned char*)lds;
    const int G = gridDim.x, bx = blockIdx.x, NGW = G * 8, NGT = G * 512;
#define KA const __attribute__((address_space(4))) unsigned char* ka_ = (const __attribute__((address_space(4))) unsigned char*)__builtin_amdgcn_kernarg_segment_ptr(); asm volatile("" : "+s"(ka_)); \
    InTab in = (InTab)ka_; float* out = *(float* const __attribute__((address_space(4)))*)(ka_ + 256); unsigned char* ws = *(unsigned char* const __attribute__((address_space(4)))*)(ka_ + 264); (void)in; (void)out;
#define IDS int tid = threadIdx.x; asm volatile("" : "+v"(tid)); const int lane = tid & 63, wave = __builtin_amdgcn_readfirstlane(tid >> 6); const int gw = bx * 8 + wave, gt = bx * 512 + tid; (void)lane; (void)gw; (void)gt;
    {
        KA
        if (threadIdx.x < 8) ((volatile LAS unsigned*)(L + RING_BYTES + 320))[threadIdx.x + 8 - 8] = 0u;
        if (threadIdx.x < 2) ((volatile LAS unsigned*)(L + RING_BYTES + 352))[threadIdx.x] = 0u;
        __syncthreads();
        (void)xcd_barrier_post((unsigned*)ws, (volatile LAS unsigned*)(L + RING_BYTES + 352));
    }

    if (ON(0)) {
        KA
        IDS
        LAS float* scr = (LAS float*)(L + wave * 16384);
        { int base = 0;
          for (int j = 0; j < NTJ; ++j) { TJob J; get_tjob(in, ws, j, J);
              int first = gw - (base % NGW); if (first < 0) first += NGW;
              for (int it = first; it < J.items; it += NGW) transpose_item(J, scr, it, lane);
              base += J.items; } }
        __syncthreads();
        LAS float* wf = (LAS float*)L;
        for (int idx = tid; idx < 8192; idx += 512) wf[idx] = in[I_W_IN][(size_t)(idx >> 3) * INCOLS + 1536 + (idx & 7)];
        __syncthreads();
        {
            f32x4 nx[4];
            if (gw < T) { const f32x4* xr = (const f32x4*)(in[I_X] + (size_t)gw * DM) + lane;
#pragma unroll
                for (int j = 0; j < 4; ++j) nx[j] = xr[64 * j]; }
            const f32x4* gp = (const f32x4*)in[I_NORM_MIX]; f32x4 gn[4];
#pragma unroll
            for (int j = 0; j < 4; ++j) gn[j] = gp[64 * j + lane];
            const float fbias = in[I_FBIAS][lane & 7];
            for (int m = gw; m < T; m += NGW) {
                f32x4 v[4]; float s = 0.f;
#pragma unroll
                for (int j = 0; j < 4; ++j) { v[j] = nx[j]; s += (v[j][0] * v[j][0] + v[j][1] * v[j][1]) + (v[j][2] * v[j][2] + v[j][3] * v[j][3]); }
                if (m + NGW < T) { const f32x4* xr = (const f32x4*)(in[I_X] + (size_t)(m + NGW) * DM) + lane;
#pragma unroll
                    for (int j = 0; j < 4; ++j) nx[j] = xr[64 * j]; }
                const float rs = rsqrtf(wave_sum(s) * (1.f / DM) + EPS);
                u32x2* o8 = (u32x2*)((bf16_t*)(ws + WS_HN) + (size_t)m * DM) + lane;
#pragma unroll
                for (int j = 0; j < 4; ++j) { v[j] = v[j] * rs * gn[j]; u32x2 w; w.x = pk2(v[j][0], v[j][1]); w.y = pk2(v[j][2], v[j][3]); o8[64 * j] = w; }
                float d[8];
#pragma unroll
                for (int h = 0; h < 8; ++h) d[h] = 0.f;
#pragma unroll
                for (int j = 0; j < 4; ++j)
#pragma unroll
                    for (int i = 0; i < 4; ++i) { const int k = 256 * j + 4 * lane + i; const f32x4 w0 = *(const LAS f32x4*)(wf + k * 8), w1 = *(const LAS f32x4*)(wf + k * 8 + 4);
                        d[0] += v[j][i] * w0[0]; d[1] += v[j][i] * w0[1]; d[2] += v[j][i] * w0[2]; d[3] += v[j][i] * w0[3];
                        d[4] += v[j][i] * w1[0]; d[5] += v[j][i] * w1[1]; d[6] += v[j][i] * w1[2]; d[7] += v[j][i] * w1[3]; }
                float e4[4];
#pragma unroll
                for (int h = 0; h < 4; ++h) { const float keep = (lane & 4) ? d[h + 4] : d[h], give = (lane & 4) ? d[h] : d[h + 4]; e4[h] = keep + __shfl_xor(give, 4); }
                float e2[2];
#pragma unroll
                for (int h = 0; h < 2; ++h) { const float keep = (lane & 2) ? e4[h + 2] : e4[h], give = (lane & 2) ? e4[h] : e4[h + 2]; e2[h] = keep + __shfl_xor(give, 2); }
                float z; { const float keep = (lane & 1) ? e2[1] : e2[0], give = (lane & 1) ? e2[0] : e2[1]; z = keep + __shfl_xor(give, 1); }
                z += __shfl_xor(z, 8); z += __shfl_xor(z, 16); z += __shfl_xor(z, 32);
                if (lane < 8) {
                    z += fbias;
                    const float ls = fminf(z, 0.f) - __logf(1.f + __expf(-fabsf(z)));
                    const int b = m >> 11, t = m & 2047;
                    ((float*)(ws + WS_LOGF))[(size_t)(b * 8 + lane) * SEQ + t] = ls; }
            }
        }
        for (int m = gw; m < TM; m += NGW) { f32x4 v[4]; rms_row(in[I_MEM] + (size_t)m * DM, in[I_NMEM], (bf16_t*)(ws + WS_MN) + (size_t)m * DM, lane, v); }
        __syncthreads();
        SYNC(0);
    }
    if (ON(2)) {
        KA
        pg8::Gemm g{WSB(WS_HN), WSB(WS_WIN), DM, DM, DM}; GOrder<OK_PLAIN> S; S.init(T / 256, 8, G, bx, DM, DM);
        Epi<EK_PROJ> E{ws + WS_Q, ws + WS_K, ws + WS_V, ws + WS_UG, in[I_FQN], in[I_FKN], nullptr};
        pg8::gemm_phase(L, g, S, E);
    }
    if (ON(1)) {
        KA
        IDS
        int seq = (bx < BATCH * NFH) ? bx : -1;
        if (G == 256) seq = (bx >= 64 && bx < 128) ? bx - 64 : ((bx >= 192) ? bx - 128 : -1);
        if (wave == 0 && seq >= 0) {
            const float* lf = (const float*)(ws + WS_LOGF) + (size_t)seq * SEQ + lane * 32; float* cb = (float*)(ws + WS_CB) + (size_t)seq * SEQ + lane * 32;
            f32x4 x[8]; float run = 0.f;
#pragma unroll
            for (int j = 0; j < 8; ++j) { x[j] = ((const f32x4*)lf)[j]; x[j][0] += run; x[j][1] += x[j][0]; x[j][2] += x[j][1]; x[j][3] += x[j][2]; run = x[j][3]; }
            float incl = run;
#pragma unroll
            for (int o = 1; o < 64; o <<= 1) { const float y = __shfl_up(incl, o); if (lane >= o) incl += y; }
            const float excl = incl - run;
#pragma unroll
            for (int j = 0; j < 8; ++j) ((f32x4*)cb)[j] = (x[j] + excl) * LOG2E;
        }
        {
            const int cnt = (G == 256) ? 128 : G, idx = (G == 256) ? seq : bx;
            if (idx >= 0) {
                const int NTASK = S5G * TC, sub = tid >> 7, ltid = tid & 127, per = NTASK / cnt;
                for (int i0 = 0; idx + i0 * cnt < NTASK; i0 += 4) { const int task = idx + (i0 + sub) * cnt; const bool valid = task < NTASK;
                    const int t2 = !valid ? 0 : ((NTASK % cnt == 0) ? (task % cnt) * per + task / cnt : task);
                    s5_prep_task<128>(in, ws, t2 / TC, t2 % TC, (LAS float*)L + sub * 5120, ltid, valid); }
            }
        }
    }
    if (ON(3)) {
        KA
        pg8::Gemm g{WSB(WS_MN), WSB(WS_WXK), DM, DM, DM}; GOrder<OK_PLAIN> S; S.init(TM / 256, 4, G, bx, DM, DM);
        Epi<EK_MEMK> E{ws + WS_KST, ws + WS_SSQK, nullptr, nullptr, nullptr, nullptr, nullptr};
        pg8::gemm_phase(L, g, S, E);
    }
    if (ON(4)) {
        KA
        pg8::Gemm g{WSB(WS_WXV), WSB(WS_MN), DM, DM, DM}; GOrder<OK_PLAIN> S; S.init(4, TM / 256, G, (bx + 128) % G, DM, DM);
        Epi<EK_MEMVT> E{ws + WS_VT, nullptr, nullptr, nullptr, nullptr, nullptr, nullptr};
        pg8::gemm_phase(L, g, S, E);
        SYNC(4);
    }
    if (ON(5)) {
        KA
        const int vcu = (G % 8 == 0) ? (bx % 8) * (G / 8) + bx / 8 : bx;
        float skip_th; { const int ln = threadIdx.x & 63; float gq = fabsf(in[I_FQN][ln]), gk = fabsf(in[I_FKN][ln]);
#pragma unroll
            for (int o = 1; o < 64; o <<= 1) { gq = fmaxf(gq, __shfl_xor(gq, o)); gk = fmaxf(gk, __shfl_xor(gk, o)); }
            skip_th = 2.f * (64.f * C2Q * gq * gk) + 40.f; }
        for (int L2 = vcu; L2 < BATCH * NFH * 2; L2 += G) { const int bh = L2 >> 1, s = L2 & 1;
            for (int i = 0; i < 4; ++i) { const int qb = (i == 0) ? s : (i == 1) ? 3 - s : (i == 2) ? 4 + s : 7 - s;
                attn_body::attn_unit<8>(bh >> 3, bh & 7, qb, (const attn_body::bf16*)(ws + WS_Q), (const attn_body::bf16*)(ws + WS_K), (const attn_body::bf16*)(ws + WS_V),
                                        (attn_body::bf16*)(ws + WS_MIXN), (const float*)(ws + WS_CB), (float*)(ws + WS_SSQF), (char*)lds, skip_th); } }
    }
    if (ON(6)) {
        KA
        pg8::Gemm g{WSB(WS_UG), WSB(WS_BTE), UGP, 512, 256}; GOrder<OK_S5E> S; S.init(256, 1, G, bx, UGP, 512);
        Epi<EK_S5E> E{ws + WS_EPART, nullptr, nullptr, nullptr, nullptr, nullptr, nullptr};
        pg8::gemm_phase(L, g, S, E);
        SYNC(6);
    }
    if (ON(7)) {
        KA
        IDS
        const float* kt = (const float*)(ws + WS_KTAB); bf16_t* bty = (bf16_t*)(ws + WS_BTY);
        for (int idx = gt; idx < S5G * 512 * 64; idx += NGT) {
            const int half = idx & 1, ss = (idx >> 1) & 31, nn = (idx >> 6) & 511, gI = idx >> 15; const int tt = nn >> 4, c = nn & 15;
            u32x4 w = (u32x4){0u, 0u, 0u, 0u};
            if (ss <= tt) { const float* src = kt + ((size_t)((gI * TC + (tt - ss)) * 16 + c)) * 16 + half * 8; const f32x4 k0 = *(const f32x4*)src, k1 = *(const f32x4*)(src + 4);
                w.x = pk2(k0[0], k0[1]); w.y = pk2(k0[2], k0[3]); w.z = pk2(k1[0], k1[1]); w.w = pk2(k1[2], k1[3]); }
            *(u32x4*)(bty + ((size_t)gI * 512 + nn) * UGP + ss * 16 + half * 8) = w; }
        const float* ep = (const float*)(ws + WS_EPART); const float* lb = (const float*)(ws + WS_LB32); bf16_t* ug = (bf16_t*)(ws + WS_UG);
        for (int idx = gt; idx < S5G * BATCH * S5P; idx += NGT) { const int p = idx & 63, gb = idx >> 6, gI = gb >> 4;
            const float lr = lb[(gI * 64 + p) * 2], li = lb[(gI * 64 + p) * 2 + 1]; float sr = 0.f, si = 0.f;
            for (int k0 = 0; k0 < NCH; k0 += 16) {
                f32x2 e0[16], e1[16];
#pragma unroll
                for (int j = 0; j < 16; ++j) { const size_t row = (size_t)gb * NCH + k0 + j; e0[j] = *(const f32x2*)(ep + row * 128 + 2 * p); e1[j] = *(const f32x2*)(ep + (size_t)32768 * 128 + row * 128 + 2 * p); }
#pragma unroll
                for (int j = 0; j < 16; ++j) { const size_t row = (size_t)gb * NCH + k0 + j;
                    *(unsigned*)(ug + row * UGP + 512 + 2 * p) = pk2(sr, si);
                    const float nr = lr * sr - li * si + (e0[j][0] + e1[j][0]), ni = lr * si + li * sr + (e0[j][1] + e1[j][1]); sr = nr; si = ni; } } }
        SYNC(7);
    }
    if (ON(8)) {
        KA
        pg8::Gemm g{WSB(WS_UG), WSB(WS_BTY), UGP, UGP, UGP}; GOrder<OK_S5Y> S; S.init(256, 1, G, bx, UGP, UGP);
        Epi<EK_S5Y> E{ws + WS_Y1, nullptr, nullptr, nullptr, nullptr, nullptr, nullptr};
        pg8::gemm_phase(L, g, S, E);
        SYNC(8);
    }
    if (ON(9)) {
        KA
        pg8::Gemm g{WSB(WS_Y1), WSB(WS_WGLU), 512, 512, 512}; GOrder<OK_PLAIN> S; S.init(T / 256, 2, G, bx, 512, 512);
        Epi<EK_GLU> E{ws + WS_MIXN, ws + WS_SSQY, nullptr, nullptr, ws + WS_Y1, in[I_BGLU], nullptr};
        pg8::gemm_phase(L, g, S, E);
        SYNC(9);
    }
    if (ON(11)) {
        KA
        pg8::Gemm g{WSB(WS_MIXN), WSB(WS_WOUT), DM, DM, DM}; GOrder<OK_PLAIN> S; S.init(T / 256, 4, G, bx, DM, DM);
        Epi<EK_WOUT> E{nullptr, ws + WS_H1B, ws + WS_SSQ1, nullptr, in[I_X], ws + WS_SSQF, ws + WS_SSQY};
        pg8::gemm_phase(L, g, S, E);
        SYNC(11);
    }
    if (ON(12)) {
        KA
        IDS
        const float* sk = (const float*)(ws + WS_SSQK); float* sck = (float*)(ws + WS_SCK);
        for (int idx = gt; idx < TM * 4; idx += NGT) { const int key = idx >> 2, h = idx & 3; const f32x4 q = *(const f32x4*)(sk + (size_t)key * 16 + h * 4);
            sck[(size_t)h * TM + key] = rsqrtf(((q[0] + q[1]) + (q[2] + q[3])) * (1.f / 256.f) + EPS); }
        { const float* s1 = (const float*)(ws + WS_SSQ1); float* r1 = (float*)(ws + WS_RS1);
          for (int row = gt; row < T; row += NGT) { const f32x4 t0 = *(const f32x4*)(s1 + (size_t)row * 16), t1 = *(const f32x4*)(s1 + (size_t)row * 16 + 4), t2 = *(const f32x4*)(s1 + (size_t)row * 16 + 8), t3 = *(const f32x4*)(s1 + (size_t)row * 16 + 12);
              r1[row] = rsqrtf((((t0[0] + t0[1]) + (t0[2] + t0[3])) + ((t1[0] + t1[1]) + (t1[2] + t1[3])) + ((t2[0] + t2[1]) + (t2[2] + t2[3])) + ((t3[0] + t3[1]) + (t3[2] + t3[3]))) * (1.f / DM) + EPS); } }
        pg8::Gemm g{WSB(WS_H1B), WSB(WS_WXQ), DM, DM, DM}; GOrder<OK_PLAIN> S; S.init(T / 256, 4, G, bx, DM, DM);
        Epi<EK_XQ> E{ws + WS_QST, ws + WS_SSQQ, nullptr, nullptr, in[I_XQN], in[I_XKN], nullptr};
        pg8::gemm_phase(L, g, S, E);
        SYNC(12);
    }
    if (ON(13)) {
        KA
        pg8::Gemm g{WSB(WS_QST), WSB(WS_KST), DM, DM, 256}; GOrder<OK_XS> S; S.init(512, 1, G, bx, DM, DM);
        Epi<EK_XS> E{ws + WS_P, ws + WS_PSUM, nullptr, nullptr, ws + WS_RS1, ws + WS_SSQQ, ws + WS_SCK};
        pg8::gemm_phase(L, g, S, E);
        SYNC(13);
    }
    if (ON(14)) {
        KA
        pg8::Gemm g{WSB(WS_P), WSB(WS_VT), DM, TM, 256}; GOrder<OK_XO> S; S.init(512, 1, G, bx, DM, TM);
        Epi<EK_XO> E{ws + WS_XO, nullptr, nullptr, nullptr, ws + WS_PSUM, nullptr, nullptr};
        pg8::gemm_phase(L, g, S, E);
        SYNC(14);
    }
    if (ON(15)) {
        KA
        pg8::Gemm g{WSB(WS_XO), WSB(WS_WXO), DM, DM, DM}; GOrder<OK_PLAIN> S; S.init(T / 256, 4, G, bx, DM, DM);
        Epi<EK_WXO> E{nullptr, ws + WS_H2B, ws + WS_SSQ2, nullptr, ws + WS_H1B, nullptr, nullptr};
        pg8::gemm_phase(L, g, S, E);
        SYNC(15);
    }
    if (ON(16)) {
        KA
        { IDS
          const float* s2 = (const float*)(ws + WS_SSQ2); float* r2 = (float*)(ws + WS_RS2);
          for (int row = gt; row < T; row += NGT) { const f32x4 t0 = *(const f32x4*)(s2 + (size_t)row * 16), t1 = *(const f32x4*)(s2 + (size_t)row * 16 + 4), t2 = *(const f32x4*)(s2 + (size_t)row * 16 + 8), t3 = *(const f32x4*)(s2 + (size_t)row * 16 + 12);
              r2[row] = rsqrtf((((t0[0] + t0[1]) + (t0[2] + t0[3])) + ((t1[0] + t1[1]) + (t1[2] + t1[3])) + ((t2[0] + t2[1]) + (t2[2] + t2[3])) + ((t3[0] + t3[1]) + (t3[2] + t3[3]))) * (1.f / DM) + EPS); }
          SYNC(15); }
        pg8::Gemm g{WSB(WS_H2B), WSB(WS_WUP), DM, DM, DM}; GOrder<OK_PLAIN> S; S.init(T / 256, 22, G, bx, DM, DM);
        Epi<EK_UPC> E{ws + WS_U, ws + WS_G, ws + WS_G + 4 * MiB, ws + WS_G + 8 * MiB, ws + WS_RS2, in[I_CONVW], in[I_CONVB], (LAS float*)(L + RING_BYTES + 1024)};
        pg8::gemm_phase(L, g, S, E);
        SYNC(16);
    }
    if (ON(17)) {
        KA
        IDS
        const float* GHF = (const float*)(ws + WS_G); const float* GHL = (const float*)(ws + WS_G + 4 * MiB); const float* UH = (const float*)(ws + WS_G + 8 * MiB);
        const float* cw = in[I_CONVW]; const float* cbv = in[I_CONVB]; bf16_t* A = (bf16_t*)(ws + WS_U);
        for (int idx = gt; idx < (T / 256) * 2 * DFF; idx += NGT) { const int j = idx % DFF, pi = idx / DFF, i = pi & 1, pm = pi >> 1; const bool first = (pm & 7) == 0;
            const float g0 = GHF[(size_t)pi * DFF + j];
            const float gl1 = first ? 0.f : GHL[((size_t)(pm - 1) * 2 + 1) * DFF + j], gl0 = first ? 0.f : GHL[((size_t)(pm - 1) * 2) * DFF + j];
            const float g1 = i ? GHF[(size_t)(pm * 2) * DFF + j] : gl1, g2 = i ? gl1 : gl0;
            const float z = cbv[j] + cw[j] * g2 + cw[DFF + j] * g1 + cw[2 * DFF + j] * g0;
            A[(size_t)(pm * 256 + i) * DFF + j] = (bf16_t)f2bf(z * sigm(z) * UH[(size_t)pi * DFF + j]); }
        SYNC(17);
    }
    if (ON(18)) {
        KA
        pg8::Gemm g{WSB(WS_U), WSB(WS_WDN), DFF, DFF, DFF}; GOrder<OK_PLAIN> S; S.init(T / 256, 4, G, bx, DFF, DFF);
        Epi<EK_DOWN> E{out, nullptr, nullptr, nullptr, ws + WS_H2B, nullptr, nullptr};
        pg8::gemm_phase(L, g, S, E);
    }
}

extern "C" void kernel_launch(void* const* d_in, const int* in_sizes, int n_in, void* d_out, int out_size, void* d_ws, size_t ws_size, hipStream_t stream) {
    static int grid = 0;
    if (grid == 0) {
        if (n_in != 32 || out_size != T * DM || ws_size < WS_END) { fprintf(stderr, "kernel_launch: unexpected shapes (n_in %d out %d ws %zu)\n", n_in, out_size, ws_size); grid = -1; return; }
        int dev = 0, cus = 0, per_cu = 0;
        (void)hipGetDevice(&dev); (void)hipDeviceGetAttribute(&cus, hipDeviceAttributeMultiprocessorCount, dev);
        if (hipFuncSetAttribute((const void*)fox_s5_mega, hipFuncAttributeMaxDynamicSharedMemorySize, LDS_TOTAL) != hipSuccess) { fprintf(stderr, "kernel_launch: hipFuncSetAttribute failed\n"); grid = -1; return; }
        if (hipOccupancyMaxActiveBlocksPerMultiprocessor(&per_cu, (const void*)fox_s5_mega, 512, LDS_TOTAL) != hipSuccess || per_cu < 1) { fprintf(stderr, "kernel_launch: occupancy query says %d\n", per_cu); per_cu = 1; }
        (void)hipGetLastError();
        grid = cus;
        if (grid > cus * per_cu) grid = cus * per_cu;
    }
    if (grid < 0) return;
    if (hipMemsetAsync(d_ws, 0, 65536, stream) != hipSuccess) { fprintf(stderr, "kernel_launch: memset of the barrier words failed\n"); return; }
    Args a{};
    for (int i = 0; i < 32; ++i) a.in[i] = (const float*)d_in[i];
    a.out = (float*)d_out; a.ws = (unsigned char*)d_ws;
    void* args[] = {&a};
    hipError_t e = hipLaunchCooperativeKernel((const void*)fox_s5_mega, dim3(grid), dim3(512), args, LDS_TOTAL, stream);
    if (e != hipSuccess) fprintf(stderr, "cooperative launch failed: %s (grid %d)\n", hipGetErrorString(e), grid);
}
```
